# Optimizing an MI355X kernel written in HIP

```python
import math
import jax, jax.numpy as jnp
from jax import lax
import numpy as np

D_MODEL = 2048
BATCH = 2
SEQ = 16384
DEPTH = 2

GRID_W = 64
CTX_LEN = 256
N_MIXERS = 2

N_HEADS = 32
N_KV_HEADS = 4
HEAD_DIM = D_MODEL // N_HEADS
GQA_GROUP = N_HEADS // N_KV_HEADS
ATTN_DIM = N_HEADS * HEAD_DIM
KV_DIM = N_KV_HEADS * HEAD_DIM
QKV_DIM = ATTN_DIM + 2 * KV_DIM
WINDOW = 128
BLOCK = 128
ROPE_BASE = 10000.0
AXIS_DIM = HEAD_DIM // 2
NEG_INF = -1e30

HY_EMB = 33
HY_FILTER_WIDTH = 64
HY_FAST_DECAY = 0.3
HY_SLOW_DECAY = 1.5
HY_TARGET = 1e-2
SHORT_CONV = 3

N_EXPERTS = 16
N_GROUPS = 4
EXPERTS_PER_GROUP = N_EXPERTS // N_GROUPS
TOP_K = 2
GROUP_SCORE_K = 2
EXPERT_FF = D_MODEL // 2

LN_EPS = 1e-5
DEEPNORM_ALPHA = (2 * DEPTH) ** 0.25
DEEPNORM_BETA = (8 * DEPTH) ** -0.25
N_ATTN_LAYERS = (DEPTH + N_MIXERS - 1) // N_MIXERS
N_HYENA_LAYERS = DEPTH // N_MIXERS

kernel_name = "hybrid_swa_hyena_grouped_moe_deepnorm"

F32 = jnp.float32


def layer_norm(x, g, b):
    xf = x.astype(F32)
    mu = jnp.mean(xf, axis=-1, keepdims=True)
    var = jnp.mean(jnp.square(xf - mu), axis=-1, keepdims=True)
    out = (xf - mu) * lax.rsqrt(var + LN_EPS) * g.astype(F32) + b.astype(F32)
    return out.astype(x.dtype)


def ada_modulation(cond, w, b):
    m = jax.nn.silu(cond) @ w + b
    return jnp.split(m, 6, axis=-1)


def axial_rope_tables(n_tok):
    rows = n_tok // GRID_W
    row = jnp.repeat(jnp.arange(rows, dtype=F32), GRID_W)
    col = jnp.tile(jnp.arange(GRID_W, dtype=F32), rows)
    inv = ROPE_BASE ** (-jnp.arange(0, AXIS_DIM, 2, dtype=F32) / AXIS_DIM)
    ang_r = row[:, None] * inv
    ang_c = col[:, None] * inv
    return (jnp.cos(ang_r), jnp.sin(ang_r), jnp.cos(ang_c), jnp.sin(ang_c))


def rotate_pairs(xh, cos, sin):
    x1, x2 = jnp.split(xh, 2, axis=-1)
    return jnp.concatenate([x1 * cos - x2 * sin, x2 * cos + x1 * sin], axis=-1)


def apply_axial_rope(x, tables):
    cos_r, sin_r, cos_c, sin_c = tables
    shape = (1, x.shape[1]) + (1,) * (x.ndim - 3) + (AXIS_DIM // 2,)
    rs = lambda t: t.reshape(shape).astype(x.dtype)
    xr = rotate_pairs(x[..., :AXIS_DIM], rs(cos_r), rs(sin_r))
    xc = rotate_pairs(x[..., AXIS_DIM:], rs(cos_c), rs(sin_c))
    return jnp.concatenate([xr, xc], axis=-1)


def banded_window_attention(q, k, v, kc, vc, sink_kg):
    B, S = q.shape[0], q.shape[1]
    C = kc.shape[1]
    nb = S // BLOCK
    kp = jnp.pad(k, ((0, 0), (BLOCK, BLOCK), (0, 0), (0, 0)))
    vp = jnp.pad(v, ((0, 0), (BLOCK, BLOCK), (0, 0), (0, 0)))
    qb = q.reshape(B, nb, BLOCK, N_KV_HEADS, GQA_GROUP, HEAD_DIM).transpose(1, 0, 2, 3, 4, 5)
    rr = jnp.arange(BLOCK)
    jj = jnp.arange(3 * BLOCK)
    band = jnp.abs(jj[None, :] - BLOCK - rr[:, None]) <= WINDOW
    s_sink = jnp.broadcast_to(sink_kg[None, :, :, None, None], (B, N_KV_HEADS, GQA_GROUP, BLOCK, 1))

    def one_block(args):
        n, qblk = args
        start = n * BLOCK
        kb = lax.dynamic_slice_in_dim(kp, start, 3 * BLOCK, axis=1)
        vb = lax.dynamic_slice_in_dim(vp, start, 3 * BLOCK, axis=1)
        kpos = start - BLOCK + jj
        valid = band & ((kpos >= 0) & (kpos < S))[None, :]
        s_loc = jnp.einsum('brkgd,bjkd->bkgrj', qblk, kb).astype(F32)
        s_loc = jnp.where(valid, s_loc, NEG_INF)
        s_ctx = jnp.einsum('brkgd,bckd->bkgrc', qblk, kc).astype(F32)
        probs = jax.nn.softmax(jnp.concatenate([s_loc, s_ctx, s_sink], axis=-1), axis=-1)
        p_loc = probs[..., :3 * BLOCK].astype(v.dtype)
        p_ctx = probs[..., 3 * BLOCK:3 * BLOCK + C].astype(v.dtype)
        return (jnp.einsum('bkgrj,bjkd->brkgd', p_loc, vb)
                + jnp.einsum('bkgrc,bckd->brkgd', p_ctx, vc))

    out = lax.map(one_block, (jnp.arange(nb), qb))
    return out.transpose(1, 0, 2, 3, 4, 5).reshape(B, S, ATTN_DIM)


def context_attention(qc, kc, vc, sink_kg):
    B, C = qc.shape[0], qc.shape[1]
    s = jnp.einsum('bqkgd,bckd->bkgqc', qc, kc).astype(F32)
    s_sink = jnp.broadcast_to(sink_kg[None, :, :, None, None], s.shape[:-1] + (1,))
    pr = jax.nn.softmax(jnp.concatenate([s, s_sink], axis=-1), axis=-1)[..., :C].astype(vc.dtype)
    return jnp.einsum('bkgqc,bckd->bqkgd', pr, vc).reshape(B, C, ATTN_DIM)


def attention_mixer(u, uc, w_in, b_in, sink, w_out, rope, ctx_out):
    B, S = u.shape[0], u.shape[1]
    C = uc.shape[1]
    scale = HEAD_DIM ** -0.5
    p = u @ w_in + b_in
    q = p[..., :ATTN_DIM].reshape(B, S, N_KV_HEADS, GQA_GROUP, HEAD_DIM)
    k = p[..., ATTN_DIM:ATTN_DIM + KV_DIM].reshape(B, S, N_KV_HEADS, HEAD_DIM)
    v = p[..., ATTN_DIM + KV_DIM:].reshape(B, S, N_KV_HEADS, HEAD_DIM)
    q = apply_axial_rope(q, rope) * scale
    k = apply_axial_rope(k, rope)
    if ctx_out:
        pc = uc @ w_in + b_in
        qc = pc[..., :ATTN_DIM].reshape(B, C, N_KV_HEADS, GQA_GROUP, HEAD_DIM) * scale
        kvc = pc[..., ATTN_DIM:]
    else:
        kvc = uc @ w_in[:, ATTN_DIM:] + b_in[ATTN_DIM:]
    kc = kvc[..., :KV_DIM].reshape(B, C, N_KV_HEADS, HEAD_DIM)
    vc = kvc[..., KV_DIM:].reshape(B, C, N_KV_HEADS, HEAD_DIM)
    sink_kg = sink.astype(F32).reshape(N_KV_HEADS, GQA_GROUP)
    y = banded_window_attention(q, k, v, kc, vc, sink_kg) @ w_out
    yc = context_attention(qc, kc, vc, sink_kg) @ w_out if ctx_out else None
    return y, yc


def hyena_pos_features(L):
    t = jnp.linspace(0.0, 1.0, L, dtype=F32)[:, None]
    bands = (HY_EMB - 1) // 2
    w = 2.0 * math.pi * jnp.arange(L, dtype=F32)[:, None] / L
    f = jnp.linspace(1e-4, bands - 1, bands, dtype=F32)[None, :]
    z = jnp.concatenate([t, jnp.cos(f * w), -jnp.sin(f * w)], axis=-1)
    return t, z


def hyena_filter(L, f_w1, f_b1, f_w2, f_b2, f_w3, f_b3, f_freq, f_w4):
    t, z = hyena_pos_features(L)
    freq = f_freq.astype(F32)
    hdn = jnp.sin(freq * (z @ f_w1.astype(F32) + f_b1.astype(F32)))
    hdn = jnp.sin(freq * (hdn @ f_w2.astype(F32) + f_b2.astype(F32)))
    hdn = jnp.sin(freq * (hdn @ f_w3.astype(F32) + f_b3.astype(F32)))
    h = (hdn @ f_w4.astype(F32)).reshape(L, 2, D_MODEL)
    max_decay = math.log(HY_TARGET) / HY_FAST_DECAY
    min_decay = math.log(HY_TARGET) / HY_SLOW_DECAY
    deltas = jnp.abs(jnp.linspace(min_decay, max_decay, D_MODEL, dtype=F32))
    h = h * jnp.exp(-t * deltas)[:, None, :]
    h_fwd, h_bwd = h[:, 0], h[:, 1]
    l1 = jnp.sum(jnp.abs(h_fwd), axis=0) + jnp.sum(jnp.abs(h_bwd[1:]), axis=0)
    h_fwd = h_fwd / l1
    h_bwd = h_bwd / l1
    return jnp.concatenate([h_fwd, jnp.zeros((1, D_MODEL), F32), h_bwd[:0:-1]], axis=0)


def bidirectional_long_conv(z, filt2):
    L = z.shape[1]
    zf = jnp.fft.rfft(z.astype(F32), n=2 * L, axis=1)
    ff = jnp.fft.rfft(filt2, n=2 * L, axis=0)
    y = jnp.fft.irfft(zf * ff[None], n=2 * L, axis=1)[:, :L]
    return y.astype(z.dtype)


def hyena_mixer(u, hp):
    (w_in, b_in, conv_w, conv_b, f_w1, f_b1, f_w2, f_b2, f_w3, f_b3, f_freq, f_w4,
     f_bias, w_out, b_out) = hp
    L = u.shape[1]
    p = u @ w_in + b_in
    pp = jnp.pad(p, ((0, 0), (1, 1), (0, 0)))
    p = conv_w[0] * pp[:, :-2] + conv_w[1] * pp[:, 1:-1] + conv_w[2] * pp[:, 2:] + conv_b
    x0, x1, v = jnp.split(p, 3, axis=-1)
    z = x1 * v
    filt2 = hyena_filter(L, f_w1, f_b1, f_w2, f_b2, f_w3, f_b3, f_freq, f_w4)
    y = x0 * (bidirectional_long_conv(z, filt2) + f_bias * z)
    return y @ w_out + b_out


def grouped_moe(u, router_w, router_b, w1, w3, w2):
    shp = u.shape
    t = u.reshape(-1, D_MODEL)
    T = t.shape[0]
    s = jax.nn.sigmoid((t @ router_w).astype(F32))
    sel = s + router_b.astype(F32)
    grp = sel.reshape(T, N_GROUPS, EXPERTS_PER_GROUP)
    gscore = jnp.sum(lax.top_k(grp, GROUP_SCORE_K)[0], axis=-1)
    gbest = jnp.argmax(gscore, axis=-1)
    in_group = (jnp.arange(N_EXPERTS) // EXPERTS_PER_GROUP)[None, :] == gbest[:, None]
    _, idx = lax.top_k(jnp.where(in_group, sel, -jnp.inf), TOP_K)
    g = jnp.take_along_axis(s, idx, axis=-1)
    g = g / jnp.sum(g, axis=-1, keepdims=True)
    combine = jnp.sum(jax.nn.one_hot(idx, N_EXPERTS, dtype=F32) * g[..., None], axis=1)
    y = jnp.zeros_like(t)
    for e in range(N_EXPERTS):
        hid = jax.nn.silu(t @ w1[e]) * (t @ w3[e])
        y = y + combine[:, e:e + 1].astype(t.dtype) * (hid @ w2[e])
    return y.reshape(shp)


def setup_inputs(seed: int = 0) -> dict:
    key = jax.random.key(seed)
    ks = iter(jax.random.split(key, 40))
    nrm = lambda shape, s: jax.random.normal(next(ks), shape, F32) * s
    D, NA, NH = D_MODEL, N_ATTN_LAYERS, N_HYENA_LAYERS
    return {
        "x": nrm((BATCH, SEQ, D), 1.0),
        "c": nrm((BATCH, D), 1.0),
        "ctx": nrm((BATCH, CTX_LEN, D), 1.0),
        "c_ctx": nrm((D,), 1.0),
        "ada_w": nrm((DEPTH, D, 6 * D), 0.5 * D ** -0.5),
        "ada_b": nrm((DEPTH, 6 * D), 0.02),
        "attn_w_in": nrm((NA, D, QKV_DIM), D ** -0.5),
        "attn_b_in": nrm((NA, QKV_DIM), 0.02),
        "attn_sink": nrm((NA, N_HEADS), 0.5),
        "attn_w_out": nrm((NA, ATTN_DIM, D), DEEPNORM_BETA * ATTN_DIM ** -0.5),
        "hy_w_in": nrm((NH, D, 3 * D), D ** -0.5),
        "hy_b_in": nrm((NH, 3 * D), 0.02),
        "hy_conv_w": nrm((NH, SHORT_CONV, 3 * D), SHORT_CONV ** -0.5),
        "hy_conv_b": nrm((NH, 3 * D), 0.02),
        "hy_f_w1": nrm((NH, HY_EMB, HY_FILTER_WIDTH), HY_EMB ** -0.5),
        "hy_f_b1": nrm((NH, HY_FILTER_WIDTH), 0.1),
        "hy_f_w2": nrm((NH, HY_FILTER_WIDTH, HY_FILTER_WIDTH), HY_FILTER_WIDTH ** -0.5),
        "hy_f_b2": nrm((NH, HY_FILTER_WIDTH), 0.1),
        "hy_f_w3": nrm((NH, HY_FILTER_WIDTH, HY_FILTER_WIDTH), HY_FILTER_WIDTH ** -0.5),
        "hy_f_b3": nrm((NH, HY_FILTER_WIDTH), 0.1),
        "hy_f_freq": 1.0 + nrm((NH, HY_FILTER_WIDTH), 0.02),
        "hy_f_w4": nrm((NH, HY_FILTER_WIDTH, 2 * D), HY_FILTER_WIDTH ** -0.5),
        "hy_f_bias": nrm((NH, D), 1.0),
        "hy_w_out": nrm((NH, D, D), DEEPNORM_BETA * D ** -0.5),
        "hy_b_out": nrm((NH, D), 0.02),
        "ln1_g": 1.0 + nrm((DEPTH, D), 0.02),
        "ln1_b": nrm((DEPTH, D), 0.02),
        "ln2_g": 1.0 + nrm((DEPTH, D), 0.02),
        "ln2_b": nrm((DEPTH, D), 0.02),
        "router_w": nrm((D, N_EXPERTS), D ** -0.5),
        "router_b": nrm((N_EXPERTS,), 0.01),
        "moe_w1": nrm((DEPTH, N_EXPERTS, D, EXPERT_FF), D ** -0.5),
        "moe_w3": nrm((DEPTH, N_EXPERTS, D, EXPERT_FF), D ** -0.5),
        "moe_w2": nrm((DEPTH, N_EXPERTS, EXPERT_FF, D), DEEPNORM_BETA * EXPERT_FF ** -0.5),
    }


def reference(x, c, ctx, c_ctx, ada_w, ada_b, attn_w_in, attn_b_in, attn_sink, attn_w_out,
              hy_w_in, hy_b_in, hy_conv_w, hy_conv_b, hy_f_w1, hy_f_b1, hy_f_w2, hy_f_b2,
              hy_f_w3, hy_f_b3, hy_f_freq, hy_f_w4, hy_f_bias, hy_w_out, hy_b_out,
              ln1_g, ln1_b, ln2_g, ln2_b, router_w, router_b, moe_w1, moe_w3, moe_w2):
    rope = axial_rope_tables(x.shape[1])
    attn_layers = [i for i in range(DEPTH) if i % N_MIXERS == 0]
    last_attn = attn_layers[-1]
    h, hc = x, ctx
    for i in range(DEPTH):
        mixer = i % N_MIXERS
        j = i // N_MIXERS
        ctx_out = i < last_attn
        ctx_used = ctx_out or mixer == 0
        sh1, sc1, g1, sh2, sc2, g2 = [m[:, None, :] for m in ada_modulation(c, ada_w[i], ada_b[i])]
        u = h * (1.0 + sc1) + sh1
        if ctx_used:
            csh1, csc1, cg1, csh2, csc2, cg2 = ada_modulation(c_ctx, ada_w[i], ada_b[i])
            uc = hc * (1.0 + csc1) + csh1
        if mixer == 0:
            y, yc = attention_mixer(u, uc, attn_w_in[j], attn_b_in[j], attn_sink[j], attn_w_out[j],
                                    rope, ctx_out)
        else:
            hp = (hy_w_in[j], hy_b_in[j], hy_conv_w[j], hy_conv_b[j], hy_f_w1[j], hy_f_b1[j],
                  hy_f_w2[j], hy_f_b2[j], hy_f_w3[j], hy_f_b3[j], hy_f_freq[j], hy_f_w4[j],
                  hy_f_bias[j], hy_w_out[j], hy_b_out[j])
            y = hyena_mixer(u, hp)
            yc = hyena_mixer(uc, hp) if ctx_out else None
        h = layer_norm(DEEPNORM_ALPHA * h + g1 * y, ln1_g[i], ln1_b[i])
        f = grouped_moe(h * (1.0 + sc2) + sh2, router_w, router_b, moe_w1[i], moe_w3[i], moe_w2[i])
        h = layer_norm(DEEPNORM_ALPHA * h + g2 * f, ln2_g[i], ln2_b[i])
        if ctx_out:
            hc = layer_norm(DEEPNORM_ALPHA * hc + cg1 * yc, ln1_g[i], ln1_b[i])
            fc = grouped_moe(hc * (1.0 + csc2) + csh2, router_w, router_b, moe_w1[i], moe_w3[i], moe_w2[i])
            hc = layer_norm(DEEPNORM_ALPHA * hc + cg2 * fc, ln2_g[i], ln2_b[i])
    return h
```

```cpp
#include <hip/hip_runtime.h>
#include <hip/hip_bf16.h>
#include <cstdio>
#include <cstdint>

#ifndef MK_SPLIT
#define MK_SPLIT 0
#endif

#define GAS __attribute__((address_space(1)))
#define LAS __attribute__((address_space(3)))
typedef unsigned short bf16;
typedef unsigned u32x4 __attribute__((ext_vector_type(4)));
typedef unsigned u32x2 __attribute__((ext_vector_type(2)));
typedef float f32x2 __attribute__((ext_vector_type(2)));
typedef float f32x4 __attribute__((ext_vector_type(4)));
typedef float f32x16 __attribute__((ext_vector_type(16)));
typedef short bf16x8 __attribute__((ext_vector_type(8)));
typedef short s16x4 __attribute__((ext_vector_type(4)));
typedef GAS unsigned gu32;

constexpr int DM = 2048, NB = 2, SEQ = 16384, MTOK = NB * SEQ, CTXL = 256, GRIDW = 64;
constexpr int NHEAD = 32, NKV = 4, HD = 64, QKVD = 2560, KVD = 256;
constexpr int NEXP = 16, EFF = 1024, NCLS = 24, LCAP = 32768;
constexpr int HYW = 64, HYEMB = 33;
constexpr float LN_EPS = 1e-5f;
constexpr float DN_ALPHA = 1.41421356237309515f;
constexpr float QSCALE = 0.125f * 1.4426950408889634f;
constexpr int NWAVES = 8, NTHR = 512;

constexpr size_t MiB = 1u << 20;
constexpr size_t WS_CTL = 0, CTL_ZERO_BYTES = 1 * MiB;
constexpr size_t WS_MOD = 1 * MiB;
constexpr size_t WS_ROPE = 1 * MiB + 512 * 1024;
constexpr size_t WS_CTXKV = 2 * MiB;
constexpr size_t WS_HDN = 3 * MiB;
constexpr size_t WS_W4T = 7 * MiB;
constexpr size_t WS_TOK = 8 * MiB;
constexpr size_t WS_GATE = 11 * MiB;
constexpr size_t WS_FFTS = 32 * MiB;
constexpr size_t WS_HT = 128 * MiB;
constexpr size_t WS_WQKV = 256 * MiB;
constexpr size_t WS_WO0 = 266 * MiB;
constexpr size_t WS_WHYIN = 274 * MiB;
constexpr size_t WS_WHYO = 298 * MiB;
constexpr size_t WS_W13 = 320 * MiB;
constexpr size_t WS_W2 = 576 * MiB;
constexpr size_t WS_A = 704 * MiB;
constexpr size_t WS_B = 832 * MiB;
constexpr size_t WS_END = 1216 * MiB;
constexpr int HID_ROWS = 38912;

constexpr int CW_TMO = 0;
constexpr int CW_BAR = 4096;
constexpr int CW_CNT = 16384;

constexpr int RING_BYTES = 131072;
constexpr int MISC_OFF = RING_BYTES + 320;
constexpr int LDS_BYTES = 147456;

#define RLX_AGENT __ATOMIC_RELAXED, __HIP_MEMORY_SCOPE_AGENT
#define LDS_WAIT() asm volatile("s_waitcnt lgkmcnt(0)" ::: "memory")
#define VM_WAIT() asm volatile("s_waitcnt vmcnt(0)" ::: "memory")

__device__ __forceinline__ unsigned cvt_pk_bf16(float lo, float hi) { unsigned r; asm volatile("v_cvt_pk_bf16_f32 %0, %1, %2" : "=v"(r) : "v"(lo), "v"(hi)); return r; }
__device__ __forceinline__ float bf2f(unsigned h) { return __builtin_bit_cast(float, h << 16); }
__device__ __forceinline__ float bflo(unsigned w) { return __builtin_bit_cast(float, w << 16); }
__device__ __forceinline__ float bfhi(unsigned w) { return __builtin_bit_cast(float, w & 0xffff0000u); }
__device__ __forceinline__ float wave_sum(float v) {
    v += __builtin_bit_cast(float, __builtin_amdgcn_update_dpp(0, __builtin_bit_cast(int, v), 0xB1, 0xf, 0xf, true));
    v += __builtin_bit_cast(float, __builtin_amdgcn_update_dpp(0, __builtin_bit_cast(int, v), 0x4E, 0xf, 0xf, true));
    v += __builtin_bit_cast(float, __builtin_amdgcn_update_dpp(0, __builtin_bit_cast(int, v), 0x141, 0xf, 0xf, true));
    v += __builtin_bit_cast(float, __builtin_amdgcn_update_dpp(0, __builtin_bit_cast(int, v), 0x140, 0xf, 0xf, true));
    { auto r = __builtin_amdgcn_permlane16_swap(__float_as_uint(v), __float_as_uint(v), false, false); v = __uint_as_float(r[0]) + __uint_as_float(r[1]); }
    { auto r = __builtin_amdgcn_permlane32_swap(__float_as_uint(v), __float_as_uint(v), false, false); v = __uint_as_float(r[0]) + __uint_as_float(r[1]); }
    return v;
}

#define XB_TMO      128
#define XB_XCNT(j)  (256  + 64 * (j))
#define XB_XSUB(j)  (1280 + 64 * (j))
#define XB_XGEN(j)  (2304 + 64 * (j))
#define XB_TOP      3328
#define XB_TOPGEN   3392
#define XCD_BAR_WORDS 3456
#define XB_SPIN_CAP (1u << 18)

__device__ __forceinline__ unsigned xb_ld(unsigned* p)              { return __hip_atomic_load(p, __ATOMIC_RELAXED, __HIP_MEMORY_SCOPE_AGENT); }
__device__ __forceinline__ unsigned xb_add(unsigned* p, unsigned v) { return __hip_atomic_fetch_add(p, v, __ATOMIC_RELAXED, __HIP_MEMORY_SCOPE_AGENT); }
__device__ __forceinline__ unsigned xb_xcc_id() { return (unsigned)__builtin_amdgcn_s_getreg((3 << 11) | 20) & 0xFu; }
#define XB_SPIN(cond, bar) do { unsigned _sp = 0; while (cond) { __builtin_amdgcn_s_sleep(1); \
    if ((++_sp & 255u) == 0u) { if (xb_ld(&(bar)[XB_TMO])) break; if (_sp > XB_SPIN_CAP) { atomicAdd(&(bar)[XB_TMO], 1u); break; } } } } while (0)

struct XcdBarrier { unsigned* bar; unsigned x; volatile LAS unsigned* st; };

__device__ __forceinline__ XcdBarrier xcd_barrier_post(unsigned* bar, volatile LAS unsigned* st) {
    XcdBarrier b; b.bar = bar; b.x = xb_xcc_id(); b.st = st;
    if (threadIdx.x == 0) (void)xb_add(&bar[XB_XCNT(b.x)], 1u);
    return b;
}
__device__ __forceinline__ void xcd_barrier_complete(unsigned* bar, unsigned x, unsigned& nloc, unsigned& nx) {
    const unsigned G = gridDim.x * gridDim.y * gridDim.z;
    unsigned sum, cnt, mine, sp = 0u;
    for (;;) {
        sum = 0u; cnt = 0u; mine = 0u;
#pragma unroll
        for (unsigned j = 0; j < 16; ++j) { const unsigned c = xb_ld(&bar[XB_XCNT(j)]); sum += c; cnt += (c > 0u) ? 1u : 0u; mine = (j == x) ? c : mine; }
        if (sum == G) break;
        __builtin_amdgcn_s_sleep(1);
        if ((++sp & 255u) == 0u) { if (xb_ld(&bar[XB_TMO])) break; if (sp > XB_SPIN_CAP) { atomicAdd(&bar[XB_TMO], 1u); break; } }
    }
    nloc = mine > 0u ? mine : 1u; nx = cnt > 0u ? cnt : 1u;
}
__device__ __forceinline__ void xcd_barrier(const XcdBarrier& b) {
    asm volatile("s_waitcnt vmcnt(0)" ::: "memory");
    __syncthreads();
    if (threadIdx.x == 0) {
        unsigned* bar = b.bar;
        __builtin_amdgcn_s_waitcnt(0);
        unsigned nloc = b.st[0], nx = b.st[1];
        if (nloc == 0u) { xcd_barrier_complete(bar, b.x, nloc, nx); b.st[0] = nloc; b.st[1] = nx; }
        const unsigned old = xb_add(&bar[XB_XSUB(b.x)], 1u);
        const unsigned gen = old / nloc;
        if (old + 1u == (gen + 1u) * nloc) {
            __builtin_amdgcn_fence(__ATOMIC_RELEASE, "agent");
            asm volatile("s_waitcnt vmcnt(0)" ::: "memory");
            const unsigned og = xb_add(&bar[XB_TOP], 1u);
            const unsigned tg = og / nx;
            if (og + 1u == (tg + 1u) * nx) xb_add(&bar[XB_TOPGEN], 1u);
            else XB_SPIN(xb_ld(&bar[XB_TOPGEN]) == tg, bar);
            __builtin_amdgcn_fence(__ATOMIC_ACQUIRE, "agent");
            xb_add(&bar[XB_XGEN(b.x)], 1u);
            asm volatile("s_waitcnt vmcnt(0)" ::: "memory");
        } else {
            XB_SPIN(xb_ld(&bar[XB_XGEN(b.x)]) == gen, bar);
            __builtin_amdgcn_fence(__ATOMIC_ACQUIRE, "agent");
            asm volatile("s_waitcnt vmcnt(0)" ::: "memory");
        }
    }
    __syncthreads();
}

namespace pg {
constexpr int BM = 256, BK = 64, HALF = 128, HTB = HALF * BK * 2, NXCD = 8, WGM = 8;
__host__ __device__ __forceinline__ int lds_byte(int r, int c) { const int st = (r >> 4) * 2 + (c >> 5), rr = r & 15, cc = c & 31, ob = rr * 64 + cc * 2; return st * 1024 + (ob ^ (((ob >> 9) & 1) << 5)); }
__host__ __device__ __forceinline__ void stage_rc(int b, int& R, int& C) { const int st = b / 1024, sb = b % 1024, swz = sb ^ (((sb >> 9) & 1) << 5); R = (st >> 1) * 16 + swz / 64; C = (st & 1) * 32 + (swz % 64) / 2; }
__host__ __device__ __forceinline__ int perm32(int rho) { const int n = rho >> 4, i = rho & 15; return 8 * (i >> 2) + 4 * n + (i & 3); }

struct Unit { int pm, pn; const char* A; const char* B; const char* B2; int cls, row0, nrows, lbase; };

__device__ __forceinline__ bool static_map(int i, int G, int c, int nM, int nN, int& pm, int& pn) {
    const int nwg = nM * nN; const long L = (long)i * G + c; if (L >= nwg) return false;
    int wgid = (int)L; { const int q = nwg / NXCD, r = nwg % NXCD, xcd = wgid % NXCD, off = wgid / NXCD; wgid = (xcd < r ? xcd * (q + 1) : r * (q + 1) + (xcd - r) * q) + off; }
    const int nig = WGM * nN, gid = wgid / nig, fm = gid * WGM, gsz = (nM - fm) < WGM ? (nM - fm) : WGM;
    pm = fm + ((wgid % nig) % gsz); pn = (wgid % nig) / gsz; return true;
}
struct PlainSched {
    const char* A; const char* Bt; int nM, nN, G, c; size_t tA, tB;
    __device__ __forceinline__ void init(const void* A_, const void* Bt_, int M, int N, int ldA, int ldB, int G_, int c_) { A = (const char*)A_; Bt = (const char*)Bt_; nM = M / BM; nN = N / BM; G = G_; c = c_; tA = (size_t)BM * ldA * 2; tB = (size_t)BM * ldB * 2; }
    __device__ __forceinline__ bool next(int i, Unit& u) const {
        if (!static_map(i, G, c, nM, nN, u.pm, u.pn)) return false;
        u.A = A + (size_t)u.pm * tA; u.B = Bt + (size_t)u.pn * tB; u.B2 = u.B; u.cls = 0; u.row0 = 0; u.nrows = 256; u.lbase = 0; return true;
    }
    __device__ __forceinline__ unsigned row_off(const Unit&, int r, int ldA) const { return (unsigned)r * (unsigned)ldA * 2u; }
};

template <class Epi, class Sched, bool GATHER, bool KSPLIT, bool ALIGN_EPI>
__device__ __forceinline__ void gemm_phase(LAS unsigned char* lds, const int tid, const int K, const int ldA, const int ldB, const Sched& S, const Epi& E) {
    const int wid = __builtin_amdgcn_readfirstlane(tid >> 6), lane = tid & 63, wr = wid >> 2, wc = wid & 3, fr = lane & 15, fq = lane >> 4;
    const int nt = K / BK, nth = nt >> 1;
    int RA[2], CA[2];
    unsigned voffB[2], voA[2][2], nvoA[2][2];
#pragma unroll
    for (int i = 0; i < 2; ++i) { int R, C; stage_rc(tid * 16 + i * 8192, R, C); const int Rb = Epi::PERM ? ((R & ~31) + perm32(R & 31)) : R;
        RA[i] = R; CA[i] = C; voffB[i] = (unsigned)(Rb * ldB + C) * 2u;
        voA[0][i] = (unsigned)(R * ldA + C) * 2u; voA[1][i] = (unsigned)((R + HALF) * ldA + C) * 2u; nvoA[0][i] = voA[0][i]; nvoA[1][i] = voA[1][i]; }
    const size_t kstep = (size_t)(BK * 2);
    const size_t hstepB = (size_t)HALF * ldB * 2;
    const unsigned ldsw = (unsigned)wid * 1024u;
    const int aoff = lds_byte(wr * 64 + fr, fq * 8), boff = lds_byte(wc * 32 + fr, fq * 8);
#define PG8_SA(b, h) (((b) * 2 + (h)) * HTB)
#define PG8_SB(b, h) ((4 + (b) * 2 + (h)) * HTB)
#define PG8_STAGEB(bufoff, gbase) do { _Pragma("unroll") for (int _i = 0; _i < 2; ++_i) \
        __builtin_amdgcn_global_load_lds((const unsigned*)((const char*)(gbase) + voffB[_i]), (LAS unsigned*)(lds + (bufoff) + ldsw + _i * 8192), 16, 0, 0); } while (0)
#define PG8_STAGEA(bufoff, gbase, vo, h) do { _Pragma("unroll") for (int _i = 0; _i < 2; ++_i) \
        __builtin_amdgcn_global_load_lds((const unsigned*)((const char*)(gbase) + (vo)[h][_i]), (LAS unsigned*)(lds + (bufoff) + ldsw + _i * 8192), 16, 0, 0); } while (0)
#define PG8_LDA(dst, b, h) do { _Pragma("unroll") for (int m = 0; m < 4; ++m) _Pragma("unroll") for (int k = 0; k < 2; ++k) dst[m][k] = *(const LAS bf16x8*)(lds + PG8_SA(b, h) + aoff + m * 2048 + k * 1024); } while (0)
#define PG8_LDB(dst, b, h) do { _Pragma("unroll") for (int n = 0; n < 2; ++n) _Pragma("unroll") for (int k = 0; k < 2; ++k) dst[n][k] = *(const LAS bf16x8*)(lds + PG8_SB(b, h) + boff + n * 2048 + k * 1024); } while (0)
#define PG8_MMA(ai, bj, At, Bt) do { __builtin_amdgcn_s_setprio(1); _Pragma("unroll") for (int m = 0; m < 4; ++m) _Pragma("unroll") for (int n = 0; n < 2; ++n) _Pragma("unroll") for (int k = 0; k < 2; ++k) \
        acc[ai][bj][m][n] = __builtin_amdgcn_mfma_f32_16x16x32_bf16(Bt[n][k], At[m][k], acc[ai][bj][m][n], 0, 0, 0); __builtin_amdgcn_s_setprio(0); } while (0)
#define PG8_WAIT_V(n) asm volatile("s_waitcnt vmcnt(" #n ")" ::: "memory")
#define PG8_WAIT_L(n) asm volatile("s_waitcnt lgkmcnt(" #n ")" ::: "memory")
#define PG8_BAR __builtin_amdgcn_s_barrier()
#define PG8_SCHED __builtin_amdgcn_sched_barrier(0)
#define PG8_BPTR(tt) ((KSPLIT && (tt) >= nth) ? cB2 + (size_t)((tt) - nth) * kstep : cB + (size_t)(tt) * kstep)
    Unit cur, nxt; int ui = 0;
    if (!S.next(0, cur)) return;
    if constexpr (GATHER) {
#pragma unroll
        for (int h = 0; h < 2; ++h)
#pragma unroll
            for (int i = 0; i < 2; ++i) voA[h][i] = S.row_off(cur, h * HALF + RA[i], ldA) + (unsigned)CA[i] * 2u;
    }
    f32x4 acc[2][2][4][2];
#pragma unroll
    for (int a = 0; a < 2; ++a)
#pragma unroll
        for (int b = 0; b < 2; ++b)
#pragma unroll
            for (int m = 0; m < 4; ++m)
#pragma unroll
                for (int n = 0; n < 2; ++n) acc[a][b][m][n] = (f32x4){0.f, 0.f, 0.f, 0.f};
    bf16x8 At[4][2], B0[2][2], B1[2][2];
    const char* cA = cur.A; const char* cB = cur.B; const char* cB2 = cur.B2;
    PG8_STAGEB(PG8_SB(0, 0), cB); PG8_STAGEB(PG8_SB(0, 1), cB + hstepB); PG8_STAGEA(PG8_SA(0, 0), cA, voA, 0); PG8_STAGEA(PG8_SA(0, 1), cA, voA, 1);
    if (wr == 1) PG8_BAR;
    PG8_WAIT_V(2); PG8_BAR;
    { const char* b1 = PG8_BPTR(1); PG8_STAGEB(PG8_SB(1, 0), b1); PG8_STAGEA(PG8_SA(1, 0), cA + kstep, voA, 0); PG8_STAGEB(PG8_SB(1, 1), b1 + hstepB); }
    PG8_WAIT_V(6); PG8_BAR;
    for (;;) {
        const bool has_next = S.next(ui + 1, nxt);
        const char* nA = has_next ? nxt.A : cA; const char* nB = has_next ? nxt.B : cB;
        if constexpr (GATHER) {
            if (has_next) {
#pragma unroll
                for (int h = 0; h < 2; ++h)
#pragma unroll
                    for (int i = 0; i < 2; ++i) nvoA[h][i] = S.row_off(nxt, h * HALF + RA[i], ldA) + (unsigned)CA[i] * 2u;
            } else {
#pragma unroll
                for (int h = 0; h < 2; ++h)
#pragma unroll
                    for (int i = 0; i < 2; ++i) nvoA[h][i] = voA[h][i];
            }
        }
        for (int t = 0; t < nt; t += 2) {
            const bool last = (t == nt - 2);
            const char* a1 = cA + (size_t)(t + 1) * kstep;
            const char* a2 = last ? nA : cA + (size_t)(t + 2) * kstep; const char* b2 = last ? nB : PG8_BPTR(t + 2);
            const char* a3 = a2 + kstep; const char* b3 = last ? nB + kstep : PG8_BPTR(t + 3);
            unsigned vo2[2][2];
#pragma unroll
            for (int h = 0; h < 2; ++h)
#pragma unroll
                for (int i = 0; i < 2; ++i) vo2[h][i] = (GATHER && last) ? nvoA[h][i] : voA[h][i];
            PG8_LDB(B0, 0, 0); PG8_LDB(B1, 0, 1); PG8_SCHED; PG8_LDA(At, 0, 0); PG8_STAGEA(PG8_SA(1, 1), a1, voA, 1);
            PG8_WAIT_V(8); PG8_WAIT_L(0); PG8_BAR; PG8_MMA(0, 0, At, B0); PG8_MMA(0, 1, At, B1); PG8_BAR; PG8_SCHED;
            PG8_LDA(At, 0, 1); PG8_STAGEB(PG8_SB(0, 0), b2); PG8_STAGEB(PG8_SB(0, 1), b2 + hstepB); PG8_STAGEA(PG8_SA(0, 0), a2, vo2, 0);
            PG8_WAIT_V(8); PG8_WAIT_L(0); PG8_BAR; PG8_MMA(1, 0, At, B0); PG8_MMA(1, 1, At, B1); PG8_BAR; PG8_SCHED;
            PG8_LDB(B0, 1, 0); PG8_LDB(B1, 1, 1); PG8_SCHED; PG8_LDA(At, 1, 0); PG8_STAGEA(PG8_SA(0, 1), a2, vo2, 1);
            PG8_WAIT_V(8); PG8_WAIT_L(0); PG8_BAR; PG8_MMA(0, 0, At, B0); PG8_MMA(0, 1, At, B1); PG8_BAR; PG8_SCHED;
            PG8_LDA(At, 1, 1); PG8_STAGEB(PG8_SB(1, 0), b3); PG8_STAGEB(PG8_SB(1, 1), b3 + hstepB); PG8_STAGEA(PG8_SA(1, 0), a3, vo2, 0);
            PG8_WAIT_V(8); PG8_WAIT_L(0); PG8_BAR; PG8_MMA(1, 0, At, B0); PG8_MMA(1, 1, At, B1); PG8_BAR; PG8_SCHED;
        }
        if constexpr (ALIGN_EPI) { if (wr == 0) PG8_BAR; }
        E(acc, cur, wr, wc, fr, fq);
        if (!has_next) break;
#pragma unroll
        for (int a = 0; a < 2; ++a)
#pragma unroll
            for (int b = 0; b < 2; ++b)
#pragma unroll
                for (int m = 0; m < 4; ++m)
#pragma unroll
                    for (int n = 0; n < 2; ++n) acc[a][b][m][n] = (f32x4){0.f, 0.f, 0.f, 0.f};
        cur = nxt; cA = nA; cB = nB; cB2 = nxt.B2; ++ui;
        if constexpr (GATHER) {
#pragma unroll
            for (int h = 0; h < 2; ++h)
#pragma unroll
                for (int i = 0; i < 2; ++i) voA[h][i] = nvoA[h][i];
        }
        if constexpr (ALIGN_EPI) { if (wr == 1) PG8_BAR; }
    }
    PG8_WAIT_V(0);
    if constexpr (!ALIGN_EPI) { if (wr == 0) PG8_BAR; }
    PG8_BAR;
#undef PG8_SA
#undef PG8_SB
#undef PG8_STAGEA
#undef PG8_STAGEB
#undef PG8_LDA
#undef PG8_LDB
#undef PG8_MMA
#undef PG8_WAIT_V
#undef PG8_WAIT_L
#undef PG8_BAR
#undef PG8_SCHED
#undef PG8_BPTR
}
}
namespace pg {
template <bool BIAS_ROW> struct EpiBf16 {
    static constexpr bool PERM = true;
    bf16* O; int ldc; const float* bias;
    __device__ __forceinline__ void operator()(const f32x4 (&acc)[2][2][4][2], const Unit& u, int wr, int wc, int fr, int fq) const {
        const int row0 = u.pm * BM + wr * 64 + fr; const int col0 = u.pn * BM + wc * 32 + 8 * fq;
        f32x4 bv[2][2];
#pragma unroll
        for (int bj = 0; bj < 2; ++bj)
#pragma unroll
            for (int n = 0; n < 2; ++n) bv[bj][n] = (bias && !BIAS_ROW) ? *(const f32x4*)(bias + col0 + bj * HALF + 4 * n) : (f32x4){0.f, 0.f, 0.f, 0.f};
#pragma unroll
        for (int ai = 0; ai < 2; ++ai)
#pragma unroll
            for (int m = 0; m < 4; ++m) { const int row = row0 + ai * HALF + m * 16; bf16* rowp = O + (size_t)row * ldc + col0;
                float br = 0.f; if (BIAS_ROW && bias) br = bias[row];
#pragma unroll
                for (int bj = 0; bj < 2; ++bj) { f32x4 v0 = acc[ai][bj][m][0] + bv[bj][0] + br, v1 = acc[ai][bj][m][1] + bv[bj][1] + br;
                    u32x4 w; w.x = cvt_pk_bf16(v0[0], v0[1]); w.y = cvt_pk_bf16(v0[2], v0[3]); w.z = cvt_pk_bf16(v1[0], v1[1]); w.w = cvt_pk_bf16(v1[2], v1[3]);
                    *(u32x4*)(rowp + bj * HALF) = w; } }
    }
};
struct EpiQKV {
    static constexpr bool PERM = false;
    bf16 *Q, *Kb, *Vb; const float* bias; const float* ropeC; const float* ropeS;
    __device__ __forceinline__ void operator()(const f32x4 (&acc)[2][2][4][2], const Unit& u, int wr, int wc, int fr, int fq) const {
        const int row0 = u.pm * BM + wr * 64 + fr; const int colt = u.pn * BM + wc * 32 + 4 * fq;
        const bool isV = (u.pn == 9), isQ = (u.pn < 8);
        bf16* base; int ldc, cofs;
        if (isQ) { base = Q; ldc = DM; cofs = 0; } else if (!isV) { base = Kb; ldc = KVD; cofs = 2048; } else { base = Vb; ldc = KVD; cofs = 2304; }
        f32x4 bv[2][2];
#pragma unroll
        for (int bj = 0; bj < 2; ++bj)
#pragma unroll
            for (int n = 0; n < 2; ++n) bv[bj][n] = *(const f32x4*)(bias + colt + bj * HALF + 16 * n);
        const float sc = isQ ? QSCALE : 1.f; const int half = wc & 1;
#pragma unroll
        for (int ai = 0; ai < 2; ++ai)
#pragma unroll
            for (int m = 0; m < 4; ++m) { const int row = row0 + ai * HALF + m * 16; const int t = row & (SEQ - 1); const int pos = half ? (t & (GRIDW - 1)) : (t >> 6);
                f32x4 cs = (f32x4){1.f, 1.f, 1.f, 1.f}, sn = (f32x4){0.f, 0.f, 0.f, 0.f};
                if (!isV) { cs = *(const f32x4*)(ropeC + pos * 16 + 4 * fq); sn = *(const f32x4*)(ropeS + pos * 16 + 4 * fq); }
                bf16* rowp = base + (size_t)row * ldc + (colt - cofs);
#pragma unroll
                for (int bj = 0; bj < 2; ++bj) { const f32x4 x1 = acc[ai][bj][m][0] + bv[bj][0], x2 = acc[ai][bj][m][1] + bv[bj][1];
                    const f32x4 o1 = (x1 * cs - x2 * sn) * sc, o2 = (x2 * cs + x1 * sn) * sc;
                    u32x2 w1, w2; w1.x = cvt_pk_bf16(o1[0], o1[1]); w1.y = cvt_pk_bf16(o1[2], o1[3]); w2.x = cvt_pk_bf16(o2[0], o2[1]); w2.y = cvt_pk_bf16(o2[2], o2[3]);
                    *(u32x2*)(rowp + bj * HALF) = w1; *(u32x2*)(rowp + bj * HALF + 16) = w2; } }
    }
};
struct EpiMoe1 {
    static constexpr bool PERM = true;
    bf16* hid; const float* gates;
    __device__ __forceinline__ void operator()(const f32x4 (&acc)[2][2][4][2], const Unit& u, int wr, int wc, int fr, int fq) const {
        const int lr0 = wr * 64 + fr; const int col0 = u.pn * HALF + wc * 32 + 8 * fq; const int gsel = (u.pn >= 8) ? 1 : 0;
#pragma unroll
        for (int ai = 0; ai < 2; ++ai)
#pragma unroll
            for (int m = 0; m < 4; ++m) { const int lr = lr0 + ai * HALF + m * 16;
                if (lr < u.nrows) { const float g = gates[(size_t)(u.lbase + lr) * 2 + gsel];
                    float o[8];
#pragma unroll
                    for (int n = 0; n < 2; ++n)
#pragma unroll
                        for (int i = 0; i < 4; ++i) { const float a = acc[ai][0][m][n][i], b = acc[ai][1][m][n][i];
                            const float sg = __builtin_amdgcn_rcpf(1.f + __builtin_amdgcn_exp2f(-1.4426950408889634f * a)); o[n * 4 + i] = a * sg * b * g; }
                    u32x4 w; w.x = cvt_pk_bf16(o[0], o[1]); w.y = cvt_pk_bf16(o[2], o[3]); w.z = cvt_pk_bf16(o[4], o[5]); w.w = cvt_pk_bf16(o[6], o[7]);
                    *(u32x4*)(hid + (size_t)(u.row0 + lr) * DM + col0) = w; } }
    }
};
struct EpiMoe2 {
    static constexpr bool PERM = true;
    bf16* Y; const int* toks;
    __device__ __forceinline__ void operator()(const f32x4 (&acc)[2][2][4][2], const Unit& u, int wr, int wc, int fr, int fq) const {
        const int lr0 = wr * 64 + fr; const int col0 = u.pn * BM + wc * 32 + 8 * fq;
#pragma unroll
        for (int ai = 0; ai < 2; ++ai)
#pragma unroll
            for (int m = 0; m < 4; ++m) { const int lr = lr0 + ai * HALF + m * 16;
                if (lr < u.nrows) { const int tok = toks[u.lbase + lr]; bf16* rowp = Y + (size_t)tok * DM + col0;
#pragma unroll
                    for (int bj = 0; bj < 2; ++bj) { const f32x4 v0 = acc[ai][bj][m][0], v1 = acc[ai][bj][m][1];
                        u32x4 w; w.x = cvt_pk_bf16(v0[0], v0[1]); w.y = cvt_pk_bf16(v0[2], v0[3]); w.z = cvt_pk_bf16(v1[0], v1[1]); w.w = cvt_pk_bf16(v1[2], v1[3]);
                        *(u32x4*)(rowp + bj * HALF) = w; } } }
    }
};
struct MoeSched {
    const LAS int* tab;
    const char* Abase; const char* W; const int* toks; int G, c, NPN, second;
    __device__ __forceinline__ bool next(int i, Unit& u) const {
        const int TM = __builtin_amdgcn_readfirstlane(tab[24]);
        if (!static_map(i, G, c, TM, NPN, u.pm, u.pn)) return false;
        int cls = 0;
        for (int k = 1; k < NCLS; ++k) { const int s = __builtin_amdgcn_readfirstlane(tab[k]); if (u.pm >= s) cls = k; }
        const int ts = __builtin_amdgcn_readfirstlane(tab[cls]), cnt = __builtin_amdgcn_readfirstlane(tab[32 + cls]);
        const int ti = u.pm - ts; u.cls = cls; u.row0 = u.pm * BM; u.nrows = (cnt - ti * BM) < BM ? (cnt - ti * BM) : BM; u.lbase = cls * LCAP + ti * BM;
        const int g = cls / 6, p = cls % 6; const int lo = (p < 3) ? 0 : (p < 5 ? 1 : 2), hi = (p < 3) ? p + 1 : (p < 5 ? p - 1 : 3);
        const int elo = g * 4 + lo, ehi = g * 4 + hi;
        if (!second) { const int e = (u.pn < 8) ? elo : ehi; u.A = Abase; u.B = W + ((size_t)e * 2048 + (size_t)(u.pn & 7) * 256) * 2048 * 2; u.B2 = u.B; }
        else { u.A = Abase + (size_t)u.row0 * DM * 2; u.B = W + ((size_t)elo * 2048 + (size_t)u.pn * 256) * 1024 * 2; u.B2 = W + ((size_t)ehi * 2048 + (size_t)u.pn * 256) * 1024 * 2; }
        return true;
    }
    __device__ __forceinline__ unsigned row_off(const Unit& u, int r, int ldA) const {
        const int rr = r < u.nrows ? r : u.nrows - 1; const int tok = toks[u.lbase + rr]; return (unsigned)tok * (unsigned)ldA * 2u;
    }
};
}
struct Args { const float* in[34]; float* out; unsigned char* ws; int ph_lo, ph_hi; };
struct Frame {
    LAS unsigned char* lds;
    gu32* ctl; unsigned char* ws;
    int tid, lane, wave, G, bid;
    const Args* a; float* out;
};
#define AIN(i) (F.a->in[i])
enum { I_X = 0, I_C, I_CTX, I_CCTX, I_ADAW, I_ADAB, I_AWIN, I_ABIN, I_SINK, I_AWOUT, I_HWIN, I_HBIN, I_HCW, I_HCB, I_FW1, I_FB1, I_FW2, I_FB2, I_FW3, I_FB3, I_FFREQ, I_FW4, I_FBIAS, I_HWOUT, I_HBOUT,
       I_LN1G, I_LN1B, I_LN2G, I_LN2B, I_RW, I_RB, I_W1, I_W3, I_W2 };
__device__ __forceinline__ int fresh_tid(int wave) { int l_; asm volatile("v_mbcnt_lo_u32_b32 %0, -1, 0\n\tv_mbcnt_hi_u32_b32 %0, -1, %0" : "=&v"(l_)); return wave * 64 + l_; }
__device__ __forceinline__ float* mod_ptr(const Frame& F, int layer, int vec, int chunk) { return (float*)(F.ws + WS_MOD) + ((size_t)(layer * 3 + vec) * 6 + chunk) * DM; }

__device__ __forceinline__ void p0_transpose_item(const float* W, int ldw, bf16* WT, int ldt, int dst_row, int k0, int n0, LAS float* scr, int lane) {
#pragma unroll 8
    for (int i = 0; i < 32; ++i) { const int kk = 2 * i + (lane >> 5); scr[kk * 33 + (lane & 31)] = W[(size_t)(k0 + kk) * ldw + n0 + (lane & 31)]; }
    LDS_WAIT(); asm volatile("" ::: "memory");
    const int c = lane & 7;
#pragma unroll
    for (int j = 0; j < 4; ++j) { const int n = (lane >> 3) + 8 * j; const LAS float* s = scr + (8 * c) * 33 + n;
        u32x4 o; o.x = cvt_pk_bf16(s[0 * 33], s[1 * 33]); o.y = cvt_pk_bf16(s[2 * 33], s[3 * 33]); o.z = cvt_pk_bf16(s[4 * 33], s[5 * 33]); o.w = cvt_pk_bf16(s[6 * 33], s[7 * 33]);
        *(GAS u32x4*)(WT + (size_t)(dst_row + n) * ldt + k0 + 8 * c) = o; }
    LDS_WAIT(); asm volatile("" ::: "memory");
}
__device__ __forceinline__ void p0_prologue(Frame& F) {
    const int gw = F.bid * NWAVES + F.wave, NGW = F.G * NWAVES, gt = F.bid * NTHR + F.tid, NGT = F.G * NTHR;
    {
        LAS float* sil = (LAS float*)F.lds; LAS float* red = sil + 3 * DM;
        for (int i = F.tid; i < 3 * DM; i += NTHR) { const int v = i / DM, k = i % DM; const float cv = (v < 2) ? AIN(I_C)[v * DM + k] : AIN(I_CCTX)[k]; sil[i] = cv / (1.f + expf(-cv)); }
        __syncthreads();
        const int cl = F.tid & 7, kg = F.tid >> 3;
        for (int unit = F.bid; unit < 768; unit += F.G) {
            const int l = unit / 384, n0 = (unit % 384) * 32;
            const float* W = AIN(I_ADAW) + (size_t)l * DM * 12288 + n0 + cl * 4;
            f32x4 a0 = {0.f, 0.f, 0.f, 0.f}, a1 = a0, a2 = a0;
#pragma unroll 8
            for (int i = 0; i < 32; ++i) { const int k = kg + 64 * i; const f32x4 w = *(const f32x4*)(W + (size_t)k * 12288); a0 += w * sil[k]; a1 += w * sil[DM + k]; a2 += w * sil[2 * DM + k]; }
#pragma unroll
            for (int j = 0; j < 4; ++j) { red[(kg * 32 + cl * 4 + j) * 3 + 0] = a0[j]; red[(kg * 32 + cl * 4 + j) * 3 + 1] = a1[j]; red[(kg * 32 + cl * 4 + j) * 3 + 2] = a2[j]; }
            __syncthreads();
            if (F.tid < 96) { const int col = F.tid & 31, v = F.tid >> 5; float s = 0.f;
                for (int k = 0; k < 64; ++k) s += red[(k * 32 + col) * 3 + v];
                ((float*)(F.ws + WS_MOD))[(size_t)(l * 3 + v) * 12288 + n0 + col] = s + AIN(I_ADAB)[l * 12288 + n0 + col]; }
            __syncthreads();
        }
    }
    {
        LAS float* scr = (LAS float*)(F.lds + F.wave * 16384);
        constexpr int I0 = 32 * 80, I1 = 32 * 64, I2 = 32 * 192, I3 = 32 * 64, ISM = I0 + I1 + I2 + I3, NIT = ISM + 96 * 1024;
        for (int it = gw; it < NIT; it += NGW) {
            int r = it;
            if (r < I0) { p0_transpose_item(AIN(I_AWIN), QKVD, (bf16*)(F.ws + WS_WQKV), DM, (r % 80) * 32, (r / 80) * 64, (r % 80) * 32, scr, F.lane); continue; } r -= I0;
            if (r < I1) { p0_transpose_item(AIN(I_AWOUT), DM, (bf16*)(F.ws + WS_WO0), DM, (r % 64) * 32, (r / 64) * 64, (r % 64) * 32, scr, F.lane); continue; } r -= I1;
            if (r < I2) { p0_transpose_item(AIN(I_HWIN), 3 * DM, (bf16*)(F.ws + WS_WHYIN), DM, (r % 192) * 32, (r / 192) * 64, (r % 192) * 32, scr, F.lane); continue; } r -= I2;
            if (r < I3) { p0_transpose_item(AIN(I_HWOUT), DM, (bf16*)(F.ws + WS_WHYO), DM, (r % 64) * 32, (r / 64) * 64, (r % 64) * 32, scr, F.lane); continue; } r -= I3;
            const int mat = r >> 10, sub = r & 1023, which = mat >> 5, le = mat & 31;
            if (which < 2) {
                const int n0 = (sub & 31) * 32, k0 = (sub >> 5) * 64;
                p0_transpose_item((which == 0 ? AIN(I_W1) : AIN(I_W3)) + (size_t)le * DM * EFF, EFF, (bf16*)(F.ws + WS_W13) + (size_t)le * 2048 * 2048, DM, (n0 >> 7) * 256 + which * 128 + (n0 & 127), k0, n0, scr, F.lane);
            } else {
                const int n0 = (sub & 63) * 32, k0 = (sub >> 6) * 64;
                p0_transpose_item(AIN(I_W2) + (size_t)le * EFF * DM, DM, (bf16*)(F.ws + WS_W2) + (size_t)le * 2048 * 1024, EFF, n0, k0, n0, scr, F.lane);
            }
        }
    }
    {
        const float* w1 = AIN(I_FW1); const float* w2 = AIN(I_FW2); const float* w3 = AIN(I_FW3);
        const int j = F.lane; const float fr = AIN(I_FFREQ)[j], b1 = AIN(I_FB1)[j], b2 = AIN(I_FB2)[j], b3 = AIN(I_FB3)[j];
        bf16* hdn = (bf16*)(F.ws + WS_HDN);
        for (int row = gw; row < SEQ; row += NGW) {
            const float tt = (float)row / (float)(SEQ - 1); const float wv = 6.283185307179586f * (float)row / (float)SEQ;
            float zv = 0.f;
            if (j == 0) zv = tt;
            else if (j <= 32) { const int jj = (j - 1) & 15; const float f = 1e-4f + (float)jj * ((15.f - 1e-4f) / 15.f); const float a = f * wv; zv = (j <= 16) ? cosf(a) : -sinf(a); }
            float h = b1;
#pragma unroll
            for (int i = 0; i < HYEMB; ++i) h += __shfl(zv, i) * w1[i * HYW + j];
            float a1 = sinf(fr * h);
            h = b2;
#pragma unroll 16
            for (int i = 0; i < HYW; ++i) h += __shfl(a1, i) * w2[i * HYW + j];
            float a2 = sinf(fr * h);
            h = b3;
#pragma unroll 16
            for (int i = 0; i < HYW; ++i) h += __shfl(a2, i) * w3[i * HYW + j];
            const float a3 = sinf(fr * h);
            hdn[(size_t)row * 128 + j] = (bf16)(cvt_pk_bf16(a3, 0.f) & 0xffffu); hdn[(size_t)row * 128 + 64 + j] = 0;
        }
    }
    for (int i = gt; i < 4096; i += NGT) { const int pos = i >> 4, dd = i & 15; const float inv = powf(10000.f, -(float)(2 * dd) / 32.f); const float a = (float)pos * inv;
        ((float*)(F.ws + WS_ROPE))[i] = cosf(a); ((float*)(F.ws + WS_ROPE))[4096 + i] = sinf(a); }
    for (int i = gt; i < 4096 * 128; i += NGT) { const int k = i >> 12, n = i & 4095;
        ((bf16*)(F.ws + WS_W4T))[(size_t)n * 128 + k] = (k < 64) ? (bf16)(cvt_pk_bf16(AIN(I_FW4)[(size_t)k * 4096 + n], 0.f) & 0xffffu) : (bf16)0; }
}

__device__ __forceinline__ void p1_prologue(Frame& F) {
    if (F.wave < 4) {
        for (int tile = F.bid * 4 + F.wave; tile < 1024; tile += F.G * 4) {
            const int r0 = (tile >> 5) * 16, n0 = (tile & 31) * 16; const int lr = F.lane & 15, kq = F.lane >> 4;
            const float* crow = AIN(I_CTX) + (size_t)(r0 + lr) * DM; const float* sh = mod_ptr(F, 0, 2, 0); const float* sc = mod_ptr(F, 0, 2, 1);
            const bf16* wrow = (const bf16*)(F.ws + WS_WQKV) + (size_t)(2048 + n0 + lr) * DM;
            f32x4 acc = {0.f, 0.f, 0.f, 0.f};
#pragma unroll 4
            for (int k0 = 0; k0 < DM; k0 += 32) { const int k = k0 + 8 * kq;
                const f32x4 x0 = *(const f32x4*)(crow + k), x1 = *(const f32x4*)(crow + k + 4), s0 = *(const f32x4*)(sc + k), s1 = *(const f32x4*)(sc + k + 4), h0 = *(const f32x4*)(sh + k), h1 = *(const f32x4*)(sh + k + 4);
                const f32x4 u0 = x0 * (s0 + 1.f) + h0, u1 = x1 * (s1 + 1.f) + h1;
                u32x4 aw; aw.x = cvt_pk_bf16(u0[0], u0[1]); aw.y = cvt_pk_bf16(u0[2], u0[3]); aw.z = cvt_pk_bf16(u1[0], u1[1]); aw.w = cvt_pk_bf16(u1[2], u1[3]);
                const bf16x8 bfrag = *(const bf16x8*)(wrow + k);
                acc = __builtin_amdgcn_mfma_f32_16x16x32_bf16(__builtin_bit_cast(bf16x8, aw), bfrag, acc, 0, 0, 0); }
            const float bb = AIN(I_ABIN)[2048 + n0 + lr]; bf16* o = (bf16*)(F.ws + WS_CTXKV);
#pragma unroll
            for (int r = 0; r < 4; ++r) o[(size_t)(r0 + 4 * kq + r) * 512 + n0 + lr] = (bf16)(cvt_pk_bf16(acc[r] + bb, 0.f) & 0xffffu);
        }
    }
    const int gt = F.bid * NTHR + F.tid, NGT = F.G * NTHR;
    const float* x = AIN(I_X); bf16* u0 = (bf16*)(F.ws + WS_A);
    for (size_t i = gt; i < (size_t)MTOK * DM / 8; i += NGT) {
        const size_t e = i * 8; const int col = (int)(e & (DM - 1)); const int b = (int)(e / ((size_t)SEQ * DM));
        const float* sh = mod_ptr(F, 0, b, 0) + col; const float* sc = mod_ptr(F, 0, b, 1) + col;
        const f32x4 x0 = *(const f32x4*)(x + e), x1 = *(const f32x4*)(x + e + 4);
        const f32x4 v0 = x0 * (*(const f32x4*)sc + 1.f) + *(const f32x4*)sh, v1 = x1 * (*(const f32x4*)(sc + 4) + 1.f) + *(const f32x4*)(sh + 4);
        u32x4 w; w.x = cvt_pk_bf16(v0[0], v0[1]); w.y = cvt_pk_bf16(v0[2], v0[3]); w.z = cvt_pk_bf16(v1[0], v1[1]); w.w = cvt_pk_bf16(v1[2], v1[3]);
        *(u32x4*)(u0 + e) = w;
    }
}
namespace att {
constexpr int LDS_K = 0, LDS_V = 8192, LDS_WS = 16384, LDS_OST = LDS_WS + NWAVES * 64 * 4;
__device__ __forceinline__ int crow(int r, int hi) { return (r & 3) + 8 * (r >> 2) + 4 * hi; }
__device__ __forceinline__ float max3f(float a, float b, float c) { return __builtin_fmaxf(__builtin_fmaxf(a, b), c); }
__device__ __forceinline__ float rowmax(const f32x16& p0, const f32x16& p1) {
    float a = max3f(p0[0], p0[1], p1[0]), b = max3f(p0[2], p0[3], p1[1]); a = max3f(a, p1[2], p1[3]);
#pragma unroll
    for (int r = 4; r < 16; r += 4) { a = max3f(a, p0[r], p0[r + 1]); b = max3f(b, p0[r + 2], p0[r + 3]); a = max3f(a, p1[r], p1[r + 1]); b = max3f(b, p1[r + 2], p1[r + 3]); }
    const float m = __builtin_fmaxf(a, b);
    auto rr = __builtin_amdgcn_permlane32_swap(__float_as_uint(m), __float_as_uint(m), false, false);
    return __builtin_fmaxf(__uint_as_float(rr[0]), __uint_as_float(rr[1]));
}
__device__ __forceinline__ void qkt(f32x16& p0, f32x16& p1, const LAS unsigned char* Kslot, const bf16x8* qr, int r32, int hi) {
    const LAS unsigned char* kb = Kslot + hi * 1024 + r32 * 16;
    const f32x16 z = {};
#pragma unroll
    for (int d0 = 0; d0 < 4; ++d0) {
        const bf16x8 b0 = *(const LAS bf16x8*)(kb + d0 * 2048);
        const bf16x8 b1 = *(const LAS bf16x8*)(kb + d0 * 2048 + 512);
        if (d0 == 0) { p0 = __builtin_amdgcn_mfma_f32_32x32x16_bf16(b0, qr[0], z, 0, 0, 0); p1 = __builtin_amdgcn_mfma_f32_32x32x16_bf16(b1, qr[0], z, 0, 0, 0); }
        else { p0 = __builtin_amdgcn_mfma_f32_32x32x16_bf16(b0, qr[d0], p0, 0, 0, 0); p1 = __builtin_amdgcn_mfma_f32_32x32x16_bf16(b1, qr[d0], p1, 0, 0, 0); }
    }
}
__device__ __forceinline__ void pv(f32x16* o, int vb, bf16x8 pa0, bf16x8 pa1, bf16x8 pa2, bf16x8 pa3) {
#pragma unroll
    for (int d0 = 0; d0 < 2; ++d0) { s16x4 lo[4], hi[4];
#pragma unroll
        for (int ks = 0; ks < 4; ++ks) {
            asm volatile("ds_read_b64_tr_b16 %0,%1 offset:%c2" : "=&v"(lo[ks]) : "v"(vb), "i"(d0 * 4096 + ks * 1024) : "memory");
            asm volatile("ds_read_b64_tr_b16 %0,%1 offset:%c2" : "=&v"(hi[ks]) : "v"(vb), "i"(d0 * 4096 + ks * 1024 + 512) : "memory"); }
        asm volatile("s_waitcnt lgkmcnt(0)" ::: "memory"); __builtin_amdgcn_sched_barrier(0);
#define PK(k) (bf16x8){lo[k][0], lo[k][1], lo[k][2], lo[k][3], hi[k][0], hi[k][1], hi[k][2], hi[k][3]}
        o[d0] = __builtin_amdgcn_mfma_f32_32x32x16_bf16(pa0, PK(0), o[d0], 0, 0, 0);
        o[d0] = __builtin_amdgcn_mfma_f32_32x32x16_bf16(pa1, PK(1), o[d0], 0, 0, 0);
        o[d0] = __builtin_amdgcn_mfma_f32_32x32x16_bf16(pa2, PK(2), o[d0], 0, 0, 0);
        o[d0] = __builtin_amdgcn_mfma_f32_32x32x16_bf16(pa3, PK(3), o[d0], 0, 0, 0);
#undef PK
    }
}
__device__ __forceinline__ void attn_unit(const Frame& F, int b, int kvh, int qb) {
    const int lane = F.lane, r32 = lane & 31, hi = lane >> 5, wid = F.wave;
    LAS unsigned char* shm = F.lds;
    const int q0 = qb * 32; const int head = kvh * 8 + wid;
    const bf16* Q = (const bf16*)(F.ws + WS_B); const bf16* Kb = (const bf16*)(F.ws + WS_B + 128 * MiB); const bf16* Vb = (const bf16*)(F.ws + WS_B + 144 * MiB);
    const bf16* CKV = (const bf16*)(F.ws + WS_CTXKV); bf16* O = (bf16*)(F.ws + WS_A);
    const size_t tok0 = (size_t)b * SEQ;
    LAS float* wsf = (LAS float*)(shm + LDS_WS) + wid * 64;
    const int vb0 = (int)(uintptr_t)(shm + LDS_V) + ((lane >> 4) & 1) * 32 + (lane & 3) * 8 + (4 * hi + ((lane & 15) >> 2)) * 64;
    bf16x8 qr[4];
    { const bf16* Qw = Q + (tok0 + q0 + r32) * DM + head * HD;
#pragma unroll
      for (int d0 = 0; d0 < 4; ++d0) qr[d0] = *(const bf16x8*)(Qw + d0 * 16 + hi * 8); }
    float mref = -INFINITY, l_reg = 0.f; f32x16 o[2]; o[0] = f32x16{}; o[1] = f32x16{};
    const int tbase = (q0 - 128) & ~63;
    for (int t = 0; t < 9; ++t) {
        const bf16* ksrc; const bf16* vsrc; int key0 = 0;
        if (t < 4) { const int c0 = b * CTXL + t * 64;
            ksrc = CKV + (size_t)(c0 + lane) * 512 + kvh * HD + wid * 8;
            vsrc = CKV + (size_t)(c0 + 16 * (wid & 3) + (lane >> 2)) * 512 + 256 + kvh * HD + (wid >> 2) * 32 + (lane & 3) * 8;
        } else { key0 = tbase + (t - 4) * 64;
            int kr = key0 + lane; kr = kr < 0 ? 0 : (kr > SEQ - 1 ? SEQ - 1 : kr);
            int vr = key0 + 16 * (wid & 3) + (lane >> 2); vr = vr < 0 ? 0 : (vr > SEQ - 1 ? SEQ - 1 : vr);
            ksrc = Kb + (tok0 + kr) * KVD + kvh * HD + wid * 8;
            vsrc = Vb + (tok0 + vr) * KVD + kvh * HD + (wid >> 2) * 32 + (lane & 3) * 8;
        }
        __builtin_amdgcn_global_load_lds((const unsigned*)ksrc, (LAS unsigned*)(shm + LDS_K + wid * 1024), 16, 0, 0);
        __builtin_amdgcn_global_load_lds((const unsigned*)vsrc, (LAS unsigned*)(shm + LDS_V + wid * 1024), 16, 0, 0);
        VM_WAIT(); __syncthreads();
        f32x16 p0, p1;
        qkt(p0, p1, shm + LDS_K, qr, r32, hi);
        if (t >= 4) { const int qpos = q0 + r32;
#pragma unroll
            for (int r = 0; r < 16; ++r) { const int k0 = key0 + crow(r, hi), k1 = k0 + 32;
                const bool v0 = (k0 >= 0) && (k0 < SEQ) && (k0 - qpos <= 128) && (qpos - k0 <= 128);
                const bool v1 = (k1 >= 0) && (k1 < SEQ) && (k1 - qpos <= 128) && (qpos - k1 <= 128);
                p0[r] = v0 ? p0[r] : -INFINITY; p1[r] = v1 ? p1[r] : -INFINITY; } }
        const float rm = rowmax(p0, p1);
        const float mnew = __builtin_fmaxf(mref, rm);
        const float f = __builtin_amdgcn_exp2f(mref - mnew);
        mref = mnew;
        float sacc = 0.f;
#pragma unroll
        for (int r = 0; r < 16; ++r) { p0[r] = __builtin_amdgcn_exp2f(p0[r] - mnew); p1[r] = __builtin_amdgcn_exp2f(p1[r] - mnew); sacc += p0[r] + p1[r]; }
        l_reg = l_reg * f + sacc;
        if (hi == 0) wsf[r32] = f;
        LDS_WAIT();
#pragma unroll
        for (int d = 0; d < 2; ++d)
#pragma unroll
            for (int r = 0; r < 16; ++r) o[d][r] *= wsf[crow(r, hi)];
        u32x4 pw0, pw1, pw2, pw3;
#define PKW(P, B) cvt_pk_bf16(P[B], P[B + 1])
        pw0 = (u32x4){PKW(p0, 0), PKW(p0, 2), PKW(p0, 4), PKW(p0, 6)}; pw1 = (u32x4){PKW(p0, 8), PKW(p0, 10), PKW(p0, 12), PKW(p0, 14)};
        pw2 = (u32x4){PKW(p1, 0), PKW(p1, 2), PKW(p1, 4), PKW(p1, 6)}; pw3 = (u32x4){PKW(p1, 8), PKW(p1, 10), PKW(p1, 12), PKW(p1, 14)};
#undef PKW
        pv(o, vb0, __builtin_bit_cast(bf16x8, pw0), __builtin_bit_cast(bf16x8, pw1), __builtin_bit_cast(bf16x8, pw2), __builtin_bit_cast(bf16x8, pw3));
        LDS_WAIT(); __syncthreads();
    }
    { auto rr = __builtin_amdgcn_permlane32_swap(__float_as_uint(l_reg), __float_as_uint(l_reg), false, false); l_reg = __uint_as_float(rr[0]) + __uint_as_float(rr[1]); }
    l_reg += __builtin_amdgcn_exp2f(AIN(I_SINK)[head] * 1.4426950408889634f - mref);
    if (hi == 0) wsf[32 + r32] = l_reg;
    LDS_WAIT();
    float rli[16];
#pragma unroll
    for (int r = 0; r < 16; ++r) rli[r] = 1.f / wsf[32 + crow(r, hi)];
    bf16* Ow = O + (tok0 + q0) * DM + head * HD;
    { LAS bf16* stg = (LAS bf16*)(shm + LDS_OST) + wid * 2048;
#pragma unroll
      for (int r = 0; r < 16; ++r) { const int orow = crow(r, hi);
#pragma unroll
          for (int d0 = 0; d0 < 2; ++d0) stg[orow * 64 + d0 * 32 + r32] = (bf16)(cvt_pk_bf16(o[d0][r] * rli[r], 0.f) & 0xffffu); }
      LDS_WAIT();
#pragma unroll
      for (int i = 0; i < 4; ++i) { const int row = i * 8 + (lane >> 3), ch = lane & 7; const u32x4 v = *(const LAS u32x4*)(stg + row * 64 + ch * 8); *(u32x4*)(Ow + (size_t)row * DM + ch * 8) = v; } }
    LDS_WAIT(); __syncthreads();
}
__device__ __forceinline__ void attn_phase(const Frame& F) {
    const int NU = NB * NKV * (SEQ / 32); const int per = (NU + F.G - 1) / F.G;
    for (int i = 0; i < per; ++i) { const int u = F.bid * per + i; if (u >= NU) break;
        const int qb = u % (SEQ / 32), bk = u / (SEQ / 32); attn_unit(F, bk / NKV, bk % NKV, qb); }
}
}

__device__ __forceinline__ void ln1_router_phase(const Frame& F, int layer, const float* hin, const bf16* ymix, bf16* u2out) {
    LAS f32x4* rw = (LAS f32x4*)F.lds;
    for (int idx = F.tid; idx < 8192; idx += NTHR) { const int l = idx & 63, i = (idx >> 6) & 3, j = (idx >> 8) & 7, g = idx >> 11; const int col = 4 * l + 256 * j + i;
        rw[idx] = *(const f32x4*)(AIN(I_RW) + (size_t)col * NEXP + 4 * g); }
    __syncthreads();
    const float* lng = AIN(I_LN1G) + layer * DM; const float* lnb = AIN(I_LN1B) + layer * DM; const float* rb = AIN(I_RB);
    int* toks = (int*)(F.ws + WS_TOK); float* gates = (float*)(F.ws + WS_GATE);
    const int l = F.lane;
    for (int row = F.bid * NWAVES + F.wave; row < MTOK; row += F.G * NWAVES) {
        const int b = row / SEQ;
        const float* g1 = mod_ptr(F, layer, b, 2); const float* sh2 = mod_ptr(F, layer, b, 3); const float* sc2 = mod_ptr(F, layer, b, 4);
        f32x4 v[8]; float s = 0.f;
#pragma unroll
        for (int j = 0; j < 8; ++j) { const int col = 4 * l + 256 * j; const f32x4 h = *(const f32x4*)(hin + (size_t)row * DM + col); const u32x2 yw = *(const u32x2*)(ymix + (size_t)row * DM + col);
            const f32x4 y = {bflo(yw.x), bfhi(yw.x), bflo(yw.y), bfhi(yw.y)}; const f32x4 g = *(const f32x4*)(g1 + col);
            v[j] = h * DN_ALPHA + g * y; s += (v[j][0] + v[j][1]) + (v[j][2] + v[j][3]); }
        const float mean = wave_sum(s) * (1.f / DM); float s2 = 0.f;
#pragma unroll
        for (int j = 0; j < 8; ++j) { v[j] = v[j] - mean; s2 += (v[j][0] * v[j][0] + v[j][1] * v[j][1]) + (v[j][2] * v[j][2] + v[j][3] * v[j][3]); }
        const float rstd = 1.f / sqrtf(wave_sum(s2) * (1.f / DM) + LN_EPS);
        f32x4 lg[4] = {{0.f, 0.f, 0.f, 0.f}, {0.f, 0.f, 0.f, 0.f}, {0.f, 0.f, 0.f, 0.f}, {0.f, 0.f, 0.f, 0.f}};
#pragma unroll
        for (int j = 0; j < 8; ++j) { const int col = 4 * l + 256 * j;
            const f32x4 hn = v[j] * rstd * *(const f32x4*)(lng + col) + *(const f32x4*)(lnb + col);
            *(f32x4*)(F.out + (size_t)row * DM + col) = hn;
            const f32x4 u = hn * (*(const f32x4*)(sc2 + col) + 1.f) + *(const f32x4*)(sh2 + col);
            u32x2 w; w.x = cvt_pk_bf16(u[0], u[1]); w.y = cvt_pk_bf16(u[2], u[3]); *(u32x2*)(u2out + (size_t)row * DM + col) = w;
#pragma unroll
            for (int i = 0; i < 4; ++i)
#pragma unroll
                for (int g = 0; g < 4; ++g) lg[g] += rw[((g * 8 + j) * 4 + i) * 64 + l] * u[i]; }
        float sg[16], sel[16];
#pragma unroll
        for (int g = 0; g < 4; ++g)
#pragma unroll
            for (int i = 0; i < 4; ++i) { const float lgt = wave_sum(lg[g][i]); const float sv = 1.f / (1.f + expf(-lgt)); sg[g * 4 + i] = sv; sel[g * 4 + i] = sv + rb[g * 4 + i]; }
        int gb = 0; float gbs = -INFINITY;
#pragma unroll
        for (int g = 0; g < 4; ++g) { const float a = sel[4 * g], bq = sel[4 * g + 1], c = sel[4 * g + 2], d = sel[4 * g + 3];
            const float ps = fmaxf(fmaxf(fmaxf(a + bq, a + c), fmaxf(a + d, bq + c)), fmaxf(bq + d, c + d)); if (ps > gbs) { gbs = ps; gb = g; } }
        float cs[4], cg[4];
#pragma unroll
        for (int i = 0; i < 4; ++i) { cs[i] = sel[i]; cg[i] = sg[i];
#pragma unroll
            for (int g = 1; g < 4; ++g) if (gb == g) { cs[i] = sel[4 * g + i]; cg[i] = sg[4 * g + i]; } }
        int i0 = 0; float b0 = cs[0];
#pragma unroll
        for (int i = 1; i < 4; ++i) if (cs[i] > b0) { b0 = cs[i]; i0 = i; }
        int i1 = -1; float b1 = -INFINITY;
#pragma unroll
        for (int i = 0; i < 4; ++i) if (i != i0 && cs[i] > b1) { b1 = cs[i]; i1 = i; }
        float ga = 0.f, gbv = 0.f;
#pragma unroll
        for (int i = 0; i < 4; ++i) { if (i == i0) ga = cg[i]; if (i == i1) gbv = cg[i]; }
        const float den = ga + gbv; ga /= den; gbv /= den;
        const int lo = i0 < i1 ? i0 : i1, hi = i0 < i1 ? i1 : i0; const float glo = i0 < i1 ? ga : gbv, ghi = i0 < i1 ? gbv : ga;
        const int pidx = (lo == 0) ? (hi - 1) : (lo == 1 ? hi + 1 : 5);
        const int cls = gb * 6 + pidx;
        if (l == 0) { const unsigned rel = __hip_atomic_fetch_add((unsigned*)(F.ctl + CW_CNT + (layer * NCLS + cls) * 64), 1u, RLX_AGENT);
            toks[cls * LCAP + rel] = row; gates[(size_t)(cls * LCAP + rel) * 2] = glo; gates[(size_t)(cls * LCAP + rel) * 2 + 1] = ghi; }
    }
}
__device__ __forceinline__ void ln2_phase(const Frame& F, int layer, bf16* fio) {
    const float* lng = AIN(I_LN2G) + layer * DM; const float* lnb = AIN(I_LN2B) + layer * DM;
    const int l = F.lane;
    for (int row = F.bid * NWAVES + F.wave; row < MTOK; row += F.G * NWAVES) {
        const int b = row / SEQ;
        const float* g2 = mod_ptr(F, layer, b, 5); const float* sh1 = mod_ptr(F, 1, b, 0); const float* sc1 = mod_ptr(F, 1, b, 1);
        f32x4 v[8]; float s = 0.f;
#pragma unroll
        for (int j = 0; j < 8; ++j) { const int col = 4 * l + 256 * j; const f32x4 h = *(const f32x4*)(F.out + (size_t)row * DM + col); const u32x2 yw = *(const u32x2*)(fio + (size_t)row * DM + col);
            const f32x4 y = {bflo(yw.x), bfhi(yw.x), bflo(yw.y), bfhi(yw.y)}; const f32x4 g = *(const f32x4*)(g2 + col);
            v[j] = h * DN_ALPHA + g * y; s += (v[j][0] + v[j][1]) + (v[j][2] + v[j][3]); }
        const float mean = wave_sum(s) * (1.f / DM); float s2 = 0.f;
#pragma unroll
        for (int j = 0; j < 8; ++j) { v[j] = v[j] - mean; s2 += (v[j][0] * v[j][0] + v[j][1] * v[j][1]) + (v[j][2] * v[j][2] + v[j][3] * v[j][3]); }
        const float rstd = 1.f / sqrtf(wave_sum(s2) * (1.f / DM) + LN_EPS);
#pragma unroll
        for (int j = 0; j < 8; ++j) { const int col = 4 * l + 256 * j;
            const f32x4 hn = v[j] * rstd * *(const f32x4*)(lng + col) + *(const f32x4*)(lnb + col);
            *(f32x4*)(F.out + (size_t)row * DM + col) = hn;
            if (layer == 0) { const f32x4 u = hn * (*(const f32x4*)(sc1 + col) + 1.f) + *(const f32x4*)(sh1 + col);
                u32x2 w; w.x = cvt_pk_bf16(u[0], u[1]); w.y = cvt_pk_bf16(u[2], u[3]); *(u32x2*)(fio + (size_t)row * DM + col) = w; } }
    }
}
namespace hy {
constexpr int L = SEQ;
__device__ constexpr float C32[16] = {1.000000000e+00f, 9.807852804e-01f, 9.238795325e-01f, 8.314696123e-01f, 7.071067812e-01f, 5.555702330e-01f, 3.826834324e-01f, 1.950903220e-01f,
                                      0.f, -1.950903220e-01f, -3.826834324e-01f, -5.555702330e-01f, -7.071067812e-01f, -8.314696123e-01f, -9.238795325e-01f, -9.807852804e-01f};
__device__ constexpr float S32[16] = {0.f, 1.950903220e-01f, 3.826834324e-01f, 5.555702330e-01f, 7.071067812e-01f, 8.314696123e-01f, 9.238795325e-01f, 9.807852804e-01f,
                                      1.f, 9.807852804e-01f, 9.238795325e-01f, 8.314696123e-01f, 7.071067812e-01f, 5.555702330e-01f, 3.826834324e-01f, 1.950903220e-01f};
__host__ __device__ constexpr int brev(int k, int bits) { int r = 0; for (int i = 0; i < bits; ++i) r |= ((k >> i) & 1) << (bits - 1 - i); return r; }
template <int N, bool INV> __device__ __forceinline__ void dft_reg(float (&re)[N], float (&im)[N]) {
#pragma unroll
    for (int half = N / 2; half >= 1; half >>= 1) {
#pragma unroll
        for (int base = 0; base < N; base += 2 * half) {
#pragma unroll
            for (int j = 0; j < half; ++j) {
                const int i0 = base + j, i1 = i0 + half; const int tk = j * (16 / half);
                const float ar = re[i0], ai = im[i0], br = re[i1], bi = im[i1];
                re[i0] = ar + br; im[i0] = ai + bi;
                const float dr = ar - br, di = ai - bi;
                if (tk == 0) { re[i1] = dr; im[i1] = di; }
                else if (tk == 8) { if (!INV) { re[i1] = di; im[i1] = -dr; } else { re[i1] = -di; im[i1] = dr; } }
                else { const float c = C32[tk], s = INV ? S32[tk] : -S32[tk]; re[i1] = dr * c - di * s; im[i1] = dr * s + di * c; }
            }
        }
    }
}
template <int R> __device__ __forceinline__ void pow_tab(float wr, float wi, float (&pr)[R], float (&pi)[R]) {
    pr[0] = 1.f; pi[0] = 0.f; pr[1] = wr; pi[1] = wi;
#pragma unroll
    for (int k = 2; k < R; ++k) {
        if ((k & 1) == 0) { const float a = pr[k / 2], b = pi[k / 2]; pr[k] = a * a - b * b; pi[k] = 2.f * a * b; }
        else { const float a = pr[k - 1], b = pi[k - 1]; pr[k] = a * wr - b * wi; pi[k] = a * wi + b * wr; }
    }
}
__device__ __forceinline__ void unit_root(float frac, bool inv, float& wr, float& wi) {
    wr = __builtin_amdgcn_cosf(frac); const float s = __builtin_amdgcn_sinf(frac); wi = inv ? s : -s;
}
template <bool INV> __device__ __forceinline__ void pass1(LAS f32x2* dat, int tid) {
    asm volatile("" : "+v"(tid));
#pragma unroll 1
    for (int bb = 0; bb < 2; ++bb) {
        const int b = tid + 512 * bb; const int pb = b ^ ((b >> 5) & 31);
        float wr, wi; unit_root((float)b * (1.f / 16384.f), INV, wr, wi);
        float re[16], im[16];
        { float cr = 1.f, ci = 0.f;
#pragma unroll
          for (int j = 0; j < 16; ++j) { const f32x2 v = dat[pb + 1024 * j];
            if (INV) { re[j] = v.x * cr - v.y * ci; im[j] = v.x * ci + v.y * cr; const float t = cr * wr - ci * wi; ci = cr * wi + ci * wr; cr = t; } else { re[j] = v.x; im[j] = v.y; } } }
        dft_reg<16, INV>(re, im);
        { float cr = 1.f, ci = 0.f;
#pragma unroll
          for (int k = 0; k < 16; ++k) { const float xr = re[brev(k, 4)], xi = im[brev(k, 4)]; f32x2 o;
            if (!INV) { o.x = xr * cr - xi * ci; o.y = xr * ci + xi * cr; const float t = cr * wr - ci * wi; ci = cr * wi + ci * wr; cr = t; } else { o.x = xr; o.y = xi; }
            dat[pb + 1024 * k] = o; } }
    }
}
template <bool INV> __device__ __forceinline__ void pass2(LAS f32x2* dat, int tid) {
    asm volatile("" : "+v"(tid));
    const int b = tid & 31, base = (tid >> 5) * 1024;
    float wr, wi; unit_root((float)b * (1.f / 1024.f), INV, wr, wi);
    float re[32], im[32];
    { float cr = 1.f, ci = 0.f;
#pragma unroll
      for (int j = 0; j < 32; ++j) { const f32x2 v = dat[base + 32 * j + (b ^ j)];
        if (INV) { re[j] = v.x * cr - v.y * ci; im[j] = v.x * ci + v.y * cr; const float t = cr * wr - ci * wi; ci = cr * wi + ci * wr; cr = t; } else { re[j] = v.x; im[j] = v.y; } } }
    dft_reg<32, INV>(re, im);
    { float cr = 1.f, ci = 0.f;
#pragma unroll
      for (int k = 0; k < 32; ++k) { const float xr = re[brev(k, 5)], xi = im[brev(k, 5)]; f32x2 o;
        if (!INV) { o.x = xr * cr - xi * ci; o.y = xr * ci + xi * cr; const float t = cr * wr - ci * wi; ci = cr * wi + ci * wr; cr = t; } else { o.x = xr; o.y = xi; }
        dat[base + 32 * k + (b ^ k)] = o; } }
}
template <bool FILTER> __device__ __forceinline__ void pass3(LAS f32x2* dat, int tid, f32x2* Kbuf) {
    asm volatile("" : "+v"(tid));
    const int q = tid, sw = q & 31, base = 32 * q;
    float re[32], im[32];
#pragma unroll
    for (int j = 0; j < 32; ++j) { const f32x2 v = dat[base + (j ^ sw)]; re[j] = v.x; im[j] = v.y; }
    dft_reg<32, false>(re, im);
    if (FILTER) {
#pragma unroll
        for (int k = 0; k < 32; ++k) { f32x2 o; o.x = re[brev(k, 5)]; o.y = im[brev(k, 5)]; Kbuf[k * 512 + q] = o; }
    } else {
        float yr[32], yi[32];
#pragma unroll
        for (int k = 0; k < 32; ++k) { const f32x2 kv = Kbuf[k * 512 + q]; const float xr = re[brev(k, 5)], xi = im[brev(k, 5)]; yr[k] = xr * kv.x - xi * kv.y; yi[k] = xr * kv.y + xi * kv.x; }
        dft_reg<32, true>(yr, yi);
#pragma unroll
        for (int j = 0; j < 32; ++j) { f32x2 o; o.x = yr[brev(j, 5)]; o.y = yi[brev(j, 5)]; dat[base + (j ^ sw)] = o; }
    }
}
__device__ __forceinline__ int phys(int p) { return p ^ ((p >> 5) & 31); }
__device__ __forceinline__ void unpack8(const u32x4 v, float (&f)[8]) { f[0] = bflo(v.x); f[1] = bfhi(v.x); f[2] = bflo(v.y); f[3] = bfhi(v.y); f[4] = bflo(v.z); f[5] = bfhi(v.z); f[6] = bflo(v.w); f[7] = bfhi(v.w); }
__device__ __forceinline__ void conv8(const bf16* rowp, int t0, float w0, float w1, float w2, float cb, float (&o)[8]) {
    float f[8]; unpack8(*(const u32x4*)(rowp + t0), f);
    const float left = (t0 > 0) ? bf2f(rowp[t0 - 1]) : 0.f, right = (t0 + 8 < L) ? bf2f(rowp[t0 + 8]) : 0.f;
#pragma unroll
    for (int e = 0; e < 8; ++e) { const float a = (e == 0) ? left : f[e - 1], c = (e == 7) ? right : f[e + 1]; o[e] = w0 * a + w1 * f[e] + w2 * c + cb; }
}
typedef const LAS float* ChanPar;
__device__ __forceinline__ void load_z(const bf16* pT, int d, int t0, ChanPar P, float (&z0)[8], float (&z1)[8]) {
#pragma unroll
    for (int bt = 0; bt < 2; ++bt) { float a[8], v[8];
        conv8(pT + (size_t)(DM + d) * MTOK + bt * L, t0, P[4], P[5], P[6], P[7], a);
        conv8(pT + (size_t)(2 * DM + d) * MTOK + bt * L, t0, P[8], P[9], P[10], P[11], v);
#pragma unroll
        for (int e = 0; e < 8; ++e) { if (bt == 0) z0[e] = a[e] * v[e]; else z1[e] = a[e] * v[e]; } }
}
__device__ __forceinline__ void filt8(const bf16* HT, int d, int t0, ChanPar P, float (&k)[8], float (&kl)[8], float& l1p) {
    float hf[8], hb[8]; unpack8(*(const u32x4*)(HT + (size_t)d * L + t0), hf); unpack8(*(const u32x4*)(HT + (size_t)(DM + d) * L + (L - t0 - 8)), hb);
    float s = 0.f;
#pragma unroll
    for (int e = 0; e < 8; ++e) { const float dc = __builtin_amdgcn_exp2f(-(float)(t0 + e) * P[13]); k[e] = hf[e] * dc; s += fabsf(k[e]); }
    float hbd[8];
#pragma unroll
    for (int e = 0; e < 8; ++e) { const int m = L - t0 - 8 + e; const float dc = __builtin_amdgcn_exp2f(-(float)m * P[13]); hbd[e] = hb[e] * dc; if (m >= 1) s += fabsf(hbd[e]); }
    float first = 0.f;
    if (t0 > 0) { const int m = L - t0; first = bf2f(HT[(size_t)(DM + d) * L + m]) * __builtin_amdgcn_exp2f(-(float)m * P[13]); }
    kl[0] = first;
#pragma unroll
    for (int e = 1; e < 8; ++e) kl[e] = hbd[8 - e];
#pragma unroll
    for (int e = 0; e < 8; ++e) { k[e] *= P[14]; kl[e] *= P[14]; }
    l1p = s;
}
__device__ __forceinline__ void hyena_phase(const Frame& F) {
    LAS f32x2* dat = (LAS f32x2*)F.lds; LAS float* redu = (LAS float*)(F.lds + RING_BYTES);
    const bf16* pT = (const bf16*)(F.ws + WS_B); const bf16* HT = (const bf16*)(F.ws + WS_HT); bf16* yT = (bf16*)(F.ws + WS_A);
    f32x2* Ke = (f32x2*)(F.ws + WS_FFTS) + (size_t)F.bid * 49152; f32x2* Ko = Ke + 16384; f32x2* SeB = Ke + 32768;
    for (int d = F.bid; d < DM; d += F.G) {
        int tid = fresh_tid(F.wave);
        LAS float* PW = (LAS float*)(F.lds + RING_BYTES + 64); ChanPar P = PW;
        __syncthreads();
        if (tid < 12) { const int i = tid & 3, pj = tid >> 2; PW[tid] = (i < 3) ? AIN(I_HCW)[i * 3 * DM + pj * DM + d] : AIN(I_HCB)[pj * DM + d]; }
        if (tid == 12) PW[12] = AIN(I_FBIAS)[d];
        if (tid == 13) { const float mind = -4.605170185988091f / 1.5f, maxd = -4.605170185988091f / 0.3f; const float delta = fabsf(mind + (maxd - mind) * ((float)d / (float)(DM - 1)));
            PW[13] = delta * (1.f / (float)(L - 1)) * 1.4426950408889634f; PW[14] = 1.f; }
        __syncthreads();
        { float s = 0.f;
#pragma unroll 1
          for (int sI = 0; sI < 4; ++sI) { float k[8], kl[8], l1p; filt8(HT, d, 8 * (tid + 512 * sI), P, k, kl, l1p); s += l1p; }
          s = wave_sum(s); if (F.lane == 0) redu[F.wave] = s; __syncthreads();
          float tot = 0.f;
#pragma unroll
          for (int w = 0; w < NWAVES; ++w) tot += redu[w];
          __syncthreads(); if (tid == 0) PW[14] = 1.f / tot; __syncthreads(); }
#pragma unroll 1
        for (int odd = 0; odd < 2; ++odd) {
            asm volatile("" : "+v"(tid));
#pragma unroll 1
            for (int sI = 0; sI < 4; ++sI) { const int t0 = 8 * (tid + 512 * sI); float k[8], kl[8], l1p; filt8(HT, d, t0, P, k, kl, l1p);
#pragma unroll
                for (int e = 0; e < 8; ++e) { f32x2 o; if (!odd) { o.x = k[e] + kl[e]; o.y = 0.f; } else { const float a = k[e] - kl[e]; float wr, wi; unit_root((float)(t0 + e) * (1.f / 32768.f), false, wr, wi); o.x = a * wr; o.y = a * wi; }
                    dat[phys(t0 + e)] = o; } }
            __syncthreads(); pass1<false>(dat, tid); __syncthreads(); pass2<false>(dat, tid); __syncthreads(); pass3<true>(dat, tid, odd ? Ko : Ke); __syncthreads();
        }
#pragma unroll 1
        for (int odd = 0; odd < 2; ++odd) {
            asm volatile("" : "+v"(tid));
#pragma unroll 1
            for (int sI = 0; sI < 4; ++sI) { const int t0 = 8 * (tid + 512 * sI); float z0[8], z1[8]; load_z(pT, d, t0, P, z0, z1);
#pragma unroll
                for (int e = 0; e < 8; ++e) { f32x2 o; if (!odd) { o.x = z0[e]; o.y = z1[e]; } else { float wr, wi; unit_root((float)(t0 + e) * (1.f / 32768.f), false, wr, wi); o.x = z0[e] * wr - z1[e] * wi; o.y = z0[e] * wi + z1[e] * wr; }
                    dat[phys(t0 + e)] = o; } }
            __syncthreads(); pass1<false>(dat, tid); __syncthreads(); pass2<false>(dat, tid); __syncthreads(); pass3<false>(dat, tid, odd ? Ko : Ke); __syncthreads();
            pass2<true>(dat, tid); __syncthreads(); pass1<true>(dat, tid); __syncthreads();
            if (!odd) {
                asm volatile("" : "+v"(tid));
#pragma unroll 1
                for (int sI = 0; sI < 4; ++sI)
#pragma unroll
                    for (int e = 0; e < 8; ++e) { const f32x2 v = dat[phys(8 * (tid + 512 * sI) + e)]; SeB[e * 2048 + tid + 512 * sI] = v; }
                __syncthreads();
            }
        }
        asm volatile("" : "+v"(tid));
#pragma unroll 1
        for (int sI = 0; sI < 4; ++sI) { const int t0 = 8 * (tid + 512 * sI); float z0[8], z1[8]; load_z(pT, d, t0, P, z0, z1);
            float o0[8], o1[8];
#pragma unroll
            for (int e = 0; e < 8; ++e) { const f32x2 so = dat[phys(t0 + e)]; const f32x2 se = SeB[e * 2048 + tid + 512 * sI]; float wr, wi; unit_root((float)(t0 + e) * (1.f / 32768.f), true, wr, wi);
                const float yr = (se.x + so.x * wr - so.y * wi) * (1.f / 32768.f), yi = (se.y + so.x * wi + so.y * wr) * (1.f / 32768.f);
                o0[e] = yr + P[12] * z0[e]; o1[e] = yi + P[12] * z1[e]; }
#pragma unroll
            for (int bt = 0; bt < 2; ++bt) { float xc[8]; conv8(pT + (size_t)d * MTOK + bt * L, t0, P[0], P[1], P[2], P[3], xc);
                u32x4 w;
                if (bt == 0) { w.x = cvt_pk_bf16(xc[0] * o0[0], xc[1] * o0[1]); w.y = cvt_pk_bf16(xc[2] * o0[2], xc[3] * o0[3]); w.z = cvt_pk_bf16(xc[4] * o0[4], xc[5] * o0[5]); w.w = cvt_pk_bf16(xc[6] * o0[6], xc[7] * o0[7]); }
                else { w.x = cvt_pk_bf16(xc[0] * o1[0], xc[1] * o1[1]); w.y = cvt_pk_bf16(xc[2] * o1[2], xc[3] * o1[3]); w.z = cvt_pk_bf16(xc[4] * o1[4], xc[5] * o1[5]); w.w = cvt_pk_bf16(xc[6] * o1[6], xc[7] * o1[7]); }
                *(u32x4*)(yT + (size_t)d * MTOK + bt * L + t0) = w; } }
        __syncthreads();
    }
}
__device__ __forceinline__ void transpose_phase(const Frame& F) {
    const bf16* yT = (const bf16*)(F.ws + WS_A); bf16* y = (bf16*)(F.ws + WS_B);
    LAS bf16* tl = (LAS bf16*)(F.lds + F.wave * 16384);
    const int gw = F.bid * NWAVES + F.wave, NGW = F.G * NWAVES, lane = F.lane;
    for (int tile = gw; tile < 32 * 512; tile += NGW) { const int d0 = (tile & 31) * 64, t0 = (tile >> 5) * 64;
#pragma unroll
        for (int i = 0; i < 8; ++i) { const int r = i * 8 + (lane >> 3), ch = lane & 7; const u32x4 v = *(const u32x4*)(yT + (size_t)(d0 + r) * MTOK + t0 + ch * 8); *(LAS u32x4*)(tl + r * 72 + ch * 8) = v; }
        LDS_WAIT();
#pragma unroll
        for (int i = 0; i < 8; ++i) { const int tr = i * 8 + (lane >> 3), ch = lane & 7; unsigned short e[8];
#pragma unroll
            for (int k = 0; k < 8; ++k) e[k] = tl[(ch * 8 + k) * 72 + tr];
            u32x4 w; w.x = e[0] | ((unsigned)e[1] << 16); w.y = e[2] | ((unsigned)e[3] << 16); w.z = e[4] | ((unsigned)e[5] << 16); w.w = e[6] | ((unsigned)e[7] << 16);
            *(u32x4*)(y + (size_t)(t0 + tr) * DM + d0 + ch * 8) = w; }
        LDS_WAIT();
    }
}
}
constexpr int NPHASE = 19;

__device__ __forceinline__ void moe_table(const Frame& F, int layer, LAS int* tab) {
    if (F.tid < NCLS) tab[32 + F.tid] = (int)__hip_atomic_load((unsigned*)(F.ctl + CW_CNT + (layer * NCLS + F.tid) * 64), RLX_AGENT);
    __syncthreads();
    if (F.tid == 0) { int a = 0; for (int c = 0; c < NCLS; ++c) { tab[c] = a; a += (tab[32 + c] + 255) >> 8; } tab[24] = a; }
    __syncthreads();
}

#define IN(k) ((ONLY < 0 || (k) == ONLY) && lo <= (k) && (k) < hi)
#define SEAM(k) do { if ((k) + 1 < hi) xcd_barrier(bar); } while (0)
#define ENTER() do { int l_; asm volatile("v_mbcnt_lo_u32_b32 %0, -1, 0\n\tv_mbcnt_hi_u32_b32 %0, -1, %0" : "=&v"(l_)); const int t_ = F.wave * 64 + l_; F.tid = t_; F.lane = l_; } while (0)
template <int ONLY> __device__ __forceinline__ void layer_phases(Frame& F, const XcdBarrier& bar, const int lo, const int hi, const int layer, LAS int* tab) {
        const int pb = 3 + 8 * layer;
        if (layer == 0) {
            if (IN(pb + 0)) { ENTER();
                pg::PlainSched S; S.init(F.ws + WS_A, F.ws + WS_WQKV, MTOK, QKVD, DM, DM, F.G, F.bid);
                pg::EpiQKV E{(bf16*)(F.ws + WS_B), (bf16*)(F.ws + WS_B + 128 * MiB), (bf16*)(F.ws + WS_B + 144 * MiB), AIN(I_ABIN), (const float*)(F.ws + WS_ROPE), (const float*)(F.ws + WS_ROPE) + 4096};
                pg::gemm_phase<pg::EpiQKV, pg::PlainSched, false, false, true>(F.lds, F.tid, DM, DM, DM, S, E);
                SEAM(pb + 0);
            }
            if (IN(pb + 1)) { ENTER(); att::attn_phase(F); SEAM(pb + 1); }
        } else {
            if (IN(pb + 0)) { ENTER();
                pg::PlainSched S; S.init(F.ws + WS_WHYIN, F.ws + WS_A, 3 * DM, MTOK, DM, DM, F.G, F.bid);
                pg::EpiBf16<true> E{(bf16*)(F.ws + WS_B), MTOK, AIN(I_HBIN)};
                pg::gemm_phase<pg::EpiBf16<true>, pg::PlainSched, false, false, true>(F.lds, F.tid, DM, DM, DM, S, E);
                SEAM(pb + 0);
            }
            if (IN(pb + 1)) { ENTER(); hy::hyena_phase(F); SEAM(pb + 1); }
            if (IN(pb + 2)) { ENTER(); hy::transpose_phase(F); SEAM(pb + 2); }
        }
        if (IN(pb + 3)) { ENTER();
            const void* A = layer ? (const void*)(F.ws + WS_B) : (const void*)(F.ws + WS_A);
            const void* Bt = layer ? (const void*)(F.ws + WS_WHYO) : (const void*)(F.ws + WS_WO0);
            bf16* O = (bf16*)(F.ws + WS_B + (layer ? 128 : 192) * MiB);
            pg::PlainSched S; S.init(A, Bt, MTOK, DM, DM, DM, F.G, F.bid);
            pg::EpiBf16<false> E{O, DM, layer ? AIN(I_HBOUT) : nullptr};
            pg::gemm_phase<pg::EpiBf16<false>, pg::PlainSched, false, false, true>(F.lds, F.tid, DM, DM, DM, S, E);
            SEAM(pb + 3);
        }
        if (IN(pb + 4)) { ENTER();
            ln1_router_phase(F, layer, layer ? (const float*)F.out : AIN(I_X), (const bf16*)(F.ws + WS_B + (layer ? 128 : 192) * MiB), (bf16*)(F.ws + WS_A));
            SEAM(pb + 4);
        }
        if (IN(pb + 5)) { ENTER();
            moe_table(F, layer, tab);
            pg::MoeSched S{tab, (const char*)(F.ws + WS_A), (const char*)(F.ws + WS_W13 + (size_t)layer * 128 * MiB), (const int*)(F.ws + WS_TOK), F.G, F.bid, 16, 0};
            pg::EpiMoe1 E{(bf16*)(F.ws + WS_B), (const float*)(F.ws + WS_GATE)};
            pg::gemm_phase<pg::EpiMoe1, pg::MoeSched, true, false, true>(F.lds, F.tid, DM, DM, DM, S, E);
            SEAM(pb + 5);
        }
        if (IN(pb + 6)) { ENTER();
            moe_table(F, layer, tab);
            pg::MoeSched S{tab, (const char*)(F.ws + WS_B), (const char*)(F.ws + WS_W2 + (size_t)layer * 64 * MiB), (const int*)(F.ws + WS_TOK), F.G, F.bid, 8, 1};
            pg::EpiMoe2 E{(bf16*)(F.ws + WS_A), (const int*)(F.ws + WS_TOK)};
            pg::gemm_phase<pg::EpiMoe2, pg::MoeSched, false, true, true>(F.lds, F.tid, DM, DM, EFF, S, E);
            SEAM(pb + 6);
        }
        if (IN(pb + 7)) { ENTER(); ln2_phase(F, layer, (bf16*)(F.ws + WS_A)); SEAM(pb + 7); }
}
template <int ONLY> __global__ void __launch_bounds__(NTHR, 2) fwd_kernel(Args args) {
    extern __shared__ __attribute__((aligned(16))) unsigned char lds_raw[];
    Frame F;
    F.lds = (LAS unsigned char*)lds_raw;
    F.tid = threadIdx.x; F.lane = F.tid & 63; F.wave = __builtin_amdgcn_readfirstlane(F.tid >> 6);
    F.G = gridDim.x; F.bid = blockIdx.x; F.ws = args.ws; F.ctl = (gu32*)(args.ws + WS_CTL); F.out = args.out;
    F.a = &args;
    for (int u = F.tid; u < (LDS_BYTES - RING_BYTES) / 4; u += NTHR) ((LAS unsigned*)(F.lds + RING_BYTES))[u] = 0u;
    __syncthreads();
    const int lo = args.ph_lo, hi = args.ph_hi;
    XcdBarrier bar; bar.bar = (unsigned*)(F.ctl + CW_BAR); bar.x = 0; bar.st = nullptr;
    if (ONLY < 0 && hi - lo > 1) bar = xcd_barrier_post((unsigned*)(F.ctl + CW_BAR), (volatile LAS unsigned*)(F.lds + MISC_OFF));
    LAS int* tab = (LAS int*)(F.lds + RING_BYTES + 64);

    if (IN(0)) { ENTER(); p0_prologue(F); SEAM(0); }
    if (IN(1)) { ENTER(); p1_prologue(F); SEAM(1); }
    if (IN(2)) { ENTER();
        pg::PlainSched S; S.init(F.ws + WS_W4T, F.ws + WS_HDN, 4096, SEQ, 128, 128, F.G, F.bid);
        pg::EpiBf16<true> E{(bf16*)(F.ws + WS_HT), SEQ, nullptr};
        int kf = 128; asm volatile("" : "+s"(kf));
        pg::gemm_phase<pg::EpiBf16<true>, pg::PlainSched, false, false, true>(F.lds, F.tid, kf, 128, 128, S, E);
        SEAM(2);
    }
    if constexpr (ONLY >= 0) { if (ONLY >= 3 && ONLY < 11) layer_phases<ONLY>(F, bar, lo, hi, 0, tab); if (ONLY >= 11) layer_phases<ONLY>(F, bar, lo, hi, 1, tab); }
    else {
#pragma unroll 1
        for (int layer = 0; layer < 2; ++layer) layer_phases<ONLY>(F, bar, lo, hi, layer, tab);
    }
}
#undef IN
#undef SEAM

extern "C" void kernel_launch(void* const* d_in, const int* in_sizes, int n_in, void* d_out, int out_size, void* d_ws, size_t ws_size, hipStream_t stream) {
    static int grid = 0;
    if (grid == 0) {
        if (n_in != 34 || in_sizes[0] != MTOK * DM || out_size != MTOK * DM || ws_size < WS_END) { fprintf(stderr, "kernel_launch: unexpected shapes / workspace (n_in %d, ws %zu, need %zu)\n", n_in, ws_size, (size_t)WS_END); grid = -1; return; }
        int dev = 0, cus = 0;
        if (hipGetDevice(&dev) != hipSuccess || hipDeviceGetAttribute(&cus, hipDeviceAttributeMultiprocessorCount, dev) != hipSuccess) { grid = -1; return; }
#if !MK_SPLIT
        if (hipFuncSetAttribute((const void*)fwd_kernel<-1>, hipFuncAttributeMaxDynamicSharedMemorySize, LDS_BYTES) != hipSuccess) { fprintf(stderr, "kernel_launch: hipFuncSetAttribute failed\n"); grid = -1; return; }
        int per_cu = 0;
        if (hipOccupancyMaxActiveBlocksPerMultiprocessor(&per_cu, (const void*)fwd_kernel<-1>, NTHR, LDS_BYTES) != hipSuccess || per_cu < 1) fprintf(stderr, "kernel_launch: occupancy query reports %d blocks per CU\n", per_cu);
        (void)hipGetLastError();
#endif
        grid = cus;
    }
    if (grid < 0) return;
    (void)hipMemsetAsync((char*)d_ws + WS_CTL, 0, CTL_ZERO_BYTES, stream);
    Args a{};
    for (int i = 0; i < 34; ++i) a.in[i] = (const float*)d_in[i];
    a.out = (float*)d_out; a.ws = (unsigned char*)d_ws;
#if MK_SPLIT
    typedef void (*kfn)(Args);
    static const kfn fns[NPHASE] = {fwd_kernel<0>, fwd_kernel<1>, fwd_kernel<2>, fwd_kernel<3>, fwd_kernel<4>, nullptr, fwd_kernel<6>, fwd_kernel<7>, fwd_kernel<8>, fwd_kernel<9>, fwd_kernel<10>,
                                      fwd_kernel<11>, fwd_kernel<12>, fwd_kernel<13>, fwd_kernel<14>, fwd_kernel<15>, fwd_kernel<16>, fwd_kernel<17>, fwd_kernel<18>};
    static bool attr_done = false;
    if (!attr_done) { for (int ph = 0; ph < NPHASE; ++ph) if (fns[ph]) (void)hipFuncSetAttribute((const void*)fns[ph], hipFuncAttributeMaxDynamicSharedMemorySize, LDS_BYTES); attr_done = true; }
    for (int ph = 0; ph < NPHASE; ++ph) { if (!fns[ph]) continue; a.ph_lo = ph; a.ph_hi = ph + 1; hipLaunchKernelGGL(fns[ph], dim3(grid), dim3(NTHR), LDS_BYTES, stream, a); }
#else
    a.ph_lo = 0; a.ph_hi = NPHASE; hipLaunchKernelGGL(fwd_kernel<-1>, dim3(grid), dim3(NTHR), LDS_BYTES, stream, a);
#endif
}
```

```cpp
#include <hip/hip_runtime.h>
#include <hip/hip_bf16.h>
#include <cstdio>
#include <cstdint>

#ifndef MK_SPLIT
#define MK_SPLIT 0
#endif

#define GAS __attribute__((address_space(1)))
#define LAS __attribute__((address_space(3)))
typedef unsigned short bf16;
typedef unsigned u32x4 __attribute__((ext_vector_type(4)));
typedef unsigned u32x2 __attribute__((ext_vector_type(2)));
typedef float f32x2 __attribute__((ext_vector_type(2)));
typedef float f32x4 __attribute__((ext_vector_type(4)));
typedef float f32x16 __attribute__((ext_vector_type(16)));
typedef short bf16x8 __attribute__((ext_vector_type(8)));
typedef short s16x4 __attribute__((ext_vector_type(4)));
typedef GAS unsigned gu32;

constexpr int DM = 2048, NB = 2, SEQ = 16384, MTOK = NB * SEQ, CTXL = 256, GRIDW = 64;
constexpr int NHEAD = 32, NKV = 4, HD = 64, QKVD = 2560, KVD = 256;
constexpr int NEXP = 16, EFF = 1024, NCLS = 24, LCAP = 32768;
constexpr int HYW = 64, HYEMB = 33;
constexpr float LN_EPS = 1e-5f;
constexpr float DN_ALPHA = 1.41421356237309515f;
constexpr float QSCALE = 0.125f * 1.4426950408889634f;
constexpr int NWAVES = 8, NTHR = 512;

constexpr size_t MiB = 1u << 20;
constexpr size_t WS_CTL = 0, CTL_ZERO_BYTES = 1 * MiB;
constexpr size_t WS_MOD = 1 * MiB;
constexpr size_t WS_ROPE = 1 * MiB + 512 * 1024;
constexpr size_t WS_FTAB = 1 * MiB + 768 * 1024;
constexpr size_t WS_CTXKV = 2 * MiB;
constexpr size_t WS_HDN = 3 * MiB;
constexpr size_t WS_W4T = 7 * MiB;
constexpr size_t WS_TOK = 8 * MiB;
constexpr size_t WS_GATE = 11 * MiB;
constexpr size_t WS_BADMAP = 1 * MiB + 384 * 1024;
constexpr size_t WS_SIDE = 20 * MiB;
constexpr size_t WS_FFTS = 32 * MiB;
constexpr size_t WS_HT = 128 * MiB;
constexpr size_t WS_WQKV = 256 * MiB;
constexpr size_t WS_WO0 = 266 * MiB;
constexpr size_t WS_WHYIN = 274 * MiB;
constexpr size_t WS_WHYO = 298 * MiB;
constexpr size_t WS_W13 = 320 * MiB;
constexpr size_t WS_W2 = 576 * MiB;
constexpr size_t WS_A = 704 * MiB;
constexpr size_t WS_B = 832 * MiB;
constexpr size_t WS_END = 1216 * MiB;
constexpr int HID_ROWS = 38912;

constexpr int CW_TMO = 0;
constexpr int CW_BAR = 4096;
constexpr int CW_CNT = 16384;

constexpr int RING_BYTES = 131072;
constexpr int MISC_OFF = RING_BYTES + 320;
constexpr int FTAB_OFF = RING_BYTES + 1024;
constexpr int LDS_BYTES = 163840;

#define RLX_AGENT __ATOMIC_RELAXED, __HIP_MEMORY_SCOPE_AGENT
#define LDS_WAIT() asm volatile("s_waitcnt lgkmcnt(0)" ::: "memory")
#define VM_WAIT() asm volatile("s_waitcnt vmcnt(0)" ::: "memory")

__device__ __forceinline__ unsigned cvt_pk_bf16(float lo, float hi) { unsigned r; asm volatile("v_cvt_pk_bf16_f32 %0, %1, %2" : "=v"(r) : "v"(lo), "v"(hi)); return r; }
__device__ __forceinline__ float bf2f(unsigned h) { return __builtin_bit_cast(float, h << 16); }
__device__ __forceinline__ float bflo(unsigned w) { return __builtin_bit_cast(float, w << 16); }
__device__ __forceinline__ float bfhi(unsigned w) { return __builtin_bit_cast(float, w & 0xffff0000u); }
__device__ __forceinline__ float wave_sum(float v) {
    v += __builtin_bit_cast(float, __builtin_amdgcn_update_dpp(0, __builtin_bit_cast(int, v), 0xB1, 0xf, 0xf, true));
    v += __builtin_bit_cast(float, __builtin_amdgcn_update_dpp(0, __builtin_bit_cast(int, v), 0x4E, 0xf, 0xf, true));
    v += __builtin_bit_cast(float, __builtin_amdgcn_update_dpp(0, __builtin_bit_cast(int, v), 0x141, 0xf, 0xf, true));
    v += __builtin_bit_cast(float, __builtin_amdgcn_update_dpp(0, __builtin_bit_cast(int, v), 0x140, 0xf, 0xf, true));
    { auto r = __builtin_amdgcn_permlane16_swap(__float_as_uint(v), __float_as_uint(v), false, false); v = __uint_as_float(r[0]) + __uint_as_float(r[1]); }
    { auto r = __builtin_amdgcn_permlane32_swap(__float_as_uint(v), __float_as_uint(v), false, false); v = __uint_as_float(r[0]) + __uint_as_float(r[1]); }
    return v;
}

#define XB_TMO      128
#define XB_XCNT(j)  (256  + 64 * (j))
#define XB_XSUB(j)  (1280 + 64 * (j))
#define XB_XGEN(j)  (2304 + 64 * (j))
#define XB_TOP      3328
#define XB_TOPGEN   3392
#define XCD_BAR_WORDS 3456
#define XB_SPIN_CAP (1u << 18)

__device__ __forceinline__ unsigned xb_ld(unsigned* p)              { return __hip_atomic_load(p, __ATOMIC_RELAXED, __HIP_MEMORY_SCOPE_AGENT); }
__device__ __forceinline__ unsigned xb_add(unsigned* p, unsigned v) { return __hip_atomic_fetch_add(p, v, __ATOMIC_RELAXED, __HIP_MEMORY_SCOPE_AGENT); }
__device__ __forceinline__ unsigned xb_xcc_id() { return (unsigned)__builtin_amdgcn_s_getreg((3 << 11) | 20) & 0xFu; }
#define XB_SPIN(cond, bar) do { unsigned _sp = 0; while (cond) { __builtin_amdgcn_s_sleep(1); \
    if ((++_sp & 255u) == 0u) { if (xb_ld(&(bar)[XB_TMO])) break; if (_sp > XB_SPIN_CAP) { atomicAdd(&(bar)[XB_TMO], 1u); break; } } } } while (0)

struct XcdBarrier { unsigned* bar; unsigned x; volatile LAS unsigned* st; };

__device__ __forceinline__ XcdBarrier xcd_barrier_post(unsigned* bar, volatile LAS unsigned* st) {
    XcdBarrier b; b.bar = bar; b.x = xb_xcc_id(); b.st = st;
    if (threadIdx.x == 0) (void)xb_add(&bar[XB_XCNT(b.x)], 1u);
    return b;
}
__device__ __forceinline__ void xcd_barrier_complete(unsigned* bar, unsigned x, unsigned& nloc, unsigned& nx) {
    const unsigned G = gridDim.x * gridDim.y * gridDim.z;
    unsigned sum, cnt, mine, sp = 0u;
    for (;;) {
        sum = 0u; cnt = 0u; mine = 0u;
#pragma unroll
        for (unsigned j = 0; j < 16; ++j) { const unsigned c = xb_ld(&bar[XB_XCNT(j)]); sum += c; cnt += (c > 0u) ? 1u : 0u; mine = (j == x) ? c : mine; }
        if (sum == G) break;
        __builtin_amdgcn_s_sleep(1);
        if ((++sp & 255u) == 0u) { if (xb_ld(&bar[XB_TMO])) break; if (sp > XB_SPIN_CAP) { atomicAdd(&bar[XB_TMO], 1u); break; } }
    }
    nloc = mine > 0u ? mine : 1u; nx = cnt > 0u ? cnt : 1u;
}
__device__ __forceinline__ void xcd_barrier(const XcdBarrier& b) {
    asm volatile("s_waitcnt vmcnt(0)" ::: "memory");
    __syncthreads();
    if (threadIdx.x == 0) {
        unsigned* bar = b.bar;
        __builtin_amdgcn_s_waitcnt(0);
        unsigned nloc = b.st[0], nx = b.st[1];
        if (nloc == 0u) { xcd_barrier_complete(bar, b.x, nloc, nx); b.st[0] = nloc; b.st[1] = nx; }
        const unsigned old = xb_add(&bar[XB_XSUB(b.x)], 1u);
        const unsigned gen = old / nloc;
        if (old + 1u == (gen + 1u) * nloc) {
            __builtin_amdgcn_fence(__ATOMIC_RELEASE, "agent");
            asm volatile("s_waitcnt vmcnt(0)" ::: "memory");
            const unsigned og = xb_add(&bar[XB_TOP], 1u);
            const unsigned tg = og / nx;
            if (og + 1u == (tg + 1u) * nx) xb_add(&bar[XB_TOPGEN], 1u);
            else XB_SPIN(xb_ld(&bar[XB_TOPGEN]) == tg, bar);
            __builtin_amdgcn_fence(__ATOMIC_ACQUIRE, "agent");
            xb_add(&bar[XB_XGEN(b.x)], 1u);
            asm volatile("s_waitcnt vmcnt(0)" ::: "memory");
        } else {
            XB_SPIN(xb_ld(&bar[XB_XGEN(b.x)]) == gen, bar);
            __builtin_amdgcn_fence(__ATOMIC_ACQUIRE, "agent");
            asm volatile("s_waitcnt vmcnt(0)" ::: "memory");
        }
    }
    __syncthreads();
}

namespace pg {
constexpr int BM = 256, BK = 64, HALF = 128, HTB = HALF * BK * 2, NXCD = 8, WGM = 8;
__host__ __device__ __forceinline__ int lds_byte(int r, int c) { const int st = (r >> 4) * 2 + (c >> 5), rr = r & 15, cc = c & 31, ob = rr * 64 + cc * 2; return st * 1024 + (ob ^ (((ob >> 9) & 1) << 5)); }
__host__ __device__ __forceinline__ void stage_rc(int b, int& R, int& C) { const int st = b / 1024, sb = b % 1024, swz = sb ^ (((sb >> 9) & 1) << 5); R = (st >> 1) * 16 + swz / 64; C = (st & 1) * 32 + (swz % 64) / 2; }
__host__ __device__ __forceinline__ int perm32(int rho) { const int n = rho >> 4, i = rho & 15; return 8 * (i >> 2) + 4 * n + (i & 3); }

struct Unit { int pm, pn; const char* A; const char* B; const char* B2; int cls, row0, nrows, lbase; };

__device__ __forceinline__ bool static_map(int i, int G, int c, int nM, int nN, int& pm, int& pn) {
    const int nwg = nM * nN; const long L = (long)i * G + c; if (L >= nwg) return false;
    int wgid = (int)L; { const int q = nwg / NXCD, r = nwg % NXCD, xcd = wgid % NXCD, off = wgid / NXCD; wgid = (xcd < r ? xcd * (q + 1) : r * (q + 1) + (xcd - r) * q) + off; }
    const int nig = WGM * nN, gid = wgid / nig, fm = gid * WGM, gsz = (nM - fm) < WGM ? (nM - fm) : WGM;
    pm = fm + ((wgid % nig) % gsz); pn = (wgid % nig) / gsz; return true;
}
struct PlainSched {
    const char* A; const char* Bt; int nM, nN, G, c; size_t tA, tB;
    __device__ __forceinline__ void init(const void* A_, const void* Bt_, int M, int N, int ldA, int ldB, int G_, int c_) { A = (const char*)A_; Bt = (const char*)Bt_; nM = M / BM; nN = N / BM; G = G_; c = c_; tA = (size_t)BM * ldA * 2; tB = (size_t)BM * ldB * 2; }
    __device__ __forceinline__ bool next(int i, Unit& u) const {
        if (!static_map(i, G, c, nM, nN, u.pm, u.pn)) return false;
        u.A = A + (size_t)u.pm * tA; u.B = Bt + (size_t)u.pn * tB; u.B2 = u.B; u.cls = 0; u.row0 = 0; u.nrows = 256; u.lbase = 0; return true;
    }
    __device__ __forceinline__ unsigned row_off(const Unit&, int r, int ldA) const { return (unsigned)r * (unsigned)ldA * 2u; }
};

template <class Epi, class Sched, bool GATHER, bool KSPLIT, bool ALIGN_EPI>
__device__ __forceinline__ void gemm_phase(LAS unsigned char* lds, const int tid, const int K, const int ldA, const int ldB, const Sched& S, const Epi& E) {
    const int wid = __builtin_amdgcn_readfirstlane(tid >> 6), lane = tid & 63, wr = wid >> 2, wc = wid & 3, fr = lane & 15, fq = lane >> 4;
    const int nt = K / BK, nth = nt >> 1;
    int RA[2], CA[2];
    unsigned voffB[2], voA[2][2], nvoA[2][2];
#pragma unroll
    for (int i = 0; i < 2; ++i) { int R, C; stage_rc(tid * 16 + i * 8192, R, C); const int Rb = Epi::PERM ? ((R & ~31) + perm32(R & 31)) : R;
        RA[i] = R; CA[i] = C; voffB[i] = (unsigned)(Rb * ldB + C) * 2u;
        voA[0][i] = (unsigned)(R * ldA + C) * 2u; voA[1][i] = (unsigned)((R + HALF) * ldA + C) * 2u; nvoA[0][i] = voA[0][i]; nvoA[1][i] = voA[1][i]; }
    const size_t kstep = (size_t)(BK * 2);
    const size_t hstepB = (size_t)HALF * ldB * 2;
    const unsigned ldsw = (unsigned)wid * 1024u;
    const int aoff = lds_byte(wr * 64 + fr, fq * 8), boff = lds_byte(wc * 32 + fr, fq * 8);
#define PG8_SA(b, h) (((b) * 2 + (h)) * HTB)
#define PG8_SB(b, h) ((4 + (b) * 2 + (h)) * HTB)
#define PG8_STAGEB(bufoff, gbase) do { _Pragma("unroll") for (int _i = 0; _i < 2; ++_i) \
        __builtin_amdgcn_global_load_lds((const unsigned*)((const char*)(gbase) + voffB[_i]), (LAS unsigned*)(lds + (bufoff) + ldsw + _i * 8192), 16, 0, 0); } while (0)
#define PG8_STAGEA(bufoff, gbase, vo, h) do { _Pragma("unroll") for (int _i = 0; _i < 2; ++_i) \
        __builtin_amdgcn_global_load_lds((const unsigned*)((const char*)(gbase) + (vo)[h][_i]), (LAS unsigned*)(lds + (bufoff) + ldsw + _i * 8192), 16, 0, 0); } while (0)
#define PG8_LDA(dst, b, h) do { _Pragma("unroll") for (int m = 0; m < 4; ++m) _Pragma("unroll") for (int k = 0; k < 2; ++k) dst[m][k] = *(const LAS bf16x8*)(lds + PG8_SA(b, h) + aoff + m * 2048 + k * 1024); } while (0)
#define PG8_LDB(dst, b, h) do { _Pragma("unroll") for (int n = 0; n < 2; ++n) _Pragma("unroll") for (int k = 0; k < 2; ++k) dst[n][k] = *(const LAS bf16x8*)(lds + PG8_SB(b, h) + boff + n * 2048 + k * 1024); } while (0)
#define PG8_MMA(ai, bj, At, Bt) do { __builtin_amdgcn_s_setprio(1); _Pragma("unroll") for (int m = 0; m < 4; ++m) _Pragma("unroll") for (int n = 0; n < 2; ++n) _Pragma("unroll") for (int k = 0; k < 2; ++k) \
        acc[ai][bj][m][n] = __builtin_amdgcn_mfma_f32_16x16x32_bf16(Bt[n][k], At[m][k], acc[ai][bj][m][n], 0, 0, 0); __builtin_amdgcn_s_setprio(0); } while (0)
#define PG8_WAIT_V(n) asm volatile("s_waitcnt vmcnt(" #n ")" ::: "memory")
#define PG8_WAIT_L(n) asm volatile("s_waitcnt lgkmcnt(" #n ")" ::: "memory")
#define PG8_BAR __builtin_amdgcn_s_barrier()
#define PG8_SCHED __builtin_amdgcn_sched_barrier(0)
#define PG8_BPTR(tt) ((KSPLIT && (tt) >= nth) ? cB2 + (size_t)((tt) - nth) * kstep : cB + (size_t)(tt) * kstep)
    Unit cur, nxt; int ui = 0;
    if (!S.next(0, cur)) return;
    if constexpr (GATHER) {
#pragma unroll
        for (int h = 0; h < 2; ++h)
#pragma unroll
            for (int i = 0; i < 2; ++i) voA[h][i] = S.row_off(cur, h * HALF + RA[i], ldA) + (unsigned)CA[i] * 2u;
    }
    f32x4 acc[2][2][4][2];
#pragma unroll
    for (int a = 0; a < 2; ++a)
#pragma unroll
        for (int b = 0; b < 2; ++b)
#pragma unroll
            for (int m = 0; m < 4; ++m)
#pragma unroll
                for (int n = 0; n < 2; ++n) acc[a][b][m][n] = (f32x4){0.f, 0.f, 0.f, 0.f};
    bf16x8 At[4][2], B0[2][2], B1[2][2];
    const char* cA = cur.A; const char* cB = cur.B; const char* cB2 = cur.B2;
    PG8_STAGEB(PG8_SB(0, 0), cB); PG8_STAGEB(PG8_SB(0, 1), cB + hstepB); PG8_STAGEA(PG8_SA(0, 0), cA, voA, 0); PG8_STAGEA(PG8_SA(0, 1), cA, voA, 1);
    if (wr == 1) PG8_BAR;
    PG8_WAIT_V(2); PG8_BAR;
    { const char* b1 = PG8_BPTR(1); PG8_STAGEB(PG8_SB(1, 0), b1); PG8_STAGEA(PG8_SA(1, 0), cA + kstep, voA, 0); PG8_STAGEB(PG8_SB(1, 1), b1 + hstepB); }
    PG8_WAIT_V(6); PG8_BAR;
    for (;;) {
        const bool has_next = S.next(ui + 1, nxt);
        const char* nA = has_next ? nxt.A : cA; const char* nB = has_next ? nxt.B : cB;
        if constexpr (GATHER) {
            if (has_next) {
#pragma unroll
                for (int h = 0; h < 2; ++h)
#pragma unroll
                    for (int i = 0; i < 2; ++i) nvoA[h][i] = S.row_off(nxt, h * HALF + RA[i], ldA) + (unsigned)CA[i] * 2u;
            } else {
#pragma unroll
                for (int h = 0; h < 2; ++h)
#pragma unroll
                    for (int i = 0; i < 2; ++i) nvoA[h][i] = voA[h][i];
            }
        }
        for (int t = 0; t < nt; t += 2) {
            const bool last = (t == nt - 2);
            const char* a1 = cA + (size_t)(t + 1) * kstep;
            const char* a2 = last ? nA : cA + (size_t)(t + 2) * kstep; const char* b2 = last ? nB : PG8_BPTR(t + 2);
            const char* a3 = a2 + kstep; const char* b3 = last ? nB + kstep : PG8_BPTR(t + 3);
            unsigned vo2[2][2];
#pragma unroll
            for (int h = 0; h < 2; ++h)
#pragma unroll
                for (int i = 0; i < 2; ++i) vo2[h][i] = (GATHER && last) ? nvoA[h][i] : voA[h][i];
            PG8_LDB(B0, 0, 0); PG8_LDB(B1, 0, 1); PG8_SCHED; PG8_LDA(At, 0, 0); PG8_STAGEA(PG8_SA(1, 1), a1, voA, 1);
            PG8_WAIT_V(8); PG8_WAIT_L(0); PG8_BAR; PG8_MMA(0, 0, At, B0); PG8_MMA(0, 1, At, B1); PG8_BAR; PG8_SCHED;
            PG8_LDA(At, 0, 1); PG8_STAGEB(PG8_SB(0, 0), b2); PG8_STAGEB(PG8_SB(0, 1), b2 + hstepB); PG8_STAGEA(PG8_SA(0, 0), a2, vo2, 0);
            PG8_WAIT_V(8); PG8_WAIT_L(0); PG8_BAR; PG8_MMA(1, 0, At, B0); PG8_MMA(1, 1, At, B1); PG8_BAR; PG8_SCHED;
            PG8_LDB(B0, 1, 0); PG8_LDB(B1, 1, 1); PG8_SCHED; PG8_LDA(At, 1, 0); PG8_STAGEA(PG8_SA(0, 1), a2, vo2, 1);
            PG8_WAIT_V(8); PG8_WAIT_L(0); PG8_BAR; PG8_MMA(0, 0, At, B0); PG8_MMA(0, 1, At, B1); PG8_BAR; PG8_SCHED;
            PG8_LDA(At, 1, 1); PG8_STAGEB(PG8_SB(1, 0), b3); PG8_STAGEB(PG8_SB(1, 1), b3 + hstepB); PG8_STAGEA(PG8_SA(1, 0), a3, vo2, 0);
            PG8_WAIT_V(8); PG8_WAIT_L(0); PG8_BAR; PG8_MMA(1, 0, At, B0); PG8_MMA(1, 1, At, B1); PG8_BAR; PG8_SCHED;
        }
        if constexpr (ALIGN_EPI) { if (wr == 0) PG8_BAR; }
        E(acc, cur, wr, wc, fr, fq);
        if (!has_next) break;
#pragma unroll
        for (int a = 0; a < 2; ++a)
#pragma unroll
            for (int b = 0; b < 2; ++b)
#pragma unroll
                for (int m = 0; m < 4; ++m)
#pragma unroll
                    for (int n = 0; n < 2; ++n) acc[a][b][m][n] = (f32x4){0.f, 0.f, 0.f, 0.f};
        cur = nxt; cA = nA; cB = nB; cB2 = nxt.B2; ++ui;
        if constexpr (GATHER) {
#pragma unroll
            for (int h = 0; h < 2; ++h)
#pragma unroll
                for (int i = 0; i < 2; ++i) voA[h][i] = nvoA[h][i];
        }
        if constexpr (ALIGN_EPI) { if (wr == 1) PG8_BAR; }
    }
    PG8_WAIT_V(0);
    if constexpr (!ALIGN_EPI) { if (wr == 0) PG8_BAR; }
    PG8_BAR;
#undef PG8_SA
#undef PG8_SB
#undef PG8_STAGEA
#undef PG8_STAGEB
#undef PG8_LDA
#undef PG8_LDB
#undef PG8_MMA
#undef PG8_WAIT_V
#undef PG8_WAIT_L
#undef PG8_BAR
#undef PG8_SCHED
#undef PG8_BPTR
}
}
namespace pg {
template <bool BIAS_ROW> struct EpiBf16 {
    static constexpr bool PERM = true;
    bf16* O; int ldc; const float* bias;
    __device__ __forceinline__ void operator()(const f32x4 (&acc)[2][2][4][2], const Unit& u, int wr, int wc, int fr, int fq) const {
        const int row0 = u.pm * BM + wr * 64 + fr; const int col0 = u.pn * BM + wc * 32 + 8 * fq;
        f32x4 bv[2][2];
#pragma unroll
        for (int bj = 0; bj < 2; ++bj)
#pragma unroll
            for (int n = 0; n < 2; ++n) bv[bj][n] = (bias && !BIAS_ROW) ? *(const f32x4*)(bias + col0 + bj * HALF + 4 * n) : (f32x4){0.f, 0.f, 0.f, 0.f};
#pragma unroll
        for (int ai = 0; ai < 2; ++ai)
#pragma unroll
            for (int m = 0; m < 4; ++m) { const int row = row0 + ai * HALF + m * 16; bf16* rowp = O + (size_t)row * ldc + col0;
                float br = 0.f; if (BIAS_ROW && bias) br = bias[row];
#pragma unroll
                for (int bj = 0; bj < 2; ++bj) { f32x4 v0 = acc[ai][bj][m][0] + bv[bj][0] + br, v1 = acc[ai][bj][m][1] + bv[bj][1] + br;
                    u32x4 w; w.x = cvt_pk_bf16(v0[0], v0[1]); w.y = cvt_pk_bf16(v0[2], v0[3]); w.z = cvt_pk_bf16(v1[0], v1[1]); w.w = cvt_pk_bf16(v1[2], v1[3]);
                    *(u32x4*)(rowp + bj * HALF) = w; } }
    }
};
struct EpiQKV {
    static constexpr bool PERM = false;
    bf16 *Q, *Kb, *Vb; const float* bias; const float* ropeC; const float* ropeS;
    __device__ __forceinline__ void operator()(const f32x4 (&acc)[2][2][4][2], const Unit& u, int wr, int wc, int fr, int fq) const {
        const int row0 = u.pm * BM + wr * 64 + fr; const int colt = u.pn * BM + wc * 32 + 4 * fq;
        const bool isV = (u.pn == 9), isQ = (u.pn < 8);
        bf16* base; int ldc, cofs;
        if (isQ) { base = Q; ldc = DM; cofs = 0; } else if (!isV) { base = Kb; ldc = KVD; cofs = 2048; } else { base = Vb; ldc = KVD; cofs = 2304; }
        f32x4 bv[2][2];
#pragma unroll
        for (int bj = 0; bj < 2; ++bj)
#pragma unroll
            for (int n = 0; n < 2; ++n) bv[bj][n] = *(const f32x4*)(bias + colt + bj * HALF + 16 * n);
        const float sc = isQ ? QSCALE : 1.f; const int half = wc & 1;
#pragma unroll
        for (int ai = 0; ai < 2; ++ai)
#pragma unroll
            for (int m = 0; m < 4; ++m) { const int row = row0 + ai * HALF + m * 16; const int t = row & (SEQ - 1); const int pos = half ? (t & (GRIDW - 1)) : (t >> 6);
                f32x4 cs = (f32x4){1.f, 1.f, 1.f, 1.f}, sn = (f32x4){0.f, 0.f, 0.f, 0.f};
                if (!isV) { cs = *(const f32x4*)(ropeC + pos * 16 + 4 * fq); sn = *(const f32x4*)(ropeS + pos * 16 + 4 * fq); }
                bf16* rowp = base + (size_t)row * ldc + (colt - cofs);
#pragma unroll
                for (int bj = 0; bj < 2; ++bj) { const f32x4 x1 = acc[ai][bj][m][0] + bv[bj][0], x2 = acc[ai][bj][m][1] + bv[bj][1];
                    const f32x4 o1 = (x1 * cs - x2 * sn) * sc, o2 = (x2 * cs + x1 * sn) * sc;
                    u32x2 w1, w2; w1.x = cvt_pk_bf16(o1[0], o1[1]); w1.y = cvt_pk_bf16(o1[2], o1[3]); w2.x = cvt_pk_bf16(o2[0], o2[1]); w2.y = cvt_pk_bf16(o2[2], o2[3]);
                    *(u32x2*)(rowp + bj * HALF) = w1; *(u32x2*)(rowp + bj * HALF + 16) = w2; } }
    }
};
struct EpiMoe1 {
    static constexpr bool PERM = true;
    bf16* hid; const float* gates;
    __device__ __forceinline__ void operator()(const f32x4 (&acc)[2][2][4][2], const Unit& u, int wr, int wc, int fr, int fq) const {
        const int lr0 = wr * 64 + fr; const int col0 = u.pn * HALF + wc * 32 + 8 * fq; const int gsel = (u.pn >= 8) ? 1 : 0;
#pragma unroll
        for (int ai = 0; ai < 2; ++ai)
#pragma unroll
            for (int m = 0; m < 4; ++m) { const int lr = lr0 + ai * HALF + m * 16;
                if (lr < u.nrows) { const float g = gates[(size_t)(u.lbase + lr) * 2 + gsel];
                    float o[8];
#pragma unroll
                    for (int n = 0; n < 2; ++n)
#pragma unroll
                        for (int i = 0; i < 4; ++i) { const float a = acc[ai][0][m][n][i], b = acc[ai][1][m][n][i];
                            const float sg = __builtin_amdgcn_rcpf(1.f + __builtin_amdgcn_exp2f(-1.4426950408889634f * a)); o[n * 4 + i] = a * sg * b * g; }
                    u32x4 w; w.x = cvt_pk_bf16(o[0], o[1]); w.y = cvt_pk_bf16(o[2], o[3]); w.z = cvt_pk_bf16(o[4], o[5]); w.w = cvt_pk_bf16(o[6], o[7]);
                    *(u32x4*)(hid + (size_t)(u.row0 + lr) * DM + col0) = w; } }
    }
};
struct EpiMoe2 {
    static constexpr bool PERM = true;
    bf16* Y; const int* toks;
    __device__ __forceinline__ void operator()(const f32x4 (&acc)[2][2][4][2], const Unit& u, int wr, int wc, int fr, int fq) const {
        const int lr0 = wr * 64 + fr; const int col0 = u.pn * BM + wc * 32 + 8 * fq;
#pragma unroll
        for (int ai = 0; ai < 2; ++ai)
#pragma unroll
            for (int m = 0; m < 4; ++m) { const int lr = lr0 + ai * HALF + m * 16;
                if (lr < u.nrows) { const int tok = toks[u.lbase + lr]; bf16* rowp = Y + (size_t)tok * DM + col0;
#pragma unroll
                    for (int bj = 0; bj < 2; ++bj) { const f32x4 v0 = acc[ai][bj][m][0], v1 = acc[ai][bj][m][1];
                        u32x4 w; w.x = cvt_pk_bf16(v0[0], v0[1]); w.y = cvt_pk_bf16(v0[2], v0[3]); w.z = cvt_pk_bf16(v1[0], v1[1]); w.w = cvt_pk_bf16(v1[2], v1[3]);
                        *(u32x4*)(rowp + bj * HALF) = w; } } }
    }
};
struct MoeSched {
    const LAS int* tab;
    const char* Abase; const char* W; const int* toks; int G, c, NPN, second;
    __device__ __forceinline__ bool next(int i, Unit& u) const {
        const int TM = __builtin_amdgcn_readfirstlane(tab[24]);
        if (!static_map(i, G, c, TM, NPN, u.pm, u.pn)) return false;
        int cls = 0;
        for (int k = 1; k < NCLS; ++k) { const int s = __builtin_amdgcn_readfirstlane(tab[k]); if (u.pm >= s) cls = k; }
        const int ts = __builtin_amdgcn_readfirstlane(tab[cls]), cnt = __builtin_amdgcn_readfirstlane(tab[32 + cls]);
        const int ti = u.pm - ts; u.cls = cls; u.row0 = u.pm * BM; u.nrows = (cnt - ti * BM) < BM ? (cnt - ti * BM) : BM; u.lbase = cls * LCAP + ti * BM;
        const int g = cls / 6, p = cls % 6; const int lo = (p < 3) ? 0 : (p < 5 ? 1 : 2), hi = (p < 3) ? p + 1 : (p < 5 ? p - 1 : 3);
        const int elo = g * 4 + lo, ehi = g * 4 + hi;
        if (!second) { const int e = (u.pn < 8) ? elo : ehi; u.A = Abase; u.B = W + ((size_t)e * 2048 + (size_t)(u.pn & 7) * 256) * 2048 * 2; u.B2 = u.B; }
        else { u.A = Abase + (size_t)u.row0 * DM * 2; u.B = W + ((size_t)elo * 2048 + (size_t)u.pn * 256) * 1024 * 2; u.B2 = W + ((size_t)ehi * 2048 + (size_t)u.pn * 256) * 1024 * 2; }
        return true;
    }
    __device__ __forceinline__ unsigned row_off(const Unit& u, int r, int ldA) const {
        const int rr = r < u.nrows ? r : u.nrows - 1; const int tok = toks[u.lbase + rr]; return (unsigned)tok * (unsigned)ldA * 2u;
    }
};
}
struct Args { const float* in[34]; float* out; unsigned char* ws; int ph_lo, ph_hi; };
struct Frame {
    LAS unsigned char* lds;
    gu32* ctl; unsigned char* ws;
    int tid, lane, wave, G, bid;
    const Args* a; float* out;
};
#define AIN(i) (F.a->in[i])
enum { I_X = 0, I_C, I_CTX, I_CCTX, I_ADAW, I_ADAB, I_AWIN, I_ABIN, I_SINK, I_AWOUT, I_HWIN, I_HBIN, I_HCW, I_HCB, I_FW1, I_FB1, I_FW2, I_FB2, I_FW3, I_FB3, I_FFREQ, I_FW4, I_FBIAS, I_HWOUT, I_HBOUT,
       I_LN1G, I_LN1B, I_LN2G, I_LN2B, I_RW, I_RB, I_W1, I_W3, I_W2 };
#ifndef TPSEL
#define TPSEL -1
#endif
#define TPS_W ((LAS unsigned long long*)(F.lds + RING_BYTES + 320 + 96))
#define TPS_START(id) do { if (TPSEL == (id) && blockIdx.x == 0 && threadIdx.x == 0) TPS_W[1] = __builtin_amdgcn_s_memrealtime(); } while (0)
#define TPS_STOP(id) do { if (TPSEL == (id) && blockIdx.x == 0 && threadIdx.x == 0) TPS_W[0] += __builtin_amdgcn_s_memrealtime() - TPS_W[1]; } while (0)
__device__ __forceinline__ int fresh_tid(int wave) { int l_; asm volatile("v_mbcnt_lo_u32_b32 %0, -1, 0\n\tv_mbcnt_hi_u32_b32 %0, -1, %0" : "=&v"(l_)); return wave * 64 + l_; }
__device__ __forceinline__ float* mod_ptr(const Frame& F, int layer, int vec, int chunk) { return (float*)(F.ws + WS_MOD) + ((size_t)(layer * 3 + vec) * 6 + chunk) * DM; }

__device__ __forceinline__ float hy_ftab_value(int f, int l, int jj);
__device__ constexpr int hy_ftab_elems() { return 28 * 64 * 8; }
__device__ __forceinline__ void p0_transpose_item(const float* W, int ldw, bf16* WT, int ldt, int dst_row, int k0, int n0, LAS float* scr, int lane) {
#pragma unroll
    for (int i = 0; i < 32; ++i) { const int kk = 2 * i + (lane >> 5); scr[kk * 33 + (lane & 31)] = W[(size_t)(k0 + kk) * ldw + n0 + (lane & 31)]; }
    LDS_WAIT(); asm volatile("" ::: "memory");
    const int c = lane & 7;
#pragma unroll
    for (int j = 0; j < 4; ++j) { const int n = (lane >> 3) + 8 * j; const LAS float* s = scr + (8 * c) * 33 + n;
        u32x4 o; o.x = cvt_pk_bf16(s[0 * 33], s[1 * 33]); o.y = cvt_pk_bf16(s[2 * 33], s[3 * 33]); o.z = cvt_pk_bf16(s[4 * 33], s[5 * 33]); o.w = cvt_pk_bf16(s[6 * 33], s[7 * 33]);
        *(GAS u32x4*)(WT + (size_t)(dst_row + n) * ldt + k0 + 8 * c) = o; }
    LDS_WAIT(); asm volatile("" ::: "memory");
}
struct ConvItem { const float* W; bf16* WT; int ldw, ldt, dst_row, k0, n0; };
__device__ __forceinline__ ConvItem moe_l1_item(const Frame& F, int it) {
    ConvItem c; const int mat = it >> 10, sub = it & 1023, which = mat >> 4, le = 16 + (mat & 15);
    if (which < 2) { c.n0 = (sub & 31) * 32; c.k0 = (sub >> 5) * 64; c.W = (which == 0 ? AIN(I_W1) : AIN(I_W3)) + (size_t)le * DM * EFF; c.ldw = EFF; c.WT = (bf16*)(F.ws + WS_W13) + (size_t)le * 2048 * 2048; c.ldt = DM; c.dst_row = (c.n0 >> 7) * 256 + which * 128 + (c.n0 & 127); }
    else { c.n0 = (sub & 63) * 32; c.k0 = (sub >> 6) * 64; c.W = AIN(I_W2) + (size_t)le * EFF * DM; c.ldw = DM; c.WT = (bf16*)(F.ws + WS_W2) + (size_t)le * 2048 * 1024; c.ldt = EFF; c.dst_row = c.n0; }
    return c;
}
__device__ __forceinline__ ConvItem early_item(const Frame& F, int it) {
    ConvItem c;
    if (it < 48 * 1024) { const int mat = it >> 10, sub = it & 1023, which = mat >> 4, le = mat & 15;
        if (which < 2) { c.n0 = (sub & 31) * 32; c.k0 = (sub >> 5) * 64; c.W = (which == 0 ? AIN(I_W1) : AIN(I_W3)) + (size_t)le * DM * EFF; c.ldw = EFF; c.WT = (bf16*)(F.ws + WS_W13) + (size_t)le * 2048 * 2048; c.ldt = DM; c.dst_row = (c.n0 >> 7) * 256 + which * 128 + (c.n0 & 127); }
        else { c.n0 = (sub & 63) * 32; c.k0 = (sub >> 6) * 64; c.W = AIN(I_W2) + (size_t)le * EFF * DM; c.ldw = DM; c.WT = (bf16*)(F.ws + WS_W2) + (size_t)le * 2048 * 1024; c.ldt = EFF; c.dst_row = c.n0; }
    } else { int r = it - 48 * 1024;
        if (r < 32 * 192) { c.n0 = (r % 192) * 32; c.k0 = (r / 192) * 64; c.W = AIN(I_HWIN); c.ldw = 3 * DM; c.WT = (bf16*)(F.ws + WS_WHYIN); c.ldt = DM; c.dst_row = c.n0; }
        else { r -= 32 * 192; c.n0 = (r % 64) * 32; c.k0 = (r / 64) * 64; c.W = AIN(I_HWOUT); c.ldw = DM; c.WT = (bf16*)(F.ws + WS_WHYO); c.ldt = DM; c.dst_row = c.n0; } }
    return c;
}
constexpr int EARLY_NIT = 48 * 1024 + 32 * 192 + 32 * 64;
__device__ __forceinline__ void conv_issue(const ConvItem& c, int lane, float (&v)[32]) {
    const float* p = c.W + (size_t)(c.k0 + (lane >> 5)) * c.ldw + c.n0 + (lane & 31); const size_t st = (size_t)2 * c.ldw;
#pragma unroll
    for (int i = 0; i < 32; ++i) { v[i] = *p; p += st; asm volatile("" : "+v"(p)); }
}
__device__ __forceinline__ void conv_finish(const ConvItem& c, int lane, const float (&v)[32]) {
    bf16* row = c.WT + (size_t)(c.dst_row + (lane & 31)) * c.ldt + c.k0 + 8 * (lane >> 5);
#pragma unroll
    for (int m = 0; m < 4; ++m) { u32x4 w;
#pragma unroll
        for (int q = 0; q < 4; ++q) { auto r = __builtin_amdgcn_permlane32_swap(__float_as_uint(v[8 * m + q]), __float_as_uint(v[8 * m + 4 + q]), false, false);
            const unsigned pk = cvt_pk_bf16(__uint_as_float(r[0]), __uint_as_float(r[1])); if (q == 0) w.x = pk; else if (q == 1) w.y = pk; else if (q == 2) w.z = pk; else w.w = pk; }
        *(GAS u32x4*)(row + 16 * m) = w; }
}
__device__ __forceinline__ void p0_prologue(Frame& F) {
    const int gw = F.bid * NWAVES + F.wave, NGW = F.G * NWAVES, gt = F.bid * NTHR + F.tid, NGT = F.G * NTHR;
#ifndef P0_REP
#define P0_REP 0
#endif
    TPS_START(20);
#pragma unroll 1
    for (int rep_a = 0; rep_a < ((P0_REP & 1) ? 2 : 1); ++rep_a) {
        LAS float* sil = (LAS float*)F.lds; LAS float* red = sil + 3 * DM;
        for (int i = F.tid; i < 3 * DM; i += NTHR) { const int v = i / DM, k = i % DM; const float cv = (v < 2) ? AIN(I_C)[v * DM + k] : AIN(I_CCTX)[k]; sil[i] = cv / (1.f + expf(-cv)); }
        __syncthreads();
        const int cl = F.tid & 7, kg = F.tid >> 3;
        for (int unit = F.bid; unit < 768; unit += F.G) {
            const int l = unit / 384, n0 = (unit % 384) * 32;
            const float* W = AIN(I_ADAW) + (size_t)l * DM * 12288 + n0 + cl * 4;
            f32x4 a0 = {0.f, 0.f, 0.f, 0.f}, a1 = a0, a2 = a0;
#pragma unroll 8
            for (int i = 0; i < 32; ++i) { const int k = kg + 64 * i; const f32x4 w = *(const f32x4*)(W + (size_t)k * 12288); a0 += w * sil[k]; a1 += w * sil[DM + k]; a2 += w * sil[2 * DM + k]; }
#pragma unroll
            for (int j = 0; j < 4; ++j) { red[(kg * 32 + cl * 4 + j) * 3 + 0] = a0[j]; red[(kg * 32 + cl * 4 + j) * 3 + 1] = a1[j]; red[(kg * 32 + cl * 4 + j) * 3 + 2] = a2[j]; }
            __syncthreads();
            if (F.tid < 96) { const int col = F.tid & 31, v = F.tid >> 5; float s = 0.f;
                for (int k = 0; k < 64; ++k) s += red[(k * 32 + col) * 3 + v];
                ((float*)(F.ws + WS_MOD))[(size_t)(l * 3 + v) * 12288 + n0 + col] = s + AIN(I_ADAB)[l * 12288 + n0 + col]; }
            __syncthreads();
        }
    }
    TPS_STOP(20); TPS_START(21);
#pragma unroll 1
    for (int rep_b = 0; rep_b < ((P0_REP & 2) ? 2 : 1); ++rep_b) {
        LAS float* scr = (LAS float*)(F.lds + F.wave * 16384);
        constexpr int I0 = 32 * 80, I1 = 32 * 64, NIT = I0 + I1 + EARLY_NIT;
        for (int it = gw; it < NIT; it += NGW) {
            int r = it;
            if (r < I0) { p0_transpose_item(AIN(I_AWIN), QKVD, (bf16*)(F.ws + WS_WQKV), DM, (r % 80) * 32, (r / 80) * 64, (r % 80) * 32, scr, F.lane); continue; } r -= I0;
            if (r < I1) { p0_transpose_item(AIN(I_AWOUT), DM, (bf16*)(F.ws + WS_WO0), DM, (r % 64) * 32, (r / 64) * 64, (r % 64) * 32, scr, F.lane); continue; } r -= I1;
            const ConvItem c = early_item(F, r); p0_transpose_item(c.W, c.ldw, c.WT, c.ldt, c.dst_row, c.k0, c.n0, scr, F.lane);
        }
    }
    TPS_STOP(21); TPS_START(22);
    {
        const int j = F.lane; const float fr = AIN(I_FFREQ)[j], b1 = AIN(I_FB1)[j], b2 = AIN(I_FB2)[j], b3 = AIN(I_FB3)[j];
        float wc1[HYEMB], wc2[HYW], wc3[HYW];
#pragma unroll
        for (int i = 0; i < HYEMB; ++i) wc1[i] = AIN(I_FW1)[i * HYW + j];
#pragma unroll
        for (int i = 0; i < HYW; ++i) { wc2[i] = AIN(I_FW2)[i * HYW + j]; wc3[i] = AIN(I_FW3)[i * HYW + j]; }
        bf16* hdn = (bf16*)(F.ws + WS_HDN);
        for (int row = gw; row < SEQ; row += NGW) {
            const float tt = (float)row / (float)(SEQ - 1); const float wv = 6.283185307179586f * (float)row / (float)SEQ;
            float zv = 0.f;
            if (j == 0) zv = tt;
            else if (j <= 32) { const int jj = (j - 1) & 15; const float f = 1e-4f + (float)jj * ((15.f - 1e-4f) / 15.f); const float a = f * wv; zv = (j <= 16) ? cosf(a) : -sinf(a); }
            float h = b1;
#pragma unroll
            for (int i = 0; i < HYEMB; ++i) h += __builtin_bit_cast(float, __builtin_amdgcn_readlane(__builtin_bit_cast(int, zv), i)) * wc1[i];
            float a1 = sinf(fr * h);
            h = b2;
#pragma unroll
            for (int i = 0; i < HYW; ++i) h += __builtin_bit_cast(float, __builtin_amdgcn_readlane(__builtin_bit_cast(int, a1), i)) * wc2[i];
            float a2 = sinf(fr * h);
            h = b3;
#pragma unroll
            for (int i = 0; i < HYW; ++i) h += __builtin_bit_cast(float, __builtin_amdgcn_readlane(__builtin_bit_cast(int, a2), i)) * wc3[i];
            const float a3 = sinf(fr * h);
            hdn[(size_t)row * 128 + j] = (bf16)(cvt_pk_bf16(a3, 0.f) & 0xffffu); hdn[(size_t)row * 128 + 64 + j] = 0;
        }
    }
    TPS_STOP(22); TPS_START(23);
    for (int i = gt; i < hy_ftab_elems(); i += NGT) ((bf16*)(F.ws + WS_FTAB))[i] = (bf16)(cvt_pk_bf16(hy_ftab_value(i >> 9, (i >> 3) & 63, i & 7), 0.f) & 0xffffu);
    for (int i = gt; i < 4096; i += NGT) { const int pos = i >> 4, dd = i & 15; const float inv = powf(10000.f, -(float)(2 * dd) / 32.f); const float a = (float)pos * inv;
        ((float*)(F.ws + WS_ROPE))[i] = cosf(a); ((float*)(F.ws + WS_ROPE))[4096 + i] = sinf(a); }
    for (int i = gt; i < 4096 * 128; i += NGT) { const int k = i >> 12, n = i & 4095;
        ((bf16*)(F.ws + WS_W4T))[(size_t)n * 128 + k] = (k < 64) ? (bf16)(cvt_pk_bf16(AIN(I_FW4)[(size_t)k * 4096 + n], 0.f) & 0xffffu) : (bf16)0; }
    TPS_STOP(23);
}

__device__ __forceinline__ void p1_prologue(Frame& F) {
    if (F.wave < 4) {
        for (int tile = F.bid * 4 + F.wave; tile < 1024; tile += F.G * 4) {
            const int r0 = (tile >> 5) * 16, n0 = (tile & 31) * 16; const int lr = F.lane & 15, kq = F.lane >> 4;
            const float* crow = AIN(I_CTX) + (size_t)(r0 + lr) * DM; const float* sh = mod_ptr(F, 0, 2, 0); const float* sc = mod_ptr(F, 0, 2, 1);
            const bf16* wrow = (const bf16*)(F.ws + WS_WQKV) + (size_t)(2048 + n0 + lr) * DM;
            f32x4 acc = {0.f, 0.f, 0.f, 0.f};
#pragma unroll 4
            for (int k0 = 0; k0 < DM; k0 += 32) { const int k = k0 + 8 * kq;
                const f32x4 x0 = *(const f32x4*)(crow + k), x1 = *(const f32x4*)(crow + k + 4), s0 = *(const f32x4*)(sc + k), s1 = *(const f32x4*)(sc + k + 4), h0 = *(const f32x4*)(sh + k), h1 = *(const f32x4*)(sh + k + 4);
                const f32x4 u0 = x0 * (s0 + 1.f) + h0, u1 = x1 * (s1 + 1.f) + h1;
                u32x4 aw; aw.x = cvt_pk_bf16(u0[0], u0[1]); aw.y = cvt_pk_bf16(u0[2], u0[3]); aw.z = cvt_pk_bf16(u1[0], u1[1]); aw.w = cvt_pk_bf16(u1[2], u1[3]);
                const bf16x8 bfrag = *(const bf16x8*)(wrow + k);
                acc = __builtin_amdgcn_mfma_f32_16x16x32_bf16(__builtin_bit_cast(bf16x8, aw), bfrag, acc, 0, 0, 0); }
            const float bb = AIN(I_ABIN)[2048 + n0 + lr]; bf16* o = (bf16*)(F.ws + WS_CTXKV);
#pragma unroll
            for (int r = 0; r < 4; ++r) o[(size_t)(r0 + 4 * kq + r) * 512 + n0 + lr] = (bf16)(cvt_pk_bf16(acc[r] + bb, 0.f) & 0xffffu);
        }
    }
    if (F.bid < 4) {
        const int l = F.bid >> 1, b = F.bid & 1; const float* sc2 = mod_ptr(F, l, b, 4); int* map = (int*)(F.ws + WS_BADMAP) + (size_t)(l * 2 + b) * DM;
        LAS int* cntl = (LAS int*)F.lds;
        int flags[4], n = 0;
#pragma unroll
        for (int i = 0; i < 4; ++i) { flags[i] = fabsf(1.f + sc2[4 * F.tid + i]) < 0.25f; n += flags[i]; }
        cntl[F.tid] = n; __syncthreads();
        if (F.tid == 0) { int a = 0; for (int t = 0; t < NTHR; ++t) { const int c = cntl[t]; cntl[t] = a; a += c; } }
        __syncthreads();
        int sl = cntl[F.tid];
#pragma unroll
        for (int i = 0; i < 4; ++i) { map[4 * F.tid + i] = (flags[i] && sl < 64) ? sl : -1; sl += flags[i]; }
        __syncthreads();
    }
    const float* x = AIN(I_X); bf16* u0 = (bf16*)(F.ws + WS_A);
    LAS int* cnt = (LAS int*)(F.lds + RING_BYTES + 64);
    const size_t NI = (size_t)MTOK * DM / 8; const size_t per = (NI + F.G - 1) / F.G; const size_t i0 = (size_t)F.bid * per; const size_t i1 = (i0 + per < NI) ? i0 + per : NI;
    const int nch = (int)((i1 - i0 + 255) / 256);
    for (;;) {
        int c = 0; if (F.lane == 0) c = __hip_atomic_fetch_add(cnt, 1, __ATOMIC_RELAXED, __HIP_MEMORY_SCOPE_WORKGROUP);
        c = __builtin_amdgcn_readfirstlane(c); if (c >= nch) break;
        f32x4 xa[4], xb[4]; size_t ee[4];
#pragma unroll
        for (int j = 0; j < 4; ++j) { const size_t i = i0 + (size_t)c * 256 + j * 64 + F.lane; ee[j] = (i < i1) ? i * 8 : (size_t)-1; if (i < i1) { xa[j] = *(const f32x4*)(x + i * 8); xb[j] = *(const f32x4*)(x + i * 8 + 4); } }
#pragma unroll
        for (int j = 0; j < 4; ++j) { if (ee[j] == (size_t)-1) continue; const size_t e = ee[j]; const int col = (int)(e & (DM - 1)); const int b = (int)(e / ((size_t)SEQ * DM));
            const float* sh = mod_ptr(F, 0, b, 0) + col; const float* sc = mod_ptr(F, 0, b, 1) + col;
            const f32x4 v0 = xa[j] * (*(const f32x4*)sc + 1.f) + *(const f32x4*)sh, v1 = xb[j] * (*(const f32x4*)(sc + 4) + 1.f) + *(const f32x4*)(sh + 4);
            u32x4 w; w.x = cvt_pk_bf16(v0[0], v0[1]); w.y = cvt_pk_bf16(v0[2], v0[3]); w.z = cvt_pk_bf16(v1[0], v1[1]); w.w = cvt_pk_bf16(v1[2], v1[3]);
            *(u32x4*)(u0 + e) = w; }
    }
}
namespace att {
constexpr int LDS_K = 0, LDS_V = 24576, LDS_WS = 49152, LDS_OST = LDS_WS + NWAVES * 64 * 4, LDS_Q = LDS_OST + NWAVES * 4096;
__device__ __forceinline__ int crow(int r, int hi) { return (r & 3) + 8 * (r >> 2) + 4 * hi; }
__device__ __forceinline__ float max3f(float a, float b, float c) { return __builtin_fmaxf(__builtin_fmaxf(a, b), c); }
__device__ __forceinline__ float rowmax(const f32x16& p0, const f32x16& p1) {
    float a = max3f(p0[0], p0[1], p1[0]), b = max3f(p0[2], p0[3], p1[1]); a = max3f(a, p1[2], p1[3]);
#pragma unroll
    for (int r = 4; r < 16; r += 4) { a = max3f(a, p0[r], p0[r + 1]); b = max3f(b, p0[r + 2], p0[r + 3]); a = max3f(a, p1[r], p1[r + 1]); b = max3f(b, p1[r + 2], p1[r + 3]); }
    const float m = __builtin_fmaxf(a, b);
    auto rr = __builtin_amdgcn_permlane32_swap(__float_as_uint(m), __float_as_uint(m), false, false);
    return __builtin_fmaxf(__uint_as_float(rr[0]), __uint_as_float(rr[1]));
}
__device__ __forceinline__ void qkt(f32x16& p0, f32x16& p1, const LAS unsigned char* Kslot, const bf16x8* qr, const f32x16& z, int r32, int hi) {
    const LAS unsigned char* kb = Kslot + hi * 1024 + r32 * 16;
#pragma unroll
    for (int d0 = 0; d0 < 4; ++d0) {
        const bf16x8 b0 = *(const LAS bf16x8*)(kb + d0 * 2048);
        const bf16x8 b1 = *(const LAS bf16x8*)(kb + d0 * 2048 + 512);
        if (d0 == 0) { p0 = __builtin_amdgcn_mfma_f32_32x32x16_bf16(b0, qr[0], z, 0, 0, 0); p1 = __builtin_amdgcn_mfma_f32_32x32x16_bf16(b1, qr[0], z, 0, 0, 0); }
        else { p0 = __builtin_amdgcn_mfma_f32_32x32x16_bf16(b0, qr[d0], p0, 0, 0, 0); p1 = __builtin_amdgcn_mfma_f32_32x32x16_bf16(b1, qr[d0], p1, 0, 0, 0); }
    }
}
__device__ __forceinline__ void pv(f32x16* o, int vb, bf16x8 pa0, bf16x8 pa1, bf16x8 pa2, bf16x8 pa3) {
#pragma unroll
    for (int d0 = 0; d0 < 2; ++d0) { s16x4 lo[4], hi[4];
#pragma unroll
        for (int ks = 0; ks < 4; ++ks) {
            asm volatile("ds_read_b64_tr_b16 %0,%1 offset:%c2" : "=&v"(lo[ks]) : "v"(vb), "i"(d0 * 4096 + ks * 1024) : "memory");
            asm volatile("ds_read_b64_tr_b16 %0,%1 offset:%c2" : "=&v"(hi[ks]) : "v"(vb), "i"(d0 * 4096 + ks * 1024 + 512) : "memory"); }
        asm volatile("s_waitcnt lgkmcnt(0)" ::: "memory"); __builtin_amdgcn_sched_barrier(0);
#define PK(k) (bf16x8){lo[k][0], lo[k][1], lo[k][2], lo[k][3], hi[k][0], hi[k][1], hi[k][2], hi[k][3]}
        o[d0] = __builtin_amdgcn_mfma_f32_32x32x16_bf16(pa0, PK(0), o[d0], 0, 0, 0);
        o[d0] = __builtin_amdgcn_mfma_f32_32x32x16_bf16(pa1, PK(1), o[d0], 0, 0, 0);
        o[d0] = __builtin_amdgcn_mfma_f32_32x32x16_bf16(pa2, PK(2), o[d0], 0, 0, 0);
        o[d0] = __builtin_amdgcn_mfma_f32_32x32x16_bf16(pa3, PK(3), o[d0], 0, 0, 0);
#undef PK
    }
}
__device__ __forceinline__ void attn_issue(const Frame& F, int u, int t, int slot) {
    const int lane = F.lane, wid = F.wave; LAS unsigned char* shm = F.lds;
    const int qb = u % (SEQ / 32), bk = u / (SEQ / 32), b = bk / NKV, kvh = bk % NKV; const int q0 = qb * 32;
    const bf16* Kb = (const bf16*)(F.ws + WS_B + 128 * MiB); const bf16* Vb = (const bf16*)(F.ws + WS_B + 144 * MiB); const bf16* CKV = (const bf16*)(F.ws + WS_CTXKV);
    const size_t tok0 = (size_t)b * SEQ; const bf16* ksrc; const bf16* vsrc;
    if (t < 4) { const int c0 = b * CTXL + t * 64;
        ksrc = CKV + (size_t)(c0 + lane) * 512 + kvh * HD + wid * 8;
        vsrc = CKV + (size_t)(c0 + 16 * (wid & 3) + (lane >> 2)) * 512 + 256 + kvh * HD + (wid >> 2) * 32 + (lane & 3) * 8;
    } else { const int key0 = ((q0 - 128) & ~63) + (t - 4) * 64;
        int kr = key0 + lane; kr = kr < 0 ? 0 : (kr > SEQ - 1 ? SEQ - 1 : kr);
        int vr = key0 + 16 * (wid & 3) + (lane >> 2); vr = vr < 0 ? 0 : (vr > SEQ - 1 ? SEQ - 1 : vr);
        ksrc = Kb + (tok0 + kr) * KVD + kvh * HD + wid * 8;
        vsrc = Vb + (tok0 + vr) * KVD + kvh * HD + (wid >> 2) * 32 + (lane & 3) * 8;
    }
    __builtin_amdgcn_global_load_lds((const unsigned*)ksrc, (LAS unsigned*)(shm + LDS_K + slot * 8192 + wid * 1024), 16, 0, 0);
    __builtin_amdgcn_global_load_lds((const unsigned*)vsrc, (LAS unsigned*)(shm + LDS_V + slot * 8192 + wid * 1024), 16, 0, 0);
    if (t == 0) {
        const bf16* Qw = (const bf16*)(F.ws + WS_B) + (tok0 + q0 + (lane & 31)) * DM + (kvh * 8 + wid) * HD + (lane >> 5) * 8;
#pragma unroll
        for (int d0 = 0; d0 < 4; ++d0) __builtin_amdgcn_global_load_lds((const unsigned*)(Qw + d0 * 16), (LAS unsigned*)(shm + LDS_Q + wid * 4096 + d0 * 1024), 16, 0, 0);
    }
}
__device__ __forceinline__ void attn_phase(const Frame& F) {
    const int NU = NB * NKV * (SEQ / 32); const int per = (NU + F.G - 1) / F.G;
    const int u0 = F.bid * per; const int u1 = (u0 + per < NU) ? u0 + per : NU; if (u0 >= u1) return;
    const int ntile = (u1 - u0) * 9;
    const int lane = F.lane, r32 = lane & 31, hi = lane >> 5, wid = F.wave;
    LAS unsigned char* shm = F.lds;
    bf16* O = (bf16*)(F.ws + WS_A);
    LAS float* wsf = (LAS float*)(shm + LDS_WS) + wid * 64;
    const int vb0 = (int)(uintptr_t)(shm + LDS_V) + ((lane >> 4) & 1) * 32 + (lane & 3) * 8 + (4 * hi + ((lane & 15) >> 2)) * 64;
    bf16x8 qr[4]; float mref = 0.f, l_reg = 0.f; f32x16 o[2]; o[0] = f32x16{}; o[1] = f32x16{}; f32x16 negm = f32x16{};
    attn_issue(F, u0, 0, 0);
    if (ntile > 1) attn_issue(F, u0, 1, 1);
    int u = u0, t = 0;
    for (int g = 0; g < ntile; ++g) {
        const int slot = g % 3;
        const int qb = u % (SEQ / 32), bk = u / (SEQ / 32), b = bk / NKV, kvh = bk % NKV; const int q0 = qb * 32; const int head = kvh * 8 + wid; const size_t tok0 = (size_t)b * SEQ;
        if (g + 1 < ntile) { if (t == 8) asm volatile("s_waitcnt vmcnt(6)" ::: "memory"); else asm volatile("s_waitcnt vmcnt(2)" ::: "memory"); }
        else asm volatile("s_waitcnt vmcnt(0)" ::: "memory");
        LDS_WAIT(); __builtin_amdgcn_s_barrier();
        if (g + 2 < ntile) { const int g2 = g + 2; attn_issue(F, u0 + g2 / 9, g2 % 9, g2 % 3); }
        if (t == 0) {
#pragma unroll
            for (int d0 = 0; d0 < 4; ++d0) qr[d0] = *(const LAS bf16x8*)(shm + LDS_Q + wid * 4096 + d0 * 1024 + lane * 16);
            mref = 0.f; l_reg = 0.f; o[0] = f32x16{}; o[1] = f32x16{}; negm = f32x16{}; }
        f32x16 p0, p1;
        qkt(p0, p1, shm + LDS_K + slot * 8192, qr, negm, r32, hi);
        { const int key0 = ((q0 - 128) & ~63) + (t - 4) * 64;
          if (t >= 4 && (t == 4 || t == 8 || key0 < 0 || key0 + 64 > SEQ)) { const int qpos = q0 + r32;
#pragma unroll
            for (int r = 0; r < 16; ++r) { const int k0 = key0 + crow(r, hi), k1 = k0 + 32;
                const bool v0 = (k0 >= 0) && (k0 < SEQ) && (k0 - qpos <= 128) && (qpos - k0 <= 128);
                const bool v1 = (k1 >= 0) && (k1 < SEQ) && (k1 - qpos <= 128) && (qpos - k1 <= 128);
                p0[r] = v0 ? p0[r] : -INFINITY; p1[r] = v1 ? p1[r] : -INFINITY; } } }
        const float rm = rowmax(p0, p1);
        if (__any(rm > 8.f)) {
            const float dl = __builtin_fmaxf(rm, 0.f); mref += dl;
            const float f = __builtin_amdgcn_exp2f(-dl); l_reg *= f;
#pragma unroll
            for (int r = 0; r < 16; ++r) { p0[r] -= dl; p1[r] -= dl; negm[r] = -mref; }
            if (hi == 0) wsf[r32] = f;
            LDS_WAIT();
#pragma unroll
            for (int d = 0; d < 2; ++d)
#pragma unroll
                for (int r = 0; r < 16; ++r) o[d][r] *= wsf[crow(r, hi)];
        }
        float sacc = 0.f;
#pragma unroll
        for (int r = 0; r < 16; ++r) { p0[r] = __builtin_amdgcn_exp2f(p0[r]); p1[r] = __builtin_amdgcn_exp2f(p1[r]); sacc += p0[r] + p1[r]; }
        l_reg += sacc;
        u32x4 pw0, pw1, pw2, pw3;
#define PKW(P, B) cvt_pk_bf16(P[B], P[B + 1])
        pw0 = (u32x4){PKW(p0, 0), PKW(p0, 2), PKW(p0, 4), PKW(p0, 6)}; pw1 = (u32x4){PKW(p0, 8), PKW(p0, 10), PKW(p0, 12), PKW(p0, 14)};
        pw2 = (u32x4){PKW(p1, 0), PKW(p1, 2), PKW(p1, 4), PKW(p1, 6)}; pw3 = (u32x4){PKW(p1, 8), PKW(p1, 10), PKW(p1, 12), PKW(p1, 14)};
#undef PKW
        pv(o, vb0 + slot * 8192, __builtin_bit_cast(bf16x8, pw0), __builtin_bit_cast(bf16x8, pw1), __builtin_bit_cast(bf16x8, pw2), __builtin_bit_cast(bf16x8, pw3));
        if (t == 8) {
            { auto rr = __builtin_amdgcn_permlane32_swap(__float_as_uint(l_reg), __float_as_uint(l_reg), false, false); l_reg = __uint_as_float(rr[0]) + __uint_as_float(rr[1]); }
            l_reg += __builtin_amdgcn_exp2f(AIN(I_SINK)[head] * 1.4426950408889634f - mref);
            if (hi == 0) wsf[32 + r32] = l_reg;
            LDS_WAIT();
            float rli[16];
#pragma unroll
            for (int r = 0; r < 16; ++r) rli[r] = 1.f / wsf[32 + crow(r, hi)];
            bf16* Ow = O + (tok0 + q0) * DM + head * HD;
            LAS bf16* stg = (LAS bf16*)(shm + LDS_OST) + wid * 2048;
#pragma unroll
            for (int r = 0; r < 16; ++r) { const int orow = crow(r, hi);
#pragma unroll
                for (int d0 = 0; d0 < 2; ++d0) stg[orow * 64 + d0 * 32 + r32] = (bf16)(cvt_pk_bf16(o[d0][r] * rli[r], 0.f) & 0xffffu); }
            LDS_WAIT();
#pragma unroll
            for (int i = 0; i < 4; ++i) { const int row = i * 8 + (lane >> 3), ch = lane & 7; const u32x4 v = *(const LAS u32x4*)(stg + row * 64 + ch * 8); *(u32x4*)(Ow + (size_t)row * DM + ch * 8) = v; }
        }
        if (t == 8) { t = 0; ++u; } else ++t;
    }
}
}

__device__ __forceinline__ float row16_sum(float v) {
    v += __builtin_bit_cast(float, __builtin_amdgcn_update_dpp(0, __builtin_bit_cast(int, v), 0xB1, 0xf, 0xf, true));
    v += __builtin_bit_cast(float, __builtin_amdgcn_update_dpp(0, __builtin_bit_cast(int, v), 0x4E, 0xf, 0xf, true));
    v += __builtin_bit_cast(float, __builtin_amdgcn_update_dpp(0, __builtin_bit_cast(int, v), 0x141, 0xf, 0xf, true));
    v += __builtin_bit_cast(float, __builtin_amdgcn_update_dpp(0, __builtin_bit_cast(int, v), 0x140, 0xf, 0xf, true));
    return v;
}
template <int NV> __device__ __forceinline__ void block_reduce(const float (&x)[NV], LAS float* red, LAS float* tot, int tid, int lane, int wave) {
    float y[NV / 2], z[NV / 4];
#pragma unroll
    for (int i = 0; i < NV / 2; ++i) { auto r = __builtin_amdgcn_permlane32_swap(__float_as_uint(x[i]), __float_as_uint(x[i + NV / 2]), false, false); y[i] = __uint_as_float(r[0]) + __uint_as_float(r[1]); }
#pragma unroll
    for (int i = 0; i < NV / 4; ++i) { auto r = __builtin_amdgcn_permlane16_swap(__float_as_uint(y[i]), __float_as_uint(y[i + NV / 4]), false, false); z[i] = row16_sum(__uint_as_float(r[0]) + __uint_as_float(r[1])); }
    if ((lane & 15) == 0) { const int q = lane >> 4;
#pragma unroll
        for (int i = 0; i < NV / 4; ++i) red[wave * NV + i + q * (NV / 4)] = z[i]; }
    __syncthreads();
    if (tid < NV) { float s = 0.f;
#pragma unroll
        for (int w = 0; w < NWAVES; ++w) s += red[w * NV + tid];
        tot[tid] = s; }
    __syncthreads();
}
struct LnLds { LAS float* red; LAS float* tot; LAS float* sab; LAS int* lcnt; LAS int* lbase; LAS int* lcls; LAS int* lrank; LAS float* lg; LAS float* rowtab; };
__device__ __forceinline__ LnLds ln_lds(const Frame& F) { LnLds L; L.red = (LAS float*)F.lds; L.tot = L.red + 8 * 72; L.sab = L.tot + 72; L.lcnt = (LAS int*)(L.sab + 32); L.lbase = L.lcnt + 32; L.lcls = L.lbase + 32; L.lrank = L.lcls + 256; L.lg = (LAS float*)(L.lrank + 256); L.rowtab = L.lg + 512; return L; }

template <bool HIN_F32> __device__ __forceinline__ void ln1_router_phase(const Frame& F, int layer, const void* hin_, const bf16* ymix, bf16* u2out, bf16* hout) {
    const float* hin = (const float*)hin_; const bf16* hinb = (const bf16*)hin_;
    const LnLds L = ln_lds(F);
    const int tid = F.tid, lane = F.lane, wave = F.wave, c0 = 4 * tid;
    int per = (MTOK + F.G - 1) / F.G; per = (per + 3) & ~3;
    const int rbase = F.bid * per; const int rend = (rbase + per < MTOK) ? rbase + per : MTOK; const int nrows = rend - rbase;
    if (tid < NCLS) L.lcnt[tid] = 0;
    if (nrows > 0 && nrows <= 256) {
    const int b = rbase / SEQ;
    const f32x4 g1 = *(const f32x4*)(mod_ptr(F, layer, b, 2) + c0), sh2 = *(const f32x4*)(mod_ptr(F, layer, b, 3) + c0), sc2 = *(const f32x4*)(mod_ptr(F, layer, b, 4) + c0);
    const f32x4 A0 = *(const f32x4*)(AIN(I_LN1G) + layer * DM + c0), B0 = *(const f32x4*)(AIN(I_LN1B) + layer * DM + c0);
    const f32x4 A1 = A0 * (sc2 + 1.f), B1 = B0 * (sc2 + 1.f) + sh2;
    int bslot[4]; { const int* map = (const int*)(F.ws + WS_BADMAP) + (size_t)(layer * 2 + b) * DM + c0;
#pragma unroll
      for (int i = 0; i < 4; ++i) bslot[i] = map[i]; }
    bf16* side = (bf16*)(F.ws + WS_SIDE);
    f32x4 P[4][4];
    { float sx[32];
#pragma unroll
      for (int c = 0; c < 4; ++c)
#pragma unroll
          for (int g = 0; g < 4; ++g) { const f32x4 w = *(const f32x4*)(AIN(I_RW) + (size_t)(c0 + c) * NEXP + 4 * g); P[c][g] = w * A1[c];
#pragma unroll
              for (int i = 0; i < 4; ++i) { if (c == 0) { sx[g * 4 + i] = 0.f; sx[16 + g * 4 + i] = 0.f; } sx[g * 4 + i] += w[i] * A1[c]; sx[16 + g * 4 + i] += w[i] * B1[c]; } }
      block_reduce<32>(sx, L.red, L.tot, tid, lane, wave);
      if (tid < 32) L.sab[tid] = L.tot[tid];
      __syncthreads(); }
    const float* rb = AIN(I_RB);
    f32x4 hv[4], hv2[4]; u32x2 yv[4], yv2[4];
#define LN_LOADH(dst, o) do { if (HIN_F32) dst = *(const f32x4*)(hin + (o)); else { const u32x2 hw_ = *(const u32x2*)(hinb + (o)); dst = (f32x4){bflo(hw_.x), bfhi(hw_.x), bflo(hw_.y), bfhi(hw_.y)}; } } while (0)
#pragma unroll
    for (int r = 0; r < 4; ++r) { const size_t o = (size_t)(rbase + r) * DM + c0; LN_LOADH(hv[r], o); yv[r] = *(const u32x2*)(ymix + o); }
    if (rbase + 4 < rend) {
#pragma unroll
        for (int r = 0; r < 4; ++r) { const size_t o = (size_t)(rbase + 4 + r) * DM + c0; LN_LOADH(hv2[r], o); yv2[r] = *(const u32x2*)(ymix + o); } }
    for (int row0 = rbase; row0 < rend; row0 += 4) {
        f32x4 v[4]; float x[72];
#pragma unroll
        for (int r = 0; r < 4; ++r) { const f32x4 y = {bflo(yv[r].x), bfhi(yv[r].x), bflo(yv[r].y), bfhi(yv[r].y)}; v[r] = hv[r] * DN_ALPHA + g1 * y;
            x[r * 18] = (v[r][0] + v[r][1]) + (v[r][2] + v[r][3]); x[r * 18 + 1] = (v[r][0] * v[r][0] + v[r][1] * v[r][1]) + (v[r][2] * v[r][2] + v[r][3] * v[r][3]);
#pragma unroll
            for (int g = 0; g < 4; ++g) { const f32x4 q = P[0][g] * v[r][0] + P[1][g] * v[r][1] + P[2][g] * v[r][2] + P[3][g] * v[r][3];
                x[r * 18 + 2 + 4 * g] = q[0]; x[r * 18 + 3 + 4 * g] = q[1]; x[r * 18 + 4 + 4 * g] = q[2]; x[r * 18 + 5 + 4 * g] = q[3]; } }
#pragma unroll
        for (int r = 0; r < 4; ++r) { hv[r] = hv2[r]; yv[r] = yv2[r]; }
        if (row0 + 8 < rend) {
#pragma unroll
            for (int r = 0; r < 4; ++r) { const size_t o = (size_t)(row0 + 8 + r) * DM + c0; LN_LOADH(hv2[r], o); yv2[r] = *(const u32x2*)(ymix + o); } }
        LAS float* gt = L.rowtab + ((row0 - rbase) >> 2) * 72;
        block_reduce<72>(x, L.red, gt, tid, lane, wave);
#pragma unroll
        for (int r = 0; r < 4; ++r) { const float mean = gt[r * 18] * (1.f / DM); const float var = gt[r * 18 + 1] * (1.f / DM) - mean * mean; const float rstd = 1.f / sqrtf(var + LN_EPS);
            const f32x4 vn = (v[r] - mean) * rstd; const f32x4 u = vn * A1 + B1; const size_t o = (size_t)(row0 + r) * DM + c0;
#pragma unroll
            for (int i = 0; i < 4; ++i) if (bslot[i] >= 0) side[(size_t)(row0 + r) * 64 + bslot[i]] = (bf16)(cvt_pk_bf16(vn[i] * A0[i] + B0[i], 0.f) & 0xffffu);
            u32x2 w; w.x = cvt_pk_bf16(u[0], u[1]); w.y = cvt_pk_bf16(u[2], u[3]); *(u32x2*)(u2out + o) = w; }
    }
    __syncthreads();
    if (tid < nrows) {
            const int rl = tid; const LAS float* gt = L.rowtab + (rl >> 2) * 72 + (rl & 3) * 18;
            const float mean = gt[0] * (1.f / DM); const float var = gt[1] * (1.f / DM) - mean * mean; const float rstd = 1.f / sqrtf(var + LN_EPS);
            float sg[16], sel[16];
#pragma unroll
            for (int e = 0; e < 16; ++e) { const float lgt = rstd * (gt[2 + e] - mean * L.sab[e]) + L.sab[16 + e]; const float sv = 1.f / (1.f + expf(-lgt)); sg[e] = sv; sel[e] = sv + rb[e]; }
            int gb = 0; float gbs = -INFINITY;
#pragma unroll
            for (int g = 0; g < 4; ++g) { const float a = sel[4 * g], bq = sel[4 * g + 1], c = sel[4 * g + 2], d = sel[4 * g + 3];
                const float ps = fmaxf(fmaxf(fmaxf(a + bq, a + c), fmaxf(a + d, bq + c)), fmaxf(bq + d, c + d)); if (ps > gbs) { gbs = ps; gb = g; } }
            float cs[4], cg[4];
#pragma unroll
            for (int i = 0; i < 4; ++i) { cs[i] = sel[i]; cg[i] = sg[i];
#pragma unroll
                for (int g = 1; g < 4; ++g) if (gb == g) { cs[i] = sel[4 * g + i]; cg[i] = sg[4 * g + i]; } }
            int i0 = 0; float b0 = cs[0];
#pragma unroll
            for (int i = 1; i < 4; ++i) if (cs[i] > b0) { b0 = cs[i]; i0 = i; }
            int i1 = -1; float b1 = -INFINITY;
#pragma unroll
            for (int i = 0; i < 4; ++i) if (i != i0 && cs[i] > b1) { b1 = cs[i]; i1 = i; }
            float ga = 0.f, gbv = 0.f;
#pragma unroll
            for (int i = 0; i < 4; ++i) { if (i == i0) ga = cg[i]; if (i == i1) gbv = cg[i]; }
            const float den = ga + gbv; ga /= den; gbv /= den;
            const int lo = i0 < i1 ? i0 : i1, hi = i0 < i1 ? i1 : i0; const float glo = i0 < i1 ? ga : gbv, ghi = i0 < i1 ? gbv : ga;
            const int pidx = (lo == 0) ? (hi - 1) : (lo == 1 ? hi + 1 : 5);
            const int cls = gb * 6 + pidx;
            L.lcls[rl] = cls; L.lrank[rl] = __hip_atomic_fetch_add(&L.lcnt[cls], 1, __ATOMIC_RELAXED, __HIP_MEMORY_SCOPE_WORKGROUP); L.lg[2 * rl] = glo; L.lg[2 * rl + 1] = ghi;
    }
    }
    __syncthreads();
    if (tid < NCLS) L.lbase[tid] = (int)__hip_atomic_fetch_add((unsigned*)(F.ctl + CW_CNT + (layer * NCLS + tid) * 64), (unsigned)L.lcnt[tid], RLX_AGENT);
    __syncthreads();
    if (tid < nrows && nrows <= 256) { const int cls = L.lcls[tid]; const int pos = cls * LCAP + L.lbase[cls] + L.lrank[tid];
        ((int*)(F.ws + WS_TOK))[pos] = rbase + tid; ((float*)(F.ws + WS_GATE))[(size_t)pos * 2] = L.lg[2 * tid]; ((float*)(F.ws + WS_GATE))[(size_t)pos * 2 + 1] = L.lg[2 * tid + 1]; }
}
#undef LN_LOADH
template <bool OUT_F32> __device__ __forceinline__ void ln2_phase(const Frame& F, int layer, const bf16* fio, bf16* hinb, void* hout_) {
    float* houtf = (float*)hout_; bf16* houtb = (bf16*)hout_;
    const LnLds L = ln_lds(F);
    const int tid = F.tid, lane = F.lane, wave = F.wave, c0 = 4 * tid;
    int per = (MTOK + F.G - 1) / F.G; per = (per + 3) & ~3;
    const int rbase = F.bid * per; const int rend = (rbase + per < MTOK) ? rbase + per : MTOK;
    if (rbase >= rend) return;
    const int b = rbase / SEQ;
    const f32x4 g2 = *(const f32x4*)(mod_ptr(F, layer, b, 5) + c0), sh1 = *(const f32x4*)(mod_ptr(F, 1, b, 0) + c0), sc1 = *(const f32x4*)(mod_ptr(F, 1, b, 1) + c0);
    const f32x4 A0 = *(const f32x4*)(AIN(I_LN2G) + layer * DM + c0), B0 = *(const f32x4*)(AIN(I_LN2B) + layer * DM + c0);
    const f32x4 A1 = A0 * (sc1 + 1.f), B1 = B0 * (sc1 + 1.f) + sh1;
    const f32x4 sh2 = *(const f32x4*)(mod_ptr(F, layer, b, 3) + c0), sc2p = *(const f32x4*)(mod_ptr(F, layer, b, 4) + c0) + 1.f;
    f32x4 rs2; for (int i = 0; i < 4; ++i) rs2[i] = (fabsf(sc2p[i]) > 1e-6f) ? 1.f / sc2p[i] : 0.f;
    int bslot[4]; { const int* map = (const int*)(F.ws + WS_BADMAP) + (size_t)(layer * 2 + b) * DM + c0;
#pragma unroll
      for (int i = 0; i < 4; ++i) bslot[i] = map[i]; }
    const bf16* side = (const bf16*)(F.ws + WS_SIDE);
    u32x2 hw[4], hw2[4], hw3[4]; u32x2 yv[4], yv2[4], yv3[4];
#pragma unroll
    for (int r = 0; r < 4; ++r) { const size_t o = (size_t)(rbase + r) * DM + c0; hw[r] = *(const u32x2*)(hinb + o); yv[r] = *(const u32x2*)(fio + o); }
#pragma unroll
    for (int r = 0; r < 4; ++r) { const size_t o = (size_t)(rbase + 4 + r) * DM + c0; if (rbase + 4 < rend) { hw2[r] = *(const u32x2*)(hinb + o); yv2[r] = *(const u32x2*)(fio + o); } }
#pragma unroll
    for (int r = 0; r < 4; ++r) { const size_t o = (size_t)(rbase + 8 + r) * DM + c0; if (rbase + 8 < rend) { hw3[r] = *(const u32x2*)(hinb + o); yv3[r] = *(const u32x2*)(fio + o); } }
    for (int row0 = rbase; row0 < rend; row0 += 4) {
        f32x4 v[4]; float x[8];
#pragma unroll
        for (int r = 0; r < 4; ++r) { const f32x4 y = {bflo(yv[r].x), bfhi(yv[r].x), bflo(yv[r].y), bfhi(yv[r].y)}; const f32x4 uvr = {bflo(hw[r].x), bfhi(hw[r].x), bflo(hw[r].y), bfhi(hw[r].y)}; f32x4 hvr = (uvr - sh2) * rs2;
#pragma unroll
            for (int i = 0; i < 4; ++i) if (bslot[i] >= 0) hvr[i] = bf2f(side[(size_t)(row0 + r) * 64 + bslot[i]]);
            v[r] = hvr * DN_ALPHA + g2 * y;
            x[r * 2] = (v[r][0] + v[r][1]) + (v[r][2] + v[r][3]); x[r * 2 + 1] = (v[r][0] * v[r][0] + v[r][1] * v[r][1]) + (v[r][2] * v[r][2] + v[r][3] * v[r][3]); }
#pragma unroll
        for (int r = 0; r < 4; ++r) { hw[r] = hw2[r]; yv[r] = yv2[r]; hw2[r] = hw3[r]; yv2[r] = yv3[r]; }
        if (row0 + 12 < rend) {
#pragma unroll
            for (int r = 0; r < 4; ++r) { const size_t o = (size_t)(row0 + 12 + r) * DM + c0; hw3[r] = *(const u32x2*)(hinb + o); yv3[r] = *(const u32x2*)(fio + o); } }
        block_reduce<8>(x, L.red, L.tot, tid, lane, wave);
#pragma unroll
        for (int r = 0; r < 4; ++r) { const float mean = L.tot[r * 2] * (1.f / DM); const float var = L.tot[r * 2 + 1] * (1.f / DM) - mean * mean; const float rstd = 1.f / sqrtf(var + LN_EPS);
            const f32x4 vn = (v[r] - mean) * rstd; const f32x4 hn = vn * A0 + B0; const size_t o = (size_t)(row0 + r) * DM + c0;
            if (OUT_F32) *(f32x4*)(houtf + o) = hn; else { u32x2 hw; hw.x = cvt_pk_bf16(hn[0], hn[1]); hw.y = cvt_pk_bf16(hn[2], hn[3]); *(u32x2*)(houtb + o) = hw; }
            if (layer == 0) { const f32x4 u = vn * A1 + B1; u32x2 w; w.x = cvt_pk_bf16(u[0], u[1]); w.y = cvt_pk_bf16(u[2], u[3]); *(u32x2*)(hinb + o) = w; } }
    }
}
namespace hy {
constexpr int L = SEQ;
__device__ constexpr float C32[16] = {1.000000000e+00f, 9.807852804e-01f, 9.238795325e-01f, 8.314696123e-01f, 7.071067812e-01f, 5.555702330e-01f, 3.826834324e-01f, 1.950903220e-01f,
                                      0.f, -1.950903220e-01f, -3.826834324e-01f, -5.555702330e-01f, -7.071067812e-01f, -8.314696123e-01f, -9.238795325e-01f, -9.807852804e-01f};
__device__ constexpr float S32[16] = {0.f, 1.950903220e-01f, 3.826834324e-01f, 5.555702330e-01f, 7.071067812e-01f, 8.314696123e-01f, 9.238795325e-01f, 9.807852804e-01f,
                                      1.f, 9.807852804e-01f, 9.238795325e-01f, 8.314696123e-01f, 7.071067812e-01f, 5.555702330e-01f, 3.826834324e-01f, 1.950903220e-01f};
__host__ __device__ constexpr int brev(int k, int bits) { int r = 0; for (int i = 0; i < bits; ++i) r |= ((k >> i) & 1) << (bits - 1 - i); return r; }
__device__ __forceinline__ void unit_root(float frac, bool inv, float& wr, float& wi) {
    wr = __builtin_amdgcn_cosf(frac); float s = __builtin_amdgcn_sinf(frac);
    asm volatile("s_nop 1" : "+v"(wr), "+v"(s));
    wi = inv ? s : -s;
}
constexpr int FT_F32 = 0, FT_I32 = 8, FT_I32P = 16, FT_F16 = 24, FT_I16 = 26, FT_NFRAG = 28;
__device__ __forceinline__ int crow(int r, int h) { return (r & 3) + 8 * (r >> 2) + 4 * h; }
__device__ __forceinline__ bf16x8 pack8(const float (&v)[8]) { u32x4 w; w.x = cvt_pk_bf16(v[0], v[1]); w.y = cvt_pk_bf16(v[2], v[3]); w.z = cvt_pk_bf16(v[4], v[5]); w.w = cvt_pk_bf16(v[6], v[7]); return __builtin_bit_cast(bf16x8, w); }
__device__ __forceinline__ void cmul(float& xr, float& xi, float wr, float wi) {
    float t0, t1, nr, ni;
    asm("v_mul_f32_e32 %0, %1, %2" : "=v"(t0) : "v"(xi), "v"(wi));
    asm("v_mul_f32_e32 %0, %1, %2" : "=v"(t1) : "v"(xi), "v"(wr));
    asm("v_fma_f32 %0, %1, %2, -%3" : "=v"(nr) : "v"(xr), "v"(wr), "v"(t0));
    asm("v_fma_f32 %0, %1, %2, %3" : "=v"(ni) : "v"(xr), "v"(wi), "v"(t1));
    xr = nr; xi = ni;
}
#define FRAG(f) (tab[(f) * 64 + lane])
template <bool INV> __device__ __forceinline__ void pass1(LAS f32x2* dat, const LAS bf16x8* tab, int lane, int wave) {
    asm volatile("" : "+v"(lane));
    const int h = lane >> 5, c5 = lane & 31;
    const bf16x8 a0 = FRAG((INV ? FT_I16 : FT_F16) + 0), a1 = FRAG((INV ? FT_I16 : FT_F16) + 1);
#pragma unroll 1
    for (int g = 0; g < 4; ++g) {
        const int col = 128 * wave + 32 * g + c5; const int pc = col ^ ((4 * wave + g) & 31) ^ ((2 * g + (c5 >> 4)) & 7);
        float wr, wi; unit_root((float)col * (1.f / 16384.f), INV, wr, wi);
        float w2r = wr, w2i = wi; cmul(w2r, w2i, wr, wi); float w4r = w2r, w4i = w2i; cmul(w4r, w4i, w2r, w2i); float w8r = w4r, w8i = w4i; cmul(w8r, w8i, w4r, w4i);
        float re[8], im[8];
#pragma unroll
        for (int jj = 0; jj < 8; ++jj) { const f32x2 v = dat[pc + 1024 * (8 * h + jj)]; re[jj] = v.x; im[jj] = v.y; }
        if (INV) {
            float cr = h ? w8r : 1.f, ci = h ? w8i : 0.f;
#pragma unroll
            for (int jj = 0; jj < 8; ++jj) { cmul(re[jj], im[jj], cr, ci); cmul(cr, ci, wr, wi); }
        }
        const f32x16 z = {};
        f32x16 d = __builtin_amdgcn_mfma_f32_32x32x16_bf16(a0, pack8(re), z, 0, 0, 0);
        d = __builtin_amdgcn_mfma_f32_32x32x16_bf16(a1, pack8(im), d, 0, 0, 0);
        asm volatile("s_nop 15\n\ts_nop 7" : "+v"(d));
        float cr = h ? w4r : 1.f, ci = h ? w4i : 0.f;
#pragma unroll
        for (int rr = 0; rr < 8; ++rr) { float xr = d[rr], xi = d[rr + 8];
            if (!INV) { if (rr == 4) { cr = h ? w4r : 1.f; ci = h ? w4i : 0.f; cmul(cr, ci, w8r, w8i); } cmul(xr, xi, cr, ci); cmul(cr, ci, wr, wi); }
            f32x2 o; o.x = xr; o.y = xi; dat[pc + 1024 * ((rr & 3) + 8 * (rr >> 2) + 4 * h)] = o; }
    }
}
template <bool INV> __device__ __forceinline__ void pass2(LAS f32x2* dat, const LAS bf16x8* tab, int lane, int wave) {
    asm volatile("" : "+v"(lane));
    const int h = lane >> 5, b = lane & 31, bp = b ^ (b >> 4);
    float wr, wi; unit_root((float)b * (1.f / 1024.f), INV, wr, wi);
    float w2r = wr, w2i = wi; cmul(w2r, w2i, wr, wi); float w4r = w2r, w4i = w2i; cmul(w4r, w4i, w2r, w2i); float w8r = w4r, w8i = w4i; cmul(w8r, w8i, w4r, w4i); float w16r = w8r, w16i = w8i; cmul(w16r, w16i, w8r, w8i);
#pragma unroll 1
    for (int g = 0; g < 2; ++g) {
        const int base = (2 * wave + g) * 1024;
        float re[2][8], im[2][8];
#pragma unroll
        for (int hf = 0; hf < 2; ++hf)
#pragma unroll
            for (int jj = 0; jj < 8; ++jj) { const int n = 16 * hf + 8 * h + jj; const f32x2 v = dat[base + 32 * n + (bp ^ (16 * hf + 8 * h + (jj ^ ((2 * jj) & 7))))]; re[hf][jj] = v.x; im[hf][jj] = v.y; }
        if (INV) {
            float cr = h ? w8r : 1.f, ci = h ? w8i : 0.f;
#pragma unroll
            for (int jj = 0; jj < 8; ++jj) { cmul(re[0][jj], im[0][jj], cr, ci); float dr = cr, di = ci; cmul(dr, di, w16r, w16i); cmul(re[1][jj], im[1][jj], dr, di); cmul(cr, ci, wr, wi); }
        }
        const bf16x8 b0 = pack8(re[0]), b1 = pack8(re[1]), b2 = pack8(im[0]), b3 = pack8(im[1]);
        const int fb = INV ? FT_I32 : FT_F32; const f32x16 z = {};
        f32x16 dre = __builtin_amdgcn_mfma_f32_32x32x16_bf16(FRAG(fb + 0), b0, z, 0, 0, 0); f32x16 dim = __builtin_amdgcn_mfma_f32_32x32x16_bf16(FRAG(fb + 4), b0, z, 0, 0, 0);
        dre = __builtin_amdgcn_mfma_f32_32x32x16_bf16(FRAG(fb + 1), b1, dre, 0, 0, 0); dim = __builtin_amdgcn_mfma_f32_32x32x16_bf16(FRAG(fb + 5), b1, dim, 0, 0, 0);
        dre = __builtin_amdgcn_mfma_f32_32x32x16_bf16(FRAG(fb + 2), b2, dre, 0, 0, 0); dim = __builtin_amdgcn_mfma_f32_32x32x16_bf16(FRAG(fb + 6), b2, dim, 0, 0, 0);
        dre = __builtin_amdgcn_mfma_f32_32x32x16_bf16(FRAG(fb + 3), b3, dre, 0, 0, 0); dim = __builtin_amdgcn_mfma_f32_32x32x16_bf16(FRAG(fb + 7), b3, dim, 0, 0, 0);
        asm volatile("s_nop 15\n\ts_nop 7" : "+v"(dre), "+v"(dim));
        float gr = h ? w4r : 1.f, gi = h ? w4i : 0.f;
#pragma unroll
        for (int r = 0; r < 16; ++r) { float xr = dre[r], xi = dim[r]; const int kf = (r & 3) + 8 * (r >> 2) + 4 * h;
            if (!INV) { float cr = gr, ci = gi; if ((r & 3) == 1) cmul(cr, ci, wr, wi); if ((r & 3) == 2) cmul(cr, ci, w2r, w2i); if ((r & 3) == 3) { cmul(cr, ci, w2r, w2i); cmul(cr, ci, wr, wi); }
                cmul(xr, xi, cr, ci); if ((r & 3) == 3) cmul(gr, gi, w8r, w8i); }
            f32x2 o; o.x = xr; o.y = xi; dat[base + 32 * kf + (bp ^ kf ^ (2 * (r & 3)))] = o; }
    }
}
template <bool FILTER> __device__ __forceinline__ void pass3(LAS f32x2* dat, const LAS bf16x8* tab, int lane, int wave, const int g, f32x2* Kbuf, const f32x2 (&kpre)[16]) {
    asm volatile("" : "+v"(lane));
    const int h = lane >> 5, sw = lane & 31, swp = sw ^ (2 * (sw & 3));
    {
        const int q = 64 * wave + 32 * g + sw, base = 32 * q;
        float re[2][8], im[2][8];
#pragma unroll
        for (int hf = 0; hf < 2; ++hf)
#pragma unroll
            for (int jj = 0; jj < 8; ++jj) { const int n = 16 * hf + 8 * h + jj; const f32x2 v = dat[base + (n ^ swp ^ hf)]; re[hf][jj] = v.x; im[hf][jj] = v.y; }
        const bf16x8 b0 = pack8(re[0]), b1 = pack8(re[1]), b2 = pack8(im[0]), b3 = pack8(im[1]);
        const f32x16 z = {};
        f32x16 dre = __builtin_amdgcn_mfma_f32_32x32x16_bf16(FRAG(FT_F32 + 0), b0, z, 0, 0, 0); f32x16 dim = __builtin_amdgcn_mfma_f32_32x32x16_bf16(FRAG(FT_F32 + 4), b0, z, 0, 0, 0);
        dre = __builtin_amdgcn_mfma_f32_32x32x16_bf16(FRAG(FT_F32 + 1), b1, dre, 0, 0, 0); dim = __builtin_amdgcn_mfma_f32_32x32x16_bf16(FRAG(FT_F32 + 5), b1, dim, 0, 0, 0);
        dre = __builtin_amdgcn_mfma_f32_32x32x16_bf16(FRAG(FT_F32 + 2), b2, dre, 0, 0, 0); dim = __builtin_amdgcn_mfma_f32_32x32x16_bf16(FRAG(FT_F32 + 6), b2, dim, 0, 0, 0);
        dre = __builtin_amdgcn_mfma_f32_32x32x16_bf16(FRAG(FT_F32 + 3), b3, dre, 0, 0, 0); dim = __builtin_amdgcn_mfma_f32_32x32x16_bf16(FRAG(FT_F32 + 7), b3, dim, 0, 0, 0);
        asm volatile("s_nop 15\n\ts_nop 7" : "+v"(dre), "+v"(dim));
        if (FILTER) {
#pragma unroll
            for (int r = 0; r < 16; ++r) { f32x2 o; o.x = dre[r]; o.y = dim[r]; Kbuf[((r & 3) + 8 * (r >> 2) + 4 * h) * 512 + q] = o; }
        } else {
            float yr[16], yi[16];
#pragma unroll
            for (int r = 0; r < 16; ++r) { const f32x2 kv = kpre[r]; float a_ = dre[r], b_ = dim[r]; cmul(a_, b_, kv.x, kv.y); yr[r] = a_; yi[r] = b_; }
            float t0[8], t1[8], t2[8], t3[8];
#pragma unroll
            for (int j = 0; j < 8; ++j) { t0[j] = yr[j]; t1[j] = yr[8 + j]; t2[j] = yi[j]; t3[j] = yi[8 + j]; }
            const bf16x8 c0 = pack8(t0), c1 = pack8(t1), c2 = pack8(t2), c3 = pack8(t3);
            f32x16 ere = __builtin_amdgcn_mfma_f32_32x32x16_bf16(FRAG(FT_I32P + 0), c0, z, 0, 0, 0); f32x16 eim = __builtin_amdgcn_mfma_f32_32x32x16_bf16(FRAG(FT_I32P + 4), c0, z, 0, 0, 0);
            ere = __builtin_amdgcn_mfma_f32_32x32x16_bf16(FRAG(FT_I32P + 1), c1, ere, 0, 0, 0); eim = __builtin_amdgcn_mfma_f32_32x32x16_bf16(FRAG(FT_I32P + 5), c1, eim, 0, 0, 0);
            ere = __builtin_amdgcn_mfma_f32_32x32x16_bf16(FRAG(FT_I32P + 2), c2, ere, 0, 0, 0); eim = __builtin_amdgcn_mfma_f32_32x32x16_bf16(FRAG(FT_I32P + 6), c2, eim, 0, 0, 0);
            ere = __builtin_amdgcn_mfma_f32_32x32x16_bf16(FRAG(FT_I32P + 3), c3, ere, 0, 0, 0); eim = __builtin_amdgcn_mfma_f32_32x32x16_bf16(FRAG(FT_I32P + 7), c3, eim, 0, 0, 0);
#pragma unroll
            for (int r = 0; r < 16; ++r) { f32x2 o; o.x = ere[r]; o.y = eim[r]; dat[base + ((((r & 3) + 8 * (r >> 2) + 4 * h)) ^ swp ^ (r >> 3))] = o; }
        }
    }
}
#undef FRAG
__device__ __forceinline__ float ftab_value(int f, int l, int jj) {
    const int r = l & 31, h = l >> 5;
    if (f < 24) {
        const int kind = f >> 3, rb = (f >> 2) & 1, s = f & 3; int kk, pp;
        if (kind < 2) { kk = 16 * (s & 1) + 8 * h + jj; pp = s >> 1; } else { kk = 16 * (s & 1) + 8 * (jj >> 2) + 4 * h + (jj & 3); pp = s >> 1; }
        const float th = 6.283185307179586f * (float)((r * kk) & 31) * (1.f / 32.f); const float c = cosf(th), sn = sinf(th);
        if (kind == 0) return rb == 0 ? (pp == 0 ? c : sn) : (pp == 0 ? -sn : c);
        return rb == 0 ? (pp == 0 ? c : -sn) : (pp == 0 ? sn : c);
    }
    const int inv = (f - 24) >> 1, s = (f - 24) & 1; const int part = r >> 4, kf = r & 15, n = 8 * h + jj;
    const float th = 6.283185307179586f * (float)((kf * n) & 15) * (1.f / 16.f); const float c = cosf(th), sn = sinf(th);
    if (!inv) return part == 0 ? (s == 0 ? c : sn) : (s == 0 ? -sn : c);
    return part == 0 ? (s == 0 ? c : -sn) : (s == 0 ? sn : c);
}
__device__ __forceinline__ int phys(int p) { return p ^ ((p >> 5) & 31) ^ ((p >> 4) & 7); }
__device__ __forceinline__ void unpack8(const u32x4 v, float (&f)[8]) { f[0] = bflo(v.x); f[1] = bfhi(v.x); f[2] = bflo(v.y); f[3] = bfhi(v.y); f[4] = bflo(v.z); f[5] = bfhi(v.z); f[6] = bflo(v.w); f[7] = bfhi(v.w); }
struct Raw8 { u32x4 v; unsigned l, r; };
__device__ __forceinline__ Raw8 load_raw8(const bf16* rowp, int t0) { Raw8 q; q.v = *(const u32x4*)(rowp + t0); q.l = (t0 > 0) ? (unsigned)rowp[t0 - 1] : 0u; q.r = (t0 + 8 < L) ? (unsigned)rowp[t0 + 8] : 0u; return q; }
__device__ __forceinline__ void conv8(const Raw8& q, float w0, float w1, float w2, float cb, float (&o)[8]) {
    float f[8]; unpack8(q.v, f); const float left = bf2f(q.l), right = bf2f(q.r);
#pragma unroll
    for (int e = 0; e < 8; ++e) { const float a = (e == 0) ? left : f[e - 1], c = (e == 7) ? right : f[e + 1]; o[e] = w0 * a + w1 * f[e] + w2 * c + cb; }
}
typedef const LAS float* ChanPar;
struct RawZ { Raw8 x[2], v[2]; };
__device__ __forceinline__ RawZ load_rawz(const bf16* pT, int d, int t0) { RawZ q;
#pragma unroll
    for (int bt = 0; bt < 2; ++bt) { q.x[bt] = load_raw8(pT + (size_t)(DM + d) * MTOK + bt * L, t0); q.v[bt] = load_raw8(pT + (size_t)(2 * DM + d) * MTOK + bt * L, t0); }
    return q; }
__device__ __forceinline__ void z_from_raw(const RawZ& q, ChanPar P, float (&z0)[8], float (&z1)[8]) {
#pragma unroll
    for (int bt = 0; bt < 2; ++bt) { float a[8], v[8];
        conv8(q.x[bt], P[4], P[5], P[6], P[7], a); conv8(q.v[bt], P[8], P[9], P[10], P[11], v);
#pragma unroll
        for (int e = 0; e < 8; ++e) { if (bt == 0) z0[e] = a[e] * v[e]; else z1[e] = a[e] * v[e]; } }
}
struct RawF { u32x4 hf, hb; unsigned first; };
__device__ __forceinline__ RawF load_rawf(const bf16* HT, int d, int t0) { RawF q; q.hf = *(const u32x4*)(HT + (size_t)d * L + t0); q.hb = *(const u32x4*)(HT + (size_t)(DM + d) * L + (L - t0 - 8));
    q.first = (t0 > 0) ? (unsigned)HT[(size_t)(DM + d) * L + (L - t0)] : 0u; return q; }
__device__ __forceinline__ void filt8(const RawF& q, int t0, ChanPar P, float (&k)[8], float (&kl)[8], float& l1p) {
    float hf[8], hb[8]; unpack8(q.hf, hf); unpack8(q.hb, hb);
    float s = 0.f;
#pragma unroll
    for (int e = 0; e < 8; ++e) { const float dc = __builtin_amdgcn_exp2f(-(float)(t0 + e) * P[13]); k[e] = hf[e] * dc; s += fabsf(k[e]); }
    float hbd[8];
#pragma unroll
    for (int e = 0; e < 8; ++e) { const int m = L - t0 - 8 + e; const float dc = __builtin_amdgcn_exp2f(-(float)m * P[13]); hbd[e] = hb[e] * dc; if (m >= 1) s += fabsf(hbd[e]); }
    kl[0] = (t0 > 0) ? bf2f(q.first) * __builtin_amdgcn_exp2f(-(float)(L - t0) * P[13]) : 0.f;
#pragma unroll
    for (int e = 1; e < 8; ++e) kl[e] = hbd[8 - e];
#pragma unroll
    for (int e = 0; e < 8; ++e) { k[e] *= P[14]; kl[e] *= P[14]; }
    l1p = s;
}
__device__ __forceinline__ void hyena_phase(const Frame& F) {
    LAS f32x2* dat = (LAS f32x2*)F.lds; LAS float* redu = (LAS float*)(F.lds + RING_BYTES);
    const bf16* pT = (const bf16*)(F.ws + WS_B); const bf16* HT = (const bf16*)(F.ws + WS_HT); bf16* yT = (bf16*)(F.ws + WS_A);
    const LAS bf16x8* tab = (const LAS bf16x8*)(F.lds + FTAB_OFF);
    for (int i = F.tid; i < FT_NFRAG * 64; i += NTHR) ((LAS u32x4*)(F.lds + FTAB_OFF))[i] = ((const u32x4*)(F.ws + WS_FTAB))[i];
    __syncthreads();
    f32x2* Ke = (f32x2*)(F.ws + WS_FFTS) + (size_t)F.bid * 49152; f32x2* Ko = Ke + 16384; f32x2* SeB = Ke + 32768;
    RawF rf[4];
    { const int tq = fresh_tid(F.wave); if (F.bid < DM) {
#pragma unroll
        for (int sI = 0; sI < 4; ++sI) rf[sI] = load_rawf((const bf16*)(F.ws + WS_HT), F.bid, 8 * (tq + 512 * sI)); } }
    const int cv_gw = F.bid * NWAVES + F.wave, cv_ngw = F.G * NWAVES; int cv_it = cv_gw; constexpr int CV_NIT = 48 * 1024;
    for (int d = F.bid; d < DM; d += F.G) {
        int tid = fresh_tid(F.wave);
        TPS_START(1);
        LAS float* PW = (LAS float*)(F.lds + RING_BYTES + 64); ChanPar P = PW;
        __syncthreads();
        if (tid < 12) { const int i = tid & 3, pj = tid >> 2; PW[tid] = (i < 3) ? AIN(I_HCW)[i * 3 * DM + pj * DM + d] : AIN(I_HCB)[pj * DM + d]; }
        if (tid == 12) PW[12] = AIN(I_FBIAS)[d];
        if (tid == 13) { const float mind = -4.605170185988091f / 1.5f, maxd = -4.605170185988091f / 0.3f; const float delta = fabsf(mind + (maxd - mind) * ((float)d / (float)(DM - 1)));
            PW[13] = delta * (1.f / (float)(L - 1)) * 1.4426950408889634f; PW[14] = 1.f; }
        __syncthreads();
        TPS_STOP(1); TPS_START(2);
#pragma unroll 1
        for (int odd = 0; odd < 2; ++odd) {
            asm volatile("" : "+v"(tid));
            float l1s = 0.f;
#pragma unroll
            for (int sI = 0; sI < 4; ++sI) { const int t0 = 8 * (tid + 512 * sI); float k[8], kl[8], l1p; filt8(rf[sI], t0, P, k, kl, l1p); l1s += l1p;
#pragma unroll
                for (int e = 0; e < 8; ++e) { f32x2 o; if (!odd) { o.x = k[e] + kl[e]; o.y = 0.f; } else { const float a = k[e] - kl[e]; float wr, wi; unit_root((float)(t0 + e) * (1.f / 32768.f), false, wr, wi); o.x = a * wr; o.y = a * wi; }
                    dat[phys(t0 + e)] = o; } }
            if (!odd) { l1s = wave_sum(l1s); if (F.lane == 0) redu[F.wave] = l1s; }
            __syncthreads();
            if (!odd && tid == 0) { float tot = 0.f;
#pragma unroll
                for (int w = 0; w < NWAVES; ++w) tot += redu[w];
                PW[15] = 1.f / tot; }
            pass1<false>(dat, tab, F.lane, F.wave); __syncthreads(); pass2<false>(dat, tab, F.lane, F.wave); { f32x2 kdummy[16]; pass3<true>(dat, tab, F.lane, F.wave, 0, odd ? Ko : Ke, kdummy); asm volatile("" ::: "memory"); pass3<true>(dat, tab, F.lane, F.wave, 1, odd ? Ko : Ke, kdummy); } __syncthreads();
        }
        TPS_STOP(2); TPS_START(3);
        unsigned zp[4][8];
        const bool cvb3 = (cv_it + 2 * cv_ngw < CV_NIT);
        const ConvItem ia = moe_l1_item(F, cvb3 ? cv_it : 0), ib = moe_l1_item(F, cvb3 ? cv_it + cv_ngw : 0), ic = moe_l1_item(F, cvb3 ? cv_it + 2 * cv_ngw : 0);
#pragma unroll
        for (int odd = 0; odd < 2; ++odd) {
            asm volatile("" : "+v"(tid));
            TPS_START(6);
            if (!odd) {
                RawZ rz[4];
#pragma unroll
                for (int sI = 0; sI < 4; ++sI) rz[sI] = load_rawz(pT, d, 8 * (tid + 512 * sI));
#pragma unroll
                for (int sI = 0; sI < 4; ++sI) { const int t0 = 8 * (tid + 512 * sI); float z0[8], z1[8]; z_from_raw(rz[sI], P, z0, z1);
#pragma unroll
                    for (int e = 0; e < 8; ++e) { f32x2 o; o.x = z0[e]; o.y = z1[e]; zp[sI][e] = cvt_pk_bf16(z0[e], z1[e]); dat[phys(t0 + e)] = o; } }
            } else {
#pragma unroll
                for (int sI = 0; sI < 4; ++sI) { const int t0 = 8 * (tid + 512 * sI);
#pragma unroll
                    for (int e = 0; e < 8; ++e) { const float z0 = bflo(zp[sI][e]), z1 = bfhi(zp[sI][e]); float wr, wi; unit_root((float)(t0 + e) * (1.f / 32768.f), false, wr, wi);
                        f32x2 o; o.x = z0 * wr - z1 * wi; o.y = z0 * wi + z1 * wr; dat[phys(t0 + e)] = o; } }
            }
#ifdef FFT_EXTRA
#pragma unroll 1
            for (int xr = 0; xr < FFT_EXTRA; ++xr) { __syncthreads(); pass2<false>(dat, tab, F.lane, F.wave); __syncthreads(); pass2<true>(dat, tab, F.lane, F.wave); __syncthreads();
#pragma unroll 1
                for (int i = fresh_tid(F.wave); i < L; i += NTHR) { f32x2 v = dat[i]; v.x *= (1.f / 32.f); v.y *= (1.f / 32.f); dat[i] = v; } }
            tid = fresh_tid(F.wave);
#endif
            TPS_STOP(6); TPS_START(5);
            f32x2 kpre0[16], kpre1[16];
            asm volatile("" ::: "memory");
            { const f32x2* Kb = odd ? Ko : Ke; int ln_ = F.lane; asm volatile("" : "+v"(ln_)); const int lq = ln_ & 31, lh = ln_ >> 5; const float il1 = P[15], fb = P[12];
#pragma unroll
              for (int r = 0; r < 16; ++r) { f32x2 k0 = Kb[((r & 3) + 8 * (r >> 2) + 4 * lh) * 512 + 64 * F.wave + lq], k1 = Kb[((r & 3) + 8 * (r >> 2) + 4 * lh) * 512 + 64 * F.wave + 32 + lq];
                  k0.x = k0.x * il1 + fb; k0.y *= il1; k1.x = k1.x * il1 + fb; k1.y *= il1; kpre0[r] = k0; kpre1[r] = k1; } }
            __syncthreads(); pass1<false>(dat, tab, F.lane, F.wave); __syncthreads(); pass2<false>(dat, tab, F.lane, F.wave); pass3<false>(dat, tab, F.lane, F.wave, 0, nullptr, kpre0); asm volatile("" ::: "memory"); pass3<false>(dat, tab, F.lane, F.wave, 1, nullptr, kpre1);
            TPS_STOP(5); TPS_START(7);
            if (odd) { float ca[32], cb[32], cc[32]; const int cvln = fresh_tid(F.wave) & 63;
                conv_issue(ia, cvln, ca); conv_issue(ib, cvln, cb); conv_issue(ic, cvln, cc);
                pass2<true>(dat, tab, F.lane, F.wave); __syncthreads(); pass1<true>(dat, tab, F.lane, F.wave);
                if (cvb3) { conv_finish(ia, cvln, ca); conv_finish(ib, cvln, cb); conv_finish(ic, cvln, cc); cv_it += 3 * cv_ngw; }
                __syncthreads();
            } else { pass2<true>(dat, tab, F.lane, F.wave); __syncthreads(); pass1<true>(dat, tab, F.lane, F.wave); __syncthreads(); }
            TPS_STOP(7);
            if (!odd) {
                asm volatile("" : "+v"(tid));
#pragma unroll 1
                for (int sI = 0; sI < 4; ++sI)
#pragma unroll
                    for (int e = 0; e < 8; ++e) { const f32x2 v = dat[phys(8 * (tid + 512 * sI) + e)]; SeB[e * 2048 + tid + 512 * sI] = v; }
                __syncthreads();
            }
        }
        TPS_STOP(3); TPS_START(4);
        asm volatile("" : "+v"(tid));
        if (d + F.G < DM) {
#pragma unroll
            for (int sI = 0; sI < 4; ++sI) rf[sI] = load_rawf(HT, d + F.G, 8 * (tid + 512 * sI)); }
        { Raw8 rx0[4][2]; f32x2 se[4][8];
#pragma unroll
          for (int sI = 0; sI < 4; ++sI) {
#pragma unroll
              for (int bt = 0; bt < 2; ++bt) rx0[sI][bt] = load_raw8(pT + (size_t)d * MTOK + bt * L, 8 * (tid + 512 * sI));
#pragma unroll
              for (int e = 0; e < 8; ++e) se[sI][e] = SeB[e * 2048 + tid + 512 * sI]; }
#pragma unroll
          for (int sI = 0; sI < 4; ++sI) { const int t0 = 8 * (tid + 512 * sI);
              float o0[8], o1[8];
#pragma unroll
              for (int e = 0; e < 8; ++e) { const f32x2 so = dat[phys(t0 + e)]; float wr, wi; unit_root((float)(t0 + e) * (1.f / 32768.f), true, wr, wi);
                  o0[e] = (se[sI][e].x + so.x * wr - so.y * wi) * (1.f / 32768.f); o1[e] = (se[sI][e].y + so.x * wi + so.y * wr) * (1.f / 32768.f); }
#pragma unroll
              for (int bt = 0; bt < 2; ++bt) { float xc[8]; conv8(rx0[sI][bt], P[0], P[1], P[2], P[3], xc);
                  u32x4 w;
                  if (bt == 0) { w.x = cvt_pk_bf16(xc[0] * o0[0], xc[1] * o0[1]); w.y = cvt_pk_bf16(xc[2] * o0[2], xc[3] * o0[3]); w.z = cvt_pk_bf16(xc[4] * o0[4], xc[5] * o0[5]); w.w = cvt_pk_bf16(xc[6] * o0[6], xc[7] * o0[7]); }
                  else { w.x = cvt_pk_bf16(xc[0] * o1[0], xc[1] * o1[1]); w.y = cvt_pk_bf16(xc[2] * o1[2], xc[3] * o1[3]); w.z = cvt_pk_bf16(xc[4] * o1[4], xc[5] * o1[5]); w.w = cvt_pk_bf16(xc[6] * o1[6], xc[7] * o1[7]); }
                  *(u32x4*)(yT + (size_t)d * MTOK + bt * L + t0) = w; } } }
        __syncthreads();
        TPS_STOP(4);
        if (cvb3) {
        } else {
#pragma unroll 1
            for (int q = 0; q < 3; ++q) { if (cv_it < CV_NIT) { float cva[32]; const ConvItem cvc = moe_l1_item(F, cv_it); conv_issue(cvc, fresh_tid(F.wave) & 63, cva); conv_finish(cvc, fresh_tid(F.wave) & 63, cva); cv_it += cv_ngw; } }
        }
    }
    while (cv_it < CV_NIT) { float cvb[32]; const ConvItem c = moe_l1_item(F, cv_it); conv_issue(c, F.lane, cvb); conv_finish(c, F.lane, cvb); cv_it += cv_ngw; }
}
__device__ __forceinline__ void transpose_phase(const Frame& F) {
    const bf16* yT = (const bf16*)(F.ws + WS_A); bf16* y = (bf16*)(F.ws + WS_B);
    LAS bf16* tl = (LAS bf16*)(F.lds + F.wave * 16384);
    const int gw = F.bid * NWAVES + F.wave, NGW = F.G * NWAVES, lane = F.lane;
    for (int tile = gw; tile < 32 * 512; tile += NGW) { const int d0 = (tile & 31) * 64, t0 = (tile >> 5) * 64;
#pragma unroll
        for (int i = 0; i < 8; ++i) { const int r = i * 8 + (lane >> 3), ch = lane & 7; const u32x4 v = *(const u32x4*)(yT + (size_t)(d0 + r) * MTOK + t0 + ch * 8); *(LAS u32x4*)(tl + r * 72 + ch * 8) = v; }
        LDS_WAIT();
#pragma unroll
        for (int i = 0; i < 8; ++i) { const int tr = i * 8 + (lane >> 3), ch = lane & 7; unsigned short e[8];
#pragma unroll
            for (int k = 0; k < 8; ++k) e[k] = tl[(ch * 8 + k) * 72 + tr];
            u32x4 w; w.x = e[0] | ((unsigned)e[1] << 16); w.y = e[2] | ((unsigned)e[3] << 16); w.z = e[4] | ((unsigned)e[5] << 16); w.w = e[6] | ((unsigned)e[7] << 16);
            *(u32x4*)(y + (size_t)(t0 + tr) * DM + d0 + ch * 8) = w; }
        LDS_WAIT();
    }
}
}
__device__ __forceinline__ float hy_ftab_value(int f, int l, int jj) { return hy::ftab_value(f, l, jj); }
constexpr int NPHASE = 19;

__device__ __forceinline__ void moe_table(const Frame& F, int layer, LAS int* tab) {
    if (F.tid < NCLS) tab[32 + F.tid] = (int)__hip_atomic_load((unsigned*)(F.ctl + CW_CNT + (layer * NCLS + F.tid) * 64), RLX_AGENT);
    __syncthreads();
    if (F.tid == 0) { int a = 0; for (int c = 0; c < NCLS; ++c) { tab[c] = a; a += (tab[32 + c] + 255) >> 8; } tab[24] = a; }
    __syncthreads();
}

#ifndef PROBE_MASK
#define PROBE_MASK 0u
#endif
#ifndef TPM
#define TPM 0u
#endif
#define TP_MULT 4
#define IN(k) ((ONLY < 0 || (k) == ONLY) && lo <= (k) && (k) < hi)
#define SEAM(k) do { if ((k) + 1 < hi) { XcdBarrier b_ = bar; asm volatile("" : "+s"(b_.bar), "+s"(b_.x)); xcd_barrier(b_); } if (TPM != 0u && ONLY < 0 && ((TPM >> (k)) & 1u) && F.bid == 0 && F.tid == 0) TPW[0] += __builtin_amdgcn_s_memrealtime() - TPW[1]; if (PROBE_MASK != 0u && ONLY < 0) { if (F.tid == 0) { LAS unsigned long long* tp_ = (LAS unsigned long long*)(F.lds + MISC_OFF + 64); const unsigned long long t1_ = __builtin_amdgcn_s_memrealtime(); if ((PROBE_MASK >> (k)) & 1u) tp_[0] += t1_ - tp_[1]; tp_[1] = t1_; } } } while (0)
#define TPW ((LAS unsigned long long*)(F.lds + MISC_OFF + 96))
#define ENTER() do { int l_; asm volatile("v_mbcnt_lo_u32_b32 %0, -1, 0\n\tv_mbcnt_hi_u32_b32 %0, -1, %0" : "=&v"(l_)); const int t_ = F.wave * 64 + l_; F.tid = t_; F.lane = l_; int b_ = blockIdx.x, g_ = gridDim.x; asm volatile("" : "+s"(b_), "+s"(g_)); F.bid = b_; F.G = g_; if (TPM != 0u && ONLY < 0 && b_ == 0 && t_ == 0) TPW[1] = __builtin_amdgcn_s_memrealtime(); } while (0)
template <int ONLY> __device__ __forceinline__ void layer_phases(Frame& F, const XcdBarrier& bar, const int lo, const int hi, const int layer, LAS int* tab) {
        const int pb = 3 + 8 * layer;
        if (layer == 0) {
            if (IN(pb + 0)) { ENTER();
                pg::PlainSched S; S.init(F.ws + WS_A, F.ws + WS_WQKV, MTOK, QKVD, DM, DM, F.G, F.bid);
                pg::EpiQKV E{(bf16*)(F.ws + WS_B), (bf16*)(F.ws + WS_B + 128 * MiB), (bf16*)(F.ws + WS_B + 144 * MiB), AIN(I_ABIN), (const float*)(F.ws + WS_ROPE), (const float*)(F.ws + WS_ROPE) + 4096};
                pg::gemm_phase<pg::EpiQKV, pg::PlainSched, false, false, true>(F.lds, F.tid, DM, DM, DM, S, E);
                SEAM(pb + 0);
            }
            if (IN(pb + 1)) { ENTER(); att::attn_phase(F); SEAM(pb + 1); }
        } else {
            if (IN(pb + 0)) { ENTER();
                pg::PlainSched S; S.init(F.ws + WS_WHYIN, F.ws + WS_A, 3 * DM, MTOK, DM, DM, F.G, F.bid);
                pg::EpiBf16<true> E{(bf16*)(F.ws + WS_B), MTOK, AIN(I_HBIN)};
                pg::gemm_phase<pg::EpiBf16<true>, pg::PlainSched, false, false, true>(F.lds, F.tid, DM, DM, DM, S, E);
                SEAM(pb + 0);
            }
            if (IN(pb + 1)) { ENTER(); hy::hyena_phase(F); SEAM(pb + 1); }
            if (IN(pb + 2)) { ENTER(); hy::transpose_phase(F); SEAM(pb + 2); }
        }
        if (IN(pb + 3)) { ENTER();
            const void* A = layer ? (const void*)(F.ws + WS_B) : (const void*)(F.ws + WS_A);
            const void* Bt = layer ? (const void*)(F.ws + WS_WHYO) : (const void*)(F.ws + WS_WO0);
            bf16* O = (bf16*)(F.ws + WS_B + (layer ? 128 : 192) * MiB);
            pg::PlainSched S; S.init(A, Bt, MTOK, DM, DM, DM, F.G, F.bid);
            pg::EpiBf16<false> E{O, DM, layer ? AIN(I_HBOUT) : nullptr};
            pg::gemm_phase<pg::EpiBf16<false>, pg::PlainSched, false, false, true>(F.lds, F.tid, DM, DM, DM, S, E);
            SEAM(pb + 3);
        }
        if (IN(pb + 4)) { ENTER();
            if (layer == 0) ln1_router_phase<true>(F, 0, AIN(I_X), (const bf16*)(F.ws + WS_B + 192 * MiB), (bf16*)(F.ws + WS_A), (bf16*)(F.ws + WS_B + 192 * MiB));
            else ln1_router_phase<false>(F, 1, F.out, (const bf16*)(F.ws + WS_B + 128 * MiB), (bf16*)(F.ws + WS_A), (bf16*)(F.ws + WS_B + 256 * MiB));
            SEAM(pb + 4);
        }
        if (IN(pb + 5)) { ENTER();
            moe_table(F, layer, tab);
            pg::MoeSched S{tab, (const char*)(F.ws + WS_A), (const char*)(F.ws + WS_W13 + (size_t)layer * 128 * MiB), (const int*)(F.ws + WS_TOK), F.G, F.bid, 16, 0};
            pg::EpiMoe1 E{(bf16*)(F.ws + WS_B), (const float*)(F.ws + WS_GATE)};
            pg::gemm_phase<pg::EpiMoe1, pg::MoeSched, true, false, true>(F.lds, F.tid, DM, DM, DM, S, E);
            SEAM(pb + 5);
        }
        if (IN(pb + 6)) { ENTER();
            moe_table(F, layer, tab);
            pg::MoeSched S{tab, (const char*)(F.ws + WS_B), (const char*)(F.ws + WS_W2 + (size_t)layer * 64 * MiB), (const int*)(F.ws + WS_TOK), F.G, F.bid, 8, 1};
            pg::EpiMoe2 E{(bf16*)(F.ws + WS_B + (layer ? 256 : 192) * MiB), (const int*)(F.ws + WS_TOK)};
            pg::gemm_phase<pg::EpiMoe2, pg::MoeSched, false, true, true>(F.lds, F.tid, DM, DM, EFF, S, E);
            SEAM(pb + 6);
        }
        if (IN(pb + 7)) { ENTER();
            if (layer == 0) ln2_phase<false>(F, 0, (const bf16*)(F.ws + WS_B + 192 * MiB), (bf16*)(F.ws + WS_A), F.out);
            else ln2_phase<true>(F, 1, (const bf16*)(F.ws + WS_B + 256 * MiB), (bf16*)(F.ws + WS_A), F.out);
            SEAM(pb + 7); }
}
template <int ONLY> __global__ void __launch_bounds__(NTHR, 2) fwd_kernel(Args args) {
    extern __shared__ __attribute__((aligned(16))) unsigned char lds_raw[];
    Frame F;
    F.lds = (LAS unsigned char*)lds_raw;
    F.tid = threadIdx.x; F.lane = F.tid & 63; F.wave = __builtin_amdgcn_readfirstlane(F.tid >> 6);
    F.G = gridDim.x; F.bid = blockIdx.x; F.ws = args.ws; F.ctl = (gu32*)(args.ws + WS_CTL); F.out = args.out;
    F.a = &args;
    for (int u = F.tid; u < (LDS_BYTES - RING_BYTES) / 4; u += NTHR) ((LAS unsigned*)(F.lds + RING_BYTES))[u] = 0u;
    __syncthreads();
    const int lo = args.ph_lo, hi = args.ph_hi;
    if (PROBE_MASK != 0u && ONLY >= 0) { if (F.bid == 0 && F.tid == 0) ((unsigned long long*)(F.ws + 512 * 1024))[ONLY] = __builtin_amdgcn_s_memrealtime(); }
    if (PROBE_MASK != 0u && ONLY < 0) { if (F.tid == 0) { LAS unsigned long long* tp_ = (LAS unsigned long long*)(F.lds + MISC_OFF + 64); tp_[0] = 0; tp_[1] = __builtin_amdgcn_s_memrealtime(); } }
    XcdBarrier bar; bar.bar = (unsigned*)(F.ctl + CW_BAR); bar.x = 0; bar.st = nullptr;
    if (ONLY < 0 && hi - lo > 1) bar = xcd_barrier_post((unsigned*)(F.ctl + CW_BAR), (volatile LAS unsigned*)(F.lds + MISC_OFF));
    LAS int* tab = (LAS int*)(F.lds + RING_BYTES + 64);

    if (IN(0)) { ENTER(); p0_prologue(F); SEAM(0); }
    if (IN(1)) { ENTER(); p1_prologue(F); if (TPM != 0u && ONLY < 0 && ((TPM >> 1) & 1u) && F.bid == 0 && F.tid == 0) TPW[0] += __builtin_amdgcn_s_memrealtime() - TPW[1]; }
    if (IN(2)) { ENTER();
        pg::PlainSched S; S.init(F.ws + WS_W4T, F.ws + WS_HDN, 4096, SEQ, 128, 128, F.G, F.bid);
        pg::EpiBf16<true> E{(bf16*)(F.ws + WS_HT), SEQ, nullptr};
        int kf = 128; asm volatile("" : "+s"(kf));
        pg::gemm_phase<pg::EpiBf16<true>, pg::PlainSched, false, false, true>(F.lds, F.tid, kf, 128, 128, S, E);
        SEAM(2);
    }
    if constexpr (ONLY >= 0) { if (ONLY >= 3 && ONLY < 11) layer_phases<ONLY>(F, bar, lo, hi, 0, tab); if (ONLY >= 11) layer_phases<ONLY>(F, bar, lo, hi, 1, tab); }
    else {
#pragma unroll 1
        for (int layer = 0; layer < 2; ++layer) layer_phases<ONLY>(F, bar, lo, hi, layer, tab);
    }
    if (PROBE_MASK != 0u && ONLY == NPHASE - 1) { __syncthreads(); if (F.bid == 0 && F.tid == 0) { const unsigned long long* ts = (const unsigned long long*)(F.ws + 512 * 1024); unsigned long long acc = 0, tend = __builtin_amdgcn_s_memrealtime();
        for (int k = 0; k < NPHASE; ++k) if (((PROBE_MASK >> k) & 1u) && k != 5) { int kn = k + 1; if (kn == 5) kn = 6; acc += ((kn < NPHASE) ? ts[kn] : tend) - ts[k]; }
        F.out[0] = 0.1f * (float)acc; } }
    if ((TPM != 0u || TPSEL >= 0) && ONLY < 0) { if (blockIdx.x == 0 && threadIdx.x == 0) { const unsigned long long acc = TPW[0] * TP_MULT, t0 = __builtin_amdgcn_s_memrealtime(); while (__builtin_amdgcn_s_memrealtime() - t0 < acc) __builtin_amdgcn_s_sleep(8); } }
    if (PROBE_MASK != 0u && ONLY < 0) { __syncthreads(); if (F.bid == 0 && F.tid == 0) F.out[0] = 0.1f * (float)((LAS unsigned long long*)(F.lds + MISC_OFF + 64))[0]; }
}
#undef IN
#undef SEAM

extern "C" void kernel_launch(void* const* d_in, const int* in_sizes, int n_in, void* d_out, int out_size, void* d_ws, size_t ws_size, hipStream_t stream) {
    static int grid = 0;
    if (grid == 0) {
        if (n_in != 34 || in_sizes[0] != MTOK * DM || out_size != MTOK * DM || ws_size < WS_END) { fprintf(stderr, "kernel_launch: unexpected shapes / workspace (n_in %d, ws %zu, need %zu)\n", n_in, ws_size, (size_t)WS_END); grid = -1; return; }
        int dev = 0, cus = 0;
        if (hipGetDevice(&dev) != hipSuccess || hipDeviceGetAttribute(&cus, hipDeviceAttributeMultiprocessorCount, dev) != hipSuccess) { grid = -1; return; }
#if !MK_SPLIT
        if (hipFuncSetAttribute((const void*)fwd_kernel<-1>, hipFuncAttributeMaxDynamicSharedMemorySize, LDS_BYTES) != hipSuccess) { fprintf(stderr, "kernel_launch: hipFuncSetAttribute failed\n"); grid = -1; return; }
        int per_cu = 0;
        if (hipOccupancyMaxActiveBlocksPerMultiprocessor(&per_cu, (const void*)fwd_kernel<-1>, NTHR, LDS_BYTES) != hipSuccess || per_cu < 1) fprintf(stderr, "kernel_launch: occupancy query reports %d blocks per CU\n", per_cu);
        (void)hipGetLastError();
#endif
        grid = cus;
    }
    if (grid < 0) return;
    (void)hipMemsetAsync((char*)d_ws + WS_CTL, 0, CTL_ZERO_BYTES, stream);
    Args a{};
    for (int i = 0; i < 34; ++i) a.in[i] = (const float*)d_in[i];
    a.out = (float*)d_out; a.ws = (unsigned char*)d_ws;
#if MK_SPLIT
    typedef void (*kfn)(Args);
    static const kfn fns[NPHASE] = {fwd_kernel<0>, fwd_kernel<1>, fwd_kernel<2>, fwd_kernel<3>, fwd_kernel<4>, nullptr, fwd_kernel<6>, fwd_kernel<7>, fwd_kernel<8>, fwd_kernel<9>, fwd_kernel<10>,
                                      fwd_kernel<11>, fwd_kernel<12>, fwd_kernel<13>, fwd_kernel<14>, fwd_kernel<15>, fwd_kernel<16>, fwd_kernel<17>, fwd_kernel<18>};
    static bool attr_done = false;
    if (!attr_done) { for (int ph = 0; ph < NPHASE; ++ph) if (fns[ph]) (void)hipFuncSetAttribute((const void*)fns[ph], hipFuncAttributeMaxDynamicSharedMemorySize, LDS_BYTES); attr_done = true; }
#ifndef REPEAT_MASK
#define REPEAT_MASK 0u
#endif
    for (int ph = 0; ph < NPHASE; ++ph) { if (!fns[ph]) continue; a.ph_lo = ph; a.ph_hi = ph + 1;
        for (int rep = 0; rep < (((REPEAT_MASK >> ph) & 1u) ? 2 : 1); ++rep) {
            if (rep == 1 && ph == 15) (void)hipMemsetAsync((char*)d_ws + WS_CTL + (size_t)(CW_CNT + NCLS * 64) * 4, 0, NCLS * 64 * 4, stream);
            hipLaunchKernelGGL(fns[ph], dim3(grid), dim3(NTHR), LDS_BYTES, stream, a); } }
#else
    a.ph_lo = 0; a.ph_hi = NPHASE; hipLaunchKernelGGL(fwd_kernel<-1>, dim3(grid), dim3(NTHR), LDS_BYTES, stream, a);
#endif
}
```

```cpp
#include <hip/hip_runtime.h>
#include <hip/hip_bf16.h>
#include <cstdio>
#include <cstdint>

#ifndef MK_SPLIT
#define MK_SPLIT 0
#endif

#define GAS __attribute__((address_space(1)))
#define LAS __attribute__((address_space(3)))
typedef unsigned short bf16;
typedef unsigned u32x4 __attribute__((ext_vector_type(4)));
typedef unsigned u32x2 __attribute__((ext_vector_type(2)));
typedef float f32x2 __attribute__((ext_vector_type(2)));
typedef float f32x4 __attribute__((ext_vector_type(4)));
typedef float f32x16 __attribute__((ext_vector_type(16)));
typedef short bf16x8 __attribute__((ext_vector_type(8)));
typedef short s16x4 __attribute__((ext_vector_type(4)));
typedef GAS unsigned gu32;

constexpr int DM = 2048, NB = 2, SEQ = 16384, MTOK = NB * SEQ, CTXL = 256, GRIDW = 64;
constexpr int NHEAD = 32, NKV = 4, HD = 64, QKVD = 2560, KVD = 256;
constexpr int NEXP = 16, EFF = 1024, NCLS = 24, LCAP = 32768;
constexpr int HYW = 64, HYEMB = 33;
constexpr float LN_EPS = 1e-5f;
constexpr float DN_ALPHA = 1.41421356237309515f;
constexpr float QSCALE = 0.125f * 1.4426950408889634f;
constexpr int NWAVES = 8, NTHR = 512;

constexpr size_t MiB = 1u << 20;
constexpr size_t WS_CTL = 0, CTL_ZERO_BYTES = 1 * MiB;
constexpr size_t WS_MOD = 1 * MiB;
constexpr size_t WS_ROPE = 1 * MiB + 512 * 1024;
constexpr size_t WS_FTAB = 1 * MiB + 768 * 1024;
constexpr size_t WS_CTXKV = 2 * MiB;
constexpr size_t WS_HDN = 3 * MiB;
constexpr size_t WS_W4T = 7 * MiB;
constexpr size_t WS_TOK = 8 * MiB;
constexpr size_t WS_GATE = 11 * MiB;
constexpr size_t WS_BADMAP = 1 * MiB + 384 * 1024;
constexpr size_t WS_SIDE = 20 * MiB;
constexpr size_t WS_FFTS = 32 * MiB;
constexpr size_t WS_HT = 128 * MiB;
constexpr size_t WS_WQKV = 256 * MiB;
constexpr size_t WS_WO0 = 266 * MiB;
constexpr size_t WS_WHYIN = 274 * MiB;
constexpr size_t WS_WHYO = 298 * MiB;
constexpr size_t WS_W13 = 320 * MiB;
constexpr size_t WS_W2 = 576 * MiB;
constexpr size_t WS_A = 704 * MiB;
constexpr size_t WS_B = 832 * MiB;
constexpr size_t WS_END = 1216 * MiB;
constexpr int HID_ROWS = 38912;

constexpr int CW_TMO = 0;
constexpr int CW_BAR = 4096;
constexpr int CW_CNT = 16384;

constexpr int RING_BYTES = 131072;
constexpr int MISC_OFF = RING_BYTES + 320;
constexpr int FTAB_OFF = RING_BYTES + 1024;
constexpr int LDS_BYTES = 163840;

#define RLX_AGENT __ATOMIC_RELAXED, __HIP_MEMORY_SCOPE_AGENT
#define LDS_WAIT() asm volatile("s_waitcnt lgkmcnt(0)" ::: "memory")
#define VM_WAIT() asm volatile("s_waitcnt vmcnt(0)" ::: "memory")

__device__ __forceinline__ unsigned cvt_pk_bf16(float lo, float hi) { unsigned r; asm volatile("v_cvt_pk_bf16_f32 %0, %1, %2" : "=v"(r) : "v"(lo), "v"(hi)); return r; }
__device__ __forceinline__ float bf2f(unsigned h) { return __builtin_bit_cast(float, h << 16); }
__device__ __forceinline__ float bflo(unsigned w) { return __builtin_bit_cast(float, w << 16); }
__device__ __forceinline__ float bfhi(unsigned w) { return __builtin_bit_cast(float, w & 0xffff0000u); }
__device__ __forceinline__ float wave_sum(float v) {
    v += __builtin_bit_cast(float, __builtin_amdgcn_update_dpp(0, __builtin_bit_cast(int, v), 0xB1, 0xf, 0xf, true));
    v += __builtin_bit_cast(float, __builtin_amdgcn_update_dpp(0, __builtin_bit_cast(int, v), 0x4E, 0xf, 0xf, true));
    v += __builtin_bit_cast(float, __builtin_amdgcn_update_dpp(0, __builtin_bit_cast(int, v), 0x141, 0xf, 0xf, true));
    v += __builtin_bit_cast(float, __builtin_amdgcn_update_dpp(0, __builtin_bit_cast(int, v), 0x140, 0xf, 0xf, true));
    { auto r = __builtin_amdgcn_permlane16_swap(__float_as_uint(v), __float_as_uint(v), false, false); v = __uint_as_float(r[0]) + __uint_as_float(r[1]); }
    { auto r = __builtin_amdgcn_permlane32_swap(__float_as_uint(v), __float_as_uint(v), false, false); v = __uint_as_float(r[0]) + __uint_as_float(r[1]); }
    return v;
}

#define XB_TMO      128
#define XB_XCNT(j)  (256  + 64 * (j))
#define XB_XSUB(j)  (1280 + 64 * (j))
#define XB_XGEN(j)  (2304 + 64 * (j))
#define XB_TOP      3328
#define XB_TOPGEN   3392
#define XCD_BAR_WORDS 3456
#define XB_SPIN_CAP (1u << 18)

__device__ __forceinline__ unsigned xb_ld(unsigned* p)              { return __hip_atomic_load(p, __ATOMIC_RELAXED, __HIP_MEMORY_SCOPE_AGENT); }
__device__ __forceinline__ unsigned xb_add(unsigned* p, unsigned v) { return __hip_atomic_fetch_add(p, v, __ATOMIC_RELAXED, __HIP_MEMORY_SCOPE_AGENT); }
__device__ __forceinline__ unsigned xb_xcc_id() { return (unsigned)__builtin_amdgcn_s_getreg((3 << 11) | 20) & 0xFu; }
#define XB_SPIN(cond, bar) do { unsigned _sp = 0; while (cond) { __builtin_amdgcn_s_sleep(1); \
    if ((++_sp & 255u) == 0u) { if (xb_ld(&(bar)[XB_TMO])) break; if (_sp > XB_SPIN_CAP) { atomicAdd(&(bar)[XB_TMO], 1u); break; } } } } while (0)

struct XcdBarrier { unsigned* bar; unsigned x; volatile LAS unsigned* st; };

__device__ __forceinline__ XcdBarrier xcd_barrier_post(unsigned* bar, volatile LAS unsigned* st) {
    XcdBarrier b; b.bar = bar; b.x = xb_xcc_id(); b.st = st;
    if (threadIdx.x == 0) (void)xb_add(&bar[XB_XCNT(b.x)], 1u);
    return b;
}
__device__ __forceinline__ void xcd_barrier_complete(unsigned* bar, unsigned x, unsigned& nloc, unsigned& nx) {
    const unsigned G = gridDim.x * gridDim.y * gridDim.z;
    unsigned sum, cnt, mine, sp = 0u;
    for (;;) {
        sum = 0u; cnt = 0u; mine = 0u;
#pragma unroll
        for (unsigned j = 0; j < 16; ++j) { const unsigned c = xb_ld(&bar[XB_XCNT(j)]); sum += c; cnt += (c > 0u) ? 1u : 0u; mine = (j == x) ? c : mine; }
        if (sum == G) break;
        __builtin_amdgcn_s_sleep(1);
        if ((++sp & 255u) == 0u) { if (xb_ld(&bar[XB_TMO])) break; if (sp > XB_SPIN_CAP) { atomicAdd(&bar[XB_TMO], 1u); break; } }
    }
    nloc = mine > 0u ? mine : 1u; nx = cnt > 0u ? cnt : 1u;
}
__device__ __forceinline__ void xcd_barrier(const XcdBarrier& b) {
    asm volatile("s_waitcnt vmcnt(0)" ::: "memory");
    __syncthreads();
    if (threadIdx.x == 0) {
        unsigned* bar = b.bar;
        __builtin_amdgcn_s_waitcnt(0);
        unsigned nloc = b.st[0], nx = b.st[1];
        if (nloc == 0u) { xcd_barrier_complete(bar, b.x, nloc, nx); b.st[0] = nloc; b.st[1] = nx; }
        const unsigned old = xb_add(&bar[XB_XSUB(b.x)], 1u);
        const unsigned gen = old / nloc;
        if (old + 1u == (gen + 1u) * nloc) {
            __builtin_amdgcn_fence(__ATOMIC_RELEASE, "agent");
            asm volatile("s_waitcnt vmcnt(0)" ::: "memory");
            const unsigned og = xb_add(&bar[XB_TOP], 1u);
            const unsigned tg = og / nx;
            if (og + 1u == (tg + 1u) * nx) xb_add(&bar[XB_TOPGEN], 1u);
            else XB_SPIN(xb_ld(&bar[XB_TOPGEN]) == tg, bar);
            __builtin_amdgcn_fence(__ATOMIC_ACQUIRE, "agent");
            xb_add(&bar[XB_XGEN(b.x)], 1u);
            asm volatile("s_waitcnt vmcnt(0)" ::: "memory");
        } else {
            XB_SPIN(xb_ld(&bar[XB_XGEN(b.x)]) == gen, bar);
            __builtin_amdgcn_fence(__ATOMIC_ACQUIRE, "agent");
            asm volatile("s_waitcnt vmcnt(0)" ::: "memory");
        }
    }
    __syncthreads();
}

namespace pg {
constexpr int BM = 256, BK = 64, HALF = 128, HTB = HALF * BK * 2, NXCD = 8, WGM = 8;
__host__ __device__ __forceinline__ int lds_byte(int r, int c) { const int st = (r >> 4) * 2 + (c >> 5), rr = r & 15, cc = c & 31, ob = rr * 64 + cc * 2; return st * 1024 + (ob ^ (((ob >> 9) & 1) << 5)); }
__host__ __device__ __forceinline__ void stage_rc(int b, int& R, int& C) { const int st = b / 1024, sb = b % 1024, swz = sb ^ (((sb >> 9) & 1) << 5); R = (st >> 1) * 16 + swz / 64; C = (st & 1) * 32 + (swz % 64) / 2; }
__host__ __device__ __forceinline__ int perm32(int rho) { const int n = rho >> 4, i = rho & 15; return 8 * (i >> 2) + 4 * n + (i & 3); }

struct Unit { int pm, pn; const char* A; const char* B; const char* B2; int cls, row0, nrows, lbase; };

__device__ __forceinline__ bool static_map(int i, int G, int c, int nM, int nN, int& pm, int& pn) {
    const int nwg = nM * nN; const long L = (long)i * G + c; if (L >= nwg) return false;
    int wgid = (int)L; { const int q = nwg / NXCD, r = nwg % NXCD, xcd = wgid % NXCD, off = wgid / NXCD; wgid = (xcd < r ? xcd * (q + 1) : r * (q + 1) + (xcd - r) * q) + off; }
    const int nig = WGM * nN, gid = wgid / nig, fm = gid * WGM, gsz = (nM - fm) < WGM ? (nM - fm) : WGM;
    pm = fm + ((wgid % nig) % gsz); pn = (wgid % nig) / gsz; return true;
}
struct PlainSched {
    const char* A; const char* Bt; int nM, nN, G, c; size_t tA, tB;
    __device__ __forceinline__ void init(const void* A_, const void* Bt_, int M, int N, int ldA, int ldB, int G_, int c_) { A = (const char*)A_; Bt = (const char*)Bt_; nM = M / BM; nN = N / BM; G = G_; c = c_; tA = (size_t)BM * ldA * 2; tB = (size_t)BM * ldB * 2; }
    __device__ __forceinline__ bool next(int i, Unit& u) const {
        if (!static_map(i, G, c, nM, nN, u.pm, u.pn)) return false;
        u.A = A + (size_t)u.pm * tA; u.B = Bt + (size_t)u.pn * tB; u.B2 = u.B; u.cls = 0; u.row0 = 0; u.nrows = 256; u.lbase = 0; return true;
    }
    __device__ __forceinline__ unsigned row_off(const Unit&, int r, int ldA) const { return (unsigned)r * (unsigned)ldA * 2u; }
};

template <class Epi, class Sched, bool GATHER, bool KSPLIT, bool ALIGN_EPI>
__device__ __forceinline__ void gemm_phase(LAS unsigned char* lds, const int tid, const int K, const int ldA, const int ldB, const Sched& S, const Epi& E) {
    const int wid = __builtin_amdgcn_readfirstlane(tid >> 6), lane = tid & 63, wr = wid >> 2, wc = wid & 3, fr = lane & 15, fq = lane >> 4;
    const int nt = K / BK, nth = nt >> 1;
    int RA[2], CA[2];
    unsigned voffB[2], voA[2][2], nvoA[2][2];
#pragma unroll
    for (int i = 0; i < 2; ++i) { int R, C; stage_rc(tid * 16 + i * 8192, R, C); const int Rb = Epi::PERM ? ((R & ~31) + perm32(R & 31)) : R;
        RA[i] = R; CA[i] = C; voffB[i] = (unsigned)(Rb * ldB + C) * 2u;
        voA[0][i] = (unsigned)(R * ldA + C) * 2u; voA[1][i] = (unsigned)((R + HALF) * ldA + C) * 2u; nvoA[0][i] = voA[0][i]; nvoA[1][i] = voA[1][i]; }
    const size_t kstep = (size_t)(BK * 2);
    const size_t hstepB = (size_t)HALF * ldB * 2;
    const unsigned ldsw = (unsigned)wid * 1024u;
    const int aoff = lds_byte(wr * 64 + fr, fq * 8), boff = lds_byte(wc * 32 + fr, fq * 8);
#define PG8_SA(b, h) (((b) * 2 + (h)) * HTB)
#define PG8_SB(b, h) ((4 + (b) * 2 + (h)) * HTB)
#define PG8_STAGEB(bufoff, gbase) do { _Pragma("unroll") for (int _i = 0; _i < 2; ++_i) \
        __builtin_amdgcn_global_load_lds((const unsigned*)((const char*)(gbase) + voffB[_i]), (LAS unsigned*)(lds + (bufoff) + ldsw + _i * 8192), 16, 0, 0); } while (0)
#define PG8_STAGEA(bufoff, gbase, vo, h) do { _Pragma("unroll") for (int _i = 0; _i < 2; ++_i) \
        __builtin_amdgcn_global_load_lds((const unsigned*)((const char*)(gbase) + (vo)[h][_i]), (LAS unsigned*)(lds + (bufoff) + ldsw + _i * 8192), 16, 0, 0); } while (0)
#define PG8_LDA(dst, b, h) do { _Pragma("unroll") for (int m = 0; m < 4; ++m) _Pragma("unroll") for (int k = 0; k < 2; ++k) dst[m][k] = *(const LAS bf16x8*)(lds + PG8_SA(b, h) + aoff + m * 2048 + k * 1024); } while (0)
#define PG8_LDB(dst, b, h) do { _Pragma("unroll") for (int n = 0; n < 2; ++n) _Pragma("unroll") for (int k = 0; k < 2; ++k) dst[n][k] = *(const LAS bf16x8*)(lds + PG8_SB(b, h) + boff + n * 2048 + k * 1024); } while (0)
#define PG8_MMA(ai, bj, At, Bt) do { __builtin_amdgcn_s_setprio(1); _Pragma("unroll") for (int m = 0; m < 4; ++m) _Pragma("unroll") for (int n = 0; n < 2; ++n) _Pragma("unroll") for (int k = 0; k < 2; ++k) \
        acc[ai][bj][m][n] = __builtin_amdgcn_mfma_f32_16x16x32_bf16(Bt[n][k], At[m][k], acc[ai][bj][m][n], 0, 0, 0); __builtin_amdgcn_s_setprio(0); } while (0)
#define PG8_WAIT_V(n) asm volatile("s_waitcnt vmcnt(" #n ")" ::: "memory")
#define PG8_WAIT_L(n) asm volatile("s_waitcnt lgkmcnt(" #n ")" ::: "memory")
#define PG8_BAR __builtin_amdgcn_s_barrier()
#define PG8_SCHED __builtin_amdgcn_sched_barrier(0)
#define PG8_BPTR(tt) ((KSPLIT && (tt) >= nth) ? cB2 + (size_t)((tt) - nth) * kstep : cB + (size_t)(tt) * kstep)
    Unit cur, nxt; int ui = 0;
    if (!S.next(0, cur)) return;
    if constexpr (GATHER) {
#pragma unroll
        for (int h = 0; h < 2; ++h)
#pragma unroll
            for (int i = 0; i < 2; ++i) voA[h][i] = S.row_off(cur, h * HALF + RA[i], ldA) + (unsigned)CA[i] * 2u;
    }
    f32x4 acc[2][2][4][2];
#pragma unroll
    for (int a = 0; a < 2; ++a)
#pragma unroll
        for (int b = 0; b < 2; ++b)
#pragma unroll
            for (int m = 0; m < 4; ++m)
#pragma unroll
                for (int n = 0; n < 2; ++n) acc[a][b][m][n] = (f32x4){0.f, 0.f, 0.f, 0.f};
    bf16x8 At[4][2], B0[2][2], B1[2][2];
    const char* cA = cur.A; const char* cB = cur.B; const char* cB2 = cur.B2;
    PG8_STAGEB(PG8_SB(0, 0), cB); PG8_STAGEB(PG8_SB(0, 1), cB + hstepB); PG8_STAGEA(PG8_SA(0, 0), cA, voA, 0); PG8_STAGEA(PG8_SA(0, 1), cA, voA, 1);
    if (wr == 1) PG8_BAR;
    PG8_WAIT_V(2); PG8_BAR;
    { const char* b1 = PG8_BPTR(1); PG8_STAGEB(PG8_SB(1, 0), b1); PG8_STAGEA(PG8_SA(1, 0), cA + kstep, voA, 0); PG8_STAGEB(PG8_SB(1, 1), b1 + hstepB); }
    PG8_WAIT_V(6); PG8_BAR;
    for (;;) {
        const bool has_next = S.next(ui + 1, nxt);
        const char* nA = has_next ? nxt.A : cA; const char* nB = has_next ? nxt.B : cB;
        if constexpr (GATHER) {
            if (has_next) {
#pragma unroll
                for (int h = 0; h < 2; ++h)
#pragma unroll
                    for (int i = 0; i < 2; ++i) nvoA[h][i] = S.row_off(nxt, h * HALF + RA[i], ldA) + (unsigned)CA[i] * 2u;
            } else {
#pragma unroll
                for (int h = 0; h < 2; ++h)
#pragma unroll
                    for (int i = 0; i < 2; ++i) nvoA[h][i] = voA[h][i];
            }
        }
        for (int t = 0; t < nt; t += 2) {
            const bool last = (t == nt - 2);
            const char* a1 = cA + (size_t)(t + 1) * kstep;
            const char* a2 = last ? nA : cA + (size_t)(t + 2) * kstep; const char* b2 = last ? nB : PG8_BPTR(t + 2);
            const char* a3 = a2 + kstep; const char* b3 = last ? nB + kstep : PG8_BPTR(t + 3);
            unsigned vo2[2][2];
#pragma unroll
            for (int h = 0; h < 2; ++h)
#pragma unroll
                for (int i = 0; i < 2; ++i) vo2[h][i] = (GATHER && last) ? nvoA[h][i] : voA[h][i];
            PG8_LDB(B0, 0, 0); PG8_LDB(B1, 0, 1); PG8_SCHED; PG8_LDA(At, 0, 0); PG8_STAGEA(PG8_SA(1, 1), a1, voA, 1);
            PG8_WAIT_V(8); PG8_WAIT_L(0); PG8_BAR; PG8_MMA(0, 0, At, B0); PG8_MMA(0, 1, At, B1); PG8_BAR; PG8_SCHED;
            PG8_LDA(At, 0, 1); PG8_STAGEB(PG8_SB(0, 0), b2); PG8_STAGEB(PG8_SB(0, 1), b2 + hstepB); PG8_STAGEA(PG8_SA(0, 0), a2, vo2, 0);
            PG8_WAIT_V(8); PG8_WAIT_L(0); PG8_BAR; PG8_MMA(1, 0, At, B0); PG8_MMA(1, 1, At, B1); PG8_BAR; PG8_SCHED;
            PG8_LDB(B0, 1, 0); PG8_LDB(B1, 1, 1); PG8_SCHED; PG8_LDA(At, 1, 0); PG8_STAGEA(PG8_SA(0, 1), a2, vo2, 1);
            PG8_WAIT_V(8); PG8_WAIT_L(0); PG8_BAR; PG8_MMA(0, 0, At, B0); PG8_MMA(0, 1, At, B1); PG8_BAR; PG8_SCHED;
            PG8_LDA(At, 1, 1); PG8_STAGEB(PG8_SB(1, 0), b3); PG8_STAGEB(PG8_SB(1, 1), b3 + hstepB); PG8_STAGEA(PG8_SA(1, 0), a3, vo2, 0);
            PG8_WAIT_V(8); PG8_WAIT_L(0); PG8_BAR; PG8_MMA(1, 0, At, B0); PG8_MMA(1, 1, At, B1); PG8_BAR; PG8_SCHED;
        }
        if constexpr (ALIGN_EPI) { if (wr == 0) PG8_BAR; }
        E(acc, cur, wr, wc, fr, fq);
        if (!has_next) break;
#pragma unroll
        for (int a = 0; a < 2; ++a)
#pragma unroll
            for (int b = 0; b < 2; ++b)
#pragma unroll
                for (int m = 0; m < 4; ++m)
#pragma unroll
                    for (int n = 0; n < 2; ++n) acc[a][b][m][n] = (f32x4){0.f, 0.f, 0.f, 0.f};
        cur = nxt; cA = nA; cB = nB; cB2 = nxt.B2; ++ui;
        if constexpr (GATHER) {
#pragma unroll
            for (int h = 0; h < 2; ++h)
#pragma unroll
                for (int i = 0; i < 2; ++i) voA[h][i] = nvoA[h][i];
        }
        if constexpr (ALIGN_EPI) { if (wr == 1) PG8_BAR; }
    }
    PG8_WAIT_V(0);
    if constexpr (!ALIGN_EPI) { if (wr == 0) PG8_BAR; }
    PG8_BAR;
#undef PG8_SA
#undef PG8_SB
#undef PG8_STAGEA
#undef PG8_STAGEB
#undef PG8_LDA
#undef PG8_LDB
#undef PG8_MMA
#undef PG8_WAIT_V
#undef PG8_WAIT_L
#undef PG8_BAR
#undef PG8_SCHED
#undef PG8_BPTR
}
}
namespace pg {
template <bool BIAS_ROW> struct EpiBf16 {
    static constexpr bool PERM = true;
    bf16* O; int ldc; const float* bias;
    __device__ __forceinline__ void operator()(const f32x4 (&acc)[2][2][4][2], const Unit& u, int wr, int wc, int fr, int fq) const {
        const int row0 = u.pm * BM + wr * 64 + fr; const int col0 = u.pn * BM + wc * 32 + 8 * fq;
        f32x4 bv[2][2];
#pragma unroll
        for (int bj = 0; bj < 2; ++bj)
#pragma unroll
            for (int n = 0; n < 2; ++n) bv[bj][n] = (bias && !BIAS_ROW) ? *(const f32x4*)(bias + col0 + bj * HALF + 4 * n) : (f32x4){0.f, 0.f, 0.f, 0.f};
#pragma unroll
        for (int ai = 0; ai < 2; ++ai)
#pragma unroll
            for (int m = 0; m < 4; ++m) { const int row = row0 + ai * HALF + m * 16; bf16* rowp = O + (size_t)row * ldc + col0;
                float br = 0.f; if (BIAS_ROW && bias) br = bias[row];
#pragma unroll
                for (int bj = 0; bj < 2; ++bj) { f32x4 v0 = acc[ai][bj][m][0] + bv[bj][0] + br, v1 = acc[ai][bj][m][1] + bv[bj][1] + br;
                    u32x4 w; w.x = cvt_pk_bf16(v0[0], v0[1]); w.y = cvt_pk_bf16(v0[2], v0[3]); w.z = cvt_pk_bf16(v1[0], v1[1]); w.w = cvt_pk_bf16(v1[2], v1[3]);
                    *(u32x4*)(rowp + bj * HALF) = w; } }
    }
};
struct EpiQKV {
    static constexpr bool PERM = false;
    bf16 *Q, *Kb, *Vb; const float* bias; const float* ropeC; const float* ropeS;
    __device__ __forceinline__ void operator()(const f32x4 (&acc)[2][2][4][2], const Unit& u, int wr, int wc, int fr, int fq) const {
        const int row0 = u.pm * BM + wr * 64 + fr; const int colt = u.pn * BM + wc * 32 + 4 * fq;
        const bool isV = (u.pn == 9), isQ = (u.pn < 8);
        bf16* base; int ldc, cofs;
        if (isQ) { base = Q; ldc = DM; cofs = 0; } else if (!isV) { base = Kb; ldc = KVD; cofs = 2048; } else { base = Vb; ldc = KVD; cofs = 2304; }
        f32x4 bv[2][2];
#pragma unroll
        for (int bj = 0; bj < 2; ++bj)
#pragma unroll
            for (int n = 0; n < 2; ++n) bv[bj][n] = *(const f32x4*)(bias + colt + bj * HALF + 16 * n);
        const float sc = isQ ? QSCALE : 1.f; const int half = wc & 1;
#pragma unroll
        for (int ai = 0; ai < 2; ++ai)
#pragma unroll
            for (int m = 0; m < 4; ++m) { const int row = row0 + ai * HALF + m * 16; const int t = row & (SEQ - 1); const int pos = half ? (t & (GRIDW - 1)) : (t >> 6);
                f32x4 cs = (f32x4){1.f, 1.f, 1.f, 1.f}, sn = (f32x4){0.f, 0.f, 0.f, 0.f};
                if (!isV) { cs = *(const f32x4*)(ropeC + pos * 16 + 4 * fq); sn = *(const f32x4*)(ropeS + pos * 16 + 4 * fq); }
                bf16* rowp = base + (size_t)row * ldc + (colt - cofs);
#pragma unroll
                for (int bj = 0; bj < 2; ++bj) { const f32x4 x1 = acc[ai][bj][m][0] + bv[bj][0], x2 = acc[ai][bj][m][1] + bv[bj][1];
                    const f32x4 o1 = (x1 * cs - x2 * sn) * sc, o2 = (x2 * cs + x1 * sn) * sc;
                    u32x2 w1, w2; w1.x = cvt_pk_bf16(o1[0], o1[1]); w1.y = cvt_pk_bf16(o1[2], o1[3]); w2.x = cvt_pk_bf16(o2[0], o2[1]); w2.y = cvt_pk_bf16(o2[2], o2[3]);
                    *(u32x2*)(rowp + bj * HALF) = w1; *(u32x2*)(rowp + bj * HALF + 16) = w2; } }
    }
};
struct EpiMoe1 {
    static constexpr bool PERM = true;
    bf16* hid; const float* gates;
    __device__ __forceinline__ void operator()(const f32x4 (&acc)[2][2][4][2], const Unit& u, int wr, int wc, int fr, int fq) const {
        const int lr0 = wr * 64 + fr; const int col0 = u.pn * HALF + wc * 32 + 8 * fq; const int gsel = (u.pn >= 8) ? 1 : 0;
#pragma unroll
        for (int ai = 0; ai < 2; ++ai)
#pragma unroll
            for (int m = 0; m < 4; ++m) { const int lr = lr0 + ai * HALF + m * 16;
                if (lr < u.nrows) { const float g = gates[(size_t)(u.lbase + lr) * 2 + gsel];
                    float o[8];
#pragma unroll
                    for (int n = 0; n < 2; ++n)
#pragma unroll
                        for (int i = 0; i < 4; ++i) { const float a = acc[ai][0][m][n][i], b = acc[ai][1][m][n][i];
                            const float sg = __builtin_amdgcn_rcpf(1.f + __builtin_amdgcn_exp2f(-1.4426950408889634f * a)); o[n * 4 + i] = a * sg * b * g; }
                    u32x4 w; w.x = cvt_pk_bf16(o[0], o[1]); w.y = cvt_pk_bf16(o[2], o[3]); w.z = cvt_pk_bf16(o[4], o[5]); w.w = cvt_pk_bf16(o[6], o[7]);
                    *(u32x4*)(hid + (size_t)(u.row0 + lr) * DM + col0) = w; } }
    }
};
struct EpiMoe2 {
    static constexpr bool PERM = true;
    bf16* Y; const int* toks;
    __device__ __forceinline__ void operator()(const f32x4 (&acc)[2][2][4][2], const Unit& u, int wr, int wc, int fr, int fq) const {
        const int lr0 = wr * 64 + fr; const int col0 = u.pn * BM + wc * 32 + 8 * fq;
#pragma unroll
        for (int ai = 0; ai < 2; ++ai)
#pragma unroll
            for (int m = 0; m < 4; ++m) { const int lr = lr0 + ai * HALF + m * 16;
                if (lr < u.nrows) { const int tok = toks[u.lbase + lr]; bf16* rowp = Y + (size_t)tok * DM + col0;
#pragma unroll
                    for (int bj = 0; bj < 2; ++bj) { const f32x4 v0 = acc[ai][bj][m][0], v1 = acc[ai][bj][m][1];
                        u32x4 w; w.x = cvt_pk_bf16(v0[0], v0[1]); w.y = cvt_pk_bf16(v0[2], v0[3]); w.z = cvt_pk_bf16(v1[0], v1[1]); w.w = cvt_pk_bf16(v1[2], v1[3]);
                        *(u32x4*)(rowp + bj * HALF) = w; } } }
    }
};
struct MoeSched {
    const LAS int* tab;
    const char* Abase; const char* W; const int* toks; int G, c, NPN, second;
    __device__ __forceinline__ bool next(int i, Unit& u) const {
        const int TM = __builtin_amdgcn_readfirstlane(tab[24]);
        if (!static_map(i, G, c, TM, NPN, u.pm, u.pn)) return false;
        int cls = 0;
        for (int k = 1; k < NCLS; ++k) { const int s = __builtin_amdgcn_readfirstlane(tab[k]); if (u.pm >= s) cls = k; }
        const int ts = __builtin_amdgcn_readfirstlane(tab[cls]), cnt = __builtin_amdgcn_readfirstlane(tab[32 + cls]);
        const int ti = u.pm - ts; u.cls = cls; u.row0 = u.pm * BM; u.nrows = (cnt - ti * BM) < BM ? (cnt - ti * BM) : BM; u.lbase = cls * LCAP + ti * BM;
        const int g = cls / 6, p = cls % 6; const int lo = (p < 3) ? 0 : (p < 5 ? 1 : 2), hi = (p < 3) ? p + 1 : (p < 5 ? p - 1 : 3);
        const int elo = g * 4 + lo, ehi = g * 4 + hi;
        if (!second) { const int e = (u.pn < 8) ? elo : ehi; u.A = Abase; u.B = W + ((size_t)e * 2048 + (size_t)(u.pn & 7) * 256) * 2048 * 2; u.B2 = u.B; }
        else { u.A = Abase + (size_t)u.row0 * DM * 2; u.B = W + ((size_t)elo * 2048 + (size_t)u.pn * 256) * 1024 * 2; u.B2 = W + ((size_t)ehi * 2048 + (size_t)u.pn * 256) * 1024 * 2; }
        return true;
    }
    __device__ __forceinline__ unsigned row_off(const Unit& u, int r, int ldA) const {
        const int rr = r < u.nrows ? r : u.nrows - 1; const int tok = toks[u.lbase + rr]; return (unsigned)tok * (unsigned)ldA * 2u;
    }
};
}
struct Args { const float* in[34]; float* out; unsigned char* ws; int ph_lo, ph_hi; };
struct Frame {
    LAS unsigned char* lds;
    gu32* ctl; unsigned char* ws;
    int tid, lane, wave, G, bid;
    const Args* a; float* out;
};
#define AIN(i) (F.a->in[i])
enum { I_X = 0, I_C, I_CTX, I_CCTX, I_ADAW, I_ADAB, I_AWIN, I_ABIN, I_SINK, I_AWOUT, I_HWIN, I_HBIN, I_HCW, I_HCB, I_FW1, I_FB1, I_FW2, I_FB2, I_FW3, I_FB3, I_FFREQ, I_FW4, I_FBIAS, I_HWOUT, I_HBOUT,
       I_LN1G, I_LN1B, I_LN2G, I_LN2B, I_RW, I_RB, I_W1, I_W3, I_W2 };
#ifndef TPSEL
#define TPSEL -1
#endif
#define TPS_W ((LAS unsigned long long*)(F.lds + RING_BYTES + 320 + 96))
#define TPS_START(id) do { if (TPSEL == (id) && blockIdx.x == 0 && threadIdx.x == 0) TPS_W[1] = __builtin_amdgcn_s_memrealtime(); } while (0)
#define TPS_STOP(id) do { if (TPSEL == (id) && blockIdx.x == 0 && threadIdx.x == 0) TPS_W[0] += __builtin_amdgcn_s_memrealtime() - TPS_W[1]; } while (0)
__device__ __forceinline__ int fresh_tid(int wave) { int l_; asm volatile("v_mbcnt_lo_u32_b32 %0, -1, 0\n\tv_mbcnt_hi_u32_b32 %0, -1, %0" : "=&v"(l_)); return wave * 64 + l_; }
__device__ __forceinline__ float* mod_ptr(const Frame& F, int layer, int vec, int chunk) { return (float*)(F.ws + WS_MOD) + ((size_t)(layer * 3 + vec) * 6 + chunk) * DM; }

__device__ __forceinline__ float hy_ftab_value(int f, int l, int jj);
__device__ constexpr int hy_ftab_elems() { return 28 * 64 * 8; }
__device__ __forceinline__ void p0_transpose_item(const float* W, int ldw, bf16* WT, int ldt, int dst_row, int k0, int n0, LAS float* scr, int lane) {
#pragma unroll
    for (int i = 0; i < 32; ++i) { const int kk = 2 * i + (lane >> 5); scr[kk * 33 + (lane & 31)] = W[(size_t)(k0 + kk) * ldw + n0 + (lane & 31)]; }
    LDS_WAIT(); asm volatile("" ::: "memory");
    const int c = lane & 7;
#pragma unroll
    for (int j = 0; j < 4; ++j) { const int n = (lane >> 3) + 8 * j; const LAS float* s = scr + (8 * c) * 33 + n;
        u32x4 o; o.x = cvt_pk_bf16(s[0 * 33], s[1 * 33]); o.y = cvt_pk_bf16(s[2 * 33], s[3 * 33]); o.z = cvt_pk_bf16(s[4 * 33], s[5 * 33]); o.w = cvt_pk_bf16(s[6 * 33], s[7 * 33]);
        *(GAS u32x4*)(WT + (size_t)(dst_row + n) * ldt + k0 + 8 * c) = o; }
    LDS_WAIT(); asm volatile("" ::: "memory");
}
struct ConvItem { const float* W; bf16* WT; int ldw, ldt, dst_row, k0, n0; };
__device__ __forceinline__ ConvItem moe_l1_item(const Frame& F, int it) {
    ConvItem c; const int mat = it >> 10, sub = it & 1023, which = mat >> 4, le = 16 + (mat & 15);
    if (which < 2) { c.n0 = (sub & 31) * 32; c.k0 = (sub >> 5) * 64; c.W = (which == 0 ? AIN(I_W1) : AIN(I_W3)) + (size_t)le * DM * EFF; c.ldw = EFF; c.WT = (bf16*)(F.ws + WS_W13) + (size_t)le * 2048 * 2048; c.ldt = DM; c.dst_row = (c.n0 >> 7) * 256 + which * 128 + (c.n0 & 127); }
    else { c.n0 = (sub & 63) * 32; c.k0 = (sub >> 6) * 64; c.W = AIN(I_W2) + (size_t)le * EFF * DM; c.ldw = DM; c.WT = (bf16*)(F.ws + WS_W2) + (size_t)le * 2048 * 1024; c.ldt = EFF; c.dst_row = c.n0; }
    return c;
}
__device__ __forceinline__ ConvItem early_item(const Frame& F, int it) {
    ConvItem c;
    if (it < 48 * 1024) { const int mat = it >> 10, sub = it & 1023, which = mat >> 4, le = mat & 15;
        if (which < 2) { c.n0 = (sub & 31) * 32; c.k0 = (sub >> 5) * 64; c.W = (which == 0 ? AIN(I_W1) : AIN(I_W3)) + (size_t)le * DM * EFF; c.ldw = EFF; c.WT = (bf16*)(F.ws + WS_W13) + (size_t)le * 2048 * 2048; c.ldt = DM; c.dst_row = (c.n0 >> 7) * 256 + which * 128 + (c.n0 & 127); }
        else { c.n0 = (sub & 63) * 32; c.k0 = (sub >> 6) * 64; c.W = AIN(I_W2) + (size_t)le * EFF * DM; c.ldw = DM; c.WT = (bf16*)(F.ws + WS_W2) + (size_t)le * 2048 * 1024; c.ldt = EFF; c.dst_row = c.n0; }
    } else { int r = it - 48 * 1024;
        if (r < 32 * 192) { c.n0 = (r % 192) * 32; c.k0 = (r / 192) * 64; c.W = AIN(I_HWIN); c.ldw = 3 * DM; c.WT = (bf16*)(F.ws + WS_WHYIN); c.ldt = DM; c.dst_row = c.n0; }
        else { r -= 32 * 192; c.n0 = (r % 64) * 32; c.k0 = (r / 64) * 64; c.W = AIN(I_HWOUT); c.ldw = DM; c.WT = (bf16*)(F.ws + WS_WHYO); c.ldt = DM; c.dst_row = c.n0; } }
    return c;
}
constexpr int EARLY_NIT = 48 * 1024 + 32 * 192 + 32 * 64;
__device__ __forceinline__ void conv_issue(const ConvItem& c, int lane, float (&v)[32]) {
    const float* p = c.W + (size_t)(c.k0 + (lane >> 5)) * c.ldw + c.n0 + (lane & 31); const size_t st = (size_t)2 * c.ldw;
#pragma unroll
    for (int i = 0; i < 32; ++i) { v[i] = *p; p += st; asm volatile("" : "+v"(p)); }
}
__device__ __forceinline__ void conv_finish(const ConvItem& c, int lane, const float (&v)[32]) {
    bf16* row = c.WT + (size_t)(c.dst_row + (lane & 31)) * c.ldt + c.k0 + 8 * (lane >> 5);
#pragma unroll
    for (int m = 0; m < 4; ++m) { u32x4 w;
#pragma unroll
        for (int q = 0; q < 4; ++q) { auto r = __builtin_amdgcn_permlane32_swap(__float_as_uint(v[8 * m + q]), __float_as_uint(v[8 * m + 4 + q]), false, false);
            const unsigned pk = cvt_pk_bf16(__uint_as_float(r[0]), __uint_as_float(r[1])); if (q == 0) w.x = pk; else if (q == 1) w.y = pk; else if (q == 2) w.z = pk; else w.w = pk; }
        *(GAS u32x4*)(row + 16 * m) = w; }
}
__device__ __forceinline__ void p0_prologue(Frame& F) {
    const int gw = F.bid * NWAVES + F.wave, NGW = F.G * NWAVES, gt = F.bid * NTHR + F.tid, NGT = F.G * NTHR;
#ifndef P0_REP
#define P0_REP 0
#endif
    TPS_START(20);
#pragma unroll 1
    for (int rep_a = 0; rep_a < ((P0_REP & 1) ? 2 : 1); ++rep_a) {
        LAS float* sil = (LAS float*)F.lds; LAS float* red = sil + 3 * DM;
        for (int i = F.tid; i < 3 * DM; i += NTHR) { const int v = i / DM, k = i % DM; const float cv = (v < 2) ? AIN(I_C)[v * DM + k] : AIN(I_CCTX)[k]; sil[i] = cv / (1.f + expf(-cv)); }
        __syncthreads();
        const int cl = F.tid & 7, kg = F.tid >> 3;
        for (int unit = F.bid; unit < 768; unit += F.G) {
            const int l = unit / 384, n0 = (unit % 384) * 32;
            const float* W = AIN(I_ADAW) + (size_t)l * DM * 12288 + n0 + cl * 4;
            f32x4 a0 = {0.f, 0.f, 0.f, 0.f}, a1 = a0, a2 = a0;
#pragma unroll 8
            for (int i = 0; i < 32; ++i) { const int k = kg + 64 * i; const f32x4 w = *(const f32x4*)(W + (size_t)k * 12288); a0 += w * sil[k]; a1 += w * sil[DM + k]; a2 += w * sil[2 * DM + k]; }
#pragma unroll
            for (int j = 0; j < 4; ++j) { red[(kg * 32 + cl * 4 + j) * 3 + 0] = a0[j]; red[(kg * 32 + cl * 4 + j) * 3 + 1] = a1[j]; red[(kg * 32 + cl * 4 + j) * 3 + 2] = a2[j]; }
            __syncthreads();
            if (F.tid < 96) { const int col = F.tid & 31, v = F.tid >> 5; float s = 0.f;
                for (int k = 0; k < 64; ++k) s += red[(k * 32 + col) * 3 + v];
                ((float*)(F.ws + WS_MOD))[(size_t)(l * 3 + v) * 12288 + n0 + col] = s + AIN(I_ADAB)[l * 12288 + n0 + col]; }
            __syncthreads();
        }
    }
    TPS_STOP(20); TPS_START(21);
#pragma unroll 1
    for (int rep_b = 0; rep_b < ((P0_REP & 2) ? 2 : 1); ++rep_b) {
        LAS float* scr = (LAS float*)(F.lds + F.wave * 16384);
        constexpr int I0 = 32 * 80, I1 = 32 * 64, NIT = I0 + I1 + EARLY_NIT;
        for (int it = gw; it < NIT; it += NGW) {
            int r = it;
            if (r < I0) { p0_transpose_item(AIN(I_AWIN), QKVD, (bf16*)(F.ws + WS_WQKV), DM, (r % 80) * 32, (r / 80) * 64, (r % 80) * 32, scr, F.lane); continue; } r -= I0;
            if (r < I1) { p0_transpose_item(AIN(I_AWOUT), DM, (bf16*)(F.ws + WS_WO0), DM, (r % 64) * 32, (r / 64) * 64, (r % 64) * 32, scr, F.lane); continue; } r -= I1;
            const ConvItem c = early_item(F, r); p0_transpose_item(c.W, c.ldw, c.WT, c.ldt, c.dst_row, c.k0, c.n0, scr, F.lane);
        }
    }
    TPS_STOP(21); TPS_START(22);
    {
        const int j = F.lane; const float fr = AIN(I_FFREQ)[j], b1 = AIN(I_FB1)[j], b2 = AIN(I_FB2)[j], b3 = AIN(I_FB3)[j];
        float wc1[HYEMB], wc2[HYW], wc3[HYW];
#pragma unroll
        for (int i = 0; i < HYEMB; ++i) wc1[i] = AIN(I_FW1)[i * HYW + j];
#pragma unroll
        for (int i = 0; i < HYW; ++i) { wc2[i] = AIN(I_FW2)[i * HYW + j]; wc3[i] = AIN(I_FW3)[i * HYW + j]; }
        bf16* hdn = (bf16*)(F.ws + WS_HDN);
        for (int row = gw; row < SEQ; row += NGW) {
            const float tt = (float)row / (float)(SEQ - 1); const float wv = 6.283185307179586f * (float)row / (float)SEQ;
            float zv = 0.f;
            if (j == 0) zv = tt;
            else if (j <= 32) { const int jj = (j - 1) & 15; const float f = 1e-4f + (float)jj * ((15.f - 1e-4f) / 15.f); const float a = f * wv; zv = (j <= 16) ? cosf(a) : -sinf(a); }
            float h = b1;
#pragma unroll
            for (int i = 0; i < HYEMB; ++i) h += __builtin_bit_cast(float, __builtin_amdgcn_readlane(__builtin_bit_cast(int, zv), i)) * wc1[i];
            float a1 = sinf(fr * h);
            h = b2;
#pragma unroll
            for (int i = 0; i < HYW; ++i) h += __builtin_bit_cast(float, __builtin_amdgcn_readlane(__builtin_bit_cast(int, a1), i)) * wc2[i];
            float a2 = sinf(fr * h);
            h = b3;
#pragma unroll
            for (int i = 0; i < HYW; ++i) h += __builtin_bit_cast(float, __builtin_amdgcn_readlane(__builtin_bit_cast(int, a2), i)) * wc3[i];
            const float a3 = sinf(fr * h);
            hdn[(size_t)row * 128 + j] = (bf16)(cvt_pk_bf16(a3, 0.f) & 0xffffu); hdn[(size_t)row * 128 + 64 + j] = 0;
        }
    }
    TPS_STOP(22); TPS_START(23);
    for (int i = gt; i < hy_ftab_elems(); i += NGT) ((bf16*)(F.ws + WS_FTAB))[i] = (bf16)(cvt_pk_bf16(hy_ftab_value(i >> 9, (i >> 3) & 63, i & 7), 0.f) & 0xffffu);
    for (int i = gt; i < 4096; i += NGT) { const int pos = i >> 4, dd = i & 15; const float inv = powf(10000.f, -(float)(2 * dd) / 32.f); const float a = (float)pos * inv;
        ((float*)(F.ws + WS_ROPE))[i] = cosf(a); ((float*)(F.ws + WS_ROPE))[4096 + i] = sinf(a); }
    for (int i = gt; i < 4096 * 128; i += NGT) { const int k = i >> 12, n = i & 4095;
        ((bf16*)(F.ws + WS_W4T))[(size_t)n * 128 + k] = (k < 64) ? (bf16)(cvt_pk_bf16(AIN(I_FW4)[(size_t)k * 4096 + n], 0.f) & 0xffffu) : (bf16)0; }
    TPS_STOP(23);
}

__device__ __forceinline__ void p1_prologue(Frame& F) {
    if (F.wave < 4) {
        for (int tile = F.bid * 4 + F.wave; tile < 1024; tile += F.G * 4) {
            const int r0 = (tile >> 5) * 16, n0 = (tile & 31) * 16; const int lr = F.lane & 15, kq = F.lane >> 4;
            const float* crow = AIN(I_CTX) + (size_t)(r0 + lr) * DM; const float* sh = mod_ptr(F, 0, 2, 0); const float* sc = mod_ptr(F, 0, 2, 1);
            const bf16* wrow = (const bf16*)(F.ws + WS_WQKV) + (size_t)(2048 + n0 + lr) * DM;
            f32x4 acc = {0.f, 0.f, 0.f, 0.f};
#pragma unroll 4
            for (int k0 = 0; k0 < DM; k0 += 32) { const int k = k0 + 8 * kq;
                const f32x4 x0 = *(const f32x4*)(crow + k), x1 = *(const f32x4*)(crow + k + 4), s0 = *(const f32x4*)(sc + k), s1 = *(const f32x4*)(sc + k + 4), h0 = *(const f32x4*)(sh + k), h1 = *(const f32x4*)(sh + k + 4);
                const f32x4 u0 = x0 * (s0 + 1.f) + h0, u1 = x1 * (s1 + 1.f) + h1;
                u32x4 aw; aw.x = cvt_pk_bf16(u0[0], u0[1]); aw.y = cvt_pk_bf16(u0[2], u0[3]); aw.z = cvt_pk_bf16(u1[0], u1[1]); aw.w = cvt_pk_bf16(u1[2], u1[3]);
                const bf16x8 bfrag = *(const bf16x8*)(wrow + k);
                acc = __builtin_amdgcn_mfma_f32_16x16x32_bf16(__builtin_bit_cast(bf16x8, aw), bfrag, acc, 0, 0, 0); }
            const float bb = AIN(I_ABIN)[2048 + n0 + lr]; bf16* o = (bf16*)(F.ws + WS_CTXKV);
#pragma unroll
            for (int r = 0; r < 4; ++r) o[(size_t)(r0 + 4 * kq + r) * 512 + n0 + lr] = (bf16)(cvt_pk_bf16(acc[r] + bb, 0.f) & 0xffffu);
        }
    }
    if (F.bid < 4) {
        const int l = F.bid >> 1, b = F.bid & 1; const float* sc2 = mod_ptr(F, l, b, 4); int* map = (int*)(F.ws + WS_BADMAP) + (size_t)(l * 2 + b) * DM;
        LAS int* cntl = (LAS int*)F.lds;
        int* inv = (int*)(F.ws + WS_BADMAP + 32768) + (l * 2 + b) * 64;
        if (F.tid < 64) inv[F.tid] = -1;
        int flags[4], n = 0;
#pragma unroll
        for (int i = 0; i < 4; ++i) { flags[i] = fabsf(1.f + sc2[4 * F.tid + i]) < 0.25f; n += flags[i]; }
        cntl[F.tid] = n; __syncthreads();
        if (F.tid == 0) { int a = 0; for (int t = 0; t < NTHR; ++t) { const int c = cntl[t]; cntl[t] = a; a += c; } }
        __syncthreads();
        int sl = cntl[F.tid];
#pragma unroll
        for (int i = 0; i < 4; ++i) { const bool use = flags[i] && sl < 64; map[4 * F.tid + i] = use ? sl : -1; if (use) inv[sl] = 4 * F.tid + i; sl += flags[i]; }
        __syncthreads();
    }
    const float* x = AIN(I_X); bf16* u0 = (bf16*)(F.ws + WS_A);
    LAS int* cnt = (LAS int*)(F.lds + RING_BYTES + 64);
    const size_t NI = (size_t)MTOK * DM / 8; const size_t per = (NI + F.G - 1) / F.G; const size_t i0 = (size_t)F.bid * per; const size_t i1 = (i0 + per < NI) ? i0 + per : NI;
    const int nch = (int)((i1 - i0 + 255) / 256);
    for (;;) {
        int c = 0; if (F.lane == 0) c = __hip_atomic_fetch_add(cnt, 1, __ATOMIC_RELAXED, __HIP_MEMORY_SCOPE_WORKGROUP);
        c = __builtin_amdgcn_readfirstlane(c); if (c >= nch) break;
        f32x4 xa[4], xb[4]; size_t ee[4];
#pragma unroll
        for (int j = 0; j < 4; ++j) { const size_t i = i0 + (size_t)c * 256 + j * 64 + F.lane; ee[j] = (i < i1) ? i * 8 : (size_t)-1; if (i < i1) { xa[j] = *(const f32x4*)(x + i * 8); xb[j] = *(const f32x4*)(x + i * 8 + 4); } }
#pragma unroll
        for (int j = 0; j < 4; ++j) { if (ee[j] == (size_t)-1) continue; const size_t e = ee[j]; const int col = (int)(e & (DM - 1)); const int b = (int)(e / ((size_t)SEQ * DM));
            const float* sh = mod_ptr(F, 0, b, 0) + col; const float* sc = mod_ptr(F, 0, b, 1) + col;
            const f32x4 v0 = xa[j] * (*(const f32x4*)sc + 1.f) + *(const f32x4*)sh, v1 = xb[j] * (*(const f32x4*)(sc + 4) + 1.f) + *(const f32x4*)(sh + 4);
            u32x4 w; w.x = cvt_pk_bf16(v0[0], v0[1]); w.y = cvt_pk_bf16(v0[2], v0[3]); w.z = cvt_pk_bf16(v1[0], v1[1]); w.w = cvt_pk_bf16(v1[2], v1[3]);
            *(u32x4*)(u0 + e) = w; }
    }
}
namespace att {
constexpr int LDS_K = 0, LDS_V = 24576, LDS_WS = 49152, LDS_OST = LDS_WS + NWAVES * 64 * 4, LDS_Q = LDS_OST + NWAVES * 4096;
__device__ __forceinline__ int crow(int r, int hi) { return (r & 3) + 8 * (r >> 2) + 4 * hi; }
__device__ __forceinline__ float max3f(float a, float b, float c) { return __builtin_fmaxf(__builtin_fmaxf(a, b), c); }
__device__ __forceinline__ float rowmax(const f32x16& p0, const f32x16& p1) {
    float a = max3f(p0[0], p0[1], p1[0]), b = max3f(p0[2], p0[3], p1[1]); a = max3f(a, p1[2], p1[3]);
#pragma unroll
    for (int r = 4; r < 16; r += 4) { a = max3f(a, p0[r], p0[r + 1]); b = max3f(b, p0[r + 2], p0[r + 3]); a = max3f(a, p1[r], p1[r + 1]); b = max3f(b, p1[r + 2], p1[r + 3]); }
    const float m = __builtin_fmaxf(a, b);
    auto rr = __builtin_amdgcn_permlane32_swap(__float_as_uint(m), __float_as_uint(m), false, false);
    return __builtin_fmaxf(__uint_as_float(rr[0]), __uint_as_float(rr[1]));
}
__device__ __forceinline__ void qkt(f32x16& p0, f32x16& p1, const LAS unsigned char* Kslot, const bf16x8* qr, const f32x16& z, int r32, int hi) {
    const LAS unsigned char* kb = Kslot + hi * 1024 + r32 * 16;
#pragma unroll
    for (int d0 = 0; d0 < 4; ++d0) {
        const bf16x8 b0 = *(const LAS bf16x8*)(kb + d0 * 2048);
        const bf16x8 b1 = *(const LAS bf16x8*)(kb + d0 * 2048 + 512);
        if (d0 == 0) { p0 = __builtin_amdgcn_mfma_f32_32x32x16_bf16(b0, qr[0], z, 0, 0, 0); p1 = __builtin_amdgcn_mfma_f32_32x32x16_bf16(b1, qr[0], z, 0, 0, 0); }
        else { p0 = __builtin_amdgcn_mfma_f32_32x32x16_bf16(b0, qr[d0], p0, 0, 0, 0); p1 = __builtin_amdgcn_mfma_f32_32x32x16_bf16(b1, qr[d0], p1, 0, 0, 0); }
    }
}
__device__ __forceinline__ void pv(f32x16* o, int vb, bf16x8 pa0, bf16x8 pa1, bf16x8 pa2, bf16x8 pa3) {
#pragma unroll
    for (int d0 = 0; d0 < 2; ++d0) { s16x4 lo[4], hi[4];
#pragma unroll
        for (int ks = 0; ks < 4; ++ks) {
            asm volatile("ds_read_b64_tr_b16 %0,%1 offset:%c2" : "=&v"(lo[ks]) : "v"(vb), "i"(d0 * 4096 + ks * 1024) : "memory");
            asm volatile("ds_read_b64_tr_b16 %0,%1 offset:%c2" : "=&v"(hi[ks]) : "v"(vb), "i"(d0 * 4096 + ks * 1024 + 512) : "memory"); }
        asm volatile("s_waitcnt lgkmcnt(0)" ::: "memory"); __builtin_amdgcn_sched_barrier(0);
#define PK(k) (bf16x8){lo[k][0], lo[k][1], lo[k][2], lo[k][3], hi[k][0], hi[k][1], hi[k][2], hi[k][3]}
        o[d0] = __builtin_amdgcn_mfma_f32_32x32x16_bf16(pa0, PK(0), o[d0], 0, 0, 0);
        o[d0] = __builtin_amdgcn_mfma_f32_32x32x16_bf16(pa1, PK(1), o[d0], 0, 0, 0);
        o[d0] = __builtin_amdgcn_mfma_f32_32x32x16_bf16(pa2, PK(2), o[d0], 0, 0, 0);
        o[d0] = __builtin_amdgcn_mfma_f32_32x32x16_bf16(pa3, PK(3), o[d0], 0, 0, 0);
#undef PK
    }
}
__device__ __forceinline__ void attn_issue(const Frame& F, int u, int t, int slot) {
    const int lane = F.lane, wid = F.wave; LAS unsigned char* shm = F.lds;
    const int qb = u % (SEQ / 32), bk = u / (SEQ / 32), b = bk / NKV, kvh = bk % NKV; const int q0 = qb * 32;
    const bf16* Kb = (const bf16*)(F.ws + WS_B + 128 * MiB); const bf16* Vb = (const bf16*)(F.ws + WS_B + 144 * MiB); const bf16* CKV = (const bf16*)(F.ws + WS_CTXKV);
    const size_t tok0 = (size_t)b * SEQ; const bf16* ksrc; const bf16* vsrc;
    if (t < 4) { const int c0 = b * CTXL + t * 64;
        ksrc = CKV + (size_t)(c0 + lane) * 512 + kvh * HD + wid * 8;
        vsrc = CKV + (size_t)(c0 + 16 * (wid & 3) + (lane >> 2)) * 512 + 256 + kvh * HD + (wid >> 2) * 32 + (lane & 3) * 8;
    } else { const int key0 = ((q0 - 128) & ~63) + (t - 4) * 64;
        int kr = key0 + lane; kr = kr < 0 ? 0 : (kr > SEQ - 1 ? SEQ - 1 : kr);
        int vr = key0 + 16 * (wid & 3) + (lane >> 2); vr = vr < 0 ? 0 : (vr > SEQ - 1 ? SEQ - 1 : vr);
        ksrc = Kb + (tok0 + kr) * KVD + kvh * HD + wid * 8;
        vsrc = Vb + (tok0 + vr) * KVD + kvh * HD + (wid >> 2) * 32 + (lane & 3) * 8;
    }
    __builtin_amdgcn_global_load_lds((const unsigned*)ksrc, (LAS unsigned*)(shm + LDS_K + slot * 8192 + wid * 1024), 16, 0, 0);
    __builtin_amdgcn_global_load_lds((const unsigned*)vsrc, (LAS unsigned*)(shm + LDS_V + slot * 8192 + wid * 1024), 16, 0, 0);
    if (t == 0) {
        const bf16* Qw = (const bf16*)(F.ws + WS_B) + (tok0 + q0 + (lane & 31)) * DM + (kvh * 8 + wid) * HD + (lane >> 5) * 8;
#pragma unroll
        for (int d0 = 0; d0 < 4; ++d0) __builtin_amdgcn_global_load_lds((const unsigned*)(Qw + d0 * 16), (LAS unsigned*)(shm + LDS_Q + wid * 4096 + d0 * 1024), 16, 0, 0);
    }
}
__device__ __forceinline__ void attn_phase(const Frame& F) {
    const int NU = NB * NKV * (SEQ / 32); const int per = (NU + F.G - 1) / F.G;
    const int u0 = F.bid * per; const int u1 = (u0 + per < NU) ? u0 + per : NU; if (u0 >= u1) return;
    const int ntile = (u1 - u0) * 9;
    const int lane = F.lane, r32 = lane & 31, hi = lane >> 5, wid = F.wave;
    LAS unsigned char* shm = F.lds;
    bf16* O = (bf16*)(F.ws + WS_A);
    LAS float* wsf = (LAS float*)(shm + LDS_WS) + wid * 64;
    const int vb0 = (int)(uintptr_t)(shm + LDS_V) + ((lane >> 4) & 1) * 32 + (lane & 3) * 8 + (4 * hi + ((lane & 15) >> 2)) * 64;
    bf16x8 qr[4]; float mref = 0.f, l_reg = 0.f; f32x16 o[2]; o[0] = f32x16{}; o[1] = f32x16{}; f32x16 negm = f32x16{};
    attn_issue(F, u0, 0, 0);
    if (ntile > 1) attn_issue(F, u0, 1, 1);
    int u = u0, t = 0;
    for (int g = 0; g < ntile; ++g) {
        const int slot = g % 3;
        const int qb = u % (SEQ / 32), bk = u / (SEQ / 32), b = bk / NKV, kvh = bk % NKV; const int q0 = qb * 32; const int head = kvh * 8 + wid; const size_t tok0 = (size_t)b * SEQ;
        if (g + 1 < ntile) { if (t == 8) asm volatile("s_waitcnt vmcnt(6)" ::: "memory"); else asm volatile("s_waitcnt vmcnt(2)" ::: "memory"); }
        else asm volatile("s_waitcnt vmcnt(0)" ::: "memory");
        LDS_WAIT(); __builtin_amdgcn_s_barrier();
        if (g + 2 < ntile) { const int g2 = g + 2; attn_issue(F, u0 + g2 / 9, g2 % 9, g2 % 3); }
        if (t == 0) {
#pragma unroll
            for (int d0 = 0; d0 < 4; ++d0) qr[d0] = *(const LAS bf16x8*)(shm + LDS_Q + wid * 4096 + d0 * 1024 + lane * 16);
            mref = 0.f; l_reg = 0.f; o[0] = f32x16{}; o[1] = f32x16{}; negm = f32x16{}; }
        f32x16 p0, p1;
        qkt(p0, p1, shm + LDS_K + slot * 8192, qr, negm, r32, hi);
        { const int key0 = ((q0 - 128) & ~63) + (t - 4) * 64;
          if (t >= 4 && (t == 4 || t == 8 || key0 < 0 || key0 + 64 > SEQ)) { const int qpos = q0 + r32;
#pragma unroll
            for (int r = 0; r < 16; ++r) { const int k0 = key0 + crow(r, hi), k1 = k0 + 32;
                const bool v0 = (k0 >= 0) && (k0 < SEQ) && (k0 - qpos <= 128) && (qpos - k0 <= 128);
                const bool v1 = (k1 >= 0) && (k1 < SEQ) && (k1 - qpos <= 128) && (qpos - k1 <= 128);
                p0[r] = v0 ? p0[r] : -INFINITY; p1[r] = v1 ? p1[r] : -INFINITY; } } }
        const float rm = rowmax(p0, p1);
        if (__any(rm > 8.f)) {
            const float dl = __builtin_fmaxf(rm, 0.f); mref += dl;
            const float f = __builtin_amdgcn_exp2f(-dl); l_reg *= f;
#pragma unroll
            for (int r = 0; r < 16; ++r) { p0[r] -= dl; p1[r] -= dl; negm[r] = -mref; }
            if (hi == 0) wsf[r32] = f;
            LDS_WAIT();
#pragma unroll
            for (int d = 0; d < 2; ++d)
#pragma unroll
                for (int r = 0; r < 16; ++r) o[d][r] *= wsf[crow(r, hi)];
        }
        float sacc = 0.f;
#pragma unroll
        for (int r = 0; r < 16; ++r) { p0[r] = __builtin_amdgcn_exp2f(p0[r]); p1[r] = __builtin_amdgcn_exp2f(p1[r]); sacc += p0[r] + p1[r]; }
        l_reg += sacc;
        u32x4 pw0, pw1, pw2, pw3;
#define PKW(P, B) cvt_pk_bf16(P[B], P[B + 1])
        pw0 = (u32x4){PKW(p0, 0), PKW(p0, 2), PKW(p0, 4), PKW(p0, 6)}; pw1 = (u32x4){PKW(p0, 8), PKW(p0, 10), PKW(p0, 12), PKW(p0, 14)};
        pw2 = (u32x4){PKW(p1, 0), PKW(p1, 2), PKW(p1, 4), PKW(p1, 6)}; pw3 = (u32x4){PKW(p1, 8), PKW(p1, 10), PKW(p1, 12), PKW(p1, 14)};
#undef PKW
        pv(o, vb0 + slot * 8192, __builtin_bit_cast(bf16x8, pw0), __builtin_bit_cast(bf16x8, pw1), __builtin_bit_cast(bf16x8, pw2), __builtin_bit_cast(bf16x8, pw3));
        if (t == 8) {
            { auto rr = __builtin_amdgcn_permlane32_swap(__float_as_uint(l_reg), __float_as_uint(l_reg), false, false); l_reg = __uint_as_float(rr[0]) + __uint_as_float(rr[1]); }
            l_reg += __builtin_amdgcn_exp2f(AIN(I_SINK)[head] * 1.4426950408889634f - mref);
            if (hi == 0) wsf[32 + r32] = l_reg;
            LDS_WAIT();
            float rli[16];
#pragma unroll
            for (int r = 0; r < 16; ++r) rli[r] = 1.f / wsf[32 + crow(r, hi)];
            bf16* Ow = O + (tok0 + q0) * DM + head * HD;
            LAS bf16* stg = (LAS bf16*)(shm + LDS_OST) + wid * 2048;
#pragma unroll
            for (int r = 0; r < 16; ++r) { const int orow = crow(r, hi);
#pragma unroll
                for (int d0 = 0; d0 < 2; ++d0) stg[orow * 64 + d0 * 32 + r32] = (bf16)(cvt_pk_bf16(o[d0][r] * rli[r], 0.f) & 0xffffu); }
            LDS_WAIT();
#pragma unroll
            for (int i = 0; i < 4; ++i) { const int row = i * 8 + (lane >> 3), ch = lane & 7; const u32x4 v = *(const LAS u32x4*)(stg + row * 64 + ch * 8); *(u32x4*)(Ow + (size_t)row * DM + ch * 8) = v; }
        }
        if (t == 8) { t = 0; ++u; } else ++t;
    }
}
}

__device__ __forceinline__ float row16_sum(float v) {
    v += __builtin_bit_cast(float, __builtin_amdgcn_update_dpp(0, __builtin_bit_cast(int, v), 0xB1, 0xf, 0xf, true));
    v += __builtin_bit_cast(float, __builtin_amdgcn_update_dpp(0, __builtin_bit_cast(int, v), 0x4E, 0xf, 0xf, true));
    v += __builtin_bit_cast(float, __builtin_amdgcn_update_dpp(0, __builtin_bit_cast(int, v), 0x141, 0xf, 0xf, true));
    v += __builtin_bit_cast(float, __builtin_amdgcn_update_dpp(0, __builtin_bit_cast(int, v), 0x140, 0xf, 0xf, true));
    return v;
}
template <int NV> __device__ __forceinline__ void block_reduce(const float (&x)[NV], LAS float* red, LAS float* tot, int tid, int lane, int wave) {
    float y[NV / 2], z[NV / 4];
#pragma unroll
    for (int i = 0; i < NV / 2; ++i) { auto r = __builtin_amdgcn_permlane32_swap(__float_as_uint(x[i]), __float_as_uint(x[i + NV / 2]), false, false); y[i] = __uint_as_float(r[0]) + __uint_as_float(r[1]); }
#pragma unroll
    for (int i = 0; i < NV / 4; ++i) { auto r = __builtin_amdgcn_permlane16_swap(__float_as_uint(y[i]), __float_as_uint(y[i + NV / 4]), false, false); z[i] = row16_sum(__uint_as_float(r[0]) + __uint_as_float(r[1])); }
    if ((lane & 15) == 0) { const int q = lane >> 4;
#pragma unroll
        for (int i = 0; i < NV / 4; ++i) red[wave * NV + i + q * (NV / 4)] = z[i]; }
    __syncthreads();
    if (tid < NV) { float s = 0.f;
#pragma unroll
        for (int w = 0; w < NWAVES; ++w) s += red[w * NV + tid];
        tot[tid] = s; }
    __syncthreads();
}
struct LnLds { LAS float* red; LAS float* tot; LAS float* sab; LAS int* lcnt; LAS int* lbase; LAS int* lcls; LAS int* lrank; LAS float* lg; LAS float* rowtab; };
__device__ __forceinline__ LnLds ln_lds(const Frame& F) { LnLds L; L.red = (LAS float*)F.lds; L.tot = L.red + 8 * 72; L.sab = L.tot + 72; L.lcnt = (LAS int*)(L.sab + 32); L.lbase = L.lcnt + 32; L.lcls = L.lbase + 32; L.lrank = L.lcls + 256; L.lg = (LAS float*)(L.lrank + 256); L.rowtab = L.lg + 512; return L; }

template <bool HIN_F32> __device__ __forceinline__ void ln1_router_phase(const Frame& F, int layer, const void* hin_, const bf16* ymix, bf16* u2out, bf16* hout) {
    const float* hin = (const float*)hin_; const bf16* hinb = (const bf16*)hin_;
    const LnLds L = ln_lds(F);
    const int tid = F.tid, lane = F.lane, wave = F.wave, c0 = 4 * tid;
    int per = (MTOK + F.G - 1) / F.G; per = (per + 3) & ~3;
    const int rbase = F.bid * per; const int rend = (rbase + per < MTOK) ? rbase + per : MTOK; const int nrows = rend - rbase;
    if (tid < NCLS) L.lcnt[tid] = 0;
    if (nrows > 0 && nrows <= 256) {
    const int b = rbase / SEQ;
    const f32x4 g1 = *(const f32x4*)(mod_ptr(F, layer, b, 2) + c0), sh2 = *(const f32x4*)(mod_ptr(F, layer, b, 3) + c0), sc2 = *(const f32x4*)(mod_ptr(F, layer, b, 4) + c0);
    const f32x4 A0 = *(const f32x4*)(AIN(I_LN1G) + layer * DM + c0), B0 = *(const f32x4*)(AIN(I_LN1B) + layer * DM + c0);
    const f32x4 A1 = A0 * (sc2 + 1.f), B1 = B0 * (sc2 + 1.f) + sh2;
    const int scol = ((const int*)(F.ws + WS_BADMAP + 32768))[(layer * 2 + b) * 64 + lane];
    const bool smine = (scol >= 0) && ((scol >> 8) == wave);
    const int sidx = 4 * ((scol >> 2) & 63), ssel = scol & 3;
    unsigned short* sbase = smine ? (unsigned short*)(F.ws + WS_SIDE) + lane : (unsigned short*)(F.ws + WS_SIDE + 4 * MiB) + (size_t)(F.bid * 8 + wave) * 64 + lane;
    const size_t sstride = smine ? 64 : 0;
    f32x4 P[4][4];
    { float sx[32];
#pragma unroll
      for (int c = 0; c < 4; ++c)
#pragma unroll
          for (int g = 0; g < 4; ++g) { const f32x4 w = *(const f32x4*)(AIN(I_RW) + (size_t)(c0 + c) * NEXP + 4 * g); P[c][g] = w * A1[c];
#pragma unroll
              for (int i = 0; i < 4; ++i) { if (c == 0) { sx[g * 4 + i] = 0.f; sx[16 + g * 4 + i] = 0.f; } sx[g * 4 + i] += w[i] * A1[c]; sx[16 + g * 4 + i] += w[i] * B1[c]; } }
      block_reduce<32>(sx, L.red, L.tot, tid, lane, wave);
      if (tid < 32) L.sab[tid] = L.tot[tid];
      __syncthreads(); }
    const float* rb = AIN(I_RB);
    f32x4 hv[4], hv2[4]; u32x2 yv[4], yv2[4];
#define LN_LOADH(dst, o) do { if (HIN_F32) dst = *(const f32x4*)(hin + (o)); else { const u32x2 hw_ = *(const u32x2*)(hinb + (o)); dst = (f32x4){bflo(hw_.x), bfhi(hw_.x), bflo(hw_.y), bfhi(hw_.y)}; } } while (0)
#pragma unroll
    for (int r = 0; r < 4; ++r) { const size_t o = (size_t)(rbase + r) * DM + c0; LN_LOADH(hv[r], o); yv[r] = *(const u32x2*)(ymix + o); }
    if (rbase + 4 < rend) {
#pragma unroll
        for (int r = 0; r < 4; ++r) { const size_t o = (size_t)(rbase + 4 + r) * DM + c0; LN_LOADH(hv2[r], o); yv2[r] = *(const u32x2*)(ymix + o); } }
    for (int row0 = rbase; row0 < rend; row0 += 4) {
        f32x4 v[4]; float x[72];
#pragma unroll
        for (int r = 0; r < 4; ++r) { const f32x4 y = {bflo(yv[r].x), bfhi(yv[r].x), bflo(yv[r].y), bfhi(yv[r].y)}; v[r] = hv[r] * DN_ALPHA + g1 * y;
            x[r * 18] = (v[r][0] + v[r][1]) + (v[r][2] + v[r][3]); x[r * 18 + 1] = (v[r][0] * v[r][0] + v[r][1] * v[r][1]) + (v[r][2] * v[r][2] + v[r][3] * v[r][3]);
#pragma unroll
            for (int g = 0; g < 4; ++g) { const f32x4 q = P[0][g] * v[r][0] + P[1][g] * v[r][1] + P[2][g] * v[r][2] + P[3][g] * v[r][3];
                x[r * 18 + 2 + 4 * g] = q[0]; x[r * 18 + 3 + 4 * g] = q[1]; x[r * 18 + 4 + 4 * g] = q[2]; x[r * 18 + 5 + 4 * g] = q[3]; } }
#pragma unroll
        for (int r = 0; r < 4; ++r) { hv[r] = hv2[r]; yv[r] = yv2[r]; }
        if (row0 + 8 < rend) {
#pragma unroll
            for (int r = 0; r < 4; ++r) { const size_t o = (size_t)(row0 + 8 + r) * DM + c0; LN_LOADH(hv2[r], o); yv2[r] = *(const u32x2*)(ymix + o); } }
        LAS float* gt = L.rowtab + ((row0 - rbase) >> 2) * 72;
        block_reduce<72>(x, L.red, gt, tid, lane, wave);
#pragma unroll
        for (int r = 0; r < 4; ++r) { const float mean = gt[r * 18] * (1.f / DM); const float var = gt[r * 18 + 1] * (1.f / DM) - mean * mean; const float rstd = 1.f / sqrtf(var + LN_EPS);
            const f32x4 vn = (v[r] - mean) * rstd; const f32x4 u = vn * A1 + B1; const size_t o = (size_t)(row0 + r) * DM + c0;
            { const f32x4 hn = vn * A0 + B0; const int w0 = (int)cvt_pk_bf16(hn[0], hn[1]), w1 = (int)cvt_pk_bf16(hn[2], hn[3]);
              const unsigned q0 = (unsigned)__builtin_amdgcn_ds_bpermute(sidx, w0), q1 = (unsigned)__builtin_amdgcn_ds_bpermute(sidx, w1); const unsigned qq = (ssel & 2) ? q1 : q0;
              sbase[(size_t)(row0 + r) * sstride] = (unsigned short)((ssel & 1) ? (qq >> 16) : qq); }
            u32x2 w; w.x = cvt_pk_bf16(u[0], u[1]); w.y = cvt_pk_bf16(u[2], u[3]); *(u32x2*)(u2out + o) = w; }
    }
    __syncthreads();
    if (tid < nrows) {
            const int rl = tid; const LAS float* gt = L.rowtab + (rl >> 2) * 72 + (rl & 3) * 18;
            const float mean = gt[0] * (1.f / DM); const float var = gt[1] * (1.f / DM) - mean * mean; const float rstd = 1.f / sqrtf(var + LN_EPS);
            float sg[16], sel[16];
#pragma unroll
            for (int e = 0; e < 16; ++e) { const float lgt = rstd * (gt[2 + e] - mean * L.sab[e]) + L.sab[16 + e]; const float sv = 1.f / (1.f + expf(-lgt)); sg[e] = sv; sel[e] = sv + rb[e]; }
            int gb = 0; float gbs = -INFINITY;
#pragma unroll
            for (int g = 0; g < 4; ++g) { const float a = sel[4 * g], bq = sel[4 * g + 1], c = sel[4 * g + 2], d = sel[4 * g + 3];
                const float ps = fmaxf(fmaxf(fmaxf(a + bq, a + c), fmaxf(a + d, bq + c)), fmaxf(bq + d, c + d)); if (ps > gbs) { gbs = ps; gb = g; } }
            float cs[4], cg[4];
#pragma unroll
            for (int i = 0; i < 4; ++i) { cs[i] = sel[i]; cg[i] = sg[i];
#pragma unroll
                for (int g = 1; g < 4; ++g) if (gb == g) { cs[i] = sel[4 * g + i]; cg[i] = sg[4 * g + i]; } }
            int i0 = 0; float b0 = cs[0];
#pragma unroll
            for (int i = 1; i < 4; ++i) if (cs[i] > b0) { b0 = cs[i]; i0 = i; }
            int i1 = -1; float b1 = -INFINITY;
#pragma unroll
            for (int i = 0; i < 4; ++i) if (i != i0 && cs[i] > b1) { b1 = cs[i]; i1 = i; }
            float ga = 0.f, gbv = 0.f;
#pragma unroll
            for (int i = 0; i < 4; ++i) { if (i == i0) ga = cg[i]; if (i == i1) gbv = cg[i]; }
            const float den = ga + gbv; ga /= den; gbv /= den;
            const int lo = i0 < i1 ? i0 : i1, hi = i0 < i1 ? i1 : i0; const float glo = i0 < i1 ? ga : gbv, ghi = i0 < i1 ? gbv : ga;
            const int pidx = (lo == 0) ? (hi - 1) : (lo == 1 ? hi + 1 : 5);
            const int cls = gb * 6 + pidx;
            L.lcls[rl] = cls; L.lrank[rl] = __hip_atomic_fetch_add(&L.lcnt[cls], 1, __ATOMIC_RELAXED, __HIP_MEMORY_SCOPE_WORKGROUP); L.lg[2 * rl] = glo; L.lg[2 * rl + 1] = ghi;
    }
    }
    __syncthreads();
    if (tid < NCLS) L.lbase[tid] = (int)__hip_atomic_fetch_add((unsigned*)(F.ctl + CW_CNT + (layer * NCLS + tid) * 64), (unsigned)L.lcnt[tid], RLX_AGENT);
    __syncthreads();
    if (tid < nrows && nrows <= 256) { const int cls = L.lcls[tid]; const int pos = cls * LCAP + L.lbase[cls] + L.lrank[tid];
        ((int*)(F.ws + WS_TOK))[pos] = rbase + tid; ((float*)(F.ws + WS_GATE))[(size_t)pos * 2] = L.lg[2 * tid]; ((float*)(F.ws + WS_GATE))[(size_t)pos * 2 + 1] = L.lg[2 * tid + 1]; }
}
#undef LN_LOADH
template <bool OUT_F32> __device__ __forceinline__ void ln2_phase(const Frame& F, int layer, const bf16* fio, bf16* hinb, void* hout_) {
    float* houtf = (float*)hout_; bf16* houtb = (bf16*)hout_;
    const LnLds L = ln_lds(F);
    const int tid = F.tid, lane = F.lane, wave = F.wave, c0 = 4 * tid;
    int per = (MTOK + F.G - 1) / F.G; per = (per + 3) & ~3;
    const int rbase = F.bid * per; const int rend = (rbase + per < MTOK) ? rbase + per : MTOK;
    if (rbase >= rend) return;
    const int b = rbase / SEQ;
    const f32x4 g2 = *(const f32x4*)(mod_ptr(F, layer, b, 5) + c0), sh1 = *(const f32x4*)(mod_ptr(F, 1, b, 0) + c0), sc1 = *(const f32x4*)(mod_ptr(F, 1, b, 1) + c0);
    const f32x4 A0 = *(const f32x4*)(AIN(I_LN2G) + layer * DM + c0), B0 = *(const f32x4*)(AIN(I_LN2B) + layer * DM + c0);
    const f32x4 A1 = A0 * (sc1 + 1.f), B1 = B0 * (sc1 + 1.f) + sh1;
    const f32x4 sh2 = *(const f32x4*)(mod_ptr(F, layer, b, 3) + c0), sc2p = *(const f32x4*)(mod_ptr(F, layer, b, 4) + c0) + 1.f;
    f32x4 rs2; for (int i = 0; i < 4; ++i) rs2[i] = (fabsf(sc2p[i]) > 1e-6f) ? 1.f / sc2p[i] : 0.f;
    int bslot[4]; { const int* map = (const int*)(F.ws + WS_BADMAP) + (size_t)(layer * 2 + b) * DM + c0;
#pragma unroll
      for (int i = 0; i < 4; ++i) bslot[i] = map[i]; }
    const unsigned short* sidel = (const unsigned short*)(F.ws + WS_SIDE) + lane;
    int bidx[4];
#pragma unroll
    for (int i = 0; i < 4; ++i) bidx[i] = 4 * (bslot[i] < 0 ? 0 : bslot[i]);
    u32x2 hw[4], hw2[4], hw3[4]; u32x2 yv[4], yv2[4], yv3[4]; unsigned short sv[4], sv2[4], sv3[4];
#pragma unroll
    for (int r = 0; r < 4; ++r) { const size_t o = (size_t)(rbase + r) * DM + c0; hw[r] = *(const u32x2*)(hinb + o); yv[r] = *(const u32x2*)(fio + o); sv[r] = sidel[(size_t)(rbase + r) * 64]; }
#pragma unroll
    for (int r = 0; r < 4; ++r) { const size_t o = (size_t)(rbase + 4 + r) * DM + c0; if (rbase + 4 < rend) { hw2[r] = *(const u32x2*)(hinb + o); yv2[r] = *(const u32x2*)(fio + o); sv2[r] = sidel[(size_t)(rbase + 4 + r) * 64]; } }
#pragma unroll
    for (int r = 0; r < 4; ++r) { const size_t o = (size_t)(rbase + 8 + r) * DM + c0; if (rbase + 8 < rend) { hw3[r] = *(const u32x2*)(hinb + o); yv3[r] = *(const u32x2*)(fio + o); sv3[r] = sidel[(size_t)(rbase + 8 + r) * 64]; } }
    for (int row0 = rbase; row0 < rend; row0 += 4) {
        f32x4 v[4]; float x[8];
        const int p0 = (int)((unsigned)sv[0] | ((unsigned)sv[1] << 16)), p1 = (int)((unsigned)sv[2] | ((unsigned)sv[3] << 16));
        unsigned t0[4], t1[4];
#pragma unroll
        for (int i = 0; i < 4; ++i) { t0[i] = (unsigned)__builtin_amdgcn_ds_bpermute(bidx[i], p0); t1[i] = (unsigned)__builtin_amdgcn_ds_bpermute(bidx[i], p1); }
#pragma unroll
        for (int r = 0; r < 4; ++r) { const f32x4 y = {bflo(yv[r].x), bfhi(yv[r].x), bflo(yv[r].y), bfhi(yv[r].y)}; const f32x4 uvr = {bflo(hw[r].x), bfhi(hw[r].x), bflo(hw[r].y), bfhi(hw[r].y)}; f32x4 hvr = (uvr - sh2) * rs2;
#pragma unroll
            for (int i = 0; i < 4; ++i) { const unsigned t = (r < 2) ? t0[i] : t1[i]; const float sf = (r & 1) ? bfhi(t) : bflo(t); hvr[i] = (bslot[i] >= 0) ? sf : hvr[i]; }
            v[r] = hvr * DN_ALPHA + g2 * y;
            x[r * 2] = (v[r][0] + v[r][1]) + (v[r][2] + v[r][3]); x[r * 2 + 1] = (v[r][0] * v[r][0] + v[r][1] * v[r][1]) + (v[r][2] * v[r][2] + v[r][3] * v[r][3]); }
#pragma unroll
        for (int r = 0; r < 4; ++r) { hw[r] = hw2[r]; yv[r] = yv2[r]; hw2[r] = hw3[r]; yv2[r] = yv3[r]; sv[r] = sv2[r]; sv2[r] = sv3[r]; }
        if (row0 + 12 < rend) {
#pragma unroll
            for (int r = 0; r < 4; ++r) { const size_t o = (size_t)(row0 + 12 + r) * DM + c0; hw3[r] = *(const u32x2*)(hinb + o); yv3[r] = *(const u32x2*)(fio + o); sv3[r] = sidel[(size_t)(row0 + 12 + r) * 64]; } }
        block_reduce<8>(x, L.red, L.tot, tid, lane, wave);
#pragma unroll
        for (int r = 0; r < 4; ++r) { const float mean = L.tot[r * 2] * (1.f / DM); const float var = L.tot[r * 2 + 1] * (1.f / DM) - mean * mean; const float rstd = 1.f / sqrtf(var + LN_EPS);
            const f32x4 vn = (v[r] - mean) * rstd; const f32x4 hn = vn * A0 + B0; const size_t o = (size_t)(row0 + r) * DM + c0;
            if (OUT_F32) *(f32x4*)(houtf + o) = hn; else { u32x2 hw; hw.x = cvt_pk_bf16(hn[0], hn[1]); hw.y = cvt_pk_bf16(hn[2], hn[3]); *(u32x2*)(houtb + o) = hw; }
            if (layer == 0) { const f32x4 u = vn * A1 + B1; u32x2 w; w.x = cvt_pk_bf16(u[0], u[1]); w.y = cvt_pk_bf16(u[2], u[3]); *(u32x2*)(hinb + o) = w; } }
    }
}
namespace hy {
constexpr int L = SEQ;
__device__ constexpr float C32[16] = {1.000000000e+00f, 9.807852804e-01f, 9.238795325e-01f, 8.314696123e-01f, 7.071067812e-01f, 5.555702330e-01f, 3.826834324e-01f, 1.950903220e-01f,
                                      0.f, -1.950903220e-01f, -3.826834324e-01f, -5.555702330e-01f, -7.071067812e-01f, -8.314696123e-01f, -9.238795325e-01f, -9.807852804e-01f};
__device__ constexpr float S32[16] = {0.f, 1.950903220e-01f, 3.826834324e-01f, 5.555702330e-01f, 7.071067812e-01f, 8.314696123e-01f, 9.238795325e-01f, 9.807852804e-01f,
                                      1.f, 9.807852804e-01f, 9.238795325e-01f, 8.314696123e-01f, 7.071067812e-01f, 5.555702330e-01f, 3.826834324e-01f, 1.950903220e-01f};
__host__ __device__ constexpr int brev(int k, int bits) { int r = 0; for (int i = 0; i < bits; ++i) r |= ((k >> i) & 1) << (bits - 1 - i); return r; }
__device__ __forceinline__ void unit_root(float frac, bool inv, float& wr, float& wi) {
    wr = __builtin_amdgcn_cosf(frac); float s = __builtin_amdgcn_sinf(frac);
    asm volatile("s_nop 1" : "+v"(wr), "+v"(s));
    wi = inv ? s : -s;
}
constexpr int FT_F32 = 0, FT_I32 = 8, FT_I32P = 16, FT_F16 = 24, FT_I16 = 26, FT_NFRAG = 28;
__device__ __forceinline__ int crow(int r, int h) { return (r & 3) + 8 * (r >> 2) + 4 * h; }
__device__ __forceinline__ bf16x8 pack8(const float (&v)[8]) { u32x4 w; w.x = cvt_pk_bf16(v[0], v[1]); w.y = cvt_pk_bf16(v[2], v[3]); w.z = cvt_pk_bf16(v[4], v[5]); w.w = cvt_pk_bf16(v[6], v[7]); return __builtin_bit_cast(bf16x8, w); }
__device__ __forceinline__ void cmul(float& xr, float& xi, float wr, float wi) {
    float t0, t1, nr, ni;
    asm("v_mul_f32_e32 %0, %1, %2" : "=v"(t0) : "v"(xi), "v"(wi));
    asm("v_mul_f32_e32 %0, %1, %2" : "=v"(t1) : "v"(xi), "v"(wr));
    asm("v_fma_f32 %0, %1, %2, -%3" : "=v"(nr) : "v"(xr), "v"(wr), "v"(t0));
    asm("v_fma_f32 %0, %1, %2, %3" : "=v"(ni) : "v"(xr), "v"(wi), "v"(t1));
    xr = nr; xi = ni;
}
#define FRAG(f) (tab[(f) * 64 + lane])
template <bool INV> __device__ __forceinline__ void pass1(LAS f32x2* dat, const LAS bf16x8* tab, int lane, int wave) {
    asm volatile("" : "+v"(lane));
    const int h = lane >> 5, c5 = lane & 31;
    const bf16x8 a0 = FRAG((INV ? FT_I16 : FT_F16) + 0), a1 = FRAG((INV ? FT_I16 : FT_F16) + 1);
#pragma unroll 1
    for (int g = 0; g < 4; ++g) {
        const int col = 128 * wave + 32 * g + c5; const int pc = col ^ ((4 * wave + g) & 31) ^ ((2 * g + (c5 >> 4)) & 7);
        float wr, wi; unit_root((float)col * (1.f / 16384.f), INV, wr, wi);
        float w2r = wr, w2i = wi; cmul(w2r, w2i, wr, wi); float w4r = w2r, w4i = w2i; cmul(w4r, w4i, w2r, w2i); float w8r = w4r, w8i = w4i; cmul(w8r, w8i, w4r, w4i);
        float re[8], im[8];
#pragma unroll
        for (int jj = 0; jj < 8; ++jj) { const f32x2 v = dat[pc + 1024 * (8 * h + jj)]; re[jj] = v.x; im[jj] = v.y; }
        if (INV) {
            float cr = h ? w8r : 1.f, ci = h ? w8i : 0.f;
#pragma unroll
            for (int jj = 0; jj < 8; ++jj) { cmul(re[jj], im[jj], cr, ci); cmul(cr, ci, wr, wi); }
        }
        const f32x16 z = {};
        f32x16 d = __builtin_amdgcn_mfma_f32_32x32x16_bf16(a0, pack8(re), z, 0, 0, 0);
        d = __builtin_amdgcn_mfma_f32_32x32x16_bf16(a1, pack8(im), d, 0, 0, 0);
        asm volatile("s_nop 15\n\ts_nop 7" : "+v"(d));
        float cr = h ? w4r : 1.f, ci = h ? w4i : 0.f;
#pragma unroll
        for (int rr = 0; rr < 8; ++rr) { float xr = d[rr], xi = d[rr + 8];
            if (!INV) { if (rr == 4) { cr = h ? w4r : 1.f; ci = h ? w4i : 0.f; cmul(cr, ci, w8r, w8i); } cmul(xr, xi, cr, ci); cmul(cr, ci, wr, wi); }
            f32x2 o; o.x = xr; o.y = xi; dat[pc + 1024 * ((rr & 3) + 8 * (rr >> 2) + 4 * h)] = o; }
    }
}
template <bool INV> __device__ __forceinline__ void pass2(LAS f32x2* dat, const LAS bf16x8* tab, int lane, int wave) {
    asm volatile("" : "+v"(lane));
    const int h = lane >> 5, b = lane & 31, bp = b ^ (b >> 4);
    float wr, wi; unit_root((float)b * (1.f / 1024.f), INV, wr, wi);
    float w2r = wr, w2i = wi; cmul(w2r, w2i, wr, wi); float w4r = w2r, w4i = w2i; cmul(w4r, w4i, w2r, w2i); float w8r = w4r, w8i = w4i; cmul(w8r, w8i, w4r, w4i); float w16r = w8r, w16i = w8i; cmul(w16r, w16i, w8r, w8i);
#pragma unroll 1
    for (int g = 0; g < 2; ++g) {
        const int base = (2 * wave + g) * 1024;
        float re[2][8], im[2][8];
#pragma unroll
        for (int hf = 0; hf < 2; ++hf)
#pragma unroll
            for (int jj = 0; jj < 8; ++jj) { const int n = 16 * hf + 8 * h + jj; const f32x2 v = dat[base + 32 * n + (bp ^ (16 * hf + 8 * h + (jj ^ ((2 * jj) & 7))))]; re[hf][jj] = v.x; im[hf][jj] = v.y; }
        if (INV) {
            float cr = h ? w8r : 1.f, ci = h ? w8i : 0.f;
#pragma unroll
            for (int jj = 0; jj < 8; ++jj) { cmul(re[0][jj], im[0][jj], cr, ci); float dr = cr, di = ci; cmul(dr, di, w16r, w16i); cmul(re[1][jj], im[1][jj], dr, di); cmul(cr, ci, wr, wi); }
        }
        const bf16x8 b0 = pack8(re[0]), b1 = pack8(re[1]), b2 = pack8(im[0]), b3 = pack8(im[1]);
        const int fb = INV ? FT_I32 : FT_F32; const f32x16 z = {};
        f32x16 dre = __builtin_amdgcn_mfma_f32_32x32x16_bf16(FRAG(fb + 0), b0, z, 0, 0, 0); f32x16 dim = __builtin_amdgcn_mfma_f32_32x32x16_bf16(FRAG(fb + 4), b0, z, 0, 0, 0);
        dre = __builtin_amdgcn_mfma_f32_32x32x16_bf16(FRAG(fb + 1), b1, dre, 0, 0, 0); dim = __builtin_amdgcn_mfma_f32_32x32x16_bf16(FRAG(fb + 5), b1, dim, 0, 0, 0);
        dre = __builtin_amdgcn_mfma_f32_32x32x16_bf16(FRAG(fb + 2), b2, dre, 0, 0, 0); dim = __builtin_amdgcn_mfma_f32_32x32x16_bf16(FRAG(fb + 6), b2, dim, 0, 0, 0);
        dre = __builtin_amdgcn_mfma_f32_32x32x16_bf16(FRAG(fb + 3), b3, dre, 0, 0, 0); dim = __builtin_amdgcn_mfma_f32_32x32x16_bf16(FRAG(fb + 7), b3, dim, 0, 0, 0);
        asm volatile("s_nop 15\n\ts_nop 7" : "+v"(dre), "+v"(dim));
        float gr = h ? w4r : 1.f, gi = h ? w4i : 0.f;
#pragma unroll
        for (int r = 0; r < 16; ++r) { float xr = dre[r], xi = dim[r]; const int kf = (r & 3) + 8 * (r >> 2) + 4 * h;
            if (!INV) { float cr = gr, ci = gi; if ((r & 3) == 1) cmul(cr, ci, wr, wi); if ((r & 3) == 2) cmul(cr, ci, w2r, w2i); if ((r & 3) == 3) { cmul(cr, ci, w2r, w2i); cmul(cr, ci, wr, wi); }
                cmul(xr, xi, cr, ci); if ((r & 3) == 3) cmul(gr, gi, w8r, w8i); }
            f32x2 o; o.x = xr; o.y = xi; dat[base + 32 * kf + (bp ^ kf ^ (2 * (r & 3)))] = o; }
    }
}
template <bool FILTER> __device__ __forceinline__ void pass3(LAS f32x2* dat, const LAS bf16x8* tab, int lane, int wave, const int g, f32x2* Kbuf, const f32x2 (&kpre)[16]) {
    asm volatile("" : "+v"(lane));
    const int h = lane >> 5, sw = lane & 31, swp = sw ^ (2 * (sw & 3));
    {
        const int q = 64 * wave + 32 * g + sw, base = 32 * q;
        float re[2][8], im[2][8];
#pragma unroll
        for (int hf = 0; hf < 2; ++hf)
#pragma unroll
            for (int jj = 0; jj < 8; ++jj) { const int n = 16 * hf + 8 * h + jj; const f32x2 v = dat[base + (n ^ swp ^ hf)]; re[hf][jj] = v.x; im[hf][jj] = v.y; }
        const bf16x8 b0 = pack8(re[0]), b1 = pack8(re[1]), b2 = pack8(im[0]), b3 = pack8(im[1]);
        const f32x16 z = {};
        f32x16 dre = __builtin_amdgcn_mfma_f32_32x32x16_bf16(FRAG(FT_F32 + 0), b0, z, 0, 0, 0); f32x16 dim = __builtin_amdgcn_mfma_f32_32x32x16_bf16(FRAG(FT_F32 + 4), b0, z, 0, 0, 0);
        dre = __builtin_amdgcn_mfma_f32_32x32x16_bf16(FRAG(FT_F32 + 1), b1, dre, 0, 0, 0); dim = __builtin_amdgcn_mfma_f32_32x32x16_bf16(FRAG(FT_F32 + 5), b1, dim, 0, 0, 0);
        dre = __builtin_amdgcn_mfma_f32_32x32x16_bf16(FRAG(FT_F32 + 2), b2, dre, 0, 0, 0); dim = __builtin_amdgcn_mfma_f32_32x32x16_bf16(FRAG(FT_F32 + 6), b2, dim, 0, 0, 0);
        dre = __builtin_amdgcn_mfma_f32_32x32x16_bf16(FRAG(FT_F32 + 3), b3, dre, 0, 0, 0); dim = __builtin_amdgcn_mfma_f32_32x32x16_bf16(FRAG(FT_F32 + 7), b3, dim, 0, 0, 0);
        asm volatile("s_nop 15\n\ts_nop 7" : "+v"(dre), "+v"(dim));
        if (FILTER) {
#pragma unroll
            for (int r = 0; r < 16; ++r) { f32x2 o; o.x = dre[r]; o.y = dim[r]; Kbuf[((r & 3) + 8 * (r >> 2) + 4 * h) * 512 + q] = o; }
        } else {
            float yr[16], yi[16];
#pragma unroll
            for (int r = 0; r < 16; ++r) { const f32x2 kv = kpre[r]; float a_ = dre[r], b_ = dim[r]; cmul(a_, b_, kv.x, kv.y); yr[r] = a_; yi[r] = b_; }
            float t0[8], t1[8], t2[8], t3[8];
#pragma unroll
            for (int j = 0; j < 8; ++j) { t0[j] = yr[j]; t1[j] = yr[8 + j]; t2[j] = yi[j]; t3[j] = yi[8 + j]; }
            const bf16x8 c0 = pack8(t0), c1 = pack8(t1), c2 = pack8(t2), c3 = pack8(t3);
            f32x16 ere = __builtin_amdgcn_mfma_f32_32x32x16_bf16(FRAG(FT_I32P + 0), c0, z, 0, 0, 0); f32x16 eim = __builtin_amdgcn_mfma_f32_32x32x16_bf16(FRAG(FT_I32P + 4), c0, z, 0, 0, 0);
            ere = __builtin_amdgcn_mfma_f32_32x32x16_bf16(FRAG(FT_I32P + 1), c1, ere, 0, 0, 0); eim = __builtin_amdgcn_mfma_f32_32x32x16_bf16(FRAG(FT_I32P + 5), c1, eim, 0, 0, 0);
            ere = __builtin_amdgcn_mfma_f32_32x32x16_bf16(FRAG(FT_I32P + 2), c2, ere, 0, 0, 0); eim = __builtin_amdgcn_mfma_f32_32x32x16_bf16(FRAG(FT_I32P + 6), c2, eim, 0, 0, 0);
            ere = __builtin_amdgcn_mfma_f32_32x32x16_bf16(FRAG(FT_I32P + 3), c3, ere, 0, 0, 0); eim = __builtin_amdgcn_mfma_f32_32x32x16_bf16(FRAG(FT_I32P + 7), c3, eim, 0, 0, 0);
#pragma unroll
            for (int r = 0; r < 16; ++r) { f32x2 o; o.x = ere[r]; o.y = eim[r]; dat[base + ((((r & 3) + 8 * (r >> 2) + 4 * h)) ^ swp ^ (r >> 3))] = o; }
        }
    }
}
#undef FRAG
__device__ __forceinline__ float ftab_value(int f, int l, int jj) {
    const int r = l & 31, h = l >> 5;
    if (f < 24) {
        const int kind = f >> 3, rb = (f >> 2) & 1, s = f & 3; int kk, pp;
        if (kind < 2) { kk = 16 * (s & 1) + 8 * h + jj; pp = s >> 1; } else { kk = 16 * (s & 1) + 8 * (jj >> 2) + 4 * h + (jj & 3); pp = s >> 1; }
        const float th = 6.283185307179586f * (float)((r * kk) & 31) * (1.f / 32.f); const float c = cosf(th), sn = sinf(th);
        if (kind == 0) return rb == 0 ? (pp == 0 ? c : sn) : (pp == 0 ? -sn : c);
        return rb == 0 ? (pp == 0 ? c : -sn) : (pp == 0 ? sn : c);
    }
    const int inv = (f - 24) >> 1, s = (f - 24) & 1; const int part = r >> 4, kf = r & 15, n = 8 * h + jj;
    const float th = 6.283185307179586f * (float)((kf * n) & 15) * (1.f / 16.f); const float c = cosf(th), sn = sinf(th);
    if (!inv) return part == 0 ? (s == 0 ? c : sn) : (s == 0 ? -sn : c);
    return part == 0 ? (s == 0 ? c : -sn) : (s == 0 ? sn : c);
}
__device__ __forceinline__ int phys(int p) { return p ^ ((p >> 5) & 31) ^ ((p >> 4) & 7); }
__device__ __forceinline__ void unpack8(const u32x4 v, float (&f)[8]) { f[0] = bflo(v.x); f[1] = bfhi(v.x); f[2] = bflo(v.y); f[3] = bfhi(v.y); f[4] = bflo(v.z); f[5] = bfhi(v.z); f[6] = bflo(v.w); f[7] = bfhi(v.w); }
struct Raw8 { u32x4 v; unsigned l, r; };
__device__ __forceinline__ Raw8 load_raw8(const bf16* rowp, int t0) { Raw8 q; q.v = *(const u32x4*)(rowp + t0); q.l = (t0 > 0) ? (unsigned)rowp[t0 - 1] : 0u; q.r = (t0 + 8 < L) ? (unsigned)rowp[t0 + 8] : 0u; return q; }
__device__ __forceinline__ void conv8(const Raw8& q, float w0, float w1, float w2, float cb, float (&o)[8]) {
    float f[8]; unpack8(q.v, f); const float left = bf2f(q.l), right = bf2f(q.r);
#pragma unroll
    for (int e = 0; e < 8; ++e) { const float a = (e == 0) ? left : f[e - 1], c = (e == 7) ? right : f[e + 1]; o[e] = w0 * a + w1 * f[e] + w2 * c + cb; }
}
typedef const LAS float* ChanPar;
struct RawZ { Raw8 x[2], v[2]; };
__device__ __forceinline__ RawZ load_rawz(const bf16* pT, int d, int t0) { RawZ q;
#pragma unroll
    for (int bt = 0; bt < 2; ++bt) { q.x[bt] = load_raw8(pT + (size_t)(DM + d) * MTOK + bt * L, t0); q.v[bt] = load_raw8(pT + (size_t)(2 * DM + d) * MTOK + bt * L, t0); }
    return q; }
__device__ __forceinline__ void z_from_raw(const RawZ& q, ChanPar P, float (&z0)[8], float (&z1)[8]) {
#pragma unroll
    for (int bt = 0; bt < 2; ++bt) { float a[8], v[8];
        conv8(q.x[bt], P[4], P[5], P[6], P[7], a); conv8(q.v[bt], P[8], P[9], P[10], P[11], v);
#pragma unroll
        for (int e = 0; e < 8; ++e) { if (bt == 0) z0[e] = a[e] * v[e]; else z1[e] = a[e] * v[e]; } }
}
struct RawF { u32x4 hf, hb; unsigned first; };
__device__ __forceinline__ RawF load_rawf(const bf16* HT, int d, int t0) { RawF q; q.hf = *(const u32x4*)(HT + (size_t)d * L + t0); q.hb = *(const u32x4*)(HT + (size_t)(DM + d) * L + (L - t0 - 8));
    q.first = (t0 > 0) ? (unsigned)HT[(size_t)(DM + d) * L + (L - t0)] : 0u; return q; }
__device__ __forceinline__ void filt8(const RawF& q, int t0, ChanPar P, float (&k)[8], float (&kl)[8], float& l1p) {
    float hf[8], hb[8]; unpack8(q.hf, hf); unpack8(q.hb, hb);
    float s = 0.f;
#pragma unroll
    for (int e = 0; e < 8; ++e) { const float dc = __builtin_amdgcn_exp2f(-(float)(t0 + e) * P[13]); k[e] = hf[e] * dc; s += fabsf(k[e]); }
    float hbd[8];
#pragma unroll
    for (int e = 0; e < 8; ++e) { const int m = L - t0 - 8 + e; const float dc = __builtin_amdgcn_exp2f(-(float)m * P[13]); hbd[e] = hb[e] * dc; if (m >= 1) s += fabsf(hbd[e]); }
    kl[0] = (t0 > 0) ? bf2f(q.first) * __builtin_amdgcn_exp2f(-(float)(L - t0) * P[13]) : 0.f;
#pragma unroll
    for (int e = 1; e < 8; ++e) kl[e] = hbd[8 - e];
#pragma unroll
    for (int e = 0; e < 8; ++e) { k[e] *= P[14]; kl[e] *= P[14]; }
    l1p = s;
}
__device__ __forceinline__ void hyena_phase(const Frame& F) {
    LAS f32x2* dat = (LAS f32x2*)F.lds; LAS float* redu = (LAS float*)(F.lds + RING_BYTES);
    const bf16* pT = (const bf16*)(F.ws + WS_B); const bf16* HT = (const bf16*)(F.ws + WS_HT); bf16* yT = (bf16*)(F.ws + WS_A);
    const LAS bf16x8* tab = (const LAS bf16x8*)(F.lds + FTAB_OFF);
    for (int i = F.tid; i < FT_NFRAG * 64; i += NTHR) ((LAS u32x4*)(F.lds + FTAB_OFF))[i] = ((const u32x4*)(F.ws + WS_FTAB))[i];
    __syncthreads();
    f32x2* Ke = (f32x2*)(F.ws + WS_FFTS) + (size_t)F.bid * 49152; f32x2* Ko = Ke + 16384; f32x2* SeB = Ke + 32768;
    RawF rf[4];
    { const int tq = fresh_tid(F.wave); if (F.bid < DM) {
#pragma unroll
        for (int sI = 0; sI < 4; ++sI) rf[sI] = load_rawf((const bf16*)(F.ws + WS_HT), F.bid, 8 * (tq + 512 * sI)); } }
    const int cv_gw = F.bid * NWAVES + F.wave, cv_ngw = F.G * NWAVES; int cv_it = cv_gw; constexpr int CV_NIT = 48 * 1024;
    for (int d = F.bid; d < DM; d += F.G) {
        int tid = fresh_tid(F.wave);
        TPS_START(1);
        LAS float* PW = (LAS float*)(F.lds + RING_BYTES + 64); ChanPar P = PW;
        __syncthreads();
        if (tid < 12) { const int i = tid & 3, pj = tid >> 2; PW[tid] = (i < 3) ? AIN(I_HCW)[i * 3 * DM + pj * DM + d] : AIN(I_HCB)[pj * DM + d]; }
        if (tid == 12) PW[12] = AIN(I_FBIAS)[d];
        if (tid == 13) { const float mind = -4.605170185988091f / 1.5f, maxd = -4.605170185988091f / 0.3f; const float delta = fabsf(mind + (maxd - mind) * ((float)d / (float)(DM - 1)));
            PW[13] = delta * (1.f / (float)(L - 1)) * 1.4426950408889634f; PW[14] = 1.f; }
        __syncthreads();
        TPS_STOP(1); TPS_START(2);
#pragma unroll 1
        for (int odd = 0; odd < 2; ++odd) {
            asm volatile("" : "+v"(tid));
            float l1s = 0.f;
#pragma unroll
            for (int sI = 0; sI < 4; ++sI) { const int t0 = 8 * (tid + 512 * sI); float k[8], kl[8], l1p; filt8(rf[sI], t0, P, k, kl, l1p); l1s += l1p;
#pragma unroll
                for (int e = 0; e < 8; ++e) { f32x2 o; if (!odd) { o.x = k[e] + kl[e]; o.y = 0.f; } else { const float a = k[e] - kl[e]; float wr, wi; unit_root((float)(t0 + e) * (1.f / 32768.f), false, wr, wi); o.x = a * wr; o.y = a * wi; }
                    dat[phys(t0 + e)] = o; } }
            if (!odd) { l1s = wave_sum(l1s); if (F.lane == 0) redu[F.wave] = l1s; }
            __syncthreads();
            if (!odd && tid == 0) { float tot = 0.f;
#pragma unroll
                for (int w = 0; w < NWAVES; ++w) tot += redu[w];
                PW[15] = 1.f / tot; }
            pass1<false>(dat, tab, F.lane, F.wave); __syncthreads(); pass2<false>(dat, tab, F.lane, F.wave); { f32x2 kdummy[16]; pass3<true>(dat, tab, F.lane, F.wave, 0, odd ? Ko : Ke, kdummy); asm volatile("" ::: "memory"); pass3<true>(dat, tab, F.lane, F.wave, 1, odd ? Ko : Ke, kdummy); } __syncthreads();
        }
        TPS_STOP(2); TPS_START(3);
        unsigned zp[4][8];
        const bool cvb3 = (cv_it + 2 * cv_ngw < CV_NIT);
        const ConvItem ia = moe_l1_item(F, cvb3 ? cv_it : 0), ib = moe_l1_item(F, cvb3 ? cv_it + cv_ngw : 0), ic = moe_l1_item(F, cvb3 ? cv_it + 2 * cv_ngw : 0);
#pragma unroll
        for (int odd = 0; odd < 2; ++odd) {
            asm volatile("" : "+v"(tid));
            TPS_START(6);
            if (!odd) {
                RawZ rz[4];
#pragma unroll
                for (int sI = 0; sI < 4; ++sI) rz[sI] = load_rawz(pT, d, 8 * (tid + 512 * sI));
#pragma unroll
                for (int sI = 0; sI < 4; ++sI) { const int t0 = 8 * (tid + 512 * sI); float z0[8], z1[8]; z_from_raw(rz[sI], P, z0, z1);
#pragma unroll
                    for (int e = 0; e < 8; ++e) { f32x2 o; o.x = z0[e]; o.y = z1[e]; zp[sI][e] = cvt_pk_bf16(z0[e], z1[e]); dat[phys(t0 + e)] = o; } }
            } else {
#pragma unroll
                for (int sI = 0; sI < 4; ++sI) { const int t0 = 8 * (tid + 512 * sI);
#pragma unroll
                    for (int e = 0; e < 8; ++e) { const float z0 = bflo(zp[sI][e]), z1 = bfhi(zp[sI][e]); float wr, wi; unit_root((float)(t0 + e) * (1.f / 32768.f), false, wr, wi);
                        f32x2 o; o.x = z0 * wr - z1 * wi; o.y = z0 * wi + z1 * wr; dat[phys(t0 + e)] = o; } }
            }
#ifdef FFT_EXTRA
#pragma unroll 1
            for (int xr = 0; xr < FFT_EXTRA; ++xr) { __syncthreads(); pass2<false>(dat, tab, F.lane, F.wave); __syncthreads(); pass2<true>(dat, tab, F.lane, F.wave); __syncthreads();
#pragma unroll 1
                for (int i = fresh_tid(F.wave); i < L; i += NTHR) { f32x2 v = dat[i]; v.x *= (1.f / 32.f); v.y *= (1.f / 32.f); dat[i] = v; } }
            tid = fresh_tid(F.wave);
#endif
            TPS_STOP(6); TPS_START(5);
            f32x2 kpre0[16], kpre1[16];
            asm volatile("" ::: "memory");
            { const f32x2* Kb = odd ? Ko : Ke; int ln_ = F.lane; asm volatile("" : "+v"(ln_)); const int lq = ln_ & 31, lh = ln_ >> 5; const float il1 = P[15], fb = P[12];
#pragma unroll
              for (int r = 0; r < 16; ++r) { f32x2 k0 = Kb[((r & 3) + 8 * (r >> 2) + 4 * lh) * 512 + 64 * F.wave + lq], k1 = Kb[((r & 3) + 8 * (r >> 2) + 4 * lh) * 512 + 64 * F.wave + 32 + lq];
                  k0.x = k0.x * il1 + fb; k0.y *= il1; k1.x = k1.x * il1 + fb; k1.y *= il1; kpre0[r] = k0; kpre1[r] = k1; } }
            __syncthreads(); pass1<false>(dat, tab, F.lane, F.wave); __syncthreads(); pass2<false>(dat, tab, F.lane, F.wave); pass3<false>(dat, tab, F.lane, F.wave, 0, nullptr, kpre0); asm volatile("" ::: "memory"); pass3<false>(dat, tab, F.lane, F.wave, 1, nullptr, kpre1);
            TPS_STOP(5); TPS_START(7);
            if (odd) { float ca[32], cb[32], cc[32]; const int cvln = fresh_tid(F.wave) & 63;
                conv_issue(ia, cvln, ca); conv_issue(ib, cvln, cb); conv_issue(ic, cvln, cc);
                pass2<true>(dat, tab, F.lane, F.wave); __syncthreads(); pass1<true>(dat, tab, F.lane, F.wave);
                if (cvb3) { conv_finish(ia, cvln, ca); conv_finish(ib, cvln, cb); conv_finish(ic, cvln, cc); cv_it += 3 * cv_ngw; }
                __syncthreads();
            } else { pass2<true>(dat, tab, F.lane, F.wave); __syncthreads(); pass1<true>(dat, tab, F.lane, F.wave); __syncthreads(); }
            TPS_STOP(7);
            if (!odd) {
                asm volatile("" : "+v"(tid));
#pragma unroll 1
                for (int sI = 0; sI < 4; ++sI)
#pragma unroll
                    for (int e = 0; e < 8; ++e) { const f32x2 v = dat[phys(8 * (tid + 512 * sI) + e)]; SeB[e * 2048 + tid + 512 * sI] = v; }
                __syncthreads();
            }
        }
        TPS_STOP(3); TPS_START(4);
        asm volatile("" : "+v"(tid));
        if (d + F.G < DM) {
#pragma unroll
            for (int sI = 0; sI < 4; ++sI) rf[sI] = load_rawf(HT, d + F.G, 8 * (tid + 512 * sI)); }
        { Raw8 rx0[4][2]; f32x2 se[4][8];
#pragma unroll
          for (int sI = 0; sI < 4; ++sI) {
#pragma unroll
              for (int bt = 0; bt < 2; ++bt) rx0[sI][bt] = load_raw8(pT + (size_t)d * MTOK + bt * L, 8 * (tid + 512 * sI));
#pragma unroll
              for (int e = 0; e < 8; ++e) se[sI][e] = SeB[e * 2048 + tid + 512 * sI]; }
#pragma unroll
          for (int sI = 0; sI < 4; ++sI) { const int t0 = 8 * (tid + 512 * sI);
              float o0[8], o1[8];
#pragma unroll
              for (int e = 0; e < 8; ++e) { const f32x2 so = dat[phys(t0 + e)]; float wr, wi; unit_root((float)(t0 + e) * (1.f / 32768.f), true, wr, wi);
                  o0[e] = (se[sI][e].x + so.x * wr - so.y * wi) * (1.f / 32768.f); o1[e] = (se[sI][e].y + so.x * wi + so.y * wr) * (1.f / 32768.f); }
#pragma unroll
              for (int bt = 0; bt < 2; ++bt) { float xc[8]; conv8(rx0[sI][bt], P[0], P[1], P[2], P[3], xc);
                  u32x4 w;
                  if (bt == 0) { w.x = cvt_pk_bf16(xc[0] * o0[0], xc[1] * o0[1]); w.y = cvt_pk_bf16(xc[2] * o0[2], xc[3] * o0[3]); w.z = cvt_pk_bf16(xc[4] * o0[4], xc[5] * o0[5]); w.w = cvt_pk_bf16(xc[6] * o0[6], xc[7] * o0[7]); }
                  else { w.x = cvt_pk_bf16(xc[0] * o1[0], xc[1] * o1[1]); w.y = cvt_pk_bf16(xc[2] * o1[2], xc[3] * o1[3]); w.z = cvt_pk_bf16(xc[4] * o1[4], xc[5] * o1[5]); w.w = cvt_pk_bf16(xc[6] * o1[6], xc[7] * o1[7]); }
                  *(u32x4*)(yT + (size_t)d * MTOK + bt * L + t0) = w; } } }
        __syncthreads();
        TPS_STOP(4);
        if (cvb3) {
        } else {
#pragma unroll 1
            for (int q = 0; q < 3; ++q) { if (cv_it < CV_NIT) { float cva[32]; const ConvItem cvc = moe_l1_item(F, cv_it); conv_issue(cvc, fresh_tid(F.wave) & 63, cva); conv_finish(cvc, fresh_tid(F.wave) & 63, cva); cv_it += cv_ngw; } }
        }
    }
    while (cv_it < CV_NIT) { float cvb[32]; const ConvItem c = moe_l1_item(F, cv_it); conv_issue(c, F.lane, cvb); conv_finish(c, F.lane, cvb); cv_it += cv_ngw; }
}
__device__ __forceinline__ void transpose_phase(const Frame& F) {
    const bf16* yT = (const bf16*)(F.ws + WS_A); bf16* y = (bf16*)(F.ws + WS_B);
    LAS bf16* tl = (LAS bf16*)(F.lds + F.wave * 16384);
    const int gw = F.bid * NWAVES + F.wave, NGW = F.G * NWAVES, lane = F.lane;
    for (int tile = gw; tile < 32 * 512; tile += NGW) { const int d0 = (tile & 31) * 64, t0 = (tile >> 5) * 64;
#pragma unroll
        for (int i = 0; i < 8; ++i) { const int r = i * 8 + (lane >> 3), ch = lane & 7; const u32x4 v = *(const u32x4*)(yT + (size_t)(d0 + r) * MTOK + t0 + ch * 8); *(LAS u32x4*)(tl + r * 72 + ch * 8) = v; }
        LDS_WAIT();
#pragma unroll
        for (int i = 0; i < 8; ++i) { const int tr = i * 8 + (lane >> 3), ch = lane & 7; unsigned short e[8];
#pragma unroll
            for (int k = 0; k < 8; ++k) e[k] = tl[(ch * 8 + k) * 72 + tr];
            u32x4 w; w.x = e[0] | ((unsigned)e[1] << 16); w.y = e[2] | ((unsigned)e[3] << 16); w.z = e[4] | ((unsigned)e[5] << 16); w.w = e[6] | ((unsigned)e[7] << 16);
            *(u32x4*)(y + (size_t)(t0 + tr) * DM + d0 + ch * 8) = w; }
        LDS_WAIT();
    }
}
}
__device__ __forceinline__ float hy_ftab_value(int f, int l, int jj) { return hy::ftab_value(f, l, jj); }
constexpr int NPHASE = 19;

__device__ __forceinline__ void moe_table(const Frame& F, int layer, LAS int* tab) {
    if (F.tid < NCLS) tab[32 + F.tid] = (int)__hip_atomic_load((unsigned*)(F.ctl + CW_CNT + (layer * NCLS + F.tid) * 64), RLX_AGENT);
    __syncthreads();
    if (F.tid == 0) { int a = 0; for (int c = 0; c < NCLS; ++c) { tab[c] = a; a += (tab[32 + c] + 255) >> 8; } tab[24] = a; }
    __syncthreads();
}

#ifndef PROBE_MASK
#define PROBE_MASK 0u
#endif
#ifndef TPM
#define TPM 0u
#endif
#define TP_MULT 4
#define IN(k) ((ONLY < 0 || (k) == ONLY) && lo <= (k) && (k) < hi)
#define SEAM(k) do { if ((k) + 1 < hi) { XcdBarrier b_ = bar; asm volatile("" : "+s"(b_.bar), "+s"(b_.x)); xcd_barrier(b_); } if (TPM != 0u && ONLY < 0 && ((TPM >> (k)) & 1u) && F.bid == 0 && F.tid == 0) TPW[0] += __builtin_amdgcn_s_memrealtime() - TPW[1]; if (PROBE_MASK != 0u && ONLY < 0) { if (F.tid == 0) { LAS unsigned long long* tp_ = (LAS unsigned long long*)(F.lds + MISC_OFF + 64); const unsigned long long t1_ = __builtin_amdgcn_s_memrealtime(); if ((PROBE_MASK >> (k)) & 1u) tp_[0] += t1_ - tp_[1]; tp_[1] = t1_; } } } while (0)
#define TPW ((LAS unsigned long long*)(F.lds + MISC_OFF + 96))
#define ENTER() do { int l_; asm volatile("v_mbcnt_lo_u32_b32 %0, -1, 0\n\tv_mbcnt_hi_u32_b32 %0, -1, %0" : "=&v"(l_)); const int t_ = F.wave * 64 + l_; F.tid = t_; F.lane = l_; int b_ = blockIdx.x, g_ = gridDim.x; asm volatile("" : "+s"(b_), "+s"(g_)); F.bid = b_; F.G = g_; if (TPM != 0u && ONLY < 0 && b_ == 0 && t_ == 0) TPW[1] = __builtin_amdgcn_s_memrealtime(); } while (0)
template <int ONLY> __device__ __forceinline__ void layer_phases(Frame& F, const XcdBarrier& bar, const int lo, const int hi, const int layer, LAS int* tab) {
        const int pb = 3 + 8 * layer;
        if (layer == 0) {
            if (IN(pb + 0)) { ENTER();
                pg::PlainSched S; S.init(F.ws + WS_A, F.ws + WS_WQKV, MTOK, QKVD, DM, DM, F.G, F.bid);
                pg::EpiQKV E{(bf16*)(F.ws + WS_B), (bf16*)(F.ws + WS_B + 128 * MiB), (bf16*)(F.ws + WS_B + 144 * MiB), AIN(I_ABIN), (const float*)(F.ws + WS_ROPE), (const float*)(F.ws + WS_ROPE) + 4096};
                pg::gemm_phase<pg::EpiQKV, pg::PlainSched, false, false, true>(F.lds, F.tid, DM, DM, DM, S, E);
                SEAM(pb + 0);
            }
            if (IN(pb + 1)) { ENTER(); att::attn_phase(F); SEAM(pb + 1); }
        } else {
            if (IN(pb + 0)) { ENTER();
                pg::PlainSched S; S.init(F.ws + WS_WHYIN, F.ws + WS_A, 3 * DM, MTOK, DM, DM, F.G, F.bid);
                pg::EpiBf16<true> E{(bf16*)(F.ws + WS_B), MTOK, AIN(I_HBIN)};
                pg::gemm_phase<pg::EpiBf16<true>, pg::PlainSched, false, false, true>(F.lds, F.tid, DM, DM, DM, S, E);
                SEAM(pb + 0);
            }
            if (IN(pb + 1)) { ENTER(); hy::hyena_phase(F); SEAM(pb + 1); }
            if (IN(pb + 2)) { ENTER(); hy::transpose_phase(F); SEAM(pb + 2); }
        }
        if (IN(pb + 3)) { ENTER();
            const void* A = layer ? (const void*)(F.ws + WS_B) : (const void*)(F.ws + WS_A);
            const void* Bt = layer ? (const void*)(F.ws + WS_WHYO) : (const void*)(F.ws + WS_WO0);
            bf16* O = (bf16*)(F.ws + WS_B + (layer ? 128 : 192) * MiB);
            pg::PlainSched S; S.init(A, Bt, MTOK, DM, DM, DM, F.G, F.bid);
            pg::EpiBf16<false> E{O, DM, layer ? AIN(I_HBOUT) : nullptr};
            pg::gemm_phase<pg::EpiBf16<false>, pg::PlainSched, false, false, true>(F.lds, F.tid, DM, DM, DM, S, E);
            SEAM(pb + 3);
        }
        if (IN(pb + 4)) { ENTER();
            if (layer == 0) ln1_router_phase<true>(F, 0, AIN(I_X), (const bf16*)(F.ws + WS_B + 192 * MiB), (bf16*)(F.ws + WS_A), (bf16*)(F.ws + WS_B + 192 * MiB));
            else ln1_router_phase<false>(F, 1, F.out, (const bf16*)(F.ws + WS_B + 128 * MiB), (bf16*)(F.ws + WS_A), (bf16*)(F.ws + WS_B + 256 * MiB));
            SEAM(pb + 4);
        }
        if (IN(pb + 5)) { ENTER();
            moe_table(F, layer, tab);
            pg::MoeSched S{tab, (const char*)(F.ws + WS_A), (const char*)(F.ws + WS_W13 + (size_t)layer * 128 * MiB), (const int*)(F.ws + WS_TOK), F.G, F.bid, 16, 0};
            pg::EpiMoe1 E{(bf16*)(F.ws + WS_B), (const float*)(F.ws + WS_GATE)};
            pg::gemm_phase<pg::EpiMoe1, pg::MoeSched, true, false, true>(F.lds, F.tid, DM, DM, DM, S, E);
            SEAM(pb + 5);
        }
        if (IN(pb + 6)) { ENTER();
            moe_table(F, layer, tab);
            pg::MoeSched S{tab, (const char*)(F.ws + WS_B), (const char*)(F.ws + WS_W2 + (size_t)layer * 64 * MiB), (const int*)(F.ws + WS_TOK), F.G, F.bid, 8, 1};
            pg::EpiMoe2 E{(bf16*)(F.ws + WS_B + (layer ? 256 : 192) * MiB), (const int*)(F.ws + WS_TOK)};
            pg::gemm_phase<pg::EpiMoe2, pg::MoeSched, false, true, true>(F.lds, F.tid, DM, DM, EFF, S, E);
            SEAM(pb + 6);
        }
        if (IN(pb + 7)) { ENTER();
            if (layer == 0) ln2_phase<false>(F, 0, (const bf16*)(F.ws + WS_B + 192 * MiB), (bf16*)(F.ws + WS_A), F.out);
            else ln2_phase<true>(F, 1, (const bf16*)(F.ws + WS_B + 256 * MiB), (bf16*)(F.ws + WS_A), F.out);
            SEAM(pb + 7); }
}
template <int ONLY> __global__ void __launch_bounds__(NTHR, 2) fwd_kernel(Args args) {
    extern __shared__ __attribute__((aligned(16))) unsigned char lds_raw[];
    Frame F;
    F.lds = (LAS unsigned char*)lds_raw;
    F.tid = threadIdx.x; F.lane = F.tid & 63; F.wave = __builtin_amdgcn_readfirstlane(F.tid >> 6);
    F.G = gridDim.x; F.bid = blockIdx.x; F.ws = args.ws; F.ctl = (gu32*)(args.ws + WS_CTL); F.out = args.out;
    F.a = &args;
    for (int u = F.tid; u < (LDS_BYTES - RING_BYTES) / 4; u += NTHR) ((LAS unsigned*)(F.lds + RING_BYTES))[u] = 0u;
    __syncthreads();
    const int lo = args.ph_lo, hi = args.ph_hi;
    if (PROBE_MASK != 0u && ONLY >= 0) { if (F.bid == 0 && F.tid == 0) ((unsigned long long*)(F.ws + 512 * 1024))[ONLY] = __builtin_amdgcn_s_memrealtime(); }
    if (PROBE_MASK != 0u && ONLY < 0) { if (F.tid == 0) { LAS unsigned long long* tp_ = (LAS unsigned long long*)(F.lds + MISC_OFF + 64); tp_[0] = 0; tp_[1] = __builtin_amdgcn_s_memrealtime(); } }
    XcdBarrier bar; bar.bar = (unsigned*)(F.ctl + CW_BAR); bar.x = 0; bar.st = nullptr;
    if (ONLY < 0 && hi - lo > 1) bar = xcd_barrier_post((unsigned*)(F.ctl + CW_BAR), (volatile LAS unsigned*)(F.lds + MISC_OFF));
    LAS int* tab = (LAS int*)(F.lds + RING_BYTES + 64);

    if (IN(0)) { ENTER(); p0_prologue(F); SEAM(0); }
    if (IN(1)) { ENTER(); p1_prologue(F); if (TPM != 0u && ONLY < 0 && ((TPM >> 1) & 1u) && F.bid == 0 && F.tid == 0) TPW[0] += __builtin_amdgcn_s_memrealtime() - TPW[1]; }
    if (IN(2)) { ENTER();
        pg::PlainSched S; S.init(F.ws + WS_W4T, F.ws + WS_HDN, 4096, SEQ, 128, 128, F.G, F.bid);
        pg::EpiBf16<true> E{(bf16*)(F.ws + WS_HT), SEQ, nullptr};
        int kf = 128; asm volatile("" : "+s"(kf));
        pg::gemm_phase<pg::EpiBf16<true>, pg::PlainSched, false, false, true>(F.lds, F.tid, kf, 128, 128, S, E);
        SEAM(2);
    }
    if constexpr (ONLY >= 0) { if (ONLY >= 3 && ONLY < 11) layer_phases<ONLY>(F, bar, lo, hi, 0, tab); if (ONLY >= 11) layer_phases<ONLY>(F, bar, lo, hi, 1, tab); }
    else {
#pragma unroll 1
        for (int layer = 0; layer < 2; ++layer) layer_phases<ONLY>(F, bar, lo, hi, layer, tab);
    }
    if (PROBE_MASK != 0u && ONLY == NPHASE - 1) { __syncthreads(); if (F.bid == 0 && F.tid == 0) { const unsigned long long* ts = (const unsigned long long*)(F.ws + 512 * 1024); unsigned long long acc = 0, tend = __builtin_amdgcn_s_memrealtime();
        for (int k = 0; k < NPHASE; ++k) if (((PROBE_MASK >> k) & 1u) && k != 5) { int kn = k + 1; if (kn == 5) kn = 6; acc += ((kn < NPHASE) ? ts[kn] : tend) - ts[k]; }
        F.out[0] = 0.1f * (float)acc; } }
    if ((TPM != 0u || TPSEL >= 0) && ONLY < 0) { if (blockIdx.x == 0 && threadIdx.x == 0) { const unsigned long long acc = TPW[0] * TP_MULT, t0 = __builtin_amdgcn_s_memrealtime(); while (__builtin_amdgcn_s_memrealtime() - t0 < acc) __builtin_amdgcn_s_sleep(8); } }
    if (PROBE_MASK != 0u && ONLY < 0) { __syncthreads(); if (F.bid == 0 && F.tid == 0) F.out[0] = 0.1f * (float)((LAS unsigned long long*)(F.lds + MISC_OFF + 64))[0]; }
}
#undef IN
#undef SEAM

extern "C" void kernel_launch(void* const* d_in, const int* in_sizes, int n_in, void* d_out, int out_size, void* d_ws, size_t ws_size, hipStream_t stream) {
    static int grid = 0;
    if (grid == 0) {
        if (n_in != 34 || in_sizes[0] != MTOK * DM || out_size != MTOK * DM || ws_size < WS_END) { fprintf(stderr, "kernel_launch: unexpected shapes / workspace (n_in %d, ws %zu, need %zu)\n", n_in, ws_size, (size_t)WS_END); grid = -1; return; }
        int dev = 0, cus = 0;
        if (hipGetDevice(&dev) != hipSuccess || hipDeviceGetAttribute(&cus, hipDeviceAttributeMultiprocessorCount, dev) != hipSuccess) { grid = -1; return; }
#if !MK_SPLIT
        if (hipFuncSetAttribute((const void*)fwd_kernel<-1>, hipFuncAttributeMaxDynamicSharedMemorySize, LDS_BYTES) != hipSuccess) { fprintf(stderr, "kernel_launch: hipFuncSetAttribute failed\n"); grid = -1; return; }
        int per_cu = 0;
        if (hipOccupancyMaxActiveBlocksPerMultiprocessor(&per_cu, (const void*)fwd_kernel<-1>, NTHR, LDS_BYTES) != hipSuccess || per_cu < 1) fprintf(stderr, "kernel_launch: occupancy query reports %d blocks per CU\n", per_cu);
        (void)hipGetLastError();
#endif
        grid = cus;
    }
    if (grid < 0) return;
    (void)hipMemsetAsync((char*)d_ws + WS_CTL, 0, CTL_ZERO_BYTES, stream);
    Args a{};
    for (int i = 0; i < 34; ++i) a.in[i] = (const float*)d_in[i];
    a.out = (float*)d_out; a.ws = (unsigned char*)d_ws;
#if MK_SPLIT
    typedef void (*kfn)(Args);
    static const kfn fns[NPHASE] = {fwd_kernel<0>, fwd_kernel<1>, fwd_kernel<2>, fwd_kernel<3>, fwd_kernel<4>, nullptr, fwd_kernel<6>, fwd_kernel<7>, fwd_kernel<8>, fwd_kernel<9>, fwd_kernel<10>,
                                      fwd_kernel<11>, fwd_kernel<12>, fwd_kernel<13>, fwd_kernel<14>, fwd_kernel<15>, fwd_kernel<16>, fwd_kernel<17>, fwd_kernel<18>};
    static bool attr_done = false;
    if (!attr_done) { for (int ph = 0; ph < NPHASE; ++ph) if (fns[ph]) (void)hipFuncSetAttribute((const void*)fns[ph], hipFuncAttributeMaxDynamicSharedMemorySize, LDS_BYTES); attr_done = true; }
#ifndef REPEAT_MASK
#define REPEAT_MASK 0u
#endif
    for (int ph = 0; ph < NPHASE; ++ph) { if (!fns[ph]) continue; a.ph_lo = ph; a.ph_hi = ph + 1;
        for (int rep = 0; rep < (((REPEAT_MASK >> ph) & 1u) ? 2 : 1); ++rep) {
            if (rep == 1 && ph == 15) (void)hipMemsetAsync((char*)d_ws + WS_CTL + (size_t)(CW_CNT + NCLS * 64) * 4, 0, NCLS * 64 * 4, stream);
            hipLaunchKernelGGL(fns[ph], dim3(grid), dim3(NTHR), LDS_BYTES, stream, a); } }
#else
    a.ph_lo = 0; a.ph_hi = NPHASE; hipLaunchKernelGGL(fwd_kernel<-1>, dim3(grid), dim3(NTHR), LDS_BYTES, stream, a);
#endif
}
```

```cpp
#include <hip/hip_runtime.h>
#include <hip/hip_bf16.h>
#include <cstdio>
#include <cstdint>

#ifndef MK_SPLIT
#define MK_SPLIT 0
#endif

#define GAS __attribute__((address_space(1)))
#define LAS __attribute__((address_space(3)))
typedef unsigned short bf16;
typedef unsigned u32x4 __attribute__((ext_vector_type(4)));
typedef unsigned u32x2 __attribute__((ext_vector_type(2)));
typedef float f32x2 __attribute__((ext_vector_type(2)));
typedef float f32x4 __attribute__((ext_vector_type(4)));
typedef float f32x16 __attribute__((ext_vector_type(16)));
typedef short bf16x8 __attribute__((ext_vector_type(8)));
typedef short s16x4 __attribute__((ext_vector_type(4)));
typedef GAS unsigned gu32;

constexpr int DM = 2048, NB = 2, SEQ = 16384, MTOK = NB * SEQ, CTXL = 256, GRIDW = 64;
constexpr int NHEAD = 32, NKV = 4, HD = 64, QKVD = 2560, KVD = 256;
constexpr int NEXP = 16, EFF = 1024, NCLS = 24, LCAP = 32768;
constexpr int HYW = 64, HYEMB = 33;
constexpr float LN_EPS = 1e-5f;
constexpr float DN_ALPHA = 1.41421356237309515f;
constexpr float QSCALE = 0.125f * 1.4426950408889634f;
constexpr int NWAVES = 8, NTHR = 512;

constexpr size_t MiB = 1u << 20;
constexpr size_t WS_CTL = 0, CTL_ZERO_BYTES = 1 * MiB;
constexpr size_t WS_MOD = 1 * MiB;
constexpr size_t WS_ROPE = 1 * MiB + 512 * 1024;
constexpr size_t WS_FTAB = 1 * MiB + 768 * 1024;
constexpr size_t WS_CTXKV = 2 * MiB;
constexpr size_t WS_HDN = 3 * MiB;
constexpr size_t WS_W4T = 7 * MiB;
constexpr size_t WS_TOK = 8 * MiB;
constexpr size_t WS_GATE = 11 * MiB;
constexpr size_t WS_BADMAP = 1 * MiB + 384 * 1024;
constexpr float BAD_THR = 0.01f;
constexpr size_t WS_SIDE = 20 * MiB;
constexpr size_t WS_FFTS = 32 * MiB;
constexpr size_t WS_HT = 128 * MiB;
constexpr size_t WS_WQKV = 256 * MiB;
constexpr size_t WS_WO0 = 266 * MiB;
constexpr size_t WS_WHYIN = 274 * MiB;
constexpr size_t WS_WHYO = 298 * MiB;
constexpr size_t WS_W13 = 320 * MiB;
constexpr size_t WS_W2 = 576 * MiB;
constexpr size_t WS_A = 704 * MiB;
constexpr size_t WS_B = 832 * MiB;
constexpr size_t WS_END = 1216 * MiB;
constexpr int HID_ROWS = 38912;

constexpr int CW_TMO = 0;
constexpr int CW_BAR = 4096;
constexpr int CW_CNT = 16384;

constexpr int RING_BYTES = 131072;
constexpr int MISC_OFF = RING_BYTES + 320;
constexpr int FTAB_OFF = RING_BYTES + 1024;
constexpr int LDS_BYTES = 163840;

#define RLX_AGENT __ATOMIC_RELAXED, __HIP_MEMORY_SCOPE_AGENT
#define LDS_WAIT() asm volatile("s_waitcnt lgkmcnt(0)" ::: "memory")
#define VM_WAIT() asm volatile("s_waitcnt vmcnt(0)" ::: "memory")

__device__ __forceinline__ unsigned cvt_pk_bf16(float lo, float hi) { unsigned r; asm volatile("v_cvt_pk_bf16_f32 %0, %1, %2" : "=v"(r) : "v"(lo), "v"(hi)); return r; }
__device__ __forceinline__ float bf2f(unsigned h) { return __builtin_bit_cast(float, h << 16); }
__device__ __forceinline__ float bflo(unsigned w) { return __builtin_bit_cast(float, w << 16); }
__device__ __forceinline__ float bfhi(unsigned w) { return __builtin_bit_cast(float, w & 0xffff0000u); }
__device__ __forceinline__ float wave_sum(float v) {
    v += __builtin_bit_cast(float, __builtin_amdgcn_update_dpp(0, __builtin_bit_cast(int, v), 0xB1, 0xf, 0xf, true));
    v += __builtin_bit_cast(float, __builtin_amdgcn_update_dpp(0, __builtin_bit_cast(int, v), 0x4E, 0xf, 0xf, true));
    v += __builtin_bit_cast(float, __builtin_amdgcn_update_dpp(0, __builtin_bit_cast(int, v), 0x141, 0xf, 0xf, true));
    v += __builtin_bit_cast(float, __builtin_amdgcn_update_dpp(0, __builtin_bit_cast(int, v), 0x140, 0xf, 0xf, true));
    { auto r = __builtin_amdgcn_permlane16_swap(__float_as_uint(v), __float_as_uint(v), false, false); v = __uint_as_float(r[0]) + __uint_as_float(r[1]); }
    { auto r = __builtin_amdgcn_permlane32_swap(__float_as_uint(v), __float_as_uint(v), false, false); v = __uint_as_float(r[0]) + __uint_as_float(r[1]); }
    return v;
}

#define XB_TMO      128
#define XB_XCNT(j)  (256  + 64 * (j))
#define XB_XSUB(j)  (1280 + 64 * (j))
#define XB_XGEN(j)  (2304 + 64 * (j))
#define XB_TOP      3328
#define XB_TOPGEN   3392
#define XCD_BAR_WORDS 3456
#define XB_SPIN_CAP (1u << 18)

__device__ __forceinline__ unsigned xb_ld(unsigned* p)              { return __hip_atomic_load(p, __ATOMIC_RELAXED, __HIP_MEMORY_SCOPE_AGENT); }
__device__ __forceinline__ unsigned xb_add(unsigned* p, unsigned v) { return __hip_atomic_fetch_add(p, v, __ATOMIC_RELAXED, __HIP_MEMORY_SCOPE_AGENT); }
__device__ __forceinline__ unsigned xb_xcc_id() { return (unsigned)__builtin_amdgcn_s_getreg((3 << 11) | 20) & 0xFu; }
#define XB_SPIN(cond, bar) do { unsigned _sp = 0; while (cond) { __builtin_amdgcn_s_sleep(1); \
    if ((++_sp & 255u) == 0u) { if (xb_ld(&(bar)[XB_TMO])) break; if (_sp > XB_SPIN_CAP) { atomicAdd(&(bar)[XB_TMO], 1u); break; } } } } while (0)

struct XcdBarrier { unsigned* bar; unsigned x; volatile LAS unsigned* st; };

__device__ __forceinline__ XcdBarrier xcd_barrier_post(unsigned* bar, volatile LAS unsigned* st) {
    XcdBarrier b; b.bar = bar; b.x = xb_xcc_id(); b.st = st;
    if (threadIdx.x == 0) (void)xb_add(&bar[XB_XCNT(b.x)], 1u);
    return b;
}
__device__ __forceinline__ void xcd_barrier_complete(unsigned* bar, unsigned x, unsigned& nloc, unsigned& nx) {
    const unsigned G = gridDim.x * gridDim.y * gridDim.z;
    unsigned sum, cnt, mine, sp = 0u;
    for (;;) {
        sum = 0u; cnt = 0u; mine = 0u;
#pragma unroll
        for (unsigned j = 0; j < 16; ++j) { const unsigned c = xb_ld(&bar[XB_XCNT(j)]); sum += c; cnt += (c > 0u) ? 1u : 0u; mine = (j == x) ? c : mine; }
        if (sum == G) break;
        __builtin_amdgcn_s_sleep(1);
        if ((++sp & 255u) == 0u) { if (xb_ld(&bar[XB_TMO])) break; if (sp > XB_SPIN_CAP) { atomicAdd(&bar[XB_TMO], 1u); break; } }
    }
    nloc = mine > 0u ? mine : 1u; nx = cnt > 0u ? cnt : 1u;
}
__device__ __forceinline__ void xcd_barrier(const XcdBarrier& b) {
    asm volatile("s_waitcnt vmcnt(0)" ::: "memory");
    __syncthreads();
    if (threadIdx.x == 0) {
        unsigned* bar = b.bar;
        __builtin_amdgcn_s_waitcnt(0);
        unsigned nloc = b.st[0], nx = b.st[1];
        if (nloc == 0u) { xcd_barrier_complete(bar, b.x, nloc, nx); b.st[0] = nloc; b.st[1] = nx; }
        const unsigned old = xb_add(&bar[XB_XSUB(b.x)], 1u);
        const unsigned gen = old / nloc;
        if (old + 1u == (gen + 1u) * nloc) {
            __builtin_amdgcn_fence(__ATOMIC_RELEASE, "agent");
            asm volatile("s_waitcnt vmcnt(0)" ::: "memory");
            const unsigned og = xb_add(&bar[XB_TOP], 1u);
            const unsigned tg = og / nx;
            if (og + 1u == (tg + 1u) * nx) xb_add(&bar[XB_TOPGEN], 1u);
            else XB_SPIN(xb_ld(&bar[XB_TOPGEN]) == tg, bar);
            __builtin_amdgcn_fence(__ATOMIC_ACQUIRE, "agent");
            xb_add(&bar[XB_XGEN(b.x)], 1u);
            asm volatile("s_waitcnt vmcnt(0)" ::: "memory");
        } else {
            XB_SPIN(xb_ld(&bar[XB_XGEN(b.x)]) == gen, bar);
            __builtin_amdgcn_fence(__ATOMIC_ACQUIRE, "agent");
            asm volatile("s_waitcnt vmcnt(0)" ::: "memory");
        }
    }
    __syncthreads();
}

namespace pg {
constexpr int BM = 256, BK = 64, HALF = 128, HTB = HALF * BK * 2, NXCD = 8, WGM = 8;
__host__ __device__ __forceinline__ int lds_byte(int r, int c) { const int st = (r >> 4) * 2 + (c >> 5), rr = r & 15, cc = c & 31, ob = rr * 64 + cc * 2; return st * 1024 + (ob ^ (((ob >> 9) & 1) << 5)); }
__host__ __device__ __forceinline__ void stage_rc(int b, int& R, int& C) { const int st = b / 1024, sb = b % 1024, swz = sb ^ (((sb >> 9) & 1) << 5); R = (st >> 1) * 16 + swz / 64; C = (st & 1) * 32 + (swz % 64) / 2; }
__host__ __device__ __forceinline__ int perm32(int rho) { const int n = rho >> 4, i = rho & 15; return 8 * (i >> 2) + 4 * n + (i & 3); }

struct Unit { int pm, pn; const char* A; const char* B; const char* B2; int cls, row0, nrows, lbase; };

__device__ __forceinline__ bool static_map(int i, int G, int c, int nM, int nN, int& pm, int& pn) {
    const int nwg = nM * nN; const long L = (long)i * G + c; if (L >= nwg) return false;
    int wgid = (int)L; { const int q = nwg / NXCD, r = nwg % NXCD, xcd = wgid % NXCD, off = wgid / NXCD; wgid = (xcd < r ? xcd * (q + 1) : r * (q + 1) + (xcd - r) * q) + off; }
    const int nig = WGM * nN, gid = wgid / nig, fm = gid * WGM, gsz = (nM - fm) < WGM ? (nM - fm) : WGM;
    pm = fm + ((wgid % nig) % gsz); pn = (wgid % nig) / gsz; return true;
}
struct PlainSched {
    const char* A; const char* Bt; int nM, nN, G, c; size_t tA, tB;
    __device__ __forceinline__ void init(const void* A_, const void* Bt_, int M, int N, int ldA, int ldB, int G_, int c_) { A = (const char*)A_; Bt = (const char*)Bt_; nM = M / BM; nN = N / BM; G = G_; c = c_; tA = (size_t)BM * ldA * 2; tB = (size_t)BM * ldB * 2; }
    __device__ __forceinline__ bool next(int i, Unit& u) const {
        if (!static_map(i, G, c, nM, nN, u.pm, u.pn)) return false;
        u.A = A + (size_t)u.pm * tA; u.B = Bt + (size_t)u.pn * tB; u.B2 = u.B; u.cls = 0; u.row0 = 0; u.nrows = 256; u.lbase = 0; return true;
    }
    __device__ __forceinline__ unsigned row_off(const Unit&, int r, int ldA) const { return (unsigned)r * (unsigned)ldA * 2u; }
};

template <class Epi, class Sched, bool GATHER, bool KSPLIT, bool ALIGN_EPI>
__device__ __forceinline__ void gemm_phase(LAS unsigned char* lds, const int tid, const int K, const int ldA, const int ldB, const Sched& S, const Epi& E) {
    const int wid = __builtin_amdgcn_readfirstlane(tid >> 6), lane = tid & 63, wr = wid >> 2, wc = wid & 3, fr = lane & 15, fq = lane >> 4;
    const int nt = K / BK, nth = nt >> 1;
    int RA[2], CA[2];
    unsigned voffB[2], voA[2][2], nvoA[2][2];
#pragma unroll
    for (int i = 0; i < 2; ++i) { int R, C; stage_rc(tid * 16 + i * 8192, R, C); const int Rb = Epi::PERM ? ((R & ~31) + perm32(R & 31)) : R;
        RA[i] = R; CA[i] = C; voffB[i] = (unsigned)(Rb * ldB + C) * 2u;
        voA[0][i] = (unsigned)(R * ldA + C) * 2u; voA[1][i] = (unsigned)((R + HALF) * ldA + C) * 2u; nvoA[0][i] = voA[0][i]; nvoA[1][i] = voA[1][i]; }
    const size_t kstep = (size_t)(BK * 2);
    const size_t hstepB = (size_t)HALF * ldB * 2;
    const unsigned ldsw = (unsigned)wid * 1024u;
    const int aoff = lds_byte(wr * 64 + fr, fq * 8), boff = lds_byte(wc * 32 + fr, fq * 8);
#define PG8_SA(b, h) (((b) * 2 + (h)) * HTB)
#define PG8_SB(b, h) ((4 + (b) * 2 + (h)) * HTB)
#define PG8_STAGEB(bufoff, gbase) do { _Pragma("unroll") for (int _i = 0; _i < 2; ++_i) \
        __builtin_amdgcn_global_load_lds((const unsigned*)((const char*)(gbase) + voffB[_i]), (LAS unsigned*)(lds + (bufoff) + ldsw + _i * 8192), 16, 0, 0); } while (0)
#define PG8_STAGEA(bufoff, gbase, vo, h) do { _Pragma("unroll") for (int _i = 0; _i < 2; ++_i) \
        __builtin_amdgcn_global_load_lds((const unsigned*)((const char*)(gbase) + (vo)[h][_i]), (LAS unsigned*)(lds + (bufoff) + ldsw + _i * 8192), 16, 0, 0); } while (0)
#define PG8_LDA(dst, b, h) do { _Pragma("unroll") for (int m = 0; m < 4; ++m) _Pragma("unroll") for (int k = 0; k < 2; ++k) dst[m][k] = *(const LAS bf16x8*)(lds + PG8_SA(b, h) + aoff + m * 2048 + k * 1024); } while (0)
#define PG8_LDB(dst, b, h) do { _Pragma("unroll") for (int n = 0; n < 2; ++n) _Pragma("unroll") for (int k = 0; k < 2; ++k) dst[n][k] = *(const LAS bf16x8*)(lds + PG8_SB(b, h) + boff + n * 2048 + k * 1024); } while (0)
#define PG8_MMA(ai, bj, At, Bt) do { __builtin_amdgcn_s_setprio(1); _Pragma("unroll") for (int m = 0; m < 4; ++m) _Pragma("unroll") for (int n = 0; n < 2; ++n) _Pragma("unroll") for (int k = 0; k < 2; ++k) \
        acc[ai][bj][m][n] = __builtin_amdgcn_mfma_f32_16x16x32_bf16(Bt[n][k], At[m][k], acc[ai][bj][m][n], 0, 0, 0); __builtin_amdgcn_s_setprio(0); } while (0)
#define PG8_WAIT_V(n) asm volatile("s_waitcnt vmcnt(" #n ")" ::: "memory")
#define PG8_WAIT_L(n) asm volatile("s_waitcnt lgkmcnt(" #n ")" ::: "memory")
#define PG8_BAR __builtin_amdgcn_s_barrier()
#define PG8_SCHED __builtin_amdgcn_sched_barrier(0)
#define PG8_BPTR(tt) ((KSPLIT && (tt) >= nth) ? cB2 + (size_t)((tt) - nth) * kstep : cB + (size_t)(tt) * kstep)
    Unit cur, nxt; int ui = 0;
    if (!S.next(0, cur)) return;
    if constexpr (GATHER) {
#pragma unroll
        for (int h = 0; h < 2; ++h)
#pragma unroll
            for (int i = 0; i < 2; ++i) voA[h][i] = S.row_off(cur, h * HALF + RA[i], ldA) + (unsigned)CA[i] * 2u;
    }
    f32x4 acc[2][2][4][2];
#pragma unroll
    for (int a = 0; a < 2; ++a)
#pragma unroll
        for (int b = 0; b < 2; ++b)
#pragma unroll
            for (int m = 0; m < 4; ++m)
#pragma unroll
                for (int n = 0; n < 2; ++n) acc[a][b][m][n] = (f32x4){0.f, 0.f, 0.f, 0.f};
    bf16x8 At[4][2], B0[2][2], B1[2][2];
    const char* cA = cur.A; const char* cB = cur.B; const char* cB2 = cur.B2;
    PG8_STAGEB(PG8_SB(0, 0), cB); PG8_STAGEB(PG8_SB(0, 1), cB + hstepB); PG8_STAGEA(PG8_SA(0, 0), cA, voA, 0); PG8_STAGEA(PG8_SA(0, 1), cA, voA, 1);
    if (wr == 1) PG8_BAR;
    PG8_WAIT_V(2); PG8_BAR;
    { const char* b1 = PG8_BPTR(1); PG8_STAGEB(PG8_SB(1, 0), b1); PG8_STAGEA(PG8_SA(1, 0), cA + kstep, voA, 0); PG8_STAGEB(PG8_SB(1, 1), b1 + hstepB); }
    PG8_WAIT_V(6); PG8_BAR;
    for (;;) {
        const bool has_next = S.next(ui + 1, nxt);
        const char* nA = has_next ? nxt.A : cA; const char* nB = has_next ? nxt.B : cB;
        if constexpr (GATHER) {
            if (has_next) {
#pragma unroll
                for (int h = 0; h < 2; ++h)
#pragma unroll
                    for (int i = 0; i < 2; ++i) nvoA[h][i] = S.row_off(nxt, h * HALF + RA[i], ldA) + (unsigned)CA[i] * 2u;
            } else {
#pragma unroll
                for (int h = 0; h < 2; ++h)
#pragma unroll
                    for (int i = 0; i < 2; ++i) nvoA[h][i] = voA[h][i];
            }
        }
        for (int t = 0; t < nt; t += 2) {
            const bool last = (t == nt - 2);
            const char* a1 = cA + (size_t)(t + 1) * kstep;
            const char* a2 = last ? nA : cA + (size_t)(t + 2) * kstep; const char* b2 = last ? nB : PG8_BPTR(t + 2);
            const char* a3 = a2 + kstep; const char* b3 = last ? nB + kstep : PG8_BPTR(t + 3);
            unsigned vo2[2][2];
#pragma unroll
            for (int h = 0; h < 2; ++h)
#pragma unroll
                for (int i = 0; i < 2; ++i) vo2[h][i] = (GATHER && last) ? nvoA[h][i] : voA[h][i];
            PG8_LDB(B0, 0, 0); PG8_LDB(B1, 0, 1); PG8_SCHED; PG8_LDA(At, 0, 0); PG8_STAGEA(PG8_SA(1, 1), a1, voA, 1);
            PG8_WAIT_V(8); PG8_WAIT_L(0); PG8_BAR; PG8_MMA(0, 0, At, B0); PG8_MMA(0, 1, At, B1); PG8_BAR; PG8_SCHED;
            PG8_LDA(At, 0, 1); PG8_STAGEB(PG8_SB(0, 0), b2); PG8_STAGEB(PG8_SB(0, 1), b2 + hstepB); PG8_STAGEA(PG8_SA(0, 0), a2, vo2, 0);
            PG8_WAIT_V(8); PG8_WAIT_L(0); PG8_BAR; PG8_MMA(1, 0, At, B0); PG8_MMA(1, 1, At, B1); PG8_BAR; PG8_SCHED;
            PG8_LDB(B0, 1, 0); PG8_LDB(B1, 1, 1); PG8_SCHED; PG8_LDA(At, 1, 0); PG8_STAGEA(PG8_SA(0, 1), a2, vo2, 1);
            PG8_WAIT_V(8); PG8_WAIT_L(0); PG8_BAR; PG8_MMA(0, 0, At, B0); PG8_MMA(0, 1, At, B1); PG8_BAR; PG8_SCHED;
            PG8_LDA(At, 1, 1); PG8_STAGEB(PG8_SB(1, 0), b3); PG8_STAGEB(PG8_SB(1, 1), b3 + hstepB); PG8_STAGEA(PG8_SA(1, 0), a3, vo2, 0);
            PG8_WAIT_V(8); PG8_WAIT_L(0); PG8_BAR; PG8_MMA(1, 0, At, B0); PG8_MMA(1, 1, At, B1); PG8_BAR; PG8_SCHED;
        }
        if constexpr (ALIGN_EPI) { if (wr == 0) PG8_BAR; }
        E(acc, cur, wr, wc, fr, fq);
        if (!has_next) break;
#pragma unroll
        for (int a = 0; a < 2; ++a)
#pragma unroll
            for (int b = 0; b < 2; ++b)
#pragma unroll
                for (int m = 0; m < 4; ++m)
#pragma unroll
                    for (int n = 0; n < 2; ++n) acc[a][b][m][n] = (f32x4){0.f, 0.f, 0.f, 0.f};
        cur = nxt; cA = nA; cB = nB; cB2 = nxt.B2; ++ui;
        if constexpr (GATHER) {
#pragma unroll
            for (int h = 0; h < 2; ++h)
#pragma unroll
                for (int i = 0; i < 2; ++i) voA[h][i] = nvoA[h][i];
        }
        if constexpr (ALIGN_EPI) { if (wr == 1) PG8_BAR; }
    }
    PG8_WAIT_V(0);
    if constexpr (!ALIGN_EPI) { if (wr == 0) PG8_BAR; }
    PG8_BAR;
#undef PG8_SA
#undef PG8_SB
#undef PG8_STAGEA
#undef PG8_STAGEB
#undef PG8_LDA
#undef PG8_LDB
#undef PG8_MMA
#undef PG8_WAIT_V
#undef PG8_WAIT_L
#undef PG8_BAR
#undef PG8_SCHED
#undef PG8_BPTR
}
}
namespace pg {
template <bool BIAS_ROW> struct EpiBf16 {
    static constexpr bool PERM = true;
    bf16* O; int ldc; const float* bias;
    __device__ __forceinline__ void operator()(const f32x4 (&acc)[2][2][4][2], const Unit& u, int wr, int wc, int fr, int fq) const {
        const int row0 = u.pm * BM + wr * 64 + fr; const int col0 = u.pn * BM + wc * 32 + 8 * fq;
        f32x4 bv[2][2];
#pragma unroll
        for (int bj = 0; bj < 2; ++bj)
#pragma unroll
            for (int n = 0; n < 2; ++n) bv[bj][n] = (bias && !BIAS_ROW) ? *(const f32x4*)(bias + col0 + bj * HALF + 4 * n) : (f32x4){0.f, 0.f, 0.f, 0.f};
#pragma unroll
        for (int ai = 0; ai < 2; ++ai)
#pragma unroll
            for (int m = 0; m < 4; ++m) { const int row = row0 + ai * HALF + m * 16; bf16* rowp = O + (size_t)row * ldc + col0;
                float br = 0.f; if (BIAS_ROW && bias) br = bias[row];
#pragma unroll
                for (int bj = 0; bj < 2; ++bj) { f32x4 v0 = acc[ai][bj][m][0] + bv[bj][0] + br, v1 = acc[ai][bj][m][1] + bv[bj][1] + br;
                    u32x4 w; w.x = cvt_pk_bf16(v0[0], v0[1]); w.y = cvt_pk_bf16(v0[2], v0[3]); w.z = cvt_pk_bf16(v1[0], v1[1]); w.w = cvt_pk_bf16(v1[2], v1[3]);
                    *(u32x4*)(rowp + bj * HALF) = w; } }
    }
};
struct EpiQKV {
    static constexpr bool PERM = false;
    bf16 *Q, *Kb, *Vb; const float* bias; const float* ropeC; const float* ropeS;
    __device__ __forceinline__ void operator()(const f32x4 (&acc)[2][2][4][2], const Unit& u, int wr, int wc, int fr, int fq) const {
        const int row0 = u.pm * BM + wr * 64 + fr; const int colt = u.pn * BM + wc * 32 + 4 * fq;
        const bool isV = (u.pn == 9), isQ = (u.pn < 8);
        bf16* base; int ldc, cofs;
        if (isQ) { base = Q; ldc = DM; cofs = 0; } else if (!isV) { base = Kb; ldc = KVD; cofs = 2048; } else { base = Vb; ldc = KVD; cofs = 2304; }
        f32x4 bv[2][2];
#pragma unroll
        for (int bj = 0; bj < 2; ++bj)
#pragma unroll
            for (int n = 0; n < 2; ++n) bv[bj][n] = *(const f32x4*)(bias + colt + bj * HALF + 16 * n);
        const float sc = isQ ? QSCALE : 1.f; const int half = wc & 1;
#pragma unroll
        for (int ai = 0; ai < 2; ++ai)
#pragma unroll
            for (int m = 0; m < 4; ++m) { const int row = row0 + ai * HALF + m * 16; const int t = row & (SEQ - 1); const int pos = half ? (t & (GRIDW - 1)) : (t >> 6);
                f32x4 cs = (f32x4){1.f, 1.f, 1.f, 1.f}, sn = (f32x4){0.f, 0.f, 0.f, 0.f};
                if (!isV) { cs = *(const f32x4*)(ropeC + pos * 16 + 4 * fq); sn = *(const f32x4*)(ropeS + pos * 16 + 4 * fq); }
                bf16* rowp = base + (size_t)row * ldc + (colt - cofs);
#pragma unroll
                for (int bj = 0; bj < 2; ++bj) { const f32x4 x1 = acc[ai][bj][m][0] + bv[bj][0], x2 = acc[ai][bj][m][1] + bv[bj][1];
                    const f32x4 o1 = (x1 * cs - x2 * sn) * sc, o2 = (x2 * cs + x1 * sn) * sc;
                    u32x2 w1, w2; w1.x = cvt_pk_bf16(o1[0], o1[1]); w1.y = cvt_pk_bf16(o1[2], o1[3]); w2.x = cvt_pk_bf16(o2[0], o2[1]); w2.y = cvt_pk_bf16(o2[2], o2[3]);
                    *(u32x2*)(rowp + bj * HALF) = w1; *(u32x2*)(rowp + bj * HALF + 16) = w2; } }
    }
};
struct EpiMoe1 {
    static constexpr bool PERM = true;
    bf16* hid; const float* gates;
    __device__ __forceinline__ void operator()(const f32x4 (&acc)[2][2][4][2], const Unit& u, int wr, int wc, int fr, int fq) const {
        const int lr0 = wr * 64 + fr; const int col0 = u.pn * HALF + wc * 32 + 8 * fq; const int gsel = (u.pn >= 8) ? 1 : 0;
#pragma unroll
        for (int ai = 0; ai < 2; ++ai)
#pragma unroll
            for (int m = 0; m < 4; ++m) { const int lr = lr0 + ai * HALF + m * 16;
                if (lr < u.nrows) { const float g = gates[(size_t)(u.lbase + lr) * 2 + gsel];
                    float o[8];
#pragma unroll
                    for (int n = 0; n < 2; ++n)
#pragma unroll
                        for (int i = 0; i < 4; ++i) { const float a = acc[ai][0][m][n][i], b = acc[ai][1][m][n][i];
                            const float sg = __builtin_amdgcn_rcpf(1.f + __builtin_amdgcn_exp2f(-1.4426950408889634f * a)); o[n * 4 + i] = a * sg * b * g; }
                    u32x4 w; w.x = cvt_pk_bf16(o[0], o[1]); w.y = cvt_pk_bf16(o[2], o[3]); w.z = cvt_pk_bf16(o[4], o[5]); w.w = cvt_pk_bf16(o[6], o[7]);
                    *(u32x4*)(hid + (size_t)(u.row0 + lr) * DM + col0) = w; } }
    }
};
struct EpiMoe2 {
    static constexpr bool PERM = true;
    bf16* Y; const int* toks;
    __device__ __forceinline__ void operator()(const f32x4 (&acc)[2][2][4][2], const Unit& u, int wr, int wc, int fr, int fq) const {
        const int lr0 = wr * 64 + fr; const int col0 = u.pn * BM + wc * 32 + 8 * fq;
#pragma unroll
        for (int ai = 0; ai < 2; ++ai)
#pragma unroll
            for (int m = 0; m < 4; ++m) { const int lr = lr0 + ai * HALF + m * 16;
                if (lr < u.nrows) { const int tok = toks[u.lbase + lr]; bf16* rowp = Y + (size_t)tok * DM + col0;
#pragma unroll
                    for (int bj = 0; bj < 2; ++bj) { const f32x4 v0 = acc[ai][bj][m][0], v1 = acc[ai][bj][m][1];
                        u32x4 w; w.x = cvt_pk_bf16(v0[0], v0[1]); w.y = cvt_pk_bf16(v0[2], v0[3]); w.z = cvt_pk_bf16(v1[0], v1[1]); w.w = cvt_pk_bf16(v1[2], v1[3]);
                        *(u32x4*)(rowp + bj * HALF) = w; } } }
    }
};
struct MoeSched {
    const LAS int* tab;
    const char* Abase; const char* W; const int* toks; int G, c, NPN, second;
    __device__ __forceinline__ bool next(int i, Unit& u) const {
        const int TM = __builtin_amdgcn_readfirstlane(tab[24]);
        if (!static_map(i, G, c, TM, NPN, u.pm, u.pn)) return false;
        int cls = 0;
        for (int k = 1; k < NCLS; ++k) { const int s = __builtin_amdgcn_readfirstlane(tab[k]); if (u.pm >= s) cls = k; }
        const int ts = __builtin_amdgcn_readfirstlane(tab[cls]), cnt = __builtin_amdgcn_readfirstlane(tab[32 + cls]);
        const int ti = u.pm - ts; u.cls = cls; u.row0 = u.pm * BM; u.nrows = (cnt - ti * BM) < BM ? (cnt - ti * BM) : BM; u.lbase = cls * LCAP + ti * BM;
        const int g = cls / 6, p = cls % 6; const int lo = (p < 3) ? 0 : (p < 5 ? 1 : 2), hi = (p < 3) ? p + 1 : (p < 5 ? p - 1 : 3);
        const int elo = g * 4 + lo, ehi = g * 4 + hi;
        if (!second) { const int e = (u.pn < 8) ? elo : ehi; u.A = Abase; u.B = W + ((size_t)e * 2048 + (size_t)(u.pn & 7) * 256) * 2048 * 2; u.B2 = u.B; }
        else { u.A = Abase + (size_t)u.row0 * DM * 2; u.B = W + ((size_t)elo * 2048 + (size_t)u.pn * 256) * 1024 * 2; u.B2 = W + ((size_t)ehi * 2048 + (size_t)u.pn * 256) * 1024 * 2; }
        return true;
    }
    __device__ __forceinline__ unsigned row_off(const Unit& u, int r, int ldA) const {
        const int rr = r < u.nrows ? r : u.nrows - 1; const int tok = toks[u.lbase + rr]; return (unsigned)tok * (unsigned)ldA * 2u;
    }
};
}
struct Args { const float* in[34]; float* out; unsigned char* ws; int ph_lo, ph_hi; };
struct Frame {
    LAS unsigned char* lds;
    gu32* ctl; unsigned char* ws;
    int tid, lane, wave, G, bid;
    const Args* a; float* out;
};
#define AIN(i) (F.a->in[i])
enum { I_X = 0, I_C, I_CTX, I_CCTX, I_ADAW, I_ADAB, I_AWIN, I_ABIN, I_SINK, I_AWOUT, I_HWIN, I_HBIN, I_HCW, I_HCB, I_FW1, I_FB1, I_FW2, I_FB2, I_FW3, I_FB3, I_FFREQ, I_FW4, I_FBIAS, I_HWOUT, I_HBOUT,
       I_LN1G, I_LN1B, I_LN2G, I_LN2B, I_RW, I_RB, I_W1, I_W3, I_W2 };
#ifndef TPSEL
#define TPSEL -1
#endif
#define TPS_W ((LAS unsigned long long*)(F.lds + RING_BYTES + 320 + 96))
#define TPS_START(id) do { if (TPSEL == (id) && blockIdx.x == 0 && threadIdx.x == 0) TPS_W[1] = __builtin_amdgcn_s_memrealtime(); } while (0)
#define TPS_STOP(id) do { if (TPSEL == (id) && blockIdx.x == 0 && threadIdx.x == 0) TPS_W[0] += __builtin_amdgcn_s_memrealtime() - TPS_W[1]; } while (0)
__device__ __forceinline__ int fresh_tid(int wave) { int l_; asm volatile("v_mbcnt_lo_u32_b32 %0, -1, 0\n\tv_mbcnt_hi_u32_b32 %0, -1, %0" : "=&v"(l_)); return wave * 64 + l_; }
__device__ __forceinline__ float* mod_ptr(const Frame& F, int layer, int vec, int chunk) { return (float*)(F.ws + WS_MOD) + ((size_t)(layer * 3 + vec) * 6 + chunk) * DM; }

__device__ __forceinline__ float hy_ftab_value(int f, int l, int jj);
__device__ constexpr int hy_ftab_elems() { return 28 * 64 * 8; }
__device__ __forceinline__ void p0_transpose_item(const float* W, int ldw, bf16* WT, int ldt, int dst_row, int k0, int n0, LAS float* scr, int lane) {
#pragma unroll
    for (int i = 0; i < 32; ++i) { const int kk = 2 * i + (lane >> 5); scr[kk * 33 + (lane & 31)] = W[(size_t)(k0 + kk) * ldw + n0 + (lane & 31)]; }
    LDS_WAIT(); asm volatile("" ::: "memory");
    const int c = lane & 7;
#pragma unroll
    for (int j = 0; j < 4; ++j) { const int n = (lane >> 3) + 8 * j; const LAS float* s = scr + (8 * c) * 33 + n;
        u32x4 o; o.x = cvt_pk_bf16(s[0 * 33], s[1 * 33]); o.y = cvt_pk_bf16(s[2 * 33], s[3 * 33]); o.z = cvt_pk_bf16(s[4 * 33], s[5 * 33]); o.w = cvt_pk_bf16(s[6 * 33], s[7 * 33]);
        *(GAS u32x4*)(WT + (size_t)(dst_row + n) * ldt + k0 + 8 * c) = o; }
    LDS_WAIT(); asm volatile("" ::: "memory");
}
struct ConvItem { const float* W; bf16* WT; int ldw, ldt, dst_row, k0, n0; };
__device__ __forceinline__ ConvItem moe_l1_item(const Frame& F, int it) {
    ConvItem c; const int mat = it >> 10, sub = it & 1023, which = mat >> 4, le = 16 + (mat & 15);
    if (which < 2) { c.n0 = (sub & 31) * 32; c.k0 = (sub >> 5) * 64; c.W = (which == 0 ? AIN(I_W1) : AIN(I_W3)) + (size_t)le * DM * EFF; c.ldw = EFF; c.WT = (bf16*)(F.ws + WS_W13) + (size_t)le * 2048 * 2048; c.ldt = DM; c.dst_row = (c.n0 >> 7) * 256 + which * 128 + (c.n0 & 127); }
    else { c.n0 = (sub & 63) * 32; c.k0 = (sub >> 6) * 64; c.W = AIN(I_W2) + (size_t)le * EFF * DM; c.ldw = DM; c.WT = (bf16*)(F.ws + WS_W2) + (size_t)le * 2048 * 1024; c.ldt = EFF; c.dst_row = c.n0; }
    return c;
}
__device__ __forceinline__ ConvItem early_item(const Frame& F, int it) {
    ConvItem c;
    if (it < 48 * 1024) { const int mat = it >> 10, sub = it & 1023, which = mat >> 4, le = mat & 15;
        if (which < 2) { c.n0 = (sub & 31) * 32; c.k0 = (sub >> 5) * 64; c.W = (which == 0 ? AIN(I_W1) : AIN(I_W3)) + (size_t)le * DM * EFF; c.ldw = EFF; c.WT = (bf16*)(F.ws + WS_W13) + (size_t)le * 2048 * 2048; c.ldt = DM; c.dst_row = (c.n0 >> 7) * 256 + which * 128 + (c.n0 & 127); }
        else { c.n0 = (sub & 63) * 32; c.k0 = (sub >> 6) * 64; c.W = AIN(I_W2) + (size_t)le * EFF * DM; c.ldw = DM; c.WT = (bf16*)(F.ws + WS_W2) + (size_t)le * 2048 * 1024; c.ldt = EFF; c.dst_row = c.n0; }
    } else { int r = it - 48 * 1024;
        if (r < 32 * 192) { c.n0 = (r % 192) * 32; c.k0 = (r / 192) * 64; c.W = AIN(I_HWIN); c.ldw = 3 * DM; c.WT = (bf16*)(F.ws + WS_WHYIN); c.ldt = DM; c.dst_row = c.n0; }
        else { r -= 32 * 192; c.n0 = (r % 64) * 32; c.k0 = (r / 64) * 64; c.W = AIN(I_HWOUT); c.ldw = DM; c.WT = (bf16*)(F.ws + WS_WHYO); c.ldt = DM; c.dst_row = c.n0; } }
    return c;
}
constexpr int EARLY_NIT = 48 * 1024 + 32 * 192 + 32 * 64;
__device__ __forceinline__ void conv_issue(const ConvItem& c, int lane, float (&v)[32]) {
    const float* p = c.W + (size_t)(c.k0 + (lane >> 5)) * c.ldw + c.n0 + (lane & 31); const size_t st = (size_t)2 * c.ldw;
#pragma unroll
    for (int i = 0; i < 32; ++i) { v[i] = *p; p += st; asm volatile("" : "+v"(p)); }
}
__device__ __forceinline__ void conv_finish(const ConvItem& c, int lane, const float (&v)[32]) {
    bf16* row = c.WT + (size_t)(c.dst_row + (lane & 31)) * c.ldt + c.k0 + 8 * (lane >> 5);
#pragma unroll
    for (int m = 0; m < 4; ++m) { u32x4 w;
#pragma unroll
        for (int q = 0; q < 4; ++q) { auto r = __builtin_amdgcn_permlane32_swap(__float_as_uint(v[8 * m + q]), __float_as_uint(v[8 * m + 4 + q]), false, false);
            const unsigned pk = cvt_pk_bf16(__uint_as_float(r[0]), __uint_as_float(r[1])); if (q == 0) w.x = pk; else if (q == 1) w.y = pk; else if (q == 2) w.z = pk; else w.w = pk; }
        *(GAS u32x4*)(row + 16 * m) = w; }
}
__device__ __forceinline__ void p0_prologue(Frame& F) {
    const int gw = F.bid * NWAVES + F.wave, NGW = F.G * NWAVES, gt = F.bid * NTHR + F.tid, NGT = F.G * NTHR;
#ifndef P0_REP
#define P0_REP 0
#endif
    TPS_START(20);
#pragma unroll 1
    for (int rep_a = 0; rep_a < ((P0_REP & 1) ? 2 : 1); ++rep_a) {
        LAS float* sil = (LAS float*)F.lds; LAS float* red = sil + 3 * DM;
        for (int i = F.tid; i < 3 * DM; i += NTHR) { const int v = i / DM, k = i % DM; const float cv = (v < 2) ? AIN(I_C)[v * DM + k] : AIN(I_CCTX)[k]; sil[i] = cv / (1.f + expf(-cv)); }
        __syncthreads();
        const int cl = F.tid & 7, kg = F.tid >> 3;
        for (int unit = F.bid; unit < 768; unit += F.G) {
            const int l = unit / 384, n0 = (unit % 384) * 32;
            const float* W = AIN(I_ADAW) + (size_t)l * DM * 12288 + n0 + cl * 4;
            f32x4 a0 = {0.f, 0.f, 0.f, 0.f}, a1 = a0, a2 = a0;
#pragma unroll 8
            for (int i = 0; i < 32; ++i) { const int k = kg + 64 * i; const f32x4 w = *(const f32x4*)(W + (size_t)k * 12288); a0 += w * sil[k]; a1 += w * sil[DM + k]; a2 += w * sil[2 * DM + k]; }
#pragma unroll
            for (int j = 0; j < 4; ++j) { red[(kg * 32 + cl * 4 + j) * 3 + 0] = a0[j]; red[(kg * 32 + cl * 4 + j) * 3 + 1] = a1[j]; red[(kg * 32 + cl * 4 + j) * 3 + 2] = a2[j]; }
            __syncthreads();
            if (F.tid < 96) { const int col = F.tid & 31, v = F.tid >> 5; float s = 0.f;
                for (int k = 0; k < 64; ++k) s += red[(k * 32 + col) * 3 + v];
                ((float*)(F.ws + WS_MOD))[(size_t)(l * 3 + v) * 12288 + n0 + col] = s + AIN(I_ADAB)[l * 12288 + n0 + col]; }
            __syncthreads();
        }
    }
    TPS_STOP(20); TPS_START(21);
#pragma unroll 1
    for (int rep_b = 0; rep_b < ((P0_REP & 2) ? 2 : 1); ++rep_b) {
        LAS float* scr = (LAS float*)(F.lds + F.wave * 16384);
        constexpr int I0 = 32 * 80, I1 = 32 * 64, NIT = I0 + I1 + EARLY_NIT;
        for (int it = gw; it < NIT; it += NGW) {
            int r = it;
            if (r < I0) { p0_transpose_item(AIN(I_AWIN), QKVD, (bf16*)(F.ws + WS_WQKV), DM, (r % 80) * 32, (r / 80) * 64, (r % 80) * 32, scr, F.lane); continue; } r -= I0;
            if (r < I1) { p0_transpose_item(AIN(I_AWOUT), DM, (bf16*)(F.ws + WS_WO0), DM, (r % 64) * 32, (r / 64) * 64, (r % 64) * 32, scr, F.lane); continue; } r -= I1;
            const ConvItem c = early_item(F, r); p0_transpose_item(c.W, c.ldw, c.WT, c.ldt, c.dst_row, c.k0, c.n0, scr, F.lane);
        }
    }
    TPS_STOP(21); TPS_START(22);
    {
        const int j = F.lane; const float fr = AIN(I_FFREQ)[j], b1 = AIN(I_FB1)[j], b2 = AIN(I_FB2)[j], b3 = AIN(I_FB3)[j];
        float wc1[HYEMB], wc2[HYW], wc3[HYW];
#pragma unroll
        for (int i = 0; i < HYEMB; ++i) wc1[i] = AIN(I_FW1)[i * HYW + j];
#pragma unroll
        for (int i = 0; i < HYW; ++i) { wc2[i] = AIN(I_FW2)[i * HYW + j]; wc3[i] = AIN(I_FW3)[i * HYW + j]; }
        bf16* hdn = (bf16*)(F.ws + WS_HDN);
        for (int row = gw; row < SEQ; row += NGW) {
            const float tt = (float)row / (float)(SEQ - 1); const float wv = 6.283185307179586f * (float)row / (float)SEQ;
            float zv = 0.f;
            if (j == 0) zv = tt;
            else if (j <= 32) { const int jj = (j - 1) & 15; const float f = 1e-4f + (float)jj * ((15.f - 1e-4f) / 15.f); const float a = f * wv; zv = (j <= 16) ? cosf(a) : -sinf(a); }
            float h = b1;
#pragma unroll
            for (int i = 0; i < HYEMB; ++i) h += __builtin_bit_cast(float, __builtin_amdgcn_readlane(__builtin_bit_cast(int, zv), i)) * wc1[i];
            float a1 = sinf(fr * h);
            h = b2;
#pragma unroll
            for (int i = 0; i < HYW; ++i) h += __builtin_bit_cast(float, __builtin_amdgcn_readlane(__builtin_bit_cast(int, a1), i)) * wc2[i];
            float a2 = sinf(fr * h);
            h = b3;
#pragma unroll
            for (int i = 0; i < HYW; ++i) h += __builtin_bit_cast(float, __builtin_amdgcn_readlane(__builtin_bit_cast(int, a2), i)) * wc3[i];
            const float a3 = sinf(fr * h);
            hdn[(size_t)row * 128 + j] = (bf16)(cvt_pk_bf16(a3, 0.f) & 0xffffu); hdn[(size_t)row * 128 + 64 + j] = 0;
        }
    }
    TPS_STOP(22); TPS_START(23);
    for (int i = gt; i < hy_ftab_elems(); i += NGT) ((bf16*)(F.ws + WS_FTAB))[i] = (bf16)(cvt_pk_bf16(hy_ftab_value(i >> 9, (i >> 3) & 63, i & 7), 0.f) & 0xffffu);
    for (int i = gt; i < 4096; i += NGT) { const int pos = i >> 4, dd = i & 15; const float inv = powf(10000.f, -(float)(2 * dd) / 32.f); const float a = (float)pos * inv;
        ((float*)(F.ws + WS_ROPE))[i] = cosf(a); ((float*)(F.ws + WS_ROPE))[4096 + i] = sinf(a); }
    for (int i = gt; i < 4096 * 128; i += NGT) { const int k = i >> 12, n = i & 4095;
        ((bf16*)(F.ws + WS_W4T))[(size_t)n * 128 + k] = (k < 64) ? (bf16)(cvt_pk_bf16(AIN(I_FW4)[(size_t)k * 4096 + n], 0.f) & 0xffffu) : (bf16)0; }
    TPS_STOP(23);
}

__device__ __forceinline__ void p1_prologue(Frame& F) {
    if (F.wave < 4) {
        for (int tile = F.bid * 4 + F.wave; tile < 1024; tile += F.G * 4) {
            const int r0 = (tile >> 5) * 16, n0 = (tile & 31) * 16; const int lr = F.lane & 15, kq = F.lane >> 4;
            const float* crow = AIN(I_CTX) + (size_t)(r0 + lr) * DM; const float* sh = mod_ptr(F, 0, 2, 0); const float* sc = mod_ptr(F, 0, 2, 1);
            const bf16* wrow = (const bf16*)(F.ws + WS_WQKV) + (size_t)(2048 + n0 + lr) * DM;
            f32x4 acc = {0.f, 0.f, 0.f, 0.f};
#pragma unroll 4
            for (int k0 = 0; k0 < DM; k0 += 32) { const int k = k0 + 8 * kq;
                const f32x4 x0 = *(const f32x4*)(crow + k), x1 = *(const f32x4*)(crow + k + 4), s0 = *(const f32x4*)(sc + k), s1 = *(const f32x4*)(sc + k + 4), h0 = *(const f32x4*)(sh + k), h1 = *(const f32x4*)(sh + k + 4);
                const f32x4 u0 = x0 * (s0 + 1.f) + h0, u1 = x1 * (s1 + 1.f) + h1;
                u32x4 aw; aw.x = cvt_pk_bf16(u0[0], u0[1]); aw.y = cvt_pk_bf16(u0[2], u0[3]); aw.z = cvt_pk_bf16(u1[0], u1[1]); aw.w = cvt_pk_bf16(u1[2], u1[3]);
                const bf16x8 bfrag = *(const bf16x8*)(wrow + k);
                acc = __builtin_amdgcn_mfma_f32_16x16x32_bf16(__builtin_bit_cast(bf16x8, aw), bfrag, acc, 0, 0, 0); }
            const float bb = AIN(I_ABIN)[2048 + n0 + lr]; bf16* o = (bf16*)(F.ws + WS_CTXKV);
#pragma unroll
            for (int r = 0; r < 4; ++r) o[(size_t)(r0 + 4 * kq + r) * 512 + n0 + lr] = (bf16)(cvt_pk_bf16(acc[r] + bb, 0.f) & 0xffffu);
        }
    }
    if (F.bid < 4 && F.wave == 7) {
        const int l = F.bid >> 1, b = F.bid & 1; const float* sc2 = mod_ptr(F, l, b, 4); int* map = (int*)(F.ws + WS_BADMAP) + (size_t)(l * 2 + b) * DM;
        int* inv = (int*)(F.ws + WS_BADMAP + 32768) + (l * 2 + b) * 64;
        const unsigned long long lt = (1ull << F.lane) - 1ull;
        int run = 0;
        for (int it = 0; it < DM / 256; ++it) { const int cb = it * 256 + 4 * F.lane;
            const f32x4 sv = *(const f32x4*)(sc2 + cb);
            int flags[4], sl = run, tot = 0;
#pragma unroll
            for (int i = 0; i < 4; ++i) { flags[i] = fabsf(1.f + sv[i]) < BAD_THR; const unsigned long long m = __builtin_amdgcn_ballot_w64(flags[i] != 0); sl += __builtin_popcountll(m & lt); tot += __builtin_popcountll(m); }
#pragma unroll
            for (int i = 0; i < 4; ++i) { const bool use = flags[i] && sl < 64; map[cb + i] = use ? sl : -1; if (use) inv[sl] = cb + i; sl += flags[i]; }
            run += tot; }
        const int total = run < 64 ? run : 64;
        if (F.lane >= total) inv[F.lane] = -1;
        if (F.lane == 0) ((int*)(F.ws + WS_BADMAP + 32768 + 1024))[l * 2 + b] = total;
    }
    const float* x = AIN(I_X); bf16* u0 = (bf16*)(F.ws + WS_A);
    LAS int* cnt = (LAS int*)(F.lds + RING_BYTES + 64);
    const size_t NI = (size_t)MTOK * DM / 8; const size_t per = (NI + F.G - 1) / F.G; const size_t i0 = (size_t)F.bid * per; const size_t i1 = (i0 + per < NI) ? i0 + per : NI;
    const int nch = (int)((i1 - i0 + 255) / 256);
    for (;;) {
        int c = 0; if (F.lane == 0) c = __hip_atomic_fetch_add(cnt, 1, __ATOMIC_RELAXED, __HIP_MEMORY_SCOPE_WORKGROUP);
        c = __builtin_amdgcn_readfirstlane(c); if (c >= nch) break;
        f32x4 xa[4], xb[4]; size_t ee[4];
#pragma unroll
        for (int j = 0; j < 4; ++j) { const size_t i = i0 + (size_t)c * 256 + j * 64 + F.lane; ee[j] = (i < i1) ? i * 8 : (size_t)-1; if (i < i1) { xa[j] = *(const f32x4*)(x + i * 8); xb[j] = *(const f32x4*)(x + i * 8 + 4); } }
#pragma unroll
        for (int j = 0; j < 4; ++j) { if (ee[j] == (size_t)-1) continue; const size_t e = ee[j]; const int col = (int)(e & (DM - 1)); const int b = (int)(e / ((size_t)SEQ * DM));
            const float* sh = mod_ptr(F, 0, b, 0) + col; const float* sc = mod_ptr(F, 0, b, 1) + col;
            const f32x4 v0 = xa[j] * (*(const f32x4*)sc + 1.f) + *(const f32x4*)sh, v1 = xb[j] * (*(const f32x4*)(sc + 4) + 1.f) + *(const f32x4*)(sh + 4);
            u32x4 w; w.x = cvt_pk_bf16(v0[0], v0[1]); w.y = cvt_pk_bf16(v0[2], v0[3]); w.z = cvt_pk_bf16(v1[0], v1[1]); w.w = cvt_pk_bf16(v1[2], v1[3]);
            *(u32x4*)(u0 + e) = w; }
    }
}
namespace att {
constexpr int LDS_K = 0, LDS_V = 24576, LDS_WS = 49152, LDS_OST = LDS_WS + NWAVES * 64 * 4, LDS_Q = LDS_OST + NWAVES * 4096;
__device__ __forceinline__ int crow(int r, int hi) { return (r & 3) + 8 * (r >> 2) + 4 * hi; }
__device__ __forceinline__ float max3f(float a, float b, float c) { return __builtin_fmaxf(__builtin_fmaxf(a, b), c); }
__device__ __forceinline__ float rowmax(const f32x16& p0, const f32x16& p1) {
    float a = max3f(p0[0], p0[1], p1[0]), b = max3f(p0[2], p0[3], p1[1]); a = max3f(a, p1[2], p1[3]);
#pragma unroll
    for (int r = 4; r < 16; r += 4) { a = max3f(a, p0[r], p0[r + 1]); b = max3f(b, p0[r + 2], p0[r + 3]); a = max3f(a, p1[r], p1[r + 1]); b = max3f(b, p1[r + 2], p1[r + 3]); }
    const float m = __builtin_fmaxf(a, b);
    auto rr = __builtin_amdgcn_permlane32_swap(__float_as_uint(m), __float_as_uint(m), false, false);
    return __builtin_fmaxf(__uint_as_float(rr[0]), __uint_as_float(rr[1]));
}
__device__ __forceinline__ void qkt(f32x16& p0, f32x16& p1, const LAS unsigned char* Kslot, const bf16x8* qr, const f32x16& z, int r32, int hi) {
    const LAS unsigned char* kb = Kslot + hi * 1024 + r32 * 16;
#pragma unroll
    for (int d0 = 0; d0 < 4; ++d0) {
        const bf16x8 b0 = *(const LAS bf16x8*)(kb + d0 * 2048);
        const bf16x8 b1 = *(const LAS bf16x8*)(kb + d0 * 2048 + 512);
        if (d0 == 0) { p0 = __builtin_amdgcn_mfma_f32_32x32x16_bf16(b0, qr[0], z, 0, 0, 0); p1 = __builtin_amdgcn_mfma_f32_32x32x16_bf16(b1, qr[0], z, 0, 0, 0); }
        else { p0 = __builtin_amdgcn_mfma_f32_32x32x16_bf16(b0, qr[d0], p0, 0, 0, 0); p1 = __builtin_amdgcn_mfma_f32_32x32x16_bf16(b1, qr[d0], p1, 0, 0, 0); }
    }
}
__device__ __forceinline__ void pv(f32x16* o, int vb, bf16x8 pa0, bf16x8 pa1, bf16x8 pa2, bf16x8 pa3) {
#pragma unroll
    for (int d0 = 0; d0 < 2; ++d0) { s16x4 lo[4], hi[4];
#pragma unroll
        for (int ks = 0; ks < 4; ++ks) {
            asm volatile("ds_read_b64_tr_b16 %0,%1 offset:%c2" : "=&v"(lo[ks]) : "v"(vb), "i"(d0 * 4096 + ks * 1024) : "memory");
            asm volatile("ds_read_b64_tr_b16 %0,%1 offset:%c2" : "=&v"(hi[ks]) : "v"(vb), "i"(d0 * 4096 + ks * 1024 + 512) : "memory"); }
        asm volatile("s_waitcnt lgkmcnt(0)" ::: "memory"); __builtin_amdgcn_sched_barrier(0);
#define PK(k) (bf16x8){lo[k][0], lo[k][1], lo[k][2], lo[k][3], hi[k][0], hi[k][1], hi[k][2], hi[k][3]}
        o[d0] = __builtin_amdgcn_mfma_f32_32x32x16_bf16(pa0, PK(0), o[d0], 0, 0, 0);
        o[d0] = __builtin_amdgcn_mfma_f32_32x32x16_bf16(pa1, PK(1), o[d0], 0, 0, 0);
        o[d0] = __builtin_amdgcn_mfma_f32_32x32x16_bf16(pa2, PK(2), o[d0], 0, 0, 0);
        o[d0] = __builtin_amdgcn_mfma_f32_32x32x16_bf16(pa3, PK(3), o[d0], 0, 0, 0);
#undef PK
    }
}
__device__ __forceinline__ void attn_issue(const Frame& F, int u, int t, int slot) {
    const int lane = F.lane, wid = F.wave; LAS unsigned char* shm = F.lds;
    const int qb = u % (SEQ / 32), bk = u / (SEQ / 32), b = bk / NKV, kvh = bk % NKV; const int q0 = qb * 32;
    const bf16* Kb = (const bf16*)(F.ws + WS_B + 128 * MiB); const bf16* Vb = (const bf16*)(F.ws + WS_B + 144 * MiB); const bf16* CKV = (const bf16*)(F.ws + WS_CTXKV);
    const size_t tok0 = (size_t)b * SEQ; const bf16* ksrc; const bf16* vsrc;
    if (t < 4) { const int c0 = b * CTXL + t * 64;
        ksrc = CKV + (size_t)(c0 + lane) * 512 + kvh * HD + wid * 8;
        vsrc = CKV + (size_t)(c0 + 16 * (wid & 3) + (lane >> 2)) * 512 + 256 + kvh * HD + (wid >> 2) * 32 + (lane & 3) * 8;
    } else { const int key0 = ((q0 - 128) & ~63) + (t - 4) * 64;
        int kr = key0 + lane; kr = kr < 0 ? 0 : (kr > SEQ - 1 ? SEQ - 1 : kr);
        int vr = key0 + 16 * (wid & 3) + (lane >> 2); vr = vr < 0 ? 0 : (vr > SEQ - 1 ? SEQ - 1 : vr);
        ksrc = Kb + (tok0 + kr) * KVD + kvh * HD + wid * 8;
        vsrc = Vb + (tok0 + vr) * KVD + kvh * HD + (wid >> 2) * 32 + (lane & 3) * 8;
    }
    __builtin_amdgcn_global_load_lds((const unsigned*)ksrc, (LAS unsigned*)(shm + LDS_K + slot * 8192 + wid * 1024), 16, 0, 0);
    __builtin_amdgcn_global_load_lds((const unsigned*)vsrc, (LAS unsigned*)(shm + LDS_V + slot * 8192 + wid * 1024), 16, 0, 0);
    if (t == 0) {
        const bf16* Qw = (const bf16*)(F.ws + WS_B) + (tok0 + q0 + (lane & 31)) * DM + (kvh * 8 + wid) * HD + (lane >> 5) * 8;
#pragma unroll
        for (int d0 = 0; d0 < 4; ++d0) __builtin_amdgcn_global_load_lds((const unsigned*)(Qw + d0 * 16), (LAS unsigned*)(shm + LDS_Q + wid * 4096 + d0 * 1024), 16, 0, 0);
    }
}
__device__ __forceinline__ void attn_phase(const Frame& F) {
    const int NU = NB * NKV * (SEQ / 32); const int per = (NU + F.G - 1) / F.G;
    const int u0 = F.bid * per; const int u1 = (u0 + per < NU) ? u0 + per : NU; if (u0 >= u1) return;
    const int ntile = (u1 - u0) * 9;
    const int lane = F.lane, r32 = lane & 31, hi = lane >> 5, wid = F.wave;
    LAS unsigned char* shm = F.lds;
    bf16* O = (bf16*)(F.ws + WS_A);
    LAS float* wsf = (LAS float*)(shm + LDS_WS) + wid * 64;
    const int vb0 = (int)(uintptr_t)(shm + LDS_V) + ((lane >> 4) & 1) * 32 + (lane & 3) * 8 + (4 * hi + ((lane & 15) >> 2)) * 64;
    bf16x8 qr[4]; float mref = 0.f, l_reg = 0.f; f32x16 o[2]; o[0] = f32x16{}; o[1] = f32x16{}; f32x16 negm = f32x16{};
    attn_issue(F, u0, 0, 0);
    if (ntile > 1) attn_issue(F, u0, 1, 1);
    int u = u0, t = 0;
    for (int g = 0; g < ntile; ++g) {
        const int slot = g % 3;
        const int qb = u % (SEQ / 32), bk = u / (SEQ / 32), b = bk / NKV, kvh = bk % NKV; const int q0 = qb * 32; const int head = kvh * 8 + wid; const size_t tok0 = (size_t)b * SEQ;
        if (g + 1 < ntile) { if (t == 8) asm volatile("s_waitcnt vmcnt(6)" ::: "memory"); else asm volatile("s_waitcnt vmcnt(2)" ::: "memory"); }
        else asm volatile("s_waitcnt vmcnt(0)" ::: "memory");
        LDS_WAIT(); __builtin_amdgcn_s_barrier();
        if (g + 2 < ntile) { const int g2 = g + 2; attn_issue(F, u0 + g2 / 9, g2 % 9, g2 % 3); }
        if (t == 0) {
#pragma unroll
            for (int d0 = 0; d0 < 4; ++d0) qr[d0] = *(const LAS bf16x8*)(shm + LDS_Q + wid * 4096 + d0 * 1024 + lane * 16);
            mref = 0.f; l_reg = 0.f; o[0] = f32x16{}; o[1] = f32x16{}; negm = f32x16{}; }
        f32x16 p0, p1;
        qkt(p0, p1, shm + LDS_K + slot * 8192, qr, negm, r32, hi);
        { const int key0 = ((q0 - 128) & ~63) + (t - 4) * 64;
          if (t >= 4 && (t == 4 || t == 8 || key0 < 0 || key0 + 64 > SEQ)) { const int qpos = q0 + r32;
#pragma unroll
            for (int r = 0; r < 16; ++r) { const int k0 = key0 + crow(r, hi), k1 = k0 + 32;
                const bool v0 = (k0 >= 0) && (k0 < SEQ) && (k0 - qpos <= 128) && (qpos - k0 <= 128);
                const bool v1 = (k1 >= 0) && (k1 < SEQ) && (k1 - qpos <= 128) && (qpos - k1 <= 128);
                p0[r] = v0 ? p0[r] : -INFINITY; p1[r] = v1 ? p1[r] : -INFINITY; } } }
        const float rm = rowmax(p0, p1);
        if (__any(rm > 8.f)) {
            const float dl = __builtin_fmaxf(rm, 0.f); mref += dl;
            const float f = __builtin_amdgcn_exp2f(-dl); l_reg *= f;
#pragma unroll
            for (int r = 0; r < 16; ++r) { p0[r] -= dl; p1[r] -= dl; negm[r] = -mref; }
            if (hi == 0) wsf[r32] = f;
            LDS_WAIT();
#pragma unroll
            for (int d = 0; d < 2; ++d)
#pragma unroll
                for (int r = 0; r < 16; ++r) o[d][r] *= wsf[crow(r, hi)];
        }
        float sacc = 0.f;
#pragma unroll
        for (int r = 0; r < 16; ++r) { p0[r] = __builtin_amdgcn_exp2f(p0[r]); p1[r] = __builtin_amdgcn_exp2f(p1[r]); sacc += p0[r] + p1[r]; }
        l_reg += sacc;
        u32x4 pw0, pw1, pw2, pw3;
#define PKW(P, B) cvt_pk_bf16(P[B], P[B + 1])
        pw0 = (u32x4){PKW(p0, 0), PKW(p0, 2), PKW(p0, 4), PKW(p0, 6)}; pw1 = (u32x4){PKW(p0, 8), PKW(p0, 10), PKW(p0, 12), PKW(p0, 14)};
        pw2 = (u32x4){PKW(p1, 0), PKW(p1, 2), PKW(p1, 4), PKW(p1, 6)}; pw3 = (u32x4){PKW(p1, 8), PKW(p1, 10), PKW(p1, 12), PKW(p1, 14)};
#undef PKW
        pv(o, vb0 + slot * 8192, __builtin_bit_cast(bf16x8, pw0), __builtin_bit_cast(bf16x8, pw1), __builtin_bit_cast(bf16x8, pw2), __builtin_bit_cast(bf16x8, pw3));
        if (t == 8) {
            { auto rr = __builtin_amdgcn_permlane32_swap(__float_as_uint(l_reg), __float_as_uint(l_reg), false, false); l_reg = __uint_as_float(rr[0]) + __uint_as_float(rr[1]); }
            l_reg += __builtin_amdgcn_exp2f(AIN(I_SINK)[head] * 1.4426950408889634f - mref);
            if (hi == 0) wsf[32 + r32] = l_reg;
            LDS_WAIT();
            float rli[16];
#pragma unroll
            for (int r = 0; r < 16; ++r) rli[r] = 1.f / wsf[32 + crow(r, hi)];
            bf16* Ow = O + (tok0 + q0) * DM + head * HD;
            LAS bf16* stg = (LAS bf16*)(shm + LDS_OST) + wid * 2048;
#pragma unroll
            for (int r = 0; r < 16; ++r) { const int orow = crow(r, hi);
#pragma unroll
                for (int d0 = 0; d0 < 2; ++d0) stg[orow * 64 + d0 * 32 + r32] = (bf16)(cvt_pk_bf16(o[d0][r] * rli[r], 0.f) & 0xffffu); }
            LDS_WAIT();
#pragma unroll
            for (int i = 0; i < 4; ++i) { const int row = i * 8 + (lane >> 3), ch = lane & 7; const u32x4 v = *(const LAS u32x4*)(stg + row * 64 + ch * 8); *(u32x4*)(Ow + (size_t)row * DM + ch * 8) = v; }
        }
        if (t == 8) { t = 0; ++u; } else ++t;
    }
}
}

__device__ __forceinline__ float row16_sum(float v) {
    v += __builtin_bit_cast(float, __builtin_amdgcn_update_dpp(0, __builtin_bit_cast(int, v), 0xB1, 0xf, 0xf, true));
    v += __builtin_bit_cast(float, __builtin_amdgcn_update_dpp(0, __builtin_bit_cast(int, v), 0x4E, 0xf, 0xf, true));
    v += __builtin_bit_cast(float, __builtin_amdgcn_update_dpp(0, __builtin_bit_cast(int, v), 0x141, 0xf, 0xf, true));
    v += __builtin_bit_cast(float, __builtin_amdgcn_update_dpp(0, __builtin_bit_cast(int, v), 0x140, 0xf, 0xf, true));
    return v;
}
template <int NV> __device__ __forceinline__ void block_reduce(const float (&x)[NV], LAS float* red, LAS float* tot, int tid, int lane, int wave) {
    float y[NV / 2], z[NV / 4];
#pragma unroll
    for (int i = 0; i < NV / 2; ++i) { auto r = __builtin_amdgcn_permlane32_swap(__float_as_uint(x[i]), __float_as_uint(x[i + NV / 2]), false, false); y[i] = __uint_as_float(r[0]) + __uint_as_float(r[1]); }
#pragma unroll
    for (int i = 0; i < NV / 4; ++i) { auto r = __builtin_amdgcn_permlane16_swap(__float_as_uint(y[i]), __float_as_uint(y[i + NV / 4]), false, false); z[i] = row16_sum(__uint_as_float(r[0]) + __uint_as_float(r[1])); }
    if ((lane & 15) == 0) { const int q = lane >> 4;
#pragma unroll
        for (int i = 0; i < NV / 4; ++i) red[wave * NV + i + q * (NV / 4)] = z[i]; }
    __syncthreads();
    if (tid < NV) { float s = 0.f;
#pragma unroll
        for (int w = 0; w < NWAVES; ++w) s += red[w * NV + tid];
        tot[tid] = s; }
    __syncthreads();
}
struct LnLds { LAS float* red; LAS float* tot; LAS float* sab; LAS int* lcnt; LAS int* lbase; LAS int* lcls; LAS int* lrank; LAS float* lg; LAS float* rowtab; };
__device__ __forceinline__ LnLds ln_lds(const Frame& F) { LnLds L; L.red = (LAS float*)F.lds; L.tot = L.red + 8 * 72; L.sab = L.tot + 72; L.lcnt = (LAS int*)(L.sab + 32); L.lbase = L.lcnt + 32; L.lcls = L.lbase + 32; L.lrank = L.lcls + 256; L.lg = (LAS float*)(L.lrank + 256); L.rowtab = L.lg + 512; return L; }

template <bool HIN_F32, bool SIDE> __device__ __forceinline__ void ln1_router_impl(const Frame& F, int layer, const void* hin_, const bf16* ymix, bf16* u2out, bf16* hout) {
    const float* hin = (const float*)hin_; const bf16* hinb = (const bf16*)hin_;
    const LnLds L = ln_lds(F);
    const int tid = F.tid, lane = F.lane, wave = F.wave, c0 = 4 * tid;
    int per = (MTOK + F.G - 1) / F.G; per = (per + 3) & ~3;
    const int rbase = F.bid * per; const int rend = (rbase + per < MTOK) ? rbase + per : MTOK; const int nrows = rend - rbase;
    if (tid < NCLS) L.lcnt[tid] = 0;
    if (nrows > 0 && nrows <= 256) {
    const int b = rbase / SEQ;
    const f32x4 g1 = *(const f32x4*)(mod_ptr(F, layer, b, 2) + c0), sh2 = *(const f32x4*)(mod_ptr(F, layer, b, 3) + c0), sc2 = *(const f32x4*)(mod_ptr(F, layer, b, 4) + c0);
    const f32x4 A0 = *(const f32x4*)(AIN(I_LN1G) + layer * DM + c0), B0 = *(const f32x4*)(AIN(I_LN1B) + layer * DM + c0);
    const f32x4 A1 = A0 * (sc2 + 1.f), B1 = B0 * (sc2 + 1.f) + sh2;
    int scol = -1; if (SIDE) scol = ((const int*)(F.ws + WS_BADMAP + 32768))[(layer * 2 + b) * 64 + lane];
    const bool smine = (scol >= 0) && ((scol >> 8) == wave);
    const int sidx = 4 * ((scol >> 2) & 63), ssel = scol & 3;
    u32x2* sbase = smine ? (u32x2*)(F.ws + WS_SIDE) + lane : (u32x2*)(F.ws + WS_SIDE + 4 * MiB) + (size_t)(F.bid * 8 + wave) * 64 + lane;
    const size_t sstride = smine ? 64 : 0;
    bool sact[4];
#pragma unroll
    for (int i = 0; i < 4; ++i) sact[i] = __builtin_amdgcn_ballot_w64(smine && ssel == i) != 0;
    f32x4 P[4][4];
    { float sx[32];
#pragma unroll
      for (int c = 0; c < 4; ++c)
#pragma unroll
          for (int g = 0; g < 4; ++g) { const f32x4 w = *(const f32x4*)(AIN(I_RW) + (size_t)(c0 + c) * NEXP + 4 * g); P[c][g] = w * A1[c];
#pragma unroll
              for (int i = 0; i < 4; ++i) { if (c == 0) { sx[g * 4 + i] = 0.f; sx[16 + g * 4 + i] = 0.f; } sx[g * 4 + i] += w[i] * A1[c]; sx[16 + g * 4 + i] += w[i] * B1[c]; } }
      block_reduce<32>(sx, L.red, L.tot, tid, lane, wave);
      if (tid < 32) L.sab[tid] = L.tot[tid];
      __syncthreads(); }
    const float* rb = AIN(I_RB);
    f32x4 hv[4], hv2[4]; u32x2 yv[4], yv2[4];
#define LN_LOADH(dst, o) do { if (HIN_F32) dst = *(const f32x4*)(hin + (o)); else { const u32x2 hw_ = *(const u32x2*)(hinb + (o)); dst = (f32x4){bflo(hw_.x), bfhi(hw_.x), bflo(hw_.y), bfhi(hw_.y)}; } } while (0)
#pragma unroll
    for (int r = 0; r < 4; ++r) { const size_t o = (size_t)(rbase + r) * DM + c0; LN_LOADH(hv[r], o); yv[r] = *(const u32x2*)(ymix + o); }
    if (rbase + 4 < rend) {
#pragma unroll
        for (int r = 0; r < 4; ++r) { const size_t o = (size_t)(rbase + 4 + r) * DM + c0; LN_LOADH(hv2[r], o); yv2[r] = *(const u32x2*)(ymix + o); } }
    for (int row0 = rbase; row0 < rend; row0 += 4) {
        f32x4 v[4]; float x[72];
#pragma unroll
        for (int r = 0; r < 4; ++r) { const f32x4 y = {bflo(yv[r].x), bfhi(yv[r].x), bflo(yv[r].y), bfhi(yv[r].y)}; v[r] = hv[r] * DN_ALPHA + g1 * y;
            x[r * 18] = (v[r][0] + v[r][1]) + (v[r][2] + v[r][3]); x[r * 18 + 1] = (v[r][0] * v[r][0] + v[r][1] * v[r][1]) + (v[r][2] * v[r][2] + v[r][3] * v[r][3]);
#pragma unroll
            for (int g = 0; g < 4; ++g) { const f32x4 q = P[0][g] * v[r][0] + P[1][g] * v[r][1] + P[2][g] * v[r][2] + P[3][g] * v[r][3];
                x[r * 18 + 2 + 4 * g] = q[0]; x[r * 18 + 3 + 4 * g] = q[1]; x[r * 18 + 4 + 4 * g] = q[2]; x[r * 18 + 5 + 4 * g] = q[3]; } }
#pragma unroll
        for (int r = 0; r < 4; ++r) { hv[r] = hv2[r]; yv[r] = yv2[r]; }
        if (row0 + 8 < rend) {
#pragma unroll
            for (int r = 0; r < 4; ++r) { const size_t o = (size_t)(row0 + 8 + r) * DM + c0; LN_LOADH(hv2[r], o); yv2[r] = *(const u32x2*)(ymix + o); } }
        LAS float* gt = L.rowtab + ((row0 - rbase) >> 2) * 72;
        block_reduce<72>(x, L.red, gt, tid, lane, wave);
        float smr[4], srr[4];
#pragma unroll
        for (int r = 0; r < 4; ++r) { const float mean = gt[r * 18] * (1.f / DM); const float var = gt[r * 18 + 1] * (1.f / DM) - mean * mean; const float rstd = 1.f / sqrtf(var + LN_EPS);
            const f32x4 vn = (v[r] - mean) * rstd; const f32x4 u = vn * A1 + B1; const size_t o = (size_t)(row0 + r) * DM + c0;
            if (SIDE) { smr[r] = mean; srr[r] = rstd; }
            u32x2 w; w.x = cvt_pk_bf16(u[0], u[1]); w.y = cvt_pk_bf16(u[2], u[3]); *(u32x2*)(u2out + o) = w; }
        if (SIDE) { u32x2 so = {0u, 0u};
#pragma unroll
            for (int i = 0; i < 4; ++i) if (sact[i]) { float h[4];
#pragma unroll
                for (int r = 0; r < 4; ++r) h[r] = (v[r][i] - smr[r]) * srr[r] * A0[i] + B0[i];
                const unsigned q0 = (unsigned)__builtin_amdgcn_ds_bpermute(sidx, (int)cvt_pk_bf16(h[0], h[1])), q1 = (unsigned)__builtin_amdgcn_ds_bpermute(sidx, (int)cvt_pk_bf16(h[2], h[3]));
                if (ssel == i) { so.x = q0; so.y = q1; } }
            sbase[(size_t)(row0 >> 2) * sstride] = so; }
    }
    __syncthreads();
    if (tid < nrows) {
            const int rl = tid; const LAS float* gt = L.rowtab + (rl >> 2) * 72 + (rl & 3) * 18;
            const float mean = gt[0] * (1.f / DM); const float var = gt[1] * (1.f / DM) - mean * mean; const float rstd = 1.f / sqrtf(var + LN_EPS);
            float sg[16], sel[16];
#pragma unroll
            for (int e = 0; e < 16; ++e) { const float lgt = rstd * (gt[2 + e] - mean * L.sab[e]) + L.sab[16 + e]; const float sv = 1.f / (1.f + expf(-lgt)); sg[e] = sv; sel[e] = sv + rb[e]; }
            int gb = 0; float gbs = -INFINITY;
#pragma unroll
            for (int g = 0; g < 4; ++g) { const float a = sel[4 * g], bq = sel[4 * g + 1], c = sel[4 * g + 2], d = sel[4 * g + 3];
                const float ps = fmaxf(fmaxf(fmaxf(a + bq, a + c), fmaxf(a + d, bq + c)), fmaxf(bq + d, c + d)); if (ps > gbs) { gbs = ps; gb = g; } }
            float cs[4], cg[4];
#pragma unroll
            for (int i = 0; i < 4; ++i) { cs[i] = sel[i]; cg[i] = sg[i];
#pragma unroll
                for (int g = 1; g < 4; ++g) if (gb == g) { cs[i] = sel[4 * g + i]; cg[i] = sg[4 * g + i]; } }
            int i0 = 0; float b0 = cs[0];
#pragma unroll
            for (int i = 1; i < 4; ++i) if (cs[i] > b0) { b0 = cs[i]; i0 = i; }
            int i1 = -1; float b1 = -INFINITY;
#pragma unroll
            for (int i = 0; i < 4; ++i) if (i != i0 && cs[i] > b1) { b1 = cs[i]; i1 = i; }
            float ga = 0.f, gbv = 0.f;
#pragma unroll
            for (int i = 0; i < 4; ++i) { if (i == i0) ga = cg[i]; if (i == i1) gbv = cg[i]; }
            const float den = ga + gbv; ga /= den; gbv /= den;
            const int lo = i0 < i1 ? i0 : i1, hi = i0 < i1 ? i1 : i0; const float glo = i0 < i1 ? ga : gbv, ghi = i0 < i1 ? gbv : ga;
            const int pidx = (lo == 0) ? (hi - 1) : (lo == 1 ? hi + 1 : 5);
            const int cls = gb * 6 + pidx;
            L.lcls[rl] = cls; L.lrank[rl] = __hip_atomic_fetch_add(&L.lcnt[cls], 1, __ATOMIC_RELAXED, __HIP_MEMORY_SCOPE_WORKGROUP); L.lg[2 * rl] = glo; L.lg[2 * rl + 1] = ghi;
    }
    }
    __syncthreads();
    if (tid < NCLS) L.lbase[tid] = (int)__hip_atomic_fetch_add((unsigned*)(F.ctl + CW_CNT + (layer * NCLS + tid) * 64), (unsigned)L.lcnt[tid], RLX_AGENT);
    __syncthreads();
    if (tid < nrows && nrows <= 256) { const int cls = L.lcls[tid]; const int pos = cls * LCAP + L.lbase[cls] + L.lrank[tid];
        ((int*)(F.ws + WS_TOK))[pos] = rbase + tid; ((float*)(F.ws + WS_GATE))[(size_t)pos * 2] = L.lg[2 * tid]; ((float*)(F.ws + WS_GATE))[(size_t)pos * 2 + 1] = L.lg[2 * tid + 1]; }
}
#undef LN_LOADH
template <bool OUT_F32, bool SIDE> __device__ __forceinline__ void ln2_impl(const Frame& F, int layer, const bf16* fio, bf16* hinb, void* hout_) {
    float* houtf = (float*)hout_; bf16* houtb = (bf16*)hout_;
    const LnLds L = ln_lds(F);
    const int tid = F.tid, lane = F.lane, wave = F.wave, c0 = 4 * tid;
    int per = (MTOK + F.G - 1) / F.G; per = (per + 3) & ~3;
    const int rbase = F.bid * per; const int rend = (rbase + per < MTOK) ? rbase + per : MTOK;
    if (rbase >= rend) return;
    const int b = rbase / SEQ;
    const f32x4 g2 = *(const f32x4*)(mod_ptr(F, layer, b, 5) + c0), sh1 = *(const f32x4*)(mod_ptr(F, 1, b, 0) + c0), sc1 = *(const f32x4*)(mod_ptr(F, 1, b, 1) + c0);
    const f32x4 A0 = *(const f32x4*)(AIN(I_LN2G) + layer * DM + c0), B0 = *(const f32x4*)(AIN(I_LN2B) + layer * DM + c0);
    const f32x4 A1 = A0 * (sc1 + 1.f), B1 = B0 * (sc1 + 1.f) + sh1;
    const f32x4 sh2 = *(const f32x4*)(mod_ptr(F, layer, b, 3) + c0), sc2p = *(const f32x4*)(mod_ptr(F, layer, b, 4) + c0) + 1.f;
    f32x4 rs2; for (int i = 0; i < 4; ++i) rs2[i] = (fabsf(sc2p[i]) > 1e-6f) ? 1.f / sc2p[i] : 0.f;
    int bslot[4] = {-1, -1, -1, -1}; if (SIDE) { const int* map = (const int*)(F.ws + WS_BADMAP) + (size_t)(layer * 2 + b) * DM + c0;
#pragma unroll
      for (int i = 0; i < 4; ++i) bslot[i] = map[i]; }
    const u32x2* sidel = (const u32x2*)(F.ws + WS_SIDE) + lane;
    int bidx[4]; bool sact[4];
#pragma unroll
    for (int i = 0; i < 4; ++i) { bidx[i] = 4 * (bslot[i] < 0 ? 0 : bslot[i]); sact[i] = __builtin_amdgcn_ballot_w64(bslot[i] >= 0) != 0; }
    u32x2 hw[4], hw2[4], hw3[4]; u32x2 yv[4], yv2[4], yv3[4]; u32x2 sw = {0u, 0u}, sw2 = {0u, 0u}, sw3 = {0u, 0u};
#pragma unroll
    for (int r = 0; r < 4; ++r) { const size_t o = (size_t)(rbase + r) * DM + c0; hw[r] = *(const u32x2*)(hinb + o); yv[r] = *(const u32x2*)(fio + o); }
    if (SIDE) sw = sidel[(size_t)(rbase >> 2) * 64];
#pragma unroll
    for (int r = 0; r < 4; ++r) { const size_t o = (size_t)(rbase + 4 + r) * DM + c0; if (rbase + 4 < rend) { hw2[r] = *(const u32x2*)(hinb + o); yv2[r] = *(const u32x2*)(fio + o); } }
    if (SIDE) if (rbase + 4 < rend) sw2 = sidel[(size_t)((rbase + 4) >> 2) * 64];
#pragma unroll
    for (int r = 0; r < 4; ++r) { const size_t o = (size_t)(rbase + 8 + r) * DM + c0; if (rbase + 8 < rend) { hw3[r] = *(const u32x2*)(hinb + o); yv3[r] = *(const u32x2*)(fio + o); } }
    if (SIDE) if (rbase + 8 < rend) sw3 = sidel[(size_t)((rbase + 8) >> 2) * 64];
    for (int row0 = rbase; row0 < rend; row0 += 4) {
        f32x4 v[4]; float x[8]; f32x4 hq[4];
#pragma unroll
        for (int r = 0; r < 4; ++r) { const f32x4 uvr = {bflo(hw[r].x), bfhi(hw[r].x), bflo(hw[r].y), bfhi(hw[r].y)}; hq[r] = (uvr - sh2) * rs2; }
        if (SIDE) {
#pragma unroll
            for (int i = 0; i < 4; ++i) if (sact[i]) { const unsigned t0 = (unsigned)__builtin_amdgcn_ds_bpermute(bidx[i], (int)sw.x), t1 = (unsigned)__builtin_amdgcn_ds_bpermute(bidx[i], (int)sw.y); const bool m = bslot[i] >= 0;
                hq[0][i] = m ? bflo(t0) : hq[0][i]; hq[1][i] = m ? bfhi(t0) : hq[1][i]; hq[2][i] = m ? bflo(t1) : hq[2][i]; hq[3][i] = m ? bfhi(t1) : hq[3][i]; } }
#pragma unroll
        for (int r = 0; r < 4; ++r) { const f32x4 y = {bflo(yv[r].x), bfhi(yv[r].x), bflo(yv[r].y), bfhi(yv[r].y)};
            v[r] = hq[r] * DN_ALPHA + g2 * y;
            x[r * 2] = (v[r][0] + v[r][1]) + (v[r][2] + v[r][3]); x[r * 2 + 1] = (v[r][0] * v[r][0] + v[r][1] * v[r][1]) + (v[r][2] * v[r][2] + v[r][3] * v[r][3]); }
#pragma unroll
        for (int r = 0; r < 4; ++r) { hw[r] = hw2[r]; yv[r] = yv2[r]; hw2[r] = hw3[r]; yv2[r] = yv3[r]; }
        if (SIDE) { sw = sw2; sw2 = sw3; }
        if (row0 + 12 < rend) {
#pragma unroll
            for (int r = 0; r < 4; ++r) { const size_t o = (size_t)(row0 + 12 + r) * DM + c0; hw3[r] = *(const u32x2*)(hinb + o); yv3[r] = *(const u32x2*)(fio + o); }
            if (SIDE) sw3 = sidel[(size_t)((row0 + 12) >> 2) * 64]; }
        block_reduce<8>(x, L.red, L.tot, tid, lane, wave);
#pragma unroll
        for (int r = 0; r < 4; ++r) { const float mean = L.tot[r * 2] * (1.f / DM); const float var = L.tot[r * 2 + 1] * (1.f / DM) - mean * mean; const float rstd = 1.f / sqrtf(var + LN_EPS);
            const f32x4 vn = (v[r] - mean) * rstd; const f32x4 hn = vn * A0 + B0; const size_t o = (size_t)(row0 + r) * DM + c0;
            if (OUT_F32) *(f32x4*)(houtf + o) = hn; else { u32x2 hw; hw.x = cvt_pk_bf16(hn[0], hn[1]); hw.y = cvt_pk_bf16(hn[2], hn[3]); *(u32x2*)(houtb + o) = hw; }
            if (layer == 0) { const f32x4 u = vn * A1 + B1; u32x2 w; w.x = cvt_pk_bf16(u[0], u[1]); w.y = cvt_pk_bf16(u[2], u[3]); *(u32x2*)(hinb + o) = w; } }
    }
}

__device__ __forceinline__ int ln_side_count(const Frame& F, int layer) {
    int per = (MTOK + F.G - 1) / F.G; per = (per + 3) & ~3; const int rbase = F.bid * per; const int b = (rbase < MTOK) ? rbase / SEQ : 0;
    return __builtin_amdgcn_readfirstlane(((const int*)(F.ws + WS_BADMAP + 32768 + 1024))[layer * 2 + b]);
}
template <bool HIN_F32> __device__ __forceinline__ void ln1_router_phase(const Frame& F, int layer, const void* hin_, const bf16* ymix, bf16* u2out, bf16* hout) {
    if (ln_side_count(F, layer) > 0) ln1_router_impl<HIN_F32, true>(F, layer, hin_, ymix, u2out, hout); else ln1_router_impl<HIN_F32, false>(F, layer, hin_, ymix, u2out, hout);
}
template <bool OUT_F32> __device__ __forceinline__ void ln2_phase(const Frame& F, int layer, const bf16* fio, bf16* hinb, void* hout_) {
    if (ln_side_count(F, layer) > 0) ln2_impl<OUT_F32, true>(F, layer, fio, hinb, hout_); else ln2_impl<OUT_F32, false>(F, layer, fio, hinb, hout_);
}
namespace hy {
constexpr int L = SEQ;
__device__ constexpr float C32[16] = {1.000000000e+00f, 9.807852804e-01f, 9.238795325e-01f, 8.314696123e-01f, 7.071067812e-01f, 5.555702330e-01f, 3.826834324e-01f, 1.950903220e-01f,
                                      0.f, -1.950903220e-01f, -3.826834324e-01f, -5.555702330e-01f, -7.071067812e-01f, -8.314696123e-01f, -9.238795325e-01f, -9.807852804e-01f};
__device__ constexpr float S32[16] = {0.f, 1.950903220e-01f, 3.826834324e-01f, 5.555702330e-01f, 7.071067812e-01f, 8.314696123e-01f, 9.238795325e-01f, 9.807852804e-01f,
                                      1.f, 9.807852804e-01f, 9.238795325e-01f, 8.314696123e-01f, 7.071067812e-01f, 5.555702330e-01f, 3.826834324e-01f, 1.950903220e-01f};
__host__ __device__ constexpr int brev(int k, int bits) { int r = 0; for (int i = 0; i < bits; ++i) r |= ((k >> i) & 1) << (bits - 1 - i); return r; }
__device__ __forceinline__ void unit_root(float frac, bool inv, float& wr, float& wi) {
    wr = __builtin_amdgcn_cosf(frac); float s = __builtin_amdgcn_sinf(frac);
    asm volatile("s_nop 1" : "+v"(wr), "+v"(s));
    wi = inv ? s : -s;
}
constexpr int FT_F32 = 0, FT_I32 = 8, FT_I32P = 16, FT_F16 = 24, FT_I16 = 26, FT_NFRAG = 28;
__device__ __forceinline__ int crow(int r, int h) { return (r & 3) + 8 * (r >> 2) + 4 * h; }
__device__ __forceinline__ bf16x8 pack8(const float (&v)[8]) { u32x4 w; w.x = cvt_pk_bf16(v[0], v[1]); w.y = cvt_pk_bf16(v[2], v[3]); w.z = cvt_pk_bf16(v[4], v[5]); w.w = cvt_pk_bf16(v[6], v[7]); return __builtin_bit_cast(bf16x8, w); }
__device__ __forceinline__ void cmul(float& xr, float& xi, float wr, float wi) {
    float t0, t1, nr, ni;
    asm("v_mul_f32_e32 %0, %1, %2" : "=v"(t0) : "v"(xi), "v"(wi));
    asm("v_mul_f32_e32 %0, %1, %2" : "=v"(t1) : "v"(xi), "v"(wr));
    asm("v_fma_f32 %0, %1, %2, -%3" : "=v"(nr) : "v"(xr), "v"(wr), "v"(t0));
    asm("v_fma_f32 %0, %1, %2, %3" : "=v"(ni) : "v"(xr), "v"(wi), "v"(t1));
    xr = nr; xi = ni;
}
#define FRAG(f) (tab[(f) * 64 + lane])
template <bool INV> __device__ __forceinline__ void pass1(LAS f32x2* dat, const LAS bf16x8* tab, int lane, int wave) {
    asm volatile("" : "+v"(lane));
    const int h = lane >> 5, c5 = lane & 31;
    const bf16x8 a0 = FRAG((INV ? FT_I16 : FT_F16) + 0), a1 = FRAG((INV ? FT_I16 : FT_F16) + 1);
#pragma unroll 1
    for (int g = 0; g < 4; ++g) {
        const int col = 128 * wave + 32 * g + c5; const int pc = col ^ ((4 * wave + g) & 31) ^ ((2 * g + (c5 >> 4)) & 7);
        float wr, wi; unit_root((float)col * (1.f / 16384.f), INV, wr, wi);
        float w2r = wr, w2i = wi; cmul(w2r, w2i, wr, wi); float w4r = w2r, w4i = w2i; cmul(w4r, w4i, w2r, w2i); float w8r = w4r, w8i = w4i; cmul(w8r, w8i, w4r, w4i);
        float re[8], im[8];
#pragma unroll
        for (int jj = 0; jj < 8; ++jj) { const f32x2 v = dat[pc + 1024 * (8 * h + jj)]; re[jj] = v.x; im[jj] = v.y; }
        if (INV) {
            float cr = h ? w8r : 1.f, ci = h ? w8i : 0.f;
#pragma unroll
            for (int jj = 0; jj < 8; ++jj) { cmul(re[jj], im[jj], cr, ci); cmul(cr, ci, wr, wi); }
        }
        const f32x16 z = {};
        f32x16 d = __builtin_amdgcn_mfma_f32_32x32x16_bf16(a0, pack8(re), z, 0, 0, 0);
        d = __builtin_amdgcn_mfma_f32_32x32x16_bf16(a1, pack8(im), d, 0, 0, 0);
        asm volatile("s_nop 15\n\ts_nop 7" : "+v"(d));
        float cr = h ? w4r : 1.f, ci = h ? w4i : 0.f;
#pragma unroll
        for (int rr = 0; rr < 8; ++rr) { float xr = d[rr], xi = d[rr + 8];
            if (!INV) { if (rr == 4) { cr = h ? w4r : 1.f; ci = h ? w4i : 0.f; cmul(cr, ci, w8r, w8i); } cmul(xr, xi, cr, ci); cmul(cr, ci, wr, wi); }
            f32x2 o; o.x = xr; o.y = xi; dat[pc + 1024 * ((rr & 3) + 8 * (rr >> 2) + 4 * h)] = o; }
    }
}
template <bool INV> __device__ __forceinline__ void pass2(LAS f32x2* dat, const LAS bf16x8* tab, int lane, int wave) {
    asm volatile("" : "+v"(lane));
    const int h = lane >> 5, b = lane & 31, bp = b ^ (b >> 4);
    float wr, wi; unit_root((float)b * (1.f / 1024.f), INV, wr, wi);
    float w2r = wr, w2i = wi; cmul(w2r, w2i, wr, wi); float w4r = w2r, w4i = w2i; cmul(w4r, w4i, w2r, w2i); float w8r = w4r, w8i = w4i; cmul(w8r, w8i, w4r, w4i); float w16r = w8r, w16i = w8i; cmul(w16r, w16i, w8r, w8i);
#pragma unroll 1
    for (int g = 0; g < 2; ++g) {
        const int base = (2 * wave + g) * 1024;
        float re[2][8], im[2][8];
#pragma unroll
        for (int hf = 0; hf < 2; ++hf)
#pragma unroll
            for (int jj = 0; jj < 8; ++jj) { const int n = 16 * hf + 8 * h + jj; const f32x2 v = dat[base + 32 * n + (bp ^ (16 * hf + 8 * h + (jj ^ ((2 * jj) & 7))))]; re[hf][jj] = v.x; im[hf][jj] = v.y; }
        if (INV) {
            float cr = h ? w8r : 1.f, ci = h ? w8i : 0.f;
#pragma unroll
            for (int jj = 0; jj < 8; ++jj) { cmul(re[0][jj], im[0][jj], cr, ci); float dr = cr, di = ci; cmul(dr, di, w16r, w16i); cmul(re[1][jj], im[1][jj], dr, di); cmul(cr, ci, wr, wi); }
        }
        const bf16x8 b0 = pack8(re[0]), b1 = pack8(re[1]), b2 = pack8(im[0]), b3 = pack8(im[1]);
        const int fb = INV ? FT_I32 : FT_F32; const f32x16 z = {};
        f32x16 dre = __builtin_amdgcn_mfma_f32_32x32x16_bf16(FRAG(fb + 0), b0, z, 0, 0, 0); f32x16 dim = __builtin_amdgcn_mfma_f32_32x32x16_bf16(FRAG(fb + 4), b0, z, 0, 0, 0);
        dre = __builtin_amdgcn_mfma_f32_32x32x16_bf16(FRAG(fb + 1), b1, dre, 0, 0, 0); dim = __builtin_amdgcn_mfma_f32_32x32x16_bf16(FRAG(fb + 5), b1, dim, 0, 0, 0);
        dre = __builtin_amdgcn_mfma_f32_32x32x16_bf16(FRAG(fb + 2), b2, dre, 0, 0, 0); dim = __builtin_amdgcn_mfma_f32_32x32x16_bf16(FRAG(fb + 6), b2, dim, 0, 0, 0);
        dre = __builtin_amdgcn_mfma_f32_32x32x16_bf16(FRAG(fb + 3), b3, dre, 0, 0, 0); dim = __builtin_amdgcn_mfma_f32_32x32x16_bf16(FRAG(fb + 7), b3, dim, 0, 0, 0);
        asm volatile("s_nop 15\n\ts_nop 7" : "+v"(dre), "+v"(dim));
        float gr = h ? w4r : 1.f, gi = h ? w4i : 0.f;
#pragma unroll
        for (int r = 0; r < 16; ++r) { float xr = dre[r], xi = dim[r]; const int kf = (r & 3) + 8 * (r >> 2) + 4 * h;
            if (!INV) { float cr = gr, ci = gi; if ((r & 3) == 1) cmul(cr, ci, wr, wi); if ((r & 3) == 2) cmul(cr, ci, w2r, w2i); if ((r & 3) == 3) { cmul(cr, ci, w2r, w2i); cmul(cr, ci, wr, wi); }
                cmul(xr, xi, cr, ci); if ((r & 3) == 3) cmul(gr, gi, w8r, w8i); }
            f32x2 o; o.x = xr; o.y = xi; dat[base + 32 * kf + (bp ^ kf ^ (2 * (r & 3)))] = o; }
    }
}
template <bool FILTER> __device__ __forceinline__ void pass3(LAS f32x2* dat, const LAS bf16x8* tab, int lane, int wave, const int g, f32x2* Kbuf, const f32x2 (&kpre)[16]) {
    asm volatile("" : "+v"(lane));
    const int h = lane >> 5, sw = lane & 31, swp = sw ^ (2 * (sw & 3));
    {
        const int q = 64 * wave + 32 * g + sw, base = 32 * q;
        float re[2][8], im[2][8];
#pragma unroll
        for (int hf = 0; hf < 2; ++hf)
#pragma unroll
            for (int jj = 0; jj < 8; ++jj) { const int n = 16 * hf + 8 * h + jj; const f32x2 v = dat[base + (n ^ swp ^ hf)]; re[hf][jj] = v.x; im[hf][jj] = v.y; }
        const bf16x8 b0 = pack8(re[0]), b1 = pack8(re[1]), b2 = pack8(im[0]), b3 = pack8(im[1]);
        const f32x16 z = {};
        f32x16 dre = __builtin_amdgcn_mfma_f32_32x32x16_bf16(FRAG(FT_F32 + 0), b0, z, 0, 0, 0); f32x16 dim = __builtin_amdgcn_mfma_f32_32x32x16_bf16(FRAG(FT_F32 + 4), b0, z, 0, 0, 0);
        dre = __builtin_amdgcn_mfma_f32_32x32x16_bf16(FRAG(FT_F32 + 1), b1, dre, 0, 0, 0); dim = __builtin_amdgcn_mfma_f32_32x32x16_bf16(FRAG(FT_F32 + 5), b1, dim, 0, 0, 0);
        dre = __builtin_amdgcn_mfma_f32_32x32x16_bf16(FRAG(FT_F32 + 2), b2, dre, 0, 0, 0); dim = __builtin_amdgcn_mfma_f32_32x32x16_bf16(FRAG(FT_F32 + 6), b2, dim, 0, 0, 0);
        dre = __builtin_amdgcn_mfma_f32_32x32x16_bf16(FRAG(FT_F32 + 3), b3, dre, 0, 0, 0); dim = __builtin_amdgcn_mfma_f32_32x32x16_bf16(FRAG(FT_F32 + 7), b3, dim, 0, 0, 0);
        asm volatile("s_nop 15\n\ts_nop 7" : "+v"(dre), "+v"(dim));
        if (FILTER) {
#pragma unroll
            for (int r = 0; r < 16; ++r) { f32x2 o; o.x = dre[r]; o.y = dim[r]; Kbuf[((r & 3) + 8 * (r >> 2) + 4 * h) * 512 + q] = o; }
        } else {
            float yr[16], yi[16];
#pragma unroll
            for (int r = 0; r < 16; ++r) { const f32x2 kv = kpre[r]; float a_ = dre[r], b_ = dim[r]; cmul(a_, b_, kv.x, kv.y); yr[r] = a_; yi[r] = b_; }
            float t0[8], t1[8], t2[8], t3[8];
#pragma unroll
            for (int j = 0; j < 8; ++j) { t0[j] = yr[j]; t1[j] = yr[8 + j]; t2[j] = yi[j]; t3[j] = yi[8 + j]; }
            const bf16x8 c0 = pack8(t0), c1 = pack8(t1), c2 = pack8(t2), c3 = pack8(t3);
            f32x16 ere = __builtin_amdgcn_mfma_f32_32x32x16_bf16(FRAG(FT_I32P + 0), c0, z, 0, 0, 0); f32x16 eim = __builtin_amdgcn_mfma_f32_32x32x16_bf16(FRAG(FT_I32P + 4), c0, z, 0, 0, 0);
            ere = __builtin_amdgcn_mfma_f32_32x32x16_bf16(FRAG(FT_I32P + 1), c1, ere, 0, 0, 0); eim = __builtin_amdgcn_mfma_f32_32x32x16_bf16(FRAG(FT_I32P + 5), c1, eim, 0, 0, 0);
            ere = __builtin_amdgcn_mfma_f32_32x32x16_bf16(FRAG(FT_I32P + 2), c2, ere, 0, 0, 0); eim = __builtin_amdgcn_mfma_f32_32x32x16_bf16(FRAG(FT_I32P + 6), c2, eim, 0, 0, 0);
            ere = __builtin_amdgcn_mfma_f32_32x32x16_bf16(FRAG(FT_I32P + 3), c3, ere, 0, 0, 0); eim = __builtin_amdgcn_mfma_f32_32x32x16_bf16(FRAG(FT_I32P + 7), c3, eim, 0, 0, 0);
#pragma unroll
            for (int r = 0; r < 16; ++r) { f32x2 o; o.x = ere[r]; o.y = eim[r]; dat[base + ((((r & 3) + 8 * (r >> 2) + 4 * h)) ^ swp ^ (r >> 3))] = o; }
        }
    }
}
#undef FRAG
__device__ __forceinline__ float ftab_value(int f, int l, int jj) {
    const int r = l & 31, h = l >> 5;
    if (f < 24) {
        const int kind = f >> 3, rb = (f >> 2) & 1, s = f & 3; int kk, pp;
        if (kind < 2) { kk = 16 * (s & 1) + 8 * h + jj; pp = s >> 1; } else { kk = 16 * (s & 1) + 8 * (jj >> 2) + 4 * h + (jj & 3); pp = s >> 1; }
        const float th = 6.283185307179586f * (float)((r * kk) & 31) * (1.f / 32.f); const float c = cosf(th), sn = sinf(th);
        if (kind == 0) return rb == 0 ? (pp == 0 ? c : sn) : (pp == 0 ? -sn : c);
        return rb == 0 ? (pp == 0 ? c : -sn) : (pp == 0 ? sn : c);
    }
    const int inv = (f - 24) >> 1, s = (f - 24) & 1; const int part = r >> 4, kf = r & 15, n = 8 * h + jj;
    const float th = 6.283185307179586f * (float)((kf * n) & 15) * (1.f / 16.f); const float c = cosf(th), sn = sinf(th);
    if (!inv) return part == 0 ? (s == 0 ? c : sn) : (s == 0 ? -sn : c);
    return part == 0 ? (s == 0 ? c : -sn) : (s == 0 ? sn : c);
}
__device__ __forceinline__ int phys(int p) { return p ^ ((p >> 5) & 31) ^ ((p >> 4) & 7); }
__device__ __forceinline__ void unpack8(const u32x4 v, float (&f)[8]) { f[0] = bflo(v.x); f[1] = bfhi(v.x); f[2] = bflo(v.y); f[3] = bfhi(v.y); f[4] = bflo(v.z); f[5] = bfhi(v.z); f[6] = bflo(v.w); f[7] = bfhi(v.w); }
struct Raw8 { u32x4 v; unsigned l, r; };
__device__ __forceinline__ Raw8 load_raw8(const bf16* rowp, int t0) { Raw8 q; q.v = *(const u32x4*)(rowp + t0); q.l = (t0 > 0) ? (unsigned)rowp[t0 - 1] : 0u; q.r = (t0 + 8 < L) ? (unsigned)rowp[t0 + 8] : 0u; return q; }
__device__ __forceinline__ void conv8(const Raw8& q, float w0, float w1, float w2, float cb, float (&o)[8]) {
    float f[8]; unpack8(q.v, f); const float left = bf2f(q.l), right = bf2f(q.r);
#pragma unroll
    for (int e = 0; e < 8; ++e) { const float a = (e == 0) ? left : f[e - 1], c = (e == 7) ? right : f[e + 1]; o[e] = w0 * a + w1 * f[e] + w2 * c + cb; }
}
typedef const LAS float* ChanPar;
struct RawZ { Raw8 x[2], v[2]; };
__device__ __forceinline__ RawZ load_rawz(const bf16* pT, int d, int t0) { RawZ q;
#pragma unroll
    for (int bt = 0; bt < 2; ++bt) { q.x[bt] = load_raw8(pT + (size_t)(DM + d) * MTOK + bt * L, t0); q.v[bt] = load_raw8(pT + (size_t)(2 * DM + d) * MTOK + bt * L, t0); }
    return q; }
__device__ __forceinline__ void z_from_raw(const RawZ& q, ChanPar P, float (&z0)[8], float (&z1)[8]) {
#pragma unroll
    for (int bt = 0; bt < 2; ++bt) { float a[8], v[8];
        conv8(q.x[bt], P[4], P[5], P[6], P[7], a); conv8(q.v[bt], P[8], P[9], P[10], P[11], v);
#pragma unroll
        for (int e = 0; e < 8; ++e) { if (bt == 0) z0[e] = a[e] * v[e]; else z1[e] = a[e] * v[e]; } }
}
struct RawF { u32x4 hf, hb; unsigned first; };
__device__ __forceinline__ RawF load_rawf(const bf16* HT, int d, int t0) { RawF q; q.hf = *(const u32x4*)(HT + (size_t)d * L + t0); q.hb = *(const u32x4*)(HT + (size_t)(DM + d) * L + (L - t0 - 8));
    q.first = (t0 > 0) ? (unsigned)HT[(size_t)(DM + d) * L + (L - t0)] : 0u; return q; }
__device__ __forceinline__ void filt8(const RawF& q, int t0, ChanPar P, float (&k)[8], float (&kl)[8], float& l1p) {
    float hf[8], hb[8]; unpack8(q.hf, hf); unpack8(q.hb, hb);
    float s = 0.f;
#pragma unroll
    for (int e = 0; e < 8; ++e) { const float dc = __builtin_amdgcn_exp2f(-(float)(t0 + e) * P[13]); k[e] = hf[e] * dc; s += fabsf(k[e]); }
    float hbd[8];
#pragma unroll
    for (int e = 0; e < 8; ++e) { const int m = L - t0 - 8 + e; const float dc = __builtin_amdgcn_exp2f(-(float)m * P[13]); hbd[e] = hb[e] * dc; if (m >= 1) s += fabsf(hbd[e]); }
    kl[0] = (t0 > 0) ? bf2f(q.first) * __builtin_amdgcn_exp2f(-(float)(L - t0) * P[13]) : 0.f;
#pragma unroll
    for (int e = 1; e < 8; ++e) kl[e] = hbd[8 - e];
#pragma unroll
    for (int e = 0; e < 8; ++e) { k[e] *= P[14]; kl[e] *= P[14]; }
    l1p = s;
}
__device__ __forceinline__ void hyena_phase(const Frame& F) {
    LAS f32x2* dat = (LAS f32x2*)F.lds; LAS float* redu = (LAS float*)(F.lds + RING_BYTES);
    const bf16* pT = (const bf16*)(F.ws + WS_B); const bf16* HT = (const bf16*)(F.ws + WS_HT); bf16* yT = (bf16*)(F.ws + WS_A);
    const LAS bf16x8* tab = (const LAS bf16x8*)(F.lds + FTAB_OFF);
    for (int i = F.tid; i < FT_NFRAG * 64; i += NTHR) ((LAS u32x4*)(F.lds + FTAB_OFF))[i] = ((const u32x4*)(F.ws + WS_FTAB))[i];
    __syncthreads();
    f32x2* Ke = (f32x2*)(F.ws + WS_FFTS) + (size_t)F.bid * 49152; f32x2* Ko = Ke + 16384; f32x2* SeB = Ke + 32768;
    RawF rf[4];
    { const int tq = fresh_tid(F.wave); if (F.bid < DM) {
#pragma unroll
        for (int sI = 0; sI < 4; ++sI) rf[sI] = load_rawf((const bf16*)(F.ws + WS_HT), F.bid, 8 * (tq + 512 * sI)); } }
    const int cv_gw = F.bid * NWAVES + F.wave, cv_ngw = F.G * NWAVES; int cv_it = cv_gw; constexpr int CV_NIT = 48 * 1024;
    for (int d = F.bid; d < DM; d += F.G) {
        int tid = fresh_tid(F.wave);
        TPS_START(1);
        LAS float* PW = (LAS float*)(F.lds + RING_BYTES + 64); ChanPar P = PW;
        __syncthreads();
        if (tid < 12) { const int i = tid & 3, pj = tid >> 2; PW[tid] = (i < 3) ? AIN(I_HCW)[i * 3 * DM + pj * DM + d] : AIN(I_HCB)[pj * DM + d]; }
        if (tid == 12) PW[12] = AIN(I_FBIAS)[d];
        if (tid == 13) { const float mind = -4.605170185988091f / 1.5f, maxd = -4.605170185988091f / 0.3f; const float delta = fabsf(mind + (maxd - mind) * ((float)d / (float)(DM - 1)));
            PW[13] = delta * (1.f / (float)(L - 1)) * 1.4426950408889634f; PW[14] = 1.f; }
        __syncthreads();
        TPS_STOP(1); TPS_START(2);
#pragma unroll 1
        for (int odd = 0; odd < 2; ++odd) {
            asm volatile("" : "+v"(tid));
            float l1s = 0.f;
#pragma unroll
            for (int sI = 0; sI < 4; ++sI) { const int t0 = 8 * (tid + 512 * sI); float k[8], kl[8], l1p; filt8(rf[sI], t0, P, k, kl, l1p); l1s += l1p;
#pragma unroll
                for (int e = 0; e < 8; ++e) { f32x2 o; if (!odd) { o.x = k[e] + kl[e]; o.y = 0.f; } else { const float a = k[e] - kl[e]; float wr, wi; unit_root((float)(t0 + e) * (1.f / 32768.f), false, wr, wi); o.x = a * wr; o.y = a * wi; }
                    dat[phys(t0 + e)] = o; } }
            if (!odd) { l1s = wave_sum(l1s); if (F.lane == 0) redu[F.wave] = l1s; }
            __syncthreads();
            if (!odd && tid == 0) { float tot = 0.f;
#pragma unroll
                for (int w = 0; w < NWAVES; ++w) tot += redu[w];
                PW[15] = 1.f / tot; }
            pass1<false>(dat, tab, F.lane, F.wave); __syncthreads(); pass2<false>(dat, tab, F.lane, F.wave); { f32x2 kdummy[16]; pass3<true>(dat, tab, F.lane, F.wave, 0, odd ? Ko : Ke, kdummy); asm volatile("" ::: "memory"); pass3<true>(dat, tab, F.lane, F.wave, 1, odd ? Ko : Ke, kdummy); } __syncthreads();
        }
        TPS_STOP(2); TPS_START(3);
        unsigned zp[4][8];
        const bool cvb3 = (cv_it + 2 * cv_ngw < CV_NIT);
        const ConvItem ia = moe_l1_item(F, cvb3 ? cv_it : 0), ib = moe_l1_item(F, cvb3 ? cv_it + cv_ngw : 0), ic = moe_l1_item(F, cvb3 ? cv_it + 2 * cv_ngw : 0);
#pragma unroll
        for (int odd = 0; odd < 2; ++odd) {
            asm volatile("" : "+v"(tid));
            TPS_START(6);
            if (!odd) {
                RawZ rz[4];
#pragma unroll
                for (int sI = 0; sI < 4; ++sI) rz[sI] = load_rawz(pT, d, 8 * (tid + 512 * sI));
#pragma unroll
                for (int sI = 0; sI < 4; ++sI) { const int t0 = 8 * (tid + 512 * sI); float z0[8], z1[8]; z_from_raw(rz[sI], P, z0, z1);
#pragma unroll
                    for (int e = 0; e < 8; ++e) { f32x2 o; o.x = z0[e]; o.y = z1[e]; zp[sI][e] = cvt_pk_bf16(z0[e], z1[e]); dat[phys(t0 + e)] = o; } }
            } else {
#pragma unroll
                for (int sI = 0; sI < 4; ++sI) { const int t0 = 8 * (tid + 512 * sI);
#pragma unroll
                    for (int e = 0; e < 8; ++e) { const float z0 = bflo(zp[sI][e]), z1 = bfhi(zp[sI][e]); float wr, wi; unit_root((float)(t0 + e) * (1.f / 32768.f), false, wr, wi);
                        f32x2 o; o.x = z0 * wr - z1 * wi; o.y = z0 * wi + z1 * wr; dat[phys(t0 + e)] = o; } }
            }
#ifdef FFT_EXTRA
#pragma unroll 1
            for (int xr = 0; xr < FFT_EXTRA; ++xr) { __syncthreads(); pass2<false>(dat, tab, F.lane, F.wave); __syncthreads(); pass2<true>(dat, tab, F.lane, F.wave); __syncthreads();
#pragma unroll 1
                for (int i = fresh_tid(F.wave); i < L; i += NTHR) { f32x2 v = dat[i]; v.x *= (1.f / 32.f); v.y *= (1.f / 32.f); dat[i] = v; } }
            tid = fresh_tid(F.wave);
#endif
            TPS_STOP(6); TPS_START(5);
            f32x2 kpre0[16], kpre1[16];
            asm volatile("" ::: "memory");
            { const f32x2* Kb = odd ? Ko : Ke; int ln_ = F.lane; asm volatile("" : "+v"(ln_)); const int lq = ln_ & 31, lh = ln_ >> 5; const float il1 = P[15], fb = P[12];
#pragma unroll
              for (int r = 0; r < 16; ++r) { f32x2 k0 = Kb[((r & 3) + 8 * (r >> 2) + 4 * lh) * 512 + 64 * F.wave + lq], k1 = Kb[((r & 3) + 8 * (r >> 2) + 4 * lh) * 512 + 64 * F.wave + 32 + lq];
                  k0.x = k0.x * il1 + fb; k0.y *= il1; k1.x = k1.x * il1 + fb; k1.y *= il1; kpre0[r] = k0; kpre1[r] = k1; } }
            __syncthreads(); pass1<false>(dat, tab, F.lane, F.wave); __syncthreads(); pass2<false>(dat, tab, F.lane, F.wave); pass3<false>(dat, tab, F.lane, F.wave, 0, nullptr, kpre0); asm volatile("" ::: "memory"); pass3<false>(dat, tab, F.lane, F.wave, 1, nullptr, kpre1);
            TPS_STOP(5); TPS_START(7);
            if (odd) { float ca[32], cb[32], cc[32]; const int cvln = fresh_tid(F.wave) & 63;
                conv_issue(ia, cvln, ca); conv_issue(ib, cvln, cb); conv_issue(ic, cvln, cc);
                pass2<true>(dat, tab, F.lane, F.wave); __syncthreads(); pass1<true>(dat, tab, F.lane, F.wave);
                if (cvb3) { conv_finish(ia, cvln, ca); conv_finish(ib, cvln, cb); conv_finish(ic, cvln, cc); cv_it += 3 * cv_ngw; }
                __syncthreads();
            } else { pass2<true>(dat, tab, F.lane, F.wave); __syncthreads(); pass1<true>(dat, tab, F.lane, F.wave); __syncthreads(); }
            TPS_STOP(7);
            if (!odd) {
                asm volatile("" : "+v"(tid));
#pragma unroll 1
                for (int sI = 0; sI < 4; ++sI)
#pragma unroll
                    for (int e = 0; e < 8; ++e) { const f32x2 v = dat[phys(8 * (tid + 512 * sI) + e)]; SeB[e * 2048 + tid + 512 * sI] = v; }
                __syncthreads();
            }
        }
        TPS_STOP(3); TPS_START(4);
        asm volatile("" : "+v"(tid));
        if (d + F.G < DM) {
#pragma unroll
            for (int sI = 0; sI < 4; ++sI) rf[sI] = load_rawf(HT, d + F.G, 8 * (tid + 512 * sI)); }
        { Raw8 rx0[4][2]; f32x2 se[4][8];
#pragma unroll
          for (int sI = 0; sI < 4; ++sI) {
#pragma unroll
              for (int bt = 0; bt < 2; ++bt) rx0[sI][bt] = load_raw8(pT + (size_t)d * MTOK + bt * L, 8 * (tid + 512 * sI));
#pragma unroll
              for (int e = 0; e < 8; ++e) se[sI][e] = SeB[e * 2048 + tid + 512 * sI]; }
#pragma unroll
          for (int sI = 0; sI < 4; ++sI) { const int t0 = 8 * (tid + 512 * sI);
              float o0[8], o1[8];
#pragma unroll
              for (int e = 0; e < 8; ++e) { const f32x2 so = dat[phys(t0 + e)]; float wr, wi; unit_root((float)(t0 + e) * (1.f / 32768.f), true, wr, wi);
                  o0[e] = (se[sI][e].x + so.x * wr - so.y * wi) * (1.f / 32768.f); o1[e] = (se[sI][e].y + so.x * wi + so.y * wr) * (1.f / 32768.f); }
#pragma unroll
              for (int bt = 0; bt < 2; ++bt) { float xc[8]; conv8(rx0[sI][bt], P[0], P[1], P[2], P[3], xc);
                  u32x4 w;
                  if (bt == 0) { w.x = cvt_pk_bf16(xc[0] * o0[0], xc[1] * o0[1]); w.y = cvt_pk_bf16(xc[2] * o0[2], xc[3] * o0[3]); w.z = cvt_pk_bf16(xc[4] * o0[4], xc[5] * o0[5]); w.w = cvt_pk_bf16(xc[6] * o0[6], xc[7] * o0[7]); }
                  else { w.x = cvt_pk_bf16(xc[0] * o1[0], xc[1] * o1[1]); w.y = cvt_pk_bf16(xc[2] * o1[2], xc[3] * o1[3]); w.z = cvt_pk_bf16(xc[4] * o1[4], xc[5] * o1[5]); w.w = cvt_pk_bf16(xc[6] * o1[6], xc[7] * o1[7]); }
                  *(u32x4*)(yT + (size_t)d * MTOK + bt * L + t0) = w; } } }
        __syncthreads();
        TPS_STOP(4);
        if (cvb3) {
        } else {
#pragma unroll 1
            for (int q = 0; q < 3; ++q) { if (cv_it < CV_NIT) { float cva[32]; const ConvItem cvc = moe_l1_item(F, cv_it); conv_issue(cvc, fresh_tid(F.wave) & 63, cva); conv_finish(cvc, fresh_tid(F.wave) & 63, cva); cv_it += cv_ngw; } }
        }
    }
    while (cv_it < CV_NIT) { float cvb[32]; const ConvItem c = moe_l1_item(F, cv_it); conv_issue(c, F.lane, cvb); conv_finish(c, F.lane, cvb); cv_it += cv_ngw; }
}
__device__ __forceinline__ void transpose_phase(const Frame& F) {
    const bf16* yT = (const bf16*)(F.ws + WS_A); bf16* y = (bf16*)(F.ws + WS_B);
    LAS bf16* tl = (LAS bf16*)(F.lds + F.wave * 16384);
    const int gw = F.bid * NWAVES + F.wave, NGW = F.G * NWAVES, lane = F.lane;
    for (int tile = gw; tile < 32 * 512; tile += NGW) { const int d0 = (tile & 31) * 64, t0 = (tile >> 5) * 64;
#pragma unroll
        for (int i = 0; i < 8; ++i) { const int r = i * 8 + (lane >> 3), ch = lane & 7; const u32x4 v = *(const u32x4*)(yT + (size_t)(d0 + r) * MTOK + t0 + ch * 8); *(LAS u32x4*)(tl + r * 72 + ch * 8) = v; }
        LDS_WAIT();
#pragma unroll
        for (int i = 0; i < 8; ++i) { const int tr = i * 8 + (lane >> 3), ch = lane & 7; unsigned short e[8];
#pragma unroll
            for (int k = 0; k < 8; ++k) e[k] = tl[(ch * 8 + k) * 72 + tr];
            u32x4 w; w.x = e[0] | ((unsigned)e[1] << 16); w.y = e[2] | ((unsigned)e[3] << 16); w.z = e[4] | ((unsigned)e[5] << 16); w.w = e[6] | ((unsigned)e[7] << 16);
            *(u32x4*)(y + (size_t)(t0 + tr) * DM + d0 + ch * 8) = w; }
        LDS_WAIT();
    }
}
}
__device__ __forceinline__ float hy_ftab_value(int f, int l, int jj) { return hy::ftab_value(f, l, jj); }
constexpr int NPHASE = 19;

__device__ __forceinline__ void moe_table(const Frame& F, int layer, LAS int* tab) {
    if (F.tid < NCLS) tab[32 + F.tid] = (int)__hip_atomic_load((unsigned*)(F.ctl + CW_CNT + (layer * NCLS + F.tid) * 64), RLX_AGENT);
    __syncthreads();
    if (F.tid == 0) { int a = 0; for (int c = 0; c < NCLS; ++c) { tab[c] = a; a += (tab[32 + c] + 255) >> 8; } tab[24] = a; }
    __syncthreads();
}

#ifndef PROBE_MASK
#define PROBE_MASK 0u
#endif
#ifndef TPM
#define TPM 0u
#endif
#define TP_MULT 4
#define IN(k) ((ONLY < 0 || (k) == ONLY) && lo <= (k) && (k) < hi)
#define SEAM(k) do { if ((k) + 1 < hi) { XcdBarrier b_ = bar; asm volatile("" : "+s"(b_.bar), "+s"(b_.x)); xcd_barrier(b_); } if (TPM != 0u && ONLY < 0 && ((TPM >> (k)) & 1u) && F.bid == 0 && F.tid == 0) TPW[0] += __builtin_amdgcn_s_memrealtime() - TPW[1]; if (PROBE_MASK != 0u && ONLY < 0) { if (F.tid == 0) { LAS unsigned long long* tp_ = (LAS unsigned long long*)(F.lds + MISC_OFF + 64); const unsigned long long t1_ = __builtin_amdgcn_s_memrealtime(); if ((PROBE_MASK >> (k)) & 1u) tp_[0] += t1_ - tp_[1]; tp_[1] = t1_; } } } while (0)
#define TPW ((LAS unsigned long long*)(F.lds + MISC_OFF + 96))
#define ENTER() do { int l_; asm volatile("v_mbcnt_lo_u32_b32 %0, -1, 0\n\tv_mbcnt_hi_u32_b32 %0, -1, %0" : "=&v"(l_)); const int t_ = F.wave * 64 + l_; F.tid = t_; F.lane = l_; int b_ = blockIdx.x, g_ = gridDim.x; asm volatile("" : "+s"(b_), "+s"(g_)); F.bid = b_; F.G = g_; if (TPM != 0u && ONLY < 0 && b_ == 0 && t_ == 0) TPW[1] = __builtin_amdgcn_s_memrealtime(); } while (0)
template <int ONLY> __device__ __forceinline__ void layer_phases(Frame& F, const XcdBarrier& bar, const int lo, const int hi, const int layer, LAS int* tab) {
        const int pb = 3 + 8 * layer;
        if (layer == 0) {
            if (IN(pb + 0)) { ENTER();
                pg::PlainSched S; S.init(F.ws + WS_A, F.ws + WS_WQKV, MTOK, QKVD, DM, DM, F.G, F.bid);
                pg::EpiQKV E{(bf16*)(F.ws + WS_B), (bf16*)(F.ws + WS_B + 128 * MiB), (bf16*)(F.ws + WS_B + 144 * MiB), AIN(I_ABIN), (const float*)(F.ws + WS_ROPE), (const float*)(F.ws + WS_ROPE) + 4096};
                pg::gemm_phase<pg::EpiQKV, pg::PlainSched, false, false, true>(F.lds, F.tid, DM, DM, DM, S, E);
                SEAM(pb + 0);
            }
            if (IN(pb + 1)) { ENTER(); att::attn_phase(F); SEAM(pb + 1); }
        } else {
            if (IN(pb + 0)) { ENTER();
                pg::PlainSched S; S.init(F.ws + WS_WHYIN, F.ws + WS_A, 3 * DM, MTOK, DM, DM, F.G, F.bid);
                pg::EpiBf16<true> E{(bf16*)(F.ws + WS_B), MTOK, AIN(I_HBIN)};
                pg::gemm_phase<pg::EpiBf16<true>, pg::PlainSched, false, false, true>(F.lds, F.tid, DM, DM, DM, S, E);
                SEAM(pb + 0);
            }
            if (IN(pb + 1)) { ENTER(); hy::hyena_phase(F); SEAM(pb + 1); }
            if (IN(pb + 2)) { ENTER(); hy::transpose_phase(F); SEAM(pb + 2); }
        }
        if (IN(pb + 3)) { ENTER();
            const void* A = layer ? (const void*)(F.ws + WS_B) : (const void*)(F.ws + WS_A);
            const void* Bt = layer ? (const void*)(F.ws + WS_WHYO) : (const void*)(F.ws + WS_WO0);
            bf16* O = (bf16*)(F.ws + WS_B + (layer ? 128 : 192) * MiB);
            pg::PlainSched S; S.init(A, Bt, MTOK, DM, DM, DM, F.G, F.bid);
            pg::EpiBf16<false> E{O, DM, layer ? AIN(I_HBOUT) : nullptr};
            pg::gemm_phase<pg::EpiBf16<false>, pg::PlainSched, false, false, true>(F.lds, F.tid, DM, DM, DM, S, E);
            SEAM(pb + 3);
        }
        if (IN(pb + 4)) { ENTER();
            if (layer == 0) ln1_router_phase<true>(F, 0, AIN(I_X), (const bf16*)(F.ws + WS_B + 192 * MiB), (bf16*)(F.ws + WS_A), (bf16*)(F.ws + WS_B + 192 * MiB));
            else ln1_router_phase<false>(F, 1, F.out, (const bf16*)(F.ws + WS_B + 128 * MiB), (bf16*)(F.ws + WS_A), (bf16*)(F.ws + WS_B + 256 * MiB));
            SEAM(pb + 4);
        }
        if (IN(pb + 5)) { ENTER();
            moe_table(F, layer, tab);
            pg::MoeSched S{tab, (const char*)(F.ws + WS_A), (const char*)(F.ws + WS_W13 + (size_t)layer * 128 * MiB), (const int*)(F.ws + WS_TOK), F.G, F.bid, 16, 0};
            pg::EpiMoe1 E{(bf16*)(F.ws + WS_B), (const float*)(F.ws + WS_GATE)};
            pg::gemm_phase<pg::EpiMoe1, pg::MoeSched, true, false, true>(F.lds, F.tid, DM, DM, DM, S, E);
            SEAM(pb + 5);
        }
        if (IN(pb + 6)) { ENTER();
            moe_table(F, layer, tab);
            pg::MoeSched S{tab, (const char*)(F.ws + WS_B), (const char*)(F.ws + WS_W2 + (size_t)layer * 64 * MiB), (const int*)(F.ws + WS_TOK), F.G, F.bid, 8, 1};
            pg::EpiMoe2 E{(bf16*)(F.ws + WS_B + (layer ? 256 : 192) * MiB), (const int*)(F.ws + WS_TOK)};
            pg::gemm_phase<pg::EpiMoe2, pg::MoeSched, false, true, true>(F.lds, F.tid, DM, DM, EFF, S, E);
            SEAM(pb + 6);
        }
        if (IN(pb + 7)) { ENTER();
            if (layer == 0) ln2_phase<false>(F, 0, (const bf16*)(F.ws + WS_B + 192 * MiB), (bf16*)(F.ws + WS_A), F.out);
            else ln2_phase<true>(F, 1, (const bf16*)(F.ws + WS_B + 256 * MiB), (bf16*)(F.ws + WS_A), F.out);
            SEAM(pb + 7); }
}
template <int ONLY> __global__ void __launch_bounds__(NTHR, 2) fwd_kernel(Args args) {
    extern __shared__ __attribute__((aligned(16))) unsigned char lds_raw[];
    Frame F;
    F.lds = (LAS unsigned char*)lds_raw;
    F.tid = threadIdx.x; F.lane = F.tid & 63; F.wave = __builtin_amdgcn_readfirstlane(F.tid >> 6);
    F.G = gridDim.x; F.bid = blockIdx.x; F.ws = args.ws; F.ctl = (gu32*)(args.ws + WS_CTL); F.out = args.out;
    F.a = &args;
    for (int u = F.tid; u < (LDS_BYTES - RING_BYTES) / 4; u += NTHR) ((LAS unsigned*)(F.lds + RING_BYTES))[u] = 0u;
    __syncthreads();
    const int lo = args.ph_lo, hi = args.ph_hi;
    if (PROBE_MASK != 0u && ONLY >= 0) { if (F.bid == 0 && F.tid == 0) ((unsigned long long*)(F.ws + 512 * 1024))[ONLY] = __builtin_amdgcn_s_memrealtime(); }
    if (PROBE_MASK != 0u && ONLY < 0) { if (F.tid == 0) { LAS unsigned long long* tp_ = (LAS unsigned long long*)(F.lds + MISC_OFF + 64); tp_[0] = 0; tp_[1] = __builtin_amdgcn_s_memrealtime(); } }
    XcdBarrier bar; bar.bar = (unsigned*)(F.ctl + CW_BAR); bar.x = 0; bar.st = nullptr;
    if (ONLY < 0 && hi - lo > 1) bar = xcd_barrier_post((unsigned*)(F.ctl + CW_BAR), (volatile LAS unsigned*)(F.lds + MISC_OFF));
    LAS int* tab = (LAS int*)(F.lds + RING_BYTES + 64);

    if (IN(0)) { ENTER(); p0_prologue(F); SEAM(0); }
    if (IN(1)) { ENTER(); p1_prologue(F); if (TPM != 0u && ONLY < 0 && ((TPM >> 1) & 1u) && F.bid == 0 && F.tid == 0) TPW[0] += __builtin_amdgcn_s_memrealtime() - TPW[1]; }
    if (IN(2)) { ENTER();
        pg::PlainSched S; S.init(F.ws + WS_W4T, F.ws + WS_HDN, 4096, SEQ, 128, 128, F.G, F.bid);
        pg::EpiBf16<true> E{(bf16*)(F.ws + WS_HT), SEQ, nullptr};
        int kf = 128; asm volatile("" : "+s"(kf));
        pg::gemm_phase<pg::EpiBf16<true>, pg::PlainSched, false, false, true>(F.lds, F.tid, kf, 128, 128, S, E);
        SEAM(2);
    }
    if constexpr (ONLY >= 0) { if (ONLY >= 3 && ONLY < 11) layer_phases<ONLY>(F, bar, lo, hi, 0, tab); if (ONLY >= 11) layer_phases<ONLY>(F, bar, lo, hi, 1, tab); }
    else {
#pragma unroll 1
        for (int layer = 0; layer < 2; ++layer) layer_phases<ONLY>(F, bar, lo, hi, layer, tab);
    }
    if (PROBE_MASK != 0u && ONLY == NPHASE - 1) { __syncthreads(); if (F.bid == 0 && F.tid == 0) { const unsigned long long* ts = (const unsigned long long*)(F.ws + 512 * 1024); unsigned long long acc = 0, tend = __builtin_amdgcn_s_memrealtime();
        for (int k = 0; k < NPHASE; ++k) if (((PROBE_MASK >> k) & 1u) && k != 5) { int kn = k + 1; if (kn == 5) kn = 6; acc += ((kn < NPHASE) ? ts[kn] : tend) - ts[k]; }
        F.out[0] = 0.1f * (float)acc; } }
    if ((TPM != 0u || TPSEL >= 0) && ONLY < 0) { if (blockIdx.x == 0 && threadIdx.x == 0) { const unsigned long long acc = TPW[0] * TP_MULT, t0 = __builtin_amdgcn_s_memrealtime(); while (__builtin_amdgcn_s_memrealtime() - t0 < acc) __builtin_amdgcn_s_sleep(8); } }
    if (PROBE_MASK != 0u && ONLY < 0) { __syncthreads(); if (F.bid == 0 && F.tid == 0) F.out[0] = 0.1f * (float)((LAS unsigned long long*)(F.lds + MISC_OFF + 64))[0]; }
}
#undef IN
#undef SEAM

extern "C" void kernel_launch(void* const* d_in, const int* in_sizes, int n_in, void* d_out, int out_size, void* d_ws, size_t ws_size, hipStream_t stream) {
    static int grid = 0;
    if (grid == 0) {
        if (n_in != 34 || in_sizes[0] != MTOK * DM || out_size != MTOK * DM || ws_size < WS_END) { fprintf(stderr, "kernel_launch: unexpected shapes / workspace (n_in %d, ws %zu, need %zu)\n", n_in, ws_size, (size_t)WS_END); grid = -1; return; }
        int dev = 0, cus = 0;
        if (hipGetDevice(&dev) != hipSuccess || hipDeviceGetAttribute(&cus, hipDeviceAttributeMultiprocessorCount, dev) != hipSuccess) { grid = -1; return; }
#if !MK_SPLIT
        if (hipFuncSetAttribute((const void*)fwd_kernel<-1>, hipFuncAttributeMaxDynamicSharedMemorySize, LDS_BYTES) != hipSuccess) { fprintf(stderr, "kernel_launch: hipFuncSetAttribute failed\n"); grid = -1; return; }
        int per_cu = 0;
        if (hipOccupancyMaxActiveBlocksPerMultiprocessor(&per_cu, (const void*)fwd_kernel<-1>, NTHR, LDS_BYTES) != hipSuccess || per_cu < 1) fprintf(stderr, "kernel_launch: occupancy query reports %d blocks per CU\n", per_cu);
        (void)hipGetLastError();
#endif
        grid = cus;
    }
    if (grid < 0) return;
    (void)hipMemsetAsync((char*)d_ws + WS_CTL, 0, CTL_ZERO_BYTES, stream);
    Args a{};
    for (int i = 0; i < 34; ++i) a.in[i] = (const float*)d_in[i];
    a.out = (float*)d_out; a.ws = (unsigned char*)d_ws;
#if MK_SPLIT
    typedef void (*kfn)(Args);
    static const kfn fns[NPHASE] = {fwd_kernel<0>, fwd_kernel<1>, fwd_kernel<2>, fwd_kernel<3>, fwd_kernel<4>, nullptr, fwd_kernel<6>, fwd_kernel<7>, fwd_kernel<8>, fwd_kernel<9>, fwd_kernel<10>,
                                      fwd_kernel<11>, fwd_kernel<12>, fwd_kernel<13>, fwd_kernel<14>, fwd_kernel<15>, fwd_kernel<16>, fwd_kernel<17>, fwd_kernel<18>};
    static bool attr_done = false;
    if (!attr_done) { for (int ph = 0; ph < NPHASE; ++ph) if (fns[ph]) (void)hipFuncSetAttribute((const void*)fns[ph], hipFuncAttributeMaxDynamicSharedMemorySize, LDS_BYTES); attr_done = true; }
#ifndef REPEAT_MASK
#define REPEAT_MASK 0u
#endif
    for (int ph = 0; ph < NPHASE; ++ph) { if (!fns[ph]) continue; a.ph_lo = ph; a.ph_hi = ph + 1;
        for (int rep = 0; rep < (((REPEAT_MASK >> ph) & 1u) ? 2 : 1); ++rep) {
            if (rep == 1 && ph == 15) (void)hipMemsetAsync((char*)d_ws + WS_CTL + (size_t)(CW_CNT + NCLS * 64) * 4, 0, NCLS * 64 * 4, stream);
            hipLaunchKernelGGL(fns[ph], dim3(grid), dim3(NTHR), LDS_BYTES, stream, a); } }
#else
    a.ph_lo = 0; a.ph_hi = NPHASE; hipLaunchKernelGGL(fwd_kernel<-1>, dim3(grid), dim3(NTHR), LDS_BYTES, stream, a);
#endif
}
```

```cpp
#include <hip/hip_runtime.h>
#include <hip/hip_bf16.h>
#include <cstdio>
#include <cstdint>

#ifndef MK_SPLIT
#define MK_SPLIT 0
#endif

#define GAS __attribute__((address_space(1)))
#define LAS __attribute__((address_space(3)))
typedef unsigned short bf16;
typedef unsigned u32x4 __attribute__((ext_vector_type(4)));
typedef unsigned u32x2 __attribute__((ext_vector_type(2)));
typedef float f32x2 __attribute__((ext_vector_type(2)));
typedef float f32x4 __attribute__((ext_vector_type(4)));
typedef float f32x16 __attribute__((ext_vector_type(16)));
typedef short bf16x8 __attribute__((ext_vector_type(8)));
typedef short s16x4 __attribute__((ext_vector_type(4)));
typedef GAS unsigned gu32;

constexpr int DM = 2048, NB = 2, SEQ = 16384, MTOK = NB * SEQ, CTXL = 256, GRIDW = 64;
constexpr int NHEAD = 32, NKV = 4, HD = 64, QKVD = 2560, KVD = 256;
constexpr int NEXP = 16, EFF = 1024, NCLS = 24, LCAP = 32768;
constexpr int HYW = 64, HYEMB = 33;
constexpr float LN_EPS = 1e-5f;
constexpr float DN_ALPHA = 1.41421356237309515f;
constexpr float QSCALE = 0.125f * 1.4426950408889634f;
constexpr int NWAVES = 8, NTHR = 512;

constexpr size_t MiB = 1u << 20;
constexpr size_t WS_CTL = 0, CTL_ZERO_BYTES = 1 * MiB;
constexpr size_t WS_MOD = 1 * MiB;
constexpr size_t WS_ROPE = 1 * MiB + 512 * 1024;
constexpr size_t WS_FTAB = 1 * MiB + 768 * 1024;
constexpr size_t WS_CTXKV = 2 * MiB;
constexpr size_t WS_HDN = 3 * MiB;
constexpr size_t WS_W4T = 7 * MiB;
constexpr size_t WS_TOK = 8 * MiB;
constexpr size_t WS_GATE = 11 * MiB;
constexpr size_t WS_FFTS = 32 * MiB;
constexpr size_t WS_HT = 128 * MiB;
constexpr size_t WS_WQKV = 256 * MiB;
constexpr size_t WS_WO0 = 266 * MiB;
constexpr size_t WS_WHYIN = 274 * MiB;
constexpr size_t WS_WHYO = 298 * MiB;
constexpr size_t WS_W13 = 320 * MiB;
constexpr size_t WS_W2 = 576 * MiB;
constexpr size_t WS_A = 704 * MiB;
constexpr size_t WS_B = 832 * MiB;
constexpr size_t WS_END = 1216 * MiB;
constexpr int HID_ROWS = 38912;

constexpr int CW_TMO = 0;
constexpr int CW_BAR = 4096;
constexpr int CW_CNT = 16384;

constexpr int RING_BYTES = 131072;
constexpr int MISC_OFF = RING_BYTES + 320;
constexpr int FTAB_OFF = RING_BYTES + 1024;
constexpr int LDS_BYTES = 163840;
constexpr int SIDE_OFF = FTAB_OFF + 28672;

#define RLX_AGENT __ATOMIC_RELAXED, __HIP_MEMORY_SCOPE_AGENT
#define LDS_WAIT() asm volatile("s_waitcnt lgkmcnt(0)" ::: "memory")
#define VM_WAIT() asm volatile("s_waitcnt vmcnt(0)" ::: "memory")

__device__ __forceinline__ unsigned cvt_pk_bf16(float lo, float hi) { unsigned r; asm volatile("v_cvt_pk_bf16_f32 %0, %1, %2" : "=v"(r) : "v"(lo), "v"(hi)); return r; }
__device__ __forceinline__ float bf2f(unsigned h) { return __builtin_bit_cast(float, h << 16); }
__device__ __forceinline__ float bflo(unsigned w) { return __builtin_bit_cast(float, w << 16); }
__device__ __forceinline__ float bfhi(unsigned w) { return __builtin_bit_cast(float, w & 0xffff0000u); }
__device__ __forceinline__ float wave_sum(float v) {
    v += __builtin_bit_cast(float, __builtin_amdgcn_update_dpp(0, __builtin_bit_cast(int, v), 0xB1, 0xf, 0xf, true));
    v += __builtin_bit_cast(float, __builtin_amdgcn_update_dpp(0, __builtin_bit_cast(int, v), 0x4E, 0xf, 0xf, true));
    v += __builtin_bit_cast(float, __builtin_amdgcn_update_dpp(0, __builtin_bit_cast(int, v), 0x141, 0xf, 0xf, true));
    v += __builtin_bit_cast(float, __builtin_amdgcn_update_dpp(0, __builtin_bit_cast(int, v), 0x140, 0xf, 0xf, true));
    { auto r = __builtin_amdgcn_permlane16_swap(__float_as_uint(v), __float_as_uint(v), false, false); v = __uint_as_float(r[0]) + __uint_as_float(r[1]); }
    { auto r = __builtin_amdgcn_permlane32_swap(__float_as_uint(v), __float_as_uint(v), false, false); v = __uint_as_float(r[0]) + __uint_as_float(r[1]); }
    return v;
}

#define XB_TMO      128
#define XB_XCNT(j)  (256  + 64 * (j))
#define XB_XSUB(j)  (1280 + 64 * (j))
#define XB_XGEN(j)  (2304 + 64 * (j))
#define XB_TOP      3328
#define XB_TOPGEN   3392
#define XCD_BAR_WORDS 3456
#define XB_SPIN_CAP (1u << 18)

__device__ __forceinline__ unsigned xb_ld(unsigned* p)              { return __hip_atomic_load(p, __ATOMIC_RELAXED, __HIP_MEMORY_SCOPE_AGENT); }
__device__ __forceinline__ unsigned xb_add(unsigned* p, unsigned v) { return __hip_atomic_fetch_add(p, v, __ATOMIC_RELAXED, __HIP_MEMORY_SCOPE_AGENT); }
__device__ __forceinline__ unsigned xb_xcc_id() { return (unsigned)__builtin_amdgcn_s_getreg((3 << 11) | 20) & 0xFu; }
#define XB_SPIN(cond, bar) do { unsigned _sp = 0; while (cond) { __builtin_amdgcn_s_sleep(1); \
    if ((++_sp & 255u) == 0u) { if (xb_ld(&(bar)[XB_TMO])) break; if (_sp > XB_SPIN_CAP) { atomicAdd(&(bar)[XB_TMO], 1u); break; } } } } while (0)

struct XcdBarrier { unsigned* bar; unsigned x; volatile LAS unsigned* st; };

__device__ __forceinline__ XcdBarrier xcd_barrier_post(unsigned* bar, volatile LAS unsigned* st) {
    XcdBarrier b; b.bar = bar; b.x = xb_xcc_id(); b.st = st;
    if (threadIdx.x == 0) (void)xb_add(&bar[XB_XCNT(b.x)], 1u);
    return b;
}
__device__ __forceinline__ void xcd_barrier_complete(unsigned* bar, unsigned x, unsigned& nloc, unsigned& nx) {
    const unsigned G = gridDim.x * gridDim.y * gridDim.z;
    unsigned sum, cnt, mine, sp = 0u;
    for (;;) {
        sum = 0u; cnt = 0u; mine = 0u;
#pragma unroll
        for (unsigned j = 0; j < 16; ++j) { const unsigned c = xb_ld(&bar[XB_XCNT(j)]); sum += c; cnt += (c > 0u) ? 1u : 0u; mine = (j == x) ? c : mine; }
        if (sum == G) break;
        __builtin_amdgcn_s_sleep(1);
        if ((++sp & 255u) == 0u) { if (xb_ld(&bar[XB_TMO])) break; if (sp > XB_SPIN_CAP) { atomicAdd(&bar[XB_TMO], 1u); break; } }
    }
    nloc = mine > 0u ? mine : 1u; nx = cnt > 0u ? cnt : 1u;
}
__device__ __forceinline__ void xcd_barrier(const XcdBarrier& b) {
    asm volatile("s_waitcnt vmcnt(0)" ::: "memory");
    __syncthreads();
    if (threadIdx.x == 0) {
        unsigned* bar = b.bar;
        __builtin_amdgcn_s_waitcnt(0);
        unsigned nloc = b.st[0], nx = b.st[1];
        if (nloc == 0u) { xcd_barrier_complete(bar, b.x, nloc, nx); b.st[0] = nloc; b.st[1] = nx; }
        const unsigned old = xb_add(&bar[XB_XSUB(b.x)], 1u);
        const unsigned gen = old / nloc;
        if (old + 1u == (gen + 1u) * nloc) {
            __builtin_amdgcn_fence(__ATOMIC_RELEASE, "agent");
            asm volatile("s_waitcnt vmcnt(0)" ::: "memory");
            const unsigned og = xb_add(&bar[XB_TOP], 1u);
            const unsigned tg = og / nx;
            if (og + 1u == (tg + 1u) * nx) xb_add(&bar[XB_TOPGEN], 1u);
            else XB_SPIN(xb_ld(&bar[XB_TOPGEN]) == tg, bar);
            __builtin_amdgcn_fence(__ATOMIC_ACQUIRE, "agent");
            xb_add(&bar[XB_XGEN(b.x)], 1u);
            asm volatile("s_waitcnt vmcnt(0)" ::: "memory");
        } else {
            XB_SPIN(xb_ld(&bar[XB_XGEN(b.x)]) == gen, bar);
            __builtin_amdgcn_fence(__ATOMIC_ACQUIRE, "agent");
            asm volatile("s_waitcnt vmcnt(0)" ::: "memory");
        }
    }
    __syncthreads();
}

namespace pg {
constexpr int BM = 256, BK = 64, HALF = 128, HTB = HALF * BK * 2, NXCD = 8, WGM = 8;
__host__ __device__ __forceinline__ int lds_byte(int r, int c) { const int st = (r >> 4) * 2 + (c >> 5), rr = r & 15, cc = c & 31, ob = rr * 64 + cc * 2; return st * 1024 + (ob ^ (((ob >> 9) & 1) << 5)); }
__host__ __device__ __forceinline__ void stage_rc(int b, int& R, int& C) { const int st = b / 1024, sb = b % 1024, swz = sb ^ (((sb >> 9) & 1) << 5); R = (st >> 1) * 16 + swz / 64; C = (st & 1) * 32 + (swz % 64) / 2; }
__host__ __device__ __forceinline__ int perm32(int rho) { const int n = rho >> 4, i = rho & 15; return 8 * (i >> 2) + 4 * n + (i & 3); }

struct Unit { int pm, pn; const char* A; const char* B; const char* B2; int cls, row0, nrows, lbase; };

__device__ __forceinline__ bool static_map(int i, int G, int c, int nM, int nN, int& pm, int& pn) {
    const int nwg = nM * nN; const long L = (long)i * G + c; if (L >= nwg) return false;
    int wgid = (int)L; { const int q = nwg / NXCD, r = nwg % NXCD, xcd = wgid % NXCD, off = wgid / NXCD; wgid = (xcd < r ? xcd * (q + 1) : r * (q + 1) + (xcd - r) * q) + off; }
    const int nig = WGM * nN, gid = wgid / nig, fm = gid * WGM, gsz = (nM - fm) < WGM ? (nM - fm) : WGM;
    pm = fm + ((wgid % nig) % gsz); pn = (wgid % nig) / gsz; return true;
}
struct PlainSched {
    const char* A; const char* Bt; int nM, nN, G, c; size_t tA, tB;
    __device__ __forceinline__ void init(const void* A_, const void* Bt_, int M, int N, int ldA, int ldB, int G_, int c_) { A = (const char*)A_; Bt = (const char*)Bt_; nM = M / BM; nN = N / BM; G = G_; c = c_; tA = (size_t)BM * ldA * 2; tB = (size_t)BM * ldB * 2; }
    __device__ __forceinline__ bool next(int i, Unit& u) const {
        if (!static_map(i, G, c, nM, nN, u.pm, u.pn)) return false;
        u.A = A + (size_t)u.pm * tA; u.B = Bt + (size_t)u.pn * tB; u.B2 = u.B; u.cls = 0; u.row0 = 0; u.nrows = 256; u.lbase = 0; return true;
    }
    __device__ __forceinline__ unsigned row_off(const Unit&, int r, int ldA) const { return (unsigned)r * (unsigned)ldA * 2u; }
};

template <class Epi, class Sched, bool GATHER, bool KSPLIT, bool ALIGN_EPI>
__device__ __forceinline__ void gemm_phase(LAS unsigned char* lds, const int tid, const int K, const int ldA, const int ldB, const Sched& S, const Epi& E) {
    const int wid = __builtin_amdgcn_readfirstlane(tid >> 6), lane = tid & 63, wr = wid >> 2, wc = wid & 3, fr = lane & 15, fq = lane >> 4;
    const int nt = K / BK, nth = nt >> 1;
    int RA[2], CA[2];
    unsigned voffB[2], voA[2][2], nvoA[2][2];
#pragma unroll
    for (int i = 0; i < 2; ++i) { int R, C; stage_rc(tid * 16 + i * 8192, R, C); const int Rb = Epi::PERM ? ((R & ~31) + perm32(R & 31)) : R;
        RA[i] = R; CA[i] = C; voffB[i] = (unsigned)(Rb * ldB + C) * 2u;
        voA[0][i] = (unsigned)(R * ldA + C) * 2u; voA[1][i] = (unsigned)((R + HALF) * ldA + C) * 2u; nvoA[0][i] = voA[0][i]; nvoA[1][i] = voA[1][i]; }
    const size_t kstep = (size_t)(BK * 2);
    const size_t hstepB = (size_t)HALF * ldB * 2;
    const unsigned ldsw = (unsigned)wid * 1024u;
    const int aoff = lds_byte(wr * 64 + fr, fq * 8), boff = lds_byte(wc * 32 + fr, fq * 8);
#define PG8_SA(b, h) (((b) * 2 + (h)) * HTB)
#define PG8_SB(b, h) ((4 + (b) * 2 + (h)) * HTB)
#define PG8_STAGEB(bufoff, gbase) do { _Pragma("unroll") for (int _i = 0; _i < 2; ++_i) \
        __builtin_amdgcn_global_load_lds((const unsigned*)((const char*)(gbase) + voffB[_i]), (LAS unsigned*)(lds + (bufoff) + ldsw + _i * 8192), 16, 0, 0); } while (0)
#define PG8_STAGEA(bufoff, gbase, vo, h) do { _Pragma("unroll") for (int _i = 0; _i < 2; ++_i) \
        __builtin_amdgcn_global_load_lds((const unsigned*)((const char*)(gbase) + (vo)[h][_i]), (LAS unsigned*)(lds + (bufoff) + ldsw + _i * 8192), 16, 0, 0); } while (0)
#define PG8_LDA(dst, b, h) do { _Pragma("unroll") for (int m = 0; m < 4; ++m) _Pragma("unroll") for (int k = 0; k < 2; ++k) dst[m][k] = *(const LAS bf16x8*)(lds + PG8_SA(b, h) + aoff + m * 2048 + k * 1024); } while (0)
#define PG8_LDB(dst, b, h) do { _Pragma("unroll") for (int n = 0; n < 2; ++n) _Pragma("unroll") for (int k = 0; k < 2; ++k) dst[n][k] = *(const LAS bf16x8*)(lds + PG8_SB(b, h) + boff + n * 2048 + k * 1024); } while (0)
#define PG8_MMA(ai, bj, At, Bt) do { __builtin_amdgcn_s_setprio(1); _Pragma("unroll") for (int m = 0; m < 4; ++m) _Pragma("unroll") for (int n = 0; n < 2; ++n) _Pragma("unroll") for (int k = 0; k < 2; ++k) \
        acc[ai][bj][m][n] = __builtin_amdgcn_mfma_f32_16x16x32_bf16(Bt[n][k], At[m][k], acc[ai][bj][m][n], 0, 0, 0); __builtin_amdgcn_s_setprio(0); } while (0)
#define PG8_WAIT_V(n) asm volatile("s_waitcnt vmcnt(" #n ")" ::: "memory")
#define PG8_WAIT_L(n) asm volatile("s_waitcnt lgkmcnt(" #n ")" ::: "memory")
#define PG8_BAR __builtin_amdgcn_s_barrier()
#define PG8_SCHED __builtin_amdgcn_sched_barrier(0)
#define PG8_BPTR(tt) ((KSPLIT && (tt) >= nth) ? cB2 + (size_t)((tt) - nth) * kstep : cB + (size_t)(tt) * kstep)
    Unit cur, nxt; int ui = 0;
    if (!S.next(0, cur)) return;
    if constexpr (GATHER) {
#pragma unroll
        for (int h = 0; h < 2; ++h)
#pragma unroll
            for (int i = 0; i < 2; ++i) voA[h][i] = S.row_off(cur, h * HALF + RA[i], ldA) + (unsigned)CA[i] * 2u;
    }
    f32x4 acc[2][2][4][2];
#pragma unroll
    for (int a = 0; a < 2; ++a)
#pragma unroll
        for (int b = 0; b < 2; ++b)
#pragma unroll
            for (int m = 0; m < 4; ++m)
#pragma unroll
                for (int n = 0; n < 2; ++n) acc[a][b][m][n] = (f32x4){0.f, 0.f, 0.f, 0.f};
    bf16x8 At[4][2], B0[2][2], B1[2][2];
    const char* cA = cur.A; const char* cB = cur.B; const char* cB2 = cur.B2;
    PG8_STAGEB(PG8_SB(0, 0), cB); PG8_STAGEB(PG8_SB(0, 1), cB + hstepB); PG8_STAGEA(PG8_SA(0, 0), cA, voA, 0); PG8_STAGEA(PG8_SA(0, 1), cA, voA, 1);
    if (wr == 1) PG8_BAR;
    PG8_WAIT_V(2); PG8_BAR;
    { const char* b1 = PG8_BPTR(1); PG8_STAGEB(PG8_SB(1, 0), b1); PG8_STAGEA(PG8_SA(1, 0), cA + kstep, voA, 0); PG8_STAGEB(PG8_SB(1, 1), b1 + hstepB); }
    PG8_WAIT_V(6); PG8_BAR;
    for (;;) {
        if constexpr (Epi::SIDE) { if (wid == 0 && E.has_side()) __builtin_amdgcn_global_load_lds((const unsigned*)(E.side_src(cur) + lane * 16), (LAS unsigned*)(lds + SIDE_OFF + (ui & 1) * 1024), 16, 0, 0); }
        const bool has_next = S.next(ui + 1, nxt);
        const char* nA = has_next ? nxt.A : cA; const char* nB = has_next ? nxt.B : cB;
        if constexpr (GATHER) {
            if (has_next) {
#pragma unroll
                for (int h = 0; h < 2; ++h)
#pragma unroll
                    for (int i = 0; i < 2; ++i) nvoA[h][i] = S.row_off(nxt, h * HALF + RA[i], ldA) + (unsigned)CA[i] * 2u;
            } else {
#pragma unroll
                for (int h = 0; h < 2; ++h)
#pragma unroll
                    for (int i = 0; i < 2; ++i) nvoA[h][i] = voA[h][i];
            }
        }
        for (int t = 0; t < nt; t += 2) {
            const bool last = (t == nt - 2);
            const char* a1 = cA + (size_t)(t + 1) * kstep;
            const char* a2 = last ? nA : cA + (size_t)(t + 2) * kstep; const char* b2 = last ? nB : PG8_BPTR(t + 2);
            const char* a3 = a2 + kstep; const char* b3 = last ? nB + kstep : PG8_BPTR(t + 3);
            unsigned vo2[2][2];
#pragma unroll
            for (int h = 0; h < 2; ++h)
#pragma unroll
                for (int i = 0; i < 2; ++i) vo2[h][i] = (GATHER && last) ? nvoA[h][i] : voA[h][i];
            PG8_LDB(B0, 0, 0); PG8_LDB(B1, 0, 1); PG8_SCHED; PG8_LDA(At, 0, 0); PG8_STAGEA(PG8_SA(1, 1), a1, voA, 1);
            PG8_WAIT_V(8); PG8_WAIT_L(0); PG8_BAR; PG8_MMA(0, 0, At, B0); PG8_MMA(0, 1, At, B1); PG8_BAR; PG8_SCHED;
            PG8_LDA(At, 0, 1); PG8_STAGEB(PG8_SB(0, 0), b2); PG8_STAGEB(PG8_SB(0, 1), b2 + hstepB); PG8_STAGEA(PG8_SA(0, 0), a2, vo2, 0);
            PG8_WAIT_V(8); PG8_WAIT_L(0); PG8_BAR; PG8_MMA(1, 0, At, B0); PG8_MMA(1, 1, At, B1); PG8_BAR; PG8_SCHED;
            PG8_LDB(B0, 1, 0); PG8_LDB(B1, 1, 1); PG8_SCHED; PG8_LDA(At, 1, 0); PG8_STAGEA(PG8_SA(0, 1), a2, vo2, 1);
            PG8_WAIT_V(8); PG8_WAIT_L(0); PG8_BAR; PG8_MMA(0, 0, At, B0); PG8_MMA(0, 1, At, B1); PG8_BAR; PG8_SCHED;
            PG8_LDA(At, 1, 1); PG8_STAGEB(PG8_SB(1, 0), b3); PG8_STAGEB(PG8_SB(1, 1), b3 + hstepB); PG8_STAGEA(PG8_SA(1, 0), a3, vo2, 0);
            PG8_WAIT_V(8); PG8_WAIT_L(0); PG8_BAR; PG8_MMA(1, 0, At, B0); PG8_MMA(1, 1, At, B1); PG8_BAR; PG8_SCHED;
        }
        if constexpr (ALIGN_EPI) { if (wr == 0) PG8_BAR; }
        E(acc, cur, wr, wc, fr, fq, (const LAS float*)(lds + SIDE_OFF + (ui & 1) * 1024));
        if (!has_next) break;
#pragma unroll
        for (int a = 0; a < 2; ++a)
#pragma unroll
            for (int b = 0; b < 2; ++b)
#pragma unroll
                for (int m = 0; m < 4; ++m)
#pragma unroll
                    for (int n = 0; n < 2; ++n) acc[a][b][m][n] = (f32x4){0.f, 0.f, 0.f, 0.f};
        cur = nxt; cA = nA; cB = nB; cB2 = nxt.B2; ++ui;
        if constexpr (GATHER) {
#pragma unroll
            for (int h = 0; h < 2; ++h)
#pragma unroll
                for (int i = 0; i < 2; ++i) voA[h][i] = nvoA[h][i];
        }
        if constexpr (ALIGN_EPI) { if (wr == 1) PG8_BAR; }
    }
    PG8_WAIT_V(0);
    if constexpr (!ALIGN_EPI) { if (wr == 0) PG8_BAR; }
    PG8_BAR;
#undef PG8_SA
#undef PG8_SB
#undef PG8_STAGEA
#undef PG8_STAGEB
#undef PG8_LDA
#undef PG8_LDB
#undef PG8_MMA
#undef PG8_WAIT_V
#undef PG8_WAIT_L
#undef PG8_BAR
#undef PG8_SCHED
#undef PG8_BPTR
}
}
namespace pg {
template <bool BIAS_ROW> struct EpiBf16 {
    static constexpr bool PERM = true; static constexpr bool SIDE = BIAS_ROW;
    bf16* O; int ldc; const float* bias;
    __device__ __forceinline__ bool has_side() const { return bias != nullptr; }
    __device__ __forceinline__ const char* side_src(const Unit& u) const { return (const char*)(bias + u.pm * BM); }
    __device__ __forceinline__ void operator()(const f32x4 (&acc)[2][2][4][2], const Unit& u, int wr, int wc, int fr, int fq, const LAS float* side) const {
        const int row0 = u.pm * BM + wr * 64 + fr; const int col0 = u.pn * BM + wc * 32 + 8 * fq;
        f32x4 bv[2][2];
#pragma unroll
        for (int bj = 0; bj < 2; ++bj)
#pragma unroll
            for (int n = 0; n < 2; ++n) bv[bj][n] = (bias && !BIAS_ROW) ? *(const f32x4*)(bias + col0 + bj * HALF + 4 * n) : (f32x4){0.f, 0.f, 0.f, 0.f};
#pragma unroll
        for (int ai = 0; ai < 2; ++ai)
#pragma unroll
            for (int m = 0; m < 4; ++m) { const int row = row0 + ai * HALF + m * 16; bf16* rowp = O + (size_t)row * ldc + col0;
                float br = 0.f; if (BIAS_ROW && bias) br = side[wr * 64 + fr + ai * HALF + m * 16];
#pragma unroll
                for (int bj = 0; bj < 2; ++bj) { f32x4 v0 = acc[ai][bj][m][0] + bv[bj][0] + br, v1 = acc[ai][bj][m][1] + bv[bj][1] + br;
                    u32x4 w; w.x = cvt_pk_bf16(v0[0], v0[1]); w.y = cvt_pk_bf16(v0[2], v0[3]); w.z = cvt_pk_bf16(v1[0], v1[1]); w.w = cvt_pk_bf16(v1[2], v1[3]);
                    *(u32x4*)(rowp + bj * HALF) = w; } }
    }
};
struct EpiQKV {
    static constexpr bool PERM = false; static constexpr bool SIDE = false;
    bf16 *Q, *Kb, *Vb; const float* bias; const float* ropeC; const float* ropeS;
    __device__ __forceinline__ bool has_side() const { return false; }
    __device__ __forceinline__ const char* side_src(const Unit&) const { return nullptr; }
    __device__ __forceinline__ void operator()(const f32x4 (&acc)[2][2][4][2], const Unit& u, int wr, int wc, int fr, int fq, const LAS float*) const {
        const int row0 = u.pm * BM + wr * 64 + fr; const int colt = u.pn * BM + wc * 32 + 4 * fq;
        const bool isV = (u.pn == 9), isQ = (u.pn < 8);
        bf16* base; int ldc, cofs;
        if (isQ) { base = Q; ldc = DM; cofs = 0; } else if (!isV) { base = Kb; ldc = KVD; cofs = 2048; } else { base = Vb; ldc = KVD; cofs = 2304; }
        f32x4 bv[2][2];
#pragma unroll
        for (int bj = 0; bj < 2; ++bj)
#pragma unroll
            for (int n = 0; n < 2; ++n) bv[bj][n] = *(const f32x4*)(bias + colt + bj * HALF + 16 * n);
        const float sc = isQ ? QSCALE : 1.f; const int half = wc & 1;
#pragma unroll
        for (int ai = 0; ai < 2; ++ai)
#pragma unroll
            for (int m = 0; m < 4; ++m) { const int row = row0 + ai * HALF + m * 16; const int t = row & (SEQ - 1); const int pos = half ? (t & (GRIDW - 1)) : (t >> 6);
                f32x4 cs = (f32x4){1.f, 1.f, 1.f, 1.f}, sn = (f32x4){0.f, 0.f, 0.f, 0.f};
                if (!isV) { cs = *(const f32x4*)(ropeC + pos * 16 + 4 * fq); sn = *(const f32x4*)(ropeS + pos * 16 + 4 * fq); }
                bf16* rowp = base + (size_t)row * ldc + (colt - cofs);
#pragma unroll
                for (int bj = 0; bj < 2; ++bj) { const f32x4 x1 = acc[ai][bj][m][0] + bv[bj][0], x2 = acc[ai][bj][m][1] + bv[bj][1];
                    const f32x4 o1 = (x1 * cs - x2 * sn) * sc, o2 = (x2 * cs + x1 * sn) * sc;
                    u32x2 w1, w2; w1.x = cvt_pk_bf16(o1[0], o1[1]); w1.y = cvt_pk_bf16(o1[2], o1[3]); w2.x = cvt_pk_bf16(o2[0], o2[1]); w2.y = cvt_pk_bf16(o2[2], o2[3]);
                    *(u32x2*)(rowp + bj * HALF) = w1; *(u32x2*)(rowp + bj * HALF + 16) = w2; } }
    }
};
struct EpiMoe1 {
    static constexpr bool PERM = true; static constexpr bool SIDE = true;
    bf16* hid; const float* gates;
    __device__ __forceinline__ bool has_side() const { return true; }
    __device__ __forceinline__ const char* side_src(const Unit& u) const { return (const char*)(gates + (size_t)((u.pn >= 8) ? 1 : 0) * NCLS * LCAP + u.lbase); }
    __device__ __forceinline__ void operator()(const f32x4 (&acc)[2][2][4][2], const Unit& u, int wr, int wc, int fr, int fq, const LAS float* side) const {
        const int lr0 = wr * 64 + fr; const int col0 = u.pn * HALF + wc * 32 + 8 * fq; const int gsel = (u.pn >= 8) ? 1 : 0;
#pragma unroll
        for (int ai = 0; ai < 2; ++ai)
#pragma unroll
            for (int m = 0; m < 4; ++m) { const int lr = lr0 + ai * HALF + m * 16;
                if (lr < u.nrows) { const float g = side[lr];
                    float o[8];
#pragma unroll
                    for (int n = 0; n < 2; ++n)
#pragma unroll
                        for (int i = 0; i < 4; ++i) { const float a = acc[ai][0][m][n][i], b = acc[ai][1][m][n][i];
                            const float sg = __builtin_amdgcn_rcpf(1.f + __builtin_amdgcn_exp2f(-1.4426950408889634f * a)); o[n * 4 + i] = a * sg * b * g; }
                    u32x4 w; w.x = cvt_pk_bf16(o[0], o[1]); w.y = cvt_pk_bf16(o[2], o[3]); w.z = cvt_pk_bf16(o[4], o[5]); w.w = cvt_pk_bf16(o[6], o[7]);
                    *(u32x4*)(hid + (size_t)(u.row0 + lr) * DM + col0) = w; } }
    }
};
struct EpiMoe2 {
    static constexpr bool PERM = true; static constexpr bool SIDE = true;
    bf16* Y; const int* toks;
    __device__ __forceinline__ bool has_side() const { return true; }
    __device__ __forceinline__ const char* side_src(const Unit& u) const { return (const char*)(toks + u.lbase); }
    __device__ __forceinline__ void operator()(const f32x4 (&acc)[2][2][4][2], const Unit& u, int wr, int wc, int fr, int fq, const LAS float* side) const {
        const int lr0 = wr * 64 + fr; const int col0 = u.pn * BM + wc * 32 + 8 * fq;
#pragma unroll
        for (int ai = 0; ai < 2; ++ai)
#pragma unroll
            for (int m = 0; m < 4; ++m) { const int lr = lr0 + ai * HALF + m * 16;
                if (lr < u.nrows) { const int tok = ((const LAS int*)side)[lr]; bf16* rowp = Y + (size_t)tok * DM + col0;
#pragma unroll
                    for (int bj = 0; bj < 2; ++bj) { const f32x4 v0 = acc[ai][bj][m][0], v1 = acc[ai][bj][m][1];
                        u32x4 w; w.x = cvt_pk_bf16(v0[0], v0[1]); w.y = cvt_pk_bf16(v0[2], v0[3]); w.z = cvt_pk_bf16(v1[0], v1[1]); w.w = cvt_pk_bf16(v1[2], v1[3]);
                        *(u32x4*)(rowp + bj * HALF) = w; } } }
    }
};
struct MoeSched {
    const LAS int* tab;
    const char* Abase; const char* W; const int* toks; int G, c, NPN, second;
    __device__ __forceinline__ bool next(int i, Unit& u) const {
        const int TM = __builtin_amdgcn_readfirstlane(tab[24]);
        if (!static_map(i, G, c, TM, NPN, u.pm, u.pn)) return false;
        int cls = 0;
        for (int k = 1; k < NCLS; ++k) { const int s = __builtin_amdgcn_readfirstlane(tab[k]); if (u.pm >= s) cls = k; }
        const int ts = __builtin_amdgcn_readfirstlane(tab[cls]), cnt = __builtin_amdgcn_readfirstlane(tab[32 + cls]);
        const int ti = u.pm - ts; u.cls = cls; u.row0 = u.pm * BM; u.nrows = (cnt - ti * BM) < BM ? (cnt - ti * BM) : BM; u.lbase = cls * LCAP + ti * BM;
        const int g = cls / 6, p = cls % 6; const int lo = (p < 3) ? 0 : (p < 5 ? 1 : 2), hi = (p < 3) ? p + 1 : (p < 5 ? p - 1 : 3);
        const int elo = g * 4 + lo, ehi = g * 4 + hi;
        if (!second) { const int e = (u.pn < 8) ? elo : ehi; u.A = Abase; u.B = W + ((size_t)e * 2048 + (size_t)(u.pn & 7) * 256) * 2048 * 2; u.B2 = u.B; }
        else { u.A = Abase + (size_t)u.row0 * DM * 2; u.B = W + ((size_t)elo * 2048 + (size_t)u.pn * 256) * 1024 * 2; u.B2 = W + ((size_t)ehi * 2048 + (size_t)u.pn * 256) * 1024 * 2; }
        return true;
    }
    __device__ __forceinline__ unsigned row_off(const Unit& u, int r, int ldA) const {
        const int rr = r < u.nrows ? r : u.nrows - 1; const int tok = toks[u.lbase + rr]; return (unsigned)tok * (unsigned)ldA * 2u;
    }
};
}
struct Args { const float* in[34]; float* out; unsigned char* ws; int ph_lo, ph_hi; };
struct Frame {
    LAS unsigned char* lds;
    gu32* ctl; unsigned char* ws;
    int tid, lane, wave, G, bid;
    const Args* a; float* out;
};
#define AIN(i) (F.a->in[i])
enum { I_X = 0, I_C, I_CTX, I_CCTX, I_ADAW, I_ADAB, I_AWIN, I_ABIN, I_SINK, I_AWOUT, I_HWIN, I_HBIN, I_HCW, I_HCB, I_FW1, I_FB1, I_FW2, I_FB2, I_FW3, I_FB3, I_FFREQ, I_FW4, I_FBIAS, I_HWOUT, I_HBOUT,
       I_LN1G, I_LN1B, I_LN2G, I_LN2B, I_RW, I_RB, I_W1, I_W3, I_W2 };
#ifndef TPSEL
#define TPSEL -1
#endif
#define TPS_W ((LAS unsigned long long*)(F.lds + RING_BYTES + 320 + 96))
#define TPS_START(id) do { if (TPSEL == (id) && blockIdx.x == 0 && threadIdx.x == 0) TPS_W[1] = __builtin_amdgcn_s_memrealtime(); } while (0)
#define TPS_STOP(id) do { if (TPSEL == (id) && blockIdx.x == 0 && threadIdx.x == 0) TPS_W[0] += __builtin_amdgcn_s_memrealtime() - TPS_W[1]; } while (0)
__device__ __forceinline__ int fresh_tid(int wave) { int l_; asm volatile("v_mbcnt_lo_u32_b32 %0, -1, 0\n\tv_mbcnt_hi_u32_b32 %0, -1, %0" : "=&v"(l_)); return wave * 64 + l_; }
__device__ __forceinline__ float* mod_ptr(const Frame& F, int layer, int vec, int chunk) { return (float*)(F.ws + WS_MOD) + ((size_t)(layer * 3 + vec) * 6 + chunk) * DM; }

__device__ __forceinline__ float hy_ftab_value(int f, int l, int jj);
__device__ constexpr int hy_ftab_elems() { return 28 * 64 * 8; }
__device__ __forceinline__ void p0_transpose_item(const float* W, int ldw, bf16* WT, int ldt, int dst_row, int k0, int n0, LAS float* scr, int lane) {
#pragma unroll
    for (int i = 0; i < 32; ++i) { const int kk = 2 * i + (lane >> 5); scr[kk * 33 + (lane & 31)] = W[(size_t)(k0 + kk) * ldw + n0 + (lane & 31)]; }
    LDS_WAIT(); asm volatile("" ::: "memory");
    const int c = lane & 7;
#pragma unroll
    for (int j = 0; j < 4; ++j) { const int n = (lane >> 3) + 8 * j; const LAS float* s = scr + (8 * c) * 33 + n;
        u32x4 o; o.x = cvt_pk_bf16(s[0 * 33], s[1 * 33]); o.y = cvt_pk_bf16(s[2 * 33], s[3 * 33]); o.z = cvt_pk_bf16(s[4 * 33], s[5 * 33]); o.w = cvt_pk_bf16(s[6 * 33], s[7 * 33]);
        *(GAS u32x4*)(WT + (size_t)(dst_row + n) * ldt + k0 + 8 * c) = o; }
    LDS_WAIT(); asm volatile("" ::: "memory");
}
struct ConvItem { const float* W; bf16* WT; int ldw, ldt, dst_row, k0, n0; };
__device__ __forceinline__ ConvItem moe_l1_item(const Frame& F, int it) {
    ConvItem c; const int mat = it >> 10, sub = it & 1023, which = mat >> 4, le = 16 + (mat & 15);
    if (which < 2) { c.n0 = (sub & 31) * 32; c.k0 = (sub >> 5) * 64; c.W = (which == 0 ? AIN(I_W1) : AIN(I_W3)) + (size_t)le * DM * EFF; c.ldw = EFF; c.WT = (bf16*)(F.ws + WS_W13) + (size_t)le * 2048 * 2048; c.ldt = DM; c.dst_row = (c.n0 >> 7) * 256 + which * 128 + (c.n0 & 127); }
    else { c.n0 = (sub & 63) * 32; c.k0 = (sub >> 6) * 64; c.W = AIN(I_W2) + (size_t)le * EFF * DM; c.ldw = DM; c.WT = (bf16*)(F.ws + WS_W2) + (size_t)le * 2048 * 1024; c.ldt = EFF; c.dst_row = c.n0; }
    return c;
}
__device__ __forceinline__ ConvItem early_item(const Frame& F, int it) {
    ConvItem c;
    if (it < 48 * 1024) { const int mat = it >> 10, sub = it & 1023, which = mat >> 4, le = mat & 15;
        if (which < 2) { c.n0 = (sub & 31) * 32; c.k0 = (sub >> 5) * 64; c.W = (which == 0 ? AIN(I_W1) : AIN(I_W3)) + (size_t)le * DM * EFF; c.ldw = EFF; c.WT = (bf16*)(F.ws + WS_W13) + (size_t)le * 2048 * 2048; c.ldt = DM; c.dst_row = (c.n0 >> 7) * 256 + which * 128 + (c.n0 & 127); }
        else { c.n0 = (sub & 63) * 32; c.k0 = (sub >> 6) * 64; c.W = AIN(I_W2) + (size_t)le * EFF * DM; c.ldw = DM; c.WT = (bf16*)(F.ws + WS_W2) + (size_t)le * 2048 * 1024; c.ldt = EFF; c.dst_row = c.n0; }
    } else { int r = it - 48 * 1024;
        if (r < 32 * 192) { c.n0 = (r % 192) * 32; c.k0 = (r / 192) * 64; c.W = AIN(I_HWIN); c.ldw = 3 * DM; c.WT = (bf16*)(F.ws + WS_WHYIN); c.ldt = DM; c.dst_row = c.n0; }
        else { r -= 32 * 192; c.n0 = (r % 64) * 32; c.k0 = (r / 64) * 64; c.W = AIN(I_HWOUT); c.ldw = DM; c.WT = (bf16*)(F.ws + WS_WHYO); c.ldt = DM; c.dst_row = c.n0; } }
    return c;
}
constexpr int EARLY_NIT = 48 * 1024 + 32 * 192 + 32 * 64;
__device__ __forceinline__ void conv_issue(const ConvItem& c, int lane, float (&v)[32]) {
    const float* p = c.W + (size_t)(c.k0 + (lane >> 5)) * c.ldw + c.n0 + (lane & 31); const size_t st = (size_t)2 * c.ldw;
#pragma unroll
    for (int i = 0; i < 32; ++i) { v[i] = *p; p += st; asm volatile("" : "+v"(p)); }
}
__device__ __forceinline__ void conv_finish(const ConvItem& c, int lane, const float (&v)[32]) {
    bf16* row = c.WT + (size_t)(c.dst_row + (lane & 31)) * c.ldt + c.k0 + 8 * (lane >> 5);
#pragma unroll
    for (int m = 0; m < 4; ++m) { u32x4 w;
#pragma unroll
        for (int q = 0; q < 4; ++q) { auto r = __builtin_amdgcn_permlane32_swap(__float_as_uint(v[8 * m + q]), __float_as_uint(v[8 * m + 4 + q]), false, false);
            const unsigned pk = cvt_pk_bf16(__uint_as_float(r[0]), __uint_as_float(r[1])); if (q == 0) w.x = pk; else if (q == 1) w.y = pk; else if (q == 2) w.z = pk; else w.w = pk; }
        *(GAS u32x4*)(row + 16 * m) = w; }
}
__device__ __forceinline__ void p0_prologue(Frame& F) {
    const int gw = F.bid * NWAVES + F.wave, NGW = F.G * NWAVES, gt = F.bid * NTHR + F.tid, NGT = F.G * NTHR;
#ifndef P0_REP
#define P0_REP 0
#endif
    TPS_START(20);
#pragma unroll 1
    for (int rep_a = 0; rep_a < ((P0_REP & 1) ? 2 : 1); ++rep_a) {
        LAS float* sil = (LAS float*)F.lds; LAS float* red = sil + 3 * DM;
        for (int i = F.tid; i < 3 * DM; i += NTHR) { const int v = i / DM, k = i % DM; const float cv = (v < 2) ? AIN(I_C)[v * DM + k] : AIN(I_CCTX)[k]; sil[i] = cv / (1.f + expf(-cv)); }
        __syncthreads();
        const int cl = F.tid & 7, kg = F.tid >> 3;
        for (int unit = F.bid; unit < 768; unit += F.G) {
            const int l = unit / 384, n0 = (unit % 384) * 32;
            const float* W = AIN(I_ADAW) + (size_t)l * DM * 12288 + n0 + cl * 4;
            f32x4 a0 = {0.f, 0.f, 0.f, 0.f}, a1 = a0, a2 = a0;
#pragma unroll 8
            for (int i = 0; i < 32; ++i) { const int k = kg + 64 * i; const f32x4 w = *(const f32x4*)(W + (size_t)k * 12288); a0 += w * sil[k]; a1 += w * sil[DM + k]; a2 += w * sil[2 * DM + k]; }
#pragma unroll
            for (int j = 0; j < 4; ++j) { red[(kg * 32 + cl * 4 + j) * 3 + 0] = a0[j]; red[(kg * 32 + cl * 4 + j) * 3 + 1] = a1[j]; red[(kg * 32 + cl * 4 + j) * 3 + 2] = a2[j]; }
            __syncthreads();
            if (F.tid < 96) { const int col = F.tid & 31, v = F.tid >> 5; float s = 0.f;
                for (int k = 0; k < 64; ++k) s += red[(k * 32 + col) * 3 + v];
                ((float*)(F.ws + WS_MOD))[(size_t)(l * 3 + v) * 12288 + n0 + col] = s + AIN(I_ADAB)[l * 12288 + n0 + col]; }
            __syncthreads();
        }
    }
    TPS_STOP(20); TPS_START(21);
#pragma unroll 1
    for (int rep_b = 0; rep_b < ((P0_REP & 2) ? 2 : 1); ++rep_b) {
        LAS float* scr = (LAS float*)(F.lds + F.wave * 16384);
        constexpr int I0 = 32 * 80, I1 = 32 * 64, NIT = I0 + I1 + EARLY_NIT;
        for (int it = gw; it < NIT; it += NGW) {
            int r = it;
            if (r < I0) { p0_transpose_item(AIN(I_AWIN), QKVD, (bf16*)(F.ws + WS_WQKV), DM, (r % 80) * 32, (r / 80) * 64, (r % 80) * 32, scr, F.lane); continue; } r -= I0;
            if (r < I1) { p0_transpose_item(AIN(I_AWOUT), DM, (bf16*)(F.ws + WS_WO0), DM, (r % 64) * 32, (r / 64) * 64, (r % 64) * 32, scr, F.lane); continue; } r -= I1;
            const ConvItem c = early_item(F, r); p0_transpose_item(c.W, c.ldw, c.WT, c.ldt, c.dst_row, c.k0, c.n0, scr, F.lane);
        }
    }
    TPS_STOP(21); TPS_START(22);
    {
        const int j = F.lane; const float fr = AIN(I_FFREQ)[j], b1 = AIN(I_FB1)[j], b2 = AIN(I_FB2)[j], b3 = AIN(I_FB3)[j];
        float wc1[HYEMB], wc2[HYW], wc3[HYW];
#pragma unroll
        for (int i = 0; i < HYEMB; ++i) wc1[i] = AIN(I_FW1)[i * HYW + j];
#pragma unroll
        for (int i = 0; i < HYW; ++i) { wc2[i] = AIN(I_FW2)[i * HYW + j]; wc3[i] = AIN(I_FW3)[i * HYW + j]; }
        bf16* hdn = (bf16*)(F.ws + WS_HDN);
        for (int row = gw; row < SEQ; row += NGW) {
            const float tt = (float)row / (float)(SEQ - 1); const float wv = 6.283185307179586f * (float)row / (float)SEQ;
            float zv = 0.f;
            if (j == 0) zv = tt;
            else if (j <= 32) { const int jj = (j - 1) & 15; const float f = 1e-4f + (float)jj * ((15.f - 1e-4f) / 15.f); const float a = f * wv; zv = (j <= 16) ? cosf(a) : -sinf(a); }
            float h = b1;
#pragma unroll
            for (int i = 0; i < HYEMB; ++i) h += __builtin_bit_cast(float, __builtin_amdgcn_readlane(__builtin_bit_cast(int, zv), i)) * wc1[i];
            float a1 = sinf(fr * h);
            h = b2;
#pragma unroll
            for (int i = 0; i < HYW; ++i) h += __builtin_bit_cast(float, __builtin_amdgcn_readlane(__builtin_bit_cast(int, a1), i)) * wc2[i];
            float a2 = sinf(fr * h);
            h = b3;
#pragma unroll
            for (int i = 0; i < HYW; ++i) h += __builtin_bit_cast(float, __builtin_amdgcn_readlane(__builtin_bit_cast(int, a2), i)) * wc3[i];
            const float a3 = sinf(fr * h);
            hdn[(size_t)row * 128 + j] = (bf16)(cvt_pk_bf16(a3, 0.f) & 0xffffu); hdn[(size_t)row * 128 + 64 + j] = 0;
        }
    }
    TPS_STOP(22); TPS_START(23);
    for (int i = gt; i < hy_ftab_elems(); i += NGT) ((bf16*)(F.ws + WS_FTAB))[i] = (bf16)(cvt_pk_bf16(hy_ftab_value(i >> 9, (i >> 3) & 63, i & 7), 0.f) & 0xffffu);
    for (int i = gt; i < 4096; i += NGT) { const int pos = i >> 4, dd = i & 15; const float inv = powf(10000.f, -(float)(2 * dd) / 32.f); const float a = (float)pos * inv;
        ((float*)(F.ws + WS_ROPE))[i] = cosf(a); ((float*)(F.ws + WS_ROPE))[4096 + i] = sinf(a); }
    for (int i = gt; i < 4096 * 128; i += NGT) { const int k = i >> 12, n = i & 4095;
        ((bf16*)(F.ws + WS_W4T))[(size_t)n * 128 + k] = (k < 64) ? (bf16)(cvt_pk_bf16(AIN(I_FW4)[(size_t)k * 4096 + n], 0.f) & 0xffffu) : (bf16)0; }
    TPS_STOP(23);
}

__device__ __forceinline__ void p1_prologue(Frame& F) {
    if (F.wave < 4) {
        for (int tile = F.bid * 4 + F.wave; tile < 1024; tile += F.G * 4) {
            const int r0 = (tile >> 5) * 16, n0 = (tile & 31) * 16; const int lr = F.lane & 15, kq = F.lane >> 4;
            const float* crow = AIN(I_CTX) + (size_t)(r0 + lr) * DM; const float* sh = mod_ptr(F, 0, 2, 0); const float* sc = mod_ptr(F, 0, 2, 1);
            const bf16* wrow = (const bf16*)(F.ws + WS_WQKV) + (size_t)(2048 + n0 + lr) * DM;
            f32x4 acc = {0.f, 0.f, 0.f, 0.f};
#pragma unroll 4
            for (int k0 = 0; k0 < DM; k0 += 32) { const int k = k0 + 8 * kq;
                const f32x4 x0 = *(const f32x4*)(crow + k), x1 = *(const f32x4*)(crow + k + 4), s0 = *(const f32x4*)(sc + k), s1 = *(const f32x4*)(sc + k + 4), h0 = *(const f32x4*)(sh + k), h1 = *(const f32x4*)(sh + k + 4);
                const f32x4 u0 = x0 * (s0 + 1.f) + h0, u1 = x1 * (s1 + 1.f) + h1;
                u32x4 aw; aw.x = cvt_pk_bf16(u0[0], u0[1]); aw.y = cvt_pk_bf16(u0[2], u0[3]); aw.z = cvt_pk_bf16(u1[0], u1[1]); aw.w = cvt_pk_bf16(u1[2], u1[3]);
                const bf16x8 bfrag = *(const bf16x8*)(wrow + k);
                acc = __builtin_amdgcn_mfma_f32_16x16x32_bf16(__builtin_bit_cast(bf16x8, aw), bfrag, acc, 0, 0, 0); }
            const float bb = AIN(I_ABIN)[2048 + n0 + lr]; bf16* o = (bf16*)(F.ws + WS_CTXKV);
#pragma unroll
            for (int r = 0; r < 4; ++r) o[(size_t)(r0 + 4 * kq + r) * 512 + n0 + lr] = (bf16)(cvt_pk_bf16(acc[r] + bb, 0.f) & 0xffffu);
        }
    }
    const float* x = AIN(I_X); bf16* u0 = (bf16*)(F.ws + WS_A);
    LAS int* cnt = (LAS int*)(F.lds + RING_BYTES + 64);
    const size_t NI = (size_t)MTOK * DM / 8; const size_t per = (NI + F.G - 1) / F.G; const size_t i0 = (size_t)F.bid * per; const size_t i1 = (i0 + per < NI) ? i0 + per : NI;
    const int nch = (int)((i1 - i0 + 255) / 256);
    for (;;) {
        int c = 0; if (F.lane == 0) c = __hip_atomic_fetch_add(cnt, 1, __ATOMIC_RELAXED, __HIP_MEMORY_SCOPE_WORKGROUP);
        c = __builtin_amdgcn_readfirstlane(c); if (c >= nch) break;
        f32x4 xa[4], xb[4]; size_t ee[4];
#pragma unroll
        for (int j = 0; j < 4; ++j) { const size_t i = i0 + (size_t)c * 256 + j * 64 + F.lane; ee[j] = (i < i1) ? i * 8 : (size_t)-1; if (i < i1) { xa[j] = *(const f32x4*)(x + i * 8); xb[j] = *(const f32x4*)(x + i * 8 + 4); } }
#pragma unroll
        for (int j = 0; j < 4; ++j) { if (ee[j] == (size_t)-1) continue; const size_t e = ee[j]; const int col = (int)(e & (DM - 1)); const int b = (int)(e / ((size_t)SEQ * DM));
            const float* sh = mod_ptr(F, 0, b, 0) + col; const float* sc = mod_ptr(F, 0, b, 1) + col;
            const f32x4 v0 = xa[j] * (*(const f32x4*)sc + 1.f) + *(const f32x4*)sh, v1 = xb[j] * (*(const f32x4*)(sc + 4) + 1.f) + *(const f32x4*)(sh + 4);
            u32x4 w; w.x = cvt_pk_bf16(v0[0], v0[1]); w.y = cvt_pk_bf16(v0[2], v0[3]); w.z = cvt_pk_bf16(v1[0], v1[1]); w.w = cvt_pk_bf16(v1[2], v1[3]);
            *(u32x4*)(u0 + e) = w; }
    }
}
namespace att {
constexpr int LDS_K = 0, LDS_V = 24576, LDS_WS = 49152, LDS_OST = LDS_WS + NWAVES * 64 * 4, LDS_Q = LDS_OST + NWAVES * 4096;
__device__ __forceinline__ int crow(int r, int hi) { return (r & 3) + 8 * (r >> 2) + 4 * hi; }
__device__ __forceinline__ float max3f(float a, float b, float c) { return __builtin_fmaxf(__builtin_fmaxf(a, b), c); }
__device__ __forceinline__ float rowmax(const f32x16& p0, const f32x16& p1) {
    float a = max3f(p0[0], p0[1], p1[0]), b = max3f(p0[2], p0[3], p1[1]); a = max3f(a, p1[2], p1[3]);
#pragma unroll
    for (int r = 4; r < 16; r += 4) { a = max3f(a, p0[r], p0[r + 1]); b = max3f(b, p0[r + 2], p0[r + 3]); a = max3f(a, p1[r], p1[r + 1]); b = max3f(b, p1[r + 2], p1[r + 3]); }
    const float m = __builtin_fmaxf(a, b);
    auto rr = __builtin_amdgcn_permlane32_swap(__float_as_uint(m), __float_as_uint(m), false, false);
    return __builtin_fmaxf(__uint_as_float(rr[0]), __uint_as_float(rr[1]));
}
__device__ __forceinline__ void qkt(f32x16& p0, f32x16& p1, const LAS unsigned char* Kslot, const bf16x8* qr, const f32x16& z, int r32, int hi) {
    const LAS unsigned char* kb = Kslot + hi * 1024 + r32 * 16;
#pragma unroll
    for (int d0 = 0; d0 < 4; ++d0) {
        const bf16x8 b0 = *(const LAS bf16x8*)(kb + d0 * 2048);
        const bf16x8 b1 = *(const LAS bf16x8*)(kb + d0 * 2048 + 512);
        if (d0 == 0) { p0 = __builtin_amdgcn_mfma_f32_32x32x16_bf16(b0, qr[0], z, 0, 0, 0); p1 = __builtin_amdgcn_mfma_f32_32x32x16_bf16(b1, qr[0], z, 0, 0, 0); }
        else { p0 = __builtin_amdgcn_mfma_f32_32x32x16_bf16(b0, qr[d0], p0, 0, 0, 0); p1 = __builtin_amdgcn_mfma_f32_32x32x16_bf16(b1, qr[d0], p1, 0, 0, 0); }
    }
}
__device__ __forceinline__ void pv(f32x16* o, int vb, bf16x8 pa0, bf16x8 pa1, bf16x8 pa2, bf16x8 pa3) {
#pragma unroll
    for (int d0 = 0; d0 < 2; ++d0) { s16x4 lo[4], hi[4];
#pragma unroll
        for (int ks = 0; ks < 4; ++ks) {
            asm volatile("ds_read_b64_tr_b16 %0,%1 offset:%c2" : "=&v"(lo[ks]) : "v"(vb), "i"(d0 * 4096 + ks * 1024) : "memory");
            asm volatile("ds_read_b64_tr_b16 %0,%1 offset:%c2" : "=&v"(hi[ks]) : "v"(vb), "i"(d0 * 4096 + ks * 1024 + 512) : "memory"); }
        asm volatile("s_waitcnt lgkmcnt(0)" ::: "memory"); __builtin_amdgcn_sched_barrier(0);
#define PK(k) (bf16x8){lo[k][0], lo[k][1], lo[k][2], lo[k][3], hi[k][0], hi[k][1], hi[k][2], hi[k][3]}
        o[d0] = __builtin_amdgcn_mfma_f32_32x32x16_bf16(pa0, PK(0), o[d0], 0, 0, 0);
        o[d0] = __builtin_amdgcn_mfma_f32_32x32x16_bf16(pa1, PK(1), o[d0], 0, 0, 0);
        o[d0] = __builtin_amdgcn_mfma_f32_32x32x16_bf16(pa2, PK(2), o[d0], 0, 0, 0);
        o[d0] = __builtin_amdgcn_mfma_f32_32x32x16_bf16(pa3, PK(3), o[d0], 0, 0, 0);
#undef PK
    }
}
__device__ __forceinline__ void attn_issue(const Frame& F, int u, int t, int slot) {
    const int lane = F.lane, wid = F.wave; LAS unsigned char* shm = F.lds;
    const int qb = u % (SEQ / 32), bk = u / (SEQ / 32), b = bk / NKV, kvh = bk % NKV; const int q0 = qb * 32;
    const bf16* Kb = (const bf16*)(F.ws + WS_B + 128 * MiB); const bf16* Vb = (const bf16*)(F.ws + WS_B + 144 * MiB); const bf16* CKV = (const bf16*)(F.ws + WS_CTXKV);
    const size_t tok0 = (size_t)b * SEQ; const bf16* ksrc; const bf16* vsrc;
    if (t < 4) { const int c0 = b * CTXL + t * 64;
        ksrc = CKV + (size_t)(c0 + lane) * 512 + kvh * HD + wid * 8;
        vsrc = CKV + (size_t)(c0 + 16 * (wid & 3) + (lane >> 2)) * 512 + 256 + kvh * HD + (wid >> 2) * 32 + (lane & 3) * 8;
    } else { const int key0 = ((q0 - 128) & ~63) + (t - 4) * 64;
        int kr = key0 + lane; kr = kr < 0 ? 0 : (kr > SEQ - 1 ? SEQ - 1 : kr);
        int vr = key0 + 16 * (wid & 3) + (lane >> 2); vr = vr < 0 ? 0 : (vr > SEQ - 1 ? SEQ - 1 : vr);
        ksrc = Kb + (tok0 + kr) * KVD + kvh * HD + wid * 8;
        vsrc = Vb + (tok0 + vr) * KVD + kvh * HD + (wid >> 2) * 32 + (lane & 3) * 8;
    }
    __builtin_amdgcn_global_load_lds((const unsigned*)ksrc, (LAS unsigned*)(shm + LDS_K + slot * 8192 + wid * 1024), 16, 0, 0);
    __builtin_amdgcn_global_load_lds((const unsigned*)vsrc, (LAS unsigned*)(shm + LDS_V + slot * 8192 + wid * 1024), 16, 0, 0);
    if (t == 0) {
        const bf16* Qw = (const bf16*)(F.ws + WS_B) + (tok0 + q0 + (lane & 31)) * DM + (kvh * 8 + wid) * HD + (lane >> 5) * 8;
#pragma unroll
        for (int d0 = 0; d0 < 4; ++d0) __builtin_amdgcn_global_load_lds((const unsigned*)(Qw + d0 * 16), (LAS unsigned*)(shm + LDS_Q + wid * 4096 + d0 * 1024), 16, 0, 0);
    }
}
__device__ __forceinline__ void attn_phase(const Frame& F) {
    const int NU = NB * NKV * (SEQ / 32); const int per = (NU + F.G - 1) / F.G;
    const int u0 = F.bid * per; const int u1 = (u0 + per < NU) ? u0 + per : NU; if (u0 >= u1) return;
    const int ntile = (u1 - u0) * 9;
    const int lane = F.lane, r32 = lane & 31, hi = lane >> 5, wid = F.wave;
    LAS unsigned char* shm = F.lds;
    bf16* O = (bf16*)(F.ws + WS_A);
    LAS float* wsf = (LAS float*)(shm + LDS_WS) + wid * 64;
    const int vb0 = (int)(uintptr_t)(shm + LDS_V) + ((lane >> 4) & 1) * 32 + (lane & 3) * 8 + (4 * hi + ((lane & 15) >> 2)) * 64;
    bf16x8 qr[4]; float mref = 0.f, l_reg = 0.f; f32x16 o[2]; o[0] = f32x16{}; o[1] = f32x16{}; f32x16 negm = f32x16{};
    attn_issue(F, u0, 0, 0);
    if (ntile > 1) attn_issue(F, u0, 1, 1);
    int u = u0, t = 0;
    for (int g = 0; g < ntile; ++g) {
        const int slot = g % 3;
        const int qb = u % (SEQ / 32), bk = u / (SEQ / 32), b = bk / NKV, kvh = bk % NKV; const int q0 = qb * 32; const int head = kvh * 8 + wid; const size_t tok0 = (size_t)b * SEQ;
        if (g + 1 < ntile) { if (t == 8) asm volatile("s_waitcnt vmcnt(6)" ::: "memory"); else asm volatile("s_waitcnt vmcnt(2)" ::: "memory"); }
        else asm volatile("s_waitcnt vmcnt(0)" ::: "memory");
        LDS_WAIT(); __builtin_amdgcn_s_barrier();
        if (g + 2 < ntile) { const int g2 = g + 2; attn_issue(F, u0 + g2 / 9, g2 % 9, g2 % 3); }
        if (t == 0) {
#pragma unroll
            for (int d0 = 0; d0 < 4; ++d0) qr[d0] = *(const LAS bf16x8*)(shm + LDS_Q + wid * 4096 + d0 * 1024 + lane * 16);
            mref = 0.f; l_reg = 0.f; o[0] = f32x16{}; o[1] = f32x16{}; negm = f32x16{}; }
        f32x16 p0, p1;
        qkt(p0, p1, shm + LDS_K + slot * 8192, qr, negm, r32, hi);
        { const int key0 = ((q0 - 128) & ~63) + (t - 4) * 64;
          if (t >= 4 && (t == 4 || t == 8 || key0 < 0 || key0 + 64 > SEQ)) { const int qpos = q0 + r32;
#pragma unroll
            for (int r = 0; r < 16; ++r) { const int k0 = key0 + crow(r, hi), k1 = k0 + 32;
                const bool v0 = (k0 >= 0) && (k0 < SEQ) && (k0 - qpos <= 128) && (qpos - k0 <= 128);
                const bool v1 = (k1 >= 0) && (k1 < SEQ) && (k1 - qpos <= 128) && (qpos - k1 <= 128);
                p0[r] = v0 ? p0[r] : -INFINITY; p1[r] = v1 ? p1[r] : -INFINITY; } } }
        const float rm = rowmax(p0, p1);
        if (__any(rm > 8.f)) {
            const float dl = __builtin_fmaxf(rm, 0.f); mref += dl;
            const float f = __builtin_amdgcn_exp2f(-dl); l_reg *= f;
#pragma unroll
            for (int r = 0; r < 16; ++r) { p0[r] -= dl; p1[r] -= dl; negm[r] = -mref; }
            if (hi == 0) wsf[r32] = f;
            LDS_WAIT();
#pragma unroll
            for (int d = 0; d < 2; ++d)
#pragma unroll
                for (int r = 0; r < 16; ++r) o[d][r] *= wsf[crow(r, hi)];
        }
        float sacc = 0.f;
#pragma unroll
        for (int r = 0; r < 16; ++r) { p0[r] = __builtin_amdgcn_exp2f(p0[r]); p1[r] = __builtin_amdgcn_exp2f(p1[r]); sacc += p0[r] + p1[r]; }
        l_reg += sacc;
        u32x4 pw0, pw1, pw2, pw3;
#define PKW(P, B) cvt_pk_bf16(P[B], P[B + 1])
        pw0 = (u32x4){PKW(p0, 0), PKW(p0, 2), PKW(p0, 4), PKW(p0, 6)}; pw1 = (u32x4){PKW(p0, 8), PKW(p0, 10), PKW(p0, 12), PKW(p0, 14)};
        pw2 = (u32x4){PKW(p1, 0), PKW(p1, 2), PKW(p1, 4), PKW(p1, 6)}; pw3 = (u32x4){PKW(p1, 8), PKW(p1, 10), PKW(p1, 12), PKW(p1, 14)};
#undef PKW
        pv(o, vb0 + slot * 8192, __builtin_bit_cast(bf16x8, pw0), __builtin_bit_cast(bf16x8, pw1), __builtin_bit_cast(bf16x8, pw2), __builtin_bit_cast(bf16x8, pw3));
        if (t == 8) {
            { auto rr = __builtin_amdgcn_permlane32_swap(__float_as_uint(l_reg), __float_as_uint(l_reg), false, false); l_reg = __uint_as_float(rr[0]) + __uint_as_float(rr[1]); }
            l_reg += __builtin_amdgcn_exp2f(AIN(I_SINK)[head] * 1.4426950408889634f - mref);
            if (hi == 0) wsf[32 + r32] = l_reg;
            LDS_WAIT();
            float rli[16];
#pragma unroll
            for (int r = 0; r < 16; ++r) rli[r] = 1.f / wsf[32 + crow(r, hi)];
            bf16* Ow = O + (tok0 + q0) * DM + head * HD;
            LAS bf16* stg = (LAS bf16*)(shm + LDS_OST) + wid * 2048;
#pragma unroll
            for (int r = 0; r < 16; ++r) { const int orow = crow(r, hi);
#pragma unroll
                for (int d0 = 0; d0 < 2; ++d0) stg[orow * 64 + d0 * 32 + r32] = (bf16)(cvt_pk_bf16(o[d0][r] * rli[r], 0.f) & 0xffffu); }
            LDS_WAIT();
#pragma unroll
            for (int i = 0; i < 4; ++i) { const int row = i * 8 + (lane >> 3), ch = lane & 7; const u32x4 v = *(const LAS u32x4*)(stg + row * 64 + ch * 8); *(u32x4*)(Ow + (size_t)row * DM + ch * 8) = v; }
        }
        if (t == 8) { t = 0; ++u; } else ++t;
    }
}
}

__device__ __forceinline__ float row16_sum(float v) {
    v += __builtin_bit_cast(float, __builtin_amdgcn_update_dpp(0, __builtin_bit_cast(int, v), 0xB1, 0xf, 0xf, true));
    v += __builtin_bit_cast(float, __builtin_amdgcn_update_dpp(0, __builtin_bit_cast(int, v), 0x4E, 0xf, 0xf, true));
    v += __builtin_bit_cast(float, __builtin_amdgcn_update_dpp(0, __builtin_bit_cast(int, v), 0x141, 0xf, 0xf, true));
    v += __builtin_bit_cast(float, __builtin_amdgcn_update_dpp(0, __builtin_bit_cast(int, v), 0x140, 0xf, 0xf, true));
    return v;
}
template <int NV> __device__ __forceinline__ void block_reduce(const float (&x)[NV], LAS float* red, LAS float* tot, int tid, int lane, int wave) {
    float y[NV / 2], z[NV / 4];
#pragma unroll
    for (int i = 0; i < NV / 2; ++i) { auto r = __builtin_amdgcn_permlane32_swap(__float_as_uint(x[i]), __float_as_uint(x[i + NV / 2]), false, false); y[i] = __uint_as_float(r[0]) + __uint_as_float(r[1]); }
#pragma unroll
    for (int i = 0; i < NV / 4; ++i) { auto r = __builtin_amdgcn_permlane16_swap(__float_as_uint(y[i]), __float_as_uint(y[i + NV / 4]), false, false); z[i] = row16_sum(__uint_as_float(r[0]) + __uint_as_float(r[1])); }
    if ((lane & 15) == 0) { const int q = lane >> 4;
#pragma unroll
        for (int i = 0; i < NV / 4; ++i) red[wave * NV + i + q * (NV / 4)] = z[i]; }
    __syncthreads();
    if (tid < NV) { float s = 0.f;
#pragma unroll
        for (int w = 0; w < NWAVES; ++w) s += red[w * NV + tid];
        tot[tid] = s; }
    __syncthreads();
}
struct LnLds { LAS float* red; LAS float* tot; LAS float* sab; LAS int* lcnt; LAS int* lbase; LAS int* lcls; LAS int* lrank; LAS float* lg; LAS float* rowtab; };
__device__ __forceinline__ LnLds ln_lds(const Frame& F) { LnLds L; L.red = (LAS float*)F.lds; L.tot = L.red + 8 * 72; L.sab = L.tot + 72; L.lcnt = (LAS int*)(L.sab + 32); L.lbase = L.lcnt + 32; L.lcls = L.lbase + 32; L.lrank = L.lcls + 256; L.lg = (LAS float*)(L.lrank + 256); L.rowtab = L.lg + 512; return L; }

template <bool HIN_F32> __device__ __forceinline__ void ln1_router_phase(const Frame& F, int layer, const void* hin_, const bf16* ymix, bf16* u2out, bf16* hout) {
    const float* hin = (const float*)hin_; const bf16* hinb = (const bf16*)hin_;
    const LnLds L = ln_lds(F);
    const int tid = F.tid, lane = F.lane, wave = F.wave, c0 = 4 * tid;
    int per = (MTOK + F.G - 1) / F.G; per = (per + 3) & ~3;
    const int rbase = F.bid * per; const int rend = (rbase + per < MTOK) ? rbase + per : MTOK; const int nrows = rend - rbase;
    if (tid < NCLS) L.lcnt[tid] = 0;
    if (nrows > 0 && nrows <= 256) {
    const int b = rbase / SEQ;
    const f32x4 g1 = *(const f32x4*)(mod_ptr(F, layer, b, 2) + c0), sh2 = *(const f32x4*)(mod_ptr(F, layer, b, 3) + c0), sc2 = *(const f32x4*)(mod_ptr(F, layer, b, 4) + c0);
    const f32x4 A0 = *(const f32x4*)(AIN(I_LN1G) + layer * DM + c0), B0 = *(const f32x4*)(AIN(I_LN1B) + layer * DM + c0);
    const f32x4 A1 = A0 * (sc2 + 1.f), B1 = B0 * (sc2 + 1.f) + sh2;
    f32x4 P[4][4];
    { float sx[32];
#pragma unroll
      for (int c = 0; c < 4; ++c)
#pragma unroll
          for (int g = 0; g < 4; ++g) { const f32x4 w = *(const f32x4*)(AIN(I_RW) + (size_t)(c0 + c) * NEXP + 4 * g); P[c][g] = w * A1[c];
#pragma unroll
              for (int i = 0; i < 4; ++i) { if (c == 0) { sx[g * 4 + i] = 0.f; sx[16 + g * 4 + i] = 0.f; } sx[g * 4 + i] += w[i] * A1[c]; sx[16 + g * 4 + i] += w[i] * B1[c]; } }
      block_reduce<32>(sx, L.red, L.tot, tid, lane, wave);
      if (tid < 32) L.sab[tid] = L.tot[tid];
      __syncthreads(); }
    const float* rb = AIN(I_RB);
    f32x4 hv[4], hv2[4]; u32x2 yv[4], yv2[4];
#define LN_LOADH(dst, o) do { if (HIN_F32) dst = *(const f32x4*)(hin + (o)); else { const u32x2 hw_ = *(const u32x2*)(hinb + (o)); dst = (f32x4){bflo(hw_.x), bfhi(hw_.x), bflo(hw_.y), bfhi(hw_.y)}; } } while (0)
#pragma unroll
    for (int r = 0; r < 4; ++r) { const size_t o = (size_t)(rbase + r) * DM + c0; LN_LOADH(hv[r], o); yv[r] = *(const u32x2*)(ymix + o); }
    if (rbase + 4 < rend) {
#pragma unroll
        for (int r = 0; r < 4; ++r) { const size_t o = (size_t)(rbase + 4 + r) * DM + c0; LN_LOADH(hv2[r], o); yv2[r] = *(const u32x2*)(ymix + o); } }
    for (int row0 = rbase; row0 < rend; row0 += 4) {
        f32x4 v[4]; float x[72];
#pragma unroll
        for (int r = 0; r < 4; ++r) { const f32x4 y = {bflo(yv[r].x), bfhi(yv[r].x), bflo(yv[r].y), bfhi(yv[r].y)}; v[r] = hv[r] * DN_ALPHA + g1 * y;
            x[r * 18] = (v[r][0] + v[r][1]) + (v[r][2] + v[r][3]); x[r * 18 + 1] = (v[r][0] * v[r][0] + v[r][1] * v[r][1]) + (v[r][2] * v[r][2] + v[r][3] * v[r][3]);
#pragma unroll
            for (int g = 0; g < 4; ++g) { const f32x4 q = P[0][g] * v[r][0] + P[1][g] * v[r][1] + P[2][g] * v[r][2] + P[3][g] * v[r][3];
                x[r * 18 + 2 + 4 * g] = q[0]; x[r * 18 + 3 + 4 * g] = q[1]; x[r * 18 + 4 + 4 * g] = q[2]; x[r * 18 + 5 + 4 * g] = q[3]; } }
#pragma unroll
        for (int r = 0; r < 4; ++r) { hv[r] = hv2[r]; yv[r] = yv2[r]; }
        if (row0 + 8 < rend) {
#pragma unroll
            for (int r = 0; r < 4; ++r) { const size_t o = (size_t)(row0 + 8 + r) * DM + c0; LN_LOADH(hv2[r], o); yv2[r] = *(const u32x2*)(ymix + o); } }
        LAS float* gt = L.rowtab + ((row0 - rbase) >> 2) * 72;
        block_reduce<72>(x, L.red, gt, tid, lane, wave);
#pragma unroll
        for (int r = 0; r < 4; ++r) { const float mean = gt[r * 18] * (1.f / DM); const float var = gt[r * 18 + 1] * (1.f / DM) - mean * mean; const float rstd = 1.f / sqrtf(var + LN_EPS);
            const f32x4 vn = (v[r] - mean) * rstd; const f32x4 hn = vn * A0 + B0, u = vn * A1 + B1; const size_t o = (size_t)(row0 + r) * DM + c0;
            u32x2 hw; hw.x = cvt_pk_bf16(hn[0], hn[1]); hw.y = cvt_pk_bf16(hn[2], hn[3]); *(u32x2*)(hout + o) = hw; u32x2 w; w.x = cvt_pk_bf16(u[0], u[1]); w.y = cvt_pk_bf16(u[2], u[3]); *(u32x2*)(u2out + o) = w; }
    }
    __syncthreads();
    if (tid < nrows) {
            const int rl = tid; const LAS float* gt = L.rowtab + (rl >> 2) * 72 + (rl & 3) * 18;
            const float mean = gt[0] * (1.f / DM); const float var = gt[1] * (1.f / DM) - mean * mean; const float rstd = 1.f / sqrtf(var + LN_EPS);
            float sg[16], sel[16];
#pragma unroll
            for (int e = 0; e < 16; ++e) { const float lgt = rstd * (gt[2 + e] - mean * L.sab[e]) + L.sab[16 + e]; const float sv = 1.f / (1.f + expf(-lgt)); sg[e] = sv; sel[e] = sv + rb[e]; }
            int gb = 0; float gbs = -INFINITY;
#pragma unroll
            for (int g = 0; g < 4; ++g) { const float a = sel[4 * g], bq = sel[4 * g + 1], c = sel[4 * g + 2], d = sel[4 * g + 3];
                const float ps = fmaxf(fmaxf(fmaxf(a + bq, a + c), fmaxf(a + d, bq + c)), fmaxf(bq + d, c + d)); if (ps > gbs) { gbs = ps; gb = g; } }
            float cs[4], cg[4];
#pragma unroll
            for (int i = 0; i < 4; ++i) { cs[i] = sel[i]; cg[i] = sg[i];
#pragma unroll
                for (int g = 1; g < 4; ++g) if (gb == g) { cs[i] = sel[4 * g + i]; cg[i] = sg[4 * g + i]; } }
            int i0 = 0; float b0 = cs[0];
#pragma unroll
            for (int i = 1; i < 4; ++i) if (cs[i] > b0) { b0 = cs[i]; i0 = i; }
            int i1 = -1; float b1 = -INFINITY;
#pragma unroll
            for (int i = 0; i < 4; ++i) if (i != i0 && cs[i] > b1) { b1 = cs[i]; i1 = i; }
            float ga = 0.f, gbv = 0.f;
#pragma unroll
            for (int i = 0; i < 4; ++i) { if (i == i0) ga = cg[i]; if (i == i1) gbv = cg[i]; }
            const float den = ga + gbv; ga /= den; gbv /= den;
            const int lo = i0 < i1 ? i0 : i1, hi = i0 < i1 ? i1 : i0; const float glo = i0 < i1 ? ga : gbv, ghi = i0 < i1 ? gbv : ga;
            const int pidx = (lo == 0) ? (hi - 1) : (lo == 1 ? hi + 1 : 5);
            const int cls = gb * 6 + pidx;
            L.lcls[rl] = cls; L.lrank[rl] = __hip_atomic_fetch_add(&L.lcnt[cls], 1, __ATOMIC_RELAXED, __HIP_MEMORY_SCOPE_WORKGROUP); L.lg[2 * rl] = glo; L.lg[2 * rl + 1] = ghi;
    }
    }
    __syncthreads();
    if (tid < NCLS) L.lbase[tid] = (int)__hip_atomic_fetch_add((unsigned*)(F.ctl + CW_CNT + (layer * NCLS + tid) * 64), (unsigned)L.lcnt[tid], RLX_AGENT);
    __syncthreads();
    if (tid < nrows && nrows <= 256) { const int cls = L.lcls[tid]; const int pos = cls * LCAP + L.lbase[cls] + L.lrank[tid];
        ((int*)(F.ws + WS_TOK))[pos] = rbase + tid; ((float*)(F.ws + WS_GATE))[pos] = L.lg[2 * tid]; ((float*)(F.ws + WS_GATE))[(size_t)NCLS * LCAP + pos] = L.lg[2 * tid + 1]; }
}
#undef LN_LOADH
template <bool OUT_F32> __device__ __forceinline__ void ln2_phase(const Frame& F, int layer, bf16* fio, const bf16* hinb, void* hout_) {
    float* houtf = (float*)hout_; bf16* houtb = (bf16*)hout_;
    const LnLds L = ln_lds(F);
    const int tid = F.tid, lane = F.lane, wave = F.wave, c0 = 4 * tid;
    int per = (MTOK + F.G - 1) / F.G; per = (per + 3) & ~3;
    const int rbase = F.bid * per; const int rend = (rbase + per < MTOK) ? rbase + per : MTOK;
    if (rbase >= rend) return;
    const int b = rbase / SEQ;
    const f32x4 g2 = *(const f32x4*)(mod_ptr(F, layer, b, 5) + c0), sh1 = *(const f32x4*)(mod_ptr(F, 1, b, 0) + c0), sc1 = *(const f32x4*)(mod_ptr(F, 1, b, 1) + c0);
    const f32x4 A0 = *(const f32x4*)(AIN(I_LN2G) + layer * DM + c0), B0 = *(const f32x4*)(AIN(I_LN2B) + layer * DM + c0);
    const f32x4 A1 = A0 * (sc1 + 1.f), B1 = B0 * (sc1 + 1.f) + sh1;
    u32x2 hw[4], hw2[4], hw3[4]; u32x2 yv[4], yv2[4], yv3[4];
#pragma unroll
    for (int r = 0; r < 4; ++r) { const size_t o = (size_t)(rbase + r) * DM + c0; hw[r] = *(const u32x2*)(hinb + o); yv[r] = *(const u32x2*)(fio + o); }
#pragma unroll
    for (int r = 0; r < 4; ++r) { const size_t o = (size_t)(rbase + 4 + r) * DM + c0; if (rbase + 4 < rend) { hw2[r] = *(const u32x2*)(hinb + o); yv2[r] = *(const u32x2*)(fio + o); } }
#pragma unroll
    for (int r = 0; r < 4; ++r) { const size_t o = (size_t)(rbase + 8 + r) * DM + c0; if (rbase + 8 < rend) { hw3[r] = *(const u32x2*)(hinb + o); yv3[r] = *(const u32x2*)(fio + o); } }
    for (int row0 = rbase; row0 < rend; row0 += 4) {
        f32x4 v[4]; float x[8];
#pragma unroll
        for (int r = 0; r < 4; ++r) { const f32x4 y = {bflo(yv[r].x), bfhi(yv[r].x), bflo(yv[r].y), bfhi(yv[r].y)}; const f32x4 hvr = {bflo(hw[r].x), bfhi(hw[r].x), bflo(hw[r].y), bfhi(hw[r].y)}; v[r] = hvr * DN_ALPHA + g2 * y;
            x[r * 2] = (v[r][0] + v[r][1]) + (v[r][2] + v[r][3]); x[r * 2 + 1] = (v[r][0] * v[r][0] + v[r][1] * v[r][1]) + (v[r][2] * v[r][2] + v[r][3] * v[r][3]); }
#pragma unroll
        for (int r = 0; r < 4; ++r) { hw[r] = hw2[r]; yv[r] = yv2[r]; hw2[r] = hw3[r]; yv2[r] = yv3[r]; }
        if (row0 + 12 < rend) {
#pragma unroll
            for (int r = 0; r < 4; ++r) { const size_t o = (size_t)(row0 + 12 + r) * DM + c0; hw3[r] = *(const u32x2*)(hinb + o); yv3[r] = *(const u32x2*)(fio + o); } }
        block_reduce<8>(x, L.red, L.tot, tid, lane, wave);
#pragma unroll
        for (int r = 0; r < 4; ++r) { const float mean = L.tot[r * 2] * (1.f / DM); const float var = L.tot[r * 2 + 1] * (1.f / DM) - mean * mean; const float rstd = 1.f / sqrtf(var + LN_EPS);
            const f32x4 vn = (v[r] - mean) * rstd; const f32x4 hn = vn * A0 + B0; const size_t o = (size_t)(row0 + r) * DM + c0;
            if (OUT_F32) *(f32x4*)(houtf + o) = hn; else { u32x2 hw; hw.x = cvt_pk_bf16(hn[0], hn[1]); hw.y = cvt_pk_bf16(hn[2], hn[3]); *(u32x2*)(houtb + o) = hw; }
            if (layer == 0) { const f32x4 u = vn * A1 + B1; u32x2 w; w.x = cvt_pk_bf16(u[0], u[1]); w.y = cvt_pk_bf16(u[2], u[3]); *(u32x2*)(fio + o) = w; } }
    }
}
namespace hy {
constexpr int L = SEQ;
__device__ constexpr float C32[16] = {1.000000000e+00f, 9.807852804e-01f, 9.238795325e-01f, 8.314696123e-01f, 7.071067812e-01f, 5.555702330e-01f, 3.826834324e-01f, 1.950903220e-01f,
                                      0.f, -1.950903220e-01f, -3.826834324e-01f, -5.555702330e-01f, -7.071067812e-01f, -8.314696123e-01f, -9.238795325e-01f, -9.807852804e-01f};
__device__ constexpr float S32[16] = {0.f, 1.950903220e-01f, 3.826834324e-01f, 5.555702330e-01f, 7.071067812e-01f, 8.314696123e-01f, 9.238795325e-01f, 9.807852804e-01f,
                                      1.f, 9.807852804e-01f, 9.238795325e-01f, 8.314696123e-01f, 7.071067812e-01f, 5.555702330e-01f, 3.826834324e-01f, 1.950903220e-01f};
__host__ __device__ constexpr int brev(int k, int bits) { int r = 0; for (int i = 0; i < bits; ++i) r |= ((k >> i) & 1) << (bits - 1 - i); return r; }
__device__ __forceinline__ void unit_root(float frac, bool inv, float& wr, float& wi) {
    wr = __builtin_amdgcn_cosf(frac); float s = __builtin_amdgcn_sinf(frac);
    asm volatile("s_nop 1" : "+v"(wr), "+v"(s));
    wi = inv ? s : -s;
}
constexpr int FT_F32 = 0, FT_I32 = 8, FT_I32P = 16, FT_F16 = 24, FT_I16 = 26, FT_NFRAG = 28;
__device__ __forceinline__ int crow(int r, int h) { return (r & 3) + 8 * (r >> 2) + 4 * h; }
__device__ __forceinline__ bf16x8 pack8(const float (&v)[8]) { u32x4 w; w.x = cvt_pk_bf16(v[0], v[1]); w.y = cvt_pk_bf16(v[2], v[3]); w.z = cvt_pk_bf16(v[4], v[5]); w.w = cvt_pk_bf16(v[6], v[7]); return __builtin_bit_cast(bf16x8, w); }
__device__ __forceinline__ void cmul(float& xr, float& xi, float wr, float wi) {
    float t0, t1, nr, ni;
    asm("v_mul_f32_e32 %0, %1, %2" : "=v"(t0) : "v"(xi), "v"(wi));
    asm("v_mul_f32_e32 %0, %1, %2" : "=v"(t1) : "v"(xi), "v"(wr));
    asm("v_fma_f32 %0, %1, %2, -%3" : "=v"(nr) : "v"(xr), "v"(wr), "v"(t0));
    asm("v_fma_f32 %0, %1, %2, %3" : "=v"(ni) : "v"(xr), "v"(wi), "v"(t1));
    xr = nr; xi = ni;
}
#define FRAG(f) (tab[(f) * 64 + lane])
template <bool INV> __device__ __forceinline__ void pass1(LAS f32x2* dat, const LAS bf16x8* tab, int lane, int wave) {
    asm volatile("" : "+v"(lane));
    const int h = lane >> 5, c5 = lane & 31;
    const bf16x8 a0 = FRAG((INV ? FT_I16 : FT_F16) + 0), a1 = FRAG((INV ? FT_I16 : FT_F16) + 1);
#pragma unroll 1
    for (int g = 0; g < 4; ++g) {
        const int col = 128 * wave + 32 * g + c5; const int pc = col ^ ((4 * wave + g) & 31) ^ ((2 * g + (c5 >> 4)) & 7);
        float wr, wi; unit_root((float)col * (1.f / 16384.f), INV, wr, wi);
        float w2r = wr, w2i = wi; cmul(w2r, w2i, wr, wi); float w4r = w2r, w4i = w2i; cmul(w4r, w4i, w2r, w2i); float w8r = w4r, w8i = w4i; cmul(w8r, w8i, w4r, w4i);
        float re[8], im[8];
#pragma unroll
        for (int jj = 0; jj < 8; ++jj) { const f32x2 v = dat[pc + 1024 * (8 * h + jj)]; re[jj] = v.x; im[jj] = v.y; }
        if (INV) {
            float cr = h ? w8r : 1.f, ci = h ? w8i : 0.f;
#pragma unroll
            for (int jj = 0; jj < 8; ++jj) { cmul(re[jj], im[jj], cr, ci); cmul(cr, ci, wr, wi); }
        }
        const f32x16 z = {};
        f32x16 d = __builtin_amdgcn_mfma_f32_32x32x16_bf16(a0, pack8(re), z, 0, 0, 0);
        d = __builtin_amdgcn_mfma_f32_32x32x16_bf16(a1, pack8(im), d, 0, 0, 0);
        asm volatile("s_nop 15\n\ts_nop 7" : "+v"(d));
        float cr = h ? w4r : 1.f, ci = h ? w4i : 0.f;
#pragma unroll
        for (int rr = 0; rr < 8; ++rr) { float xr = d[rr], xi = d[rr + 8];
            if (!INV) { if (rr == 4) { cr = h ? w4r : 1.f; ci = h ? w4i : 0.f; cmul(cr, ci, w8r, w8i); } cmul(xr, xi, cr, ci); cmul(cr, ci, wr, wi); }
            f32x2 o; o.x = xr; o.y = xi; dat[pc + 1024 * ((rr & 3) + 8 * (rr >> 2) + 4 * h)] = o; }
    }
}
template <bool INV> __device__ __forceinline__ void pass2(LAS f32x2* dat, const LAS bf16x8* tab, int lane, int wave) {
    asm volatile("" : "+v"(lane));
    const int h = lane >> 5, b = lane & 31, bp = b ^ (b >> 4);
    float wr, wi; unit_root((float)b * (1.f / 1024.f), INV, wr, wi);
    float w2r = wr, w2i = wi; cmul(w2r, w2i, wr, wi); float w4r = w2r, w4i = w2i; cmul(w4r, w4i, w2r, w2i); float w8r = w4r, w8i = w4i; cmul(w8r, w8i, w4r, w4i); float w16r = w8r, w16i = w8i; cmul(w16r, w16i, w8r, w8i);
#pragma unroll 1
    for (int g = 0; g < 2; ++g) {
        const int base = (2 * wave + g) * 1024;
        float re[2][8], im[2][8];
#pragma unroll
        for (int hf = 0; hf < 2; ++hf)
#pragma unroll
            for (int jj = 0; jj < 8; ++jj) { const int n = 16 * hf + 8 * h + jj; const f32x2 v = dat[base + 32 * n + (bp ^ (16 * hf + 8 * h + (jj ^ ((2 * jj) & 7))))]; re[hf][jj] = v.x; im[hf][jj] = v.y; }
        if (INV) {
            float cr = h ? w8r : 1.f, ci = h ? w8i : 0.f;
#pragma unroll
            for (int jj = 0; jj < 8; ++jj) { cmul(re[0][jj], im[0][jj], cr, ci); float dr = cr, di = ci; cmul(dr, di, w16r, w16i); cmul(re[1][jj], im[1][jj], dr, di); cmul(cr, ci, wr, wi); }
        }
        const bf16x8 b0 = pack8(re[0]), b1 = pack8(re[1]), b2 = pack8(im[0]), b3 = pack8(im[1]);
        const int fb = INV ? FT_I32 : FT_F32; const f32x16 z = {};
        f32x16 dre = __builtin_amdgcn_mfma_f32_32x32x16_bf16(FRAG(fb + 0), b0, z, 0, 0, 0); f32x16 dim = __builtin_amdgcn_mfma_f32_32x32x16_bf16(FRAG(fb + 4), b0, z, 0, 0, 0);
        dre = __builtin_amdgcn_mfma_f32_32x32x16_bf16(FRAG(fb + 1), b1, dre, 0, 0, 0); dim = __builtin_amdgcn_mfma_f32_32x32x16_bf16(FRAG(fb + 5), b1, dim, 0, 0, 0);
        dre = __builtin_amdgcn_mfma_f32_32x32x16_bf16(FRAG(fb + 2), b2, dre, 0, 0, 0); dim = __builtin_amdgcn_mfma_f32_32x32x16_bf16(FRAG(fb + 6), b2, dim, 0, 0, 0);
        dre = __builtin_amdgcn_mfma_f32_32x32x16_bf16(FRAG(fb + 3), b3, dre, 0, 0, 0); dim = __builtin_amdgcn_mfma_f32_32x32x16_bf16(FRAG(fb + 7), b3, dim, 0, 0, 0);
        asm volatile("s_nop 15\n\ts_nop 7" : "+v"(dre), "+v"(dim));
        float gr = h ? w4r : 1.f, gi = h ? w4i : 0.f;
#pragma unroll
        for (int r = 0; r < 16; ++r) { float xr = dre[r], xi = dim[r]; const int kf = (r & 3) + 8 * (r >> 2) + 4 * h;
            if (!INV) { float cr = gr, ci = gi; if ((r & 3) == 1) cmul(cr, ci, wr, wi); if ((r & 3) == 2) cmul(cr, ci, w2r, w2i); if ((r & 3) == 3) { cmul(cr, ci, w2r, w2i); cmul(cr, ci, wr, wi); }
                cmul(xr, xi, cr, ci); if ((r & 3) == 3) cmul(gr, gi, w8r, w8i); }
            f32x2 o; o.x = xr; o.y = xi; dat[base + 32 * kf + (bp ^ kf ^ (2 * (r & 3)))] = o; }
    }
}
template <bool FILTER> __device__ __forceinline__ void pass3(LAS f32x2* dat, const LAS bf16x8* tab, int lane, int wave, const int g, f32x2* Kbuf, const f32x2 (&kpre)[16]) {
    asm volatile("" : "+v"(lane));
    const int h = lane >> 5, sw = lane & 31, swp = sw ^ (2 * (sw & 3));
    {
        const int q = 64 * wave + 32 * g + sw, base = 32 * q;
        float re[2][8], im[2][8];
#pragma unroll
        for (int hf = 0; hf < 2; ++hf)
#pragma unroll
            for (int jj = 0; jj < 8; ++jj) { const int n = 16 * hf + 8 * h + jj; const f32x2 v = dat[base + (n ^ swp ^ hf)]; re[hf][jj] = v.x; im[hf][jj] = v.y; }
        const bf16x8 b0 = pack8(re[0]), b1 = pack8(re[1]), b2 = pack8(im[0]), b3 = pack8(im[1]);
        const f32x16 z = {};
        f32x16 dre = __builtin_amdgcn_mfma_f32_32x32x16_bf16(FRAG(FT_F32 + 0), b0, z, 0, 0, 0); f32x16 dim = __builtin_amdgcn_mfma_f32_32x32x16_bf16(FRAG(FT_F32 + 4), b0, z, 0, 0, 0);
        dre = __builtin_amdgcn_mfma_f32_32x32x16_bf16(FRAG(FT_F32 + 1), b1, dre, 0, 0, 0); dim = __builtin_amdgcn_mfma_f32_32x32x16_bf16(FRAG(FT_F32 + 5), b1, dim, 0, 0, 0);
        dre = __builtin_amdgcn_mfma_f32_32x32x16_bf16(FRAG(FT_F32 + 2), b2, dre, 0, 0, 0); dim = __builtin_amdgcn_mfma_f32_32x32x16_bf16(FRAG(FT_F32 + 6), b2, dim, 0, 0, 0);
        dre = __builtin_amdgcn_mfma_f32_32x32x16_bf16(FRAG(FT_F32 + 3), b3, dre, 0, 0, 0); dim = __builtin_amdgcn_mfma_f32_32x32x16_bf16(FRAG(FT_F32 + 7), b3, dim, 0, 0, 0);
        asm volatile("s_nop 15\n\ts_nop 7" : "+v"(dre), "+v"(dim));
        if (FILTER) {
#pragma unroll
            for (int r = 0; r < 16; ++r) { f32x2 o; o.x = dre[r]; o.y = dim[r]; Kbuf[((r & 3) + 8 * (r >> 2) + 4 * h) * 512 + q] = o; }
        } else {
            float yr[16], yi[16];
#pragma unroll
            for (int r = 0; r < 16; ++r) { const f32x2 kv = kpre[r]; float a_ = dre[r], b_ = dim[r]; cmul(a_, b_, kv.x, kv.y); yr[r] = a_; yi[r] = b_; }
            float t0[8], t1[8], t2[8], t3[8];
#pragma unroll
            for (int j = 0; j < 8; ++j) { t0[j] = yr[j]; t1[j] = yr[8 + j]; t2[j] = yi[j]; t3[j] = yi[8 + j]; }
            const bf16x8 c0 = pack8(t0), c1 = pack8(t1), c2 = pack8(t2), c3 = pack8(t3);
            f32x16 ere = __builtin_amdgcn_mfma_f32_32x32x16_bf16(FRAG(FT_I32P + 0), c0, z, 0, 0, 0); f32x16 eim = __builtin_amdgcn_mfma_f32_32x32x16_bf16(FRAG(FT_I32P + 4), c0, z, 0, 0, 0);
            ere = __builtin_amdgcn_mfma_f32_32x32x16_bf16(FRAG(FT_I32P + 1), c1, ere, 0, 0, 0); eim = __builtin_amdgcn_mfma_f32_32x32x16_bf16(FRAG(FT_I32P + 5), c1, eim, 0, 0, 0);
            ere = __builtin_amdgcn_mfma_f32_32x32x16_bf16(FRAG(FT_I32P + 2), c2, ere, 0, 0, 0); eim = __builtin_amdgcn_mfma_f32_32x32x16_bf16(FRAG(FT_I32P + 6), c2, eim, 0, 0, 0);
            ere = __builtin_amdgcn_mfma_f32_32x32x16_bf16(FRAG(FT_I32P + 3), c3, ere, 0, 0, 0); eim = __builtin_amdgcn_mfma_f32_32x32x16_bf16(FRAG(FT_I32P + 7), c3, eim, 0, 0, 0);
#pragma unroll
            for (int r = 0; r < 16; ++r) { f32x2 o; o.x = ere[r]; o.y = eim[r]; dat[base + ((((r & 3) + 8 * (r >> 2) + 4 * h)) ^ swp ^ (r >> 3))] = o; }
        }
    }
}
#undef FRAG
__device__ __forceinline__ float ftab_value(int f, int l, int jj) {
    const int r = l & 31, h = l >> 5;
    if (f < 24) {
        const int kind = f >> 3, rb = (f >> 2) & 1, s = f & 3; int kk, pp;
        if (kind < 2) { kk = 16 * (s & 1) + 8 * h + jj; pp = s >> 1; } else { kk = 16 * (s & 1) + 8 * (jj >> 2) + 4 * h + (jj & 3); pp = s >> 1; }
        const float th = 6.283185307179586f * (float)((r * kk) & 31) * (1.f / 32.f); const float c = cosf(th), sn = sinf(th);
        if (kind == 0) return rb == 0 ? (pp == 0 ? c : sn) : (pp == 0 ? -sn : c);
        return rb == 0 ? (pp == 0 ? c : -sn) : (pp == 0 ? sn : c);
    }
    const int inv = (f - 24) >> 1, s = (f - 24) & 1; const int part = r >> 4, kf = r & 15, n = 8 * h + jj;
    const float th = 6.283185307179586f * (float)((kf * n) & 15) * (1.f / 16.f); const float c = cosf(th), sn = sinf(th);
    if (!inv) return part == 0 ? (s == 0 ? c : sn) : (s == 0 ? -sn : c);
    return part == 0 ? (s == 0 ? c : -sn) : (s == 0 ? sn : c);
}
__device__ __forceinline__ int phys(int p) { return p ^ ((p >> 5) & 31) ^ ((p >> 4) & 7); }
__device__ __forceinline__ void unpack8(const u32x4 v, float (&f)[8]) { f[0] = bflo(v.x); f[1] = bfhi(v.x); f[2] = bflo(v.y); f[3] = bfhi(v.y); f[4] = bflo(v.z); f[5] = bfhi(v.z); f[6] = bflo(v.w); f[7] = bfhi(v.w); }
struct Raw8 { u32x4 v; unsigned l, r; };
__device__ __forceinline__ Raw8 load_raw8(const bf16* rowp, int t0) { Raw8 q; q.v = *(const u32x4*)(rowp + t0); q.l = (t0 > 0) ? (unsigned)rowp[t0 - 1] : 0u; q.r = (t0 + 8 < L) ? (unsigned)rowp[t0 + 8] : 0u; return q; }
__device__ __forceinline__ void conv8(const Raw8& q, float w0, float w1, float w2, float cb, float (&o)[8]) {
    float f[8]; unpack8(q.v, f); const float left = bf2f(q.l), right = bf2f(q.r);
#pragma unroll
    for (int e = 0; e < 8; ++e) { const float a = (e == 0) ? left : f[e - 1], c = (e == 7) ? right : f[e + 1]; o[e] = w0 * a + w1 * f[e] + w2 * c + cb; }
}
typedef const LAS float* ChanPar;
struct RawZ { Raw8 x[2], v[2]; };
__device__ __forceinline__ RawZ load_rawz(const bf16* pT, int d, int t0) { RawZ q;
#pragma unroll
    for (int bt = 0; bt < 2; ++bt) { q.x[bt] = load_raw8(pT + (size_t)(DM + d) * MTOK + bt * L, t0); q.v[bt] = load_raw8(pT + (size_t)(2 * DM + d) * MTOK + bt * L, t0); }
    return q; }
__device__ __forceinline__ void z_from_raw(const RawZ& q, ChanPar P, float (&z0)[8], float (&z1)[8]) {
#pragma unroll
    for (int bt = 0; bt < 2; ++bt) { float a[8], v[8];
        conv8(q.x[bt], P[4], P[5], P[6], P[7], a); conv8(q.v[bt], P[8], P[9], P[10], P[11], v);
#pragma unroll
        for (int e = 0; e < 8; ++e) { if (bt == 0) z0[e] = a[e] * v[e]; else z1[e] = a[e] * v[e]; } }
}
struct RawF { u32x4 hf, hb; unsigned first; };
__device__ __forceinline__ RawF load_rawf(const bf16* HT, int d, int t0) { RawF q; q.hf = *(const u32x4*)(HT + (size_t)d * L + t0); q.hb = *(const u32x4*)(HT + (size_t)(DM + d) * L + (L - t0 - 8));
    q.first = (t0 > 0) ? (unsigned)HT[(size_t)(DM + d) * L + (L - t0)] : 0u; return q; }
__device__ __forceinline__ void filt8(const RawF& q, int t0, ChanPar P, float (&k)[8], float (&kl)[8], float& l1p) {
    float hf[8], hb[8]; unpack8(q.hf, hf); unpack8(q.hb, hb);
    float s = 0.f;
#pragma unroll
    for (int e = 0; e < 8; ++e) { const float dc = __builtin_amdgcn_exp2f(-(float)(t0 + e) * P[13]); k[e] = hf[e] * dc; s += fabsf(k[e]); }
    float hbd[8];
#pragma unroll
    for (int e = 0; e < 8; ++e) { const int m = L - t0 - 8 + e; const float dc = __builtin_amdgcn_exp2f(-(float)m * P[13]); hbd[e] = hb[e] * dc; if (m >= 1) s += fabsf(hbd[e]); }
    kl[0] = (t0 > 0) ? bf2f(q.first) * __builtin_amdgcn_exp2f(-(float)(L - t0) * P[13]) : 0.f;
#pragma unroll
    for (int e = 1; e < 8; ++e) kl[e] = hbd[8 - e];
#pragma unroll
    for (int e = 0; e < 8; ++e) { k[e] *= P[14]; kl[e] *= P[14]; }
    l1p = s;
}
__device__ __forceinline__ void hyena_phase(const Frame& F) {
    LAS f32x2* dat = (LAS f32x2*)F.lds; LAS float* redu = (LAS float*)(F.lds + RING_BYTES);
    const bf16* pT = (const bf16*)(F.ws + WS_B); const bf16* HT = (const bf16*)(F.ws + WS_HT); bf16* yT = (bf16*)(F.ws + WS_A);
    const LAS bf16x8* tab = (const LAS bf16x8*)(F.lds + FTAB_OFF);
    for (int i = F.tid; i < FT_NFRAG * 64; i += NTHR) ((LAS u32x4*)(F.lds + FTAB_OFF))[i] = ((const u32x4*)(F.ws + WS_FTAB))[i];
    __syncthreads();
    f32x2* Ke = (f32x2*)(F.ws + WS_FFTS) + (size_t)F.bid * 49152; f32x2* Ko = Ke + 16384; f32x2* SeB = Ke + 32768;
    RawF rf[4];
    { const int tq = fresh_tid(F.wave); if (F.bid < DM) {
#pragma unroll
        for (int sI = 0; sI < 4; ++sI) rf[sI] = load_rawf((const bf16*)(F.ws + WS_HT), F.bid, 8 * (tq + 512 * sI)); } }
    const int cv_gw = F.bid * NWAVES + F.wave, cv_ngw = F.G * NWAVES; int cv_it = cv_gw; constexpr int CV_NIT = 48 * 1024;
    for (int d = F.bid; d < DM; d += F.G) {
        int tid = fresh_tid(F.wave);
        TPS_START(1);
        LAS float* PW = (LAS float*)(F.lds + RING_BYTES + 64); ChanPar P = PW;
        __syncthreads();
        if (tid < 12) { const int i = tid & 3, pj = tid >> 2; PW[tid] = (i < 3) ? AIN(I_HCW)[i * 3 * DM + pj * DM + d] : AIN(I_HCB)[pj * DM + d]; }
        if (tid == 12) PW[12] = AIN(I_FBIAS)[d];
        if (tid == 13) { const float mind = -4.605170185988091f / 1.5f, maxd = -4.605170185988091f / 0.3f; const float delta = fabsf(mind + (maxd - mind) * ((float)d / (float)(DM - 1)));
            PW[13] = delta * (1.f / (float)(L - 1)) * 1.4426950408889634f; PW[14] = 1.f; }
        __syncthreads();
        TPS_STOP(1); TPS_START(2);
#pragma unroll 1
        for (int odd = 0; odd < 2; ++odd) {
            asm volatile("" : "+v"(tid));
            float l1s = 0.f;
#pragma unroll
            for (int sI = 0; sI < 4; ++sI) { const int t0 = 8 * (tid + 512 * sI); float k[8], kl[8], l1p; filt8(rf[sI], t0, P, k, kl, l1p); l1s += l1p;
#pragma unroll
                for (int e = 0; e < 8; ++e) { f32x2 o; if (!odd) { o.x = k[e] + kl[e]; o.y = 0.f; } else { const float a = k[e] - kl[e]; float wr, wi; unit_root((float)(t0 + e) * (1.f / 32768.f), false, wr, wi); o.x = a * wr; o.y = a * wi; }
                    dat[phys(t0 + e)] = o; } }
            if (!odd) { l1s = wave_sum(l1s); if (F.lane == 0) redu[F.wave] = l1s; }
            __syncthreads();
            if (!odd && tid == 0) { float tot = 0.f;
#pragma unroll
                for (int w = 0; w < NWAVES; ++w) tot += redu[w];
                PW[15] = 1.f / tot; }
            pass1<false>(dat, tab, F.lane, F.wave); __syncthreads(); pass2<false>(dat, tab, F.lane, F.wave); { f32x2 kdummy[16]; pass3<true>(dat, tab, F.lane, F.wave, 0, odd ? Ko : Ke, kdummy); asm volatile("" ::: "memory"); pass3<true>(dat, tab, F.lane, F.wave, 1, odd ? Ko : Ke, kdummy); } __syncthreads();
        }
        TPS_STOP(2); TPS_START(3);
        unsigned zp[4][8];
        const bool cvb3 = (cv_it + 2 * cv_ngw < CV_NIT);
        const ConvItem ia = moe_l1_item(F, cvb3 ? cv_it : 0), ib = moe_l1_item(F, cvb3 ? cv_it + cv_ngw : 0), ic = moe_l1_item(F, cvb3 ? cv_it + 2 * cv_ngw : 0);
#pragma unroll
        for (int odd = 0; odd < 2; ++odd) {
            asm volatile("" : "+v"(tid));
            TPS_START(6);
            if (!odd) {
                RawZ rz[4];
#pragma unroll
                for (int sI = 0; sI < 4; ++sI) rz[sI] = load_rawz(pT, d, 8 * (tid + 512 * sI));
#pragma unroll
                for (int sI = 0; sI < 4; ++sI) { const int t0 = 8 * (tid + 512 * sI); float z0[8], z1[8]; z_from_raw(rz[sI], P, z0, z1);
#pragma unroll
                    for (int e = 0; e < 8; ++e) { f32x2 o; o.x = z0[e]; o.y = z1[e]; zp[sI][e] = cvt_pk_bf16(z0[e], z1[e]); dat[phys(t0 + e)] = o; } }
            } else {
#pragma unroll
                for (int sI = 0; sI < 4; ++sI) { const int t0 = 8 * (tid + 512 * sI);
#pragma unroll
                    for (int e = 0; e < 8; ++e) { const float z0 = bflo(zp[sI][e]), z1 = bfhi(zp[sI][e]); float wr, wi; unit_root((float)(t0 + e) * (1.f / 32768.f), false, wr, wi);
                        f32x2 o; o.x = z0 * wr - z1 * wi; o.y = z0 * wi + z1 * wr; dat[phys(t0 + e)] = o; } }
            }
#ifdef FFT_EXTRA
#pragma unroll 1
            for (int xr = 0; xr < FFT_EXTRA; ++xr) { __syncthreads(); pass2<false>(dat, tab, F.lane, F.wave); __syncthreads(); pass2<true>(dat, tab, F.lane, F.wave); __syncthreads();
#pragma unroll 1
                for (int i = fresh_tid(F.wave); i < L; i += NTHR) { f32x2 v = dat[i]; v.x *= (1.f / 32.f); v.y *= (1.f / 32.f); dat[i] = v; } }
            tid = fresh_tid(F.wave);
#endif
            TPS_STOP(6); TPS_START(5);
            f32x2 kpre0[16], kpre1[16];
            asm volatile("" ::: "memory");
            { const f32x2* Kb = odd ? Ko : Ke; int ln_ = F.lane; asm volatile("" : "+v"(ln_)); const int lq = ln_ & 31, lh = ln_ >> 5; const float il1 = P[15], fb = P[12];
#pragma unroll
              for (int r = 0; r < 16; ++r) { f32x2 k0 = Kb[((r & 3) + 8 * (r >> 2) + 4 * lh) * 512 + 64 * F.wave + lq], k1 = Kb[((r & 3) + 8 * (r >> 2) + 4 * lh) * 512 + 64 * F.wave + 32 + lq];
                  k0.x = k0.x * il1 + fb; k0.y *= il1; k1.x = k1.x * il1 + fb; k1.y *= il1; kpre0[r] = k0; kpre1[r] = k1; } }
            __syncthreads(); pass1<false>(dat, tab, F.lane, F.wave); __syncthreads(); pass2<false>(dat, tab, F.lane, F.wave); pass3<false>(dat, tab, F.lane, F.wave, 0, nullptr, kpre0); asm volatile("" ::: "memory"); pass3<false>(dat, tab, F.lane, F.wave, 1, nullptr, kpre1);
            TPS_STOP(5); TPS_START(7);
            if (odd) { float ca[32], cb[32], cc[32]; const int cvln = fresh_tid(F.wave) & 63;
                conv_issue(ia, cvln, ca); conv_issue(ib, cvln, cb); conv_issue(ic, cvln, cc);
                pass2<true>(dat, tab, F.lane, F.wave); __syncthreads(); pass1<true>(dat, tab, F.lane, F.wave);
                if (cvb3) { conv_finish(ia, cvln, ca); conv_finish(ib, cvln, cb); conv_finish(ic, cvln, cc); cv_it += 3 * cv_ngw; }
                __syncthreads();
            } else { pass2<true>(dat, tab, F.lane, F.wave); __syncthreads(); pass1<true>(dat, tab, F.lane, F.wave); __syncthreads(); }
            TPS_STOP(7);
            if (!odd) {
                asm volatile("" : "+v"(tid));
#pragma unroll 1
                for (int sI = 0; sI < 4; ++sI)
#pragma unroll
                    for (int e = 0; e < 8; ++e) { const f32x2 v = dat[phys(8 * (tid + 512 * sI) + e)]; SeB[e * 2048 + tid + 512 * sI] = v; }
                __syncthreads();
            }
        }
        TPS_STOP(3); TPS_START(4);
        asm volatile("" : "+v"(tid));
        if (d + F.G < DM) {
#pragma unroll
            for (int sI = 0; sI < 4; ++sI) rf[sI] = load_rawf(HT, d + F.G, 8 * (tid + 512 * sI)); }
        { Raw8 rx0[4][2]; f32x2 se[4][8];
#pragma unroll
          for (int sI = 0; sI < 4; ++sI) {
#pragma unroll
              for (int bt = 0; bt < 2; ++bt) rx0[sI][bt] = load_raw8(pT + (size_t)d * MTOK + bt * L, 8 * (tid + 512 * sI));
#pragma unroll
              for (int e = 0; e < 8; ++e) se[sI][e] = SeB[e * 2048 + tid + 512 * sI]; }
#pragma unroll
          for (int sI = 0; sI < 4; ++sI) { const int t0 = 8 * (tid + 512 * sI);
              float o0[8], o1[8];
#pragma unroll
              for (int e = 0; e < 8; ++e) { const f32x2 so = dat[phys(t0 + e)]; float wr, wi; unit_root((float)(t0 + e) * (1.f / 32768.f), true, wr, wi);
                  o0[e] = (se[sI][e].x + so.x * wr - so.y * wi) * (1.f / 32768.f); o1[e] = (se[sI][e].y + so.x * wi + so.y * wr) * (1.f / 32768.f); }
#pragma unroll
              for (int bt = 0; bt < 2; ++bt) { float xc[8]; conv8(rx0[sI][bt], P[0], P[1], P[2], P[3], xc);
                  u32x4 w;
                  if (bt == 0) { w.x = cvt_pk_bf16(xc[0] * o0[0], xc[1] * o0[1]); w.y = cvt_pk_bf16(xc[2] * o0[2], xc[3] * o0[3]); w.z = cvt_pk_bf16(xc[4] * o0[4], xc[5] * o0[5]); w.w = cvt_pk_bf16(xc[6] * o0[6], xc[7] * o0[7]); }
                  else { w.x = cvt_pk_bf16(xc[0] * o1[0], xc[1] * o1[1]); w.y = cvt_pk_bf16(xc[2] * o1[2], xc[3] * o1[3]); w.z = cvt_pk_bf16(xc[4] * o1[4], xc[5] * o1[5]); w.w = cvt_pk_bf16(xc[6] * o1[6], xc[7] * o1[7]); }
                  *(u32x4*)(yT + (size_t)d * MTOK + bt * L + t0) = w; } } }
        __syncthreads();
        TPS_STOP(4);
        if (cvb3) {
        } else {
#pragma unroll 1
            for (int q = 0; q < 3; ++q) { if (cv_it < CV_NIT) { float cva[32]; const ConvItem cvc = moe_l1_item(F, cv_it); conv_issue(cvc, fresh_tid(F.wave) & 63, cva); conv_finish(cvc, fresh_tid(F.wave) & 63, cva); cv_it += cv_ngw; } }
        }
    }
    while (cv_it < CV_NIT) { float cvb[32]; const ConvItem c = moe_l1_item(F, cv_it); conv_issue(c, F.lane, cvb); conv_finish(c, F.lane, cvb); cv_it += cv_ngw; }
}
__device__ __forceinline__ void transpose_phase(const Frame& F) {
    const bf16* yT = (const bf16*)(F.ws + WS_A); bf16* y = (bf16*)(F.ws + WS_B);
    LAS bf16* tl = (LAS bf16*)(F.lds + F.wave * 16384);
    const int gw = F.bid * NWAVES + F.wave, NGW = F.G * NWAVES, lane = F.lane;
    for (int tile = gw; tile < 32 * 512; tile += NGW) { const int d0 = (tile & 31) * 64, t0 = (tile >> 5) * 64;
#pragma unroll
        for (int i = 0; i < 8; ++i) { const int r = i * 8 + (lane >> 3), ch = lane & 7; const u32x4 v = *(const u32x4*)(yT + (size_t)(d0 + r) * MTOK + t0 + ch * 8); *(LAS u32x4*)(tl + r * 72 + ch * 8) = v; }
        LDS_WAIT();
#pragma unroll
        for (int i = 0; i < 8; ++i) { const int tr = i * 8 + (lane >> 3), ch = lane & 7; unsigned short e[8];
#pragma unroll
            for (int k = 0; k < 8; ++k) e[k] = tl[(ch * 8 + k) * 72 + tr];
            u32x4 w; w.x = e[0] | ((unsigned)e[1] << 16); w.y = e[2] | ((unsigned)e[3] << 16); w.z = e[4] | ((unsigned)e[5] << 16); w.w = e[6] | ((unsigned)e[7] << 16);
            *(u32x4*)(y + (size_t)(t0 + tr) * DM + d0 + ch * 8) = w; }
        LDS_WAIT();
    }
}
}
__device__ __forceinline__ float hy_ftab_value(int f, int l, int jj) { return hy::ftab_value(f, l, jj); }
constexpr int NPHASE = 19;

__device__ __forceinline__ void moe_table(const Frame& F, int layer, LAS int* tab) {
    if (F.tid < NCLS) tab[32 + F.tid] = (int)__hip_atomic_load((unsigned*)(F.ctl + CW_CNT + (layer * NCLS + F.tid) * 64), RLX_AGENT);
    __syncthreads();
    if (F.tid == 0) { int a = 0; for (int c = 0; c < NCLS; ++c) { tab[c] = a; a += (tab[32 + c] + 255) >> 8; } tab[24] = a; }
    __syncthreads();
}

#ifndef PROBE_MASK
#define PROBE_MASK 0u
#endif
#ifndef TPM
#define TPM 0u
#endif
#define TP_MULT 4
#define IN(k) ((ONLY < 0 || (k) == ONLY) && lo <= (k) && (k) < hi)
#define SEAM(k) do { if ((k) + 1 < hi) { XcdBarrier b_ = bar; asm volatile("" : "+s"(b_.bar), "+s"(b_.x)); xcd_barrier(b_); } if (TPM != 0u && ONLY < 0 && ((TPM >> (k)) & 1u) && F.bid == 0 && F.tid == 0) TPW[0] += __builtin_amdgcn_s_memrealtime() - TPW[1]; if (PROBE_MASK != 0u && ONLY < 0) { if (F.tid == 0) { LAS unsigned long long* tp_ = (LAS unsigned long long*)(F.lds + MISC_OFF + 64); const unsigned long long t1_ = __builtin_amdgcn_s_memrealtime(); if ((PROBE_MASK >> (k)) & 1u) tp_[0] += t1_ - tp_[1]; tp_[1] = t1_; } } } while (0)
#define TPW ((LAS unsigned long long*)(F.lds + MISC_OFF + 96))
#define ENTER() do { int l_; asm volatile("v_mbcnt_lo_u32_b32 %0, -1, 0\n\tv_mbcnt_hi_u32_b32 %0, -1, %0" : "=&v"(l_)); const int t_ = F.wave * 64 + l_; F.tid = t_; F.lane = l_; int b_ = blockIdx.x, g_ = gridDim.x; asm volatile("" : "+s"(b_), "+s"(g_)); F.bid = b_; F.G = g_; if (TPM != 0u && ONLY < 0 && b_ == 0 && t_ == 0) TPW[1] = __builtin_amdgcn_s_memrealtime(); } while (0)
template <int ONLY> __device__ __forceinline__ void layer_phases(Frame& F, const XcdBarrier& bar, const int lo, const int hi, const int layer, LAS int* tab) {
        const int pb = 3 + 8 * layer;
        if (layer == 0) {
            if (IN(pb + 0)) { ENTER();
                pg::PlainSched S; S.init(F.ws + WS_A, F.ws + WS_WQKV, MTOK, QKVD, DM, DM, F.G, F.bid);
                pg::EpiQKV E{(bf16*)(F.ws + WS_B), (bf16*)(F.ws + WS_B + 128 * MiB), (bf16*)(F.ws + WS_B + 144 * MiB), AIN(I_ABIN), (const float*)(F.ws + WS_ROPE), (const float*)(F.ws + WS_ROPE) + 4096};
                pg::gemm_phase<pg::EpiQKV, pg::PlainSched, false, false, true>(F.lds, F.tid, DM, DM, DM, S, E);
                SEAM(pb + 0);
            }
            if (IN(pb + 1)) { ENTER(); att::attn_phase(F); SEAM(pb + 1); }
        } else {
            if (IN(pb + 0)) { ENTER();
                pg::PlainSched S; S.init(F.ws + WS_WHYIN, F.ws + WS_A, 3 * DM, MTOK, DM, DM, F.G, F.bid);
                pg::EpiBf16<true> E{(bf16*)(F.ws + WS_B), MTOK, AIN(I_HBIN)};
                pg::gemm_phase<pg::EpiBf16<true>, pg::PlainSched, false, false, true>(F.lds, F.tid, DM, DM, DM, S, E);
                SEAM(pb + 0);
            }
            if (IN(pb + 1)) { ENTER(); hy::hyena_phase(F); SEAM(pb + 1); }
            if (IN(pb + 2)) { ENTER(); hy::transpose_phase(F); SEAM(pb + 2); }
        }
        if (IN(pb + 3)) { ENTER();
            const void* A = layer ? (const void*)(F.ws + WS_B) : (const void*)(F.ws + WS_A);
            const void* Bt = layer ? (const void*)(F.ws + WS_WHYO) : (const void*)(F.ws + WS_WO0);
            bf16* O = (bf16*)(F.ws + WS_B + (layer ? 128 : 192) * MiB);
            pg::PlainSched S; S.init(A, Bt, MTOK, DM, DM, DM, F.G, F.bid);
            pg::EpiBf16<false> E{O, DM, layer ? AIN(I_HBOUT) : nullptr};
            pg::gemm_phase<pg::EpiBf16<false>, pg::PlainSched, false, false, true>(F.lds, F.tid, DM, DM, DM, S, E);
            SEAM(pb + 3);
        }
        if (IN(pb + 4)) { ENTER();
            if (layer == 0) ln1_router_phase<true>(F, 0, AIN(I_X), (const bf16*)(F.ws + WS_B + 192 * MiB), (bf16*)(F.ws + WS_A), (bf16*)(F.ws + WS_B + 192 * MiB));
            else ln1_router_phase<false>(F, 1, F.out, (const bf16*)(F.ws + WS_B + 128 * MiB), (bf16*)(F.ws + WS_A), (bf16*)(F.ws + WS_B + 256 * MiB));
            SEAM(pb + 4);
        }
        if (IN(pb + 5)) { ENTER();
            moe_table(F, layer, tab);
            pg::MoeSched S{tab, (const char*)(F.ws + WS_A), (const char*)(F.ws + WS_W13 + (size_t)layer * 128 * MiB), (const int*)(F.ws + WS_TOK), F.G, F.bid, 16, 0};
            pg::EpiMoe1 E{(bf16*)(F.ws + WS_B), (const float*)(F.ws + WS_GATE)};
            pg::gemm_phase<pg::EpiMoe1, pg::MoeSched, true, false, true>(F.lds, F.tid, DM, DM, DM, S, E);
            SEAM(pb + 5);
        }
        if (IN(pb + 6)) { ENTER();
            moe_table(F, layer, tab);
            pg::MoeSched S{tab, (const char*)(F.ws + WS_B), (const char*)(F.ws + WS_W2 + (size_t)layer * 64 * MiB), (const int*)(F.ws + WS_TOK), F.G, F.bid, 8, 1};
            pg::EpiMoe2 E{(bf16*)(F.ws + WS_A), (const int*)(F.ws + WS_TOK)};
            pg::gemm_phase<pg::EpiMoe2, pg::MoeSched, false, true, true>(F.lds, F.tid, DM, DM, EFF, S, E);
            SEAM(pb + 6);
        }
        if (IN(pb + 7)) { ENTER();
            if (layer == 0) ln2_phase<false>(F, 0, (bf16*)(F.ws + WS_A), (const bf16*)(F.ws + WS_B + 192 * MiB), F.out);
            else ln2_phase<true>(F, 1, (bf16*)(F.ws + WS_A), (const bf16*)(F.ws + WS_B + 256 * MiB), F.out);
            SEAM(pb + 7); }
}
template <int ONLY> __global__ void __launch_bounds__(NTHR, 2) fwd_kernel(Args args) {
    extern __shared__ __attribute__((aligned(16))) unsigned char lds_raw[];
    Frame F;
    F.lds = (LAS unsigned char*)lds_raw;
    F.tid = threadIdx.x; F.lane = F.tid & 63; F.wave = __builtin_amdgcn_readfirstlane(F.tid >> 6);
    F.G = gridDim.x; F.bid = blockIdx.x; F.ws = args.ws; F.ctl = (gu32*)(args.ws + WS_CTL); F.out = args.out;
    F.a = &args;
    for (int u = F.tid; u < (LDS_BYTES - RING_BYTES) / 4; u += NTHR) ((LAS unsigned*)(F.lds + RING_BYTES))[u] = 0u;
    __syncthreads();
    const int lo = args.ph_lo, hi = args.ph_hi;
    if (PROBE_MASK != 0u && ONLY >= 0) { if (F.bid == 0 && F.tid == 0) ((unsigned long long*)(F.ws + 512 * 1024))[ONLY] = __builtin_amdgcn_s_memrealtime(); }
    if (PROBE_MASK != 0u && ONLY < 0) { if (F.tid == 0) { LAS unsigned long long* tp_ = (LAS unsigned long long*)(F.lds + MISC_OFF + 64); tp_[0] = 0; tp_[1] = __builtin_amdgcn_s_memrealtime(); } }
    XcdBarrier bar; bar.bar = (unsigned*)(F.ctl + CW_BAR); bar.x = 0; bar.st = nullptr;
    if (ONLY < 0 && hi - lo > 1) bar = xcd_barrier_post((unsigned*)(F.ctl + CW_BAR), (volatile LAS unsigned*)(F.lds + MISC_OFF));
    LAS int* tab = (LAS int*)(F.lds + RING_BYTES + 64);

    if (IN(0)) { ENTER(); p0_prologue(F); SEAM(0); }
    if (IN(1)) { ENTER(); p1_prologue(F); if (TPM != 0u && ONLY < 0 && ((TPM >> 1) & 1u) && F.bid == 0 && F.tid == 0) TPW[0] += __builtin_amdgcn_s_memrealtime() - TPW[1]; }
    if (IN(2)) { ENTER();
        pg::PlainSched S; S.init(F.ws + WS_W4T, F.ws + WS_HDN, 4096, SEQ, 128, 128, F.G, F.bid);
        pg::EpiBf16<true> E{(bf16*)(F.ws + WS_HT), SEQ, nullptr};
        int kf = 128; asm volatile("" : "+s"(kf));
        pg::gemm_phase<pg::EpiBf16<true>, pg::PlainSched, false, false, true>(F.lds, F.tid, kf, 128, 128, S, E);
        SEAM(2);
    }
    if constexpr (ONLY >= 0) { if (ONLY >= 3 && ONLY < 11) layer_phases<ONLY>(F, bar, lo, hi, 0, tab); if (ONLY >= 11) layer_phases<ONLY>(F, bar, lo, hi, 1, tab); }
    else {
#pragma unroll 1
        for (int layer = 0; layer < 2; ++layer) layer_phases<ONLY>(F, bar, lo, hi, layer, tab);
    }
    if (PROBE_MASK != 0u && ONLY == NPHASE - 1) { __syncthreads(); if (F.bid == 0 && F.tid == 0) { const unsigned long long* ts = (const unsigned long long*)(F.ws + 512 * 1024); unsigned long long acc = 0, tend = __builtin_amdgcn_s_memrealtime();
        for (int k = 0; k < NPHASE; ++k) if (((PROBE_MASK >> k) & 1u) && k != 5) { int kn = k + 1; if (kn == 5) kn = 6; acc += ((kn < NPHASE) ? ts[kn] : tend) - ts[k]; }
        F.out[0] = 0.1f * (float)acc; } }
    if ((TPM != 0u || TPSEL >= 0) && ONLY < 0) { if (blockIdx.x == 0 && threadIdx.x == 0) { const unsigned long long acc = TPW[0] * TP_MULT, t0 = __builtin_amdgcn_s_memrealtime(); while (__builtin_amdgcn_s_memrealtime() - t0 < acc) __builtin_amdgcn_s_sleep(8); } }
    if (PROBE_MASK != 0u && ONLY < 0) { __syncthreads(); if (F.bid == 0 && F.tid == 0) F.out[0] = 0.1f * (float)((LAS unsigned long long*)(F.lds + MISC_OFF + 64))[0]; }
}
#undef IN
#undef SEAM

extern "C" void kernel_launch(void* const* d_in, const int* in_sizes, int n_in, void* d_out, int out_size, void* d_ws, size_t ws_size, hipStream_t stream) {
    static int grid = 0;
    if (grid == 0) {
        if (n_in != 34 || in_sizes[0] != MTOK * DM || out_size != MTOK * DM || ws_size < WS_END) { fprintf(stderr, "kernel_launch: unexpected shapes / workspace (n_in %d, ws %zu, need %zu)\n", n_in, ws_size, (size_t)WS_END); grid = -1; return; }
        int dev = 0, cus = 0;
        if (hipGetDevice(&dev) != hipSuccess || hipDeviceGetAttribute(&cus, hipDeviceAttributeMultiprocessorCount, dev) != hipSuccess) { grid = -1; return; }
#if !MK_SPLIT
        if (hipFuncSetAttribute((const void*)fwd_kernel<-1>, hipFuncAttributeMaxDynamicSharedMemorySize, LDS_BYTES) != hipSuccess) { fprintf(stderr, "kernel_launch: hipFuncSetAttribute failed\n"); grid = -1; return; }
        int per_cu = 0;
        if (hipOccupancyMaxActiveBlocksPerMultiprocessor(&per_cu, (const void*)fwd_kernel<-1>, NTHR, LDS_BYTES) != hipSuccess || per_cu < 1) fprintf(stderr, "kernel_launch: occupancy query reports %d blocks per CU\n", per_cu);
        (void)hipGetLastError();
#endif
        grid = cus;
    }
    if (grid < 0) return;
    (void)hipMemsetAsync((char*)d_ws + WS_CTL, 0, CTL_ZERO_BYTES, stream);
    Args a{};
    for (int i = 0; i < 34; ++i) a.in[i] = (const float*)d_in[i];
    a.out = (float*)d_out; a.ws = (unsigned char*)d_ws;
#if MK_SPLIT
    typedef void (*kfn)(Args);
    static const kfn fns[NPHASE] = {fwd_kernel<0>, fwd_kernel<1>, fwd_kernel<2>, fwd_kernel<3>, fwd_kernel<4>, nullptr, fwd_kernel<6>, fwd_kernel<7>, fwd_kernel<8>, fwd_kernel<9>, fwd_kernel<10>,
                                      fwd_kernel<11>, fwd_kernel<12>, fwd_kernel<13>, fwd_kernel<14>, fwd_kernel<15>, fwd_kernel<16>, fwd_kernel<17>, fwd_kernel<18>};
    static bool attr_done = false;
    if (!attr_done) { for (int ph = 0; ph < NPHASE; ++ph) if (fns[ph]) (void)hipFuncSetAttribute((const void*)fns[ph], hipFuncAttributeMaxDynamicSharedMemorySize, LDS_BYTES); attr_done = true; }
#ifndef REPEAT_MASK
#define REPEAT_MASK 0u
#endif
    for (int ph = 0; ph < NPHASE; ++ph) { if (!fns[ph]) continue; a.ph_lo = ph; a.ph_hi = ph + 1;
        for (int rep = 0; rep < (((REPEAT_MASK >> ph) & 1u) ? 2 : 1); ++rep) {
            if (rep == 1 && ph == 15) (void)hipMemsetAsync((char*)d_ws + WS_CTL + (size_t)(CW_CNT + NCLS * 64) * 4, 0, NCLS * 64 * 4, stream);
            hipLaunchKernelGGL(fns[ph], dim3(grid), dim3(NTHR), LDS_BYTES, stream, a); } }
#else
    a.ph_lo = 0; a.ph_hi = NPHASE; hipLaunchKernelGGL(fwd_kernel<-1>, dim3(grid), dim3(NTHR), LDS_BYTES, stream, a);
#endif
}
```

```cpp
#include <hip/hip_runtime.h>
#include <hip/hip_bf16.h>
#include <cstdio>
#include <cstdint>

#ifndef MK_SPLIT
#define MK_SPLIT 0
#endif

#define GAS __attribute__((address_space(1)))
#define LAS __attribute__((address_space(3)))
typedef unsigned short bf16;
typedef unsigned u32x4 __attribute__((ext_vector_type(4)));
typedef unsigned u32x2 __attribute__((ext_vector_type(2)));
typedef float f32x2 __attribute__((ext_vector_type(2)));
typedef float f32x4 __attribute__((ext_vector_type(4)));
typedef float f32x16 __attribute__((ext_vector_type(16)));
typedef short bf16x8 __attribute__((ext_vector_type(8)));
typedef short s16x4 __attribute__((ext_vector_type(4)));
typedef GAS unsigned gu32;

constexpr int DM = 2048, NB = 2, SEQ = 16384, MTOK = NB * SEQ, CTXL = 256, GRIDW = 64;
constexpr int NHEAD = 32, NKV = 4, HD = 64, QKVD = 2560, KVD = 256;
constexpr int NEXP = 16, EFF = 1024, NCLS = 24, LCAP = 32768;
constexpr int HYW = 64, HYEMB = 33;
constexpr float LN_EPS = 1e-5f;
constexpr float DN_ALPHA = 1.41421356237309515f;
constexpr float QSCALE = 0.125f * 1.4426950408889634f;
constexpr int NWAVES = 8, NTHR = 512;

constexpr size_t MiB = 1u << 20;
constexpr size_t WS_CTL = 0, CTL_ZERO_BYTES = 1 * MiB;
constexpr size_t WS_MOD = 1 * MiB;
constexpr size_t WS_ROPE = 1 * MiB + 512 * 1024;
constexpr size_t WS_FTAB = 1 * MiB + 768 * 1024;
constexpr size_t WS_CTXKV = 2 * MiB;
constexpr size_t WS_HDN = 3 * MiB;
constexpr size_t WS_W4T = 7 * MiB;
constexpr size_t WS_TOK = 8 * MiB;
constexpr size_t WS_GATE = 11 * MiB;
constexpr size_t WS_FFTS = 32 * MiB;
constexpr size_t WS_HT = 128 * MiB;
constexpr size_t WS_WQKV = 256 * MiB;
constexpr size_t WS_WO0 = 266 * MiB;
constexpr size_t WS_WHYIN = 274 * MiB;
constexpr size_t WS_WHYO = 298 * MiB;
constexpr size_t WS_W13 = 320 * MiB;
constexpr size_t WS_W2 = 576 * MiB;
constexpr size_t WS_A = 704 * MiB;
constexpr size_t WS_B = 832 * MiB;
constexpr size_t WS_END = 1216 * MiB;
constexpr int HID_ROWS = 38912;

constexpr int CW_TMO = 0;
constexpr int CW_BAR = 4096;
constexpr int CW_CNT = 16384;

constexpr int RING_BYTES = 131072;
constexpr int MISC_OFF = RING_BYTES + 320;
constexpr int FTAB_OFF = RING_BYTES + 1024;
constexpr int LDS_BYTES = 163840;
constexpr int SIDE_OFF = FTAB_OFF + 28672;

#define RLX_AGENT __ATOMIC_RELAXED, __HIP_MEMORY_SCOPE_AGENT
#define LDS_WAIT() asm volatile("s_waitcnt lgkmcnt(0)" ::: "memory")
#define VM_WAIT() asm volatile("s_waitcnt vmcnt(0)" ::: "memory")

__device__ __forceinline__ unsigned cvt_pk_bf16(float lo, float hi) { unsigned r; asm volatile("v_cvt_pk_bf16_f32 %0, %1, %2" : "=v"(r) : "v"(lo), "v"(hi)); return r; }
__device__ __forceinline__ float bf2f(unsigned h) { return __builtin_bit_cast(float, h << 16); }
__device__ __forceinline__ float bflo(unsigned w) { return __builtin_bit_cast(float, w << 16); }
__device__ __forceinline__ float bfhi(unsigned w) { return __builtin_bit_cast(float, w & 0xffff0000u); }
__device__ __forceinline__ float wave_sum(float v) {
    v += __builtin_bit_cast(float, __builtin_amdgcn_update_dpp(0, __builtin_bit_cast(int, v), 0xB1, 0xf, 0xf, true));
    v += __builtin_bit_cast(float, __builtin_amdgcn_update_dpp(0, __builtin_bit_cast(int, v), 0x4E, 0xf, 0xf, true));
    v += __builtin_bit_cast(float, __builtin_amdgcn_update_dpp(0, __builtin_bit_cast(int, v), 0x141, 0xf, 0xf, true));
    v += __builtin_bit_cast(float, __builtin_amdgcn_update_dpp(0, __builtin_bit_cast(int, v), 0x140, 0xf, 0xf, true));
    { auto r = __builtin_amdgcn_permlane16_swap(__float_as_uint(v), __float_as_uint(v), false, false); v = __uint_as_float(r[0]) + __uint_as_float(r[1]); }
    { auto r = __builtin_amdgcn_permlane32_swap(__float_as_uint(v), __float_as_uint(v), false, false); v = __uint_as_float(r[0]) + __uint_as_float(r[1]); }
    return v;
}

#define XB_TMO      128
#define XB_XCNT(j)  (256  + 64 * (j))
#define XB_XSUB(j)  (1280 + 64 * (j))
#define XB_XGEN(j)  (2304 + 64 * (j))
#define XB_TOP      3328
#define XB_TOPGEN   3392
#define XCD_BAR_WORDS 3456
#define XB_SPIN_CAP (1u << 18)

__device__ __forceinline__ unsigned xb_ld(unsigned* p)              { return __hip_atomic_load(p, __ATOMIC_RELAXED, __HIP_MEMORY_SCOPE_AGENT); }
__device__ __forceinline__ unsigned xb_add(unsigned* p, unsigned v) { return __hip_atomic_fetch_add(p, v, __ATOMIC_RELAXED, __HIP_MEMORY_SCOPE_AGENT); }
__device__ __forceinline__ unsigned xb_xcc_id() { return (unsigned)__builtin_amdgcn_s_getreg((3 << 11) | 20) & 0xFu; }
#define XB_SPIN(cond, bar) do { unsigned _sp = 0; while (cond) { __builtin_amdgcn_s_sleep(1); \
    if ((++_sp & 255u) == 0u) { if (xb_ld(&(bar)[XB_TMO])) break; if (_sp > XB_SPIN_CAP) { atomicAdd(&(bar)[XB_TMO], 1u); break; } } } } while (0)

struct XcdBarrier { unsigned* bar; unsigned x; volatile LAS unsigned* st; };

__device__ __forceinline__ XcdBarrier xcd_barrier_post(unsigned* bar, volatile LAS unsigned* st) {
    XcdBarrier b; b.bar = bar; b.x = xb_xcc_id(); b.st = st;
    if (threadIdx.x == 0) (void)xb_add(&bar[XB_XCNT(b.x)], 1u);
    return b;
}
__device__ __forceinline__ void xcd_barrier_complete(unsigned* bar, unsigned x, unsigned& nloc, unsigned& nx) {
    const unsigned G = gridDim.x * gridDim.y * gridDim.z;
    unsigned sum, cnt, mine, sp = 0u;
    for (;;) {
        sum = 0u; cnt = 0u; mine = 0u;
#pragma unroll
        for (unsigned j = 0; j < 16; ++j) { const unsigned c = xb_ld(&bar[XB_XCNT(j)]); sum += c; cnt += (c > 0u) ? 1u : 0u; mine = (j == x) ? c : mine; }
        if (sum == G) break;
        __builtin_amdgcn_s_sleep(1);
        if ((++sp & 255u) == 0u) { if (xb_ld(&bar[XB_TMO])) break; if (sp > XB_SPIN_CAP) { atomicAdd(&bar[XB_TMO], 1u); break; } }
    }
    nloc = mine > 0u ? mine : 1u; nx = cnt > 0u ? cnt : 1u;
}
__device__ __forceinline__ void xcd_barrier(const XcdBarrier& b) {
    asm volatile("s_waitcnt vmcnt(0)" ::: "memory");
    __syncthreads();
    if (threadIdx.x == 0) {
        unsigned* bar = b.bar;
        __builtin_amdgcn_s_waitcnt(0);
        unsigned nloc = b.st[0], nx = b.st[1];
        if (nloc == 0u) { xcd_barrier_complete(bar, b.x, nloc, nx); b.st[0] = nloc; b.st[1] = nx; }
        const unsigned old = xb_add(&bar[XB_XSUB(b.x)], 1u);
        const unsigned gen = old / nloc;
        if (old + 1u == (gen + 1u) * nloc) {
            __builtin_amdgcn_fence(__ATOMIC_RELEASE, "agent");
            asm volatile("s_waitcnt vmcnt(0)" ::: "memory");
            const unsigned og = xb_add(&bar[XB_TOP], 1u);
            const unsigned tg = og / nx;
            if (og + 1u == (tg + 1u) * nx) xb_add(&bar[XB_TOPGEN], 1u);
            else XB_SPIN(xb_ld(&bar[XB_TOPGEN]) == tg, bar);
            __builtin_amdgcn_fence(__ATOMIC_ACQUIRE, "agent");
            xb_add(&bar[XB_XGEN(b.x)], 1u);
            asm volatile("s_waitcnt vmcnt(0)" ::: "memory");
        } else {
            XB_SPIN(xb_ld(&bar[XB_XGEN(b.x)]) == gen, bar);
            __builtin_amdgcn_fence(__ATOMIC_ACQUIRE, "agent");
            asm volatile("s_waitcnt vmcnt(0)" ::: "memory");
        }
    }
    __syncthreads();
}

namespace pg {
constexpr int BM = 256, BK = 64, HALF = 128, HTB = HALF * BK * 2, NXCD = 8, WGM = 8;
__host__ __device__ __forceinline__ int lds_byte(int r, int c) { const int st = (r >> 4) * 2 + (c >> 5), rr = r & 15, cc = c & 31, ob = rr * 64 + cc * 2; return st * 1024 + (ob ^ (((ob >> 9) & 1) << 5)); }
__host__ __device__ __forceinline__ void stage_rc(int b, int& R, int& C) { const int st = b / 1024, sb = b % 1024, swz = sb ^ (((sb >> 9) & 1) << 5); R = (st >> 1) * 16 + swz / 64; C = (st & 1) * 32 + (swz % 64) / 2; }
__host__ __device__ __forceinline__ int perm32(int rho) { const int n = rho >> 4, i = rho & 15; return 8 * (i >> 2) + 4 * n + (i & 3); }

struct Unit { int pm, pn; const char* A; const char* B; const char* B2; int cls, row0, nrows, lbase; };

__device__ __forceinline__ bool static_map(int i, int G, int c, int nM, int nN, int& pm, int& pn) {
    const int nwg = nM * nN; const long L = (long)i * G + c; if (L >= nwg) return false;
    int wgid = (int)L; { const int q = nwg / NXCD, r = nwg % NXCD, xcd = wgid % NXCD, off = wgid / NXCD; wgid = (xcd < r ? xcd * (q + 1) : r * (q + 1) + (xcd - r) * q) + off; }
    const int nig = WGM * nN, gid = wgid / nig, fm = gid * WGM, gsz = (nM - fm) < WGM ? (nM - fm) : WGM;
    pm = fm + ((wgid % nig) % gsz); pn = (wgid % nig) / gsz; return true;
}
struct PlainSched {
    const char* A; const char* Bt; int nM, nN, G, c; size_t tA, tB;
    __device__ __forceinline__ void init(const void* A_, const void* Bt_, int M, int N, int ldA, int ldB, int G_, int c_) { A = (const char*)A_; Bt = (const char*)Bt_; nM = M / BM; nN = N / BM; G = G_; c = c_; tA = (size_t)BM * ldA * 2; tB = (size_t)BM * ldB * 2; }
    __device__ __forceinline__ bool next(int i, Unit& u) const {
        if (!static_map(i, G, c, nM, nN, u.pm, u.pn)) return false;
        u.A = A + (size_t)u.pm * tA; u.B = Bt + (size_t)u.pn * tB; u.B2 = u.B; u.cls = 0; u.row0 = 0; u.nrows = 256; u.lbase = 0; return true;
    }
    __device__ __forceinline__ unsigned row_off(const Unit&, int r, int ldA) const { return (unsigned)r * (unsigned)ldA * 2u; }
};

template <class Epi, class Sched, bool GATHER, bool KSPLIT, bool ALIGN_EPI>
__device__ __forceinline__ void gemm_phase(LAS unsigned char* lds, const int tid, const int K, const int ldA, const int ldB, const Sched& S, const Epi& E) {
    const int wid = __builtin_amdgcn_readfirstlane(tid >> 6), lane = tid & 63, wr = wid >> 2, wc = wid & 3, fr = lane & 15, fq = lane >> 4;
    const int nt = K / BK, nth = nt >> 1;
    int RA[2], CA[2];
    unsigned voffB[2], voA[2][2], nvoA[2][2];
#pragma unroll
    for (int i = 0; i < 2; ++i) { int R, C; stage_rc(tid * 16 + i * 8192, R, C); const int Rb = Epi::PERM ? ((R & ~31) + perm32(R & 31)) : R;
        RA[i] = R; CA[i] = C; voffB[i] = (unsigned)(Rb * ldB + C) * 2u;
        voA[0][i] = (unsigned)(R * ldA + C) * 2u; voA[1][i] = (unsigned)((R + HALF) * ldA + C) * 2u; nvoA[0][i] = voA[0][i]; nvoA[1][i] = voA[1][i]; }
    const size_t kstep = (size_t)(BK * 2);
    const size_t hstepB = (size_t)HALF * ldB * 2;
    const unsigned ldsw = (unsigned)wid * 1024u;
    const int aoff = lds_byte(wr * 64 + fr, fq * 8), boff = lds_byte(wc * 32 + fr, fq * 8);
#define PG8_SA(b, h) (((b) * 2 + (h)) * HTB)
#define PG8_SB(b, h) ((4 + (b) * 2 + (h)) * HTB)
#define PG8_STAGEB(bufoff, gbase) do { _Pragma("unroll") for (int _i = 0; _i < 2; ++_i) \
        __builtin_amdgcn_global_load_lds((const unsigned*)((const char*)(gbase) + voffB[_i]), (LAS unsigned*)(lds + (bufoff) + ldsw + _i * 8192), 16, 0, 0); } while (0)
#define PG8_STAGEA(bufoff, gbase, vo, h) do { _Pragma("unroll") for (int _i = 0; _i < 2; ++_i) \
        __builtin_amdgcn_global_load_lds((const unsigned*)((const char*)(gbase) + (vo)[h][_i]), (LAS unsigned*)(lds + (bufoff) + ldsw + _i * 8192), 16, 0, 0); } while (0)
#define PG8_LDA(dst, b, h) do { _Pragma("unroll") for (int m = 0; m < 4; ++m) _Pragma("unroll") for (int k = 0; k < 2; ++k) dst[m][k] = *(const LAS bf16x8*)(lds + PG8_SA(b, h) + aoff + m * 2048 + k * 1024); } while (0)
#define PG8_LDB(dst, b, h) do { _Pragma("unroll") for (int n = 0; n < 2; ++n) _Pragma("unroll") for (int k = 0; k < 2; ++k) dst[n][k] = *(const LAS bf16x8*)(lds + PG8_SB(b, h) + boff + n * 2048 + k * 1024); } while (0)
#define PG8_MMA(ai, bj, At, Bt) do { __builtin_amdgcn_s_setprio(1); _Pragma("unroll") for (int m = 0; m < 4; ++m) _Pragma("unroll") for (int n = 0; n < 2; ++n) _Pragma("unroll") for (int k = 0; k < 2; ++k) \
        acc[ai][bj][m][n] = __builtin_amdgcn_mfma_f32_16x16x32_bf16(Bt[n][k], At[m][k], acc[ai][bj][m][n], 0, 0, 0); __builtin_amdgcn_s_setprio(0); } while (0)
#define PG8_WAIT_V(n) asm volatile("s_waitcnt vmcnt(" #n ")" ::: "memory")
#define PG8_WAIT_L(n) asm volatile("s_waitcnt lgkmcnt(" #n ")" ::: "memory")
#define PG8_BAR __builtin_amdgcn_s_barrier()
#define PG8_SCHED __builtin_amdgcn_sched_barrier(0)
#define PG8_BPTR(tt) ((KSPLIT && (tt) >= nth) ? cB2 + (size_t)((tt) - nth) * kstep : cB + (size_t)(tt) * kstep)
    Unit cur, nxt; int ui = 0;
    if (!S.next(0, cur)) return;
    if constexpr (GATHER) {
#pragma unroll
        for (int h = 0; h < 2; ++h)
#pragma unroll
            for (int i = 0; i < 2; ++i) voA[h][i] = S.row_off(cur, h * HALF + RA[i], ldA) + (unsigned)CA[i] * 2u;
    }
    f32x4 acc[2][2][4][2];
#pragma unroll
    for (int a = 0; a < 2; ++a)
#pragma unroll
        for (int b = 0; b < 2; ++b)
#pragma unroll
            for (int m = 0; m < 4; ++m)
#pragma unroll
                for (int n = 0; n < 2; ++n) acc[a][b][m][n] = (f32x4){0.f, 0.f, 0.f, 0.f};
    bf16x8 At[4][2], B0[2][2], B1[2][2];
    const char* cA = cur.A; const char* cB = cur.B; const char* cB2 = cur.B2;
    if constexpr (Epi::SIDE) { if (wid == 0 && E.has_side()) __builtin_amdgcn_global_load_lds((const unsigned*)(E.side_src(cur) + lane * 16), (LAS unsigned*)(lds + SIDE_OFF), 16, 0, 0); }
    PG8_STAGEB(PG8_SB(0, 0), cB); PG8_STAGEB(PG8_SB(0, 1), cB + hstepB); PG8_STAGEA(PG8_SA(0, 0), cA, voA, 0); PG8_STAGEA(PG8_SA(0, 1), cA, voA, 1);
    if (wr == 1) PG8_BAR;
    PG8_WAIT_V(2); PG8_BAR;
    { const char* b1 = PG8_BPTR(1); PG8_STAGEB(PG8_SB(1, 0), b1); PG8_STAGEA(PG8_SA(1, 0), cA + kstep, voA, 0); PG8_STAGEB(PG8_SB(1, 1), b1 + hstepB); }
    PG8_WAIT_V(6); PG8_BAR;
    for (;;) {
        const bool has_next = S.next(ui + 1, nxt);
        const char* nA = has_next ? nxt.A : cA; const char* nB = has_next ? nxt.B : cB;
        if constexpr (GATHER) {
            if (has_next) {
#pragma unroll
                for (int h = 0; h < 2; ++h)
#pragma unroll
                    for (int i = 0; i < 2; ++i) nvoA[h][i] = S.row_off(nxt, h * HALF + RA[i], ldA) + (unsigned)CA[i] * 2u;
            } else {
#pragma unroll
                for (int h = 0; h < 2; ++h)
#pragma unroll
                    for (int i = 0; i < 2; ++i) nvoA[h][i] = voA[h][i];
            }
        }
        for (int t = 0; t < nt; t += 2) {
            const bool last = (t == nt - 2);
            const char* a1 = cA + (size_t)(t + 1) * kstep;
            const char* a2 = last ? nA : cA + (size_t)(t + 2) * kstep; const char* b2 = last ? nB : PG8_BPTR(t + 2);
            const char* a3 = a2 + kstep; const char* b3 = last ? nB + kstep : PG8_BPTR(t + 3);
            unsigned vo2[2][2];
#pragma unroll
            for (int h = 0; h < 2; ++h)
#pragma unroll
                for (int i = 0; i < 2; ++i) vo2[h][i] = (GATHER && last) ? nvoA[h][i] : voA[h][i];
            PG8_LDB(B0, 0, 0); PG8_LDB(B1, 0, 1); PG8_SCHED; PG8_LDA(At, 0, 0); PG8_STAGEA(PG8_SA(1, 1), a1, voA, 1);
            PG8_WAIT_V(8); PG8_WAIT_L(0); PG8_BAR; PG8_MMA(0, 0, At, B0); PG8_MMA(0, 1, At, B1); PG8_BAR; PG8_SCHED;
            PG8_LDA(At, 0, 1); PG8_STAGEB(PG8_SB(0, 0), b2); PG8_STAGEB(PG8_SB(0, 1), b2 + hstepB); PG8_STAGEA(PG8_SA(0, 0), a2, vo2, 0);
            PG8_WAIT_V(8); PG8_WAIT_L(0); PG8_BAR; PG8_MMA(1, 0, At, B0); PG8_MMA(1, 1, At, B1); PG8_BAR; PG8_SCHED;
            PG8_LDB(B0, 1, 0); PG8_LDB(B1, 1, 1); PG8_SCHED; PG8_LDA(At, 1, 0); PG8_STAGEA(PG8_SA(0, 1), a2, vo2, 1);
            PG8_WAIT_V(8); PG8_WAIT_L(0); PG8_BAR; PG8_MMA(0, 0, At, B0); PG8_MMA(0, 1, At, B1); PG8_BAR; PG8_SCHED;
            PG8_LDA(At, 1, 1); PG8_STAGEB(PG8_SB(1, 0), b3); PG8_STAGEB(PG8_SB(1, 1), b3 + hstepB); PG8_STAGEA(PG8_SA(1, 0), a3, vo2, 0);
            PG8_WAIT_V(8); PG8_WAIT_L(0); PG8_BAR; PG8_MMA(1, 0, At, B0); PG8_MMA(1, 1, At, B1); PG8_BAR; PG8_SCHED;
        }
        if constexpr (ALIGN_EPI) { if (wr == 0) PG8_BAR; }
        if constexpr (Epi::SIDE) { if (has_next && wid == 0 && E.has_side()) __builtin_amdgcn_global_load_lds((const unsigned*)(E.side_src(nxt) + lane * 16), (LAS unsigned*)(lds + SIDE_OFF + ((ui + 1) & 1) * 1024), 16, 0, 0); }
        E(acc, cur, wr, wc, fr, fq, (const LAS float*)(lds + SIDE_OFF + (ui & 1) * 1024));
        if (!has_next) break;
#pragma unroll
        for (int a = 0; a < 2; ++a)
#pragma unroll
            for (int b = 0; b < 2; ++b)
#pragma unroll
                for (int m = 0; m < 4; ++m)
#pragma unroll
                    for (int n = 0; n < 2; ++n) acc[a][b][m][n] = (f32x4){0.f, 0.f, 0.f, 0.f};
        cur = nxt; cA = nA; cB = nB; cB2 = nxt.B2; ++ui;
        if constexpr (GATHER) {
#pragma unroll
            for (int h = 0; h < 2; ++h)
#pragma unroll
                for (int i = 0; i < 2; ++i) voA[h][i] = nvoA[h][i];
        }
        if constexpr (ALIGN_EPI) { if (wr == 1) PG8_BAR; }
    }
    PG8_WAIT_V(0);
    if constexpr (!ALIGN_EPI) { if (wr == 0) PG8_BAR; }
    PG8_BAR;
#undef PG8_SA
#undef PG8_SB
#undef PG8_STAGEA
#undef PG8_STAGEB
#undef PG8_LDA
#undef PG8_LDB
#undef PG8_MMA
#undef PG8_WAIT_V
#undef PG8_WAIT_L
#undef PG8_BAR
#undef PG8_SCHED
#undef PG8_BPTR
}
}
namespace pg {
template <bool BIAS_ROW> struct EpiBf16 {
    static constexpr bool PERM = true; static constexpr bool SIDE = true; static constexpr int NST = 16;
    __device__ __forceinline__ bool full_stores(const Unit&) const { return true; }
    bf16* O; int ldc; const float* bias;
    __device__ __forceinline__ bool has_side() const { return bias != nullptr; }
    __device__ __forceinline__ const char* side_src(const Unit& u) const { return (const char*)(bias + (BIAS_ROW ? u.pm : u.pn) * BM); }
    __device__ __forceinline__ void operator()(const f32x4 (&acc)[2][2][4][2], const Unit& u, int wr, int wc, int fr, int fq, const LAS float* side) const {
        const int row0 = u.pm * BM + wr * 64 + fr; const int col0 = u.pn * BM + wc * 32 + 8 * fq;
        f32x4 bv[2][2];
#pragma unroll
        for (int bj = 0; bj < 2; ++bj)
#pragma unroll
            for (int n = 0; n < 2; ++n) bv[bj][n] = (bias && !BIAS_ROW) ? *(const LAS f32x4*)(side + wc * 32 + 8 * fq + bj * HALF + 4 * n) : (f32x4){0.f, 0.f, 0.f, 0.f};
#pragma unroll
        for (int ai = 0; ai < 2; ++ai)
#pragma unroll
            for (int m = 0; m < 4; ++m) { const int row = row0 + ai * HALF + m * 16; bf16* rowp = O + (size_t)row * ldc + col0;
                float br = 0.f; if (BIAS_ROW && bias) br = side[wr * 64 + fr + ai * HALF + m * 16];
#pragma unroll
                for (int bj = 0; bj < 2; ++bj) { f32x4 v0 = acc[ai][bj][m][0] + bv[bj][0] + br, v1 = acc[ai][bj][m][1] + bv[bj][1] + br;
                    u32x4 w; w.x = cvt_pk_bf16(v0[0], v0[1]); w.y = cvt_pk_bf16(v0[2], v0[3]); w.z = cvt_pk_bf16(v1[0], v1[1]); w.w = cvt_pk_bf16(v1[2], v1[3]);
                    *(u32x4*)(rowp + bj * HALF) = w; } }
    }
};
struct EpiQKV {
    static constexpr bool PERM = false; static constexpr bool SIDE = false; static constexpr int NST = 32;
    __device__ __forceinline__ bool full_stores(const Unit&) const { return true; }
    bf16 *Q, *Kb, *Vb; const float* bias; const float* ropeC; const float* ropeS;
    __device__ __forceinline__ bool has_side() const { return false; }
    __device__ __forceinline__ const char* side_src(const Unit&) const { return nullptr; }
    __device__ __forceinline__ void operator()(const f32x4 (&acc)[2][2][4][2], const Unit& u, int wr, int wc, int fr, int fq, const LAS float*) const {
        const int row0 = u.pm * BM + wr * 64 + fr; const int colt = u.pn * BM + wc * 32 + 4 * fq;
        const bool isV = (u.pn == 9), isQ = (u.pn < 8);
        bf16* base; int ldc, cofs;
        if (isQ) { base = Q; ldc = DM; cofs = 0; } else if (!isV) { base = Kb; ldc = KVD; cofs = 2048; } else { base = Vb; ldc = KVD; cofs = 2304; }
        f32x4 bv[2][2];
#pragma unroll
        for (int bj = 0; bj < 2; ++bj)
#pragma unroll
            for (int n = 0; n < 2; ++n) bv[bj][n] = *(const f32x4*)(bias + colt + bj * HALF + 16 * n);
        const float sc = isQ ? QSCALE : 1.f; const int half = wc & 1;
#pragma unroll
        for (int ai = 0; ai < 2; ++ai)
#pragma unroll
            for (int m = 0; m < 4; ++m) { const int row = row0 + ai * HALF + m * 16; const int t = row & (SEQ - 1); const int pos = half ? (t & (GRIDW - 1)) : (t >> 6);
                f32x4 cs = (f32x4){1.f, 1.f, 1.f, 1.f}, sn = (f32x4){0.f, 0.f, 0.f, 0.f};
                if (!isV) { cs = *(const f32x4*)(ropeC + pos * 16 + 4 * fq); sn = *(const f32x4*)(ropeS + pos * 16 + 4 * fq); }
                bf16* rowp = base + (size_t)row * ldc + (colt - cofs);
#pragma unroll
                for (int bj = 0; bj < 2; ++bj) { const f32x4 x1 = acc[ai][bj][m][0] + bv[bj][0], x2 = acc[ai][bj][m][1] + bv[bj][1];
                    const f32x4 o1 = (x1 * cs - x2 * sn) * sc, o2 = (x2 * cs + x1 * sn) * sc;
                    u32x2 w1, w2; w1.x = cvt_pk_bf16(o1[0], o1[1]); w1.y = cvt_pk_bf16(o1[2], o1[3]); w2.x = cvt_pk_bf16(o2[0], o2[1]); w2.y = cvt_pk_bf16(o2[2], o2[3]);
                    *(u32x2*)(rowp + bj * HALF) = w1; *(u32x2*)(rowp + bj * HALF + 16) = w2; } }
    }
};
struct EpiMoe1 {
    static constexpr bool PERM = true; static constexpr bool SIDE = true; static constexpr int NST = 8;
    __device__ __forceinline__ bool full_stores(const Unit& u) const { return u.nrows == BM; }
    bf16* hid; const float* gates;
    __device__ __forceinline__ bool has_side() const { return true; }
    __device__ __forceinline__ const char* side_src(const Unit& u) const { return (const char*)(gates + (size_t)((u.pn >= 8) ? 1 : 0) * NCLS * LCAP + u.lbase); }
    __device__ __forceinline__ void operator()(const f32x4 (&acc)[2][2][4][2], const Unit& u, int wr, int wc, int fr, int fq, const LAS float* side) const {
        const int lr0 = wr * 64 + fr; const int col0 = u.pn * HALF + wc * 32 + 8 * fq; const int gsel = (u.pn >= 8) ? 1 : 0;
#pragma unroll
        for (int ai = 0; ai < 2; ++ai)
#pragma unroll
            for (int m = 0; m < 4; ++m) { const int lr = lr0 + ai * HALF + m * 16;
                if (lr < u.nrows) { const float g = side[lr];
                    float o[8];
#pragma unroll
                    for (int n = 0; n < 2; ++n)
#pragma unroll
                        for (int i = 0; i < 4; ++i) { const float a = acc[ai][0][m][n][i], b = acc[ai][1][m][n][i];
                            const float sg = __builtin_amdgcn_rcpf(1.f + __builtin_amdgcn_exp2f(-1.4426950408889634f * a)); o[n * 4 + i] = a * sg * b * g; }
                    u32x4 w; w.x = cvt_pk_bf16(o[0], o[1]); w.y = cvt_pk_bf16(o[2], o[3]); w.z = cvt_pk_bf16(o[4], o[5]); w.w = cvt_pk_bf16(o[6], o[7]);
                    *(u32x4*)(hid + (size_t)(u.row0 + lr) * DM + col0) = w; } }
    }
};
struct EpiMoe2 {
    static constexpr bool PERM = true; static constexpr bool SIDE = true; static constexpr int NST = 16;
    __device__ __forceinline__ bool full_stores(const Unit& u) const { return u.nrows == BM; }
    bf16* Y; const int* toks;
    __device__ __forceinline__ bool has_side() const { return true; }
    __device__ __forceinline__ const char* side_src(const Unit& u) const { return (const char*)(toks + u.lbase); }
    __device__ __forceinline__ void operator()(const f32x4 (&acc)[2][2][4][2], const Unit& u, int wr, int wc, int fr, int fq, const LAS float* side) const {
        const int lr0 = wr * 64 + fr; const int col0 = u.pn * BM + wc * 32 + 8 * fq;
#pragma unroll
        for (int ai = 0; ai < 2; ++ai)
#pragma unroll
            for (int m = 0; m < 4; ++m) { const int lr = lr0 + ai * HALF + m * 16;
                if (lr < u.nrows) { const int tok = ((const LAS int*)side)[lr]; bf16* rowp = Y + (size_t)tok * DM + col0;
#pragma unroll
                    for (int bj = 0; bj < 2; ++bj) { const f32x4 v0 = acc[ai][bj][m][0], v1 = acc[ai][bj][m][1];
                        u32x4 w; w.x = cvt_pk_bf16(v0[0], v0[1]); w.y = cvt_pk_bf16(v0[2], v0[3]); w.z = cvt_pk_bf16(v1[0], v1[1]); w.w = cvt_pk_bf16(v1[2], v1[3]);
                        *(u32x4*)(rowp + bj * HALF) = w; } } }
    }
};
struct MoeSched {
    const LAS int* tab;
    const char* Abase; const char* W; const int* toks; int G, c, NPN, second;
    __device__ __forceinline__ bool next(int i, Unit& u) const {
        const int TM = __builtin_amdgcn_readfirstlane(tab[24]);
        if (!static_map(i, G, c, TM, NPN, u.pm, u.pn)) return false;
        int cls = 0;
        for (int k = 1; k < NCLS; ++k) { const int s = __builtin_amdgcn_readfirstlane(tab[k]); if (u.pm >= s) cls = k; }
        const int ts = __builtin_amdgcn_readfirstlane(tab[cls]), cnt = __builtin_amdgcn_readfirstlane(tab[32 + cls]);
        const int ti = u.pm - ts; u.cls = cls; u.row0 = u.pm * BM; u.nrows = (cnt - ti * BM) < BM ? (cnt - ti * BM) : BM; u.lbase = cls * LCAP + ti * BM;
        const int g = cls / 6, p = cls % 6; const int lo = (p < 3) ? 0 : (p < 5 ? 1 : 2), hi = (p < 3) ? p + 1 : (p < 5 ? p - 1 : 3);
        const int elo = g * 4 + lo, ehi = g * 4 + hi;
        if (!second) { const int e = (u.pn < 8) ? elo : ehi; u.A = Abase; u.B = W + ((size_t)e * 2048 + (size_t)(u.pn & 7) * 256) * 2048 * 2; u.B2 = u.B; }
        else { u.A = Abase + (size_t)u.row0 * DM * 2; u.B = W + ((size_t)elo * 2048 + (size_t)u.pn * 256) * 1024 * 2; u.B2 = W + ((size_t)ehi * 2048 + (size_t)u.pn * 256) * 1024 * 2; }
        return true;
    }
    __device__ __forceinline__ unsigned row_off(const Unit& u, int r, int ldA) const {
        const int rr = r < u.nrows ? r : u.nrows - 1; const int tok = toks[u.lbase + rr]; return (unsigned)tok * (unsigned)ldA * 2u;
    }
};
}
struct Args { const float* in[34]; float* out; unsigned char* ws; int ph_lo, ph_hi; };
struct Frame {
    LAS unsigned char* lds;
    gu32* ctl; unsigned char* ws;
    int tid, lane, wave, G, bid;
    const Args* a; float* out;
};
#define AIN(i) (F.a->in[i])
enum { I_X = 0, I_C, I_CTX, I_CCTX, I_ADAW, I_ADAB, I_AWIN, I_ABIN, I_SINK, I_AWOUT, I_HWIN, I_HBIN, I_HCW, I_HCB, I_FW1, I_FB1, I_FW2, I_FB2, I_FW3, I_FB3, I_FFREQ, I_FW4, I_FBIAS, I_HWOUT, I_HBOUT,
       I_LN1G, I_LN1B, I_LN2G, I_LN2B, I_RW, I_RB, I_W1, I_W3, I_W2 };
#ifndef TPSEL
#define TPSEL -1
#endif
#define TPS_W ((LAS unsigned long long*)(F.lds + RING_BYTES + 320 + 96))
#define TPS_START(id) do { if (TPSEL == (id) && blockIdx.x == 0 && threadIdx.x == 0) TPS_W[1] = __builtin_amdgcn_s_memrealtime(); } while (0)
#define TPS_STOP(id) do { if (TPSEL == (id) && blockIdx.x == 0 && threadIdx.x == 0) TPS_W[0] += __builtin_amdgcn_s_memrealtime() - TPS_W[1]; } while (0)
__device__ __forceinline__ int fresh_tid(int wave) { int l_; asm volatile("v_mbcnt_lo_u32_b32 %0, -1, 0\n\tv_mbcnt_hi_u32_b32 %0, -1, %0" : "=&v"(l_)); return wave * 64 + l_; }
__device__ __forceinline__ float* mod_ptr(const Frame& F, int layer, int vec, int chunk) { return (float*)(F.ws + WS_MOD) + ((size_t)(layer * 3 + vec) * 6 + chunk) * DM; }

__device__ __forceinline__ float hy_ftab_value(int f, int l, int jj);
__device__ constexpr int hy_ftab_elems() { return 28 * 64 * 8; }
__device__ __forceinline__ void p0_transpose_item(const float* W, int ldw, bf16* WT, int ldt, int dst_row, int k0, int n0, LAS float* scr, int lane) {
#pragma unroll
    for (int i = 0; i < 32; ++i) { const int kk = 2 * i + (lane >> 5); scr[kk * 33 + (lane & 31)] = W[(size_t)(k0 + kk) * ldw + n0 + (lane & 31)]; }
    LDS_WAIT(); asm volatile("" ::: "memory");
    const int c = lane & 7;
#pragma unroll
    for (int j = 0; j < 4; ++j) { const int n = (lane >> 3) + 8 * j; const LAS float* s = scr + (8 * c) * 33 + n;
        u32x4 o; o.x = cvt_pk_bf16(s[0 * 33], s[1 * 33]); o.y = cvt_pk_bf16(s[2 * 33], s[3 * 33]); o.z = cvt_pk_bf16(s[4 * 33], s[5 * 33]); o.w = cvt_pk_bf16(s[6 * 33], s[7 * 33]);
        *(GAS u32x4*)(WT + (size_t)(dst_row + n) * ldt + k0 + 8 * c) = o; }
    LDS_WAIT(); asm volatile("" ::: "memory");
}
struct ConvItem { const float* W; bf16* WT; int ldw, ldt, dst_row, k0, n0; };
__device__ __forceinline__ ConvItem moe_l1_item(const Frame& F, int it) {
    ConvItem c; const int mat = it >> 10, sub = it & 1023, which = mat >> 4, le = 16 + (mat & 15);
    if (which < 2) { c.n0 = (sub & 31) * 32; c.k0 = (sub >> 5) * 64; c.W = (which == 0 ? AIN(I_W1) : AIN(I_W3)) + (size_t)le * DM * EFF; c.ldw = EFF; c.WT = (bf16*)(F.ws + WS_W13) + (size_t)le * 2048 * 2048; c.ldt = DM; c.dst_row = (c.n0 >> 7) * 256 + which * 128 + (c.n0 & 127); }
    else { c.n0 = (sub & 63) * 32; c.k0 = (sub >> 6) * 64; c.W = AIN(I_W2) + (size_t)le * EFF * DM; c.ldw = DM; c.WT = (bf16*)(F.ws + WS_W2) + (size_t)le * 2048 * 1024; c.ldt = EFF; c.dst_row = c.n0; }
    return c;
}
__device__ __forceinline__ ConvItem early_item(const Frame& F, int it) {
    ConvItem c;
    if (it < 48 * 1024) { const int mat = it >> 10, sub = it & 1023, which = mat >> 4, le = mat & 15;
        if (which < 2) { c.n0 = (sub & 31) * 32; c.k0 = (sub >> 5) * 64; c.W = (which == 0 ? AIN(I_W1) : AIN(I_W3)) + (size_t)le * DM * EFF; c.ldw = EFF; c.WT = (bf16*)(F.ws + WS_W13) + (size_t)le * 2048 * 2048; c.ldt = DM; c.dst_row = (c.n0 >> 7) * 256 + which * 128 + (c.n0 & 127); }
        else { c.n0 = (sub & 63) * 32; c.k0 = (sub >> 6) * 64; c.W = AIN(I_W2) + (size_t)le * EFF * DM; c.ldw = DM; c.WT = (bf16*)(F.ws + WS_W2) + (size_t)le * 2048 * 1024; c.ldt = EFF; c.dst_row = c.n0; }
    } else { int r = it - 48 * 1024;
        if (r < 32 * 192) { c.n0 = (r % 192) * 32; c.k0 = (r / 192) * 64; c.W = AIN(I_HWIN); c.ldw = 3 * DM; c.WT = (bf16*)(F.ws + WS_WHYIN); c.ldt = DM; c.dst_row = c.n0; }
        else { r -= 32 * 192; c.n0 = (r % 64) * 32; c.k0 = (r / 64) * 64; c.W = AIN(I_HWOUT); c.ldw = DM; c.WT = (bf16*)(F.ws + WS_WHYO); c.ldt = DM; c.dst_row = c.n0; } }
    return c;
}
constexpr int EARLY_NIT = 48 * 1024 + 32 * 192 + 32 * 64;
__device__ __forceinline__ void conv_issue(const ConvItem& c, int lane, float (&v)[32]) {
    const float* p = c.W + (size_t)(c.k0 + (lane >> 5)) * c.ldw + c.n0 + (lane & 31); const size_t st = (size_t)2 * c.ldw;
#pragma unroll
    for (int i = 0; i < 32; ++i) { v[i] = *p; p += st; asm volatile("" : "+v"(p)); }
}
__device__ __forceinline__ void conv_finish(const ConvItem& c, int lane, const float (&v)[32]) {
    bf16* row = c.WT + (size_t)(c.dst_row + (lane & 31)) * c.ldt + c.k0 + 8 * (lane >> 5);
#pragma unroll
    for (int m = 0; m < 4; ++m) { u32x4 w;
#pragma unroll
        for (int q = 0; q < 4; ++q) { auto r = __builtin_amdgcn_permlane32_swap(__float_as_uint(v[8 * m + q]), __float_as_uint(v[8 * m + 4 + q]), false, false);
            const unsigned pk = cvt_pk_bf16(__uint_as_float(r[0]), __uint_as_float(r[1])); if (q == 0) w.x = pk; else if (q == 1) w.y = pk; else if (q == 2) w.z = pk; else w.w = pk; }
        *(GAS u32x4*)(row + 16 * m) = w; }
}
__device__ __forceinline__ void p0_prologue(Frame& F) {
    const int gw = F.bid * NWAVES + F.wave, NGW = F.G * NWAVES, gt = F.bid * NTHR + F.tid, NGT = F.G * NTHR;
#ifndef P0_REP
#define P0_REP 0
#endif
    TPS_START(20);
#pragma unroll 1
    for (int rep_a = 0; rep_a < ((P0_REP & 1) ? 2 : 1); ++rep_a) {
        LAS float* sil = (LAS float*)F.lds; LAS float* red = sil + 3 * DM;
        for (int i = F.tid; i < 3 * DM; i += NTHR) { const int v = i / DM, k = i % DM; const float cv = (v < 2) ? AIN(I_C)[v * DM + k] : AIN(I_CCTX)[k]; sil[i] = cv / (1.f + expf(-cv)); }
        __syncthreads();
        const int cl = F.tid & 7, kg = F.tid >> 3;
        for (int unit = F.bid; unit < 768; unit += F.G) {
            const int l = unit / 384, n0 = (unit % 384) * 32;
            const float* W = AIN(I_ADAW) + (size_t)l * DM * 12288 + n0 + cl * 4;
            f32x4 a0 = {0.f, 0.f, 0.f, 0.f}, a1 = a0, a2 = a0;
#pragma unroll 8
            for (int i = 0; i < 32; ++i) { const int k = kg + 64 * i; const f32x4 w = *(const f32x4*)(W + (size_t)k * 12288); a0 += w * sil[k]; a1 += w * sil[DM + k]; a2 += w * sil[2 * DM + k]; }
#pragma unroll
            for (int j = 0; j < 4; ++j) { red[(kg * 32 + cl * 4 + j) * 3 + 0] = a0[j]; red[(kg * 32 + cl * 4 + j) * 3 + 1] = a1[j]; red[(kg * 32 + cl * 4 + j) * 3 + 2] = a2[j]; }
            __syncthreads();
            if (F.tid < 96) { const int col = F.tid & 31, v = F.tid >> 5; float s = 0.f;
                for (int k = 0; k < 64; ++k) s += red[(k * 32 + col) * 3 + v];
                ((float*)(F.ws + WS_MOD))[(size_t)(l * 3 + v) * 12288 + n0 + col] = s + AIN(I_ADAB)[l * 12288 + n0 + col]; }
            __syncthreads();
        }
    }
    TPS_STOP(20); TPS_START(21);
#pragma unroll 1
    for (int rep_b = 0; rep_b < ((P0_REP & 2) ? 2 : 1); ++rep_b) {
        LAS float* scr = (LAS float*)(F.lds + F.wave * 16384);
        constexpr int I0 = 32 * 80, I1 = 32 * 64, NIT = I0 + I1 + EARLY_NIT;
        for (int it = gw; it < NIT; it += NGW) {
            int r = it;
            if (r < I0) { p0_transpose_item(AIN(I_AWIN), QKVD, (bf16*)(F.ws + WS_WQKV), DM, (r % 80) * 32, (r / 80) * 64, (r % 80) * 32, scr, F.lane); continue; } r -= I0;
            if (r < I1) { p0_transpose_item(AIN(I_AWOUT), DM, (bf16*)(F.ws + WS_WO0), DM, (r % 64) * 32, (r / 64) * 64, (r % 64) * 32, scr, F.lane); continue; } r -= I1;
            const ConvItem c = early_item(F, r); p0_transpose_item(c.W, c.ldw, c.WT, c.ldt, c.dst_row, c.k0, c.n0, scr, F.lane);
        }
    }
    TPS_STOP(21); TPS_START(22);
    {
        const int j = F.lane; const float fr = AIN(I_FFREQ)[j], b1 = AIN(I_FB1)[j], b2 = AIN(I_FB2)[j], b3 = AIN(I_FB3)[j];
        float wc1[HYEMB], wc2[HYW], wc3[HYW];
#pragma unroll
        for (int i = 0; i < HYEMB; ++i) wc1[i] = AIN(I_FW1)[i * HYW + j];
#pragma unroll
        for (int i = 0; i < HYW; ++i) { wc2[i] = AIN(I_FW2)[i * HYW + j]; wc3[i] = AIN(I_FW3)[i * HYW + j]; }
        bf16* hdn = (bf16*)(F.ws + WS_HDN);
        for (int row = gw; row < SEQ; row += NGW) {
            const float tt = (float)row / (float)(SEQ - 1); const float wv = 6.283185307179586f * (float)row / (float)SEQ;
            float zv = 0.f;
            if (j == 0) zv = tt;
            else if (j <= 32) { const int jj = (j - 1) & 15; const float f = 1e-4f + (float)jj * ((15.f - 1e-4f) / 15.f); const float a = f * wv; zv = (j <= 16) ? cosf(a) : -sinf(a); }
            float h = b1;
#pragma unroll
            for (int i = 0; i < HYEMB; ++i) h += __builtin_bit_cast(float, __builtin_amdgcn_readlane(__builtin_bit_cast(int, zv), i)) * wc1[i];
            float a1 = sinf(fr * h);
            h = b2;
#pragma unroll
            for (int i = 0; i < HYW; ++i) h += __builtin_bit_cast(float, __builtin_amdgcn_readlane(__builtin_bit_cast(int, a1), i)) * wc2[i];
            float a2 = sinf(fr * h);
            h = b3;
#pragma unroll
            for (int i = 0; i < HYW; ++i) h += __builtin_bit_cast(float, __builtin_amdgcn_readlane(__builtin_bit_cast(int, a2), i)) * wc3[i];
            const float a3 = sinf(fr * h);
            hdn[(size_t)row * 128 + j] = (bf16)(cvt_pk_bf16(a3, 0.f) & 0xffffu); hdn[(size_t)row * 128 + 64 + j] = 0;
        }
    }
    TPS_STOP(22); TPS_START(23);
    for (int i = gt; i < hy_ftab_elems(); i += NGT) ((bf16*)(F.ws + WS_FTAB))[i] = (bf16)(cvt_pk_bf16(hy_ftab_value(i >> 9, (i >> 3) & 63, i & 7), 0.f) & 0xffffu);
    for (int i = gt; i < 4096; i += NGT) { const int pos = i >> 4, dd = i & 15; const float inv = powf(10000.f, -(float)(2 * dd) / 32.f); const float a = (float)pos * inv;
        ((float*)(F.ws + WS_ROPE))[i] = cosf(a); ((float*)(F.ws + WS_ROPE))[4096 + i] = sinf(a); }
    for (int i = gt; i < 4096 * 128; i += NGT) { const int k = i >> 12, n = i & 4095;
        ((bf16*)(F.ws + WS_W4T))[(size_t)n * 128 + k] = (k < 64) ? (bf16)(cvt_pk_bf16(AIN(I_FW4)[(size_t)k * 4096 + n], 0.f) & 0xffffu) : (bf16)0; }
    TPS_STOP(23);
}

__device__ __forceinline__ void p1_prologue(Frame& F) {
    if (F.wave < 4) {
        for (int tile = F.bid * 4 + F.wave; tile < 1024; tile += F.G * 4) {
            const int r0 = (tile >> 5) * 16, n0 = (tile & 31) * 16; const int lr = F.lane & 15, kq = F.lane >> 4;
            const float* crow = AIN(I_CTX) + (size_t)(r0 + lr) * DM; const float* sh = mod_ptr(F, 0, 2, 0); const float* sc = mod_ptr(F, 0, 2, 1);
            const bf16* wrow = (const bf16*)(F.ws + WS_WQKV) + (size_t)(2048 + n0 + lr) * DM;
            f32x4 acc = {0.f, 0.f, 0.f, 0.f};
#pragma unroll 4
            for (int k0 = 0; k0 < DM; k0 += 32) { const int k = k0 + 8 * kq;
                const f32x4 x0 = *(const f32x4*)(crow + k), x1 = *(const f32x4*)(crow + k + 4), s0 = *(const f32x4*)(sc + k), s1 = *(const f32x4*)(sc + k + 4), h0 = *(const f32x4*)(sh + k), h1 = *(const f32x4*)(sh + k + 4);
                const f32x4 u0 = x0 * (s0 + 1.f) + h0, u1 = x1 * (s1 + 1.f) + h1;
                u32x4 aw; aw.x = cvt_pk_bf16(u0[0], u0[1]); aw.y = cvt_pk_bf16(u0[2], u0[3]); aw.z = cvt_pk_bf16(u1[0], u1[1]); aw.w = cvt_pk_bf16(u1[2], u1[3]);
                const bf16x8 bfrag = *(const bf16x8*)(wrow + k);
                acc = __builtin_amdgcn_mfma_f32_16x16x32_bf16(__builtin_bit_cast(bf16x8, aw), bfrag, acc, 0, 0, 0); }
            const float bb = AIN(I_ABIN)[2048 + n0 + lr]; bf16* o = (bf16*)(F.ws + WS_CTXKV);
#pragma unroll
            for (int r = 0; r < 4; ++r) o[(size_t)(r0 + 4 * kq + r) * 512 + n0 + lr] = (bf16)(cvt_pk_bf16(acc[r] + bb, 0.f) & 0xffffu);
        }
    }
    const float* x = AIN(I_X); bf16* u0 = (bf16*)(F.ws + WS_A);
    LAS int* cnt = (LAS int*)(F.lds + RING_BYTES + 64);
    const size_t NI = (size_t)MTOK * DM / 8; const size_t per = (NI + F.G - 1) / F.G; const size_t i0 = (size_t)F.bid * per; const size_t i1 = (i0 + per < NI) ? i0 + per : NI;
    const int nch = (int)((i1 - i0 + 255) / 256);
    for (;;) {
        int c = 0; if (F.lane == 0) c = __hip_atomic_fetch_add(cnt, 1, __ATOMIC_RELAXED, __HIP_MEMORY_SCOPE_WORKGROUP);
        c = __builtin_amdgcn_readfirstlane(c); if (c >= nch) break;
        f32x4 xa[4], xb[4]; size_t ee[4];
#pragma unroll
        for (int j = 0; j < 4; ++j) { const size_t i = i0 + (size_t)c * 256 + j * 64 + F.lane; ee[j] = (i < i1) ? i * 8 : (size_t)-1; if (i < i1) { xa[j] = *(const f32x4*)(x + i * 8); xb[j] = *(const f32x4*)(x + i * 8 + 4); } }
#pragma unroll
        for (int j = 0; j < 4; ++j) { if (ee[j] == (size_t)-1) continue; const size_t e = ee[j]; const int col = (int)(e & (DM - 1)); const int b = (int)(e / ((size_t)SEQ * DM));
            const float* sh = mod_ptr(F, 0, b, 0) + col; const float* sc = mod_ptr(F, 0, b, 1) + col;
            const f32x4 v0 = xa[j] * (*(const f32x4*)sc + 1.f) + *(const f32x4*)sh, v1 = xb[j] * (*(const f32x4*)(sc + 4) + 1.f) + *(const f32x4*)(sh + 4);
            u32x4 w; w.x = cvt_pk_bf16(v0[0], v0[1]); w.y = cvt_pk_bf16(v0[2], v0[3]); w.z = cvt_pk_bf16(v1[0], v1[1]); w.w = cvt_pk_bf16(v1[2], v1[3]);
            *(u32x4*)(u0 + e) = w; }
    }
}
namespace att {
constexpr int LDS_K = 0, LDS_V = 24576, LDS_WS = 49152, LDS_OST = LDS_WS + NWAVES * 64 * 4, LDS_Q = LDS_OST + NWAVES * 4096;
__device__ __forceinline__ int crow(int r, int hi) { return (r & 3) + 8 * (r >> 2) + 4 * hi; }
__device__ __forceinline__ float max3f(float a, float b, float c) { return __builtin_fmaxf(__builtin_fmaxf(a, b), c); }
__device__ __forceinline__ float rowmax(const f32x16& p0, const f32x16& p1) {
    float a = max3f(p0[0], p0[1], p1[0]), b = max3f(p0[2], p0[3], p1[1]); a = max3f(a, p1[2], p1[3]);
#pragma unroll
    for (int r = 4; r < 16; r += 4) { a = max3f(a, p0[r], p0[r + 1]); b = max3f(b, p0[r + 2], p0[r + 3]); a = max3f(a, p1[r], p1[r + 1]); b = max3f(b, p1[r + 2], p1[r + 3]); }
    const float m = __builtin_fmaxf(a, b);
    auto rr = __builtin_amdgcn_permlane32_swap(__float_as_uint(m), __float_as_uint(m), false, false);
    return __builtin_fmaxf(__uint_as_float(rr[0]), __uint_as_float(rr[1]));
}
__device__ __forceinline__ void qkt(f32x16& p0, f32x16& p1, const LAS unsigned char* Kslot, const bf16x8* qr, const f32x16& z, int r32, int hi) {
    const LAS unsigned char* kb = Kslot + hi * 1024 + r32 * 16;
#pragma unroll
    for (int d0 = 0; d0 < 4; ++d0) {
        const bf16x8 b0 = *(const LAS bf16x8*)(kb + d0 * 2048);
        const bf16x8 b1 = *(const LAS bf16x8*)(kb + d0 * 2048 + 512);
        if (d0 == 0) { p0 = __builtin_amdgcn_mfma_f32_32x32x16_bf16(b0, qr[0], z, 0, 0, 0); p1 = __builtin_amdgcn_mfma_f32_32x32x16_bf16(b1, qr[0], z, 0, 0, 0); }
        else { p0 = __builtin_amdgcn_mfma_f32_32x32x16_bf16(b0, qr[d0], p0, 0, 0, 0); p1 = __builtin_amdgcn_mfma_f32_32x32x16_bf16(b1, qr[d0], p1, 0, 0, 0); }
    }
}
__device__ __forceinline__ void pv(f32x16* o, int vb, bf16x8 pa0, bf16x8 pa1, bf16x8 pa2, bf16x8 pa3) {
#pragma unroll
    for (int d0 = 0; d0 < 2; ++d0) { s16x4 lo[4], hi[4];
#pragma unroll
        for (int ks = 0; ks < 4; ++ks) {
            asm volatile("ds_read_b64_tr_b16 %0,%1 offset:%c2" : "=&v"(lo[ks]) : "v"(vb), "i"(d0 * 4096 + ks * 1024) : "memory");
            asm volatile("ds_read_b64_tr_b16 %0,%1 offset:%c2" : "=&v"(hi[ks]) : "v"(vb), "i"(d0 * 4096 + ks * 1024 + 512) : "memory"); }
        asm volatile("s_waitcnt lgkmcnt(0)" ::: "memory"); __builtin_amdgcn_sched_barrier(0);
#define PK(k) (bf16x8){lo[k][0], lo[k][1], lo[k][2], lo[k][3], hi[k][0], hi[k][1], hi[k][2], hi[k][3]}
        o[d0] = __builtin_amdgcn_mfma_f32_32x32x16_bf16(pa0, PK(0), o[d0], 0, 0, 0);
        o[d0] = __builtin_amdgcn_mfma_f32_32x32x16_bf16(pa1, PK(1), o[d0], 0, 0, 0);
        o[d0] = __builtin_amdgcn_mfma_f32_32x32x16_bf16(pa2, PK(2), o[d0], 0, 0, 0);
        o[d0] = __builtin_amdgcn_mfma_f32_32x32x16_bf16(pa3, PK(3), o[d0], 0, 0, 0);
#undef PK
    }
}
__device__ __forceinline__ void attn_issue(const Frame& F, int u, int t, int slot) {
    const int lane = F.lane, wid = F.wave; LAS unsigned char* shm = F.lds;
    const int qb = u % (SEQ / 32), bk = u / (SEQ / 32), b = bk / NKV, kvh = bk % NKV; const int q0 = qb * 32;
    const bf16* Kb = (const bf16*)(F.ws + WS_B + 128 * MiB); const bf16* Vb = (const bf16*)(F.ws + WS_B + 144 * MiB); const bf16* CKV = (const bf16*)(F.ws + WS_CTXKV);
    const size_t tok0 = (size_t)b * SEQ; const bf16* ksrc; const bf16* vsrc;
    if (t < 4) { const int c0 = b * CTXL + t * 64;
        ksrc = CKV + (size_t)(c0 + lane) * 512 + kvh * HD + wid * 8;
        vsrc = CKV + (size_t)(c0 + 16 * (wid & 3) + (lane >> 2)) * 512 + 256 + kvh * HD + (wid >> 2) * 32 + (lane & 3) * 8;
    } else { const int key0 = ((q0 - 128) & ~63) + (t - 4) * 64;
        int kr = key0 + lane; kr = kr < 0 ? 0 : (kr > SEQ - 1 ? SEQ - 1 : kr);
        int vr = key0 + 16 * (wid & 3) + (lane >> 2); vr = vr < 0 ? 0 : (vr > SEQ - 1 ? SEQ - 1 : vr);
        ksrc = Kb + (tok0 + kr) * KVD + kvh * HD + wid * 8;
        vsrc = Vb + (tok0 + vr) * KVD + kvh * HD + (wid >> 2) * 32 + (lane & 3) * 8;
    }
    __builtin_amdgcn_global_load_lds((const unsigned*)ksrc, (LAS unsigned*)(shm + LDS_K + slot * 8192 + wid * 1024), 16, 0, 0);
    __builtin_amdgcn_global_load_lds((const unsigned*)vsrc, (LAS unsigned*)(shm + LDS_V + slot * 8192 + wid * 1024), 16, 0, 0);
    if (t == 0) {
        const bf16* Qw = (const bf16*)(F.ws + WS_B) + (tok0 + q0 + (lane & 31)) * DM + (kvh * 8 + wid) * HD + (lane >> 5) * 8;
#pragma unroll
        for (int d0 = 0; d0 < 4; ++d0) __builtin_amdgcn_global_load_lds((const unsigned*)(Qw + d0 * 16), (LAS unsigned*)(shm + LDS_Q + wid * 4096 + d0 * 1024), 16, 0, 0);
    }
}
__device__ __forceinline__ void attn_phase(const Frame& F) {
    const int NU = NB * NKV * (SEQ / 32); const int per = (NU + F.G - 1) / F.G;
    const int u0 = F.bid * per; const int u1 = (u0 + per < NU) ? u0 + per : NU; if (u0 >= u1) return;
    const int ntile = (u1 - u0) * 9;
    const int lane = F.lane, r32 = lane & 31, hi = lane >> 5, wid = F.wave;
    LAS unsigned char* shm = F.lds;
    bf16* O = (bf16*)(F.ws + WS_A);
    LAS float* wsf = (LAS float*)(shm + LDS_WS) + wid * 64;
    const int vb0 = (int)(uintptr_t)(shm + LDS_V) + ((lane >> 4) & 1) * 32 + (lane & 3) * 8 + (4 * hi + ((lane & 15) >> 2)) * 64;
    bf16x8 qr[4]; float mref = 0.f, l_reg = 0.f; f32x16 o[2]; o[0] = f32x16{}; o[1] = f32x16{}; f32x16 negm = f32x16{};
    attn_issue(F, u0, 0, 0);
    if (ntile > 1) attn_issue(F, u0, 1, 1);
    int u = u0, t = 0;
    for (int g = 0; g < ntile; ++g) {
        const int slot = g % 3;
        const int qb = u % (SEQ / 32), bk = u / (SEQ / 32), b = bk / NKV, kvh = bk % NKV; const int q0 = qb * 32; const int head = kvh * 8 + wid; const size_t tok0 = (size_t)b * SEQ;
        if (g + 1 < ntile) { if (t == 8 || (t == 0 && g > 0)) asm volatile("s_waitcnt vmcnt(6)" ::: "memory"); else asm volatile("s_waitcnt vmcnt(2)" ::: "memory"); }
        else asm volatile("s_waitcnt vmcnt(0)" ::: "memory");
        LDS_WAIT(); __builtin_amdgcn_s_barrier();
        if (g + 2 < ntile) { const int g2 = g + 2; attn_issue(F, u0 + g2 / 9, g2 % 9, g2 % 3); }
        if (t == 0) {
#pragma unroll
            for (int d0 = 0; d0 < 4; ++d0) qr[d0] = *(const LAS bf16x8*)(shm + LDS_Q + wid * 4096 + d0 * 1024 + lane * 16);
            mref = 0.f; l_reg = 0.f; o[0] = f32x16{}; o[1] = f32x16{}; negm = f32x16{}; }
        f32x16 p0, p1;
        qkt(p0, p1, shm + LDS_K + slot * 8192, qr, negm, r32, hi);
        { const int key0 = ((q0 - 128) & ~63) + (t - 4) * 64;
          if (t >= 4 && (t == 4 || t == 8 || key0 < 0 || key0 + 64 > SEQ)) { const int qpos = q0 + r32;
#pragma unroll
            for (int r = 0; r < 16; ++r) { const int k0 = key0 + crow(r, hi), k1 = k0 + 32;
                const bool v0 = (k0 >= 0) && (k0 < SEQ) && (k0 - qpos <= 128) && (qpos - k0 <= 128);
                const bool v1 = (k1 >= 0) && (k1 < SEQ) && (k1 - qpos <= 128) && (qpos - k1 <= 128);
                p0[r] = v0 ? p0[r] : -INFINITY; p1[r] = v1 ? p1[r] : -INFINITY; } } }
        const float rm = rowmax(p0, p1);
        if (__any(rm > 8.f)) {
            const float dl = __builtin_fmaxf(rm, 0.f); mref += dl;
            const float f = __builtin_amdgcn_exp2f(-dl); l_reg *= f;
#pragma unroll
            for (int r = 0; r < 16; ++r) { p0[r] -= dl; p1[r] -= dl; negm[r] = -mref; }
            if (hi == 0) wsf[r32] = f;
            LDS_WAIT();
#pragma unroll
            for (int d = 0; d < 2; ++d)
#pragma unroll
                for (int r = 0; r < 16; ++r) o[d][r] *= wsf[crow(r, hi)];
        }
        float sacc = 0.f;
#pragma unroll
        for (int r = 0; r < 16; ++r) { p0[r] = __builtin_amdgcn_exp2f(p0[r]); p1[r] = __builtin_amdgcn_exp2f(p1[r]); sacc += p0[r] + p1[r]; }
        l_reg += sacc;
        u32x4 pw0, pw1, pw2, pw3;
#define PKW(P, B) cvt_pk_bf16(P[B], P[B + 1])
        pw0 = (u32x4){PKW(p0, 0), PKW(p0, 2), PKW(p0, 4), PKW(p0, 6)}; pw1 = (u32x4){PKW(p0, 8), PKW(p0, 10), PKW(p0, 12), PKW(p0, 14)};
        pw2 = (u32x4){PKW(p1, 0), PKW(p1, 2), PKW(p1, 4), PKW(p1, 6)}; pw3 = (u32x4){PKW(p1, 8), PKW(p1, 10), PKW(p1, 12), PKW(p1, 14)};
#undef PKW
        pv(o, vb0 + slot * 8192, __builtin_bit_cast(bf16x8, pw0), __builtin_bit_cast(bf16x8, pw1), __builtin_bit_cast(bf16x8, pw2), __builtin_bit_cast(bf16x8, pw3));
        if (t == 8) {
            { auto rr = __builtin_amdgcn_permlane32_swap(__float_as_uint(l_reg), __float_as_uint(l_reg), false, false); l_reg = __uint_as_float(rr[0]) + __uint_as_float(rr[1]); }
            l_reg += __builtin_amdgcn_exp2f(AIN(I_SINK)[head] * 1.4426950408889634f - mref);
            if (hi == 0) wsf[32 + r32] = l_reg;
            LDS_WAIT();
            float rli[16];
#pragma unroll
            for (int r = 0; r < 16; ++r) rli[r] = 1.f / wsf[32 + crow(r, hi)];
            bf16* Ow = O + (tok0 + q0) * DM + head * HD;
            LAS bf16* stg = (LAS bf16*)(shm + LDS_OST) + wid * 2048;
#pragma unroll
            for (int r = 0; r < 16; ++r) { const int orow = crow(r, hi);
#pragma unroll
                for (int d0 = 0; d0 < 2; ++d0) stg[orow * 64 + d0 * 32 + r32] = (bf16)(cvt_pk_bf16(o[d0][r] * rli[r], 0.f) & 0xffffu); }
            LDS_WAIT();
#pragma unroll
            for (int i = 0; i < 4; ++i) { const int row = i * 8 + (lane >> 3), ch = lane & 7; const u32x4 v = *(const LAS u32x4*)(stg + row * 64 + ch * 8); *(u32x4*)(Ow + (size_t)row * DM + ch * 8) = v; }
        }
        if (t == 8) { t = 0; ++u; } else ++t;
    }
}
}

__device__ __forceinline__ float row16_sum(float v) {
    v += __builtin_bit_cast(float, __builtin_amdgcn_update_dpp(0, __builtin_bit_cast(int, v), 0xB1, 0xf, 0xf, true));
    v += __builtin_bit_cast(float, __builtin_amdgcn_update_dpp(0, __builtin_bit_cast(int, v), 0x4E, 0xf, 0xf, true));
    v += __builtin_bit_cast(float, __builtin_amdgcn_update_dpp(0, __builtin_bit_cast(int, v), 0x141, 0xf, 0xf, true));
    v += __builtin_bit_cast(float, __builtin_amdgcn_update_dpp(0, __builtin_bit_cast(int, v), 0x140, 0xf, 0xf, true));
    return v;
}
template <int NV> __device__ __forceinline__ void block_reduce(const float (&x)[NV], LAS float* red, LAS float* tot, int tid, int lane, int wave) {
    float y[NV / 2], z[NV / 4];
#pragma unroll
    for (int i = 0; i < NV / 2; ++i) { auto r = __builtin_amdgcn_permlane32_swap(__float_as_uint(x[i]), __float_as_uint(x[i + NV / 2]), false, false); y[i] = __uint_as_float(r[0]) + __uint_as_float(r[1]); }
#pragma unroll
    for (int i = 0; i < NV / 4; ++i) { auto r = __builtin_amdgcn_permlane16_swap(__float_as_uint(y[i]), __float_as_uint(y[i + NV / 4]), false, false); z[i] = row16_sum(__uint_as_float(r[0]) + __uint_as_float(r[1])); }
    if ((lane & 15) == 0) { const int q = lane >> 4;
#pragma unroll
        for (int i = 0; i < NV / 4; ++i) red[wave * NV + i + q * (NV / 4)] = z[i]; }
    __syncthreads();
    if (tid < NV) { float s = 0.f;
#pragma unroll
        for (int w = 0; w < NWAVES; ++w) s += red[w * NV + tid];
        tot[tid] = s; }
    __syncthreads();
}
struct LnLds { LAS float* red; LAS float* tot; LAS float* sab; LAS int* lcnt; LAS int* lbase; LAS int* lcls; LAS int* lrank; LAS float* lg; LAS float* rowtab; };
__device__ __forceinline__ LnLds ln_lds(const Frame& F) { LnLds L; L.red = (LAS float*)F.lds; L.tot = L.red + 8 * 72; L.sab = L.tot + 72; L.lcnt = (LAS int*)(L.sab + 32); L.lbase = L.lcnt + 32; L.lcls = L.lbase + 32; L.lrank = L.lcls + 256; L.lg = (LAS float*)(L.lrank + 256); L.rowtab = L.lg + 512; return L; }

template <bool HIN_F32> __device__ __forceinline__ void ln1_router_phase(const Frame& F, int layer, const void* hin_, const bf16* ymix, bf16* u2out, bf16* hout) {
    const float* hin = (const float*)hin_; const bf16* hinb = (const bf16*)hin_;
    const LnLds L = ln_lds(F);
    const int tid = F.tid, lane = F.lane, wave = F.wave, c0 = 4 * tid;
    int per = (MTOK + F.G - 1) / F.G; per = (per + 3) & ~3;
    const int rbase = F.bid * per; const int rend = (rbase + per < MTOK) ? rbase + per : MTOK; const int nrows = rend - rbase;
    if (tid < NCLS) L.lcnt[tid] = 0;
    if (nrows > 0 && nrows <= 256) {
    const int b = rbase / SEQ;
    const f32x4 g1 = *(const f32x4*)(mod_ptr(F, layer, b, 2) + c0), sh2 = *(const f32x4*)(mod_ptr(F, layer, b, 3) + c0), sc2 = *(const f32x4*)(mod_ptr(F, layer, b, 4) + c0);
    const f32x4 A0 = *(const f32x4*)(AIN(I_LN1G) + layer * DM + c0), B0 = *(const f32x4*)(AIN(I_LN1B) + layer * DM + c0);
    const f32x4 A1 = A0 * (sc2 + 1.f), B1 = B0 * (sc2 + 1.f) + sh2;
    f32x4 P[4][4];
    { float sx[32];
#pragma unroll
      for (int c = 0; c < 4; ++c)
#pragma unroll
          for (int g = 0; g < 4; ++g) { const f32x4 w = *(const f32x4*)(AIN(I_RW) + (size_t)(c0 + c) * NEXP + 4 * g); P[c][g] = w * A1[c];
#pragma unroll
              for (int i = 0; i < 4; ++i) { if (c == 0) { sx[g * 4 + i] = 0.f; sx[16 + g * 4 + i] = 0.f; } sx[g * 4 + i] += w[i] * A1[c]; sx[16 + g * 4 + i] += w[i] * B1[c]; } }
      block_reduce<32>(sx, L.red, L.tot, tid, lane, wave);
      if (tid < 32) L.sab[tid] = L.tot[tid];
      __syncthreads(); }
    const float* rb = AIN(I_RB);
    f32x4 hv[4], hv2[4]; u32x2 yv[4], yv2[4];
#define LN_LOADH(dst, o) do { if (HIN_F32) dst = *(const f32x4*)(hin + (o)); else { const u32x2 hw_ = *(const u32x2*)(hinb + (o)); dst = (f32x4){bflo(hw_.x), bfhi(hw_.x), bflo(hw_.y), bfhi(hw_.y)}; } } while (0)
#pragma unroll
    for (int r = 0; r < 4; ++r) { const size_t o = (size_t)(rbase + r) * DM + c0; LN_LOADH(hv[r], o); yv[r] = *(const u32x2*)(ymix + o); }
    if (rbase + 4 < rend) {
#pragma unroll
        for (int r = 0; r < 4; ++r) { const size_t o = (size_t)(rbase + 4 + r) * DM + c0; LN_LOADH(hv2[r], o); yv2[r] = *(const u32x2*)(ymix + o); } }
    for (int row0 = rbase; row0 < rend; row0 += 4) {
        f32x4 v[4]; float x[72];
#pragma unroll
        for (int r = 0; r < 4; ++r) { const f32x4 y = {bflo(yv[r].x), bfhi(yv[r].x), bflo(yv[r].y), bfhi(yv[r].y)}; v[r] = hv[r] * DN_ALPHA + g1 * y;
            x[r * 18] = (v[r][0] + v[r][1]) + (v[r][2] + v[r][3]); x[r * 18 + 1] = (v[r][0] * v[r][0] + v[r][1] * v[r][1]) + (v[r][2] * v[r][2] + v[r][3] * v[r][3]);
#pragma unroll
            for (int g = 0; g < 4; ++g) { const f32x4 q = P[0][g] * v[r][0] + P[1][g] * v[r][1] + P[2][g] * v[r][2] + P[3][g] * v[r][3];
                x[r * 18 + 2 + 4 * g] = q[0]; x[r * 18 + 3 + 4 * g] = q[1]; x[r * 18 + 4 + 4 * g] = q[2]; x[r * 18 + 5 + 4 * g] = q[3]; } }
#pragma unroll
        for (int r = 0; r < 4; ++r) { hv[r] = hv2[r]; yv[r] = yv2[r]; }
        if (row0 + 8 < rend) {
#pragma unroll
            for (int r = 0; r < 4; ++r) { const size_t o = (size_t)(row0 + 8 + r) * DM + c0; LN_LOADH(hv2[r], o); yv2[r] = *(const u32x2*)(ymix + o); } }
        LAS float* gt = L.rowtab + ((row0 - rbase) >> 2) * 72;
        block_reduce<72>(x, L.red, gt, tid, lane, wave);
#pragma unroll
        for (int r = 0; r < 4; ++r) { const float mean = gt[r * 18] * (1.f / DM); const float var = gt[r * 18 + 1] * (1.f / DM) - mean * mean; const float rstd = 1.f / sqrtf(var + LN_EPS);
            const f32x4 vn = (v[r] - mean) * rstd; const f32x4 hn = vn * A0 + B0, u = vn * A1 + B1; const size_t o = (size_t)(row0 + r) * DM + c0;
            u32x2 hw; hw.x = cvt_pk_bf16(hn[0], hn[1]); hw.y = cvt_pk_bf16(hn[2], hn[3]); *(u32x2*)(hout + o) = hw; u32x2 w; w.x = cvt_pk_bf16(u[0], u[1]); w.y = cvt_pk_bf16(u[2], u[3]); *(u32x2*)(u2out + o) = w; }
    }
    __syncthreads();
    if (tid < nrows) {
            const int rl = tid; const LAS float* gt = L.rowtab + (rl >> 2) * 72 + (rl & 3) * 18;
            const float mean = gt[0] * (1.f / DM); const float var = gt[1] * (1.f / DM) - mean * mean; const float rstd = 1.f / sqrtf(var + LN_EPS);
            float sg[16], sel[16];
#pragma unroll
            for (int e = 0; e < 16; ++e) { const float lgt = rstd * (gt[2 + e] - mean * L.sab[e]) + L.sab[16 + e]; const float sv = 1.f / (1.f + expf(-lgt)); sg[e] = sv; sel[e] = sv + rb[e]; }
            int gb = 0; float gbs = -INFINITY;
#pragma unroll
            for (int g = 0; g < 4; ++g) { const float a = sel[4 * g], bq = sel[4 * g + 1], c = sel[4 * g + 2], d = sel[4 * g + 3];
                const float ps = fmaxf(fmaxf(fmaxf(a + bq, a + c), fmaxf(a + d, bq + c)), fmaxf(bq + d, c + d)); if (ps > gbs) { gbs = ps; gb = g; } }
            float cs[4], cg[4];
#pragma unroll
            for (int i = 0; i < 4; ++i) { cs[i] = sel[i]; cg[i] = sg[i];
#pragma unroll
                for (int g = 1; g < 4; ++g) if (gb == g) { cs[i] = sel[4 * g + i]; cg[i] = sg[4 * g + i]; } }
            int i0 = 0; float b0 = cs[0];
#pragma unroll
            for (int i = 1; i < 4; ++i) if (cs[i] > b0) { b0 = cs[i]; i0 = i; }
            int i1 = -1; float b1 = -INFINITY;
#pragma unroll
            for (int i = 0; i < 4; ++i) if (i != i0 && cs[i] > b1) { b1 = cs[i]; i1 = i; }
            float ga = 0.f, gbv = 0.f;
#pragma unroll
            for (int i = 0; i < 4; ++i) { if (i == i0) ga = cg[i]; if (i == i1) gbv = cg[i]; }
            const float den = ga + gbv; ga /= den; gbv /= den;
            const int lo = i0 < i1 ? i0 : i1, hi = i0 < i1 ? i1 : i0; const float glo = i0 < i1 ? ga : gbv, ghi = i0 < i1 ? gbv : ga;
            const int pidx = (lo == 0) ? (hi - 1) : (lo == 1 ? hi + 1 : 5);
            const int cls = gb * 6 + pidx;
            L.lcls[rl] = cls; L.lrank[rl] = __hip_atomic_fetch_add(&L.lcnt[cls], 1, __ATOMIC_RELAXED, __HIP_MEMORY_SCOPE_WORKGROUP); L.lg[2 * rl] = glo; L.lg[2 * rl + 1] = ghi;
    }
    }
    __syncthreads();
    if (tid < NCLS) L.lbase[tid] = (int)__hip_atomic_fetch_add((unsigned*)(F.ctl + CW_CNT + (layer * NCLS + tid) * 64), (unsigned)L.lcnt[tid], RLX_AGENT);
    __syncthreads();
    if (tid < nrows && nrows <= 256) { const int cls = L.lcls[tid]; const int pos = cls * LCAP + L.lbase[cls] + L.lrank[tid];
        ((int*)(F.ws + WS_TOK))[pos] = rbase + tid; ((float*)(F.ws + WS_GATE))[pos] = L.lg[2 * tid]; ((float*)(F.ws + WS_GATE))[(size_t)NCLS * LCAP + pos] = L.lg[2 * tid + 1]; }
}
#undef LN_LOADH
template <bool OUT_F32> __device__ __forceinline__ void ln2_phase(const Frame& F, int layer, bf16* fio, const bf16* hinb, void* hout_) {
    float* houtf = (float*)hout_; bf16* houtb = (bf16*)hout_;
    const LnLds L = ln_lds(F);
    const int tid = F.tid, lane = F.lane, wave = F.wave, c0 = 4 * tid;
    int per = (MTOK + F.G - 1) / F.G; per = (per + 3) & ~3;
    const int rbase = F.bid * per; const int rend = (rbase + per < MTOK) ? rbase + per : MTOK;
    if (rbase >= rend) return;
    const int b = rbase / SEQ;
    const f32x4 g2 = *(const f32x4*)(mod_ptr(F, layer, b, 5) + c0), sh1 = *(const f32x4*)(mod_ptr(F, 1, b, 0) + c0), sc1 = *(const f32x4*)(mod_ptr(F, 1, b, 1) + c0);
    const f32x4 A0 = *(const f32x4*)(AIN(I_LN2G) + layer * DM + c0), B0 = *(const f32x4*)(AIN(I_LN2B) + layer * DM + c0);
    const f32x4 A1 = A0 * (sc1 + 1.f), B1 = B0 * (sc1 + 1.f) + sh1;
    u32x2 hw[4], hw2[4], hw3[4]; u32x2 yv[4], yv2[4], yv3[4];
#pragma unroll
    for (int r = 0; r < 4; ++r) { const size_t o = (size_t)(rbase + r) * DM + c0; hw[r] = *(const u32x2*)(hinb + o); yv[r] = *(const u32x2*)(fio + o); }
#pragma unroll
    for (int r = 0; r < 4; ++r) { const size_t o = (size_t)(rbase + 4 + r) * DM + c0; if (rbase + 4 < rend) { hw2[r] = *(const u32x2*)(hinb + o); yv2[r] = *(const u32x2*)(fio + o); } }
#pragma unroll
    for (int r = 0; r < 4; ++r) { const size_t o = (size_t)(rbase + 8 + r) * DM + c0; if (rbase + 8 < rend) { hw3[r] = *(const u32x2*)(hinb + o); yv3[r] = *(const u32x2*)(fio + o); } }
    for (int row0 = rbase; row0 < rend; row0 += 4) {
        f32x4 v[4]; float x[8];
#pragma unroll
        for (int r = 0; r < 4; ++r) { const f32x4 y = {bflo(yv[r].x), bfhi(yv[r].x), bflo(yv[r].y), bfhi(yv[r].y)}; const f32x4 hvr = {bflo(hw[r].x), bfhi(hw[r].x), bflo(hw[r].y), bfhi(hw[r].y)}; v[r] = hvr * DN_ALPHA + g2 * y;
            x[r * 2] = (v[r][0] + v[r][1]) + (v[r][2] + v[r][3]); x[r * 2 + 1] = (v[r][0] * v[r][0] + v[r][1] * v[r][1]) + (v[r][2] * v[r][2] + v[r][3] * v[r][3]); }
#pragma unroll
        for (int r = 0; r < 4; ++r) { hw[r] = hw2[r]; yv[r] = yv2[r]; hw2[r] = hw3[r]; yv2[r] = yv3[r]; }
        if (row0 + 12 < rend) {
#pragma unroll
            for (int r = 0; r < 4; ++r) { const size_t o = (size_t)(row0 + 12 + r) * DM + c0; hw3[r] = *(const u32x2*)(hinb + o); yv3[r] = *(const u32x2*)(fio + o); } }
        block_reduce<8>(x, L.red, L.tot, tid, lane, wave);
#pragma unroll
        for (int r = 0; r < 4; ++r) { const float mean = L.tot[r * 2] * (1.f / DM); const float var = L.tot[r * 2 + 1] * (1.f / DM) - mean * mean; const float rstd = 1.f / sqrtf(var + LN_EPS);
            const f32x4 vn = (v[r] - mean) * rstd; const f32x4 hn = vn * A0 + B0; const size_t o = (size_t)(row0 + r) * DM + c0;
            if (OUT_F32) *(f32x4*)(houtf + o) = hn; else { u32x2 hw; hw.x = cvt_pk_bf16(hn[0], hn[1]); hw.y = cvt_pk_bf16(hn[2], hn[3]); *(u32x2*)(houtb + o) = hw; }
            if (layer == 0) { const f32x4 u = vn * A1 + B1; u32x2 w; w.x = cvt_pk_bf16(u[0], u[1]); w.y = cvt_pk_bf16(u[2], u[3]); *(u32x2*)(fio + o) = w; } }
    }
}
namespace hy {
constexpr int L = SEQ;
__device__ constexpr float C32[16] = {1.000000000e+00f, 9.807852804e-01f, 9.238795325e-01f, 8.314696123e-01f, 7.071067812e-01f, 5.555702330e-01f, 3.826834324e-01f, 1.950903220e-01f,
                                      0.f, -1.950903220e-01f, -3.826834324e-01f, -5.555702330e-01f, -7.071067812e-01f, -8.314696123e-01f, -9.238795325e-01f, -9.807852804e-01f};
__device__ constexpr float S32[16] = {0.f, 1.950903220e-01f, 3.826834324e-01f, 5.555702330e-01f, 7.071067812e-01f, 8.314696123e-01f, 9.238795325e-01f, 9.807852804e-01f,
                                      1.f, 9.807852804e-01f, 9.238795325e-01f, 8.314696123e-01f, 7.071067812e-01f, 5.555702330e-01f, 3.826834324e-01f, 1.950903220e-01f};
__host__ __device__ constexpr int brev(int k, int bits) { int r = 0; for (int i = 0; i < bits; ++i) r |= ((k >> i) & 1) << (bits - 1 - i); return r; }
__device__ __forceinline__ void unit_root(float frac, bool inv, float& wr, float& wi) {
    wr = __builtin_amdgcn_cosf(frac); float s = __builtin_amdgcn_sinf(frac);
    asm volatile("s_nop 1" : "+v"(wr), "+v"(s));
    wi = inv ? s : -s;
}
constexpr int FT_F32 = 0, FT_I32 = 8, FT_I32P = 16, FT_F16 = 24, FT_I16 = 26, FT_NFRAG = 28;
__device__ __forceinline__ int crow(int r, int h) { return (r & 3) + 8 * (r >> 2) + 4 * h; }
__device__ __forceinline__ bf16x8 pack8(const float (&v)[8]) { u32x4 w; w.x = cvt_pk_bf16(v[0], v[1]); w.y = cvt_pk_bf16(v[2], v[3]); w.z = cvt_pk_bf16(v[4], v[5]); w.w = cvt_pk_bf16(v[6], v[7]); return __builtin_bit_cast(bf16x8, w); }
__device__ __forceinline__ void cmul(float& xr, float& xi, float wr, float wi) {
    float t0, t1, nr, ni;
    asm("v_mul_f32_e32 %0, %1, %2" : "=v"(t0) : "v"(xi), "v"(wi));
    asm("v_mul_f32_e32 %0, %1, %2" : "=v"(t1) : "v"(xi), "v"(wr));
    asm("v_fma_f32 %0, %1, %2, -%3" : "=v"(nr) : "v"(xr), "v"(wr), "v"(t0));
    asm("v_fma_f32 %0, %1, %2, %3" : "=v"(ni) : "v"(xr), "v"(wi), "v"(t1));
    xr = nr; xi = ni;
}
#define FRAG(f) (tab[(f) * 64 + lane])
template <bool INV> __device__ __forceinline__ void pass1(LAS f32x2* dat, const LAS bf16x8* tab, int lane, int wave) {
    asm volatile("" : "+v"(lane));
    const int h = lane >> 5, c5 = lane & 31;
    const bf16x8 a0 = FRAG((INV ? FT_I16 : FT_F16) + 0), a1 = FRAG((INV ? FT_I16 : FT_F16) + 1);
#pragma unroll 1
    for (int g = 0; g < 4; ++g) {
        const int col = 128 * wave + 32 * g + c5; const int pc = col ^ ((4 * wave + g) & 31) ^ ((2 * g + (c5 >> 4)) & 7);
        float wr, wi; unit_root((float)col * (1.f / 16384.f), INV, wr, wi);
        float w2r = wr, w2i = wi; cmul(w2r, w2i, wr, wi); float w4r = w2r, w4i = w2i; cmul(w4r, w4i, w2r, w2i); float w8r = w4r, w8i = w4i; cmul(w8r, w8i, w4r, w4i);
        float re[8], im[8];
#pragma unroll
        for (int jj = 0; jj < 8; ++jj) { const f32x2 v = dat[pc + 1024 * (8 * h + jj)]; re[jj] = v.x; im[jj] = v.y; }
        if (INV) {
            float cr = h ? w8r : 1.f, ci = h ? w8i : 0.f;
#pragma unroll
            for (int jj = 0; jj < 8; ++jj) { cmul(re[jj], im[jj], cr, ci); cmul(cr, ci, wr, wi); }
        }
        const f32x16 z = {};
        f32x16 d = __builtin_amdgcn_mfma_f32_32x32x16_bf16(a0, pack8(re), z, 0, 0, 0);
        d = __builtin_amdgcn_mfma_f32_32x32x16_bf16(a1, pack8(im), d, 0, 0, 0);
        asm volatile("s_nop 15\n\ts_nop 7" : "+v"(d));
        float cr = h ? w4r : 1.f, ci = h ? w4i : 0.f;
#pragma unroll
        for (int rr = 0; rr < 8; ++rr) { float xr = d[rr], xi = d[rr + 8];
            if (!INV) { if (rr == 4) { cr = h ? w4r : 1.f; ci = h ? w4i : 0.f; cmul(cr, ci, w8r, w8i); } cmul(xr, xi, cr, ci); cmul(cr, ci, wr, wi); }
            f32x2 o; o.x = xr; o.y = xi; dat[pc + 1024 * ((rr & 3) + 8 * (rr >> 2) + 4 * h)] = o; }
    }
}
template <bool INV> __device__ __forceinline__ void pass2(LAS f32x2* dat, const LAS bf16x8* tab, int lane, int wave) {
    asm volatile("" : "+v"(lane));
    const int h = lane >> 5, b = lane & 31, bp = b ^ (b >> 4);
    float wr, wi; unit_root((float)b * (1.f / 1024.f), INV, wr, wi);
    float w2r = wr, w2i = wi; cmul(w2r, w2i, wr, wi); float w4r = w2r, w4i = w2i; cmul(w4r, w4i, w2r, w2i); float w8r = w4r, w8i = w4i; cmul(w8r, w8i, w4r, w4i); float w16r = w8r, w16i = w8i; cmul(w16r, w16i, w8r, w8i);
#pragma unroll 1
    for (int g = 0; g < 2; ++g) {
        const int base = (2 * wave + g) * 1024;
        float re[2][8], im[2][8];
#pragma unroll
        for (int hf = 0; hf < 2; ++hf)
#pragma unroll
            for (int jj = 0; jj < 8; ++jj) { const int n = 16 * hf + 8 * h + jj; const f32x2 v = dat[base + 32 * n + (bp ^ (16 * hf + 8 * h + (jj ^ ((2 * jj) & 7))))]; re[hf][jj] = v.x; im[hf][jj] = v.y; }
        if (INV) {
            float cr = h ? w8r : 1.f, ci = h ? w8i : 0.f;
#pragma unroll
            for (int jj = 0; jj < 8; ++jj) { cmul(re[0][jj], im[0][jj], cr, ci); float dr = cr, di = ci; cmul(dr, di, w16r, w16i); cmul(re[1][jj], im[1][jj], dr, di); cmul(cr, ci, wr, wi); }
        }
        const bf16x8 b0 = pack8(re[0]), b1 = pack8(re[1]), b2 = pack8(im[0]), b3 = pack8(im[1]);
        const int fb = INV ? FT_I32 : FT_F32; const f32x16 z = {};
        f32x16 dre = __builtin_amdgcn_mfma_f32_32x32x16_bf16(FRAG(fb + 0), b0, z, 0, 0, 0); f32x16 dim = __builtin_amdgcn_mfma_f32_32x32x16_bf16(FRAG(fb + 4), b0, z, 0, 0, 0);
        dre = __builtin_amdgcn_mfma_f32_32x32x16_bf16(FRAG(fb + 1), b1, dre, 0, 0, 0); dim = __builtin_amdgcn_mfma_f32_32x32x16_bf16(FRAG(fb + 5), b1, dim, 0, 0, 0);
        dre = __builtin_amdgcn_mfma_f32_32x32x16_bf16(FRAG(fb + 2), b2, dre, 0, 0, 0); dim = __builtin_amdgcn_mfma_f32_32x32x16_bf16(FRAG(fb + 6), b2, dim, 0, 0, 0);
        dre = __builtin_amdgcn_mfma_f32_32x32x16_bf16(FRAG(fb + 3), b3, dre, 0, 0, 0); dim = __builtin_amdgcn_mfma_f32_32x32x16_bf16(FRAG(fb + 7), b3, dim, 0, 0, 0);
        asm volatile("s_nop 15\n\ts_nop 7" : "+v"(dre), "+v"(dim));
        float gr = h ? w4r : 1.f, gi = h ? w4i : 0.f;
#pragma unroll
        for (int r = 0; r < 16; ++r) { float xr = dre[r], xi = dim[r]; const int kf = (r & 3) + 8 * (r >> 2) + 4 * h;
            if (!INV) { float cr = gr, ci = gi; if ((r & 3) == 1) cmul(cr, ci, wr, wi); if ((r & 3) == 2) cmul(cr, ci, w2r, w2i); if ((r & 3) == 3) { cmul(cr, ci, w2r, w2i); cmul(cr, ci, wr, wi); }
                cmul(xr, xi, cr, ci); if ((r & 3) == 3) cmul(gr, gi, w8r, w8i); }
            f32x2 o; o.x = xr; o.y = xi; dat[base + 32 * kf + (bp ^ kf ^ (2 * (r & 3)))] = o; }
    }
}
template <bool FILTER> __device__ __forceinline__ void pass3(LAS f32x2* dat, const LAS bf16x8* tab, int lane, int wave, const int g, f32x2* Kbuf, const f32x2 (&kpre)[16]) {
    asm volatile("" : "+v"(lane));
    const int h = lane >> 5, sw = lane & 31, swp = sw ^ (2 * (sw & 3));
    {
        const int q = 64 * wave + 32 * g + sw, base = 32 * q;
        float re[2][8], im[2][8];
#pragma unroll
        for (int hf = 0; hf < 2; ++hf)
#pragma unroll
            for (int jj = 0; jj < 8; ++jj) { const int n = 16 * hf + 8 * h + jj; const f32x2 v = dat[base + (n ^ swp ^ hf)]; re[hf][jj] = v.x; im[hf][jj] = v.y; }
        const bf16x8 b0 = pack8(re[0]), b1 = pack8(re[1]), b2 = pack8(im[0]), b3 = pack8(im[1]);
        const f32x16 z = {};
        f32x16 dre = __builtin_amdgcn_mfma_f32_32x32x16_bf16(FRAG(FT_F32 + 0), b0, z, 0, 0, 0); f32x16 dim = __builtin_amdgcn_mfma_f32_32x32x16_bf16(FRAG(FT_F32 + 4), b0, z, 0, 0, 0);
        dre = __builtin_amdgcn_mfma_f32_32x32x16_bf16(FRAG(FT_F32 + 1), b1, dre, 0, 0, 0); dim = __builtin_amdgcn_mfma_f32_32x32x16_bf16(FRAG(FT_F32 + 5), b1, dim, 0, 0, 0);
        dre = __builtin_amdgcn_mfma_f32_32x32x16_bf16(FRAG(FT_F32 + 2), b2, dre, 0, 0, 0); dim = __builtin_amdgcn_mfma_f32_32x32x16_bf16(FRAG(FT_F32 + 6), b2, dim, 0, 0, 0);
        dre = __builtin_amdgcn_mfma_f32_32x32x16_bf16(FRAG(FT_F32 + 3), b3, dre, 0, 0, 0); dim = __builtin_amdgcn_mfma_f32_32x32x16_bf16(FRAG(FT_F32 + 7), b3, dim, 0, 0, 0);
        asm volatile("s_nop 15\n\ts_nop 7" : "+v"(dre), "+v"(dim));
        if (FILTER) {
#pragma unroll
            for (int r = 0; r < 16; ++r) { f32x2 o; o.x = dre[r]; o.y = dim[r]; Kbuf[((r & 3) + 8 * (r >> 2) + 4 * h) * 512 + q] = o; }
        } else {
            float yr[16], yi[16];
#pragma unroll
            for (int r = 0; r < 16; ++r) { const f32x2 kv = kpre[r]; float a_ = dre[r], b_ = dim[r]; cmul(a_, b_, kv.x, kv.y); yr[r] = a_; yi[r] = b_; }
            float t0[8], t1[8], t2[8], t3[8];
#pragma unroll
            for (int j = 0; j < 8; ++j) { t0[j] = yr[j]; t1[j] = yr[8 + j]; t2[j] = yi[j]; t3[j] = yi[8 + j]; }
            const bf16x8 c0 = pack8(t0), c1 = pack8(t1), c2 = pack8(t2), c3 = pack8(t3);
            f32x16 ere = __builtin_amdgcn_mfma_f32_32x32x16_bf16(FRAG(FT_I32P + 0), c0, z, 0, 0, 0); f32x16 eim = __builtin_amdgcn_mfma_f32_32x32x16_bf16(FRAG(FT_I32P + 4), c0, z, 0, 0, 0);
            ere = __builtin_amdgcn_mfma_f32_32x32x16_bf16(FRAG(FT_I32P + 1), c1, ere, 0, 0, 0); eim = __builtin_amdgcn_mfma_f32_32x32x16_bf16(FRAG(FT_I32P + 5), c1, eim, 0, 0, 0);
            ere = __builtin_amdgcn_mfma_f32_32x32x16_bf16(FRAG(FT_I32P + 2), c2, ere, 0, 0, 0); eim = __builtin_amdgcn_mfma_f32_32x32x16_bf16(FRAG(FT_I32P + 6), c2, eim, 0, 0, 0);
            ere = __builtin_amdgcn_mfma_f32_32x32x16_bf16(FRAG(FT_I32P + 3), c3, ere, 0, 0, 0); eim = __builtin_amdgcn_mfma_f32_32x32x16_bf16(FRAG(FT_I32P + 7), c3, eim, 0, 0, 0);
#pragma unroll
            for (int r = 0; r < 16; ++r) { f32x2 o; o.x = ere[r]; o.y = eim[r]; dat[base + ((((r & 3) + 8 * (r >> 2) + 4 * h)) ^ swp ^ (r >> 3))] = o; }
        }
    }
}
#undef FRAG
__device__ __forceinline__ float ftab_value(int f, int l, int jj) {
    const int r = l & 31, h = l >> 5;
    if (f < 24) {
        const int kind = f >> 3, rb = (f >> 2) & 1, s = f & 3; int kk, pp;
        if (kind < 2) { kk = 16 * (s & 1) + 8 * h + jj; pp = s >> 1; } else { kk = 16 * (s & 1) + 8 * (jj >> 2) + 4 * h + (jj & 3); pp = s >> 1; }
        const float th = 6.283185307179586f * (float)((r * kk) & 31) * (1.f / 32.f); const float c = cosf(th), sn = sinf(th);
        if (kind == 0) return rb == 0 ? (pp == 0 ? c : sn) : (pp == 0 ? -sn : c);
        return rb == 0 ? (pp == 0 ? c : -sn) : (pp == 0 ? sn : c);
    }
    const int inv = (f - 24) >> 1, s = (f - 24) & 1; const int part = r >> 4, kf = r & 15, n = 8 * h + jj;
    const float th = 6.283185307179586f * (float)((kf * n) & 15) * (1.f / 16.f); const float c = cosf(th), sn = sinf(th);
    if (!inv) return part == 0 ? (s == 0 ? c : sn) : (s == 0 ? -sn : c);
    return part == 0 ? (s == 0 ? c : -sn) : (s == 0 ? sn : c);
}
__device__ __forceinline__ int phys(int p) { return p ^ ((p >> 5) & 31) ^ ((p >> 4) & 7); }
__device__ __forceinline__ void unpack8(const u32x4 v, float (&f)[8]) { f[0] = bflo(v.x); f[1] = bfhi(v.x); f[2] = bflo(v.y); f[3] = bfhi(v.y); f[4] = bflo(v.z); f[5] = bfhi(v.z); f[6] = bflo(v.w); f[7] = bfhi(v.w); }
struct Raw8 { u32x4 v; unsigned l, r; };
__device__ __forceinline__ Raw8 load_raw8(const bf16* rowp, int t0) { Raw8 q; q.v = *(const u32x4*)(rowp + t0); q.l = (t0 > 0) ? (unsigned)rowp[t0 - 1] : 0u; q.r = (t0 + 8 < L) ? (unsigned)rowp[t0 + 8] : 0u; return q; }
__device__ __forceinline__ void conv8(const Raw8& q, float w0, float w1, float w2, float cb, float (&o)[8]) {
    float f[8]; unpack8(q.v, f); const float left = bf2f(q.l), right = bf2f(q.r);
#pragma unroll
    for (int e = 0; e < 8; ++e) { const float a = (e == 0) ? left : f[e - 1], c = (e == 7) ? right : f[e + 1]; o[e] = w0 * a + w1 * f[e] + w2 * c + cb; }
}
typedef const LAS float* ChanPar;
struct RawZ { Raw8 x[2], v[2]; };
__device__ __forceinline__ RawZ load_rawz(const bf16* pT, int d, int t0) { RawZ q;
#pragma unroll
    for (int bt = 0; bt < 2; ++bt) { q.x[bt] = load_raw8(pT + (size_t)(DM + d) * MTOK + bt * L, t0); q.v[bt] = load_raw8(pT + (size_t)(2 * DM + d) * MTOK + bt * L, t0); }
    return q; }
__device__ __forceinline__ void z_from_raw(const RawZ& q, ChanPar P, float (&z0)[8], float (&z1)[8]) {
#pragma unroll
    for (int bt = 0; bt < 2; ++bt) { float a[8], v[8];
        conv8(q.x[bt], P[4], P[5], P[6], P[7], a); conv8(q.v[bt], P[8], P[9], P[10], P[11], v);
#pragma unroll
        for (int e = 0; e < 8; ++e) { if (bt == 0) z0[e] = a[e] * v[e]; else z1[e] = a[e] * v[e]; } }
}
struct RawF { u32x4 hf, hb; unsigned first; };
__device__ __forceinline__ RawF load_rawf(const bf16* HT, int d, int t0) { RawF q; q.hf = *(const u32x4*)(HT + (size_t)d * L + t0); q.hb = *(const u32x4*)(HT + (size_t)(DM + d) * L + (L - t0 - 8));
    q.first = (t0 > 0) ? (unsigned)HT[(size_t)(DM + d) * L + (L - t0)] : 0u; return q; }
__device__ __forceinline__ void filt8(const RawF& q, int t0, ChanPar P, float (&k)[8], float (&kl)[8], float& l1p) {
    float hf[8], hb[8]; unpack8(q.hf, hf); unpack8(q.hb, hb);
    float s = 0.f;
#pragma unroll
    for (int e = 0; e < 8; ++e) { const float dc = __builtin_amdgcn_exp2f(-(float)(t0 + e) * P[13]); k[e] = hf[e] * dc; s += fabsf(k[e]); }
    float hbd[8];
#pragma unroll
    for (int e = 0; e < 8; ++e) { const int m = L - t0 - 8 + e; const float dc = __builtin_amdgcn_exp2f(-(float)m * P[13]); hbd[e] = hb[e] * dc; if (m >= 1) s += fabsf(hbd[e]); }
    kl[0] = (t0 > 0) ? bf2f(q.first) * __builtin_amdgcn_exp2f(-(float)(L - t0) * P[13]) : 0.f;
#pragma unroll
    for (int e = 1; e < 8; ++e) kl[e] = hbd[8 - e];
#pragma unroll
    for (int e = 0; e < 8; ++e) { k[e] *= P[14]; kl[e] *= P[14]; }
    l1p = s;
}
__device__ __forceinline__ void hyena_phase(const Frame& F) {
    LAS f32x2* dat = (LAS f32x2*)F.lds; LAS float* redu = (LAS float*)(F.lds + RING_BYTES);
    const bf16* pT = (const bf16*)(F.ws + WS_B); const bf16* HT = (const bf16*)(F.ws + WS_HT); bf16* yT = (bf16*)(F.ws + WS_A);
    const LAS bf16x8* tab = (const LAS bf16x8*)(F.lds + FTAB_OFF);
    for (int i = F.tid; i < FT_NFRAG * 64; i += NTHR) ((LAS u32x4*)(F.lds + FTAB_OFF))[i] = ((const u32x4*)(F.ws + WS_FTAB))[i];
    __syncthreads();
    f32x2* Ke = (f32x2*)(F.ws + WS_FFTS) + (size_t)F.bid * 49152; f32x2* Ko = Ke + 16384; f32x2* SeB = Ke + 32768;
    RawF rf[4];
    { const int tq = fresh_tid(F.wave); if (F.bid < DM) {
#pragma unroll
        for (int sI = 0; sI < 4; ++sI) rf[sI] = load_rawf((const bf16*)(F.ws + WS_HT), F.bid, 8 * (tq + 512 * sI)); } }
    const int cv_gw = F.bid * NWAVES + F.wave, cv_ngw = F.G * NWAVES; int cv_it = cv_gw; constexpr int CV_NIT = 48 * 1024;
    for (int d = F.bid; d < DM; d += F.G) {
        int tid = fresh_tid(F.wave);
        TPS_START(1);
        LAS float* PW = (LAS float*)(F.lds + RING_BYTES + 64); ChanPar P = PW;
        __syncthreads();
        if (tid < 12) { const int i = tid & 3, pj = tid >> 2; PW[tid] = (i < 3) ? AIN(I_HCW)[i * 3 * DM + pj * DM + d] : AIN(I_HCB)[pj * DM + d]; }
        if (tid == 12) PW[12] = AIN(I_FBIAS)[d];
        if (tid == 13) { const float mind = -4.605170185988091f / 1.5f, maxd = -4.605170185988091f / 0.3f; const float delta = fabsf(mind + (maxd - mind) * ((float)d / (float)(DM - 1)));
            PW[13] = delta * (1.f / (float)(L - 1)) * 1.4426950408889634f; PW[14] = 1.f; }
        __syncthreads();
        TPS_STOP(1); TPS_START(2);
#pragma unroll 1
        for (int odd = 0; odd < 2; ++odd) {
            asm volatile("" : "+v"(tid));
            float l1s = 0.f;
#pragma unroll
            for (int sI = 0; sI < 4; ++sI) { const int t0 = 8 * (tid + 512 * sI); float k[8], kl[8], l1p; filt8(rf[sI], t0, P, k, kl, l1p); l1s += l1p;
#pragma unroll
                for (int e = 0; e < 8; ++e) { f32x2 o; if (!odd) { o.x = k[e] + kl[e]; o.y = 0.f; } else { const float a = k[e] - kl[e]; float wr, wi; unit_root((float)(t0 + e) * (1.f / 32768.f), false, wr, wi); o.x = a * wr; o.y = a * wi; }
                    dat[phys(t0 + e)] = o; } }
            if (!odd) { l1s = wave_sum(l1s); if (F.lane == 0) redu[F.wave] = l1s; }
            __syncthreads();
            if (!odd && tid == 0) { float tot = 0.f;
#pragma unroll
                for (int w = 0; w < NWAVES; ++w) tot += redu[w];
                PW[15] = 1.f / tot; }
            pass1<false>(dat, tab, F.lane, F.wave); __syncthreads(); pass2<false>(dat, tab, F.lane, F.wave); { f32x2 kdummy[16]; pass3<true>(dat, tab, F.lane, F.wave, 0, odd ? Ko : Ke, kdummy); asm volatile("" ::: "memory"); pass3<true>(dat, tab, F.lane, F.wave, 1, odd ? Ko : Ke, kdummy); } __syncthreads();
        }
        TPS_STOP(2); TPS_START(3);
        unsigned zp[4][8];
        const bool cvb3 = (cv_it + 2 * cv_ngw < CV_NIT);
        const ConvItem ia = moe_l1_item(F, cvb3 ? cv_it : 0), ib = moe_l1_item(F, cvb3 ? cv_it + cv_ngw : 0), ic = moe_l1_item(F, cvb3 ? cv_it + 2 * cv_ngw : 0);
#pragma unroll
        for (int odd = 0; odd < 2; ++odd) {
            asm volatile("" : "+v"(tid));
            TPS_START(6);
            if (!odd) {
                RawZ rz[4];
#pragma unroll
                for (int sI = 0; sI < 4; ++sI) rz[sI] = load_rawz(pT, d, 8 * (tid + 512 * sI));
#pragma unroll
                for (int sI = 0; sI < 4; ++sI) { const int t0 = 8 * (tid + 512 * sI); float z0[8], z1[8]; z_from_raw(rz[sI], P, z0, z1);
#pragma unroll
                    for (int e = 0; e < 8; ++e) { f32x2 o; o.x = z0[e]; o.y = z1[e]; zp[sI][e] = cvt_pk_bf16(z0[e], z1[e]); dat[phys(t0 + e)] = o; } }
            } else {
#pragma unroll
                for (int sI = 0; sI < 4; ++sI) { const int t0 = 8 * (tid + 512 * sI);
#pragma unroll
                    for (int e = 0; e < 8; ++e) { const float z0 = bflo(zp[sI][e]), z1 = bfhi(zp[sI][e]); float wr, wi; unit_root((float)(t0 + e) * (1.f / 32768.f), false, wr, wi);
                        f32x2 o; o.x = z0 * wr - z1 * wi; o.y = z0 * wi + z1 * wr; dat[phys(t0 + e)] = o; } }
            }
#ifdef FFT_EXTRA
#pragma unroll 1
            for (int xr = 0; xr < FFT_EXTRA; ++xr) { __syncthreads(); pass2<false>(dat, tab, F.lane, F.wave); __syncthreads(); pass2<true>(dat, tab, F.lane, F.wave); __syncthreads();
#pragma unroll 1
                for (int i = fresh_tid(F.wave); i < L; i += NTHR) { f32x2 v = dat[i]; v.x *= (1.f / 32.f); v.y *= (1.f / 32.f); dat[i] = v; } }
            tid = fresh_tid(F.wave);
#endif
            TPS_STOP(6); TPS_START(5);
            f32x2 kpre0[16], kpre1[16];
            asm volatile("" ::: "memory");
            { const f32x2* Kb = odd ? Ko : Ke; int ln_ = F.lane; asm volatile("" : "+v"(ln_)); const int lq = ln_ & 31, lh = ln_ >> 5; const float il1 = P[15], fb = P[12];
#pragma unroll
              for (int r = 0; r < 16; ++r) { f32x2 k0 = Kb[((r & 3) + 8 * (r >> 2) + 4 * lh) * 512 + 64 * F.wave + lq], k1 = Kb[((r & 3) + 8 * (r >> 2) + 4 * lh) * 512 + 64 * F.wave + 32 + lq];
                  k0.x = k0.x * il1 + fb; k0.y *= il1; k1.x = k1.x * il1 + fb; k1.y *= il1; kpre0[r] = k0; kpre1[r] = k1; } }
            __syncthreads(); pass1<false>(dat, tab, F.lane, F.wave); __syncthreads(); pass2<false>(dat, tab, F.lane, F.wave); pass3<false>(dat, tab, F.lane, F.wave, 0, nullptr, kpre0); asm volatile("" ::: "memory"); pass3<false>(dat, tab, F.lane, F.wave, 1, nullptr, kpre1);
            TPS_STOP(5); TPS_START(7);
            if (odd) { float ca[32], cb[32], cc[32]; const int cvln = fresh_tid(F.wave) & 63;
                conv_issue(ia, cvln, ca); conv_issue(ib, cvln, cb); conv_issue(ic, cvln, cc);
                pass2<true>(dat, tab, F.lane, F.wave); __syncthreads(); pass1<true>(dat, tab, F.lane, F.wave);
                if (cvb3) { conv_finish(ia, cvln, ca); conv_finish(ib, cvln, cb); conv_finish(ic, cvln, cc); cv_it += 3 * cv_ngw; }
                __syncthreads();
            } else { pass2<true>(dat, tab, F.lane, F.wave); __syncthreads(); pass1<true>(dat, tab, F.lane, F.wave); __syncthreads(); }
            TPS_STOP(7);
            if (!odd) {
                asm volatile("" : "+v"(tid));
#pragma unroll 1
                for (int sI = 0; sI < 4; ++sI)
#pragma unroll
                    for (int e = 0; e < 8; ++e) { const f32x2 v = dat[phys(8 * (tid + 512 * sI) + e)]; SeB[e * 2048 + tid + 512 * sI] = v; }
                __syncthreads();
            }
        }
        TPS_STOP(3); TPS_START(4);
        asm volatile("" : "+v"(tid));
        if (d + F.G < DM) {
#pragma unroll
            for (int sI = 0; sI < 4; ++sI) rf[sI] = load_rawf(HT, d + F.G, 8 * (tid + 512 * sI)); }
        { Raw8 rx0[4][2]; f32x2 se[4][8];
#pragma unroll
          for (int sI = 0; sI < 4; ++sI) {
#pragma unroll
              for (int bt = 0; bt < 2; ++bt) rx0[sI][bt] = load_raw8(pT + (size_t)d * MTOK + bt * L, 8 * (tid + 512 * sI));
#pragma unroll
              for (int e = 0; e < 8; ++e) se[sI][e] = SeB[e * 2048 + tid + 512 * sI]; }
#pragma unroll
          for (int sI = 0; sI < 4; ++sI) { const int t0 = 8 * (tid + 512 * sI);
              float o0[8], o1[8];
#pragma unroll
              for (int e = 0; e < 8; ++e) { const f32x2 so = dat[phys(t0 + e)]; float wr, wi; unit_root((float)(t0 + e) * (1.f / 32768.f), true, wr, wi);
                  o0[e] = (se[sI][e].x + so.x * wr - so.y * wi) * (1.f / 32768.f); o1[e] = (se[sI][e].y + so.x * wi + so.y * wr) * (1.f / 32768.f); }
#pragma unroll
              for (int bt = 0; bt < 2; ++bt) { float xc[8]; conv8(rx0[sI][bt], P[0], P[1], P[2], P[3], xc);
                  u32x4 w;
                  if (bt == 0) { w.x = cvt_pk_bf16(xc[0] * o0[0], xc[1] * o0[1]); w.y = cvt_pk_bf16(xc[2] * o0[2], xc[3] * o0[3]); w.z = cvt_pk_bf16(xc[4] * o0[4], xc[5] * o0[5]); w.w = cvt_pk_bf16(xc[6] * o0[6], xc[7] * o0[7]); }
                  else { w.x = cvt_pk_bf16(xc[0] * o1[0], xc[1] * o1[1]); w.y = cvt_pk_bf16(xc[2] * o1[2], xc[3] * o1[3]); w.z = cvt_pk_bf16(xc[4] * o1[4], xc[5] * o1[5]); w.w = cvt_pk_bf16(xc[6] * o1[6], xc[7] * o1[7]); }
                  *(u32x4*)(yT + (size_t)d * MTOK + bt * L + t0) = w; } } }
        __syncthreads();
        TPS_STOP(4);
        if (cvb3) {
        } else {
#pragma unroll 1
            for (int q = 0; q < 3; ++q) { if (cv_it < CV_NIT) { float cva[32]; const ConvItem cvc = moe_l1_item(F, cv_it); conv_issue(cvc, fresh_tid(F.wave) & 63, cva); conv_finish(cvc, fresh_tid(F.wave) & 63, cva); cv_it += cv_ngw; } }
        }
    }
    while (cv_it < CV_NIT) { float cvb[32]; const ConvItem c = moe_l1_item(F, cv_it); conv_issue(c, F.lane, cvb); conv_finish(c, F.lane, cvb); cv_it += cv_ngw; }
}
__device__ __forceinline__ void transpose_phase(const Frame& F) {
    const bf16* yT = (const bf16*)(F.ws + WS_A); bf16* y = (bf16*)(F.ws + WS_B);
    LAS bf16* tl = (LAS bf16*)(F.lds + F.wave * 16384);
    const int gw = F.bid * NWAVES + F.wave, NGW = F.G * NWAVES, lane = F.lane;
    for (int tile = gw; tile < 32 * 512; tile += NGW) { const int d0 = (tile & 31) * 64, t0 = (tile >> 5) * 64;
#pragma unroll
        for (int i = 0; i < 8; ++i) { const int r = i * 8 + (lane >> 3), ch = lane & 7; const u32x4 v = *(const u32x4*)(yT + (size_t)(d0 + r) * MTOK + t0 + ch * 8); *(LAS u32x4*)(tl + r * 72 + ch * 8) = v; }
        LDS_WAIT();
#pragma unroll
        for (int i = 0; i < 8; ++i) { const int tr = i * 8 + (lane >> 3), ch = lane & 7; unsigned short e[8];
#pragma unroll
            for (int k = 0; k < 8; ++k) e[k] = tl[(ch * 8 + k) * 72 + tr];
            u32x4 w; w.x = e[0] | ((unsigned)e[1] << 16); w.y = e[2] | ((unsigned)e[3] << 16); w.z = e[4] | ((unsigned)e[5] << 16); w.w = e[6] | ((unsigned)e[7] << 16);
            *(u32x4*)(y + (size_t)(t0 + tr) * DM + d0 + ch * 8) = w; }
        LDS_WAIT();
    }
}
}
__device__ __forceinline__ float hy_ftab_value(int f, int l, int jj) { return hy::ftab_value(f, l, jj); }
constexpr int NPHASE = 19;

__device__ __forceinline__ void moe_table(const Frame& F, int layer, LAS int* tab) {
    if (F.tid < NCLS) tab[32 + F.tid] = (int)__hip_atomic_load((unsigned*)(F.ctl + CW_CNT + (layer * NCLS + F.tid) * 64), RLX_AGENT);
    __syncthreads();
    if (F.tid == 0) { int a = 0; for (int c = 0; c < NCLS; ++c) { tab[c] = a; a += (tab[32 + c] + 255) >> 8; } tab[24] = a; }
    __syncthreads();
}

#ifndef PROBE_MASK
#define PROBE_MASK 0u
#endif
#ifndef TPM
#define TPM 0u
#endif
#define TP_MULT 4
#define IN(k) ((ONLY < 0 || (k) == ONLY) && lo <= (k) && (k) < hi)
#define SEAM(k) do { if ((k) + 1 < hi) { XcdBarrier b_ = bar; asm volatile("" : "+s"(b_.bar), "+s"(b_.x)); xcd_barrier(b_); } if (TPM != 0u && ONLY < 0 && ((TPM >> (k)) & 1u) && F.bid == 0 && F.tid == 0) TPW[0] += __builtin_amdgcn_s_memrealtime() - TPW[1]; if (PROBE_MASK != 0u && ONLY < 0) { if (F.tid == 0) { LAS unsigned long long* tp_ = (LAS unsigned long long*)(F.lds + MISC_OFF + 64); const unsigned long long t1_ = __builtin_amdgcn_s_memrealtime(); if ((PROBE_MASK >> (k)) & 1u) tp_[0] += t1_ - tp_[1]; tp_[1] = t1_; } } } while (0)
#define TPW ((LAS unsigned long long*)(F.lds + MISC_OFF + 96))
#define ENTER() do { int l_; asm volatile("v_mbcnt_lo_u32_b32 %0, -1, 0\n\tv_mbcnt_hi_u32_b32 %0, -1, %0" : "=&v"(l_)); const int t_ = F.wave * 64 + l_; F.tid = t_; F.lane = l_; int b_ = blockIdx.x, g_ = gridDim.x; asm volatile("" : "+s"(b_), "+s"(g_)); F.bid = b_; F.G = g_; if (TPM != 0u && ONLY < 0 && b_ == 0 && t_ == 0) TPW[1] = __builtin_amdgcn_s_memrealtime(); } while (0)
template <int ONLY> __device__ __forceinline__ void layer_phases(Frame& F, const XcdBarrier& bar, const int lo, const int hi, const int layer, LAS int* tab) {
        const int pb = 3 + 8 * layer;
        if (layer == 0) {
            if (IN(pb + 0)) { ENTER();
                pg::PlainSched S; S.init(F.ws + WS_A, F.ws + WS_WQKV, MTOK, QKVD, DM, DM, F.G, F.bid);
                pg::EpiQKV E{(bf16*)(F.ws + WS_B), (bf16*)(F.ws + WS_B + 128 * MiB), (bf16*)(F.ws + WS_B + 144 * MiB), AIN(I_ABIN), (const float*)(F.ws + WS_ROPE), (const float*)(F.ws + WS_ROPE) + 4096};
                pg::gemm_phase<pg::EpiQKV, pg::PlainSched, false, false, true>(F.lds, F.tid, DM, DM, DM, S, E);
                SEAM(pb + 0);
            }
            if (IN(pb + 1)) { ENTER(); att::attn_phase(F); SEAM(pb + 1); }
        } else {
            if (IN(pb + 0)) { ENTER();
                pg::PlainSched S; S.init(F.ws + WS_WHYIN, F.ws + WS_A, 3 * DM, MTOK, DM, DM, F.G, F.bid);
                pg::EpiBf16<true> E{(bf16*)(F.ws + WS_B), MTOK, AIN(I_HBIN)};
                pg::gemm_phase<pg::EpiBf16<true>, pg::PlainSched, false, false, true>(F.lds, F.tid, DM, DM, DM, S, E);
                SEAM(pb + 0);
            }
            if (IN(pb + 1)) { ENTER(); hy::hyena_phase(F); SEAM(pb + 1); }
            if (IN(pb + 2)) { ENTER(); hy::transpose_phase(F); SEAM(pb + 2); }
        }
        if (IN(pb + 3)) { ENTER();
            const void* A = layer ? (const void*)(F.ws + WS_B) : (const void*)(F.ws + WS_A);
            const void* Bt = layer ? (const void*)(F.ws + WS_WHYO) : (const void*)(F.ws + WS_WO0);
            bf16* O = (bf16*)(F.ws + WS_B + (layer ? 128 : 192) * MiB);
            pg::PlainSched S; S.init(A, Bt, MTOK, DM, DM, DM, F.G, F.bid);
            pg::EpiBf16<false> E{O, DM, layer ? AIN(I_HBOUT) : nullptr};
            pg::gemm_phase<pg::EpiBf16<false>, pg::PlainSched, false, false, true>(F.lds, F.tid, DM, DM, DM, S, E);
            SEAM(pb + 3);
        }
        if (IN(pb + 4)) { ENTER();
            if (layer == 0) ln1_router_phase<true>(F, 0, AIN(I_X), (const bf16*)(F.ws + WS_B + 192 * MiB), (bf16*)(F.ws + WS_A), (bf16*)(F.ws + WS_B + 192 * MiB));
            else ln1_router_phase<false>(F, 1, F.out, (const bf16*)(F.ws + WS_B + 128 * MiB), (bf16*)(F.ws + WS_A), (bf16*)(F.ws + WS_B + 256 * MiB));
            SEAM(pb + 4);
        }
        if (IN(pb + 5)) { ENTER();
            moe_table(F, layer, tab);
            pg::MoeSched S{tab, (const char*)(F.ws + WS_A), (const char*)(F.ws + WS_W13 + (size_t)layer * 128 * MiB), (const int*)(F.ws + WS_TOK), F.G, F.bid, 16, 0};
            pg::EpiMoe1 E{(bf16*)(F.ws + WS_B), (const float*)(F.ws + WS_GATE)};
            pg::gemm_phase<pg::EpiMoe1, pg::MoeSched, true, false, true>(F.lds, F.tid, DM, DM, DM, S, E);
            SEAM(pb + 5);
        }
        if (IN(pb + 6)) { ENTER();
            moe_table(F, layer, tab);
            pg::MoeSched S{tab, (const char*)(F.ws + WS_B), (const char*)(F.ws + WS_W2 + (size_t)layer * 64 * MiB), (const int*)(F.ws + WS_TOK), F.G, F.bid, 8, 1};
            pg::EpiMoe2 E{(bf16*)(F.ws + WS_A), (const int*)(F.ws + WS_TOK)};
            pg::gemm_phase<pg::EpiMoe2, pg::MoeSched, false, true, true>(F.lds, F.tid, DM, DM, EFF, S, E);
            SEAM(pb + 6);
        }
        if (IN(pb + 7)) { ENTER();
            if (layer == 0) ln2_phase<false>(F, 0, (bf16*)(F.ws + WS_A), (const bf16*)(F.ws + WS_B + 192 * MiB), F.out);
            else ln2_phase<true>(F, 1, (bf16*)(F.ws + WS_A), (const bf16*)(F.ws + WS_B + 256 * MiB), F.out);
            SEAM(pb + 7); }
}
template <int ONLY> __global__ void __launch_bounds__(NTHR, 2) fwd_kernel(Args args) {
    extern __shared__ __attribute__((aligned(16))) unsigned char lds_raw[];
    Frame F;
    F.lds = (LAS unsigned char*)lds_raw;
    F.tid = threadIdx.x; F.lane = F.tid & 63; F.wave = __builtin_amdgcn_readfirstlane(F.tid >> 6);
    F.G = gridDim.x; F.bid = blockIdx.x; F.ws = args.ws; F.ctl = (gu32*)(args.ws + WS_CTL); F.out = args.out;
    F.a = &args;
    for (int u = F.tid; u < (LDS_BYTES - RING_BYTES) / 4; u += NTHR) ((LAS unsigned*)(F.lds + RING_BYTES))[u] = 0u;
    __syncthreads();
    const int lo = args.ph_lo, hi = args.ph_hi;
    if (PROBE_MASK != 0u && ONLY >= 0) { if (F.bid == 0 && F.tid == 0) ((unsigned long long*)(F.ws + 512 * 1024))[ONLY] = __builtin_amdgcn_s_memrealtime(); }
    if (PROBE_MASK != 0u && ONLY < 0) { if (F.tid == 0) { LAS unsigned long long* tp_ = (LAS unsigned long long*)(F.lds + MISC_OFF + 64); tp_[0] = 0; tp_[1] = __builtin_amdgcn_s_memrealtime(); } }
    XcdBarrier bar; bar.bar = (unsigned*)(F.ctl + CW_BAR); bar.x = 0; bar.st = nullptr;
    if (ONLY < 0 && hi - lo > 1) bar = xcd_barrier_post((unsigned*)(F.ctl + CW_BAR), (volatile LAS unsigned*)(F.lds + MISC_OFF));
    LAS int* tab = (LAS int*)(F.lds + RING_BYTES + 64);

    if (IN(0)) { ENTER(); p0_prologue(F); SEAM(0); }
    if (IN(1)) { ENTER(); p1_prologue(F); if (TPM != 0u && ONLY < 0 && ((TPM >> 1) & 1u) && F.bid == 0 && F.tid == 0) TPW[0] += __builtin_amdgcn_s_memrealtime() - TPW[1]; }
    if (IN(2)) { ENTER();
        pg::PlainSched S; S.init(F.ws + WS_W4T, F.ws + WS_HDN, 4096, SEQ, 128, 128, F.G, F.bid);
        pg::EpiBf16<true> E{(bf16*)(F.ws + WS_HT), SEQ, nullptr};
        int kf = 128; asm volatile("" : "+s"(kf));
        pg::gemm_phase<pg::EpiBf16<true>, pg::PlainSched, false, false, true>(F.lds, F.tid, kf, 128, 128, S, E);
        SEAM(2);
    }
    if constexpr (ONLY >= 0) { if (ONLY >= 3 && ONLY < 11) layer_phases<ONLY>(F, bar, lo, hi, 0, tab); if (ONLY >= 11) layer_phases<ONLY>(F, bar, lo, hi, 1, tab); }
    else {
#pragma unroll 1
        for (int layer = 0; layer < 2; ++layer) layer_phases<ONLY>(F, bar, lo, hi, layer, tab);
    }
    if (PROBE_MASK != 0u && ONLY == NPHASE - 1) { __syncthreads(); if (F.bid == 0 && F.tid == 0) { const unsigned long long* ts = (const unsigned long long*)(F.ws + 512 * 1024); unsigned long long acc = 0, tend = __builtin_amdgcn_s_memrealtime();
        for (int k = 0; k < NPHASE; ++k) if (((PROBE_MASK >> k) & 1u) && k != 5) { int kn = k + 1; if (kn == 5) kn = 6; acc += ((kn < NPHASE) ? ts[kn] : tend) - ts[k]; }
        F.out[0] = 0.1f * (float)acc; } }
    if ((TPM != 0u || TPSEL >= 0) && ONLY < 0) { if (blockIdx.x == 0 && threadIdx.x == 0) { const unsigned long long acc = TPW[0] * TP_MULT, t0 = __builtin_amdgcn_s_memrealtime(); while (__builtin_amdgcn_s_memrealtime() - t0 < acc) __builtin_amdgcn_s_sleep(8); } }
    if (PROBE_MASK != 0u && ONLY < 0) { __syncthreads(); if (F.bid == 0 && F.tid == 0) F.out[0] = 0.1f * (float)((LAS unsigned long long*)(F.lds + MISC_OFF + 64))[0]; }
}
#undef IN
#undef SEAM

extern "C" void kernel_launch(void* const* d_in, const int* in_sizes, int n_in, void* d_out, int out_size, void* d_ws, size_t ws_size, hipStream_t stream) {
    static int grid = 0;
    if (grid == 0) {
        if (n_in != 34 || in_sizes[0] != MTOK * DM || out_size != MTOK * DM || ws_size < WS_END) { fprintf(stderr, "kernel_launch: unexpected shapes / workspace (n_in %d, ws %zu, need %zu)\n", n_in, ws_size, (size_t)WS_END); grid = -1; return; }
        int dev = 0, cus = 0;
        if (hipGetDevice(&dev) != hipSuccess || hipDeviceGetAttribute(&cus, hipDeviceAttributeMultiprocessorCount, dev) != hipSuccess) { grid = -1; return; }
#if !MK_SPLIT
        if (hipFuncSetAttribute((const void*)fwd_kernel<-1>, hipFuncAttributeMaxDynamicSharedMemorySize, LDS_BYTES) != hipSuccess) { fprintf(stderr, "kernel_launch: hipFuncSetAttribute failed\n"); grid = -1; return; }
        int per_cu = 0;
        if (hipOccupancyMaxActiveBlocksPerMultiprocessor(&per_cu, (const void*)fwd_kernel<-1>, NTHR, LDS_BYTES) != hipSuccess || per_cu < 1) fprintf(stderr, "kernel_launch: occupancy query reports %d blocks per CU\n", per_cu);
        (void)hipGetLastError();
#endif
        grid = cus;
    }
    if (grid < 0) return;
    (void)hipMemsetAsync((char*)d_ws + WS_CTL, 0, CTL_ZERO_BYTES, stream);
    Args a{};
    for (int i = 0; i < 34; ++i) a.in[i] = (const float*)d_in[i];
    a.out = (float*)d_out; a.ws = (unsigned char*)d_ws;
#if MK_SPLIT
    typedef void (*kfn)(Args);
    static const kfn fns[NPHASE] = {fwd_kernel<0>, fwd_kernel<1>, fwd_kernel<2>, fwd_kernel<3>, fwd_kernel<4>, nullptr, fwd_kernel<6>, fwd_kernel<7>, fwd_kernel<8>, fwd_kernel<9>, fwd_kernel<10>,
                                      fwd_kernel<11>, fwd_kernel<12>, fwd_kernel<13>, fwd_kernel<14>, fwd_kernel<15>, fwd_kernel<16>, fwd_kernel<17>, fwd_kernel<18>};
    static bool attr_done = false;
    if (!attr_done) { for (int ph = 0; ph < NPHASE; ++ph) if (fns[ph]) (void)hipFuncSetAttribute((const void*)fns[ph], hipFuncAttributeMaxDynamicSharedMemorySize, LDS_BYTES); attr_done = true; }
#ifndef REPEAT_MASK
#define REPEAT_MASK 0u
#endif
    for (int ph = 0; ph < NPHASE; ++ph) { if (!fns[ph]) continue; a.ph_lo = ph; a.ph_hi = ph + 1;
        for (int rep = 0; rep < (((REPEAT_MASK >> ph) & 1u) ? 2 : 1); ++rep) {
            if (rep == 1 && ph == 15) (void)hipMemsetAsync((char*)d_ws + WS_CTL + (size_t)(CW_CNT + NCLS * 64) * 4, 0, NCLS * 64 * 4, stream);
            hipLaunchKernelGGL(fns[ph], dim3(grid), dim3(NTHR), LDS_BYTES, stream, a); } }
#else
    a.ph_lo = 0; a.ph_hi = NPHASE; hipLaunchKernelGGL(fwd_kernel<-1>, dim3(grid), dim3(NTHR), LDS_BYTES, stream, a);
#endif
}
```

```cpp
#include <hip/hip_runtime.h>
#include <hip/hip_bf16.h>
#include <cstdio>
#include <cstdint>

#ifndef MK_SPLIT
#define MK_SPLIT 0
#endif

#define GAS __attribute__((address_space(1)))
#define LAS __attribute__((address_space(3)))
typedef unsigned short bf16;
typedef unsigned u32x4 __attribute__((ext_vector_type(4)));
typedef unsigned u32x2 __attribute__((ext_vector_type(2)));
typedef float f32x2 __attribute__((ext_vector_type(2)));
typedef float f32x4 __attribute__((ext_vector_type(4)));
typedef float f32x16 __attribute__((ext_vector_type(16)));
typedef short bf16x8 __attribute__((ext_vector_type(8)));
typedef short s16x4 __attribute__((ext_vector_type(4)));
typedef GAS unsigned gu32;

constexpr int DM = 2048, NB = 2, SEQ = 16384, MTOK = NB * SEQ, CTXL = 256, GRIDW = 64;
constexpr int NHEAD = 32, NKV = 4, HD = 64, QKVD = 2560, KVD = 256;
constexpr int NEXP = 16, EFF = 1024, NCLS = 24, LCAP = 32768;
constexpr int HYW = 64, HYEMB = 33;
constexpr float LN_EPS = 1e-5f;
constexpr float DN_ALPHA = 1.41421356237309515f;
constexpr float QSCALE = 0.125f * 1.4426950408889634f;
constexpr int NWAVES = 8, NTHR = 512;

constexpr size_t MiB = 1u << 20;
constexpr size_t WS_CTL = 0, CTL_ZERO_BYTES = 1 * MiB;
constexpr size_t WS_MOD = 1 * MiB;
constexpr size_t WS_ROPE = 1 * MiB + 512 * 1024;
constexpr size_t WS_FTAB = 1 * MiB + 768 * 1024;
constexpr size_t WS_CTXKV = 2 * MiB;
constexpr size_t WS_HDN = 3 * MiB;
constexpr size_t WS_W4T = 7 * MiB;
constexpr size_t WS_TOK = 8 * MiB;
constexpr size_t WS_GATE = 11 * MiB;
constexpr size_t WS_FFTS = 32 * MiB;
constexpr size_t WS_HT = 128 * MiB;
constexpr size_t WS_WQKV = 256 * MiB;
constexpr size_t WS_WO0 = 266 * MiB;
constexpr size_t WS_WHYIN = 274 * MiB;
constexpr size_t WS_WHYO = 298 * MiB;
constexpr size_t WS_W13 = 320 * MiB;
constexpr size_t WS_W2 = 576 * MiB;
constexpr size_t WS_A = 704 * MiB;
constexpr size_t WS_B = 832 * MiB;
constexpr size_t WS_END = 1216 * MiB;
constexpr int HID_ROWS = 38912;

constexpr int CW_TMO = 0;
constexpr int CW_BAR = 4096;
constexpr int CW_CNT = 16384;

constexpr int RING_BYTES = 131072;
constexpr int MISC_OFF = RING_BYTES + 320;
constexpr int FTAB_OFF = RING_BYTES + 1024;
constexpr int LDS_BYTES = 163840;
constexpr int SIDE_OFF = FTAB_OFF + 28672;

#define RLX_AGENT __ATOMIC_RELAXED, __HIP_MEMORY_SCOPE_AGENT
#define LDS_WAIT() asm volatile("s_waitcnt lgkmcnt(0)" ::: "memory")
#define VM_WAIT() asm volatile("s_waitcnt vmcnt(0)" ::: "memory")

__device__ __forceinline__ unsigned cvt_pk_bf16(float lo, float hi) { unsigned r; asm volatile("v_cvt_pk_bf16_f32 %0, %1, %2" : "=v"(r) : "v"(lo), "v"(hi)); return r; }
__device__ __forceinline__ float bf2f(unsigned h) { return __builtin_bit_cast(float, h << 16); }
__device__ __forceinline__ float bflo(unsigned w) { return __builtin_bit_cast(float, w << 16); }
__device__ __forceinline__ float bfhi(unsigned w) { return __builtin_bit_cast(float, w & 0xffff0000u); }
__device__ __forceinline__ float wave_sum(float v) {
    v += __builtin_bit_cast(float, __builtin_amdgcn_update_dpp(0, __builtin_bit_cast(int, v), 0xB1, 0xf, 0xf, true));
    v += __builtin_bit_cast(float, __builtin_amdgcn_update_dpp(0, __builtin_bit_cast(int, v), 0x4E, 0xf, 0xf, true));
    v += __builtin_bit_cast(float, __builtin_amdgcn_update_dpp(0, __builtin_bit_cast(int, v), 0x141, 0xf, 0xf, true));
    v += __builtin_bit_cast(float, __builtin_amdgcn_update_dpp(0, __builtin_bit_cast(int, v), 0x140, 0xf, 0xf, true));
    { auto r = __builtin_amdgcn_permlane16_swap(__float_as_uint(v), __float_as_uint(v), false, false); v = __uint_as_float(r[0]) + __uint_as_float(r[1]); }
    { auto r = __builtin_amdgcn_permlane32_swap(__float_as_uint(v), __float_as_uint(v), false, false); v = __uint_as_float(r[0]) + __uint_as_float(r[1]); }
    return v;
}

#define XB_TMO      128
#define XB_XCNT(j)  (256  + 64 * (j))
#define XB_XSUB(j)  (1280 + 64 * (j))
#define XB_XGEN(j)  (2304 + 64 * (j))
#define XB_TOP      3328
#define XB_TOPGEN   3392
#define XCD_BAR_WORDS 3456
#define XB_SPIN_CAP (1u << 18)

__device__ __forceinline__ unsigned xb_ld(unsigned* p)              { return __hip_atomic_load(p, __ATOMIC_RELAXED, __HIP_MEMORY_SCOPE_AGENT); }
__device__ __forceinline__ unsigned xb_add(unsigned* p, unsigned v) { return __hip_atomic_fetch_add(p, v, __ATOMIC_RELAXED, __HIP_MEMORY_SCOPE_AGENT); }
__device__ __forceinline__ unsigned xb_xcc_id() { return (unsigned)__builtin_amdgcn_s_getreg((3 << 11) | 20) & 0xFu; }
#define XB_SPIN(cond, bar) do { unsigned _sp = 0; while (cond) { __builtin_amdgcn_s_sleep(1); \
    if ((++_sp & 255u) == 0u) { if (xb_ld(&(bar)[XB_TMO])) break; if (_sp > XB_SPIN_CAP) { atomicAdd(&(bar)[XB_TMO], 1u); break; } } } } while (0)

struct XcdBarrier { unsigned* bar; unsigned x; volatile LAS unsigned* st; };

__device__ __forceinline__ XcdBarrier xcd_barrier_post(unsigned* bar, volatile LAS unsigned* st) {
    XcdBarrier b; b.bar = bar; b.x = xb_xcc_id(); b.st = st;
    if (threadIdx.x == 0) (void)xb_add(&bar[XB_XCNT(b.x)], 1u);
    return b;
}
__device__ __forceinline__ void xcd_barrier_complete(unsigned* bar, unsigned x, unsigned& nloc, unsigned& nx) {
    const unsigned G = gridDim.x * gridDim.y * gridDim.z;
    unsigned sum, cnt, mine, sp = 0u;
    for (;;) {
        sum = 0u; cnt = 0u; mine = 0u;
#pragma unroll
        for (unsigned j = 0; j < 16; ++j) { const unsigned c = xb_ld(&bar[XB_XCNT(j)]); sum += c; cnt += (c > 0u) ? 1u : 0u; mine = (j == x) ? c : mine; }
        if (sum == G) break;
        __builtin_amdgcn_s_sleep(1);
        if ((++sp & 255u) == 0u) { if (xb_ld(&bar[XB_TMO])) break; if (sp > XB_SPIN_CAP) { atomicAdd(&bar[XB_TMO], 1u); break; } }
    }
    nloc = mine > 0u ? mine : 1u; nx = cnt > 0u ? cnt : 1u;
}
__device__ __forceinline__ void xcd_barrier(const XcdBarrier& b) {
    asm volatile("s_waitcnt vmcnt(0)" ::: "memory");
    __syncthreads();
    if (threadIdx.x == 0) {
        unsigned* bar = b.bar;
        __builtin_amdgcn_s_waitcnt(0);
        unsigned nloc = b.st[0], nx = b.st[1];
        if (nloc == 0u) { xcd_barrier_complete(bar, b.x, nloc, nx); b.st[0] = nloc; b.st[1] = nx; }
        const unsigned old = xb_add(&bar[XB_XSUB(b.x)], 1u);
        const unsigned gen = old / nloc;
        if (old + 1u == (gen + 1u) * nloc) {
            __builtin_amdgcn_fence(__ATOMIC_RELEASE, "agent");
            asm volatile("s_waitcnt vmcnt(0)" ::: "memory");
            const unsigned og = xb_add(&bar[XB_TOP], 1u);
            const unsigned tg = og / nx;
            if (og + 1u == (tg + 1u) * nx) xb_add(&bar[XB_TOPGEN], 1u);
            else XB_SPIN(xb_ld(&bar[XB_TOPGEN]) == tg, bar);
            __builtin_amdgcn_fence(__ATOMIC_ACQUIRE, "agent");
            xb_add(&bar[XB_XGEN(b.x)], 1u);
            asm volatile("s_waitcnt vmcnt(0)" ::: "memory");
        } else {
            XB_SPIN(xb_ld(&bar[XB_XGEN(b.x)]) == gen, bar);
            __builtin_amdgcn_fence(__ATOMIC_ACQUIRE, "agent");
            asm volatile("s_waitcnt vmcnt(0)" ::: "memory");
        }
    }
    __syncthreads();
}

namespace pg {
constexpr int BM = 256, BK = 64, HALF = 128, HTB = HALF * BK * 2, NXCD = 8, WGM = 8;
__host__ __device__ __forceinline__ int lds_byte(int r, int c) { const int st = (r >> 4) * 2 + (c >> 5), rr = r & 15, cc = c & 31, ob = rr * 64 + cc * 2; return st * 1024 + (ob ^ (((ob >> 9) & 1) << 5)); }
__host__ __device__ __forceinline__ void stage_rc(int b, int& R, int& C) { const int st = b / 1024, sb = b % 1024, swz = sb ^ (((sb >> 9) & 1) << 5); R = (st >> 1) * 16 + swz / 64; C = (st & 1) * 32 + (swz % 64) / 2; }
__host__ __device__ __forceinline__ int perm32(int rho) { const int n = rho >> 4, i = rho & 15; return 8 * (i >> 2) + 4 * n + (i & 3); }

struct Unit { int pm, pn; const char* A; const char* B; const char* B2; int cls, row0, nrows, lbase; };

__device__ __forceinline__ bool static_map(int i, int G, int c, int nM, int nN, int& pm, int& pn) {
    const int nwg = nM * nN; const long L = (long)i * G + c; if (L >= nwg) return false;
    int wgid = (int)L; { const int q = nwg / NXCD, r = nwg % NXCD, xcd = wgid % NXCD, off = wgid / NXCD; wgid = (xcd < r ? xcd * (q + 1) : r * (q + 1) + (xcd - r) * q) + off; }
    const int nig = WGM * nN, gid = wgid / nig, fm = gid * WGM, gsz = (nM - fm) < WGM ? (nM - fm) : WGM;
    pm = fm + ((wgid % nig) % gsz); pn = (wgid % nig) / gsz; return true;
}
struct PlainSched {
    const char* A; const char* Bt; int nM, nN, G, c; size_t tA, tB;
    __device__ __forceinline__ void init(const void* A_, const void* Bt_, int M, int N, int ldA, int ldB, int G_, int c_) { A = (const char*)A_; Bt = (const char*)Bt_; nM = M / BM; nN = N / BM; G = G_; c = c_; tA = (size_t)BM * ldA * 2; tB = (size_t)BM * ldB * 2; }
    __device__ __forceinline__ bool next(int i, Unit& u) const {
        if (!static_map(i, G, c, nM, nN, u.pm, u.pn)) return false;
        u.A = A + (size_t)u.pm * tA; u.B = Bt + (size_t)u.pn * tB; u.B2 = u.B; u.cls = 0; u.row0 = 0; u.nrows = 256; u.lbase = 0; return true;
    }
    __device__ __forceinline__ unsigned row_off(const Unit&, int r, int ldA) const { return (unsigned)r * (unsigned)ldA * 2u; }
};

template <class Epi, class Sched, bool GATHER, bool KSPLIT, bool ALIGN_EPI>
__device__ __forceinline__ void gemm_phase(LAS unsigned char* lds, const int tid, const int K, const int ldA, const int ldB, const Sched& S, const Epi& E) {
    const int wid = __builtin_amdgcn_readfirstlane(tid >> 6), lane = tid & 63, wr = wid >> 2, wc = wid & 3, fr = lane & 15, fq = lane >> 4;
    const int nt = K / BK, nth = nt >> 1;
    int RA[2], CA[2];
    unsigned voffB[2], voA[2][2], nvoA[2][2];
#pragma unroll
    for (int i = 0; i < 2; ++i) { int R, C; stage_rc(tid * 16 + i * 8192, R, C); const int Rb = Epi::PERM ? ((R & ~31) + perm32(R & 31)) : R;
        RA[i] = R; CA[i] = C; voffB[i] = (unsigned)(Rb * ldB + C) * 2u;
        voA[0][i] = (unsigned)(R * ldA + C) * 2u; voA[1][i] = (unsigned)((R + HALF) * ldA + C) * 2u; nvoA[0][i] = voA[0][i]; nvoA[1][i] = voA[1][i]; }
    const size_t kstep = (size_t)(BK * 2);
    const size_t hstepB = (size_t)HALF * ldB * 2;
    const unsigned ldsw = (unsigned)wid * 1024u;
    const int aoff = lds_byte(wr * 64 + fr, fq * 8), boff = lds_byte(wc * 32 + fr, fq * 8);
#define PG8_SA(b, h) (((b) * 2 + (h)) * HTB)
#define PG8_SB(b, h) ((4 + (b) * 2 + (h)) * HTB)
#define PG8_STAGEB(bufoff, gbase) do { _Pragma("unroll") for (int _i = 0; _i < 2; ++_i) \
        __builtin_amdgcn_global_load_lds((const unsigned*)((const char*)(gbase) + voffB[_i]), (LAS unsigned*)(lds + (bufoff) + ldsw + _i * 8192), 16, 0, 0); } while (0)
#define PG8_STAGEA(bufoff, gbase, vo, h) do { _Pragma("unroll") for (int _i = 0; _i < 2; ++_i) \
        __builtin_amdgcn_global_load_lds((const unsigned*)((const char*)(gbase) + (vo)[h][_i]), (LAS unsigned*)(lds + (bufoff) + ldsw + _i * 8192), 16, 0, 0); } while (0)
#define PG8_LDA(dst, b, h) do { _Pragma("unroll") for (int m = 0; m < 4; ++m) _Pragma("unroll") for (int k = 0; k < 2; ++k) dst[m][k] = *(const LAS bf16x8*)(lds + PG8_SA(b, h) + aoff + m * 2048 + k * 1024); } while (0)
#define PG8_LDB(dst, b, h) do { _Pragma("unroll") for (int n = 0; n < 2; ++n) _Pragma("unroll") for (int k = 0; k < 2; ++k) dst[n][k] = *(const LAS bf16x8*)(lds + PG8_SB(b, h) + boff + n * 2048 + k * 1024); } while (0)
#define PG8_MMA(ai, bj, At, Bt) do { __builtin_amdgcn_s_setprio(1); _Pragma("unroll") for (int m = 0; m < 4; ++m) _Pragma("unroll") for (int n = 0; n < 2; ++n) _Pragma("unroll") for (int k = 0; k < 2; ++k) \
        acc[ai][bj][m][n] = __builtin_amdgcn_mfma_f32_16x16x32_bf16(Bt[n][k], At[m][k], acc[ai][bj][m][n], 0, 0, 0); __builtin_amdgcn_s_setprio(0); } while (0)
#define PG8_WAIT_V(n) asm volatile("s_waitcnt vmcnt(" #n ")" ::: "memory")
#define PG8_WAIT_L(n) asm volatile("s_waitcnt lgkmcnt(" #n ")" ::: "memory")
#define PG8_BAR __builtin_amdgcn_s_barrier()
#define PG8_SCHED __builtin_amdgcn_sched_barrier(0)
#define PG8_BPTR(tt) ((KSPLIT && (tt) >= nth) ? cB2 + (size_t)((tt) - nth) * kstep : cB + (size_t)(tt) * kstep)
    Unit cur, nxt; int ui = 0;
    if (!S.next(0, cur)) return;
    if constexpr (GATHER) {
#pragma unroll
        for (int h = 0; h < 2; ++h)
#pragma unroll
            for (int i = 0; i < 2; ++i) voA[h][i] = S.row_off(cur, h * HALF + RA[i], ldA) + (unsigned)CA[i] * 2u;
    }
    f32x4 acc[2][2][4][2];
#pragma unroll
    for (int a = 0; a < 2; ++a)
#pragma unroll
        for (int b = 0; b < 2; ++b)
#pragma unroll
            for (int m = 0; m < 4; ++m)
#pragma unroll
                for (int n = 0; n < 2; ++n) acc[a][b][m][n] = (f32x4){0.f, 0.f, 0.f, 0.f};
    bf16x8 At[4][2], B0[2][2], B1[2][2];
    const char* cA = cur.A; const char* cB = cur.B; const char* cB2 = cur.B2;
    if constexpr (Epi::SIDE) { if (wid == 0 && E.has_side()) __builtin_amdgcn_global_load_lds((const unsigned*)(E.side_src(cur) + lane * 16), (LAS unsigned*)(lds + SIDE_OFF), 16, 0, 0); }
    PG8_STAGEB(PG8_SB(0, 0), cB); PG8_STAGEB(PG8_SB(0, 1), cB + hstepB); PG8_STAGEA(PG8_SA(0, 0), cA, voA, 0); PG8_STAGEA(PG8_SA(0, 1), cA, voA, 1);
    if (wr == 1) PG8_BAR;
    PG8_WAIT_V(2); PG8_BAR;
    { const char* b1 = PG8_BPTR(1); PG8_STAGEB(PG8_SB(1, 0), b1); PG8_STAGEA(PG8_SA(1, 0), cA + kstep, voA, 0); PG8_STAGEB(PG8_SB(1, 1), b1 + hstepB); }
    PG8_WAIT_V(6); PG8_BAR;
    for (;;) {
        const bool has_next = S.next(ui + 1, nxt);
        const char* nA = has_next ? nxt.A : cA; const char* nB = has_next ? nxt.B : cB;
        if constexpr (GATHER) {
            if (has_next) {
#pragma unroll
                for (int h = 0; h < 2; ++h)
#pragma unroll
                    for (int i = 0; i < 2; ++i) nvoA[h][i] = S.row_off(nxt, h * HALF + RA[i], ldA) + (unsigned)CA[i] * 2u;
            } else {
#pragma unroll
                for (int h = 0; h < 2; ++h)
#pragma unroll
                    for (int i = 0; i < 2; ++i) nvoA[h][i] = voA[h][i];
            }
        }
        for (int t = 0; t < nt; t += 2) {
            const bool last = (t == nt - 2);
            const char* a1 = cA + (size_t)(t + 1) * kstep;
            const char* a2 = last ? nA : cA + (size_t)(t + 2) * kstep; const char* b2 = last ? nB : PG8_BPTR(t + 2);
            const char* a3 = a2 + kstep; const char* b3 = last ? nB + kstep : PG8_BPTR(t + 3);
            unsigned vo2[2][2];
#pragma unroll
            for (int h = 0; h < 2; ++h)
#pragma unroll
                for (int i = 0; i < 2; ++i) vo2[h][i] = (GATHER && last) ? nvoA[h][i] : voA[h][i];
            PG8_LDB(B0, 0, 0); PG8_LDB(B1, 0, 1); PG8_SCHED; PG8_LDA(At, 0, 0); PG8_STAGEA(PG8_SA(1, 1), a1, voA, 1);
            PG8_WAIT_V(8); PG8_WAIT_L(0); PG8_BAR; PG8_MMA(0, 0, At, B0); PG8_MMA(0, 1, At, B1); PG8_BAR; PG8_SCHED;
            PG8_LDA(At, 0, 1); PG8_STAGEB(PG8_SB(0, 0), b2); PG8_STAGEB(PG8_SB(0, 1), b2 + hstepB); PG8_STAGEA(PG8_SA(0, 0), a2, vo2, 0);
            PG8_WAIT_V(8); PG8_WAIT_L(0); PG8_BAR; PG8_MMA(1, 0, At, B0); PG8_MMA(1, 1, At, B1); PG8_BAR; PG8_SCHED;
            PG8_LDB(B0, 1, 0); PG8_LDB(B1, 1, 1); PG8_SCHED; PG8_LDA(At, 1, 0); PG8_STAGEA(PG8_SA(0, 1), a2, vo2, 1);
            PG8_WAIT_V(8); PG8_WAIT_L(0); PG8_BAR; PG8_MMA(0, 0, At, B0); PG8_MMA(0, 1, At, B1); PG8_BAR; PG8_SCHED;
            PG8_LDA(At, 1, 1); PG8_STAGEB(PG8_SB(1, 0), b3); PG8_STAGEB(PG8_SB(1, 1), b3 + hstepB); PG8_STAGEA(PG8_SA(1, 0), a3, vo2, 0);
            PG8_WAIT_V(8); PG8_WAIT_L(0); PG8_BAR; PG8_MMA(1, 0, At, B0); PG8_MMA(1, 1, At, B1); PG8_BAR; PG8_SCHED;
        }
        if constexpr (ALIGN_EPI) { if (wr == 0) PG8_BAR; }
        if constexpr (Epi::SIDE) { if (has_next && wid == 0 && E.has_side()) __builtin_amdgcn_global_load_lds((const unsigned*)(E.side_src(nxt) + lane * 16), (LAS unsigned*)(lds + SIDE_OFF + ((ui + 1) & 1) * 1024), 16, 0, 0); }
        E(acc, cur, wr, wc, fr, fq, (const LAS float*)(lds + SIDE_OFF + (ui & 1) * 1024));
        if (!has_next) break;
#pragma unroll
        for (int a = 0; a < 2; ++a)
#pragma unroll
            for (int b = 0; b < 2; ++b)
#pragma unroll
                for (int m = 0; m < 4; ++m)
#pragma unroll
                    for (int n = 0; n < 2; ++n) acc[a][b][m][n] = (f32x4){0.f, 0.f, 0.f, 0.f};
        cur = nxt; cA = nA; cB = nB; cB2 = nxt.B2; ++ui;
        if constexpr (GATHER) {
#pragma unroll
            for (int h = 0; h < 2; ++h)
#pragma unroll
                for (int i = 0; i < 2; ++i) voA[h][i] = nvoA[h][i];
        }
        if constexpr (ALIGN_EPI) { if (wr == 1) PG8_BAR; }
    }
    PG8_WAIT_V(0);
    if constexpr (!ALIGN_EPI) { if (wr == 0) PG8_BAR; }
    PG8_BAR;
#undef PG8_SA
#undef PG8_SB
#undef PG8_STAGEA
#undef PG8_STAGEB
#undef PG8_LDA
#undef PG8_LDB
#undef PG8_MMA
#undef PG8_WAIT_V
#undef PG8_WAIT_L
#undef PG8_BAR
#undef PG8_SCHED
#undef PG8_BPTR
}
}
namespace pg {
template <bool BIAS_ROW> struct EpiBf16 {
    static constexpr bool PERM = true; static constexpr bool SIDE = true; static constexpr int NST = 16;
    __device__ __forceinline__ bool full_stores(const Unit&) const { return true; }
    bf16* O; int ldc; const float* bias;
    __device__ __forceinline__ bool has_side() const { return bias != nullptr; }
    __device__ __forceinline__ const char* side_src(const Unit& u) const { return (const char*)(bias + (BIAS_ROW ? u.pm : u.pn) * BM); }
    __device__ __forceinline__ void operator()(const f32x4 (&acc)[2][2][4][2], const Unit& u, int wr, int wc, int fr, int fq, const LAS float* side) const {
        const int row0 = u.pm * BM + wr * 64 + fr; const int col0 = u.pn * BM + wc * 32 + 8 * fq;
        f32x4 bv[2][2];
#pragma unroll
        for (int bj = 0; bj < 2; ++bj)
#pragma unroll
            for (int n = 0; n < 2; ++n) bv[bj][n] = (bias && !BIAS_ROW) ? *(const LAS f32x4*)(side + wc * 32 + 8 * fq + bj * HALF + 4 * n) : (f32x4){0.f, 0.f, 0.f, 0.f};
#pragma unroll
        for (int ai = 0; ai < 2; ++ai)
#pragma unroll
            for (int m = 0; m < 4; ++m) { const int row = row0 + ai * HALF + m * 16; bf16* rowp = O + (size_t)row * ldc + col0;
                float br = 0.f; if (BIAS_ROW && bias) br = side[wr * 64 + fr + ai * HALF + m * 16];
#pragma unroll
                for (int bj = 0; bj < 2; ++bj) { f32x4 v0 = acc[ai][bj][m][0] + bv[bj][0] + br, v1 = acc[ai][bj][m][1] + bv[bj][1] + br;
                    u32x4 w; w.x = cvt_pk_bf16(v0[0], v0[1]); w.y = cvt_pk_bf16(v0[2], v0[3]); w.z = cvt_pk_bf16(v1[0], v1[1]); w.w = cvt_pk_bf16(v1[2], v1[3]);
                    *(u32x4*)(rowp + bj * HALF) = w; } }
    }
};
struct EpiQKV {
    static constexpr bool PERM = false; static constexpr bool SIDE = false; static constexpr int NST = 32;
    __device__ __forceinline__ bool full_stores(const Unit&) const { return true; }
    bf16 *Q, *Kb, *Vb; const float* bias; const float* ropeC; const float* ropeS;
    __device__ __forceinline__ bool has_side() const { return false; }
    __device__ __forceinline__ const char* side_src(const Unit&) const { return nullptr; }
    __device__ __forceinline__ void operator()(const f32x4 (&acc)[2][2][4][2], const Unit& u, int wr, int wc, int fr, int fq, const LAS float*) const {
        const int row0 = u.pm * BM + wr * 64 + fr; const int colt = u.pn * BM + wc * 32 + 4 * fq;
        const bool isV = (u.pn == 9), isQ = (u.pn < 8);
        bf16* base; int ldc, cofs;
        if (isQ) { base = Q; ldc = DM; cofs = 0; } else if (!isV) { base = Kb; ldc = KVD; cofs = 2048; } else { base = Vb; ldc = KVD; cofs = 2304; }
        f32x4 bv[2][2];
#pragma unroll
        for (int bj = 0; bj < 2; ++bj)
#pragma unroll
            for (int n = 0; n < 2; ++n) bv[bj][n] = *(const f32x4*)(bias + colt + bj * HALF + 16 * n);
        const float sc = isQ ? QSCALE : 1.f; const int half = wc & 1;
#pragma unroll
        for (int ai = 0; ai < 2; ++ai)
#pragma unroll
            for (int m = 0; m < 4; ++m) { const int row = row0 + ai * HALF + m * 16; const int t = row & (SEQ - 1); const int pos = half ? (t & (GRIDW - 1)) : (t >> 6);
                f32x4 cs = (f32x4){1.f, 1.f, 1.f, 1.f}, sn = (f32x4){0.f, 0.f, 0.f, 0.f};
                if (!isV) { cs = *(const f32x4*)(ropeC + pos * 16 + 4 * fq); sn = *(const f32x4*)(ropeS + pos * 16 + 4 * fq); }
                bf16* rowp = base + (size_t)row * ldc + (colt - cofs);
#pragma unroll
                for (int bj = 0; bj < 2; ++bj) { const f32x4 x1 = acc[ai][bj][m][0] + bv[bj][0], x2 = acc[ai][bj][m][1] + bv[bj][1];
                    const f32x4 o1 = (x1 * cs - x2 * sn) * sc, o2 = (x2 * cs + x1 * sn) * sc;
                    u32x2 w1, w2; w1.x = cvt_pk_bf16(o1[0], o1[1]); w1.y = cvt_pk_bf16(o1[2], o1[3]); w2.x = cvt_pk_bf16(o2[0], o2[1]); w2.y = cvt_pk_bf16(o2[2], o2[3]);
                    *(u32x2*)(rowp + bj * HALF) = w1; *(u32x2*)(rowp + bj * HALF + 16) = w2; } }
    }
};
struct EpiMoe1 {
    static constexpr bool PERM = true; static constexpr bool SIDE = true; static constexpr int NST = 8;
    __device__ __forceinline__ bool full_stores(const Unit& u) const { return u.nrows == BM; }
    bf16* hid; const float* gates;
    __device__ __forceinline__ bool has_side() const { return true; }
    __device__ __forceinline__ const char* side_src(const Unit& u) const { return (const char*)(gates + (size_t)((u.pn >= 8) ? 1 : 0) * NCLS * LCAP + u.lbase); }
    __device__ __forceinline__ void operator()(const f32x4 (&acc)[2][2][4][2], const Unit& u, int wr, int wc, int fr, int fq, const LAS float* side) const {
        const int lr0 = wr * 64 + fr; const int col0 = u.pn * HALF + wc * 32 + 8 * fq; const int gsel = (u.pn >= 8) ? 1 : 0;
#pragma unroll
        for (int ai = 0; ai < 2; ++ai)
#pragma unroll
            for (int m = 0; m < 4; ++m) { const int lr = lr0 + ai * HALF + m * 16;
                if (lr < u.nrows) { const float g = side[lr];
                    float o[8];
#pragma unroll
                    for (int n = 0; n < 2; ++n)
#pragma unroll
                        for (int i = 0; i < 4; ++i) { const float a = acc[ai][0][m][n][i], b = acc[ai][1][m][n][i];
                            const float sg = __builtin_amdgcn_rcpf(1.f + __builtin_amdgcn_exp2f(-1.4426950408889634f * a)); o[n * 4 + i] = a * sg * b * g; }
                    u32x4 w; w.x = cvt_pk_bf16(o[0], o[1]); w.y = cvt_pk_bf16(o[2], o[3]); w.z = cvt_pk_bf16(o[4], o[5]); w.w = cvt_pk_bf16(o[6], o[7]);
                    *(u32x4*)(hid + (size_t)(u.row0 + lr) * DM + col0) = w; } }
    }
};
struct EpiMoe2 {
    static constexpr bool PERM = true; static constexpr bool SIDE = true; static constexpr int NST = 16;
    __device__ __forceinline__ bool full_stores(const Unit& u) const { return u.nrows == BM; }
    bf16* Y; const int* toks;
    __device__ __forceinline__ bool has_side() const { return true; }
    __device__ __forceinline__ const char* side_src(const Unit& u) const { return (const char*)(toks + u.lbase); }
    __device__ __forceinline__ void operator()(const f32x4 (&acc)[2][2][4][2], const Unit& u, int wr, int wc, int fr, int fq, const LAS float* side) const {
        const int lr0 = wr * 64 + fr; const int col0 = u.pn * BM + wc * 32 + 8 * fq;
#pragma unroll
        for (int ai = 0; ai < 2; ++ai)
#pragma unroll
            for (int m = 0; m < 4; ++m) { const int lr = lr0 + ai * HALF + m * 16;
                if (lr < u.nrows) { const int tok = ((const LAS int*)side)[lr]; bf16* rowp = Y + (size_t)tok * DM + col0;
#pragma unroll
                    for (int bj = 0; bj < 2; ++bj) { const f32x4 v0 = acc[ai][bj][m][0], v1 = acc[ai][bj][m][1];
                        u32x4 w; w.x = cvt_pk_bf16(v0[0], v0[1]); w.y = cvt_pk_bf16(v0[2], v0[3]); w.z = cvt_pk_bf16(v1[0], v1[1]); w.w = cvt_pk_bf16(v1[2], v1[3]);
                        *(u32x4*)(rowp + bj * HALF) = w; } } }
    }
};
struct MoeSched {
    const LAS int* tab;
    const char* Abase; const char* W; const int* toks; int G, c, NPN, second;
    __device__ __forceinline__ bool next(int i, Unit& u) const {
        const int TM = __builtin_amdgcn_readfirstlane(tab[24]);
        if (!static_map(i, G, c, TM, NPN, u.pm, u.pn)) return false;
        int cls = 0;
        for (int k = 1; k < NCLS; ++k) { const int s = __builtin_amdgcn_readfirstlane(tab[k]); if (u.pm >= s) cls = k; }
        const int ts = __builtin_amdgcn_readfirstlane(tab[cls]), cnt = __builtin_amdgcn_readfirstlane(tab[32 + cls]);
        const int ti = u.pm - ts; u.cls = cls; u.row0 = u.pm * BM; u.nrows = (cnt - ti * BM) < BM ? (cnt - ti * BM) : BM; u.lbase = cls * LCAP + ti * BM;
        const int g = cls / 6, p = cls % 6; const int lo = (p < 3) ? 0 : (p < 5 ? 1 : 2), hi = (p < 3) ? p + 1 : (p < 5 ? p - 1 : 3);
        const int elo = g * 4 + lo, ehi = g * 4 + hi;
        if (!second) { const int e = (u.pn < 8) ? elo : ehi; u.A = Abase; u.B = W + ((size_t)e * 2048 + (size_t)(u.pn & 7) * 256) * 2048 * 2; u.B2 = u.B; }
        else { u.A = Abase + (size_t)u.row0 * DM * 2; u.B = W + ((size_t)elo * 2048 + (size_t)u.pn * 256) * 1024 * 2; u.B2 = W + ((size_t)ehi * 2048 + (size_t)u.pn * 256) * 1024 * 2; }
        return true;
    }
    __device__ __forceinline__ unsigned row_off(const Unit& u, int r, int ldA) const {
        const int rr = r < u.nrows ? r : u.nrows - 1; const int tok = toks[u.lbase + rr]; return (unsigned)tok * (unsigned)ldA * 2u;
    }
};
}
struct Args { const float* in[34]; float* out; unsigned char* ws; int ph_lo, ph_hi; };
struct Frame {
    LAS unsigned char* lds;
    gu32* ctl; unsigned char* ws;
    int tid, lane, wave, G, bid;
    const Args* a; float* out;
};
#define AIN(i) (F.a->in[i])
enum { I_X = 0, I_C, I_CTX, I_CCTX, I_ADAW, I_ADAB, I_AWIN, I_ABIN, I_SINK, I_AWOUT, I_HWIN, I_HBIN, I_HCW, I_HCB, I_FW1, I_FB1, I_FW2, I_FB2, I_FW3, I_FB3, I_FFREQ, I_FW4, I_FBIAS, I_HWOUT, I_HBOUT,
       I_LN1G, I_LN1B, I_LN2G, I_LN2B, I_RW, I_RB, I_W1, I_W3, I_W2 };
#ifndef TPSEL
#define TPSEL -1
#endif
#define TPS_W ((LAS unsigned long long*)(F.lds + RING_BYTES + 320 + 96))
#define TPS_START(id) do { if (TPSEL == (id) && blockIdx.x == 0 && threadIdx.x == 0) TPS_W[1] = __builtin_amdgcn_s_memrealtime(); } while (0)
#define TPS_STOP(id) do { if (TPSEL == (id) && blockIdx.x == 0 && threadIdx.x == 0) TPS_W[0] += __builtin_amdgcn_s_memrealtime() - TPS_W[1]; } while (0)
__device__ __forceinline__ int fresh_tid(int wave) { int l_; asm volatile("v_mbcnt_lo_u32_b32 %0, -1, 0\n\tv_mbcnt_hi_u32_b32 %0, -1, %0" : "=&v"(l_)); return wave * 64 + l_; }
__device__ __forceinline__ float* mod_ptr(const Frame& F, int layer, int vec, int chunk) { return (float*)(F.ws + WS_MOD) + ((size_t)(layer * 3 + vec) * 6 + chunk) * DM; }

__device__ __forceinline__ float hy_ftab_value(int f, int l, int jj);
__device__ constexpr int hy_ftab_elems() { return 28 * 64 * 8; }
__device__ __forceinline__ void p0_transpose_item(const float* W, int ldw, bf16* WT, int ldt, int dst_row, int k0, int n0, LAS float* scr, int lane) {
#pragma unroll
    for (int i = 0; i < 32; ++i) { const int kk = 2 * i + (lane >> 5); scr[kk * 33 + (lane & 31)] = W[(size_t)(k0 + kk) * ldw + n0 + (lane & 31)]; }
    LDS_WAIT(); asm volatile("" ::: "memory");
    const int c = lane & 7;
#pragma unroll
    for (int j = 0; j < 4; ++j) { const int n = (lane >> 3) + 8 * j; const LAS float* s = scr + (8 * c) * 33 + n;
        u32x4 o; o.x = cvt_pk_bf16(s[0 * 33], s[1 * 33]); o.y = cvt_pk_bf16(s[2 * 33], s[3 * 33]); o.z = cvt_pk_bf16(s[4 * 33], s[5 * 33]); o.w = cvt_pk_bf16(s[6 * 33], s[7 * 33]);
        *(GAS u32x4*)(WT + (size_t)(dst_row + n) * ldt + k0 + 8 * c) = o; }
    LDS_WAIT(); asm volatile("" ::: "memory");
}
struct ConvItem { const float* W; bf16* WT; int ldw, ldt, dst_row, k0, n0; };
__device__ __forceinline__ ConvItem moe_l1_item(const Frame& F, int it) {
    ConvItem c; const int mat = it >> 10, sub = it & 1023, which = mat >> 4, le = 16 + (mat & 15);
    if (which < 2) { c.n0 = (sub & 31) * 32; c.k0 = (sub >> 5) * 64; c.W = (which == 0 ? AIN(I_W1) : AIN(I_W3)) + (size_t)le * DM * EFF; c.ldw = EFF; c.WT = (bf16*)(F.ws + WS_W13) + (size_t)le * 2048 * 2048; c.ldt = DM; c.dst_row = (c.n0 >> 7) * 256 + which * 128 + (c.n0 & 127); }
    else { c.n0 = (sub & 63) * 32; c.k0 = (sub >> 6) * 64; c.W = AIN(I_W2) + (size_t)le * EFF * DM; c.ldw = DM; c.WT = (bf16*)(F.ws + WS_W2) + (size_t)le * 2048 * 1024; c.ldt = EFF; c.dst_row = c.n0; }
    return c;
}
__device__ __forceinline__ ConvItem early_item(const Frame& F, int it) {
    ConvItem c;
    if (it < 48 * 1024) { const int mat = it >> 10, sub = it & 1023, which = mat >> 4, le = mat & 15;
        if (which < 2) { c.n0 = (sub & 31) * 32; c.k0 = (sub >> 5) * 64; c.W = (which == 0 ? AIN(I_W1) : AIN(I_W3)) + (size_t)le * DM * EFF; c.ldw = EFF; c.WT = (bf16*)(F.ws + WS_W13) + (size_t)le * 2048 * 2048; c.ldt = DM; c.dst_row = (c.n0 >> 7) * 256 + which * 128 + (c.n0 & 127); }
        else { c.n0 = (sub & 63) * 32; c.k0 = (sub >> 6) * 64; c.W = AIN(I_W2) + (size_t)le * EFF * DM; c.ldw = DM; c.WT = (bf16*)(F.ws + WS_W2) + (size_t)le * 2048 * 1024; c.ldt = EFF; c.dst_row = c.n0; }
    } else { int r = it - 48 * 1024;
        if (r < 32 * 192) { c.n0 = (r % 192) * 32; c.k0 = (r / 192) * 64; c.W = AIN(I_HWIN); c.ldw = 3 * DM; c.WT = (bf16*)(F.ws + WS_WHYIN); c.ldt = DM; c.dst_row = c.n0; }
        else { r -= 32 * 192; c.n0 = (r % 64) * 32; c.k0 = (r / 64) * 64; c.W = AIN(I_HWOUT); c.ldw = DM; c.WT = (bf16*)(F.ws + WS_WHYO); c.ldt = DM; c.dst_row = c.n0; } }
    return c;
}
constexpr int EARLY_NIT = 48 * 1024 + 32 * 192 + 32 * 64;
__device__ __forceinline__ void conv_issue(const ConvItem& c, int lane, float (&v)[32]) {
    const float* p = c.W + (size_t)(c.k0 + (lane >> 5)) * c.ldw + c.n0 + (lane & 31); const size_t st = (size_t)2 * c.ldw;
#pragma unroll
    for (int i = 0; i < 32; ++i) { v[i] = *p; p += st; asm volatile("" : "+v"(p)); }
}
__device__ __forceinline__ void conv_finish(const ConvItem& c, int lane, const float (&v)[32]) {
    bf16* row = c.WT + (size_t)(c.dst_row + (lane & 31)) * c.ldt + c.k0 + 8 * (lane >> 5);
#pragma unroll
    for (int m = 0; m < 4; ++m) { u32x4 w;
#pragma unroll
        for (int q = 0; q < 4; ++q) { auto r = __builtin_amdgcn_permlane32_swap(__float_as_uint(v[8 * m + q]), __float_as_uint(v[8 * m + 4 + q]), false, false);
            const unsigned pk = cvt_pk_bf16(__uint_as_float(r[0]), __uint_as_float(r[1])); if (q == 0) w.x = pk; else if (q == 1) w.y = pk; else if (q == 2) w.z = pk; else w.w = pk; }
        *(GAS u32x4*)(row + 16 * m) = w; }
}
__device__ __forceinline__ void p0_prologue(Frame& F) {
    const int gw = F.bid * NWAVES + F.wave, NGW = F.G * NWAVES, gt = F.bid * NTHR + F.tid, NGT = F.G * NTHR;
#ifndef P0_REP
#define P0_REP 0
#endif
    TPS_START(20);
#pragma unroll 1
    for (int rep_a = 0; rep_a < ((P0_REP & 1) ? 2 : 1); ++rep_a) {
        LAS float* sil = (LAS float*)F.lds; LAS float* red = sil + 3 * DM;
        for (int i = F.tid; i < 3 * DM; i += NTHR) { const int v = i / DM, k = i % DM; const float cv = (v < 2) ? AIN(I_C)[v * DM + k] : AIN(I_CCTX)[k]; sil[i] = cv / (1.f + expf(-cv)); }
        __syncthreads();
        const int cl = F.tid & 7, kg = F.tid >> 3;
        for (int unit = F.bid; unit < 768; unit += F.G) {
            const int l = unit / 384, n0 = (unit % 384) * 32;
            const float* W = AIN(I_ADAW) + (size_t)l * DM * 12288 + n0 + cl * 4;
            f32x4 a0 = {0.f, 0.f, 0.f, 0.f}, a1 = a0, a2 = a0;
#pragma unroll 8
            for (int i = 0; i < 32; ++i) { const int k = kg + 64 * i; const f32x4 w = *(const f32x4*)(W + (size_t)k * 12288); a0 += w * sil[k]; a1 += w * sil[DM + k]; a2 += w * sil[2 * DM + k]; }
#pragma unroll
            for (int j = 0; j < 4; ++j) { red[(kg * 32 + cl * 4 + j) * 3 + 0] = a0[j]; red[(kg * 32 + cl * 4 + j) * 3 + 1] = a1[j]; red[(kg * 32 + cl * 4 + j) * 3 + 2] = a2[j]; }
            __syncthreads();
            if (F.tid < 96) { const int col = F.tid & 31, v = F.tid >> 5; float s = 0.f;
                for (int k = 0; k < 64; ++k) s += red[(k * 32 + col) * 3 + v];
                ((float*)(F.ws + WS_MOD))[(size_t)(l * 3 + v) * 12288 + n0 + col] = s + AIN(I_ADAB)[l * 12288 + n0 + col]; }
            __syncthreads();
        }
    }
    TPS_STOP(20); TPS_START(21);
#pragma unroll 1
    for (int rep_b = 0; rep_b < ((P0_REP & 2) ? 2 : 1); ++rep_b) {
        LAS float* scr = (LAS float*)(F.lds + F.wave * 16384);
        constexpr int I0 = 32 * 80, I1 = 32 * 64, NIT = I0 + I1 + EARLY_NIT;
        for (int it = gw; it < NIT; it += NGW) {
            int r = it;
            if (r < I0) { p0_transpose_item(AIN(I_AWIN), QKVD, (bf16*)(F.ws + WS_WQKV), DM, (r % 80) * 32, (r / 80) * 64, (r % 80) * 32, scr, F.lane); continue; } r -= I0;
            if (r < I1) { p0_transpose_item(AIN(I_AWOUT), DM, (bf16*)(F.ws + WS_WO0), DM, (r % 64) * 32, (r / 64) * 64, (r % 64) * 32, scr, F.lane); continue; } r -= I1;
            const ConvItem c = early_item(F, r); p0_transpose_item(c.W, c.ldw, c.WT, c.ldt, c.dst_row, c.k0, c.n0, scr, F.lane);
        }
    }
    TPS_STOP(21); TPS_START(22);
    {
        const int j = F.lane; const float fr = AIN(I_FFREQ)[j], b1 = AIN(I_FB1)[j], b2 = AIN(I_FB2)[j], b3 = AIN(I_FB3)[j];
        float wc1[HYEMB], wc2[HYW], wc3[HYW];
#pragma unroll
        for (int i = 0; i < HYEMB; ++i) wc1[i] = AIN(I_FW1)[i * HYW + j];
#pragma unroll
        for (int i = 0; i < HYW; ++i) { wc2[i] = AIN(I_FW2)[i * HYW + j]; wc3[i] = AIN(I_FW3)[i * HYW + j]; }
        bf16* hdn = (bf16*)(F.ws + WS_HDN);
        for (int row = gw; row < SEQ; row += NGW) {
            const float tt = (float)row / (float)(SEQ - 1); const float wv = 6.283185307179586f * (float)row / (float)SEQ;
            float zv = 0.f;
            if (j == 0) zv = tt;
            else if (j <= 32) { const int jj = (j - 1) & 15; const float f = 1e-4f + (float)jj * ((15.f - 1e-4f) / 15.f); const float a = f * wv; zv = (j <= 16) ? cosf(a) : -sinf(a); }
            float h = b1;
#pragma unroll
            for (int i = 0; i < HYEMB; ++i) h += __builtin_bit_cast(float, __builtin_amdgcn_readlane(__builtin_bit_cast(int, zv), i)) * wc1[i];
            float a1 = sinf(fr * h);
            h = b2;
#pragma unroll
            for (int i = 0; i < HYW; ++i) h += __builtin_bit_cast(float, __builtin_amdgcn_readlane(__builtin_bit_cast(int, a1), i)) * wc2[i];
            float a2 = sinf(fr * h);
            h = b3;
#pragma unroll
            for (int i = 0; i < HYW; ++i) h += __builtin_bit_cast(float, __builtin_amdgcn_readlane(__builtin_bit_cast(int, a2), i)) * wc3[i];
            const float a3 = sinf(fr * h);
            hdn[(size_t)row * 128 + j] = (bf16)(cvt_pk_bf16(a3, 0.f) & 0xffffu); hdn[(size_t)row * 128 + 64 + j] = 0;
        }
    }
    TPS_STOP(22); TPS_START(23);
    for (int i = gt; i < hy_ftab_elems(); i += NGT) ((bf16*)(F.ws + WS_FTAB))[i] = (bf16)(cvt_pk_bf16(hy_ftab_value(i >> 9, (i >> 3) & 63, i & 7), 0.f) & 0xffffu);
    for (int i = gt; i < 4096; i += NGT) { const int pos = i >> 4, dd = i & 15; const float inv = powf(10000.f, -(float)(2 * dd) / 32.f); const float a = (float)pos * inv;
        ((float*)(F.ws + WS_ROPE))[i] = cosf(a); ((float*)(F.ws + WS_ROPE))[4096 + i] = sinf(a); }
    for (int i = gt; i < 4096 * 128; i += NGT) { const int k = i >> 12, n = i & 4095;
        ((bf16*)(F.ws + WS_W4T))[(size_t)n * 128 + k] = (k < 64) ? (bf16)(cvt_pk_bf16(AIN(I_FW4)[(size_t)k * 4096 + n], 0.f) & 0xffffu) : (bf16)0; }
    TPS_STOP(23);
}

__device__ __forceinline__ void p1_prologue(Frame& F) {
    if (F.wave < 4) {
        for (int tile = F.bid * 4 + F.wave; tile < 1024; tile += F.G * 4) {
            const int r0 = (tile >> 5) * 16, n0 = (tile & 31) * 16; const int lr = F.lane & 15, kq = F.lane >> 4;
            const float* crow = AIN(I_CTX) + (size_t)(r0 + lr) * DM; const float* sh = mod_ptr(F, 0, 2, 0); const float* sc = mod_ptr(F, 0, 2, 1);
            const bf16* wrow = (const bf16*)(F.ws + WS_WQKV) + (size_t)(2048 + n0 + lr) * DM;
            f32x4 acc = {0.f, 0.f, 0.f, 0.f};
#pragma unroll 4
            for (int k0 = 0; k0 < DM; k0 += 32) { const int k = k0 + 8 * kq;
                const f32x4 x0 = *(const f32x4*)(crow + k), x1 = *(const f32x4*)(crow + k + 4), s0 = *(const f32x4*)(sc + k), s1 = *(const f32x4*)(sc + k + 4), h0 = *(const f32x4*)(sh + k), h1 = *(const f32x4*)(sh + k + 4);
                const f32x4 u0 = x0 * (s0 + 1.f) + h0, u1 = x1 * (s1 + 1.f) + h1;
                u32x4 aw; aw.x = cvt_pk_bf16(u0[0], u0[1]); aw.y = cvt_pk_bf16(u0[2], u0[3]); aw.z = cvt_pk_bf16(u1[0], u1[1]); aw.w = cvt_pk_bf16(u1[2], u1[3]);
                const bf16x8 bfrag = *(const bf16x8*)(wrow + k);
                acc = __builtin_amdgcn_mfma_f32_16x16x32_bf16(__builtin_bit_cast(bf16x8, aw), bfrag, acc, 0, 0, 0); }
            const float bb = AIN(I_ABIN)[2048 + n0 + lr]; bf16* o = (bf16*)(F.ws + WS_CTXKV);
#pragma unroll
            for (int r = 0; r < 4; ++r) o[(size_t)(r0 + 4 * kq + r) * 512 + n0 + lr] = (bf16)(cvt_pk_bf16(acc[r] + bb, 0.f) & 0xffffu);
        }
    }
    const float* x = AIN(I_X); bf16* u0 = (bf16*)(F.ws + WS_A);
    LAS int* cnt = (LAS int*)(F.lds + RING_BYTES + 64);
    const size_t NI = (size_t)MTOK * DM / 8; const size_t per = (NI + F.G - 1) / F.G; const size_t i0 = (size_t)F.bid * per; const size_t i1 = (i0 + per < NI) ? i0 + per : NI;
    const int nch = (int)((i1 - i0 + 255) / 256);
    for (;;) {
        int c = 0; if (F.lane == 0) c = __hip_atomic_fetch_add(cnt, 1, __ATOMIC_RELAXED, __HIP_MEMORY_SCOPE_WORKGROUP);
        c = __builtin_amdgcn_readfirstlane(c); if (c >= nch) break;
        f32x4 xa[4], xb[4]; size_t ee[4];
#pragma unroll
        for (int j = 0; j < 4; ++j) { const size_t i = i0 + (size_t)c * 256 + j * 64 + F.lane; ee[j] = (i < i1) ? i * 8 : (size_t)-1; if (i < i1) { xa[j] = *(const f32x4*)(x + i * 8); xb[j] = *(const f32x4*)(x + i * 8 + 4); } }
#pragma unroll
        for (int j = 0; j < 4; ++j) { if (ee[j] == (size_t)-1) continue; const size_t e = ee[j]; const int col = (int)(e & (DM - 1)); const int b = (int)(e / ((size_t)SEQ * DM));
            const float* sh = mod_ptr(F, 0, b, 0) + col; const float* sc = mod_ptr(F, 0, b, 1) + col;
            const f32x4 v0 = xa[j] * (*(const f32x4*)sc + 1.f) + *(const f32x4*)sh, v1 = xb[j] * (*(const f32x4*)(sc + 4) + 1.f) + *(const f32x4*)(sh + 4);
            u32x4 w; w.x = cvt_pk_bf16(v0[0], v0[1]); w.y = cvt_pk_bf16(v0[2], v0[3]); w.z = cvt_pk_bf16(v1[0], v1[1]); w.w = cvt_pk_bf16(v1[2], v1[3]);
            *(u32x4*)(u0 + e) = w; }
    }
}
namespace att {
constexpr int LDS_K = 0, LDS_V = 24576, LDS_WS = 49152, LDS_OST = LDS_WS + NWAVES * 64 * 4, LDS_Q = LDS_OST + NWAVES * 4096;
__device__ __forceinline__ int crow(int r, int hi) { return (r & 3) + 8 * (r >> 2) + 4 * hi; }
__device__ __forceinline__ float max3f(float a, float b, float c) { return __builtin_fmaxf(__builtin_fmaxf(a, b), c); }
__device__ __forceinline__ float rowmax(const f32x16& p0, const f32x16& p1) {
    float a = max3f(p0[0], p0[1], p1[0]), b = max3f(p0[2], p0[3], p1[1]); a = max3f(a, p1[2], p1[3]);
#pragma unroll
    for (int r = 4; r < 16; r += 4) { a = max3f(a, p0[r], p0[r + 1]); b = max3f(b, p0[r + 2], p0[r + 3]); a = max3f(a, p1[r], p1[r + 1]); b = max3f(b, p1[r + 2], p1[r + 3]); }
    const float m = __builtin_fmaxf(a, b);
    auto rr = __builtin_amdgcn_permlane32_swap(__float_as_uint(m), __float_as_uint(m), false, false);
    return __builtin_fmaxf(__uint_as_float(rr[0]), __uint_as_float(rr[1]));
}
__device__ __forceinline__ void qkt(f32x16& p0, f32x16& p1, const LAS unsigned char* Kslot, const bf16x8* qr, const f32x16& z, int r32, int hi) {
    const LAS unsigned char* kb = Kslot + hi * 1024 + r32 * 16;
#pragma unroll
    for (int d0 = 0; d0 < 4; ++d0) {
        const bf16x8 b0 = *(const LAS bf16x8*)(kb + d0 * 2048);
        const bf16x8 b1 = *(const LAS bf16x8*)(kb + d0 * 2048 + 512);
        if (d0 == 0) { p0 = __builtin_amdgcn_mfma_f32_32x32x16_bf16(b0, qr[0], z, 0, 0, 0); p1 = __builtin_amdgcn_mfma_f32_32x32x16_bf16(b1, qr[0], z, 0, 0, 0); }
        else { p0 = __builtin_amdgcn_mfma_f32_32x32x16_bf16(b0, qr[d0], p0, 0, 0, 0); p1 = __builtin_amdgcn_mfma_f32_32x32x16_bf16(b1, qr[d0], p1, 0, 0, 0); }
    }
}
__device__ __forceinline__ void pv(f32x16* o, int vb, bf16x8 pa0, bf16x8 pa1, bf16x8 pa2, bf16x8 pa3) {
#pragma unroll
    for (int d0 = 0; d0 < 2; ++d0) { s16x4 lo[4], hi[4];
#pragma unroll
        for (int ks = 0; ks < 4; ++ks) {
            asm volatile("ds_read_b64_tr_b16 %0,%1 offset:%c2" : "=&v"(lo[ks]) : "v"(vb), "i"(d0 * 4096 + ks * 1024) : "memory");
            asm volatile("ds_read_b64_tr_b16 %0,%1 offset:%c2" : "=&v"(hi[ks]) : "v"(vb), "i"(d0 * 4096 + ks * 1024 + 512) : "memory"); }
        asm volatile("s_waitcnt lgkmcnt(0)" ::: "memory"); __builtin_amdgcn_sched_barrier(0);
#define PK(k) (bf16x8){lo[k][0], lo[k][1], lo[k][2], lo[k][3], hi[k][0], hi[k][1], hi[k][2], hi[k][3]}
        o[d0] = __builtin_amdgcn_mfma_f32_32x32x16_bf16(pa0, PK(0), o[d0], 0, 0, 0);
        o[d0] = __builtin_amdgcn_mfma_f32_32x32x16_bf16(pa1, PK(1), o[d0], 0, 0, 0);
        o[d0] = __builtin_amdgcn_mfma_f32_32x32x16_bf16(pa2, PK(2), o[d0], 0, 0, 0);
        o[d0] = __builtin_amdgcn_mfma_f32_32x32x16_bf16(pa3, PK(3), o[d0], 0, 0, 0);
#undef PK
    }
}
__device__ __forceinline__ void attn_issue(const Frame& F, int u, int t, int slot) {
    const int lane = F.lane, wid = F.wave; LAS unsigned char* shm = F.lds;
    const int qb = u % (SEQ / 32), bk = u / (SEQ / 32), b = bk / NKV, kvh = bk % NKV; const int q0 = qb * 32;
    const bf16* Kb = (const bf16*)(F.ws + WS_B + 128 * MiB); const bf16* Vb = (const bf16*)(F.ws + WS_B + 144 * MiB); const bf16* CKV = (const bf16*)(F.ws + WS_CTXKV);
    const size_t tok0 = (size_t)b * SEQ; const bf16* ksrc; const bf16* vsrc;
    if (t < 4) { const int c0 = b * CTXL + t * 64;
        ksrc = CKV + (size_t)(c0 + lane) * 512 + kvh * HD + wid * 8;
        vsrc = CKV + (size_t)(c0 + 16 * (wid & 3) + (lane >> 2)) * 512 + 256 + kvh * HD + (wid >> 2) * 32 + (lane & 3) * 8;
    } else { const int key0 = ((q0 - 128) & ~63) + (t - 4) * 64;
        int kr = key0 + lane; kr = kr < 0 ? 0 : (kr > SEQ - 1 ? SEQ - 1 : kr);
        int vr = key0 + 16 * (wid & 3) + (lane >> 2); vr = vr < 0 ? 0 : (vr > SEQ - 1 ? SEQ - 1 : vr);
        ksrc = Kb + (tok0 + kr) * KVD + kvh * HD + wid * 8;
        vsrc = Vb + (tok0 + vr) * KVD + kvh * HD + (wid >> 2) * 32 + (lane & 3) * 8;
    }
    __builtin_amdgcn_global_load_lds((const unsigned*)ksrc, (LAS unsigned*)(shm + LDS_K + slot * 8192 + wid * 1024), 16, 0, 0);
    __builtin_amdgcn_global_load_lds((const unsigned*)vsrc, (LAS unsigned*)(shm + LDS_V + slot * 8192 + wid * 1024), 16, 0, 0);
    if (t == 0) {
        const bf16* Qw = (const bf16*)(F.ws + WS_B) + (tok0 + q0 + (lane & 31)) * DM + (kvh * 8 + wid) * HD + (lane >> 5) * 8;
#pragma unroll
        for (int d0 = 0; d0 < 4; ++d0) __builtin_amdgcn_global_load_lds((const unsigned*)(Qw + d0 * 16), (LAS unsigned*)(shm + LDS_Q + wid * 4096 + d0 * 1024), 16, 0, 0);
    }
}
__device__ __forceinline__ void attn_phase(const Frame& F) {
    const int NU = NB * NKV * (SEQ / 32); const int per = (NU + F.G - 1) / F.G;
    const int u0 = F.bid * per; const int u1 = (u0 + per < NU) ? u0 + per : NU; if (u0 >= u1) return;
    const int ntile = (u1 - u0) * 9;
    const int lane = F.lane, r32 = lane & 31, hi = lane >> 5, wid = F.wave;
    LAS unsigned char* shm = F.lds;
    bf16* O = (bf16*)(F.ws + WS_A);
    LAS float* wsf = (LAS float*)(shm + LDS_WS) + wid * 64;
    const int vb0 = (int)(uintptr_t)(shm + LDS_V) + ((lane >> 4) & 1) * 32 + (lane & 3) * 8 + (4 * hi + ((lane & 15) >> 2)) * 64;
    bf16x8 qr[4]; float mref = 0.f, l_reg = 0.f; f32x16 o[2]; o[0] = f32x16{}; o[1] = f32x16{}; f32x16 negm = f32x16{};
    attn_issue(F, u0, 0, 0);
    if (ntile > 1) attn_issue(F, u0, 1, 1);
    int u = u0, t = 0;
    for (int g = 0; g < ntile; ++g) {
        const int slot = g % 3;
        const int qb = u % (SEQ / 32), bk = u / (SEQ / 32), b = bk / NKV, kvh = bk % NKV; const int q0 = qb * 32; const int head = kvh * 8 + wid; const size_t tok0 = (size_t)b * SEQ;
        if (g + 1 < ntile) { if (t == 8 || (t == 0 && g > 0)) asm volatile("s_waitcnt vmcnt(6)" ::: "memory"); else asm volatile("s_waitcnt vmcnt(2)" ::: "memory"); }
        else asm volatile("s_waitcnt vmcnt(0)" ::: "memory");
        LDS_WAIT(); __builtin_amdgcn_s_barrier();
        if (g + 2 < ntile) { const int g2 = g + 2; attn_issue(F, u0 + g2 / 9, g2 % 9, g2 % 3); }
        if (t == 0) {
#pragma unroll
            for (int d0 = 0; d0 < 4; ++d0) qr[d0] = *(const LAS bf16x8*)(shm + LDS_Q + wid * 4096 + d0 * 1024 + lane * 16);
            mref = 0.f; l_reg = 0.f; o[0] = f32x16{}; o[1] = f32x16{}; negm = f32x16{}; }
        f32x16 p0, p1;
        qkt(p0, p1, shm + LDS_K + slot * 8192, qr, negm, r32, hi);
        { const int key0 = ((q0 - 128) & ~63) + (t - 4) * 64;
          if (t >= 4 && (t == 4 || t == 8 || key0 < 0 || key0 + 64 > SEQ)) { const int qpos = q0 + r32;
#pragma unroll
            for (int r = 0; r < 16; ++r) { const int k0 = key0 + crow(r, hi), k1 = k0 + 32;
                const bool v0 = (k0 >= 0) && (k0 < SEQ) && (k0 - qpos <= 128) && (qpos - k0 <= 128);
                const bool v1 = (k1 >= 0) && (k1 < SEQ) && (k1 - qpos <= 128) && (qpos - k1 <= 128);
                p0[r] = v0 ? p0[r] : -INFINITY; p1[r] = v1 ? p1[r] : -INFINITY; } } }
        const float rm = rowmax(p0, p1);
        if (__any(rm > 8.f)) {
            const float dl = __builtin_fmaxf(rm, 0.f); mref += dl;
            const float f = __builtin_amdgcn_exp2f(-dl); l_reg *= f;
#pragma unroll
            for (int r = 0; r < 16; ++r) { p0[r] -= dl; p1[r] -= dl; negm[r] = -mref; }
            if (hi == 0) wsf[r32] = f;
            LDS_WAIT();
#pragma unroll
            for (int d = 0; d < 2; ++d)
#pragma unroll
                for (int r = 0; r < 16; ++r) o[d][r] *= wsf[crow(r, hi)];
        }
        float sacc = 0.f;
#pragma unroll
        for (int r = 0; r < 16; ++r) { p0[r] = __builtin_amdgcn_exp2f(p0[r]); p1[r] = __builtin_amdgcn_exp2f(p1[r]); sacc += p0[r] + p1[r]; }
        l_reg += sacc;
        u32x4 pw0, pw1, pw2, pw3;
#define PKW(P, B) cvt_pk_bf16(P[B], P[B + 1])
        pw0 = (u32x4){PKW(p0, 0), PKW(p0, 2), PKW(p0, 4), PKW(p0, 6)}; pw1 = (u32x4){PKW(p0, 8), PKW(p0, 10), PKW(p0, 12), PKW(p0, 14)};
        pw2 = (u32x4){PKW(p1, 0), PKW(p1, 2), PKW(p1, 4), PKW(p1, 6)}; pw3 = (u32x4){PKW(p1, 8), PKW(p1, 10), PKW(p1, 12), PKW(p1, 14)};
#undef PKW
        pv(o, vb0 + slot * 8192, __builtin_bit_cast(bf16x8, pw0), __builtin_bit_cast(bf16x8, pw1), __builtin_bit_cast(bf16x8, pw2), __builtin_bit_cast(bf16x8, pw3));
        if (t == 8) {
            { auto rr = __builtin_amdgcn_permlane32_swap(__float_as_uint(l_reg), __float_as_uint(l_reg), false, false); l_reg = __uint_as_float(rr[0]) + __uint_as_float(rr[1]); }
            l_reg += __builtin_amdgcn_exp2f(AIN(I_SINK)[head] * 1.4426950408889634f - mref);
            if (hi == 0) wsf[32 + r32] = l_reg;
            LDS_WAIT();
            float rli[16];
#pragma unroll
            for (int r = 0; r < 16; ++r) rli[r] = 1.f / wsf[32 + crow(r, hi)];
            bf16* Ow = O + (tok0 + q0) * DM + head * HD;
            LAS bf16* stg = (LAS bf16*)(shm + LDS_OST) + wid * 2048;
#pragma unroll
            for (int r = 0; r < 16; ++r) { const int orow = crow(r, hi);
#pragma unroll
                for (int d0 = 0; d0 < 2; ++d0) stg[orow * 64 + d0 * 32 + r32] = (bf16)(cvt_pk_bf16(o[d0][r] * rli[r], 0.f) & 0xffffu); }
            LDS_WAIT();
#pragma unroll
            for (int i = 0; i < 4; ++i) { const int row = i * 8 + (lane >> 3), ch = lane & 7; const u32x4 v = *(const LAS u32x4*)(stg + row * 64 + ch * 8); *(u32x4*)(Ow + (size_t)row * DM + ch * 8) = v; }
        }
        if (t == 8) { t = 0; ++u; } else ++t;
    }
}
}

__device__ __forceinline__ float row16_sum(float v) {
    v += __builtin_bit_cast(float, __builtin_amdgcn_update_dpp(0, __builtin_bit_cast(int, v), 0xB1, 0xf, 0xf, true));
    v += __builtin_bit_cast(float, __builtin_amdgcn_update_dpp(0, __builtin_bit_cast(int, v), 0x4E, 0xf, 0xf, true));
    v += __builtin_bit_cast(float, __builtin_amdgcn_update_dpp(0, __builtin_bit_cast(int, v), 0x141, 0xf, 0xf, true));
    v += __builtin_bit_cast(float, __builtin_amdgcn_update_dpp(0, __builtin_bit_cast(int, v), 0x140, 0xf, 0xf, true));
    return v;
}
template <int NV> __device__ __forceinline__ void block_reduce(const float (&x)[NV], LAS float* red, LAS float* tot, int tid, int lane, int wave) {
    float y[NV / 2], z[NV / 4];
#pragma unroll
    for (int i = 0; i < NV / 2; ++i) { auto r = __builtin_amdgcn_permlane32_swap(__float_as_uint(x[i]), __float_as_uint(x[i + NV / 2]), false, false); y[i] = __uint_as_float(r[0]) + __uint_as_float(r[1]); }
#pragma unroll
    for (int i = 0; i < NV / 4; ++i) { auto r = __builtin_amdgcn_permlane16_swap(__float_as_uint(y[i]), __float_as_uint(y[i + NV / 4]), false, false); z[i] = row16_sum(__uint_as_float(r[0]) + __uint_as_float(r[1])); }
    if ((lane & 15) == 0) { const int q = lane >> 4;
#pragma unroll
        for (int i = 0; i < NV / 4; ++i) red[wave * NV + i + q * (NV / 4)] = z[i]; }
    __syncthreads();
    if (tid < NV) { float s = 0.f;
#pragma unroll
        for (int w = 0; w < NWAVES; ++w) s += red[w * NV + tid];
        tot[tid] = s; }
    __syncthreads();
}
struct LnLds { LAS float* red; LAS float* tot; LAS float* sab; LAS int* lcnt; LAS int* lbase; LAS int* lcls; LAS int* lrank; LAS float* lg; LAS float* rowtab; };
__device__ __forceinline__ LnLds ln_lds(const Frame& F) { LnLds L; L.red = (LAS float*)F.lds; L.tot = L.red + 8 * 72; L.sab = L.tot + 72; L.lcnt = (LAS int*)(L.sab + 32); L.lbase = L.lcnt + 32; L.lcls = L.lbase + 32; L.lrank = L.lcls + 256; L.lg = (LAS float*)(L.lrank + 256); L.rowtab = L.lg + 512; return L; }

template <bool HIN_F32> __device__ __forceinline__ void ln1_router_phase(const Frame& F, int layer, const void* hin_, const bf16* ymix, bf16* u2out, bf16* hout) {
    const float* hin = (const float*)hin_; const bf16* hinb = (const bf16*)hin_;
    const LnLds L = ln_lds(F);
    const int tid = F.tid, lane = F.lane, wave = F.wave, c0 = 4 * tid;
    int per = (MTOK + F.G - 1) / F.G; per = (per + 3) & ~3;
    const int rbase = F.bid * per; const int rend = (rbase + per < MTOK) ? rbase + per : MTOK; const int nrows = rend - rbase;
    if (tid < NCLS) L.lcnt[tid] = 0;
    if (nrows > 0 && nrows <= 256) {
    const int b = rbase / SEQ;
    const f32x4 g1 = *(const f32x4*)(mod_ptr(F, layer, b, 2) + c0), sh2 = *(const f32x4*)(mod_ptr(F, layer, b, 3) + c0), sc2 = *(const f32x4*)(mod_ptr(F, layer, b, 4) + c0);
    const f32x4 A0 = *(const f32x4*)(AIN(I_LN1G) + layer * DM + c0), B0 = *(const f32x4*)(AIN(I_LN1B) + layer * DM + c0);
    const f32x4 A1 = A0 * (sc2 + 1.f), B1 = B0 * (sc2 + 1.f) + sh2;
    f32x4 P[4][4];
    { float sx[32];
#pragma unroll
      for (int c = 0; c < 4; ++c)
#pragma unroll
          for (int g = 0; g < 4; ++g) { const f32x4 w = *(const f32x4*)(AIN(I_RW) + (size_t)(c0 + c) * NEXP + 4 * g); P[c][g] = w * A1[c];
#pragma unroll
              for (int i = 0; i < 4; ++i) { if (c == 0) { sx[g * 4 + i] = 0.f; sx[16 + g * 4 + i] = 0.f; } sx[g * 4 + i] += w[i] * A1[c]; sx[16 + g * 4 + i] += w[i] * B1[c]; } }
      block_reduce<32>(sx, L.red, L.tot, tid, lane, wave);
      if (tid < 32) L.sab[tid] = L.tot[tid];
      __syncthreads(); }
    const float* rb = AIN(I_RB);
    f32x4 hf[4], hf2[4]; u32x2 hb[4], hb2[4]; u32x2 yv[4], yv2[4];
#define LN_LOADH(k, r_, o) do { if (HIN_F32) hf##k[r_] = *(const f32x4*)(hin + (o)); else hb##k[r_] = *(const u32x2*)(hinb + (o)); } while (0)
#pragma unroll
    for (int r = 0; r < 4; ++r) { const size_t o = (size_t)(rbase + r) * DM + c0; LN_LOADH(, r, o); yv[r] = *(const u32x2*)(ymix + o); }
    { const int pr0 = (rbase + 4 < rend) ? rbase + 4 : rend - 4;
#pragma unroll
      for (int r = 0; r < 4; ++r) { const size_t o = (size_t)(pr0 + r) * DM + c0; LN_LOADH(2, r, o); yv2[r] = *(const u32x2*)(ymix + o); } }
    for (int row0 = rbase; row0 < rend; row0 += 4) {
        f32x4 v[4]; float x[72];
#pragma unroll
        for (int r = 0; r < 4; ++r) { const f32x4 y = {bflo(yv[r].x), bfhi(yv[r].x), bflo(yv[r].y), bfhi(yv[r].y)};
            const f32x4 hq = HIN_F32 ? hf[r] : (f32x4){bflo(hb[r].x), bfhi(hb[r].x), bflo(hb[r].y), bfhi(hb[r].y)};
            v[r] = hq * DN_ALPHA + g1 * y;
            x[r * 18] = (v[r][0] + v[r][1]) + (v[r][2] + v[r][3]); x[r * 18 + 1] = (v[r][0] * v[r][0] + v[r][1] * v[r][1]) + (v[r][2] * v[r][2] + v[r][3] * v[r][3]);
#pragma unroll
            for (int g = 0; g < 4; ++g) { const f32x4 q = P[0][g] * v[r][0] + P[1][g] * v[r][1] + P[2][g] * v[r][2] + P[3][g] * v[r][3];
                x[r * 18 + 2 + 4 * g] = q[0]; x[r * 18 + 3 + 4 * g] = q[1]; x[r * 18 + 4 + 4 * g] = q[2]; x[r * 18 + 5 + 4 * g] = q[3]; } }
#pragma unroll
        for (int r = 0; r < 4; ++r) { hf[r] = hf2[r]; hb[r] = hb2[r]; yv[r] = yv2[r]; }
        { const int pr0 = (row0 + 8 < rend) ? row0 + 8 : rend - 4;
#pragma unroll
          for (int r = 0; r < 4; ++r) { const size_t o = (size_t)(pr0 + r) * DM + c0; LN_LOADH(2, r, o); yv2[r] = *(const u32x2*)(ymix + o); } }
        LAS float* gt = L.rowtab + ((row0 - rbase) >> 2) * 72;
        block_reduce<72>(x, L.red, gt, tid, lane, wave);
#pragma unroll
        for (int r = 0; r < 4; ++r) { const float mean = gt[r * 18] * (1.f / DM); const float var = gt[r * 18 + 1] * (1.f / DM) - mean * mean; const float rstd = 1.f / sqrtf(var + LN_EPS);
            const f32x4 vn = (v[r] - mean) * rstd; const f32x4 hn = vn * A0 + B0, u = vn * A1 + B1; const size_t o = (size_t)(row0 + r) * DM + c0;
            u32x2 hw; hw.x = cvt_pk_bf16(hn[0], hn[1]); hw.y = cvt_pk_bf16(hn[2], hn[3]); *(u32x2*)(hout + o) = hw; u32x2 w; w.x = cvt_pk_bf16(u[0], u[1]); w.y = cvt_pk_bf16(u[2], u[3]); *(u32x2*)(u2out + o) = w; }
    }
    __syncthreads();
    if (tid < nrows) {
            const int rl = tid; const LAS float* gt = L.rowtab + (rl >> 2) * 72 + (rl & 3) * 18;
            const float mean = gt[0] * (1.f / DM); const float var = gt[1] * (1.f / DM) - mean * mean; const float rstd = 1.f / sqrtf(var + LN_EPS);
            float sg[16], sel[16];
#pragma unroll
            for (int e = 0; e < 16; ++e) { const float lgt = rstd * (gt[2 + e] - mean * L.sab[e]) + L.sab[16 + e]; const float sv = 1.f / (1.f + expf(-lgt)); sg[e] = sv; sel[e] = sv + rb[e]; }
            int gb = 0; float gbs = -INFINITY;
#pragma unroll
            for (int g = 0; g < 4; ++g) { const float a = sel[4 * g], bq = sel[4 * g + 1], c = sel[4 * g + 2], d = sel[4 * g + 3];
                const float ps = fmaxf(fmaxf(fmaxf(a + bq, a + c), fmaxf(a + d, bq + c)), fmaxf(bq + d, c + d)); if (ps > gbs) { gbs = ps; gb = g; } }
            float cs[4], cg[4];
#pragma unroll
            for (int i = 0; i < 4; ++i) { cs[i] = sel[i]; cg[i] = sg[i];
#pragma unroll
                for (int g = 1; g < 4; ++g) if (gb == g) { cs[i] = sel[4 * g + i]; cg[i] = sg[4 * g + i]; } }
            int i0 = 0; float b0 = cs[0];
#pragma unroll
            for (int i = 1; i < 4; ++i) if (cs[i] > b0) { b0 = cs[i]; i0 = i; }
            int i1 = -1; float b1 = -INFINITY;
#pragma unroll
            for (int i = 0; i < 4; ++i) if (i != i0 && cs[i] > b1) { b1 = cs[i]; i1 = i; }
            float ga = 0.f, gbv = 0.f;
#pragma unroll
            for (int i = 0; i < 4; ++i) { if (i == i0) ga = cg[i]; if (i == i1) gbv = cg[i]; }
            const float den = ga + gbv; ga /= den; gbv /= den;
            const int lo = i0 < i1 ? i0 : i1, hi = i0 < i1 ? i1 : i0; const float glo = i0 < i1 ? ga : gbv, ghi = i0 < i1 ? gbv : ga;
            const int pidx = (lo == 0) ? (hi - 1) : (lo == 1 ? hi + 1 : 5);
            const int cls = gb * 6 + pidx;
            L.lcls[rl] = cls; L.lrank[rl] = __hip_atomic_fetch_add(&L.lcnt[cls], 1, __ATOMIC_RELAXED, __HIP_MEMORY_SCOPE_WORKGROUP); L.lg[2 * rl] = glo; L.lg[2 * rl + 1] = ghi;
    }
    }
    __syncthreads();
    if (tid < NCLS) L.lbase[tid] = (int)__hip_atomic_fetch_add((unsigned*)(F.ctl + CW_CNT + (layer * NCLS + tid) * 64), (unsigned)L.lcnt[tid], RLX_AGENT);
    __syncthreads();
    if (tid < nrows && nrows <= 256) { const int cls = L.lcls[tid]; const int pos = cls * LCAP + L.lbase[cls] + L.lrank[tid];
        ((int*)(F.ws + WS_TOK))[pos] = rbase + tid; ((float*)(F.ws + WS_GATE))[pos] = L.lg[2 * tid]; ((float*)(F.ws + WS_GATE))[(size_t)NCLS * LCAP + pos] = L.lg[2 * tid + 1]; }
}
#undef LN_LOADH
template <bool OUT_F32> __device__ __forceinline__ void ln2_phase(const Frame& F, int layer, bf16* fio, const bf16* hinb, void* hout_) {
    float* houtf = (float*)hout_; bf16* houtb = (bf16*)hout_;
    const LnLds L = ln_lds(F);
    const int tid = F.tid, lane = F.lane, wave = F.wave, c0 = 4 * tid;
    int per = (MTOK + F.G - 1) / F.G; per = (per + 3) & ~3;
    const int rbase = F.bid * per; const int rend = (rbase + per < MTOK) ? rbase + per : MTOK;
    if (rbase >= rend) return;
    const int b = rbase / SEQ;
    const f32x4 g2 = *(const f32x4*)(mod_ptr(F, layer, b, 5) + c0), sh1 = *(const f32x4*)(mod_ptr(F, 1, b, 0) + c0), sc1 = *(const f32x4*)(mod_ptr(F, 1, b, 1) + c0);
    const f32x4 A0 = *(const f32x4*)(AIN(I_LN2G) + layer * DM + c0), B0 = *(const f32x4*)(AIN(I_LN2B) + layer * DM + c0);
    const f32x4 A1 = A0 * (sc1 + 1.f), B1 = B0 * (sc1 + 1.f) + sh1;
    u32x2 hw[4], hw2[4], hw3[4]; u32x2 yv[4], yv2[4], yv3[4];
#pragma unroll
    for (int r = 0; r < 4; ++r) { const size_t o = (size_t)(rbase + r) * DM + c0; hw[r] = *(const u32x2*)(hinb + o); yv[r] = *(const u32x2*)(fio + o); }
#pragma unroll
    for (int r = 0; r < 4; ++r) { const size_t o = (size_t)(rbase + 4 + r) * DM + c0; if (rbase + 4 < rend) { hw2[r] = *(const u32x2*)(hinb + o); yv2[r] = *(const u32x2*)(fio + o); } }
#pragma unroll
    for (int r = 0; r < 4; ++r) { const size_t o = (size_t)(rbase + 8 + r) * DM + c0; if (rbase + 8 < rend) { hw3[r] = *(const u32x2*)(hinb + o); yv3[r] = *(const u32x2*)(fio + o); } }
    for (int row0 = rbase; row0 < rend; row0 += 4) {
        f32x4 v[4]; float x[8];
#pragma unroll
        for (int r = 0; r < 4; ++r) { const f32x4 y = {bflo(yv[r].x), bfhi(yv[r].x), bflo(yv[r].y), bfhi(yv[r].y)}; const f32x4 hvr = {bflo(hw[r].x), bfhi(hw[r].x), bflo(hw[r].y), bfhi(hw[r].y)}; v[r] = hvr * DN_ALPHA + g2 * y;
            x[r * 2] = (v[r][0] + v[r][1]) + (v[r][2] + v[r][3]); x[r * 2 + 1] = (v[r][0] * v[r][0] + v[r][1] * v[r][1]) + (v[r][2] * v[r][2] + v[r][3] * v[r][3]); }
#pragma unroll
        for (int r = 0; r < 4; ++r) { hw[r] = hw2[r]; yv[r] = yv2[r]; hw2[r] = hw3[r]; yv2[r] = yv3[r]; }
        if (row0 + 12 < rend) {
#pragma unroll
            for (int r = 0; r < 4; ++r) { const size_t o = (size_t)(row0 + 12 + r) * DM + c0; hw3[r] = *(const u32x2*)(hinb + o); yv3[r] = *(const u32x2*)(fio + o); } }
        block_reduce<8>(x, L.red, L.tot, tid, lane, wave);
#pragma unroll
        for (int r = 0; r < 4; ++r) { const float mean = L.tot[r * 2] * (1.f / DM); const float var = L.tot[r * 2 + 1] * (1.f / DM) - mean * mean; const float rstd = 1.f / sqrtf(var + LN_EPS);
            const f32x4 vn = (v[r] - mean) * rstd; const f32x4 hn = vn * A0 + B0; const size_t o = (size_t)(row0 + r) * DM + c0;
            if (OUT_F32) *(f32x4*)(houtf + o) = hn; else { u32x2 hw; hw.x = cvt_pk_bf16(hn[0], hn[1]); hw.y = cvt_pk_bf16(hn[2], hn[3]); *(u32x2*)(houtb + o) = hw; }
            if (layer == 0) { const f32x4 u = vn * A1 + B1; u32x2 w; w.x = cvt_pk_bf16(u[0], u[1]); w.y = cvt_pk_bf16(u[2], u[3]); *(u32x2*)(fio + o) = w; } }
    }
}
namespace hy {
constexpr int L = SEQ;
__device__ constexpr float C32[16] = {1.000000000e+00f, 9.807852804e-01f, 9.238795325e-01f, 8.314696123e-01f, 7.071067812e-01f, 5.555702330e-01f, 3.826834324e-01f, 1.950903220e-01f,
                                      0.f, -1.950903220e-01f, -3.826834324e-01f, -5.555702330e-01f, -7.071067812e-01f, -8.314696123e-01f, -9.238795325e-01f, -9.807852804e-01f};
__device__ constexpr float S32[16] = {0.f, 1.950903220e-01f, 3.826834324e-01f, 5.555702330e-01f, 7.071067812e-01f, 8.314696123e-01f, 9.238795325e-01f, 9.807852804e-01f,
                                      1.f, 9.807852804e-01f, 9.238795325e-01f, 8.314696123e-01f, 7.071067812e-01f, 5.555702330e-01f, 3.826834324e-01f, 1.950903220e-01f};
__host__ __device__ constexpr int brev(int k, int bits) { int r = 0; for (int i = 0; i < bits; ++i) r |= ((k >> i) & 1) << (bits - 1 - i); return r; }
__device__ __forceinline__ void unit_root(float frac, bool inv, float& wr, float& wi) {
    wr = __builtin_amdgcn_cosf(frac); float s = __builtin_amdgcn_sinf(frac);
    asm volatile("s_nop 1" : "+v"(wr), "+v"(s));
    wi = inv ? s : -s;
}
constexpr int FT_F32 = 0, FT_I32 = 8, FT_I32P = 16, FT_F16 = 24, FT_I16 = 26, FT_NFRAG = 28;
__device__ __forceinline__ int crow(int r, int h) { return (r & 3) + 8 * (r >> 2) + 4 * h; }
__device__ __forceinline__ bf16x8 pack8(const float (&v)[8]) { u32x4 w; w.x = cvt_pk_bf16(v[0], v[1]); w.y = cvt_pk_bf16(v[2], v[3]); w.z = cvt_pk_bf16(v[4], v[5]); w.w = cvt_pk_bf16(v[6], v[7]); return __builtin_bit_cast(bf16x8, w); }
__device__ __forceinline__ void cmul(float& xr, float& xi, float wr, float wi) {
    float t0, t1, nr, ni;
    asm("v_mul_f32_e32 %0, %1, %2" : "=v"(t0) : "v"(xi), "v"(wi));
    asm("v_mul_f32_e32 %0, %1, %2" : "=v"(t1) : "v"(xi), "v"(wr));
    asm("v_fma_f32 %0, %1, %2, -%3" : "=v"(nr) : "v"(xr), "v"(wr), "v"(t0));
    asm("v_fma_f32 %0, %1, %2, %3" : "=v"(ni) : "v"(xr), "v"(wi), "v"(t1));
    xr = nr; xi = ni;
}
#define FRAG(f) (tab[(f) * 64 + lane])
template <bool INV> __device__ __forceinline__ void pass1(LAS f32x2* dat, const LAS bf16x8* tab, int lane, int wave) {
    asm volatile("" : "+v"(lane));
    const int h = lane >> 5, c5 = lane & 31;
    const bf16x8 a0 = FRAG((INV ? FT_I16 : FT_F16) + 0), a1 = FRAG((INV ? FT_I16 : FT_F16) + 1);
#pragma unroll 1
    for (int g = 0; g < 4; ++g) {
        const int col = 128 * wave + 32 * g + c5; const int pc = col ^ ((4 * wave + g) & 31) ^ ((2 * g + (c5 >> 4)) & 7);
        float wr, wi; unit_root((float)col * (1.f / 16384.f), INV, wr, wi);
        float w2r = wr, w2i = wi; cmul(w2r, w2i, wr, wi); float w4r = w2r, w4i = w2i; cmul(w4r, w4i, w2r, w2i); float w8r = w4r, w8i = w4i; cmul(w8r, w8i, w4r, w4i);
        float re[8], im[8];
#pragma unroll
        for (int jj = 0; jj < 8; ++jj) { const f32x2 v = dat[pc + 1024 * (8 * h + jj)]; re[jj] = v.x; im[jj] = v.y; }
        if (INV) {
            float cr = h ? w8r : 1.f, ci = h ? w8i : 0.f;
#pragma unroll
            for (int jj = 0; jj < 8; ++jj) { cmul(re[jj], im[jj], cr, ci); cmul(cr, ci, wr, wi); }
        }
        const f32x16 z = {};
        f32x16 d = __builtin_amdgcn_mfma_f32_32x32x16_bf16(a0, pack8(re), z, 0, 0, 0);
        d = __builtin_amdgcn_mfma_f32_32x32x16_bf16(a1, pack8(im), d, 0, 0, 0);
        asm volatile("s_nop 15\n\ts_nop 7" : "+v"(d));
        float cr = h ? w4r : 1.f, ci = h ? w4i : 0.f;
#pragma unroll
        for (int rr = 0; rr < 8; ++rr) { float xr = d[rr], xi = d[rr + 8];
            if (!INV) { if (rr == 4) { cr = h ? w4r : 1.f; ci = h ? w4i : 0.f; cmul(cr, ci, w8r, w8i); } cmul(xr, xi, cr, ci); cmul(cr, ci, wr, wi); }
            f32x2 o; o.x = xr; o.y = xi; dat[pc + 1024 * ((rr & 3) + 8 * (rr >> 2) + 4 * h)] = o; }
    }
}
template <bool INV> __device__ __forceinline__ void pass2(LAS f32x2* dat, const LAS bf16x8* tab, int lane, int wave) {
    asm volatile("" : "+v"(lane));
    const int h = lane >> 5, b = lane & 31, bp = b ^ (b >> 4);
    float wr, wi; unit_root((float)b * (1.f / 1024.f), INV, wr, wi);
    float w2r = wr, w2i = wi; cmul(w2r, w2i, wr, wi); float w4r = w2r, w4i = w2i; cmul(w4r, w4i, w2r, w2i); float w8r = w4r, w8i = w4i; cmul(w8r, w8i, w4r, w4i); float w16r = w8r, w16i = w8i; cmul(w16r, w16i, w8r, w8i);
#pragma unroll 1
    for (int g = 0; g < 2; ++g) {
        const int base = (2 * wave + g) * 1024;
        float re[2][8], im[2][8];
#pragma unroll
        for (int hf = 0; hf < 2; ++hf)
#pragma unroll
            for (int jj = 0; jj < 8; ++jj) { const int n = 16 * hf + 8 * h + jj; const f32x2 v = dat[base + 32 * n + (bp ^ (16 * hf + 8 * h + (jj ^ ((2 * jj) & 7))))]; re[hf][jj] = v.x; im[hf][jj] = v.y; }
        if (INV) {
            float cr = h ? w8r : 1.f, ci = h ? w8i : 0.f;
#pragma unroll
            for (int jj = 0; jj < 8; ++jj) { cmul(re[0][jj], im[0][jj], cr, ci); float dr = cr, di = ci; cmul(dr, di, w16r, w16i); cmul(re[1][jj], im[1][jj], dr, di); cmul(cr, ci, wr, wi); }
        }
        const bf16x8 b0 = pack8(re[0]), b1 = pack8(re[1]), b2 = pack8(im[0]), b3 = pack8(im[1]);
        const int fb = INV ? FT_I32 : FT_F32; const f32x16 z = {};
        f32x16 dre = __builtin_amdgcn_mfma_f32_32x32x16_bf16(FRAG(fb + 0), b0, z, 0, 0, 0); f32x16 dim = __builtin_amdgcn_mfma_f32_32x32x16_bf16(FRAG(fb + 4), b0, z, 0, 0, 0);
        dre = __builtin_amdgcn_mfma_f32_32x32x16_bf16(FRAG(fb + 1), b1, dre, 0, 0, 0); dim = __builtin_amdgcn_mfma_f32_32x32x16_bf16(FRAG(fb + 5), b1, dim, 0, 0, 0);
        dre = __builtin_amdgcn_mfma_f32_32x32x16_bf16(FRAG(fb + 2), b2, dre, 0, 0, 0); dim = __builtin_amdgcn_mfma_f32_32x32x16_bf16(FRAG(fb + 6), b2, dim, 0, 0, 0);
        dre = __builtin_amdgcn_mfma_f32_32x32x16_bf16(FRAG(fb + 3), b3, dre, 0, 0, 0); dim = __builtin_amdgcn_mfma_f32_32x32x16_bf16(FRAG(fb + 7), b3, dim, 0, 0, 0);
        asm volatile("s_nop 15\n\ts_nop 7" : "+v"(dre), "+v"(dim));
        float gr = h ? w4r : 1.f, gi = h ? w4i : 0.f;
#pragma unroll
        for (int r = 0; r < 16; ++r) { float xr = dre[r], xi = dim[r]; const int kf = (r & 3) + 8 * (r >> 2) + 4 * h;
            if (!INV) { float cr = gr, ci = gi; if ((r & 3) == 1) cmul(cr, ci, wr, wi); if ((r & 3) == 2) cmul(cr, ci, w2r, w2i); if ((r & 3) == 3) { cmul(cr, ci, w2r, w2i); cmul(cr, ci, wr, wi); }
                cmul(xr, xi, cr, ci); if ((r & 3) == 3) cmul(gr, gi, w8r, w8i); }
            f32x2 o; o.x = xr; o.y = xi; dat[base + 32 * kf + (bp ^ kf ^ (2 * (r & 3)))] = o; }
    }
}
template <bool FILTER> __device__ __forceinline__ void pass3(LAS f32x2* dat, const LAS bf16x8* tab, int lane, int wave, const int g, f32x2* Kbuf, const f32x2 (&kpre)[16]) {
    asm volatile("" : "+v"(lane));
    const int h = lane >> 5, sw = lane & 31, swp = sw ^ (2 * (sw & 3));
    {
        const int q = 64 * wave + 32 * g + sw, base = 32 * q;
        float re[2][8], im[2][8];
#pragma unroll
        for (int hf = 0; hf < 2; ++hf)
#pragma unroll
            for (int jj = 0; jj < 8; ++jj) { const int n = 16 * hf + 8 * h + jj; const f32x2 v = dat[base + (n ^ swp ^ hf)]; re[hf][jj] = v.x; im[hf][jj] = v.y; }
        const bf16x8 b0 = pack8(re[0]), b1 = pack8(re[1]), b2 = pack8(im[0]), b3 = pack8(im[1]);
        const f32x16 z = {};
        f32x16 dre = __builtin_amdgcn_mfma_f32_32x32x16_bf16(FRAG(FT_F32 + 0), b0, z, 0, 0, 0); f32x16 dim = __builtin_amdgcn_mfma_f32_32x32x16_bf16(FRAG(FT_F32 + 4), b0, z, 0, 0, 0);
        dre = __builtin_amdgcn_mfma_f32_32x32x16_bf16(FRAG(FT_F32 + 1), b1, dre, 0, 0, 0); dim = __builtin_amdgcn_mfma_f32_32x32x16_bf16(FRAG(FT_F32 + 5), b1, dim, 0, 0, 0);
        dre = __builtin_amdgcn_mfma_f32_32x32x16_bf16(FRAG(FT_F32 + 2), b2, dre, 0, 0, 0); dim = __builtin_amdgcn_mfma_f32_32x32x16_bf16(FRAG(FT_F32 + 6), b2, dim, 0, 0, 0);
        dre = __builtin_amdgcn_mfma_f32_32x32x16_bf16(FRAG(FT_F32 + 3), b3, dre, 0, 0, 0); dim = __builtin_amdgcn_mfma_f32_32x32x16_bf16(FRAG(FT_F32 + 7), b3, dim, 0, 0, 0);
        asm volatile("s_nop 15\n\ts_nop 7" : "+v"(dre), "+v"(dim));
        if (FILTER) {
#pragma unroll
            for (int r = 0; r < 16; ++r) { f32x2 o; o.x = dre[r]; o.y = dim[r]; Kbuf[((r & 3) + 8 * (r >> 2) + 4 * h) * 512 + q] = o; }
        } else {
            float yr[16], yi[16];
#pragma unroll
            for (int r = 0; r < 16; ++r) { const f32x2 kv = kpre[r]; float a_ = dre[r], b_ = dim[r]; cmul(a_, b_, kv.x, kv.y); yr[r] = a_; yi[r] = b_; }
            float t0[8], t1[8], t2[8], t3[8];
#pragma unroll
            for (int j = 0; j < 8; ++j) { t0[j] = yr[j]; t1[j] = yr[8 + j]; t2[j] = yi[j]; t3[j] = yi[8 + j]; }
            const bf16x8 c0 = pack8(t0), c1 = pack8(t1), c2 = pack8(t2), c3 = pack8(t3);
            f32x16 ere = __builtin_amdgcn_mfma_f32_32x32x16_bf16(FRAG(FT_I32P + 0), c0, z, 0, 0, 0); f32x16 eim = __builtin_amdgcn_mfma_f32_32x32x16_bf16(FRAG(FT_I32P + 4), c0, z, 0, 0, 0);
            ere = __builtin_amdgcn_mfma_f32_32x32x16_bf16(FRAG(FT_I32P + 1), c1, ere, 0, 0, 0); eim = __builtin_amdgcn_mfma_f32_32x32x16_bf16(FRAG(FT_I32P + 5), c1, eim, 0, 0, 0);
            ere = __builtin_amdgcn_mfma_f32_32x32x16_bf16(FRAG(FT_I32P + 2), c2, ere, 0, 0, 0); eim = __builtin_amdgcn_mfma_f32_32x32x16_bf16(FRAG(FT_I32P + 6), c2, eim, 0, 0, 0);
            ere = __builtin_amdgcn_mfma_f32_32x32x16_bf16(FRAG(FT_I32P + 3), c3, ere, 0, 0, 0); eim = __builtin_amdgcn_mfma_f32_32x32x16_bf16(FRAG(FT_I32P + 7), c3, eim, 0, 0, 0);
#pragma unroll
            for (int r = 0; r < 16; ++r) { f32x2 o; o.x = ere[r]; o.y = eim[r]; dat[base + ((((r & 3) + 8 * (r >> 2) + 4 * h)) ^ swp ^ (r >> 3))] = o; }
        }
    }
}
#undef FRAG
__device__ __forceinline__ float ftab_value(int f, int l, int jj) {
    const int r = l & 31, h = l >> 5;
    if (f < 24) {
        const int kind = f >> 3, rb = (f >> 2) & 1, s = f & 3; int kk, pp;
        if (kind < 2) { kk = 16 * (s & 1) + 8 * h + jj; pp = s >> 1; } else { kk = 16 * (s & 1) + 8 * (jj >> 2) + 4 * h + (jj & 3); pp = s >> 1; }
        const float th = 6.283185307179586f * (float)((r * kk) & 31) * (1.f / 32.f); const float c = cosf(th), sn = sinf(th);
        if (kind == 0) return rb == 0 ? (pp == 0 ? c : sn) : (pp == 0 ? -sn : c);
        return rb == 0 ? (pp == 0 ? c : -sn) : (pp == 0 ? sn : c);
    }
    const int inv = (f - 24) >> 1, s = (f - 24) & 1; const int part = r >> 4, kf = r & 15, n = 8 * h + jj;
    const float th = 6.283185307179586f * (float)((kf * n) & 15) * (1.f / 16.f); const float c = cosf(th), sn = sinf(th);
    if (!inv) return part == 0 ? (s == 0 ? c : sn) : (s == 0 ? -sn : c);
    return part == 0 ? (s == 0 ? c : -sn) : (s == 0 ? sn : c);
}
__device__ __forceinline__ int phys(int p) { return p ^ ((p >> 5) & 31) ^ ((p >> 4) & 7); }
__device__ __forceinline__ void unpack8(const u32x4 v, float (&f)[8]) { f[0] = bflo(v.x); f[1] = bfhi(v.x); f[2] = bflo(v.y); f[3] = bfhi(v.y); f[4] = bflo(v.z); f[5] = bfhi(v.z); f[6] = bflo(v.w); f[7] = bfhi(v.w); }
struct Raw8 { u32x4 v; unsigned l, r; };
__device__ __forceinline__ Raw8 load_raw8(const bf16* rowp, int t0) { Raw8 q; q.v = *(const u32x4*)(rowp + t0); q.l = (t0 > 0) ? (unsigned)rowp[t0 - 1] : 0u; q.r = (t0 + 8 < L) ? (unsigned)rowp[t0 + 8] : 0u; return q; }
__device__ __forceinline__ void conv8(const Raw8& q, float w0, float w1, float w2, float cb, float (&o)[8]) {
    float f[8]; unpack8(q.v, f); const float left = bf2f(q.l), right = bf2f(q.r);
#pragma unroll
    for (int e = 0; e < 8; ++e) { const float a = (e == 0) ? left : f[e - 1], c = (e == 7) ? right : f[e + 1]; o[e] = w0 * a + w1 * f[e] + w2 * c + cb; }
}
typedef const LAS float* ChanPar;
struct RawZ { Raw8 x[2], v[2]; };
__device__ __forceinline__ RawZ load_rawz(const bf16* pT, int d, int t0) { RawZ q;
#pragma unroll
    for (int bt = 0; bt < 2; ++bt) { q.x[bt] = load_raw8(pT + (size_t)(DM + d) * MTOK + bt * L, t0); q.v[bt] = load_raw8(pT + (size_t)(2 * DM + d) * MTOK + bt * L, t0); }
    return q; }
__device__ __forceinline__ void z_from_raw(const RawZ& q, ChanPar P, float (&z0)[8], float (&z1)[8]) {
#pragma unroll
    for (int bt = 0; bt < 2; ++bt) { float a[8], v[8];
        conv8(q.x[bt], P[4], P[5], P[6], P[7], a); conv8(q.v[bt], P[8], P[9], P[10], P[11], v);
#pragma unroll
        for (int e = 0; e < 8; ++e) { if (bt == 0) z0[e] = a[e] * v[e]; else z1[e] = a[e] * v[e]; } }
}
struct RawF { u32x4 hf, hb; unsigned first; };
__device__ __forceinline__ RawF load_rawf(const bf16* HT, int d, int t0) { RawF q; q.hf = *(const u32x4*)(HT + (size_t)d * L + t0); q.hb = *(const u32x4*)(HT + (size_t)(DM + d) * L + (L - t0 - 8));
    q.first = (t0 > 0) ? (unsigned)HT[(size_t)(DM + d) * L + (L - t0)] : 0u; return q; }
__device__ __forceinline__ void filt8(const RawF& q, int t0, ChanPar P, float (&k)[8], float (&kl)[8], float& l1p) {
    float hf[8], hb[8]; unpack8(q.hf, hf); unpack8(q.hb, hb);
    float s = 0.f;
#pragma unroll
    for (int e = 0; e < 8; ++e) { const float dc = __builtin_amdgcn_exp2f(-(float)(t0 + e) * P[13]); k[e] = hf[e] * dc; s += fabsf(k[e]); }
    float hbd[8];
#pragma unroll
    for (int e = 0; e < 8; ++e) { const int m = L - t0 - 8 + e; const float dc = __builtin_amdgcn_exp2f(-(float)m * P[13]); hbd[e] = hb[e] * dc; if (m >= 1) s += fabsf(hbd[e]); }
    kl[0] = (t0 > 0) ? bf2f(q.first) * __builtin_amdgcn_exp2f(-(float)(L - t0) * P[13]) : 0.f;
#pragma unroll
    for (int e = 1; e < 8; ++e) kl[e] = hbd[8 - e];
#pragma unroll
    for (int e = 0; e < 8; ++e) { k[e] *= P[14]; kl[e] *= P[14]; }
    l1p = s;
}
__device__ __forceinline__ void hyena_phase(const Frame& F) {
    LAS f32x2* dat = (LAS f32x2*)F.lds; LAS float* redu = (LAS float*)(F.lds + RING_BYTES);
    const bf16* pT = (const bf16*)(F.ws + WS_B); const bf16* HT = (const bf16*)(F.ws + WS_HT); bf16* yT = (bf16*)(F.ws + WS_A);
    const LAS bf16x8* tab = (const LAS bf16x8*)(F.lds + FTAB_OFF);
    for (int i = F.tid; i < FT_NFRAG * 64; i += NTHR) ((LAS u32x4*)(F.lds + FTAB_OFF))[i] = ((const u32x4*)(F.ws + WS_FTAB))[i];
    __syncthreads();
    f32x2* Ke = (f32x2*)(F.ws + WS_FFTS) + (size_t)F.bid * 49152; f32x2* Ko = Ke + 16384; f32x2* SeB = Ke + 32768;
    RawF rf[4];
    { const int tq = fresh_tid(F.wave); if (F.bid < DM) {
#pragma unroll
        for (int sI = 0; sI < 4; ++sI) rf[sI] = load_rawf((const bf16*)(F.ws + WS_HT), F.bid, 8 * (tq + 512 * sI)); } }
    const int cv_gw = F.bid * NWAVES + F.wave, cv_ngw = F.G * NWAVES; int cv_it = cv_gw; constexpr int CV_NIT = 48 * 1024;
    for (int d = F.bid; d < DM; d += F.G) {
        int tid = fresh_tid(F.wave);
        TPS_START(1);
        LAS float* PW = (LAS float*)(F.lds + RING_BYTES + 64); ChanPar P = PW;
        __syncthreads();
        if (tid < 12) { const int i = tid & 3, pj = tid >> 2; PW[tid] = (i < 3) ? AIN(I_HCW)[i * 3 * DM + pj * DM + d] : AIN(I_HCB)[pj * DM + d]; }
        if (tid == 12) PW[12] = AIN(I_FBIAS)[d];
        if (tid == 13) { const float mind = -4.605170185988091f / 1.5f, maxd = -4.605170185988091f / 0.3f; const float delta = fabsf(mind + (maxd - mind) * ((float)d / (float)(DM - 1)));
            PW[13] = delta * (1.f / (float)(L - 1)) * 1.4426950408889634f; PW[14] = 1.f; }
        __syncthreads();
        TPS_STOP(1); TPS_START(2);
#pragma unroll 1
        for (int odd = 0; odd < 2; ++odd) {
            asm volatile("" : "+v"(tid));
            float l1s = 0.f;
#pragma unroll
            for (int sI = 0; sI < 4; ++sI) { const int t0 = 8 * (tid + 512 * sI); float k[8], kl[8], l1p; filt8(rf[sI], t0, P, k, kl, l1p); l1s += l1p;
#pragma unroll
                for (int e = 0; e < 8; ++e) { f32x2 o; if (!odd) { o.x = k[e] + kl[e]; o.y = 0.f; } else { const float a = k[e] - kl[e]; float wr, wi; unit_root((float)(t0 + e) * (1.f / 32768.f), false, wr, wi); o.x = a * wr; o.y = a * wi; }
                    dat[phys(t0 + e)] = o; } }
            if (!odd) { l1s = wave_sum(l1s); if (F.lane == 0) redu[F.wave] = l1s; }
            __syncthreads();
            if (!odd && tid == 0) { float tot = 0.f;
#pragma unroll
                for (int w = 0; w < NWAVES; ++w) tot += redu[w];
                PW[15] = 1.f / tot; }
            pass1<false>(dat, tab, F.lane, F.wave); __syncthreads(); pass2<false>(dat, tab, F.lane, F.wave); { f32x2 kdummy[16]; pass3<true>(dat, tab, F.lane, F.wave, 0, odd ? Ko : Ke, kdummy); asm volatile("" ::: "memory"); pass3<true>(dat, tab, F.lane, F.wave, 1, odd ? Ko : Ke, kdummy); } __syncthreads();
        }
        TPS_STOP(2); TPS_START(3);
        unsigned zp[4][8];
        const bool cvb3 = (cv_it + 2 * cv_ngw < CV_NIT);
        const ConvItem ia = moe_l1_item(F, cvb3 ? cv_it : 0), ib = moe_l1_item(F, cvb3 ? cv_it + cv_ngw : 0), ic = moe_l1_item(F, cvb3 ? cv_it + 2 * cv_ngw : 0);
#pragma unroll
        for (int odd = 0; odd < 2; ++odd) {
            asm volatile("" : "+v"(tid));
            TPS_START(6);
            if (!odd) {
                RawZ rz[4];
#pragma unroll
                for (int sI = 0; sI < 4; ++sI) rz[sI] = load_rawz(pT, d, 8 * (tid + 512 * sI));
#pragma unroll
                for (int sI = 0; sI < 4; ++sI) { const int t0 = 8 * (tid + 512 * sI); float z0[8], z1[8]; z_from_raw(rz[sI], P, z0, z1);
#pragma unroll
                    for (int e = 0; e < 8; ++e) { f32x2 o; o.x = z0[e]; o.y = z1[e]; zp[sI][e] = cvt_pk_bf16(z0[e], z1[e]); dat[phys(t0 + e)] = o; } }
            } else {
#pragma unroll
                for (int sI = 0; sI < 4; ++sI) { const int t0 = 8 * (tid + 512 * sI);
#pragma unroll
                    for (int e = 0; e < 8; ++e) { const float z0 = bflo(zp[sI][e]), z1 = bfhi(zp[sI][e]); float wr, wi; unit_root((float)(t0 + e) * (1.f / 32768.f), false, wr, wi);
                        f32x2 o; o.x = z0 * wr - z1 * wi; o.y = z0 * wi + z1 * wr; dat[phys(t0 + e)] = o; } }
            }
#ifdef FFT_EXTRA
#pragma unroll 1
            for (int xr = 0; xr < FFT_EXTRA; ++xr) { __syncthreads(); pass2<false>(dat, tab, F.lane, F.wave); __syncthreads(); pass2<true>(dat, tab, F.lane, F.wave); __syncthreads();
#pragma unroll 1
                for (int i = fresh_tid(F.wave); i < L; i += NTHR) { f32x2 v = dat[i]; v.x *= (1.f / 32.f); v.y *= (1.f / 32.f); dat[i] = v; } }
            tid = fresh_tid(F.wave);
#endif
            TPS_STOP(6); TPS_START(5);
            f32x2 kpre0[16], kpre1[16];
            asm volatile("" ::: "memory");
            { const f32x2* Kb = odd ? Ko : Ke; int ln_ = F.lane; asm volatile("" : "+v"(ln_)); const int lq = ln_ & 31, lh = ln_ >> 5; const float il1 = P[15], fb = P[12];
#pragma unroll
              for (int r = 0; r < 16; ++r) { f32x2 k0 = Kb[((r & 3) + 8 * (r >> 2) + 4 * lh) * 512 + 64 * F.wave + lq], k1 = Kb[((r & 3) + 8 * (r >> 2) + 4 * lh) * 512 + 64 * F.wave + 32 + lq];
                  k0.x = k0.x * il1 + fb; k0.y *= il1; k1.x = k1.x * il1 + fb; k1.y *= il1; kpre0[r] = k0; kpre1[r] = k1; } }
            __syncthreads(); pass1<false>(dat, tab, F.lane, F.wave); __syncthreads(); pass2<false>(dat, tab, F.lane, F.wave); pass3<false>(dat, tab, F.lane, F.wave, 0, nullptr, kpre0); asm volatile("" ::: "memory"); pass3<false>(dat, tab, F.lane, F.wave, 1, nullptr, kpre1);
            TPS_STOP(5); TPS_START(7);
            if (odd) { float ca[32], cb[32], cc[32]; const int cvln = fresh_tid(F.wave) & 63;
                conv_issue(ia, cvln, ca); conv_issue(ib, cvln, cb); conv_issue(ic, cvln, cc);
                pass2<true>(dat, tab, F.lane, F.wave); __syncthreads(); pass1<true>(dat, tab, F.lane, F.wave);
                if (cvb3) { conv_finish(ia, cvln, ca); conv_finish(ib, cvln, cb); conv_finish(ic, cvln, cc); cv_it += 3 * cv_ngw; }
                __syncthreads();
            } else { pass2<true>(dat, tab, F.lane, F.wave); __syncthreads(); pass1<true>(dat, tab, F.lane, F.wave); __syncthreads(); }
            TPS_STOP(7);
            if (!odd) {
                asm volatile("" : "+v"(tid));
#pragma unroll 1
                for (int sI = 0; sI < 4; ++sI)
#pragma unroll
                    for (int e = 0; e < 8; ++e) { const f32x2 v = dat[phys(8 * (tid + 512 * sI) + e)]; SeB[e * 2048 + tid + 512 * sI] = v; }
                __syncthreads();
            }
        }
        TPS_STOP(3); TPS_START(4);
        asm volatile("" : "+v"(tid));
        if (d + F.G < DM) {
#pragma unroll
            for (int sI = 0; sI < 4; ++sI) rf[sI] = load_rawf(HT, d + F.G, 8 * (tid + 512 * sI)); }
        { Raw8 rx0[4][2]; f32x2 se[4][8];
#pragma unroll
          for (int sI = 0; sI < 4; ++sI) {
#pragma unroll
              for (int bt = 0; bt < 2; ++bt) rx0[sI][bt] = load_raw8(pT + (size_t)d * MTOK + bt * L, 8 * (tid + 512 * sI));
#pragma unroll
              for (int e = 0; e < 8; ++e) se[sI][e] = SeB[e * 2048 + tid + 512 * sI]; }
#pragma unroll
          for (int sI = 0; sI < 4; ++sI) { const int t0 = 8 * (tid + 512 * sI);
              float o0[8], o1[8];
#pragma unroll
              for (int e = 0; e < 8; ++e) { const f32x2 so = dat[phys(t0 + e)]; float wr, wi; unit_root((float)(t0 + e) * (1.f / 32768.f), true, wr, wi);
                  o0[e] = (se[sI][e].x + so.x * wr - so.y * wi) * (1.f / 32768.f); o1[e] = (se[sI][e].y + so.x * wi + so.y * wr) * (1.f / 32768.f); }
#pragma unroll
              for (int bt = 0; bt < 2; ++bt) { float xc[8]; conv8(rx0[sI][bt], P[0], P[1], P[2], P[3], xc);
                  u32x4 w;
                  if (bt == 0) { w.x = cvt_pk_bf16(xc[0] * o0[0], xc[1] * o0[1]); w.y = cvt_pk_bf16(xc[2] * o0[2], xc[3] * o0[3]); w.z = cvt_pk_bf16(xc[4] * o0[4], xc[5] * o0[5]); w.w = cvt_pk_bf16(xc[6] * o0[6], xc[7] * o0[7]); }
                  else { w.x = cvt_pk_bf16(xc[0] * o1[0], xc[1] * o1[1]); w.y = cvt_pk_bf16(xc[2] * o1[2], xc[3] * o1[3]); w.z = cvt_pk_bf16(xc[4] * o1[4], xc[5] * o1[5]); w.w = cvt_pk_bf16(xc[6] * o1[6], xc[7] * o1[7]); }
                  *(u32x4*)(yT + (size_t)d * MTOK + bt * L + t0) = w; } } }
        __syncthreads();
        TPS_STOP(4);
        if (cvb3) {
        } else {
#pragma unroll 1
            for (int q = 0; q < 3; ++q) { if (cv_it < CV_NIT) { float cva[32]; const ConvItem cvc = moe_l1_item(F, cv_it); conv_issue(cvc, fresh_tid(F.wave) & 63, cva); conv_finish(cvc, fresh_tid(F.wave) & 63, cva); cv_it += cv_ngw; } }
        }
    }
    while (cv_it < CV_NIT) { float cvb[32]; const ConvItem c = moe_l1_item(F, cv_it); conv_issue(c, F.lane, cvb); conv_finish(c, F.lane, cvb); cv_it += cv_ngw; }
}
__device__ __forceinline__ void transpose_phase(const Frame& F) {
    const bf16* yT = (const bf16*)(F.ws + WS_A); bf16* y = (bf16*)(F.ws + WS_B);
    LAS bf16* tl = (LAS bf16*)(F.lds + F.wave * 16384);
    const int gw = F.bid * NWAVES + F.wave, NGW = F.G * NWAVES, lane = F.lane;
    for (int tile = gw; tile < 32 * 512; tile += NGW) { const int d0 = (tile & 31) * 64, t0 = (tile >> 5) * 64;
#pragma unroll
        for (int i = 0; i < 8; ++i) { const int r = i * 8 + (lane >> 3), ch = lane & 7; const u32x4 v = *(const u32x4*)(yT + (size_t)(d0 + r) * MTOK + t0 + ch * 8); *(LAS u32x4*)(tl + r * 72 + ch * 8) = v; }
        LDS_WAIT();
#pragma unroll
        for (int i = 0; i < 8; ++i) { const int tr = i * 8 + (lane >> 3), ch = lane & 7; unsigned short e[8];
#pragma unroll
            for (int k = 0; k < 8; ++k) e[k] = tl[(ch * 8 + k) * 72 + tr];
            u32x4 w; w.x = e[0] | ((unsigned)e[1] << 16); w.y = e[2] | ((unsigned)e[3] << 16); w.z = e[4] | ((unsigned)e[5] << 16); w.w = e[6] | ((unsigned)e[7] << 16);
            *(u32x4*)(y + (size_t)(t0 + tr) * DM + d0 + ch * 8) = w; }
        LDS_WAIT();
    }
}
}
__device__ __forceinline__ float hy_ftab_value(int f, int l, int jj) { return hy::ftab_value(f, l, jj); }
constexpr int NPHASE = 19;

__device__ __forceinline__ void moe_table(const Frame& F, int layer, LAS int* tab) {
    if (F.tid < NCLS) tab[32 + F.tid] = (int)__hip_atomic_load((unsigned*)(F.ctl + CW_CNT + (layer * NCLS + F.tid) * 64), RLX_AGENT);
    __syncthreads();
    if (F.tid == 0) { int a = 0; for (int c = 0; c < NCLS; ++c) { tab[c] = a; a += (tab[32 + c] + 255) >> 8; } tab[24] = a; }
    __syncthreads();
}

#ifndef PROBE_MASK
#define PROBE_MASK 0u
#endif
#ifndef TPM
#define TPM 0u
#endif
#define TP_MULT 4
#define IN(k) ((ONLY < 0 || (k) == ONLY) && lo <= (k) && (k) < hi)
#define SEAM(k) do { if ((k) + 1 < hi) { XcdBarrier b_ = bar; asm volatile("" : "+s"(b_.bar), "+s"(b_.x)); xcd_barrier(b_); } if (TPM != 0u && ONLY < 0 && ((TPM >> (k)) & 1u) && F.bid == 0 && F.tid == 0) TPW[0] += __builtin_amdgcn_s_memrealtime() - TPW[1]; if (PROBE_MASK != 0u && ONLY < 0) { if (F.tid == 0) { LAS unsigned long long* tp_ = (LAS unsigned long long*)(F.lds + MISC_OFF + 64); const unsigned long long t1_ = __builtin_amdgcn_s_memrealtime(); if ((PROBE_MASK >> (k)) & 1u) tp_[0] += t1_ - tp_[1]; tp_[1] = t1_; } } } while (0)
#define TPW ((LAS unsigned long long*)(F.lds + MISC_OFF + 96))
#define ENTER() do { int l_; asm volatile("v_mbcnt_lo_u32_b32 %0, -1, 0\n\tv_mbcnt_hi_u32_b32 %0, -1, %0" : "=&v"(l_)); const int t_ = F.wave * 64 + l_; F.tid = t_; F.lane = l_; int b_ = blockIdx.x, g_ = gridDim.x; asm volatile("" : "+s"(b_), "+s"(g_)); F.bid = b_; F.G = g_; if (TPM != 0u && ONLY < 0 && b_ == 0 && t_ == 0) TPW[1] = __builtin_amdgcn_s_memrealtime(); } while (0)
template <int ONLY> __device__ __forceinline__ void layer_phases(Frame& F, const XcdBarrier& bar, const int lo, const int hi, const int layer, LAS int* tab) {
        const int pb = 3 + 8 * layer;
        if (layer == 0) {
            if (IN(pb + 0)) { ENTER();
                pg::PlainSched S; S.init(F.ws + WS_A, F.ws + WS_WQKV, MTOK, QKVD, DM, DM, F.G, F.bid);
                pg::EpiQKV E{(bf16*)(F.ws + WS_B), (bf16*)(F.ws + WS_B + 128 * MiB), (bf16*)(F.ws + WS_B + 144 * MiB), AIN(I_ABIN), (const float*)(F.ws + WS_ROPE), (const float*)(F.ws + WS_ROPE) + 4096};
                pg::gemm_phase<pg::EpiQKV, pg::PlainSched, false, false, true>(F.lds, F.tid, DM, DM, DM, S, E);
                SEAM(pb + 0);
            }
            if (IN(pb + 1)) { ENTER(); att::attn_phase(F); SEAM(pb + 1); }
        } else {
            if (IN(pb + 0)) { ENTER();
                pg::PlainSched S; S.init(F.ws + WS_WHYIN, F.ws + WS_A, 3 * DM, MTOK, DM, DM, F.G, F.bid);
                pg::EpiBf16<true> E{(bf16*)(F.ws + WS_B), MTOK, AIN(I_HBIN)};
                pg::gemm_phase<pg::EpiBf16<true>, pg::PlainSched, false, false, true>(F.lds, F.tid, DM, DM, DM, S, E);
                SEAM(pb + 0);
            }
            if (IN(pb + 1)) { ENTER(); hy::hyena_phase(F); SEAM(pb + 1); }
            if (IN(pb + 2)) { ENTER(); hy::transpose_phase(F); SEAM(pb + 2); }
        }
        if (IN(pb + 3)) { ENTER();
            const void* A = layer ? (const void*)(F.ws + WS_B) : (const void*)(F.ws + WS_A);
            const void* Bt = layer ? (const void*)(F.ws + WS_WHYO) : (const void*)(F.ws + WS_WO0);
            bf16* O = (bf16*)(F.ws + WS_B + (layer ? 128 : 192) * MiB);
            pg::PlainSched S; S.init(A, Bt, MTOK, DM, DM, DM, F.G, F.bid);
            pg::EpiBf16<false> E{O, DM, layer ? AIN(I_HBOUT) : nullptr};
            pg::gemm_phase<pg::EpiBf16<false>, pg::PlainSched, false, false, true>(F.lds, F.tid, DM, DM, DM, S, E);
            SEAM(pb + 3);
        }
        if (IN(pb + 4)) { ENTER();
            if (layer == 0) ln1_router_phase<true>(F, 0, AIN(I_X), (const bf16*)(F.ws + WS_B + 192 * MiB), (bf16*)(F.ws + WS_A), (bf16*)(F.ws + WS_B + 192 * MiB));
            else ln1_router_phase<false>(F, 1, F.out, (const bf16*)(F.ws + WS_B + 128 * MiB), (bf16*)(F.ws + WS_A), (bf16*)(F.ws + WS_B + 256 * MiB));
            SEAM(pb + 4);
        }
        if (IN(pb + 5)) { ENTER();
            moe_table(F, layer, tab);
            pg::MoeSched S{tab, (const char*)(F.ws + WS_A), (const char*)(F.ws + WS_W13 + (size_t)layer * 128 * MiB), (const int*)(F.ws + WS_TOK), F.G, F.bid, 16, 0};
            pg::EpiMoe1 E{(bf16*)(F.ws + WS_B), (const float*)(F.ws + WS_GATE)};
            pg::gemm_phase<pg::EpiMoe1, pg::MoeSched, true, false, true>(F.lds, F.tid, DM, DM, DM, S, E);
            SEAM(pb + 5);
        }
        if (IN(pb + 6)) { ENTER();
            moe_table(F, layer, tab);
            pg::MoeSched S{tab, (const char*)(F.ws + WS_B), (const char*)(F.ws + WS_W2 + (size_t)layer * 64 * MiB), (const int*)(F.ws + WS_TOK), F.G, F.bid, 8, 1};
            pg::EpiMoe2 E{(bf16*)(F.ws + WS_A), (const int*)(F.ws + WS_TOK)};
            pg::gemm_phase<pg::EpiMoe2, pg::MoeSched, false, true, true>(F.lds, F.tid, DM, DM, EFF, S, E);
            SEAM(pb + 6);
        }
        if (IN(pb + 7)) { ENTER();
            if (layer == 0) ln2_phase<false>(F, 0, (bf16*)(F.ws + WS_A), (const bf16*)(F.ws + WS_B + 192 * MiB), F.out);
            else ln2_phase<true>(F, 1, (bf16*)(F.ws + WS_A), (const bf16*)(F.ws + WS_B + 256 * MiB), F.out);
            SEAM(pb + 7); }
}
template <int ONLY> __global__ void __launch_bounds__(NTHR, 2) fwd_kernel(Args args) {
    extern __shared__ __attribute__((aligned(16))) unsigned char lds_raw[];
    Frame F;
    F.lds = (LAS unsigned char*)lds_raw;
    F.tid = threadIdx.x; F.lane = F.tid & 63; F.wave = __builtin_amdgcn_readfirstlane(F.tid >> 6);
    F.G = gridDim.x; F.bid = blockIdx.x; F.ws = args.ws; F.ctl = (gu32*)(args.ws + WS_CTL); F.out = args.out;
    F.a = &args;
    for (int u = F.tid; u < (LDS_BYTES - RING_BYTES) / 4; u += NTHR) ((LAS unsigned*)(F.lds + RING_BYTES))[u] = 0u;
    __syncthreads();
    const int lo = args.ph_lo, hi = args.ph_hi;
    if (PROBE_MASK != 0u && ONLY >= 0) { if (F.bid == 0 && F.tid == 0) ((unsigned long long*)(F.ws + 512 * 1024))[ONLY] = __builtin_amdgcn_s_memrealtime(); }
    if (PROBE_MASK != 0u && ONLY < 0) { if (F.tid == 0) { LAS unsigned long long* tp_ = (LAS unsigned long long*)(F.lds + MISC_OFF + 64); tp_[0] = 0; tp_[1] = __builtin_amdgcn_s_memrealtime(); } }
    XcdBarrier bar; bar.bar = (unsigned*)(F.ctl + CW_BAR); bar.x = 0; bar.st = nullptr;
    if (ONLY < 0 && hi - lo > 1) bar = xcd_barrier_post((unsigned*)(F.ctl + CW_BAR), (volatile LAS unsigned*)(F.lds + MISC_OFF));
    LAS int* tab = (LAS int*)(F.lds + RING_BYTES + 64);

    if (IN(0)) { ENTER(); p0_prologue(F); SEAM(0); }
    if (IN(1)) { ENTER(); p1_prologue(F); if (TPM != 0u && ONLY < 0 && ((TPM >> 1) & 1u) && F.bid == 0 && F.tid == 0) TPW[0] += __builtin_amdgcn_s_memrealtime() - TPW[1]; }
    if (IN(2)) { ENTER();
        pg::PlainSched S; S.init(F.ws + WS_W4T, F.ws + WS_HDN, 4096, SEQ, 128, 128, F.G, F.bid);
        pg::EpiBf16<true> E{(bf16*)(F.ws + WS_HT), SEQ, nullptr};
        int kf = 128; asm volatile("" : "+s"(kf));
        pg::gemm_phase<pg::EpiBf16<true>, pg::PlainSched, false, false, true>(F.lds, F.tid, kf, 128, 128, S, E);
        SEAM(2);
    }
    if constexpr (ONLY >= 0) { if (ONLY >= 3 && ONLY < 11) layer_phases<ONLY>(F, bar, lo, hi, 0, tab); if (ONLY >= 11) layer_phases<ONLY>(F, bar, lo, hi, 1, tab); }
    else {
#pragma unroll 1
        for (int layer = 0; layer < 2; ++layer) layer_phases<ONLY>(F, bar, lo, hi, layer, tab);
    }
    if (PROBE_MASK != 0u && ONLY == NPHASE - 1) { __syncthreads(); if (F.bid == 0 && F.tid == 0) { const unsigned long long* ts = (const unsigned long long*)(F.ws + 512 * 1024); unsigned long long acc = 0, tend = __builtin_amdgcn_s_memrealtime();
        for (int k = 0; k < NPHASE; ++k) if (((PROBE_MASK >> k) & 1u) && k != 5) { int kn = k + 1; if (kn == 5) kn = 6; acc += ((kn < NPHASE) ? ts[kn] : tend) - ts[k]; }
        F.out[0] = 0.1f * (float)acc; } }
    if ((TPM != 0u || TPSEL >= 0) && ONLY < 0) { if (blockIdx.x == 0 && threadIdx.x == 0) { const unsigned long long acc = TPW[0] * TP_MULT, t0 = __builtin_amdgcn_s_memrealtime(); while (__builtin_amdgcn_s_memrealtime() - t0 < acc) __builtin_amdgcn_s_sleep(8); } }
    if (PROBE_MASK != 0u && ONLY < 0) { __syncthreads(); if (F.bid == 0 && F.tid == 0) F.out[0] = 0.1f * (float)((LAS unsigned long long*)(F.lds + MISC_OFF + 64))[0]; }
}
#undef IN
#undef SEAM

extern "C" void kernel_launch(void* const* d_in, const int* in_sizes, int n_in, void* d_out, int out_size, void* d_ws, size_t ws_size, hipStream_t stream) {
    static int grid = 0;
    if (grid == 0) {
        if (n_in != 34 || in_sizes[0] != MTOK * DM || out_size != MTOK * DM || ws_size < WS_END) { fprintf(stderr, "kernel_launch: unexpected shapes / workspace (n_in %d, ws %zu, need %zu)\n", n_in, ws_size, (size_t)WS_END); grid = -1; return; }
        int dev = 0, cus = 0;
        if (hipGetDevice(&dev) != hipSuccess || hipDeviceGetAttribute(&cus, hipDeviceAttributeMultiprocessorCount, dev) != hipSuccess) { grid = -1; return; }
#if !MK_SPLIT
        if (hipFuncSetAttribute((const void*)fwd_kernel<-1>, hipFuncAttributeMaxDynamicSharedMemorySize, LDS_BYTES) != hipSuccess) { fprintf(stderr, "kernel_launch: hipFuncSetAttribute failed\n"); grid = -1; return; }
        int per_cu = 0;
        if (hipOccupancyMaxActiveBlocksPerMultiprocessor(&per_cu, (const void*)fwd_kernel<-1>, NTHR, LDS_BYTES) != hipSuccess || per_cu < 1) fprintf(stderr, "kernel_launch: occupancy query reports %d blocks per CU\n", per_cu);
        (void)hipGetLastError();
#endif
        grid = cus;
    }
    if (grid < 0) return;
    (void)hipMemsetAsync((char*)d_ws + WS_CTL, 0, CTL_ZERO_BYTES, stream);
    Args a{};
    for (int i = 0; i < 34; ++i) a.in[i] = (const float*)d_in[i];
    a.out = (float*)d_out; a.ws = (unsigned char*)d_ws;
#if MK_SPLIT
    typedef void (*kfn)(Args);
    static const kfn fns[NPHASE] = {fwd_kernel<0>, fwd_kernel<1>, fwd_kernel<2>, fwd_kernel<3>, fwd_kernel<4>, nullptr, fwd_kernel<6>, fwd_kernel<7>, fwd_kernel<8>, fwd_kernel<9>, fwd_kernel<10>,
                                      fwd_kernel<11>, fwd_kernel<12>, fwd_kernel<13>, fwd_kernel<14>, fwd_kernel<15>, fwd_kernel<16>, fwd_kernel<17>, fwd_kernel<18>};
    static bool attr_done = false;
    if (!attr_done) { for (int ph = 0; ph < NPHASE; ++ph) if (fns[ph]) (void)hipFuncSetAttribute((const void*)fns[ph], hipFuncAttributeMaxDynamicSharedMemorySize, LDS_BYTES); attr_done = true; }
#ifndef REPEAT_MASK
#define REPEAT_MASK 0u
#endif
    for (int ph = 0; ph < NPHASE; ++ph) { if (!fns[ph]) continue; a.ph_lo = ph; a.ph_hi = ph + 1;
        for (int rep = 0; rep < (((REPEAT_MASK >> ph) & 1u) ? 2 : 1); ++rep) {
            if (rep == 1 && ph == 15) (void)hipMemsetAsync((char*)d_ws + WS_CTL + (size_t)(CW_CNT + NCLS * 64) * 4, 0, NCLS * 64 * 4, stream);
            hipLaunchKernelGGL(fns[ph], dim3(grid), dim3(NTHR), LDS_BYTES, stream, a); } }
#else
    a.ph_lo = 0; a.ph_hi = NPHASE; hipLaunchKernelGGL(fwd_kernel<-1>, dim3(grid), dim3(NTHR), LDS_BYTES, stream, a);
#endif
}
```

```cpp
#include <hip/hip_runtime.h>
#include <hip/hip_bf16.h>
#include <cstdio>
#include <cstdint>

#ifndef MK_SPLIT
#define MK_SPLIT 0
#endif

#define GAS __attribute__((address_space(1)))
#define LAS __attribute__((address_space(3)))
typedef unsigned short bf16;
typedef unsigned u32x4 __attribute__((ext_vector_type(4)));
typedef unsigned u32x2 __attribute__((ext_vector_type(2)));
typedef float f32x2 __attribute__((ext_vector_type(2)));
typedef float f32x4 __attribute__((ext_vector_type(4)));
typedef float f32x16 __attribute__((ext_vector_type(16)));
typedef short bf16x8 __attribute__((ext_vector_type(8)));
typedef short s16x4 __attribute__((ext_vector_type(4)));
typedef GAS unsigned gu32;

constexpr int DM = 2048, NB = 2, SEQ = 16384, MTOK = NB * SEQ, CTXL = 256, GRIDW = 64;
constexpr int NHEAD = 32, NKV = 4, HD = 64, QKVD = 2560, KVD = 256;
constexpr int NEXP = 16, EFF = 1024, NCLS = 24, LCAP = 32768;
constexpr int HYW = 64, HYEMB = 33;
constexpr float LN_EPS = 1e-5f;
constexpr float DN_ALPHA = 1.41421356237309515f;
constexpr float QSCALE = 0.125f * 1.4426950408889634f;
constexpr int NWAVES = 8, NTHR = 512;

constexpr size_t MiB = 1u << 20;
constexpr size_t WS_CTL = 0, CTL_ZERO_BYTES = 1 * MiB;
constexpr size_t WS_MOD = 1 * MiB;
constexpr size_t WS_ROPE = 1 * MiB + 512 * 1024;
constexpr size_t WS_FTAB = 1 * MiB + 768 * 1024;
constexpr size_t WS_CTXKV = 2 * MiB;
constexpr size_t WS_HDN = 3 * MiB;
constexpr size_t WS_W4T = 7 * MiB;
constexpr size_t WS_TOK = 8 * MiB;
constexpr size_t WS_GATE = 11 * MiB;
constexpr size_t WS_FFTS = 32 * MiB;
constexpr size_t WS_HT = 128 * MiB;
constexpr size_t WS_WQKV = 256 * MiB;
constexpr size_t WS_WO0 = 266 * MiB;
constexpr size_t WS_WHYIN = 274 * MiB;
constexpr size_t WS_WHYO = 298 * MiB;
constexpr size_t WS_W13 = 320 * MiB;
constexpr size_t WS_W2 = 576 * MiB;
constexpr size_t WS_A = 704 * MiB;
constexpr size_t WS_B = 832 * MiB;
constexpr size_t WS_END = 1216 * MiB;
constexpr int HID_ROWS = 38912;

constexpr int CW_TMO = 0;
constexpr int CW_BAR = 4096;
constexpr int CW_CNT = 16384;

constexpr int RING_BYTES = 131072;
constexpr int MISC_OFF = RING_BYTES + 320;
constexpr int FTAB_OFF = RING_BYTES + 1024;
constexpr int LDS_BYTES = 163840;
constexpr int SIDE_OFF = FTAB_OFF + 28672;

#define RLX_AGENT __ATOMIC_RELAXED, __HIP_MEMORY_SCOPE_AGENT
#define LDS_WAIT() asm volatile("s_waitcnt lgkmcnt(0)" ::: "memory")
#define VM_WAIT() asm volatile("s_waitcnt vmcnt(0)" ::: "memory")

__device__ __forceinline__ unsigned cvt_pk_bf16(float lo, float hi) { unsigned r; asm volatile("v_cvt_pk_bf16_f32 %0, %1, %2" : "=v"(r) : "v"(lo), "v"(hi)); return r; }
__device__ __forceinline__ float bf2f(unsigned h) { return __builtin_bit_cast(float, h << 16); }
__device__ __forceinline__ float bflo(unsigned w) { return __builtin_bit_cast(float, w << 16); }
__device__ __forceinline__ float bfhi(unsigned w) { return __builtin_bit_cast(float, w & 0xffff0000u); }
__device__ __forceinline__ float wave_sum(float v) {
    v += __builtin_bit_cast(float, __builtin_amdgcn_update_dpp(0, __builtin_bit_cast(int, v), 0xB1, 0xf, 0xf, true));
    v += __builtin_bit_cast(float, __builtin_amdgcn_update_dpp(0, __builtin_bit_cast(int, v), 0x4E, 0xf, 0xf, true));
    v += __builtin_bit_cast(float, __builtin_amdgcn_update_dpp(0, __builtin_bit_cast(int, v), 0x141, 0xf, 0xf, true));
    v += __builtin_bit_cast(float, __builtin_amdgcn_update_dpp(0, __builtin_bit_cast(int, v), 0x140, 0xf, 0xf, true));
    { auto r = __builtin_amdgcn_permlane16_swap(__float_as_uint(v), __float_as_uint(v), false, false); v = __uint_as_float(r[0]) + __uint_as_float(r[1]); }
    { auto r = __builtin_amdgcn_permlane32_swap(__float_as_uint(v), __float_as_uint(v), false, false); v = __uint_as_float(r[0]) + __uint_as_float(r[1]); }
    return v;
}

#define XB_TMO      128
#define XB_XCNT(j)  (256  + 64 * (j))
#define XB_XSUB(j)  (1280 + 64 * (j))
#define XB_XGEN(j)  (2304 + 64 * (j))
#define XB_TOP      3328
#define XB_TOPGEN   3392
#define XCD_BAR_WORDS 3456
#define XB_SPIN_CAP (1u << 18)

__device__ __forceinline__ unsigned xb_ld(unsigned* p)              { return __hip_atomic_load(p, __ATOMIC_RELAXED, __HIP_MEMORY_SCOPE_AGENT); }
__device__ __forceinline__ unsigned xb_add(unsigned* p, unsigned v) { return __hip_atomic_fetch_add(p, v, __ATOMIC_RELAXED, __HIP_MEMORY_SCOPE_AGENT); }
__device__ __forceinline__ unsigned xb_xcc_id() { return (unsigned)__builtin_amdgcn_s_getreg((3 << 11) | 20) & 0xFu; }
#define XB_SPIN(cond, bar) do { unsigned _sp = 0; while (cond) { __builtin_amdgcn_s_sleep(1); \
    if ((++_sp & 255u) == 0u) { if (xb_ld(&(bar)[XB_TMO])) break; if (_sp > XB_SPIN_CAP) { atomicAdd(&(bar)[XB_TMO], 1u); break; } } } } while (0)

struct XcdBarrier { unsigned* bar; unsigned x; volatile LAS unsigned* st; };

__device__ __forceinline__ XcdBarrier xcd_barrier_post(unsigned* bar, volatile LAS unsigned* st) {
    XcdBarrier b; b.bar = bar; b.x = xb_xcc_id(); b.st = st;
    if (threadIdx.x == 0) (void)xb_add(&bar[XB_XCNT(b.x)], 1u);
    return b;
}
__device__ __forceinline__ void xcd_barrier_complete(unsigned* bar, unsigned x, unsigned& nloc, unsigned& nx) {
    const unsigned G = gridDim.x * gridDim.y * gridDim.z;
    unsigned sum, cnt, mine, sp = 0u;
    for (;;) {
        sum = 0u; cnt = 0u; mine = 0u;
#pragma unroll
        for (unsigned j = 0; j < 16; ++j) { const unsigned c = xb_ld(&bar[XB_XCNT(j)]); sum += c; cnt += (c > 0u) ? 1u : 0u; mine = (j == x) ? c : mine; }
        if (sum == G) break;
        __builtin_amdgcn_s_sleep(1);
        if ((++sp & 255u) == 0u) { if (xb_ld(&bar[XB_TMO])) break; if (sp > XB_SPIN_CAP) { atomicAdd(&bar[XB_TMO], 1u); break; } }
    }
    nloc = mine > 0u ? mine : 1u; nx = cnt > 0u ? cnt : 1u;
}
__device__ __forceinline__ void xcd_barrier(const XcdBarrier& b) {
    asm volatile("s_waitcnt vmcnt(0)" ::: "memory");
    __syncthreads();
    if (threadIdx.x == 0) {
        unsigned* bar = b.bar;
        __builtin_amdgcn_s_waitcnt(0);
        unsigned nloc = b.st[0], nx = b.st[1];
        if (nloc == 0u) { xcd_barrier_complete(bar, b.x, nloc, nx); b.st[0] = nloc; b.st[1] = nx; }
        const unsigned old = xb_add(&bar[XB_XSUB(b.x)], 1u);
        const unsigned gen = old / nloc;
        if (old + 1u == (gen + 1u) * nloc) {
            __builtin_amdgcn_fence(__ATOMIC_RELEASE, "agent");
            asm volatile("s_waitcnt vmcnt(0)" ::: "memory");
            const unsigned og = xb_add(&bar[XB_TOP], 1u);
            const unsigned tg = og / nx;
            if (og + 1u == (tg + 1u) * nx) xb_add(&bar[XB_TOPGEN], 1u);
            else XB_SPIN(xb_ld(&bar[XB_TOPGEN]) == tg, bar);
            __builtin_amdgcn_fence(__ATOMIC_ACQUIRE, "agent");
            xb_add(&bar[XB_XGEN(b.x)], 1u);
            asm volatile("s_waitcnt vmcnt(0)" ::: "memory");
        } else {
            XB_SPIN(xb_ld(&bar[XB_XGEN(b.x)]) == gen, bar);
            __builtin_amdgcn_fence(__ATOMIC_ACQUIRE, "agent");
            asm volatile("s_waitcnt vmcnt(0)" ::: "memory");
        }
    }
    __syncthreads();
}

namespace pg {
constexpr int BM = 256, BK = 64, HALF = 128, HTB = HALF * BK * 2, NXCD = 8, WGM = 8;
__host__ __device__ __forceinline__ int lds_byte(int r, int c) { const int st = (r >> 4) * 2 + (c >> 5), rr = r & 15, cc = c & 31, ob = rr * 64 + cc * 2; return st * 1024 + (ob ^ (((ob >> 9) & 1) << 5)); }
__host__ __device__ __forceinline__ void stage_rc(int b, int& R, int& C) { const int st = b / 1024, sb = b % 1024, swz = sb ^ (((sb >> 9) & 1) << 5); R = (st >> 1) * 16 + swz / 64; C = (st & 1) * 32 + (swz % 64) / 2; }
__host__ __device__ __forceinline__ int perm32(int rho) { const int n = rho >> 4, i = rho & 15; return 8 * (i >> 2) + 4 * n + (i & 3); }

struct Unit { int pm, pn; const char* A; const char* B; const char* B2; int cls, row0, nrows, lbase; };

__device__ __forceinline__ bool static_map(int i, int G, int c, int nM, int nN, int& pm, int& pn) {
    const int nwg = nM * nN; const long L = (long)i * G + c; if (L >= nwg) return false;
    int wgid = (int)L; { const int q = nwg / NXCD, r = nwg % NXCD, xcd = wgid % NXCD, off = wgid / NXCD; wgid = (xcd < r ? xcd * (q + 1) : r * (q + 1) + (xcd - r) * q) + off; }
    const int nig = WGM * nN, gid = wgid / nig, fm = gid * WGM, gsz = (nM - fm) < WGM ? (nM - fm) : WGM;
    pm = fm + ((wgid % nig) % gsz); pn = (wgid % nig) / gsz; return true;
}
struct PlainSched {
    const char* A; const char* Bt; int nM, nN, G, c; size_t tA, tB;
    __device__ __forceinline__ void init(const void* A_, const void* Bt_, int M, int N, int ldA, int ldB, int G_, int c_) { A = (const char*)A_; Bt = (const char*)Bt_; nM = M / BM; nN = N / BM; G = G_; c = c_; tA = (size_t)BM * ldA * 2; tB = (size_t)BM * ldB * 2; }
    __device__ __forceinline__ bool next(int i, Unit& u) const {
        if (!static_map(i, G, c, nM, nN, u.pm, u.pn)) return false;
        u.A = A + (size_t)u.pm * tA; u.B = Bt + (size_t)u.pn * tB; u.B2 = u.B; u.cls = 0; u.row0 = 0; u.nrows = 256; u.lbase = 0; return true;
    }
    __device__ __forceinline__ unsigned row_off(const Unit&, int r, int ldA) const { return (unsigned)r * (unsigned)ldA * 2u; }
};

template <class Epi, class Sched, bool GATHER, bool KSPLIT, bool ALIGN_EPI>
__device__ __forceinline__ void gemm_phase(LAS unsigned char* lds, const int tid, const int K, const int ldA, const int ldB, const Sched& S, const Epi& E) {
    const int wid = __builtin_amdgcn_readfirstlane(tid >> 6), lane = tid & 63, wr = wid >> 2, wc = wid & 3, fr = lane & 15, fq = lane >> 4;
    const int nt = K / BK, nth = nt >> 1;
    int RA[2], CA[2];
    unsigned voffB[2], voA[2][2], nvoA[2][2];
#pragma unroll
    for (int i = 0; i < 2; ++i) { int R, C; stage_rc(tid * 16 + i * 8192, R, C); const int Rb = Epi::PERM ? ((R & ~31) + perm32(R & 31)) : R;
        RA[i] = R; CA[i] = C; voffB[i] = (unsigned)(Rb * ldB + C) * 2u;
        voA[0][i] = (unsigned)(R * ldA + C) * 2u; voA[1][i] = (unsigned)((R + HALF) * ldA + C) * 2u; nvoA[0][i] = voA[0][i]; nvoA[1][i] = voA[1][i]; }
    const size_t kstep = (size_t)(BK * 2);
    const size_t hstepB = (size_t)HALF * ldB * 2;
    const unsigned ldsw = (unsigned)wid * 1024u;
    const int aoff = lds_byte(wr * 64 + fr, fq * 8), boff = lds_byte(wc * 32 + fr, fq * 8);
#define PG8_SA(b, h) (((b) * 2 + (h)) * HTB)
#define PG8_SB(b, h) ((4 + (b) * 2 + (h)) * HTB)
#define PG8_STAGEB(bufoff, gbase) do { _Pragma("unroll") for (int _i = 0; _i < 2; ++_i) \
        __builtin_amdgcn_global_load_lds((const unsigned*)((const char*)(gbase) + voffB[_i]), (LAS unsigned*)(lds + (bufoff) + ldsw + _i * 8192), 16, 0, 0); } while (0)
#define PG8_STAGEA(bufoff, gbase, vo, h) do { _Pragma("unroll") for (int _i = 0; _i < 2; ++_i) \
        __builtin_amdgcn_global_load_lds((const unsigned*)((const char*)(gbase) + (vo)[h][_i]), (LAS unsigned*)(lds + (bufoff) + ldsw + _i * 8192), 16, 0, 0); } while (0)
#define PG8_LDA(dst, b, h) do { _Pragma("unroll") for (int m = 0; m < 4; ++m) _Pragma("unroll") for (int k = 0; k < 2; ++k) dst[m][k] = *(const LAS bf16x8*)(lds + PG8_SA(b, h) + aoff + m * 2048 + k * 1024); } while (0)
#define PG8_LDB(dst, b, h) do { _Pragma("unroll") for (int n = 0; n < 2; ++n) _Pragma("unroll") for (int k = 0; k < 2; ++k) dst[n][k] = *(const LAS bf16x8*)(lds + PG8_SB(b, h) + boff + n * 2048 + k * 1024); } while (0)
#define PG8_MMA(ai, bj, At, Bt) do { __builtin_amdgcn_s_setprio(1); _Pragma("unroll") for (int m = 0; m < 4; ++m) _Pragma("unroll") for (int n = 0; n < 2; ++n) _Pragma("unroll") for (int k = 0; k < 2; ++k) \
        acc[ai][bj][m][n] = __builtin_amdgcn_mfma_f32_16x16x32_bf16(Bt[n][k], At[m][k], acc[ai][bj][m][n], 0, 0, 0); __builtin_amdgcn_s_setprio(0); } while (0)
#define PG8_WAIT_V(n) asm volatile("s_waitcnt vmcnt(" #n ")" ::: "memory")
#define PG8_WAIT_L(n) asm volatile("s_waitcnt lgkmcnt(" #n ")" ::: "memory")
#define PG8_BAR __builtin_amdgcn_s_barrier()
#define PG8_SCHED __builtin_amdgcn_sched_barrier(0)
#define PG8_BPTR(tt) ((KSPLIT && (tt) >= nth) ? cB2 + (size_t)((tt) - nth) * kstep : cB + (size_t)(tt) * kstep)
    Unit cur, nxt; int ui = 0;
    if (!S.next(0, cur)) return;
    if constexpr (GATHER) {
#pragma unroll
        for (int h = 0; h < 2; ++h)
#pragma unroll
            for (int i = 0; i < 2; ++i) voA[h][i] = S.row_off(cur, h * HALF + RA[i], ldA) + (unsigned)CA[i] * 2u;
    }
    f32x4 acc[2][2][4][2];
#pragma unroll
    for (int a = 0; a < 2; ++a)
#pragma unroll
        for (int b = 0; b < 2; ++b)
#pragma unroll
            for (int m = 0; m < 4; ++m)
#pragma unroll
                for (int n = 0; n < 2; ++n) acc[a][b][m][n] = (f32x4){0.f, 0.f, 0.f, 0.f};
    bf16x8 At[4][2], B0[2][2], B1[2][2];
    const char* cA = cur.A; const char* cB = cur.B; const char* cB2 = cur.B2;
    if constexpr (Epi::SIDE) { if (wid == 0 && E.has_side()) __builtin_amdgcn_global_load_lds((const unsigned*)(E.side_src(cur) + lane * 16), (LAS unsigned*)(lds + SIDE_OFF), 16, 0, 0); }
    PG8_STAGEB(PG8_SB(0, 0), cB); PG8_STAGEB(PG8_SB(0, 1), cB + hstepB); PG8_STAGEA(PG8_SA(0, 0), cA, voA, 0); PG8_STAGEA(PG8_SA(0, 1), cA, voA, 1);
    if (wr == 1) PG8_BAR;
    PG8_WAIT_V(2); PG8_BAR;
    { const char* b1 = PG8_BPTR(1); PG8_STAGEB(PG8_SB(1, 0), b1); PG8_STAGEA(PG8_SA(1, 0), cA + kstep, voA, 0); PG8_STAGEB(PG8_SB(1, 1), b1 + hstepB); }
    PG8_WAIT_V(6); PG8_BAR;
    for (;;) {
        const bool has_next = S.next(ui + 1, nxt);
        const char* nA = has_next ? nxt.A : cA; const char* nB = has_next ? nxt.B : cB;
        if constexpr (GATHER) {
            if (has_next) {
#pragma unroll
                for (int h = 0; h < 2; ++h)
#pragma unroll
                    for (int i = 0; i < 2; ++i) nvoA[h][i] = S.row_off(nxt, h * HALF + RA[i], ldA) + (unsigned)CA[i] * 2u;
            } else {
#pragma unroll
                for (int h = 0; h < 2; ++h)
#pragma unroll
                    for (int i = 0; i < 2; ++i) nvoA[h][i] = voA[h][i];
            }
        }
        for (int t = 0; t < nt; t += 2) {
            const bool last = (t == nt - 2);
            const char* a1 = cA + (size_t)(t + 1) * kstep;
            const char* a2 = last ? nA : cA + (size_t)(t + 2) * kstep; const char* b2 = last ? nB : PG8_BPTR(t + 2);
            const char* a3 = a2 + kstep; const char* b3 = last ? nB + kstep : PG8_BPTR(t + 3);
            unsigned vo2[2][2];
#pragma unroll
            for (int h = 0; h < 2; ++h)
#pragma unroll
                for (int i = 0; i < 2; ++i) vo2[h][i] = (GATHER && last) ? nvoA[h][i] : voA[h][i];
            PG8_LDB(B0, 0, 0); PG8_LDB(B1, 0, 1); PG8_SCHED; PG8_LDA(At, 0, 0); PG8_STAGEA(PG8_SA(1, 1), a1, voA, 1);
            PG8_WAIT_V(8); PG8_WAIT_L(0); PG8_BAR; PG8_MMA(0, 0, At, B0); PG8_MMA(0, 1, At, B1); PG8_BAR; PG8_SCHED;
            PG8_LDA(At, 0, 1); PG8_STAGEB(PG8_SB(0, 0), b2); PG8_STAGEB(PG8_SB(0, 1), b2 + hstepB); PG8_STAGEA(PG8_SA(0, 0), a2, vo2, 0);
            PG8_WAIT_V(8); PG8_WAIT_L(0); PG8_BAR; PG8_MMA(1, 0, At, B0); PG8_MMA(1, 1, At, B1); PG8_BAR; PG8_SCHED;
            PG8_LDB(B0, 1, 0); PG8_LDB(B1, 1, 1); PG8_SCHED; PG8_LDA(At, 1, 0); PG8_STAGEA(PG8_SA(0, 1), a2, vo2, 1);
            PG8_WAIT_V(8); PG8_WAIT_L(0); PG8_BAR; PG8_MMA(0, 0, At, B0); PG8_MMA(0, 1, At, B1); PG8_BAR; PG8_SCHED;
            PG8_LDA(At, 1, 1); PG8_STAGEB(PG8_SB(1, 0), b3); PG8_STAGEB(PG8_SB(1, 1), b3 + hstepB); PG8_STAGEA(PG8_SA(1, 0), a3, vo2, 0);
            PG8_WAIT_V(8); PG8_WAIT_L(0); PG8_BAR; PG8_MMA(1, 0, At, B0); PG8_MMA(1, 1, At, B1); PG8_BAR; PG8_SCHED;
        }
        if constexpr (ALIGN_EPI) { if (wr == 0) PG8_BAR; }
        if constexpr (Epi::SIDE) { if (has_next && wid == 0 && E.has_side()) __builtin_amdgcn_global_load_lds((const unsigned*)(E.side_src(nxt) + lane * 16), (LAS unsigned*)(lds + SIDE_OFF + ((ui + 1) & 1) * 1024), 16, 0, 0); }
        E(acc, cur, wr, wc, fr, fq, (const LAS float*)(lds + SIDE_OFF + (ui & 1) * 1024));
        if (!has_next) break;
#pragma unroll
        for (int a = 0; a < 2; ++a)
#pragma unroll
            for (int b = 0; b < 2; ++b)
#pragma unroll
                for (int m = 0; m < 4; ++m)
#pragma unroll
                    for (int n = 0; n < 2; ++n) acc[a][b][m][n] = (f32x4){0.f, 0.f, 0.f, 0.f};
        cur = nxt; cA = nA; cB = nB; cB2 = nxt.B2; ++ui;
        if constexpr (GATHER) {
#pragma unroll
            for (int h = 0; h < 2; ++h)
#pragma unroll
                for (int i = 0; i < 2; ++i) voA[h][i] = nvoA[h][i];
        }
        if constexpr (ALIGN_EPI) { if (wr == 1) PG8_BAR; }
    }
    PG8_WAIT_V(0);
    if constexpr (!ALIGN_EPI) { if (wr == 0) PG8_BAR; }
    PG8_BAR;
#undef PG8_SA
#undef PG8_SB
#undef PG8_STAGEA
#undef PG8_STAGEB
#undef PG8_LDA
#undef PG8_LDB
#undef PG8_MMA
#undef PG8_WAIT_V
#undef PG8_WAIT_L
#undef PG8_BAR
#undef PG8_SCHED
#undef PG8_BPTR
}
}
namespace pg {
template <bool BIAS_ROW> struct EpiBf16 {
    static constexpr bool PERM = true; static constexpr bool SIDE = true; static constexpr int NST = 16;
    __device__ __forceinline__ bool full_stores(const Unit&) const { return true; }
    bf16* O; int ldc; const float* bias;
    __device__ __forceinline__ bool has_side() const { return bias != nullptr; }
    __device__ __forceinline__ const char* side_src(const Unit& u) const { return (const char*)(bias + (BIAS_ROW ? u.pm : u.pn) * BM); }
    __device__ __forceinline__ void operator()(const f32x4 (&acc)[2][2][4][2], const Unit& u, int wr, int wc, int fr, int fq, const LAS float* side) const {
        const int row0 = u.pm * BM + wr * 64 + fr; const int col0 = u.pn * BM + wc * 32 + 8 * fq;
        f32x4 bv[2][2];
#pragma unroll
        for (int bj = 0; bj < 2; ++bj)
#pragma unroll
            for (int n = 0; n < 2; ++n) bv[bj][n] = (bias && !BIAS_ROW) ? *(const LAS f32x4*)(side + wc * 32 + 8 * fq + bj * HALF + 4 * n) : (f32x4){0.f, 0.f, 0.f, 0.f};
#pragma unroll
        for (int ai = 0; ai < 2; ++ai)
#pragma unroll
            for (int m = 0; m < 4; ++m) { const int row = row0 + ai * HALF + m * 16; bf16* rowp = O + (size_t)row * ldc + col0;
                float br = 0.f; if (BIAS_ROW && bias) br = side[wr * 64 + fr + ai * HALF + m * 16];
#pragma unroll
                for (int bj = 0; bj < 2; ++bj) { f32x4 v0 = acc[ai][bj][m][0] + bv[bj][0] + br, v1 = acc[ai][bj][m][1] + bv[bj][1] + br;
                    u32x4 w; w.x = cvt_pk_bf16(v0[0], v0[1]); w.y = cvt_pk_bf16(v0[2], v0[3]); w.z = cvt_pk_bf16(v1[0], v1[1]); w.w = cvt_pk_bf16(v1[2], v1[3]);
                    *(u32x4*)(rowp + bj * HALF) = w; } }
    }
};
struct EpiQKV {
    static constexpr bool PERM = false; static constexpr bool SIDE = false; static constexpr int NST = 32;
    __device__ __forceinline__ bool full_stores(const Unit&) const { return true; }
    bf16 *Q, *Kb, *Vb; const float* bias; const float* ropeC; const float* ropeS;
    __device__ __forceinline__ bool has_side() const { return false; }
    __device__ __forceinline__ const char* side_src(const Unit&) const { return nullptr; }
    __device__ __forceinline__ void operator()(const f32x4 (&acc)[2][2][4][2], const Unit& u, int wr, int wc, int fr, int fq, const LAS float*) const {
        const int row0 = u.pm * BM + wr * 64 + fr; const int colt = u.pn * BM + wc * 32 + 4 * fq;
        const bool isV = (u.pn == 9), isQ = (u.pn < 8);
        bf16* base; int ldc, cofs;
        if (isQ) { base = Q; ldc = DM; cofs = 0; } else if (!isV) { base = Kb; ldc = KVD; cofs = 2048; } else { base = Vb; ldc = KVD; cofs = 2304; }
        f32x4 bv[2][2];
#pragma unroll
        for (int bj = 0; bj < 2; ++bj)
#pragma unroll
            for (int n = 0; n < 2; ++n) bv[bj][n] = *(const f32x4*)(bias + colt + bj * HALF + 16 * n);
        const float sc = isQ ? QSCALE : 1.f; const int half = wc & 1;
#pragma unroll
        for (int ai = 0; ai < 2; ++ai)
#pragma unroll
            for (int m = 0; m < 4; ++m) { const int row = row0 + ai * HALF + m * 16; const int t = row & (SEQ - 1); const int pos = half ? (t & (GRIDW - 1)) : (t >> 6);
                f32x4 cs = (f32x4){1.f, 1.f, 1.f, 1.f}, sn = (f32x4){0.f, 0.f, 0.f, 0.f};
                if (!isV) { cs = *(const f32x4*)(ropeC + pos * 16 + 4 * fq); sn = *(const f32x4*)(ropeS + pos * 16 + 4 * fq); }
                bf16* rowp = base + (size_t)row * ldc + (colt - cofs);
#pragma unroll
                for (int bj = 0; bj < 2; ++bj) { const f32x4 x1 = acc[ai][bj][m][0] + bv[bj][0], x2 = acc[ai][bj][m][1] + bv[bj][1];
                    const f32x4 o1 = (x1 * cs - x2 * sn) * sc, o2 = (x2 * cs + x1 * sn) * sc;
                    u32x2 w1, w2; w1.x = cvt_pk_bf16(o1[0], o1[1]); w1.y = cvt_pk_bf16(o1[2], o1[3]); w2.x = cvt_pk_bf16(o2[0], o2[1]); w2.y = cvt_pk_bf16(o2[2], o2[3]);
                    *(u32x2*)(rowp + bj * HALF) = w1; *(u32x2*)(rowp + bj * HALF + 16) = w2; } }
    }
};
struct EpiMoe1 {
    static constexpr bool PERM = true; static constexpr bool SIDE = true; static constexpr int NST = 8;
    __device__ __forceinline__ bool full_stores(const Unit& u) const { return u.nrows == BM; }
    bf16* hid; const float* gates;
    __device__ __forceinline__ bool has_side() const { return true; }
    __device__ __forceinline__ const char* side_src(const Unit& u) const { return (const char*)(gates + (size_t)((u.pn >= 8) ? 1 : 0) * NCLS * LCAP + u.lbase); }
    __device__ __forceinline__ void operator()(const f32x4 (&acc)[2][2][4][2], const Unit& u, int wr, int wc, int fr, int fq, const LAS float* side) const {
        const int lr0 = wr * 64 + fr; const int col0 = u.pn * HALF + wc * 32 + 8 * fq; const int gsel = (u.pn >= 8) ? 1 : 0;
#pragma unroll
        for (int ai = 0; ai < 2; ++ai)
#pragma unroll
            for (int m = 0; m < 4; ++m) { const int lr = lr0 + ai * HALF + m * 16;
                if (lr < u.nrows) { const float g = side[lr];
                    float o[8];
#pragma unroll
                    for (int n = 0; n < 2; ++n)
#pragma unroll
                        for (int i = 0; i < 4; ++i) { const float a = acc[ai][0][m][n][i], b = acc[ai][1][m][n][i];
                            const float sg = __builtin_amdgcn_rcpf(1.f + __builtin_amdgcn_exp2f(-1.4426950408889634f * a)); o[n * 4 + i] = a * sg * b * g; }
                    u32x4 w; w.x = cvt_pk_bf16(o[0], o[1]); w.y = cvt_pk_bf16(o[2], o[3]); w.z = cvt_pk_bf16(o[4], o[5]); w.w = cvt_pk_bf16(o[6], o[7]);
                    *(u32x4*)(hid + (size_t)(u.row0 + lr) * DM + col0) = w; } }
    }
};
struct EpiMoe2 {
    static constexpr bool PERM = true; static constexpr bool SIDE = true; static constexpr int NST = 16;
    __device__ __forceinline__ bool full_stores(const Unit& u) const { return u.nrows == BM; }
    bf16* Y; const int* toks;
    __device__ __forceinline__ bool has_side() const { return true; }
    __device__ __forceinline__ const char* side_src(const Unit& u) const { return (const char*)(toks + u.lbase); }
    __device__ __forceinline__ void operator()(const f32x4 (&acc)[2][2][4][2], const Unit& u, int wr, int wc, int fr, int fq, const LAS float* side) const {
        const int lr0 = wr * 64 + fr; const int col0 = u.pn * BM + wc * 32 + 8 * fq;
#pragma unroll
        for (int ai = 0; ai < 2; ++ai)
#pragma unroll
            for (int m = 0; m < 4; ++m) { const int lr = lr0 + ai * HALF + m * 16;
                if (lr < u.nrows) { const int tok = ((const LAS int*)side)[lr]; bf16* rowp = Y + (size_t)tok * DM + col0;
#pragma unroll
                    for (int bj = 0; bj < 2; ++bj) { const f32x4 v0 = acc[ai][bj][m][0], v1 = acc[ai][bj][m][1];
                        u32x4 w; w.x = cvt_pk_bf16(v0[0], v0[1]); w.y = cvt_pk_bf16(v0[2], v0[3]); w.z = cvt_pk_bf16(v1[0], v1[1]); w.w = cvt_pk_bf16(v1[2], v1[3]);
                        *(u32x4*)(rowp + bj * HALF) = w; } } }
    }
};
struct MoeSched {
    const LAS int* tab;
    const char* Abase; const char* W; const int* toks; int G, c, NPN, second;
    __device__ __forceinline__ bool next(int i, Unit& u) const {
        const int TM = __builtin_amdgcn_readfirstlane(tab[24]);
        if (!static_map(i, G, c, TM, NPN, u.pm, u.pn)) return false;
        int cls = 0;
        for (int k = 1; k < NCLS; ++k) { const int s = __builtin_amdgcn_readfirstlane(tab[k]); if (u.pm >= s) cls = k; }
        const int ts = __builtin_amdgcn_readfirstlane(tab[cls]), cnt = __builtin_amdgcn_readfirstlane(tab[32 + cls]);
        const int ti = u.pm - ts; u.cls = cls; u.row0 = u.pm * BM; u.nrows = (cnt - ti * BM) < BM ? (cnt - ti * BM) : BM; u.lbase = cls * LCAP + ti * BM;
        const int g = cls / 6, p = cls % 6; const int lo = (p < 3) ? 0 : (p < 5 ? 1 : 2), hi = (p < 3) ? p + 1 : (p < 5 ? p - 1 : 3);
        const int elo = g * 4 + lo, ehi = g * 4 + hi;
        if (!second) { const int e = (u.pn < 8) ? elo : ehi; u.A = Abase; u.B = W + ((size_t)e * 2048 + (size_t)(u.pn & 7) * 256) * 2048 * 2; u.B2 = u.B; }
        else { u.A = Abase + (size_t)u.row0 * DM * 2; u.B = W + ((size_t)elo * 2048 + (size_t)u.pn * 256) * 1024 * 2; u.B2 = W + ((size_t)ehi * 2048 + (size_t)u.pn * 256) * 1024 * 2; }
        return true;
    }
    __device__ __forceinline__ unsigned row_off(const Unit& u, int r, int ldA) const {
        const int rr = r < u.nrows ? r : u.nrows - 1; const int tok = toks[u.lbase + rr]; return (unsigned)tok * (unsigned)ldA * 2u;
    }
};
}
struct Args { const float* in[34]; float* out; unsigned char* ws; int ph_lo, ph_hi; };
struct Frame {
    LAS unsigned char* lds;
    gu32* ctl; unsigned char* ws;
    int tid, lane, wave, G, bid;
    const Args* a; float* out;
};
#define AIN(i) (F.a->in[i])
enum { I_X = 0, I_C, I_CTX, I_CCTX, I_ADAW, I_ADAB, I_AWIN, I_ABIN, I_SINK, I_AWOUT, I_HWIN, I_HBIN, I_HCW, I_HCB, I_FW1, I_FB1, I_FW2, I_FB2, I_FW3, I_FB3, I_FFREQ, I_FW4, I_FBIAS, I_HWOUT, I_HBOUT,
       I_LN1G, I_LN1B, I_LN2G, I_LN2B, I_RW, I_RB, I_W1, I_W3, I_W2 };
#ifndef TPSEL
#define TPSEL -1
#endif
#define TPS_W ((LAS unsigned long long*)(F.lds + RING_BYTES + 320 + 96))
#define TPS_START(id) do { if (TPSEL == (id) && blockIdx.x == 0 && threadIdx.x == 0) TPS_W[1] = __builtin_amdgcn_s_memrealtime(); } while (0)
#define TPS_STOP(id) do { if (TPSEL == (id) && blockIdx.x == 0 && threadIdx.x == 0) TPS_W[0] += __builtin_amdgcn_s_memrealtime() - TPS_W[1]; } while (0)
__device__ __forceinline__ int fresh_tid(int wave) { int l_; asm volatile("v_mbcnt_lo_u32_b32 %0, -1, 0\n\tv_mbcnt_hi_u32_b32 %0, -1, %0" : "=&v"(l_)); return wave * 64 + l_; }
__device__ __forceinline__ float* mod_ptr(const Frame& F, int layer, int vec, int chunk) { return (float*)(F.ws + WS_MOD) + ((size_t)(layer * 3 + vec) * 6 + chunk) * DM; }

__device__ __forceinline__ float hy_ftab_value(int f, int l, int jj);
__device__ constexpr int hy_ftab_elems() { return 28 * 64 * 8; }
__device__ __forceinline__ void p0_transpose_item(const float* W, int ldw, bf16* WT, int ldt, int dst_row, int k0, int n0, LAS float* scr, int lane) {
#pragma unroll
    for (int i = 0; i < 32; ++i) { const int kk = 2 * i + (lane >> 5); scr[kk * 33 + (lane & 31)] = W[(size_t)(k0 + kk) * ldw + n0 + (lane & 31)]; }
    LDS_WAIT(); asm volatile("" ::: "memory");
    const int c = lane & 7;
#pragma unroll
    for (int j = 0; j < 4; ++j) { const int n = (lane >> 3) + 8 * j; const LAS float* s = scr + (8 * c) * 33 + n;
        u32x4 o; o.x = cvt_pk_bf16(s[0 * 33], s[1 * 33]); o.y = cvt_pk_bf16(s[2 * 33], s[3 * 33]); o.z = cvt_pk_bf16(s[4 * 33], s[5 * 33]); o.w = cvt_pk_bf16(s[6 * 33], s[7 * 33]);
        *(GAS u32x4*)(WT + (size_t)(dst_row + n) * ldt + k0 + 8 * c) = o; }
    LDS_WAIT(); asm volatile("" ::: "memory");
}
struct ConvItem { const float* W; bf16* WT; int ldw, ldt, dst_row, k0, n0; };
__device__ __forceinline__ ConvItem moe_l1_item(const Frame& F, int it) {
    ConvItem c; const int mat = it >> 10, sub = it & 1023, which = mat >> 4, le = 16 + (mat & 15);
    if (which < 2) { c.n0 = (sub & 31) * 32; c.k0 = (sub >> 5) * 64; c.W = (which == 0 ? AIN(I_W1) : AIN(I_W3)) + (size_t)le * DM * EFF; c.ldw = EFF; c.WT = (bf16*)(F.ws + WS_W13) + (size_t)le * 2048 * 2048; c.ldt = DM; c.dst_row = (c.n0 >> 7) * 256 + which * 128 + (c.n0 & 127); }
    else { c.n0 = (sub & 63) * 32; c.k0 = (sub >> 6) * 64; c.W = AIN(I_W2) + (size_t)le * EFF * DM; c.ldw = DM; c.WT = (bf16*)(F.ws + WS_W2) + (size_t)le * 2048 * 1024; c.ldt = EFF; c.dst_row = c.n0; }
    return c;
}
__device__ __forceinline__ ConvItem early_item(const Frame& F, int it) {
    ConvItem c;
    if (it < 48 * 1024) { const int mat = it >> 10, sub = it & 1023, which = mat >> 4, le = mat & 15;
        if (which < 2) { c.n0 = (sub & 31) * 32; c.k0 = (sub >> 5) * 64; c.W = (which == 0 ? AIN(I_W1) : AIN(I_W3)) + (size_t)le * DM * EFF; c.ldw = EFF; c.WT = (bf16*)(F.ws + WS_W13) + (size_t)le * 2048 * 2048; c.ldt = DM; c.dst_row = (c.n0 >> 7) * 256 + which * 128 + (c.n0 & 127); }
        else { c.n0 = (sub & 63) * 32; c.k0 = (sub >> 6) * 64; c.W = AIN(I_W2) + (size_t)le * EFF * DM; c.ldw = DM; c.WT = (bf16*)(F.ws + WS_W2) + (size_t)le * 2048 * 1024; c.ldt = EFF; c.dst_row = c.n0; }
    } else { int r = it - 48 * 1024;
        if (r < 32 * 192) { c.n0 = (r % 192) * 32; c.k0 = (r / 192) * 64; c.W = AIN(I_HWIN); c.ldw = 3 * DM; c.WT = (bf16*)(F.ws + WS_WHYIN); c.ldt = DM; c.dst_row = c.n0; }
        else { r -= 32 * 192; c.n0 = (r % 64) * 32; c.k0 = (r / 64) * 64; c.W = AIN(I_HWOUT); c.ldw = DM; c.WT = (bf16*)(F.ws + WS_WHYO); c.ldt = DM; c.dst_row = c.n0; } }
    return c;
}
constexpr int EARLY_NIT = 48 * 1024 + 32 * 192 + 32 * 64;
__device__ __forceinline__ void conv_issue(const ConvItem& c, int lane, float (&v)[32]) {
    const float* p = c.W + (size_t)(c.k0 + (lane >> 5)) * c.ldw + c.n0 + (lane & 31); const size_t st = (size_t)2 * c.ldw;
#pragma unroll
    for (int i = 0; i < 32; ++i) { v[i] = *p; p += st; asm volatile("" : "+v"(p)); }
}
__device__ __forceinline__ void conv_finish(const ConvItem& c, int lane, const float (&v)[32]) {
    bf16* row = c.WT + (size_t)(c.dst_row + (lane & 31)) * c.ldt + c.k0 + 8 * (lane >> 5);
#pragma unroll
    for (int m = 0; m < 4; ++m) { u32x4 w;
#pragma unroll
        for (int q = 0; q < 4; ++q) { auto r = __builtin_amdgcn_permlane32_swap(__float_as_uint(v[8 * m + q]), __float_as_uint(v[8 * m + 4 + q]), false, false);
            const unsigned pk = cvt_pk_bf16(__uint_as_float(r[0]), __uint_as_float(r[1])); if (q == 0) w.x = pk; else if (q == 1) w.y = pk; else if (q == 2) w.z = pk; else w.w = pk; }
        *(GAS u32x4*)(row + 16 * m) = w; }
}
__device__ __forceinline__ void p0_prologue(Frame& F) {
    const int gw = F.bid * NWAVES + F.wave, NGW = F.G * NWAVES, gt = F.bid * NTHR + F.tid, NGT = F.G * NTHR;
#ifndef P0_REP
#define P0_REP 0
#endif
    TPS_START(20);
#pragma unroll 1
    for (int rep_a = 0; rep_a < ((P0_REP & 1) ? 2 : 1); ++rep_a) {
        LAS float* sil = (LAS float*)F.lds; LAS float* red = sil + 3 * DM;
        for (int i = F.tid; i < 3 * DM; i += NTHR) { const int v = i / DM, k = i % DM; const float cv = (v < 2) ? AIN(I_C)[v * DM + k] : AIN(I_CCTX)[k]; sil[i] = cv / (1.f + expf(-cv)); }
        __syncthreads();
        const int cl = F.tid & 7, kg = F.tid >> 3;
        for (int unit = F.bid; unit < 768; unit += F.G) {
            const int l = unit / 384, n0 = (unit % 384) * 32;
            const float* W = AIN(I_ADAW) + (size_t)l * DM * 12288 + n0 + cl * 4;
            f32x4 a0 = {0.f, 0.f, 0.f, 0.f}, a1 = a0, a2 = a0;
#pragma unroll 8
            for (int i = 0; i < 32; ++i) { const int k = kg + 64 * i; const f32x4 w = *(const f32x4*)(W + (size_t)k * 12288); a0 += w * sil[k]; a1 += w * sil[DM + k]; a2 += w * sil[2 * DM + k]; }
#pragma unroll
            for (int j = 0; j < 4; ++j) { red[(kg * 32 + cl * 4 + j) * 3 + 0] = a0[j]; red[(kg * 32 + cl * 4 + j) * 3 + 1] = a1[j]; red[(kg * 32 + cl * 4 + j) * 3 + 2] = a2[j]; }
            __syncthreads();
            if (F.tid < 96) { const int col = F.tid & 31, v = F.tid >> 5; float s = 0.f;
                for (int k = 0; k < 64; ++k) s += red[(k * 32 + col) * 3 + v];
                ((float*)(F.ws + WS_MOD))[(size_t)(l * 3 + v) * 12288 + n0 + col] = s + AIN(I_ADAB)[l * 12288 + n0 + col]; }
            __syncthreads();
        }
    }
    TPS_STOP(20); TPS_START(21);
#pragma unroll 1
    for (int rep_b = 0; rep_b < ((P0_REP & 2) ? 2 : 1); ++rep_b) {
        LAS float* scr = (LAS float*)(F.lds + F.wave * 16384);
        constexpr int I0 = 32 * 80, I1 = 32 * 64, NIT = I0 + I1 + EARLY_NIT;
        for (int it = gw; it < NIT; it += NGW) {
            int r = it;
            if (r < I0) { p0_transpose_item(AIN(I_AWIN), QKVD, (bf16*)(F.ws + WS_WQKV), DM, (r % 80) * 32, (r / 80) * 64, (r % 80) * 32, scr, F.lane); continue; } r -= I0;
            if (r < I1) { p0_transpose_item(AIN(I_AWOUT), DM, (bf16*)(F.ws + WS_WO0), DM, (r % 64) * 32, (r / 64) * 64, (r % 64) * 32, scr, F.lane); continue; } r -= I1;
            const ConvItem c = early_item(F, r); p0_transpose_item(c.W, c.ldw, c.WT, c.ldt, c.dst_row, c.k0, c.n0, scr, F.lane);
        }
    }
    TPS_STOP(21); TPS_START(22);
    {
        const int j = F.lane; const float fr = AIN(I_FFREQ)[j], b1 = AIN(I_FB1)[j], b2 = AIN(I_FB2)[j], b3 = AIN(I_FB3)[j];
        float wc1[HYEMB], wc2[HYW], wc3[HYW];
#pragma unroll
        for (int i = 0; i < HYEMB; ++i) wc1[i] = AIN(I_FW1)[i * HYW + j];
#pragma unroll
        for (int i = 0; i < HYW; ++i) { wc2[i] = AIN(I_FW2)[i * HYW + j]; wc3[i] = AIN(I_FW3)[i * HYW + j]; }
        bf16* hdn = (bf16*)(F.ws + WS_HDN);
        for (int row = gw; row < SEQ; row += NGW) {
            const float tt = (float)row / (float)(SEQ - 1); const float wv = 6.283185307179586f * (float)row / (float)SEQ;
            float zv = 0.f;
            if (j == 0) zv = tt;
            else if (j <= 32) { const int jj = (j - 1) & 15; const float f = 1e-4f + (float)jj * ((15.f - 1e-4f) / 15.f); const float a = f * wv; zv = (j <= 16) ? cosf(a) : -sinf(a); }
            float h = b1;
#pragma unroll
            for (int i = 0; i < HYEMB; ++i) h += __builtin_bit_cast(float, __builtin_amdgcn_readlane(__builtin_bit_cast(int, zv), i)) * wc1[i];
            float a1 = sinf(fr * h);
            h = b2;
#pragma unroll
            for (int i = 0; i < HYW; ++i) h += __builtin_bit_cast(float, __builtin_amdgcn_readlane(__builtin_bit_cast(int, a1), i)) * wc2[i];
            float a2 = sinf(fr * h);
            h = b3;
#pragma unroll
            for (int i = 0; i < HYW; ++i) h += __builtin_bit_cast(float, __builtin_amdgcn_readlane(__builtin_bit_cast(int, a2), i)) * wc3[i];
            const float a3 = sinf(fr * h);
            hdn[(size_t)row * 128 + j] = (bf16)(cvt_pk_bf16(a3, 0.f) & 0xffffu); hdn[(size_t)row * 128 + 64 + j] = 0;
        }
    }
    TPS_STOP(22); TPS_START(23);
    for (int i = gt; i < hy_ftab_elems(); i += NGT) ((bf16*)(F.ws + WS_FTAB))[i] = (bf16)(cvt_pk_bf16(hy_ftab_value(i >> 9, (i >> 3) & 63, i & 7), 0.f) & 0xffffu);
    for (int i = gt; i < 4096; i += NGT) { const int pos = i >> 4, dd = i & 15; const float inv = powf(10000.f, -(float)(2 * dd) / 32.f); const float a = (float)pos * inv;
        ((float*)(F.ws + WS_ROPE))[i] = cosf(a); ((float*)(F.ws + WS_ROPE))[4096 + i] = sinf(a); }
    for (int i = gt; i < 4096 * 128; i += NGT) { const int k = i >> 12, n = i & 4095;
        ((bf16*)(F.ws + WS_W4T))[(size_t)n * 128 + k] = (k < 64) ? (bf16)(cvt_pk_bf16(AIN(I_FW4)[(size_t)k * 4096 + n], 0.f) & 0xffffu) : (bf16)0; }
    TPS_STOP(23);
}

__device__ __forceinline__ void p1_prologue(Frame& F) {
    if (F.wave < 4) {
        for (int tile = F.bid * 4 + F.wave; tile < 1024; tile += F.G * 4) {
            const int r0 = (tile >> 5) * 16, n0 = (tile & 31) * 16; const int lr = F.lane & 15, kq = F.lane >> 4;
            const float* crow = AIN(I_CTX) + (size_t)(r0 + lr) * DM; const float* sh = mod_ptr(F, 0, 2, 0); const float* sc = mod_ptr(F, 0, 2, 1);
            const bf16* wrow = (const bf16*)(F.ws + WS_WQKV) + (size_t)(2048 + n0 + lr) * DM;
            f32x4 acc = {0.f, 0.f, 0.f, 0.f};
#pragma unroll 4
            for (int k0 = 0; k0 < DM; k0 += 32) { const int k = k0 + 8 * kq;
                const f32x4 x0 = *(const f32x4*)(crow + k), x1 = *(const f32x4*)(crow + k + 4), s0 = *(const f32x4*)(sc + k), s1 = *(const f32x4*)(sc + k + 4), h0 = *(const f32x4*)(sh + k), h1 = *(const f32x4*)(sh + k + 4);
                const f32x4 u0 = x0 * (s0 + 1.f) + h0, u1 = x1 * (s1 + 1.f) + h1;
                u32x4 aw; aw.x = cvt_pk_bf16(u0[0], u0[1]); aw.y = cvt_pk_bf16(u0[2], u0[3]); aw.z = cvt_pk_bf16(u1[0], u1[1]); aw.w = cvt_pk_bf16(u1[2], u1[3]);
                const bf16x8 bfrag = *(const bf16x8*)(wrow + k);
                acc = __builtin_amdgcn_mfma_f32_16x16x32_bf16(__builtin_bit_cast(bf16x8, aw), bfrag, acc, 0, 0, 0); }
            const float bb = AIN(I_ABIN)[2048 + n0 + lr]; bf16* o = (bf16*)(F.ws + WS_CTXKV);
#pragma unroll
            for (int r = 0; r < 4; ++r) o[(size_t)(r0 + 4 * kq + r) * 512 + n0 + lr] = (bf16)(cvt_pk_bf16(acc[r] + bb, 0.f) & 0xffffu);
        }
    }
    const float* x = AIN(I_X); bf16* u0 = (bf16*)(F.ws + WS_A);
    LAS int* cnt = (LAS int*)(F.lds + RING_BYTES + 64);
    const size_t NI = (size_t)MTOK * DM / 8; const size_t per = (NI + F.G - 1) / F.G; const size_t i0 = (size_t)F.bid * per; const size_t i1 = (i0 + per < NI) ? i0 + per : NI;
    const int nch = (int)((i1 - i0 + 255) / 256);
    for (;;) {
        int c = 0; if (F.lane == 0) c = __hip_atomic_fetch_add(cnt, 1, __ATOMIC_RELAXED, __HIP_MEMORY_SCOPE_WORKGROUP);
        c = __builtin_amdgcn_readfirstlane(c); if (c >= nch) break;
        f32x4 xa[4], xb[4]; size_t ee[4];
#pragma unroll
        for (int j = 0; j < 4; ++j) { const size_t i = i0 + (size_t)c * 256 + j * 64 + F.lane; ee[j] = (i < i1) ? i * 8 : (size_t)-1; if (i < i1) { xa[j] = *(const f32x4*)(x + i * 8); xb[j] = *(const f32x4*)(x + i * 8 + 4); } }
#pragma unroll
        for (int j = 0; j < 4; ++j) { if (ee[j] == (size_t)-1) continue; const size_t e = ee[j]; const int col = (int)(e & (DM - 1)); const int b = (int)(e / ((size_t)SEQ * DM));
            const float* sh = mod_ptr(F, 0, b, 0) + col; const float* sc = mod_ptr(F, 0, b, 1) + col;
            const f32x4 v0 = xa[j] * (*(const f32x4*)sc + 1.f) + *(const f32x4*)sh, v1 = xb[j] * (*(const f32x4*)(sc + 4) + 1.f) + *(const f32x4*)(sh + 4);
            u32x4 w; w.x = cvt_pk_bf16(v0[0], v0[1]); w.y = cvt_pk_bf16(v0[2], v0[3]); w.z = cvt_pk_bf16(v1[0], v1[1]); w.w = cvt_pk_bf16(v1[2], v1[3]);
            *(u32x4*)(u0 + e) = w; }
    }
}
namespace att {
constexpr int LDS_K = 0, LDS_V = 24576, LDS_WS = 49152, LDS_OST = LDS_WS + NWAVES * 64 * 4, LDS_Q = LDS_OST + NWAVES * 4096;
__device__ __forceinline__ int crow(int r, int hi) { return (r & 3) + 8 * (r >> 2) + 4 * hi; }
__device__ __forceinline__ float max3f(float a, float b, float c) { return __builtin_fmaxf(__builtin_fmaxf(a, b), c); }
__device__ __forceinline__ float rowmax(const f32x16& p0, const f32x16& p1) {
    float a = max3f(p0[0], p0[1], p1[0]), b = max3f(p0[2], p0[3], p1[1]); a = max3f(a, p1[2], p1[3]);
#pragma unroll
    for (int r = 4; r < 16; r += 4) { a = max3f(a, p0[r], p0[r + 1]); b = max3f(b, p0[r + 2], p0[r + 3]); a = max3f(a, p1[r], p1[r + 1]); b = max3f(b, p1[r + 2], p1[r + 3]); }
    const float m = __builtin_fmaxf(a, b);
    auto rr = __builtin_amdgcn_permlane32_swap(__float_as_uint(m), __float_as_uint(m), false, false);
    return __builtin_fmaxf(__uint_as_float(rr[0]), __uint_as_float(rr[1]));
}
__device__ __forceinline__ void qkt(f32x16& p0, f32x16& p1, const LAS unsigned char* Kslot, const bf16x8* qr, const f32x16& z, int r32, int hi) {
    const LAS unsigned char* kb = Kslot + hi * 1024 + r32 * 16;
#pragma unroll
    for (int d0 = 0; d0 < 4; ++d0) {
        const bf16x8 b0 = *(const LAS bf16x8*)(kb + d0 * 2048);
        const bf16x8 b1 = *(const LAS bf16x8*)(kb + d0 * 2048 + 512);
        if (d0 == 0) { p0 = __builtin_amdgcn_mfma_f32_32x32x16_bf16(b0, qr[0], z, 0, 0, 0); p1 = __builtin_amdgcn_mfma_f32_32x32x16_bf16(b1, qr[0], z, 0, 0, 0); }
        else { p0 = __builtin_amdgcn_mfma_f32_32x32x16_bf16(b0, qr[d0], p0, 0, 0, 0); p1 = __builtin_amdgcn_mfma_f32_32x32x16_bf16(b1, qr[d0], p1, 0, 0, 0); }
    }
}
__device__ __forceinline__ void pv(f32x16* o, int vb, bf16x8 pa0, bf16x8 pa1, bf16x8 pa2, bf16x8 pa3) {
#pragma unroll
    for (int d0 = 0; d0 < 2; ++d0) { s16x4 lo[4], hi[4];
#pragma unroll
        for (int ks = 0; ks < 4; ++ks) {
            asm volatile("ds_read_b64_tr_b16 %0,%1 offset:%c2" : "=&v"(lo[ks]) : "v"(vb), "i"(d0 * 4096 + ks * 1024) : "memory");
            asm volatile("ds_read_b64_tr_b16 %0,%1 offset:%c2" : "=&v"(hi[ks]) : "v"(vb), "i"(d0 * 4096 + ks * 1024 + 512) : "memory"); }
        asm volatile("s_waitcnt lgkmcnt(0)" ::: "memory"); __builtin_amdgcn_sched_barrier(0);
#define PK(k) (bf16x8){lo[k][0], lo[k][1], lo[k][2], lo[k][3], hi[k][0], hi[k][1], hi[k][2], hi[k][3]}
        o[d0] = __builtin_amdgcn_mfma_f32_32x32x16_bf16(pa0, PK(0), o[d0], 0, 0, 0);
        o[d0] = __builtin_amdgcn_mfma_f32_32x32x16_bf16(pa1, PK(1), o[d0], 0, 0, 0);
        o[d0] = __builtin_amdgcn_mfma_f32_32x32x16_bf16(pa2, PK(2), o[d0], 0, 0, 0);
        o[d0] = __builtin_amdgcn_mfma_f32_32x32x16_bf16(pa3, PK(3), o[d0], 0, 0, 0);
#undef PK
    }
}
__device__ __forceinline__ void attn_issue(const Frame& F, int u, int t, int slot) {
    const int lane = F.lane, wid = F.wave; LAS unsigned char* shm = F.lds;
    const int qb = u % (SEQ / 32), bk = u / (SEQ / 32), b = bk / NKV, kvh = bk % NKV; const int q0 = qb * 32;
    const bf16* Kb = (const bf16*)(F.ws + WS_B + 128 * MiB); const bf16* Vb = (const bf16*)(F.ws + WS_B + 144 * MiB); const bf16* CKV = (const bf16*)(F.ws + WS_CTXKV);
    const size_t tok0 = (size_t)b * SEQ; const bf16* ksrc; const bf16* vsrc;
    if (t < 4) { const int c0 = b * CTXL + t * 64;
        ksrc = CKV + (size_t)(c0 + lane) * 512 + kvh * HD + wid * 8;
        vsrc = CKV + (size_t)(c0 + 16 * (wid & 3) + (lane >> 2)) * 512 + 256 + kvh * HD + (wid >> 2) * 32 + (lane & 3) * 8;
    } else { const int key0 = ((q0 - 128) & ~63) + (t - 4) * 64;
        int kr = key0 + lane; kr = kr < 0 ? 0 : (kr > SEQ - 1 ? SEQ - 1 : kr);
        int vr = key0 + 16 * (wid & 3) + (lane >> 2); vr = vr < 0 ? 0 : (vr > SEQ - 1 ? SEQ - 1 : vr);
        ksrc = Kb + (tok0 + kr) * KVD + kvh * HD + wid * 8;
        vsrc = Vb + (tok0 + vr) * KVD + kvh * HD + (wid >> 2) * 32 + (lane & 3) * 8;
    }
    __builtin_amdgcn_global_load_lds((const unsigned*)ksrc, (LAS unsigned*)(shm + LDS_K + slot * 8192 + wid * 1024), 16, 0, 0);
    __builtin_amdgcn_global_load_lds((const unsigned*)vsrc, (LAS unsigned*)(shm + LDS_V + slot * 8192 + wid * 1024), 16, 0, 0);
    if (t == 0) {
        const bf16* Qw = (const bf16*)(F.ws + WS_B) + (tok0 + q0 + (lane & 31)) * DM + (kvh * 8 + wid) * HD + (lane >> 5) * 8;
#pragma unroll
        for (int d0 = 0; d0 < 4; ++d0) __builtin_amdgcn_global_load_lds((const unsigned*)(Qw + d0 * 16), (LAS unsigned*)(shm + LDS_Q + wid * 4096 + d0 * 1024), 16, 0, 0);
    }
}
__device__ __forceinline__ void attn_phase(const Frame& F) {
    const int NU = NB * NKV * (SEQ / 32); const int per = (NU + F.G - 1) / F.G;
    const int u0 = F.bid * per; const int u1 = (u0 + per < NU) ? u0 + per : NU; if (u0 >= u1) return;
    const int ntile = (u1 - u0) * 9;
    const int lane = F.lane, r32 = lane & 31, hi = lane >> 5, wid = F.wave;
    LAS unsigned char* shm = F.lds;
    bf16* O = (bf16*)(F.ws + WS_A);
    LAS float* wsf = (LAS float*)(shm + LDS_WS) + wid * 64;
    const int vb0 = (int)(uintptr_t)(shm + LDS_V) + ((lane >> 4) & 1) * 32 + (lane & 3) * 8 + (4 * hi + ((lane & 15) >> 2)) * 64;
    bf16x8 qr[4]; float mref = 0.f, l_reg = 0.f; f32x16 o[2]; o[0] = f32x16{}; o[1] = f32x16{}; f32x16 negm = f32x16{};
    attn_issue(F, u0, 0, 0);
    if (ntile > 1) attn_issue(F, u0, 1, 1);
    int u = u0, t = 0;
    for (int g = 0; g < ntile; ++g) {
        const int slot = g % 3;
        const int qb = u % (SEQ / 32), bk = u / (SEQ / 32), b = bk / NKV, kvh = bk % NKV; const int q0 = qb * 32; const int head = kvh * 8 + wid; const size_t tok0 = (size_t)b * SEQ;
        if (g + 1 < ntile) { if (t == 8 || (t == 0 && g > 0)) asm volatile("s_waitcnt vmcnt(6)" ::: "memory"); else asm volatile("s_waitcnt vmcnt(2)" ::: "memory"); }
        else asm volatile("s_waitcnt vmcnt(0)" ::: "memory");
        LDS_WAIT(); __builtin_amdgcn_s_barrier();
        if (g + 2 < ntile) { const int g2 = g + 2; attn_issue(F, u0 + g2 / 9, g2 % 9, g2 % 3); }
        if (t == 0) {
#pragma unroll
            for (int d0 = 0; d0 < 4; ++d0) qr[d0] = *(const LAS bf16x8*)(shm + LDS_Q + wid * 4096 + d0 * 1024 + lane * 16);
            mref = 0.f; l_reg = 0.f; o[0] = f32x16{}; o[1] = f32x16{}; negm = f32x16{}; }
        f32x16 p0, p1;
        qkt(p0, p1, shm + LDS_K + slot * 8192, qr, negm, r32, hi);
        { const int key0 = ((q0 - 128) & ~63) + (t - 4) * 64;
          if (t >= 4 && (t == 4 || t == 8 || key0 < 0 || key0 + 64 > SEQ)) { const int qpos = q0 + r32;
#pragma unroll
            for (int r = 0; r < 16; ++r) { const int k0 = key0 + crow(r, hi), k1 = k0 + 32;
                const bool v0 = (k0 >= 0) && (k0 < SEQ) && (k0 - qpos <= 128) && (qpos - k0 <= 128);
                const bool v1 = (k1 >= 0) && (k1 < SEQ) && (k1 - qpos <= 128) && (qpos - k1 <= 128);
                p0[r] = v0 ? p0[r] : -INFINITY; p1[r] = v1 ? p1[r] : -INFINITY; } } }
        const float rm = rowmax(p0, p1);
        if (__any(rm > 8.f)) {
            const float dl = __builtin_fmaxf(rm, 0.f); mref += dl;
            const float f = __builtin_amdgcn_exp2f(-dl); l_reg *= f;
#pragma unroll
            for (int r = 0; r < 16; ++r) { p0[r] -= dl; p1[r] -= dl; negm[r] = -mref; }
            if (hi == 0) wsf[r32] = f;
            LDS_WAIT();
#pragma unroll
            for (int d = 0; d < 2; ++d)
#pragma unroll
                for (int r = 0; r < 16; ++r) o[d][r] *= wsf[crow(r, hi)];
        }
        float sacc = 0.f;
#pragma unroll
        for (int r = 0; r < 16; ++r) { p0[r] = __builtin_amdgcn_exp2f(p0[r]); p1[r] = __builtin_amdgcn_exp2f(p1[r]); sacc += p0[r] + p1[r]; }
        l_reg += sacc;
        u32x4 pw0, pw1, pw2, pw3;
#define PKW(P, B) cvt_pk_bf16(P[B], P[B + 1])
        pw0 = (u32x4){PKW(p0, 0), PKW(p0, 2), PKW(p0, 4), PKW(p0, 6)}; pw1 = (u32x4){PKW(p0, 8), PKW(p0, 10), PKW(p0, 12), PKW(p0, 14)};
        pw2 = (u32x4){PKW(p1, 0), PKW(p1, 2), PKW(p1, 4), PKW(p1, 6)}; pw3 = (u32x4){PKW(p1, 8), PKW(p1, 10), PKW(p1, 12), PKW(p1, 14)};
#undef PKW
        pv(o, vb0 + slot * 8192, __builtin_bit_cast(bf16x8, pw0), __builtin_bit_cast(bf16x8, pw1), __builtin_bit_cast(bf16x8, pw2), __builtin_bit_cast(bf16x8, pw3));
        if (t == 8) {
            { auto rr = __builtin_amdgcn_permlane32_swap(__float_as_uint(l_reg), __float_as_uint(l_reg), false, false); l_reg = __uint_as_float(rr[0]) + __uint_as_float(rr[1]); }
            l_reg += __builtin_amdgcn_exp2f(AIN(I_SINK)[head] * 1.4426950408889634f - mref);
            if (hi == 0) wsf[32 + r32] = l_reg;
            LDS_WAIT();
            float rli[16];
#pragma unroll
            for (int r = 0; r < 16; ++r) rli[r] = 1.f / wsf[32 + crow(r, hi)];
            bf16* Ow = O + (tok0 + q0) * DM + head * HD;
            LAS bf16* stg = (LAS bf16*)(shm + LDS_OST) + wid * 2048;
#pragma unroll
            for (int r = 0; r < 16; ++r) { const int orow = crow(r, hi);
#pragma unroll
                for (int d0 = 0; d0 < 2; ++d0) stg[orow * 64 + d0 * 32 + r32] = (bf16)(cvt_pk_bf16(o[d0][r] * rli[r], 0.f) & 0xffffu); }
            LDS_WAIT();
#pragma unroll
            for (int i = 0; i < 4; ++i) { const int row = i * 8 + (lane >> 3), ch = lane & 7; const u32x4 v = *(const LAS u32x4*)(stg + row * 64 + ch * 8); *(u32x4*)(Ow + (size_t)row * DM + ch * 8) = v; }
        }
        if (t == 8) { t = 0; ++u; } else ++t;
    }
}
}

__device__ __forceinline__ float row16_sum(float v) {
    v += __builtin_bit_cast(float, __builtin_amdgcn_update_dpp(0, __builtin_bit_cast(int, v), 0xB1, 0xf, 0xf, true));
    v += __builtin_bit_cast(float, __builtin_amdgcn_update_dpp(0, __builtin_bit_cast(int, v), 0x4E, 0xf, 0xf, true));
    v += __builtin_bit_cast(float, __builtin_amdgcn_update_dpp(0, __builtin_bit_cast(int, v), 0x141, 0xf, 0xf, true));
    v += __builtin_bit_cast(float, __builtin_amdgcn_update_dpp(0, __builtin_bit_cast(int, v), 0x140, 0xf, 0xf, true));
    return v;
}
template <int NV> __device__ __forceinline__ void block_reduce(const float (&x)[NV], LAS float* red, LAS float* tot, int tid, int lane, int wave) {
    float y[NV / 2], z[NV / 4];
#pragma unroll
    for (int i = 0; i < NV / 2; ++i) { auto r = __builtin_amdgcn_permlane32_swap(__float_as_uint(x[i]), __float_as_uint(x[i + NV / 2]), false, false); y[i] = __uint_as_float(r[0]) + __uint_as_float(r[1]); }
#pragma unroll
    for (int i = 0; i < NV / 4; ++i) { auto r = __builtin_amdgcn_permlane16_swap(__float_as_uint(y[i]), __float_as_uint(y[i + NV / 4]), false, false); z[i] = row16_sum(__uint_as_float(r[0]) + __uint_as_float(r[1])); }
    if ((lane & 15) == 0) { const int q = lane >> 4;
#pragma unroll
        for (int i = 0; i < NV / 4; ++i) red[wave * NV + i + q * (NV / 4)] = z[i]; }
    __syncthreads();
    if (tid < NV) { float s = 0.f;
#pragma unroll
        for (int w = 0; w < NWAVES; ++w) s += red[w * NV + tid];
        tot[tid] = s; }
    __syncthreads();
}
struct LnLds { LAS float* red; LAS float* tot; LAS float* sab; LAS int* lcnt; LAS int* lbase; LAS int* lcls; LAS int* lrank; LAS float* lg; LAS float* rowtab; };
__device__ __forceinline__ LnLds ln_lds(const Frame& F) { LnLds L; L.red = (LAS float*)F.lds; L.tot = L.red + 8 * 72; L.sab = L.tot + 72; L.lcnt = (LAS int*)(L.sab + 32); L.lbase = L.lcnt + 32; L.lcls = L.lbase + 32; L.lrank = L.lcls + 256; L.lg = (LAS float*)(L.lrank + 256); L.rowtab = L.lg + 512; return L; }

template <bool HIN_F32> __device__ __forceinline__ void ln1_router_phase(const Frame& F, int layer, const void* hin_, const bf16* ymix, bf16* u2out, bf16* hout) {
    const float* hin = (const float*)hin_; const bf16* hinb = (const bf16*)hin_;
    const LnLds L = ln_lds(F);
    const int tid = F.tid, lane = F.lane, wave = F.wave, c0 = 4 * tid;
    int per = (MTOK + F.G - 1) / F.G; per = (per + 7) & ~7;
    const int rbase = F.bid * per; const int rend = (rbase + per < MTOK) ? rbase + per : MTOK; const int nrows = rend - rbase;
    if (tid < NCLS) L.lcnt[tid] = 0;
    if (nrows > 0 && nrows <= 256) {
    const int b = rbase / SEQ;
    const f32x4 g1 = *(const f32x4*)(mod_ptr(F, layer, b, 2) + c0), sh2 = *(const f32x4*)(mod_ptr(F, layer, b, 3) + c0), sc2 = *(const f32x4*)(mod_ptr(F, layer, b, 4) + c0);
    const f32x4 A0 = *(const f32x4*)(AIN(I_LN1G) + layer * DM + c0), B0 = *(const f32x4*)(AIN(I_LN1B) + layer * DM + c0);
    const f32x4 A1 = A0 * (sc2 + 1.f), B1 = B0 * (sc2 + 1.f) + sh2;
    f32x4 P[4][4];
    { float sx[32];
#pragma unroll
      for (int c = 0; c < 4; ++c)
#pragma unroll
          for (int g = 0; g < 4; ++g) { const f32x4 w = *(const f32x4*)(AIN(I_RW) + (size_t)(c0 + c) * NEXP + 4 * g); P[c][g] = w * A1[c];
#pragma unroll
              for (int i = 0; i < 4; ++i) { if (c == 0) { sx[g * 4 + i] = 0.f; sx[16 + g * 4 + i] = 0.f; } sx[g * 4 + i] += w[i] * A1[c]; sx[16 + g * 4 + i] += w[i] * B1[c]; } }
      block_reduce<32>(sx, L.red, L.tot, tid, lane, wave);
      if (tid < 32) L.sab[tid] = L.tot[tid];
      __syncthreads(); }
    const float* rb = AIN(I_RB);
    f32x4 hf[4], hf2[4]; u32x2 hb[4], hb2[4]; u32x2 yv[4], yv2[4];
#define LN_LOADH(k, r_, o) do { if (HIN_F32) hf##k[r_] = *(const f32x4*)(hin + (o)); else hb##k[r_] = *(const u32x2*)(hinb + (o)); } while (0)
#pragma unroll
    for (int r = 0; r < 4; ++r) { const size_t o = (size_t)(rbase + r) * DM + c0; LN_LOADH(, r, o); yv[r] = *(const u32x2*)(ymix + o); }
    { const int pr0 = (rbase + 4 < rend) ? rbase + 4 : rend - 4;
#pragma unroll
      for (int r = 0; r < 4; ++r) { const size_t o = (size_t)(pr0 + r) * DM + c0; LN_LOADH(2, r, o); yv2[r] = *(const u32x2*)(ymix + o); } }
#define LN1_GROUP(HF, HB, YV, ROW0) do { \
        f32x4 v[4]; float x[72]; \
        _Pragma("unroll") for (int r = 0; r < 4; ++r) { const f32x4 y = {bflo(YV[r].x), bfhi(YV[r].x), bflo(YV[r].y), bfhi(YV[r].y)}; \
            const f32x4 hq = HIN_F32 ? HF[r] : (f32x4){bflo(HB[r].x), bfhi(HB[r].x), bflo(HB[r].y), bfhi(HB[r].y)}; \
            v[r] = hq * DN_ALPHA + g1 * y; \
            x[r * 18] = (v[r][0] + v[r][1]) + (v[r][2] + v[r][3]); x[r * 18 + 1] = (v[r][0] * v[r][0] + v[r][1] * v[r][1]) + (v[r][2] * v[r][2] + v[r][3] * v[r][3]); \
            _Pragma("unroll") for (int g = 0; g < 4; ++g) { const f32x4 q = P[0][g] * v[r][0] + P[1][g] * v[r][1] + P[2][g] * v[r][2] + P[3][g] * v[r][3]; \
                x[r * 18 + 2 + 4 * g] = q[0]; x[r * 18 + 3 + 4 * g] = q[1]; x[r * 18 + 4 + 4 * g] = q[2]; x[r * 18 + 5 + 4 * g] = q[3]; } } \
        { const int pr0 = ((ROW0) + 8 < rend) ? (ROW0) + 8 : rend - 4; \
          _Pragma("unroll") for (int r = 0; r < 4; ++r) { const size_t o = (size_t)(pr0 + r) * DM + c0; if (HIN_F32) HF[r] = *(const f32x4*)(hin + o); else HB[r] = *(const u32x2*)(hinb + o); YV[r] = *(const u32x2*)(ymix + o); } } \
        LAS float* gt = L.rowtab + (((ROW0) - rbase) >> 2) * 72; \
        block_reduce<72>(x, L.red, gt, tid, lane, wave); \
        _Pragma("unroll") for (int r = 0; r < 4; ++r) { const float mean = gt[r * 18] * (1.f / DM); const float var = gt[r * 18 + 1] * (1.f / DM) - mean * mean; const float rstd = 1.f / sqrtf(var + LN_EPS); \
            const f32x4 vn = (v[r] - mean) * rstd; const f32x4 hn = vn * A0 + B0, u = vn * A1 + B1; const size_t o = (size_t)((ROW0) + r) * DM + c0; \
            u32x2 hw; hw.x = cvt_pk_bf16(hn[0], hn[1]); hw.y = cvt_pk_bf16(hn[2], hn[3]); *(u32x2*)(hout + o) = hw; u32x2 w; w.x = cvt_pk_bf16(u[0], u[1]); w.y = cvt_pk_bf16(u[2], u[3]); *(u32x2*)(u2out + o) = w; } \
    } while (0)
    for (int row0 = rbase; row0 < rend; row0 += 8) { LN1_GROUP(hf, hb, yv, row0); LN1_GROUP(hf2, hb2, yv2, row0 + 4); }
#undef LN1_GROUP
    __syncthreads();
    if (tid < nrows) {
            const int rl = tid; const LAS float* gt = L.rowtab + (rl >> 2) * 72 + (rl & 3) * 18;
            const float mean = gt[0] * (1.f / DM); const float var = gt[1] * (1.f / DM) - mean * mean; const float rstd = 1.f / sqrtf(var + LN_EPS);
            float sg[16], sel[16];
#pragma unroll
            for (int e = 0; e < 16; ++e) { const float lgt = rstd * (gt[2 + e] - mean * L.sab[e]) + L.sab[16 + e]; const float sv = 1.f / (1.f + expf(-lgt)); sg[e] = sv; sel[e] = sv + rb[e]; }
            int gb = 0; float gbs = -INFINITY;
#pragma unroll
            for (int g = 0; g < 4; ++g) { const float a = sel[4 * g], bq = sel[4 * g + 1], c = sel[4 * g + 2], d = sel[4 * g + 3];
                const float ps = fmaxf(fmaxf(fmaxf(a + bq, a + c), fmaxf(a + d, bq + c)), fmaxf(bq + d, c + d)); if (ps > gbs) { gbs = ps; gb = g; } }
            float cs[4], cg[4];
#pragma unroll
            for (int i = 0; i < 4; ++i) { cs[i] = sel[i]; cg[i] = sg[i];
#pragma unroll
                for (int g = 1; g < 4; ++g) if (gb == g) { cs[i] = sel[4 * g + i]; cg[i] = sg[4 * g + i]; } }
            int i0 = 0; float b0 = cs[0];
#pragma unroll
            for (int i = 1; i < 4; ++i) if (cs[i] > b0) { b0 = cs[i]; i0 = i; }
            int i1 = -1; float b1 = -INFINITY;
#pragma unroll
            for (int i = 0; i < 4; ++i) if (i != i0 && cs[i] > b1) { b1 = cs[i]; i1 = i; }
            float ga = 0.f, gbv = 0.f;
#pragma unroll
            for (int i = 0; i < 4; ++i) { if (i == i0) ga = cg[i]; if (i == i1) gbv = cg[i]; }
            const float den = ga + gbv; ga /= den; gbv /= den;
            const int lo = i0 < i1 ? i0 : i1, hi = i0 < i1 ? i1 : i0; const float glo = i0 < i1 ? ga : gbv, ghi = i0 < i1 ? gbv : ga;
            const int pidx = (lo == 0) ? (hi - 1) : (lo == 1 ? hi + 1 : 5);
            const int cls = gb * 6 + pidx;
            L.lcls[rl] = cls; L.lrank[rl] = __hip_atomic_fetch_add(&L.lcnt[cls], 1, __ATOMIC_RELAXED, __HIP_MEMORY_SCOPE_WORKGROUP); L.lg[2 * rl] = glo; L.lg[2 * rl + 1] = ghi;
    }
    }
    __syncthreads();
    if (tid < NCLS) L.lbase[tid] = (int)__hip_atomic_fetch_add((unsigned*)(F.ctl + CW_CNT + (layer * NCLS + tid) * 64), (unsigned)L.lcnt[tid], RLX_AGENT);
    __syncthreads();
    if (tid < nrows && nrows <= 256) { const int cls = L.lcls[tid]; const int pos = cls * LCAP + L.lbase[cls] + L.lrank[tid];
        ((int*)(F.ws + WS_TOK))[pos] = rbase + tid; ((float*)(F.ws + WS_GATE))[pos] = L.lg[2 * tid]; ((float*)(F.ws + WS_GATE))[(size_t)NCLS * LCAP + pos] = L.lg[2 * tid + 1]; }
}
#undef LN_LOADH
template <bool OUT_F32> __device__ __forceinline__ void ln2_phase(const Frame& F, int layer, bf16* fio, const bf16* hinb, void* hout_) {
    float* houtf = (float*)hout_; bf16* houtb = (bf16*)hout_;
    const LnLds L = ln_lds(F);
    const int tid = F.tid, lane = F.lane, wave = F.wave, c0 = 4 * tid;
    int per = (MTOK + F.G - 1) / F.G; per = (per + 3) & ~3;
    const int rbase = F.bid * per; const int rend = (rbase + per < MTOK) ? rbase + per : MTOK;
    if (rbase >= rend) return;
    const int b = rbase / SEQ;
    const f32x4 g2 = *(const f32x4*)(mod_ptr(F, layer, b, 5) + c0), sh1 = *(const f32x4*)(mod_ptr(F, 1, b, 0) + c0), sc1 = *(const f32x4*)(mod_ptr(F, 1, b, 1) + c0);
    const f32x4 A0 = *(const f32x4*)(AIN(I_LN2G) + layer * DM + c0), B0 = *(const f32x4*)(AIN(I_LN2B) + layer * DM + c0);
    const f32x4 A1 = A0 * (sc1 + 1.f), B1 = B0 * (sc1 + 1.f) + sh1;
    u32x2 hw[4], hw2[4], hw3[4]; u32x2 yv[4], yv2[4], yv3[4];
#pragma unroll
    for (int r = 0; r < 4; ++r) { const size_t o = (size_t)(rbase + r) * DM + c0; hw[r] = *(const u32x2*)(hinb + o); yv[r] = *(const u32x2*)(fio + o); }
#pragma unroll
    for (int r = 0; r < 4; ++r) { const size_t o = (size_t)(rbase + 4 + r) * DM + c0; if (rbase + 4 < rend) { hw2[r] = *(const u32x2*)(hinb + o); yv2[r] = *(const u32x2*)(fio + o); } }
#pragma unroll
    for (int r = 0; r < 4; ++r) { const size_t o = (size_t)(rbase + 8 + r) * DM + c0; if (rbase + 8 < rend) { hw3[r] = *(const u32x2*)(hinb + o); yv3[r] = *(const u32x2*)(fio + o); } }
    for (int row0 = rbase; row0 < rend; row0 += 4) {
        f32x4 v[4]; float x[8];
#pragma unroll
        for (int r = 0; r < 4; ++r) { const f32x4 y = {bflo(yv[r].x), bfhi(yv[r].x), bflo(yv[r].y), bfhi(yv[r].y)}; const f32x4 hvr = {bflo(hw[r].x), bfhi(hw[r].x), bflo(hw[r].y), bfhi(hw[r].y)}; v[r] = hvr * DN_ALPHA + g2 * y;
            x[r * 2] = (v[r][0] + v[r][1]) + (v[r][2] + v[r][3]); x[r * 2 + 1] = (v[r][0] * v[r][0] + v[r][1] * v[r][1]) + (v[r][2] * v[r][2] + v[r][3] * v[r][3]); }
#pragma unroll
        for (int r = 0; r < 4; ++r) { hw[r] = hw2[r]; yv[r] = yv2[r]; hw2[r] = hw3[r]; yv2[r] = yv3[r]; }
        if (row0 + 12 < rend) {
#pragma unroll
            for (int r = 0; r < 4; ++r) { const size_t o = (size_t)(row0 + 12 + r) * DM + c0; hw3[r] = *(const u32x2*)(hinb + o); yv3[r] = *(const u32x2*)(fio + o); } }
        block_reduce<8>(x, L.red, L.tot, tid, lane, wave);
#pragma unroll
        for (int r = 0; r < 4; ++r) { const float mean = L.tot[r * 2] * (1.f / DM); const float var = L.tot[r * 2 + 1] * (1.f / DM) - mean * mean; const float rstd = 1.f / sqrtf(var + LN_EPS);
            const f32x4 vn = (v[r] - mean) * rstd; const f32x4 hn = vn * A0 + B0; const size_t o = (size_t)(row0 + r) * DM + c0;
            if (OUT_F32) *(f32x4*)(houtf + o) = hn; else { u32x2 hw; hw.x = cvt_pk_bf16(hn[0], hn[1]); hw.y = cvt_pk_bf16(hn[2], hn[3]); *(u32x2*)(houtb + o) = hw; }
            if (layer == 0) { const f32x4 u = vn * A1 + B1; u32x2 w; w.x = cvt_pk_bf16(u[0], u[1]); w.y = cvt_pk_bf16(u[2], u[3]); *(u32x2*)(fio + o) = w; } }
    }
}
namespace hy {
constexpr int L = SEQ;
__device__ constexpr float C32[16] = {1.000000000e+00f, 9.807852804e-01f, 9.238795325e-01f, 8.314696123e-01f, 7.071067812e-01f, 5.555702330e-01f, 3.826834324e-01f, 1.950903220e-01f,
                                      0.f, -1.950903220e-01f, -3.826834324e-01f, -5.555702330e-01f, -7.071067812e-01f, -8.314696123e-01f, -9.238795325e-01f, -9.807852804e-01f};
__device__ constexpr float S32[16] = {0.f, 1.950903220e-01f, 3.826834324e-01f, 5.555702330e-01f, 7.071067812e-01f, 8.314696123e-01f, 9.238795325e-01f, 9.807852804e-01f,
                                      1.f, 9.807852804e-01f, 9.238795325e-01f, 8.314696123e-01f, 7.071067812e-01f, 5.555702330e-01f, 3.826834324e-01f, 1.950903220e-01f};
__host__ __device__ constexpr int brev(int k, int bits) { int r = 0; for (int i = 0; i < bits; ++i) r |= ((k >> i) & 1) << (bits - 1 - i); return r; }
__device__ __forceinline__ void unit_root(float frac, bool inv, float& wr, float& wi) {
    wr = __builtin_amdgcn_cosf(frac); float s = __builtin_amdgcn_sinf(frac);
    asm volatile("s_nop 1" : "+v"(wr), "+v"(s));
    wi = inv ? s : -s;
}
constexpr int FT_F32 = 0, FT_I32 = 8, FT_I32P = 16, FT_F16 = 24, FT_I16 = 26, FT_NFRAG = 28;
__device__ __forceinline__ int crow(int r, int h) { return (r & 3) + 8 * (r >> 2) + 4 * h; }
__device__ __forceinline__ bf16x8 pack8(const float (&v)[8]) { u32x4 w; w.x = cvt_pk_bf16(v[0], v[1]); w.y = cvt_pk_bf16(v[2], v[3]); w.z = cvt_pk_bf16(v[4], v[5]); w.w = cvt_pk_bf16(v[6], v[7]); return __builtin_bit_cast(bf16x8, w); }
__device__ __forceinline__ void cmul(float& xr, float& xi, float wr, float wi) {
    float t0, t1, nr, ni;
    asm("v_mul_f32_e32 %0, %1, %2" : "=v"(t0) : "v"(xi), "v"(wi));
    asm("v_mul_f32_e32 %0, %1, %2" : "=v"(t1) : "v"(xi), "v"(wr));
    asm("v_fma_f32 %0, %1, %2, -%3" : "=v"(nr) : "v"(xr), "v"(wr), "v"(t0));
    asm("v_fma_f32 %0, %1, %2, %3" : "=v"(ni) : "v"(xr), "v"(wi), "v"(t1));
    xr = nr; xi = ni;
}
#define FRAG(f) (tab[(f) * 64 + lane])
template <bool INV> __device__ __forceinline__ void pass1(LAS f32x2* dat, const LAS bf16x8* tab, int lane, int wave) {
    asm volatile("" : "+v"(lane));
    const int h = lane >> 5, c5 = lane & 31;
    const bf16x8 a0 = FRAG((INV ? FT_I16 : FT_F16) + 0), a1 = FRAG((INV ? FT_I16 : FT_F16) + 1);
#pragma unroll 1
    for (int g = 0; g < 4; ++g) {
        const int col = 128 * wave + 32 * g + c5; const int pc = col ^ ((4 * wave + g) & 31) ^ ((2 * g + (c5 >> 4)) & 7);
        float wr, wi; unit_root((float)col * (1.f / 16384.f), INV, wr, wi);
        float w2r = wr, w2i = wi; cmul(w2r, w2i, wr, wi); float w4r = w2r, w4i = w2i; cmul(w4r, w4i, w2r, w2i); float w8r = w4r, w8i = w4i; cmul(w8r, w8i, w4r, w4i);
        float re[8], im[8];
#pragma unroll
        for (int jj = 0; jj < 8; ++jj) { const f32x2 v = dat[pc + 1024 * (8 * h + jj)]; re[jj] = v.x; im[jj] = v.y; }
        if (INV) {
            float cr = h ? w8r : 1.f, ci = h ? w8i : 0.f;
#pragma unroll
            for (int jj = 0; jj < 8; ++jj) { cmul(re[jj], im[jj], cr, ci); cmul(cr, ci, wr, wi); }
        }
        const f32x16 z = {};
        f32x16 d = __builtin_amdgcn_mfma_f32_32x32x16_bf16(a0, pack8(re), z, 0, 0, 0);
        d = __builtin_amdgcn_mfma_f32_32x32x16_bf16(a1, pack8(im), d, 0, 0, 0);
        asm volatile("s_nop 15\n\ts_nop 7" : "+v"(d));
        float cr = h ? w4r : 1.f, ci = h ? w4i : 0.f;
#pragma unroll
        for (int rr = 0; rr < 8; ++rr) { float xr = d[rr], xi = d[rr + 8];
            if (!INV) { if (rr == 4) { cr = h ? w4r : 1.f; ci = h ? w4i : 0.f; cmul(cr, ci, w8r, w8i); } cmul(xr, xi, cr, ci); cmul(cr, ci, wr, wi); }
            f32x2 o; o.x = xr; o.y = xi; dat[pc + 1024 * ((rr & 3) + 8 * (rr >> 2) + 4 * h)] = o; }
    }
}
template <bool INV> __device__ __forceinline__ void pass2(LAS f32x2* dat, const LAS bf16x8* tab, int lane, int wave) {
    asm volatile("" : "+v"(lane));
    const int h = lane >> 5, b = lane & 31, bp = b ^ (b >> 4);
    float wr, wi; unit_root((float)b * (1.f / 1024.f), INV, wr, wi);
    float w2r = wr, w2i = wi; cmul(w2r, w2i, wr, wi); float w4r = w2r, w4i = w2i; cmul(w4r, w4i, w2r, w2i); float w8r = w4r, w8i = w4i; cmul(w8r, w8i, w4r, w4i); float w16r = w8r, w16i = w8i; cmul(w16r, w16i, w8r, w8i);
#pragma unroll 1
    for (int g = 0; g < 2; ++g) {
        const int base = (2 * wave + g) * 1024;
        float re[2][8], im[2][8];
#pragma unroll
        for (int hf = 0; hf < 2; ++hf)
#pragma unroll
            for (int jj = 0; jj < 8; ++jj) { const int n = 16 * hf + 8 * h + jj; const f32x2 v = dat[base + 32 * n + (bp ^ (16 * hf + 8 * h + (jj ^ ((2 * jj) & 7))))]; re[hf][jj] = v.x; im[hf][jj] = v.y; }
        if (INV) {
            float cr = h ? w8r : 1.f, ci = h ? w8i : 0.f;
#pragma unroll
            for (int jj = 0; jj < 8; ++jj) { cmul(re[0][jj], im[0][jj], cr, ci); float dr = cr, di = ci; cmul(dr, di, w16r, w16i); cmul(re[1][jj], im[1][jj], dr, di); cmul(cr, ci, wr, wi); }
        }
        const bf16x8 b0 = pack8(re[0]), b1 = pack8(re[1]), b2 = pack8(im[0]), b3 = pack8(im[1]);
        const int fb = INV ? FT_I32 : FT_F32; const f32x16 z = {};
        f32x16 dre = __builtin_amdgcn_mfma_f32_32x32x16_bf16(FRAG(fb + 0), b0, z, 0, 0, 0); f32x16 dim = __builtin_amdgcn_mfma_f32_32x32x16_bf16(FRAG(fb + 4), b0, z, 0, 0, 0);
        dre = __builtin_amdgcn_mfma_f32_32x32x16_bf16(FRAG(fb + 1), b1, dre, 0, 0, 0); dim = __builtin_amdgcn_mfma_f32_32x32x16_bf16(FRAG(fb + 5), b1, dim, 0, 0, 0);
        dre = __builtin_amdgcn_mfma_f32_32x32x16_bf16(FRAG(fb + 2), b2, dre, 0, 0, 0); dim = __builtin_amdgcn_mfma_f32_32x32x16_bf16(FRAG(fb + 6), b2, dim, 0, 0, 0);
        dre = __builtin_amdgcn_mfma_f32_32x32x16_bf16(FRAG(fb + 3), b3, dre, 0, 0, 0); dim = __builtin_amdgcn_mfma_f32_32x32x16_bf16(FRAG(fb + 7), b3, dim, 0, 0, 0);
        asm volatile("s_nop 15\n\ts_nop 7" : "+v"(dre), "+v"(dim));
        float gr = h ? w4r : 1.f, gi = h ? w4i : 0.f;
#pragma unroll
        for (int r = 0; r < 16; ++r) { float xr = dre[r], xi = dim[r]; const int kf = (r & 3) + 8 * (r >> 2) + 4 * h;
            if (!INV) { float cr = gr, ci = gi; if ((r & 3) == 1) cmul(cr, ci, wr, wi); if ((r & 3) == 2) cmul(cr, ci, w2r, w2i); if ((r & 3) == 3) { cmul(cr, ci, w2r, w2i); cmul(cr, ci, wr, wi); }
                cmul(xr, xi, cr, ci); if ((r & 3) == 3) cmul(gr, gi, w8r, w8i); }
            f32x2 o; o.x = xr; o.y = xi; dat[base + 32 * kf + (bp ^ kf ^ (2 * (r & 3)))] = o; }
    }
}
template <bool FILTER> __device__ __forceinline__ void pass3(LAS f32x2* dat, const LAS bf16x8* tab, int lane, int wave, const int g, f32x2* Kbuf, const f32x2 (&kpre)[16]) {
    asm volatile("" : "+v"(lane));
    const int h = lane >> 5, sw = lane & 31, swp = sw ^ (2 * (sw & 3));
    {
        const int q = 64 * wave + 32 * g + sw, base = 32 * q;
        float re[2][8], im[2][8];
#pragma unroll
        for (int hf = 0; hf < 2; ++hf)
#pragma unroll
            for (int jj = 0; jj < 8; ++jj) { const int n = 16 * hf + 8 * h + jj; const f32x2 v = dat[base + (n ^ swp ^ hf)]; re[hf][jj] = v.x; im[hf][jj] = v.y; }
        const bf16x8 b0 = pack8(re[0]), b1 = pack8(re[1]), b2 = pack8(im[0]), b3 = pack8(im[1]);
        const f32x16 z = {};
        f32x16 dre = __builtin_amdgcn_mfma_f32_32x32x16_bf16(FRAG(FT_F32 + 0), b0, z, 0, 0, 0); f32x16 dim = __builtin_amdgcn_mfma_f32_32x32x16_bf16(FRAG(FT_F32 + 4), b0, z, 0, 0, 0);
        dre = __builtin_amdgcn_mfma_f32_32x32x16_bf16(FRAG(FT_F32 + 1), b1, dre, 0, 0, 0); dim = __builtin_amdgcn_mfma_f32_32x32x16_bf16(FRAG(FT_F32 + 5), b1, dim, 0, 0, 0);
        dre = __builtin_amdgcn_mfma_f32_32x32x16_bf16(FRAG(FT_F32 + 2), b2, dre, 0, 0, 0); dim = __builtin_amdgcn_mfma_f32_32x32x16_bf16(FRAG(FT_F32 + 6), b2, dim, 0, 0, 0);
        dre = __builtin_amdgcn_mfma_f32_32x32x16_bf16(FRAG(FT_F32 + 3), b3, dre, 0, 0, 0); dim = __builtin_amdgcn_mfma_f32_32x32x16_bf16(FRAG(FT_F32 + 7), b3, dim, 0, 0, 0);
        asm volatile("s_nop 15\n\ts_nop 7" : "+v"(dre), "+v"(dim));
        if (FILTER) {
#pragma unroll
            for (int r = 0; r < 16; ++r) { f32x2 o; o.x = dre[r]; o.y = dim[r]; Kbuf[((r & 3) + 8 * (r >> 2) + 4 * h) * 512 + q] = o; }
        } else {
            float yr[16], yi[16];
#pragma unroll
            for (int r = 0; r < 16; ++r) { const f32x2 kv = kpre[r]; float a_ = dre[r], b_ = dim[r]; cmul(a_, b_, kv.x, kv.y); yr[r] = a_; yi[r] = b_; }
            float t0[8], t1[8], t2[8], t3[8];
#pragma unroll
            for (int j = 0; j < 8; ++j) { t0[j] = yr[j]; t1[j] = yr[8 + j]; t2[j] = yi[j]; t3[j] = yi[8 + j]; }
            const bf16x8 c0 = pack8(t0), c1 = pack8(t1), c2 = pack8(t2), c3 = pack8(t3);
            f32x16 ere = __builtin_amdgcn_mfma_f32_32x32x16_bf16(FRAG(FT_I32P + 0), c0, z, 0, 0, 0); f32x16 eim = __builtin_amdgcn_mfma_f32_32x32x16_bf16(FRAG(FT_I32P + 4), c0, z, 0, 0, 0);
            ere = __builtin_amdgcn_mfma_f32_32x32x16_bf16(FRAG(FT_I32P + 1), c1, ere, 0, 0, 0); eim = __builtin_amdgcn_mfma_f32_32x32x16_bf16(FRAG(FT_I32P + 5), c1, eim, 0, 0, 0);
            ere = __builtin_amdgcn_mfma_f32_32x32x16_bf16(FRAG(FT_I32P + 2), c2, ere, 0, 0, 0); eim = __builtin_amdgcn_mfma_f32_32x32x16_bf16(FRAG(FT_I32P + 6), c2, eim, 0, 0, 0);
            ere = __builtin_amdgcn_mfma_f32_32x32x16_bf16(FRAG(FT_I32P + 3), c3, ere, 0, 0, 0); eim = __builtin_amdgcn_mfma_f32_32x32x16_bf16(FRAG(FT_I32P + 7), c3, eim, 0, 0, 0);
#pragma unroll
            for (int r = 0; r < 16; ++r) { f32x2 o; o.x = ere[r]; o.y = eim[r]; dat[base + ((((r & 3) + 8 * (r >> 2) + 4 * h)) ^ swp ^ (r >> 3))] = o; }
        }
    }
}
#undef FRAG
__device__ __forceinline__ float ftab_value(int f, int l, int jj) {
    const int r = l & 31, h = l >> 5;
    if (f < 24) {
        const int kind = f >> 3, rb = (f >> 2) & 1, s = f & 3; int kk, pp;
        if (kind < 2) { kk = 16 * (s & 1) + 8 * h + jj; pp = s >> 1; } else { kk = 16 * (s & 1) + 8 * (jj >> 2) + 4 * h + (jj & 3); pp = s >> 1; }
        const float th = 6.283185307179586f * (float)((r * kk) & 31) * (1.f / 32.f); const float c = cosf(th), sn = sinf(th);
        if (kind == 0) return rb == 0 ? (pp == 0 ? c : sn) : (pp == 0 ? -sn : c);
        return rb == 0 ? (pp == 0 ? c : -sn) : (pp == 0 ? sn : c);
    }
    const int inv = (f - 24) >> 1, s = (f - 24) & 1; const int part = r >> 4, kf = r & 15, n = 8 * h + jj;
    const float th = 6.283185307179586f * (float)((kf * n) & 15) * (1.f / 16.f); const float c = cosf(th), sn = sinf(th);
    if (!inv) return part == 0 ? (s == 0 ? c : sn) : (s == 0 ? -sn : c);
    return part == 0 ? (s == 0 ? c : -sn) : (s == 0 ? sn : c);
}
__device__ __forceinline__ int phys(int p) { return p ^ ((p >> 5) & 31) ^ ((p >> 4) & 7); }
__device__ __forceinline__ void unpack8(const u32x4 v, float (&f)[8]) { f[0] = bflo(v.x); f[1] = bfhi(v.x); f[2] = bflo(v.y); f[3] = bfhi(v.y); f[4] = bflo(v.z); f[5] = bfhi(v.z); f[6] = bflo(v.w); f[7] = bfhi(v.w); }
struct Raw8 { u32x4 v; unsigned l, r; };
__device__ __forceinline__ Raw8 load_raw8(const bf16* rowp, int t0) { Raw8 q; q.v = *(const u32x4*)(rowp + t0); q.l = (t0 > 0) ? (unsigned)rowp[t0 - 1] : 0u; q.r = (t0 + 8 < L) ? (unsigned)rowp[t0 + 8] : 0u; return q; }
__device__ __forceinline__ void conv8(const Raw8& q, float w0, float w1, float w2, float cb, float (&o)[8]) {
    float f[8]; unpack8(q.v, f); const float left = bf2f(q.l), right = bf2f(q.r);
#pragma unroll
    for (int e = 0; e < 8; ++e) { const float a = (e == 0) ? left : f[e - 1], c = (e == 7) ? right : f[e + 1]; o[e] = w0 * a + w1 * f[e] + w2 * c + cb; }
}
typedef const LAS float* ChanPar;
struct RawZ { Raw8 x[2], v[2]; };
__device__ __forceinline__ RawZ load_rawz(const bf16* pT, int d, int t0) { RawZ q;
#pragma unroll
    for (int bt = 0; bt < 2; ++bt) { q.x[bt] = load_raw8(pT + (size_t)(DM + d) * MTOK + bt * L, t0); q.v[bt] = load_raw8(pT + (size_t)(2 * DM + d) * MTOK + bt * L, t0); }
    return q; }
__device__ __forceinline__ void z_from_raw(const RawZ& q, ChanPar P, float (&z0)[8], float (&z1)[8]) {
#pragma unroll
    for (int bt = 0; bt < 2; ++bt) { float a[8], v[8];
        conv8(q.x[bt], P[4], P[5], P[6], P[7], a); conv8(q.v[bt], P[8], P[9], P[10], P[11], v);
#pragma unroll
        for (int e = 0; e < 8; ++e) { if (bt == 0) z0[e] = a[e] * v[e]; else z1[e] = a[e] * v[e]; } }
}
struct RawF { u32x4 hf, hb; unsigned first; };
__device__ __forceinline__ RawF load_rawf(const bf16* HT, int d, int t0) { RawF q; q.hf = *(const u32x4*)(HT + (size_t)d * L + t0); q.hb = *(const u32x4*)(HT + (size_t)(DM + d) * L + (L - t0 - 8));
    q.first = (t0 > 0) ? (unsigned)HT[(size_t)(DM + d) * L + (L - t0)] : 0u; return q; }
__device__ __forceinline__ void filt8(const RawF& q, int t0, ChanPar P, float (&k)[8], float (&kl)[8], float& l1p) {
    float hf[8], hb[8]; unpack8(q.hf, hf); unpack8(q.hb, hb);
    float s = 0.f;
#pragma unroll
    for (int e = 0; e < 8; ++e) { const float dc = __builtin_amdgcn_exp2f(-(float)(t0 + e) * P[13]); k[e] = hf[e] * dc; s += fabsf(k[e]); }
    float hbd[8];
#pragma unroll
    for (int e = 0; e < 8; ++e) { const int m = L - t0 - 8 + e; const float dc = __builtin_amdgcn_exp2f(-(float)m * P[13]); hbd[e] = hb[e] * dc; if (m >= 1) s += fabsf(hbd[e]); }
    kl[0] = (t0 > 0) ? bf2f(q.first) * __builtin_amdgcn_exp2f(-(float)(L - t0) * P[13]) : 0.f;
#pragma unroll
    for (int e = 1; e < 8; ++e) kl[e] = hbd[8 - e];
#pragma unroll
    for (int e = 0; e < 8; ++e) { k[e] *= P[14]; kl[e] *= P[14]; }
    l1p = s;
}
__device__ __forceinline__ void hyena_phase(const Frame& F) {
    LAS f32x2* dat = (LAS f32x2*)F.lds; LAS float* redu = (LAS float*)(F.lds + RING_BYTES);
    const bf16* pT = (const bf16*)(F.ws + WS_B); const bf16* HT = (const bf16*)(F.ws + WS_HT); bf16* yT = (bf16*)(F.ws + WS_A);
    const LAS bf16x8* tab = (const LAS bf16x8*)(F.lds + FTAB_OFF);
    for (int i = F.tid; i < FT_NFRAG * 64; i += NTHR) ((LAS u32x4*)(F.lds + FTAB_OFF))[i] = ((const u32x4*)(F.ws + WS_FTAB))[i];
    __syncthreads();
    f32x2* Ke = (f32x2*)(F.ws + WS_FFTS) + (size_t)F.bid * 49152; f32x2* Ko = Ke + 16384; f32x2* SeB = Ke + 32768;
    RawF rf[4];
    { const int tq = fresh_tid(F.wave); if (F.bid < DM) {
#pragma unroll
        for (int sI = 0; sI < 4; ++sI) rf[sI] = load_rawf((const bf16*)(F.ws + WS_HT), F.bid, 8 * (tq + 512 * sI)); } }
    const int cv_gw = F.bid * NWAVES + F.wave, cv_ngw = F.G * NWAVES; int cv_it = cv_gw; constexpr int CV_NIT = 48 * 1024;
    for (int d = F.bid; d < DM; d += F.G) {
        int tid = fresh_tid(F.wave);
        TPS_START(1);
        LAS float* PW = (LAS float*)(F.lds + RING_BYTES + 64); ChanPar P = PW;
        __syncthreads();
        if (tid < 12) { const int i = tid & 3, pj = tid >> 2; PW[tid] = (i < 3) ? AIN(I_HCW)[i * 3 * DM + pj * DM + d] : AIN(I_HCB)[pj * DM + d]; }
        if (tid == 12) PW[12] = AIN(I_FBIAS)[d];
        if (tid == 13) { const float mind = -4.605170185988091f / 1.5f, maxd = -4.605170185988091f / 0.3f; const float delta = fabsf(mind + (maxd - mind) * ((float)d / (float)(DM - 1)));
            PW[13] = delta * (1.f / (float)(L - 1)) * 1.4426950408889634f; PW[14] = 1.f; }
        __syncthreads();
        TPS_STOP(1); TPS_START(2);
#pragma unroll 1
        for (int odd = 0; odd < 2; ++odd) {
            asm volatile("" : "+v"(tid));
            float l1s = 0.f;
#pragma unroll
            for (int sI = 0; sI < 4; ++sI) { const int t0 = 8 * (tid + 512 * sI); float k[8], kl[8], l1p; filt8(rf[sI], t0, P, k, kl, l1p); l1s += l1p;
#pragma unroll
                for (int e = 0; e < 8; ++e) { f32x2 o; if (!odd) { o.x = k[e] + kl[e]; o.y = 0.f; } else { const float a = k[e] - kl[e]; float wr, wi; unit_root((float)(t0 + e) * (1.f / 32768.f), false, wr, wi); o.x = a * wr; o.y = a * wi; }
                    dat[phys(t0 + e)] = o; } }
            if (!odd) { l1s = wave_sum(l1s); if (F.lane == 0) redu[F.wave] = l1s; }
            __syncthreads();
            if (!odd && tid == 0) { float tot = 0.f;
#pragma unroll
                for (int w = 0; w < NWAVES; ++w) tot += redu[w];
                PW[15] = 1.f / tot; }
            pass1<false>(dat, tab, F.lane, F.wave); __syncthreads(); pass2<false>(dat, tab, F.lane, F.wave); { f32x2 kdummy[16]; pass3<true>(dat, tab, F.lane, F.wave, 0, odd ? Ko : Ke, kdummy); asm volatile("" ::: "memory"); pass3<true>(dat, tab, F.lane, F.wave, 1, odd ? Ko : Ke, kdummy); } __syncthreads();
        }
        TPS_STOP(2); TPS_START(3);
        unsigned zp[4][8];
        const bool cvb3 = (cv_it + 2 * cv_ngw < CV_NIT);
        const ConvItem ia = moe_l1_item(F, cvb3 ? cv_it : 0), ib = moe_l1_item(F, cvb3 ? cv_it + cv_ngw : 0), ic = moe_l1_item(F, cvb3 ? cv_it + 2 * cv_ngw : 0);
#pragma unroll
        for (int odd = 0; odd < 2; ++odd) {
            asm volatile("" : "+v"(tid));
            TPS_START(6);
            if (!odd) {
                RawZ rz[4];
#pragma unroll
                for (int sI = 0; sI < 4; ++sI) rz[sI] = load_rawz(pT, d, 8 * (tid + 512 * sI));
#pragma unroll
                for (int sI = 0; sI < 4; ++sI) { const int t0 = 8 * (tid + 512 * sI); float z0[8], z1[8]; z_from_raw(rz[sI], P, z0, z1);
#pragma unroll
                    for (int e = 0; e < 8; ++e) { f32x2 o; o.x = z0[e]; o.y = z1[e]; zp[sI][e] = cvt_pk_bf16(z0[e], z1[e]); dat[phys(t0 + e)] = o; } }
            } else {
#pragma unroll
                for (int sI = 0; sI < 4; ++sI) { const int t0 = 8 * (tid + 512 * sI);
#pragma unroll
                    for (int e = 0; e < 8; ++e) { const float z0 = bflo(zp[sI][e]), z1 = bfhi(zp[sI][e]); float wr, wi; unit_root((float)(t0 + e) * (1.f / 32768.f), false, wr, wi);
                        f32x2 o; o.x = z0 * wr - z1 * wi; o.y = z0 * wi + z1 * wr; dat[phys(t0 + e)] = o; } }
            }
#ifdef FFT_EXTRA
#pragma unroll 1
            for (int xr = 0; xr < FFT_EXTRA; ++xr) { __syncthreads(); pass2<false>(dat, tab, F.lane, F.wave); __syncthreads(); pass2<true>(dat, tab, F.lane, F.wave); __syncthreads();
#pragma unroll 1
                for (int i = fresh_tid(F.wave); i < L; i += NTHR) { f32x2 v = dat[i]; v.x *= (1.f / 32.f); v.y *= (1.f / 32.f); dat[i] = v; } }
            tid = fresh_tid(F.wave);
#endif
            TPS_STOP(6); TPS_START(5);
            f32x2 kpre0[16], kpre1[16];
            asm volatile("" ::: "memory");
            { const f32x2* Kb = odd ? Ko : Ke; int ln_ = F.lane; asm volatile("" : "+v"(ln_)); const int lq = ln_ & 31, lh = ln_ >> 5; const float il1 = P[15], fb = P[12];
#pragma unroll
              for (int r = 0; r < 16; ++r) { f32x2 k0 = Kb[((r & 3) + 8 * (r >> 2) + 4 * lh) * 512 + 64 * F.wave + lq], k1 = Kb[((r & 3) + 8 * (r >> 2) + 4 * lh) * 512 + 64 * F.wave + 32 + lq];
                  k0.x = k0.x * il1 + fb; k0.y *= il1; k1.x = k1.x * il1 + fb; k1.y *= il1; kpre0[r] = k0; kpre1[r] = k1; } }
            __syncthreads(); pass1<false>(dat, tab, F.lane, F.wave); __syncthreads(); pass2<false>(dat, tab, F.lane, F.wave); pass3<false>(dat, tab, F.lane, F.wave, 0, nullptr, kpre0); asm volatile("" ::: "memory"); pass3<false>(dat, tab, F.lane, F.wave, 1, nullptr, kpre1);
            TPS_STOP(5); TPS_START(7);
            if (odd) { float ca[32], cb[32], cc[32]; const int cvln = fresh_tid(F.wave) & 63;
                conv_issue(ia, cvln, ca); conv_issue(ib, cvln, cb); conv_issue(ic, cvln, cc);
                pass2<true>(dat, tab, F.lane, F.wave); __syncthreads(); pass1<true>(dat, tab, F.lane, F.wave);
                if (cvb3) { conv_finish(ia, cvln, ca); conv_finish(ib, cvln, cb); conv_finish(ic, cvln, cc); cv_it += 3 * cv_ngw; }
                __syncthreads();
            } else { pass2<true>(dat, tab, F.lane, F.wave); __syncthreads(); pass1<true>(dat, tab, F.lane, F.wave); __syncthreads(); }
            TPS_STOP(7);
            if (!odd) {
                asm volatile("" : "+v"(tid));
#pragma unroll 1
                for (int sI = 0; sI < 4; ++sI)
#pragma unroll
                    for (int e = 0; e < 8; ++e) { const f32x2 v = dat[phys(8 * (tid + 512 * sI) + e)]; SeB[e * 2048 + tid + 512 * sI] = v; }
                __syncthreads();
            }
        }
        TPS_STOP(3); TPS_START(4);
        asm volatile("" : "+v"(tid));
        if (d + F.G < DM) {
#pragma unroll
            for (int sI = 0; sI < 4; ++sI) rf[sI] = load_rawf(HT, d + F.G, 8 * (tid + 512 * sI)); }
        { Raw8 rx0[4][2]; f32x2 se[4][8];
#pragma unroll
          for (int sI = 0; sI < 4; ++sI) {
#pragma unroll
              for (int bt = 0; bt < 2; ++bt) rx0[sI][bt] = load_raw8(pT + (size_t)d * MTOK + bt * L, 8 * (tid + 512 * sI));
#pragma unroll
              for (int e = 0; e < 8; ++e) se[sI][e] = SeB[e * 2048 + tid + 512 * sI]; }
#pragma unroll
          for (int sI = 0; sI < 4; ++sI) { const int t0 = 8 * (tid + 512 * sI);
              float o0[8], o1[8];
#pragma unroll
              for (int e = 0; e < 8; ++e) { const f32x2 so = dat[phys(t0 + e)]; float wr, wi; unit_root((float)(t0 + e) * (1.f / 32768.f), true, wr, wi);
                  o0[e] = (se[sI][e].x + so.x * wr - so.y * wi) * (1.f / 32768.f); o1[e] = (se[sI][e].y + so.x * wi + so.y * wr) * (1.f / 32768.f); }
#pragma unroll
              for (int bt = 0; bt < 2; ++bt) { float xc[8]; conv8(rx0[sI][bt], P[0], P[1], P[2], P[3], xc);
                  u32x4 w;
                  if (bt == 0) { w.x = cvt_pk_bf16(xc[0] * o0[0], xc[1] * o0[1]); w.y = cvt_pk_bf16(xc[2] * o0[2], xc[3] * o0[3]); w.z = cvt_pk_bf16(xc[4] * o0[4], xc[5] * o0[5]); w.w = cvt_pk_bf16(xc[6] * o0[6], xc[7] * o0[7]); }
                  else { w.x = cvt_pk_bf16(xc[0] * o1[0], xc[1] * o1[1]); w.y = cvt_pk_bf16(xc[2] * o1[2], xc[3] * o1[3]); w.z = cvt_pk_bf16(xc[4] * o1[4], xc[5] * o1[5]); w.w = cvt_pk_bf16(xc[6] * o1[6], xc[7] * o1[7]); }
                  *(u32x4*)(yT + (size_t)d * MTOK + bt * L + t0) = w; } } }
        __syncthreads();
        TPS_STOP(4);
        if (cvb3) {
        } else {
#pragma unroll 1
            for (int q = 0; q < 3; ++q) { if (cv_it < CV_NIT) { float cva[32]; const ConvItem cvc = moe_l1_item(F, cv_it); conv_issue(cvc, fresh_tid(F.wave) & 63, cva); conv_finish(cvc, fresh_tid(F.wave) & 63, cva); cv_it += cv_ngw; } }
        }
    }
    while (cv_it < CV_NIT) { float cvb[32]; const ConvItem c = moe_l1_item(F, cv_it); conv_issue(c, F.lane, cvb); conv_finish(c, F.lane, cvb); cv_it += cv_ngw; }
}
__device__ __forceinline__ void transpose_phase(const Frame& F) {
    const bf16* yT = (const bf16*)(F.ws + WS_A); bf16* y = (bf16*)(F.ws + WS_B);
    LAS bf16* tl = (LAS bf16*)(F.lds + F.wave * 16384);
    const int gw = F.bid * NWAVES + F.wave, NGW = F.G * NWAVES, lane = F.lane;
    for (int tile = gw; tile < 32 * 512; tile += NGW) { const int d0 = (tile & 31) * 64, t0 = (tile >> 5) * 64;
#pragma unroll
        for (int i = 0; i < 8; ++i) { const int r = i * 8 + (lane >> 3), ch = lane & 7; const u32x4 v = *(const u32x4*)(yT + (size_t)(d0 + r) * MTOK + t0 + ch * 8); *(LAS u32x4*)(tl + r * 72 + ch * 8) = v; }
        LDS_WAIT();
#pragma unroll
        for (int i = 0; i < 8; ++i) { const int tr = i * 8 + (lane >> 3), ch = lane & 7; unsigned short e[8];
#pragma unroll
            for (int k = 0; k < 8; ++k) e[k] = tl[(ch * 8 + k) * 72 + tr];
            u32x4 w; w.x = e[0] | ((unsigned)e[1] << 16); w.y = e[2] | ((unsigned)e[3] << 16); w.z = e[4] | ((unsigned)e[5] << 16); w.w = e[6] | ((unsigned)e[7] << 16);
            *(u32x4*)(y + (size_t)(t0 + tr) * DM + d0 + ch * 8) = w; }
        LDS_WAIT();
    }
}
}
__device__ __forceinline__ float hy_ftab_value(int f, int l, int jj) { return hy::ftab_value(f, l, jj); }
constexpr int NPHASE = 19;

__device__ __forceinline__ void moe_table(const Frame& F, int layer, LAS int* tab) {
    if (F.tid < NCLS) tab[32 + F.tid] = (int)__hip_atomic_load((unsigned*)(F.ctl + CW_CNT + (layer * NCLS + F.tid) * 64), RLX_AGENT);
    __syncthreads();
    if (F.tid == 0) { int a = 0; for (int c = 0; c < NCLS; ++c) { tab[c] = a; a += (tab[32 + c] + 255) >> 8; } tab[24] = a; }
    __syncthreads();
}

#ifndef PROBE_MASK
#define PROBE_MASK 0u
#endif
#ifndef TPM
#define TPM 0u
#endif
#define TP_MULT 4
#define IN(k) ((ONLY < 0 || (k) == ONLY) && lo <= (k) && (k) < hi)
#define SEAM(k) do { if ((k) + 1 < hi) { XcdBarrier b_ = bar; asm volatile("" : "+s"(b_.bar), "+s"(b_.x)); xcd_barrier(b_); } if (TPM != 0u && ONLY < 0 && ((TPM >> (k)) & 1u) && F.bid == 0 && F.tid == 0) TPW[0] += __builtin_amdgcn_s_memrealtime() - TPW[1]; if (PROBE_MASK != 0u && ONLY < 0) { if (F.tid == 0) { LAS unsigned long long* tp_ = (LAS unsigned long long*)(F.lds + MISC_OFF + 64); const unsigned long long t1_ = __builtin_amdgcn_s_memrealtime(); if ((PROBE_MASK >> (k)) & 1u) tp_[0] += t1_ - tp_[1]; tp_[1] = t1_; } } } while (0)
#define TPW ((LAS unsigned long long*)(F.lds + MISC_OFF + 96))
#define ENTER() do { int l_; asm volatile("v_mbcnt_lo_u32_b32 %0, -1, 0\n\tv_mbcnt_hi_u32_b32 %0, -1, %0" : "=&v"(l_)); const int t_ = F.wave * 64 + l_; F.tid = t_; F.lane = l_; int b_ = blockIdx.x, g_ = gridDim.x; asm volatile("" : "+s"(b_), "+s"(g_)); F.bid = b_; F.G = g_; if (TPM != 0u && ONLY < 0 && b_ == 0 && t_ == 0) TPW[1] = __builtin_amdgcn_s_memrealtime(); } while (0)
template <int ONLY> __device__ __forceinline__ void layer_phases(Frame& F, const XcdBarrier& bar, const int lo, const int hi, const int layer, LAS int* tab) {
        const int pb = 3 + 8 * layer;
        if (layer == 0) {
            if (IN(pb + 0)) { ENTER();
                pg::PlainSched S; S.init(F.ws + WS_A, F.ws + WS_WQKV, MTOK, QKVD, DM, DM, F.G, F.bid);
                pg::EpiQKV E{(bf16*)(F.ws + WS_B), (bf16*)(F.ws + WS_B + 128 * MiB), (bf16*)(F.ws + WS_B + 144 * MiB), AIN(I_ABIN), (const float*)(F.ws + WS_ROPE), (const float*)(F.ws + WS_ROPE) + 4096};
                pg::gemm_phase<pg::EpiQKV, pg::PlainSched, false, false, true>(F.lds, F.tid, DM, DM, DM, S, E);
                SEAM(pb + 0);
            }
            if (IN(pb + 1)) { ENTER(); att::attn_phase(F); SEAM(pb + 1); }
        } else {
            if (IN(pb + 0)) { ENTER();
                pg::PlainSched S; S.init(F.ws + WS_WHYIN, F.ws + WS_A, 3 * DM, MTOK, DM, DM, F.G, F.bid);
                pg::EpiBf16<true> E{(bf16*)(F.ws + WS_B), MTOK, AIN(I_HBIN)};
                pg::gemm_phase<pg::EpiBf16<true>, pg::PlainSched, false, false, true>(F.lds, F.tid, DM, DM, DM, S, E);
                SEAM(pb + 0);
            }
            if (IN(pb + 1)) { ENTER(); hy::hyena_phase(F); SEAM(pb + 1); }
            if (IN(pb + 2)) { ENTER(); hy::transpose_phase(F); SEAM(pb + 2); }
        }
        if (IN(pb + 3)) { ENTER();
            const void* A = layer ? (const void*)(F.ws + WS_B) : (const void*)(F.ws + WS_A);
            const void* Bt = layer ? (const void*)(F.ws + WS_WHYO) : (const void*)(F.ws + WS_WO0);
            bf16* O = (bf16*)(F.ws + WS_B + (layer ? 128 : 192) * MiB);
            pg::PlainSched S; S.init(A, Bt, MTOK, DM, DM, DM, F.G, F.bid);
            pg::EpiBf16<false> E{O, DM, layer ? AIN(I_HBOUT) : nullptr};
            pg::gemm_phase<pg::EpiBf16<false>, pg::PlainSched, false, false, true>(F.lds, F.tid, DM, DM, DM, S, E);
            SEAM(pb + 3);
        }
        if (IN(pb + 4)) { ENTER();
            if (layer == 0) ln1_router_phase<true>(F, 0, AIN(I_X), (const bf16*)(F.ws + WS_B + 192 * MiB), (bf16*)(F.ws + WS_A), (bf16*)(F.ws + WS_B + 192 * MiB));
            else ln1_router_phase<false>(F, 1, F.out, (const bf16*)(F.ws + WS_B + 128 * MiB), (bf16*)(F.ws + WS_A), (bf16*)(F.ws + WS_B + 256 * MiB));
            SEAM(pb + 4);
        }
        if (IN(pb + 5)) { ENTER();
            moe_table(F, layer, tab);
            pg::MoeSched S{tab, (const char*)(F.ws + WS_A), (const char*)(F.ws + WS_W13 + (size_t)layer * 128 * MiB), (const int*)(F.ws + WS_TOK), F.G, F.bid, 16, 0};
            pg::EpiMoe1 E{(bf16*)(F.ws + WS_B), (const float*)(F.ws + WS_GATE)};
            pg::gemm_phase<pg::EpiMoe1, pg::MoeSched, true, false, true>(F.lds, F.tid, DM, DM, DM, S, E);
            SEAM(pb + 5);
        }
        if (IN(pb + 6)) { ENTER();
            moe_table(F, layer, tab);
            pg::MoeSched S{tab, (const char*)(F.ws + WS_B), (const char*)(F.ws + WS_W2 + (size_t)layer * 64 * MiB), (const int*)(F.ws + WS_TOK), F.G, F.bid, 8, 1};
            pg::EpiMoe2 E{(bf16*)(F.ws + WS_A), (const int*)(F.ws + WS_TOK)};
            pg::gemm_phase<pg::EpiMoe2, pg::MoeSched, false, true, true>(F.lds, F.tid, DM, DM, EFF, S, E);
            SEAM(pb + 6);
        }
        if (IN(pb + 7)) { ENTER();
            if (layer == 0) ln2_phase<false>(F, 0, (bf16*)(F.ws + WS_A), (const bf16*)(F.ws + WS_B + 192 * MiB), F.out);
            else ln2_phase<true>(F, 1, (bf16*)(F.ws + WS_A), (const bf16*)(F.ws + WS_B + 256 * MiB), F.out);
            SEAM(pb + 7); }
}
template <int ONLY> __global__ void __launch_bounds__(NTHR, 2) fwd_kernel(Args args) {
    extern __shared__ __attribute__((aligned(16))) unsigned char lds_raw[];
    Frame F;
    F.lds = (LAS unsigned char*)lds_raw;
    F.tid = threadIdx.x; F.lane = F.tid & 63; F.wave = __builtin_amdgcn_readfirstlane(F.tid >> 6);
    F.G = gridDim.x; F.bid = blockIdx.x; F.ws = args.ws; F.ctl = (gu32*)(args.ws + WS_CTL); F.out = args.out;
    F.a = &args;
    for (int u = F.tid; u < (LDS_BYTES - RING_BYTES) / 4; u += NTHR) ((LAS unsigned*)(F.lds + RING_BYTES))[u] = 0u;
    __syncthreads();
    const int lo = args.ph_lo, hi = args.ph_hi;
    if (PROBE_MASK != 0u && ONLY >= 0) { if (F.bid == 0 && F.tid == 0) ((unsigned long long*)(F.ws + 512 * 1024))[ONLY] = __builtin_amdgcn_s_memrealtime(); }
    if (PROBE_MASK != 0u && ONLY < 0) { if (F.tid == 0) { LAS unsigned long long* tp_ = (LAS unsigned long long*)(F.lds + MISC_OFF + 64); tp_[0] = 0; tp_[1] = __builtin_amdgcn_s_memrealtime(); } }
    XcdBarrier bar; bar.bar = (unsigned*)(F.ctl + CW_BAR); bar.x = 0; bar.st = nullptr;
    if (ONLY < 0 && hi - lo > 1) bar = xcd_barrier_post((unsigned*)(F.ctl + CW_BAR), (volatile LAS unsigned*)(F.lds + MISC_OFF));
    LAS int* tab = (LAS int*)(F.lds + RING_BYTES + 64);

    if (IN(0)) { ENTER(); p0_prologue(F); SEAM(0); }
    if (IN(1)) { ENTER(); p1_prologue(F); if (TPM != 0u && ONLY < 0 && ((TPM >> 1) & 1u) && F.bid == 0 && F.tid == 0) TPW[0] += __builtin_amdgcn_s_memrealtime() - TPW[1]; }
    if (IN(2)) { ENTER();
        pg::PlainSched S; S.init(F.ws + WS_W4T, F.ws + WS_HDN, 4096, SEQ, 128, 128, F.G, F.bid);
        pg::EpiBf16<true> E{(bf16*)(F.ws + WS_HT), SEQ, nullptr};
        int kf = 128; asm volatile("" : "+s"(kf));
        pg::gemm_phase<pg::EpiBf16<true>, pg::PlainSched, false, false, true>(F.lds, F.tid, kf, 128, 128, S, E);
        SEAM(2);
    }
    if constexpr (ONLY >= 0) { if (ONLY >= 3 && ONLY < 11) layer_phases<ONLY>(F, bar, lo, hi, 0, tab); if (ONLY >= 11) layer_phases<ONLY>(F, bar, lo, hi, 1, tab); }
    else {
#pragma unroll 1
        for (int layer = 0; layer < 2; ++layer) layer_phases<ONLY>(F, bar, lo, hi, layer, tab);
    }
    if (PROBE_MASK != 0u && ONLY == NPHASE - 1) { __syncthreads(); if (F.bid == 0 && F.tid == 0) { const unsigned long long* ts = (const unsigned long long*)(F.ws + 512 * 1024); unsigned long long acc = 0, tend = __builtin_amdgcn_s_memrealtime();
        for (int k = 0; k < NPHASE; ++k) if (((PROBE_MASK >> k) & 1u) && k != 5) { int kn = k + 1; if (kn == 5) kn = 6; acc += ((kn < NPHASE) ? ts[kn] : tend) - ts[k]; }
        F.out[0] = 0.1f * (float)acc; } }
    if ((TPM != 0u || TPSEL >= 0) && ONLY < 0) { if (blockIdx.x == 0 && threadIdx.x == 0) { const unsigned long long acc = TPW[0] * TP_MULT, t0 = __builtin_amdgcn_s_memrealtime(); while (__builtin_amdgcn_s_memrealtime() - t0 < acc) __builtin_amdgcn_s_sleep(8); } }
    if (PROBE_MASK != 0u && ONLY < 0) { __syncthreads(); if (F.bid == 0 && F.tid == 0) F.out[0] = 0.1f * (float)((LAS unsigned long long*)(F.lds + MISC_OFF + 64))[0]; }
}
#undef IN
#undef SEAM

extern "C" void kernel_launch(void* const* d_in, const int* in_sizes, int n_in, void* d_out, int out_size, void* d_ws, size_t ws_size, hipStream_t stream) {
    static int grid = 0;
    if (grid == 0) {
        if (n_in != 34 || in_sizes[0] != MTOK * DM || out_size != MTOK * DM || ws_size < WS_END) { fprintf(stderr, "kernel_launch: unexpected shapes / workspace (n_in %d, ws %zu, need %zu)\n", n_in, ws_size, (size_t)WS_END); grid = -1; return; }
        int dev = 0, cus = 0;
        if (hipGetDevice(&dev) != hipSuccess || hipDeviceGetAttribute(&cus, hipDeviceAttributeMultiprocessorCount, dev) != hipSuccess) { grid = -1; return; }
#if !MK_SPLIT
        if (hipFuncSetAttribute((const void*)fwd_kernel<-1>, hipFuncAttributeMaxDynamicSharedMemorySize, LDS_BYTES) != hipSuccess) { fprintf(stderr, "kernel_launch: hipFuncSetAttribute failed\n"); grid = -1; return; }
        int per_cu = 0;
        if (hipOccupancyMaxActiveBlocksPerMultiprocessor(&per_cu, (const void*)fwd_kernel<-1>, NTHR, LDS_BYTES) != hipSuccess || per_cu < 1) fprintf(stderr, "kernel_launch: occupancy query reports %d blocks per CU\n", per_cu);
        (void)hipGetLastError();
#endif
        grid = cus;
    }
    if (grid < 0) return;
    (void)hipMemsetAsync((char*)d_ws + WS_CTL, 0, CTL_ZERO_BYTES, stream);
    Args a{};
    for (int i = 0; i < 34; ++i) a.in[i] = (const float*)d_in[i];
    a.out = (float*)d_out; a.ws = (unsigned char*)d_ws;
#if MK_SPLIT
    typedef void (*kfn)(Args);
    static const kfn fns[NPHASE] = {fwd_kernel<0>, fwd_kernel<1>, fwd_kernel<2>, fwd_kernel<3>, fwd_kernel<4>, nullptr, fwd_kernel<6>, fwd_kernel<7>, fwd_kernel<8>, fwd_kernel<9>, fwd_kernel<10>,
                                      fwd_kernel<11>, fwd_kernel<12>, fwd_kernel<13>, fwd_kernel<14>, fwd_kernel<15>, fwd_kernel<16>, fwd_kernel<17>, fwd_kernel<18>};
    static bool attr_done = false;
    if (!attr_done) { for (int ph = 0; ph < NPHASE; ++ph) if (fns[ph]) (void)hipFuncSetAttribute((const void*)fns[ph], hipFuncAttributeMaxDynamicSharedMemorySize, LDS_BYTES); attr_done = true; }
#ifndef REPEAT_MASK
#define REPEAT_MASK 0u
#endif
    for (int ph = 0; ph < NPHASE; ++ph) { if (!fns[ph]) continue; a.ph_lo = ph; a.ph_hi = ph + 1;
        for (int rep = 0; rep < (((REPEAT_MASK >> ph) & 1u) ? 2 : 1); ++rep) {
            if (rep == 1 && ph == 15) (void)hipMemsetAsync((char*)d_ws + WS_CTL + (size_t)(CW_CNT + NCLS * 64) * 4, 0, NCLS * 64 * 4, stream);
            hipLaunchKernelGGL(fns[ph], dim3(grid), dim3(NTHR), LDS_BYTES, stream, a); } }
#else
    a.ph_lo = 0; a.ph_hi = NPHASE; hipLaunchKernelGGL(fwd_kernel<-1>, dim3(grid), dim3(NTHR), LDS_BYTES, stream, a);
#endif
}
```

```cpp
#include <hip/hip_runtime.h>
#include <hip/hip_bf16.h>
#include <cstdio>
#include <cstdint>

#ifndef MK_SPLIT
#define MK_SPLIT 0
#endif

#define GAS __attribute__((address_space(1)))
#define LAS __attribute__((address_space(3)))
typedef unsigned short bf16;
typedef unsigned u32x4 __attribute__((ext_vector_type(4)));
typedef unsigned u32x2 __attribute__((ext_vector_type(2)));
typedef float f32x2 __attribute__((ext_vector_type(2)));
typedef float f32x4 __attribute__((ext_vector_type(4)));
typedef float f32x16 __attribute__((ext_vector_type(16)));
typedef short bf16x8 __attribute__((ext_vector_type(8)));
typedef short s16x4 __attribute__((ext_vector_type(4)));
typedef GAS unsigned gu32;

constexpr int DM = 2048, NB = 2, SEQ = 16384, MTOK = NB * SEQ, CTXL = 256, GRIDW = 64;
constexpr int NHEAD = 32, NKV = 4, HD = 64, QKVD = 2560, KVD = 256;
constexpr int NEXP = 16, EFF = 1024, NCLS = 24, LCAP = 32768;
constexpr int HYW = 64, HYEMB = 33;
constexpr float LN_EPS = 1e-5f;
constexpr float DN_ALPHA = 1.41421356237309515f;
constexpr float QSCALE = 0.125f * 1.4426950408889634f;
constexpr int NWAVES = 8, NTHR = 512;

constexpr size_t MiB = 1u << 20;
constexpr size_t WS_CTL = 0, CTL_ZERO_BYTES = 1 * MiB;
constexpr size_t WS_MOD = 1 * MiB;
constexpr size_t WS_ROPE = 1 * MiB + 512 * 1024;
constexpr size_t WS_FTAB = 1 * MiB + 768 * 1024;
constexpr size_t WS_CTXKV = 2 * MiB;
constexpr size_t WS_HDN = 3 * MiB;
constexpr size_t WS_W4T = 7 * MiB;
constexpr size_t WS_TOK = 8 * MiB;
constexpr size_t WS_GATE = 11 * MiB;
constexpr size_t WS_FFTS = 32 * MiB;
constexpr size_t WS_HT = 128 * MiB;
constexpr size_t WS_WQKV = 256 * MiB;
constexpr size_t WS_WO0 = 266 * MiB;
constexpr size_t WS_WHYIN = 274 * MiB;
constexpr size_t WS_WHYO = 298 * MiB;
constexpr size_t WS_W13 = 320 * MiB;
constexpr size_t WS_W2 = 576 * MiB;
constexpr size_t WS_A = 704 * MiB;
constexpr size_t WS_B = 832 * MiB;
constexpr size_t WS_END = 1216 * MiB;
constexpr int HID_ROWS = 38912;

constexpr int CW_TMO = 0;
constexpr int CW_BAR = 4096;
constexpr int CW_CNT = 16384;

constexpr int RING_BYTES = 131072;
constexpr int MISC_OFF = RING_BYTES + 320;
constexpr int FTAB_OFF = RING_BYTES + 1024;
constexpr int LDS_BYTES = 163840;
constexpr int SIDE_OFF = FTAB_OFF + 28672;

#define RLX_AGENT __ATOMIC_RELAXED, __HIP_MEMORY_SCOPE_AGENT
#define LDS_WAIT() asm volatile("s_waitcnt lgkmcnt(0)" ::: "memory")
#define VM_WAIT() asm volatile("s_waitcnt vmcnt(0)" ::: "memory")

__device__ __forceinline__ unsigned cvt_pk_bf16(float lo, float hi) { unsigned r; asm volatile("v_cvt_pk_bf16_f32 %0, %1, %2" : "=v"(r) : "v"(lo), "v"(hi)); return r; }
__device__ __forceinline__ float bf2f(unsigned h) { return __builtin_bit_cast(float, h << 16); }
__device__ __forceinline__ float bflo(unsigned w) { return __builtin_bit_cast(float, w << 16); }
__device__ __forceinline__ float bfhi(unsigned w) { return __builtin_bit_cast(float, w & 0xffff0000u); }
__device__ __forceinline__ float wave_sum(float v) {
    v += __builtin_bit_cast(float, __builtin_amdgcn_update_dpp(0, __builtin_bit_cast(int, v), 0xB1, 0xf, 0xf, true));
    v += __builtin_bit_cast(float, __builtin_amdgcn_update_dpp(0, __builtin_bit_cast(int, v), 0x4E, 0xf, 0xf, true));
    v += __builtin_bit_cast(float, __builtin_amdgcn_update_dpp(0, __builtin_bit_cast(int, v), 0x141, 0xf, 0xf, true));
    v += __builtin_bit_cast(float, __builtin_amdgcn_update_dpp(0, __builtin_bit_cast(int, v), 0x140, 0xf, 0xf, true));
    { auto r = __builtin_amdgcn_permlane16_swap(__float_as_uint(v), __float_as_uint(v), false, false); v = __uint_as_float(r[0]) + __uint_as_float(r[1]); }
    { auto r = __builtin_amdgcn_permlane32_swap(__float_as_uint(v), __float_as_uint(v), false, false); v = __uint_as_float(r[0]) + __uint_as_float(r[1]); }
    return v;
}

#define XB_TMO      128
#define XB_XCNT(j)  (256  + 64 * (j))
#define XB_XSUB(j)  (1280 + 64 * (j))
#define XB_XGEN(j)  (2304 + 64 * (j))
#define XB_TOP      3328
#define XB_TOPGEN   3392
#define XCD_BAR_WORDS 3456
#define XB_SPIN_CAP (1u << 18)

__device__ __forceinline__ unsigned xb_ld(unsigned* p)              { return __hip_atomic_load(p, __ATOMIC_RELAXED, __HIP_MEMORY_SCOPE_AGENT); }
__device__ __forceinline__ unsigned xb_add(unsigned* p, unsigned v) { return __hip_atomic_fetch_add(p, v, __ATOMIC_RELAXED, __HIP_MEMORY_SCOPE_AGENT); }
__device__ __forceinline__ unsigned xb_xcc_id() { return (unsigned)__builtin_amdgcn_s_getreg((3 << 11) | 20) & 0xFu; }
#define XB_SPIN(cond, bar) do { unsigned _sp = 0; while (cond) { __builtin_amdgcn_s_sleep(1); \
    if ((++_sp & 255u) == 0u) { if (xb_ld(&(bar)[XB_TMO])) break; if (_sp > XB_SPIN_CAP) { atomicAdd(&(bar)[XB_TMO], 1u); break; } } } } while (0)

struct XcdBarrier { unsigned* bar; unsigned x; volatile LAS unsigned* st; };

__device__ __forceinline__ XcdBarrier xcd_barrier_post(unsigned* bar, volatile LAS unsigned* st) {
    XcdBarrier b; b.bar = bar; b.x = xb_xcc_id(); b.st = st;
    if (threadIdx.x == 0) (void)xb_add(&bar[XB_XCNT(b.x)], 1u);
    return b;
}
__device__ __forceinline__ void xcd_barrier_complete(unsigned* bar, unsigned x, unsigned& nloc, unsigned& nx) {
    const unsigned G = gridDim.x * gridDim.y * gridDim.z;
    unsigned sum, cnt, mine, sp = 0u;
    for (;;) {
        sum = 0u; cnt = 0u; mine = 0u;
#pragma unroll
        for (unsigned j = 0; j < 16; ++j) { const unsigned c = xb_ld(&bar[XB_XCNT(j)]); sum += c; cnt += (c > 0u) ? 1u : 0u; mine = (j == x) ? c : mine; }
        if (sum == G) break;
        __builtin_amdgcn_s_sleep(1);
        if ((++sp & 255u) == 0u) { if (xb_ld(&bar[XB_TMO])) break; if (sp > XB_SPIN_CAP) { atomicAdd(&bar[XB_TMO], 1u); break; } }
    }
    nloc = mine > 0u ? mine : 1u; nx = cnt > 0u ? cnt : 1u;
}
__device__ __forceinline__ void xcd_barrier(const XcdBarrier& b) {
    asm volatile("s_waitcnt vmcnt(0)" ::: "memory");
    __syncthreads();
    if (threadIdx.x == 0) {
        unsigned* bar = b.bar;
        __builtin_amdgcn_s_waitcnt(0);
        unsigned nloc = b.st[0], nx = b.st[1];
        if (nloc == 0u) { xcd_barrier_complete(bar, b.x, nloc, nx); b.st[0] = nloc; b.st[1] = nx; }
        const unsigned old = xb_add(&bar[XB_XSUB(b.x)], 1u);
        const unsigned gen = old / nloc;
        if (old + 1u == (gen + 1u) * nloc) {
            __builtin_amdgcn_fence(__ATOMIC_RELEASE, "agent");
            asm volatile("s_waitcnt vmcnt(0)" ::: "memory");
            const unsigned og = xb_add(&bar[XB_TOP], 1u);
            const unsigned tg = og / nx;
            if (og + 1u == (tg + 1u) * nx) xb_add(&bar[XB_TOPGEN], 1u);
            else XB_SPIN(xb_ld(&bar[XB_TOPGEN]) == tg, bar);
            __builtin_amdgcn_fence(__ATOMIC_ACQUIRE, "agent");
            xb_add(&bar[XB_XGEN(b.x)], 1u);
            asm volatile("s_waitcnt vmcnt(0)" ::: "memory");
        } else {
            XB_SPIN(xb_ld(&bar[XB_XGEN(b.x)]) == gen, bar);
            __builtin_amdgcn_fence(__ATOMIC_ACQUIRE, "agent");
            asm volatile("s_waitcnt vmcnt(0)" ::: "memory");
        }
    }
    __syncthreads();
}

namespace pg {
constexpr int BM = 256, BK = 64, HALF = 128, HTB = HALF * BK * 2, NXCD = 8, WGM = 8;
__host__ __device__ __forceinline__ int lds_byte(int r, int c) { const int st = (r >> 4) * 2 + (c >> 5), rr = r & 15, cc = c & 31, ob = rr * 64 + cc * 2; return st * 1024 + (ob ^ (((ob >> 9) & 1) << 5)); }
__host__ __device__ __forceinline__ void stage_rc(int b, int& R, int& C) { const int st = b / 1024, sb = b % 1024, swz = sb ^ (((sb >> 9) & 1) << 5); R = (st >> 1) * 16 + swz / 64; C = (st & 1) * 32 + (swz % 64) / 2; }
__host__ __device__ __forceinline__ int perm32(int rho) { const int n = rho >> 4, i = rho & 15; return 8 * (i >> 2) + 4 * n + (i & 3); }

struct Unit { int pm, pn; const char* A; const char* B; const char* B2; int cls, row0, nrows, lbase; };

__device__ __forceinline__ bool static_map(int i, int G, int c, int nM, int nN, int& pm, int& pn) {
    const int nwg = nM * nN; const long L = (long)i * G + c; if (L >= nwg) return false;
    int wgid = (int)L; { const int q = nwg / NXCD, r = nwg % NXCD, xcd = wgid % NXCD, off = wgid / NXCD; wgid = (xcd < r ? xcd * (q + 1) : r * (q + 1) + (xcd - r) * q) + off; }
    const int nig = WGM * nN, gid = wgid / nig, fm = gid * WGM, gsz = (nM - fm) < WGM ? (nM - fm) : WGM;
    pm = fm + ((wgid % nig) % gsz); pn = (wgid % nig) / gsz; return true;
}
struct PlainSched {
    const char* A; const char* Bt; int nM, nN, G, c; size_t tA, tB;
    __device__ __forceinline__ void init(const void* A_, const void* Bt_, int M, int N, int ldA, int ldB, int G_, int c_) { A = (const char*)A_; Bt = (const char*)Bt_; nM = M / BM; nN = N / BM; G = G_; c = c_; tA = (size_t)BM * ldA * 2; tB = (size_t)BM * ldB * 2; }
    __device__ __forceinline__ bool next(int i, Unit& u) const {
        if (!static_map(i, G, c, nM, nN, u.pm, u.pn)) return false;
        u.A = A + (size_t)u.pm * tA; u.B = Bt + (size_t)u.pn * tB; u.B2 = u.B; u.cls = 0; u.row0 = 0; u.nrows = 256; u.lbase = 0; return true;
    }
    __device__ __forceinline__ unsigned row_off(const Unit&, int r, int ldA) const { return (unsigned)r * (unsigned)ldA * 2u; }
};

template <class Epi, class Sched, bool GATHER, bool KSPLIT, bool ALIGN_EPI>
__device__ __forceinline__ void gemm_phase(LAS unsigned char* lds, const int tid, const int K, const int ldA, const int ldB, const Sched& S, const Epi& E) {
    const int wid = __builtin_amdgcn_readfirstlane(tid >> 6), lane = tid & 63, wr = wid >> 2, wc = wid & 3, fr = lane & 15, fq = lane >> 4;
    const int nt = K / BK, nth = nt >> 1;
    int RA[2], CA[2];
    unsigned voffB[2], voA[2][2], nvoA[2][2];
#pragma unroll
    for (int i = 0; i < 2; ++i) { int R, C; stage_rc(tid * 16 + i * 8192, R, C); const int Rb = Epi::PERM ? ((R & ~31) + perm32(R & 31)) : R;
        RA[i] = R; CA[i] = C; voffB[i] = (unsigned)(Rb * ldB + C) * 2u;
        voA[0][i] = (unsigned)(R * ldA + C) * 2u; voA[1][i] = (unsigned)((R + HALF) * ldA + C) * 2u; nvoA[0][i] = voA[0][i]; nvoA[1][i] = voA[1][i]; }
    const size_t kstep = (size_t)(BK * 2);
    const size_t hstepB = (size_t)HALF * ldB * 2;
    const unsigned ldsw = (unsigned)wid * 1024u;
    const int aoff = lds_byte(wr * 64 + fr, fq * 8), boff = lds_byte(wc * 32 + fr, fq * 8);
#define PG8_SA(b, h) (((b) * 2 + (h)) * HTB)
#define PG8_SB(b, h) ((4 + (b) * 2 + (h)) * HTB)
#define PG8_STAGEB(bufoff, gbase) do { _Pragma("unroll") for (int _i = 0; _i < 2; ++_i) \
        __builtin_amdgcn_global_load_lds((const unsigned*)((const char*)(gbase) + voffB[_i]), (LAS unsigned*)(lds + (bufoff) + ldsw + _i * 8192), 16, 0, 0); } while (0)
#define PG8_STAGEA(bufoff, gbase, vo, h) do { _Pragma("unroll") for (int _i = 0; _i < 2; ++_i) \
        __builtin_amdgcn_global_load_lds((const unsigned*)((const char*)(gbase) + (vo)[h][_i]), (LAS unsigned*)(lds + (bufoff) + ldsw + _i * 8192), 16, 0, 0); } while (0)
#define PG8_LDA(dst, b, h) do { _Pragma("unroll") for (int m = 0; m < 4; ++m) _Pragma("unroll") for (int k = 0; k < 2; ++k) dst[m][k] = *(const LAS bf16x8*)(lds + PG8_SA(b, h) + aoff + m * 2048 + k * 1024); } while (0)
#define PG8_LDB(dst, b, h) do { _Pragma("unroll") for (int n = 0; n < 2; ++n) _Pragma("unroll") for (int k = 0; k < 2; ++k) dst[n][k] = *(const LAS bf16x8*)(lds + PG8_SB(b, h) + boff + n * 2048 + k * 1024); } while (0)
#define PG8_MMA(ai, bj, At, Bt) do { __builtin_amdgcn_s_setprio(1); _Pragma("unroll") for (int m = 0; m < 4; ++m) _Pragma("unroll") for (int n = 0; n < 2; ++n) _Pragma("unroll") for (int k = 0; k < 2; ++k) \
        acc[ai][bj][m][n] = __builtin_amdgcn_mfma_f32_16x16x32_bf16(Bt[n][k], At[m][k], acc[ai][bj][m][n], 0, 0, 0); __builtin_amdgcn_s_setprio(0); } while (0)
#define PG8_WAIT_V(n) asm volatile("s_waitcnt vmcnt(" #n ")" ::: "memory")
#define PG8_WAIT_L(n) asm volatile("s_waitcnt lgkmcnt(" #n ")" ::: "memory")
#define PG8_BAR __builtin_amdgcn_s_barrier()
#define PG8_SCHED __builtin_amdgcn_sched_barrier(0)
#define PG8_BPTR(tt) ((KSPLIT && (tt) >= nth) ? cB2 + (size_t)((tt) - nth) * kstep : cB + (size_t)(tt) * kstep)
    Unit cur, nxt; int ui = 0;
    if (!S.next(0, cur)) return;
    if constexpr (GATHER) {
#pragma unroll
        for (int h = 0; h < 2; ++h)
#pragma unroll
            for (int i = 0; i < 2; ++i) voA[h][i] = S.row_off(cur, h * HALF + RA[i], ldA) + (unsigned)CA[i] * 2u;
    }
    f32x4 acc[2][2][4][2];
#pragma unroll
    for (int a = 0; a < 2; ++a)
#pragma unroll
        for (int b = 0; b < 2; ++b)
#pragma unroll
            for (int m = 0; m < 4; ++m)
#pragma unroll
                for (int n = 0; n < 2; ++n) acc[a][b][m][n] = (f32x4){0.f, 0.f, 0.f, 0.f};
    bf16x8 At[4][2], B0[2][2], B1[2][2];
    const char* cA = cur.A; const char* cB = cur.B; const char* cB2 = cur.B2;
    if constexpr (Epi::SIDE) { if (wid == 0 && E.has_side()) __builtin_amdgcn_global_load_lds((const unsigned*)(E.side_src(cur) + lane * 16), (LAS unsigned*)(lds + SIDE_OFF), 16, 0, 0); }
    PG8_STAGEB(PG8_SB(0, 0), cB); PG8_STAGEB(PG8_SB(0, 1), cB + hstepB); PG8_STAGEA(PG8_SA(0, 0), cA, voA, 0); PG8_STAGEA(PG8_SA(0, 1), cA, voA, 1);
    if (wr == 1) PG8_BAR;
    PG8_WAIT_V(2); PG8_BAR;
    { const char* b1 = PG8_BPTR(1); PG8_STAGEB(PG8_SB(1, 0), b1); PG8_STAGEA(PG8_SA(1, 0), cA + kstep, voA, 0); PG8_STAGEB(PG8_SB(1, 1), b1 + hstepB); }
    PG8_WAIT_V(6); PG8_BAR;
    for (;;) {
        const bool has_next = S.next(ui + 1, nxt);
        const char* nA = has_next ? nxt.A : cA; const char* nB = has_next ? nxt.B : cB;
        if constexpr (GATHER) {
            if (has_next) {
#pragma unroll
                for (int h = 0; h < 2; ++h)
#pragma unroll
                    for (int i = 0; i < 2; ++i) nvoA[h][i] = S.row_off(nxt, h * HALF + RA[i], ldA) + (unsigned)CA[i] * 2u;
            } else {
#pragma unroll
                for (int h = 0; h < 2; ++h)
#pragma unroll
                    for (int i = 0; i < 2; ++i) nvoA[h][i] = voA[h][i];
            }
        }
        for (int t = 0; t < nt; t += 2) {
            const bool last = (t == nt - 2);
            const char* a1 = cA + (size_t)(t + 1) * kstep;
            const char* a2 = last ? nA : cA + (size_t)(t + 2) * kstep; const char* b2 = last ? nB : PG8_BPTR(t + 2);
            const char* a3 = a2 + kstep; const char* b3 = last ? nB + kstep : PG8_BPTR(t + 3);
            unsigned vo2[2][2];
#pragma unroll
            for (int h = 0; h < 2; ++h)
#pragma unroll
                for (int i = 0; i < 2; ++i) vo2[h][i] = (GATHER && last) ? nvoA[h][i] : voA[h][i];
            PG8_LDB(B0, 0, 0); PG8_LDB(B1, 0, 1); PG8_SCHED; PG8_LDA(At, 0, 0); PG8_STAGEA(PG8_SA(1, 1), a1, voA, 1);
            PG8_WAIT_V(8); PG8_WAIT_L(0); PG8_BAR; PG8_MMA(0, 0, At, B0); PG8_MMA(0, 1, At, B1); PG8_BAR; PG8_SCHED;
            PG8_LDA(At, 0, 1); PG8_STAGEB(PG8_SB(0, 0), b2); PG8_STAGEB(PG8_SB(0, 1), b2 + hstepB); PG8_STAGEA(PG8_SA(0, 0), a2, vo2, 0);
            PG8_WAIT_V(8); PG8_WAIT_L(0); PG8_BAR; PG8_MMA(1, 0, At, B0); PG8_MMA(1, 1, At, B1); PG8_BAR; PG8_SCHED;
            PG8_LDB(B0, 1, 0); PG8_LDB(B1, 1, 1); PG8_SCHED; PG8_LDA(At, 1, 0); PG8_STAGEA(PG8_SA(0, 1), a2, vo2, 1);
            PG8_WAIT_V(8); PG8_WAIT_L(0); PG8_BAR; PG8_MMA(0, 0, At, B0); PG8_MMA(0, 1, At, B1); PG8_BAR; PG8_SCHED;
            PG8_LDA(At, 1, 1); PG8_STAGEB(PG8_SB(1, 0), b3); PG8_STAGEB(PG8_SB(1, 1), b3 + hstepB); PG8_STAGEA(PG8_SA(1, 0), a3, vo2, 0);
            PG8_WAIT_V(8); PG8_WAIT_L(0); PG8_BAR; PG8_MMA(1, 0, At, B0); PG8_MMA(1, 1, At, B1); PG8_BAR; PG8_SCHED;
        }
        if constexpr (ALIGN_EPI) { if (wr == 0) PG8_BAR; }
        if constexpr (Epi::SIDE) { if (has_next && wid == 0 && E.has_side()) __builtin_amdgcn_global_load_lds((const unsigned*)(E.side_src(nxt) + lane * 16), (LAS unsigned*)(lds + SIDE_OFF + ((ui + 1) & 1) * 1024), 16, 0, 0); }
        E(acc, cur, wr, wc, fr, fq, (const LAS float*)(lds + SIDE_OFF + (ui & 1) * 1024));
        if (!has_next) break;
#pragma unroll
        for (int a = 0; a < 2; ++a)
#pragma unroll
            for (int b = 0; b < 2; ++b)
#pragma unroll
                for (int m = 0; m < 4; ++m)
#pragma unroll
                    for (int n = 0; n < 2; ++n) acc[a][b][m][n] = (f32x4){0.f, 0.f, 0.f, 0.f};
        cur = nxt; cA = nA; cB = nB; cB2 = nxt.B2; ++ui;
        if constexpr (GATHER) {
#pragma unroll
            for (int h = 0; h < 2; ++h)
#pragma unroll
                for (int i = 0; i < 2; ++i) voA[h][i] = nvoA[h][i];
        }
        if constexpr (ALIGN_EPI) { if (wr == 1) PG8_BAR; }
    }
    PG8_WAIT_V(0);
    if constexpr (!ALIGN_EPI) { if (wr == 0) PG8_BAR; }
    PG8_BAR;
#undef PG8_SA
#undef PG8_SB
#undef PG8_STAGEA
#undef PG8_STAGEB
#undef PG8_LDA
#undef PG8_LDB
#undef PG8_MMA
#undef PG8_WAIT_V
#undef PG8_WAIT_L
#undef PG8_BAR
#undef PG8_SCHED
#undef PG8_BPTR
}
}
namespace pg {
template <bool BIAS_ROW> struct EpiBf16 {
    static constexpr bool PERM = true; static constexpr bool SIDE = true; static constexpr int NST = 16;
    __device__ __forceinline__ bool full_stores(const Unit&) const { return true; }
    bf16* O; int ldc; const float* bias;
    __device__ __forceinline__ bool has_side() const { return bias != nullptr; }
    __device__ __forceinline__ const char* side_src(const Unit& u) const { return (const char*)(bias + (BIAS_ROW ? u.pm : u.pn) * BM); }
    __device__ __forceinline__ void operator()(const f32x4 (&acc)[2][2][4][2], const Unit& u, int wr, int wc, int fr, int fq, const LAS float* side) const {
        const int row0 = u.pm * BM + wr * 64 + fr; const int col0 = u.pn * BM + wc * 32 + 8 * fq;
        f32x4 bv[2][2];
#pragma unroll
        for (int bj = 0; bj < 2; ++bj)
#pragma unroll
            for (int n = 0; n < 2; ++n) bv[bj][n] = (bias && !BIAS_ROW) ? *(const LAS f32x4*)(side + wc * 32 + 8 * fq + bj * HALF + 4 * n) : (f32x4){0.f, 0.f, 0.f, 0.f};
#pragma unroll
        for (int ai = 0; ai < 2; ++ai)
#pragma unroll
            for (int m = 0; m < 4; ++m) { const int row = row0 + ai * HALF + m * 16; bf16* rowp = O + (size_t)row * ldc + col0;
                float br = 0.f; if (BIAS_ROW && bias) br = side[wr * 64 + fr + ai * HALF + m * 16];
#pragma unroll
                for (int bj = 0; bj < 2; ++bj) { f32x4 v0 = acc[ai][bj][m][0] + bv[bj][0] + br, v1 = acc[ai][bj][m][1] + bv[bj][1] + br;
                    u32x4 w; w.x = cvt_pk_bf16(v0[0], v0[1]); w.y = cvt_pk_bf16(v0[2], v0[3]); w.z = cvt_pk_bf16(v1[0], v1[1]); w.w = cvt_pk_bf16(v1[2], v1[3]);
                    *(u32x4*)(rowp + bj * HALF) = w; } }
    }
};
struct EpiQKV {
    static constexpr bool PERM = false; static constexpr bool SIDE = false; static constexpr int NST = 32;
    __device__ __forceinline__ bool full_stores(const Unit&) const { return true; }
    bf16 *Q, *Kb, *Vb; const float* bias; const float* ropeC; const float* ropeS;
    __device__ __forceinline__ bool has_side() const { return false; }
    __device__ __forceinline__ const char* side_src(const Unit&) const { return nullptr; }
    __device__ __forceinline__ void operator()(const f32x4 (&acc)[2][2][4][2], const Unit& u, int wr, int wc, int fr, int fq, const LAS float*) const {
        const int row0 = u.pm * BM + wr * 64 + fr; const int colt = u.pn * BM + wc * 32 + 4 * fq;
        const bool isV = (u.pn == 9), isQ = (u.pn < 8);
        bf16* base; int ldc, cofs;
        if (isQ) { base = Q; ldc = DM; cofs = 0; } else if (!isV) { base = Kb; ldc = KVD; cofs = 2048; } else { base = Vb; ldc = KVD; cofs = 2304; }
        f32x4 bv[2][2];
#pragma unroll
        for (int bj = 0; bj < 2; ++bj)
#pragma unroll
            for (int n = 0; n < 2; ++n) bv[bj][n] = *(const f32x4*)(bias + colt + bj * HALF + 16 * n);
        const float sc = isQ ? QSCALE : 1.f; const int half = wc & 1;
#pragma unroll
        for (int ai = 0; ai < 2; ++ai)
#pragma unroll
            for (int m = 0; m < 4; ++m) { const int row = row0 + ai * HALF + m * 16; const int t = row & (SEQ - 1); const int pos = half ? (t & (GRIDW - 1)) : (t >> 6);
                f32x4 cs = (f32x4){1.f, 1.f, 1.f, 1.f}, sn = (f32x4){0.f, 0.f, 0.f, 0.f};
                if (!isV) { cs = *(const f32x4*)(ropeC + pos * 16 + 4 * fq); sn = *(const f32x4*)(ropeS + pos * 16 + 4 * fq); }
                bf16* rowp = base + (size_t)row * ldc + (colt - cofs);
#pragma unroll
                for (int bj = 0; bj < 2; ++bj) { const f32x4 x1 = acc[ai][bj][m][0] + bv[bj][0], x2 = acc[ai][bj][m][1] + bv[bj][1];
                    const f32x4 o1 = (x1 * cs - x2 * sn) * sc, o2 = (x2 * cs + x1 * sn) * sc;
                    u32x2 w1, w2; w1.x = cvt_pk_bf16(o1[0], o1[1]); w1.y = cvt_pk_bf16(o1[2], o1[3]); w2.x = cvt_pk_bf16(o2[0], o2[1]); w2.y = cvt_pk_bf16(o2[2], o2[3]);
                    *(u32x2*)(rowp + bj * HALF) = w1; *(u32x2*)(rowp + bj * HALF + 16) = w2; } }
    }
};
struct EpiMoe1 {
    static constexpr bool PERM = true; static constexpr bool SIDE = true; static constexpr int NST = 8;
    __device__ __forceinline__ bool full_stores(const Unit& u) const { return u.nrows == BM; }
    bf16* hid; const float* gates;
    __device__ __forceinline__ bool has_side() const { return true; }
    __device__ __forceinline__ const char* side_src(const Unit& u) const { return (const char*)(gates + (size_t)((u.pn >= 8) ? 1 : 0) * NCLS * LCAP + u.lbase); }
    __device__ __forceinline__ void operator()(const f32x4 (&acc)[2][2][4][2], const Unit& u, int wr, int wc, int fr, int fq, const LAS float* side) const {
        const int lr0 = wr * 64 + fr; const int col0 = u.pn * HALF + wc * 32 + 8 * fq; const int gsel = (u.pn >= 8) ? 1 : 0;
#pragma unroll
        for (int ai = 0; ai < 2; ++ai)
#pragma unroll
            for (int m = 0; m < 4; ++m) { const int lr = lr0 + ai * HALF + m * 16;
                if (lr < u.nrows) { const float g = side[lr];
                    float o[8];
#pragma unroll
                    for (int n = 0; n < 2; ++n)
#pragma unroll
                        for (int i = 0; i < 4; ++i) { const float a = acc[ai][0][m][n][i], b = acc[ai][1][m][n][i];
                            const float sg = __builtin_amdgcn_rcpf(1.f + __builtin_amdgcn_exp2f(-1.4426950408889634f * a)); o[n * 4 + i] = a * sg * b * g; }
                    u32x4 w; w.x = cvt_pk_bf16(o[0], o[1]); w.y = cvt_pk_bf16(o[2], o[3]); w.z = cvt_pk_bf16(o[4], o[5]); w.w = cvt_pk_bf16(o[6], o[7]);
                    *(u32x4*)(hid + (size_t)(u.row0 + lr) * DM + col0) = w; } }
    }
};
struct EpiMoe2 {
    static constexpr bool PERM = true; static constexpr bool SIDE = true; static constexpr int NST = 16;
    __device__ __forceinline__ bool full_stores(const Unit& u) const { return u.nrows == BM; }
    bf16* Y; const int* toks;
    __device__ __forceinline__ bool has_side() const { return true; }
    __device__ __forceinline__ const char* side_src(const Unit& u) const { return (const char*)(toks + u.lbase); }
    __device__ __forceinline__ void operator()(const f32x4 (&acc)[2][2][4][2], const Unit& u, int wr, int wc, int fr, int fq, const LAS float* side) const {
        const int lr0 = wr * 64 + fr; const int col0 = u.pn * BM + wc * 32 + 8 * fq;
#pragma unroll
        for (int ai = 0; ai < 2; ++ai)
#pragma unroll
            for (int m = 0; m < 4; ++m) { const int lr = lr0 + ai * HALF + m * 16;
                if (lr < u.nrows) { const int tok = ((const LAS int*)side)[lr]; bf16* rowp = Y + (size_t)tok * DM + col0;
#pragma unroll
                    for (int bj = 0; bj < 2; ++bj) { const f32x4 v0 = acc[ai][bj][m][0], v1 = acc[ai][bj][m][1];
                        u32x4 w; w.x = cvt_pk_bf16(v0[0], v0[1]); w.y = cvt_pk_bf16(v0[2], v0[3]); w.z = cvt_pk_bf16(v1[0], v1[1]); w.w = cvt_pk_bf16(v1[2], v1[3]);
                        *(u32x4*)(rowp + bj * HALF) = w; } } }
    }
};
struct MoeSched {
    const LAS int* tab;
    const char* Abase; const char* W; const int* toks; int G, c, NPN, second;
    __device__ __forceinline__ bool next(int i, Unit& u) const {
        const int TM = __builtin_amdgcn_readfirstlane(tab[24]);
        if (!static_map(i, G, c, TM, NPN, u.pm, u.pn)) return false;
        int cls = 0;
        for (int k = 1; k < NCLS; ++k) { const int s = __builtin_amdgcn_readfirstlane(tab[k]); if (u.pm >= s) cls = k; }
        const int ts = __builtin_amdgcn_readfirstlane(tab[cls]), cnt = __builtin_amdgcn_readfirstlane(tab[32 + cls]);
        const int ti = u.pm - ts; u.cls = cls; u.row0 = u.pm * BM; u.nrows = (cnt - ti * BM) < BM ? (cnt - ti * BM) : BM; u.lbase = cls * LCAP + ti * BM;
        const int g = cls / 6, p = cls % 6; const int lo = (p < 3) ? 0 : (p < 5 ? 1 : 2), hi = (p < 3) ? p + 1 : (p < 5 ? p - 1 : 3);
        const int elo = g * 4 + lo, ehi = g * 4 + hi;
        if (!second) { const int e = (u.pn < 8) ? elo : ehi; u.A = Abase; u.B = W + ((size_t)e * 2048 + (size_t)(u.pn & 7) * 256) * 2048 * 2; u.B2 = u.B; }
        else { u.A = Abase + (size_t)u.row0 * DM * 2; u.B = W + ((size_t)elo * 2048 + (size_t)u.pn * 256) * 1024 * 2; u.B2 = W + ((size_t)ehi * 2048 + (size_t)u.pn * 256) * 1024 * 2; }
        return true;
    }
    __device__ __forceinline__ unsigned row_off(const Unit& u, int r, int ldA) const {
        const int rr = r < u.nrows ? r : u.nrows - 1; const int tok = toks[u.lbase + rr]; return (unsigned)tok * (unsigned)ldA * 2u;
    }
};
}
struct Args { const float* in[34]; float* out; unsigned char* ws; int ph_lo, ph_hi; };
struct Frame {
    LAS unsigned char* lds;
    gu32* ctl; unsigned char* ws;
    int tid, lane, wave, G, bid;
    const Args* a; float* out;
};
#define AIN(i) (F.a->in[i])
enum { I_X = 0, I_C, I_CTX, I_CCTX, I_ADAW, I_ADAB, I_AWIN, I_ABIN, I_SINK, I_AWOUT, I_HWIN, I_HBIN, I_HCW, I_HCB, I_FW1, I_FB1, I_FW2, I_FB2, I_FW3, I_FB3, I_FFREQ, I_FW4, I_FBIAS, I_HWOUT, I_HBOUT,
       I_LN1G, I_LN1B, I_LN2G, I_LN2B, I_RW, I_RB, I_W1, I_W3, I_W2 };
#ifndef TPSEL
#define TPSEL -1
#endif
#define TPS_W ((LAS unsigned long long*)(F.lds + RING_BYTES + 320 + 96))
#define TPS_START(id) do { if (TPSEL == (id) && blockIdx.x == 0 && threadIdx.x == 0) TPS_W[1] = __builtin_amdgcn_s_memrealtime(); } while (0)
#define TPS_STOP(id) do { if (TPSEL == (id) && blockIdx.x == 0 && threadIdx.x == 0) TPS_W[0] += __builtin_amdgcn_s_memrealtime() - TPS_W[1]; } while (0)
__device__ __forceinline__ int fresh_tid(int wave) { int l_; asm volatile("v_mbcnt_lo_u32_b32 %0, -1, 0\n\tv_mbcnt_hi_u32_b32 %0, -1, %0" : "=&v"(l_)); return wave * 64 + l_; }
__device__ __forceinline__ float* mod_ptr(const Frame& F, int layer, int vec, int chunk) { return (float*)(F.ws + WS_MOD) + ((size_t)(layer * 3 + vec) * 6 + chunk) * DM; }

__device__ __forceinline__ float hy_ftab_value(int f, int l, int jj);
__device__ constexpr int hy_ftab_elems() { return 28 * 64 * 8; }
__device__ __forceinline__ void p0_transpose_item(const float* W, int ldw, bf16* WT, int ldt, int dst_row, int k0, int n0, LAS float* scr, int lane) {
#pragma unroll
    for (int i = 0; i < 32; ++i) { const int kk = 2 * i + (lane >> 5); scr[kk * 33 + (lane & 31)] = W[(size_t)(k0 + kk) * ldw + n0 + (lane & 31)]; }
    LDS_WAIT(); asm volatile("" ::: "memory");
    const int c = lane & 7;
#pragma unroll
    for (int j = 0; j < 4; ++j) { const int n = (lane >> 3) + 8 * j; const LAS float* s = scr + (8 * c) * 33 + n;
        u32x4 o; o.x = cvt_pk_bf16(s[0 * 33], s[1 * 33]); o.y = cvt_pk_bf16(s[2 * 33], s[3 * 33]); o.z = cvt_pk_bf16(s[4 * 33], s[5 * 33]); o.w = cvt_pk_bf16(s[6 * 33], s[7 * 33]);
        *(GAS u32x4*)(WT + (size_t)(dst_row + n) * ldt + k0 + 8 * c) = o; }
    LDS_WAIT(); asm volatile("" ::: "memory");
}
struct ConvItem { const float* W; bf16* WT; int ldw, ldt, dst_row, k0, n0; };
__device__ __forceinline__ ConvItem moe_l1_item(const Frame& F, int it) {
    ConvItem c; const int mat = it >> 10, sub = it & 1023, which = mat >> 4, le = 16 + (mat & 15);
    if (which < 2) { c.n0 = (sub & 31) * 32; c.k0 = (sub >> 5) * 64; c.W = (which == 0 ? AIN(I_W1) : AIN(I_W3)) + (size_t)le * DM * EFF; c.ldw = EFF; c.WT = (bf16*)(F.ws + WS_W13) + (size_t)le * 2048 * 2048; c.ldt = DM; c.dst_row = (c.n0 >> 7) * 256 + which * 128 + (c.n0 & 127); }
    else { c.n0 = (sub & 63) * 32; c.k0 = (sub >> 6) * 64; c.W = AIN(I_W2) + (size_t)le * EFF * DM; c.ldw = DM; c.WT = (bf16*)(F.ws + WS_W2) + (size_t)le * 2048 * 1024; c.ldt = EFF; c.dst_row = c.n0; }
    return c;
}
__device__ __forceinline__ ConvItem early_item(const Frame& F, int it) {
    ConvItem c;
    if (it < 48 * 1024) { const int mat = it >> 10, sub = it & 1023, which = mat >> 4, le = mat & 15;
        if (which < 2) { c.n0 = (sub & 31) * 32; c.k0 = (sub >> 5) * 64; c.W = (which == 0 ? AIN(I_W1) : AIN(I_W3)) + (size_t)le * DM * EFF; c.ldw = EFF; c.WT = (bf16*)(F.ws + WS_W13) + (size_t)le * 2048 * 2048; c.ldt = DM; c.dst_row = (c.n0 >> 7) * 256 + which * 128 + (c.n0 & 127); }
        else { c.n0 = (sub & 63) * 32; c.k0 = (sub >> 6) * 64; c.W = AIN(I_W2) + (size_t)le * EFF * DM; c.ldw = DM; c.WT = (bf16*)(F.ws + WS_W2) + (size_t)le * 2048 * 1024; c.ldt = EFF; c.dst_row = c.n0; }
    } else { int r = it - 48 * 1024;
        if (r < 32 * 192) { c.n0 = (r % 192) * 32; c.k0 = (r / 192) * 64; c.W = AIN(I_HWIN); c.ldw = 3 * DM; c.WT = (bf16*)(F.ws + WS_WHYIN); c.ldt = DM; c.dst_row = c.n0; }
        else { r -= 32 * 192; c.n0 = (r % 64) * 32; c.k0 = (r / 64) * 64; c.W = AIN(I_HWOUT); c.ldw = DM; c.WT = (bf16*)(F.ws + WS_WHYO); c.ldt = DM; c.dst_row = c.n0; } }
    return c;
}
constexpr int EARLY_NIT = 48 * 1024 + 32 * 192 + 32 * 64;
__device__ __forceinline__ void conv_issue(const ConvItem& c, int lane, float (&v)[32]) {
    const float* p = c.W + (size_t)(c.k0 + (lane >> 5)) * c.ldw + c.n0 + (lane & 31); const size_t st = (size_t)2 * c.ldw;
#pragma unroll
    for (int i = 0; i < 32; ++i) { v[i] = *p; p += st; asm volatile("" : "+v"(p)); }
}
__device__ __forceinline__ void conv_finish(const ConvItem& c, int lane, const float (&v)[32]) {
    bf16* row = c.WT + (size_t)(c.dst_row + (lane & 31)) * c.ldt + c.k0 + 8 * (lane >> 5);
#pragma unroll
    for (int m = 0; m < 4; ++m) { u32x4 w;
#pragma unroll
        for (int q = 0; q < 4; ++q) { auto r = __builtin_amdgcn_permlane32_swap(__float_as_uint(v[8 * m + q]), __float_as_uint(v[8 * m + 4 + q]), false, false);
            const unsigned pk = cvt_pk_bf16(__uint_as_float(r[0]), __uint_as_float(r[1])); if (q == 0) w.x = pk; else if (q == 1) w.y = pk; else if (q == 2) w.z = pk; else w.w = pk; }
        *(GAS u32x4*)(row + 16 * m) = w; }
}
__device__ __forceinline__ void p0_prologue(Frame& F) {
    const int gw = F.bid * NWAVES + F.wave, NGW = F.G * NWAVES, gt = F.bid * NTHR + F.tid, NGT = F.G * NTHR;
#ifndef P0_REP
#define P0_REP 0
#endif
    TPS_START(20);
#pragma unroll 1
    for (int rep_a = 0; rep_a < ((P0_REP & 1) ? 2 : 1); ++rep_a) {
        LAS float* sil = (LAS float*)F.lds; LAS float* red = sil + 3 * DM;
        for (int i = F.tid; i < 3 * DM; i += NTHR) { const int v = i / DM, k = i % DM; const float cv = (v < 2) ? AIN(I_C)[v * DM + k] : AIN(I_CCTX)[k]; sil[i] = cv / (1.f + expf(-cv)); }
        __syncthreads();
        const int cl = F.tid & 7, kg = F.tid >> 3;
        for (int unit = F.bid; unit < 768; unit += F.G) {
            const int l = unit / 384, n0 = (unit % 384) * 32;
            const float* W = AIN(I_ADAW) + (size_t)l * DM * 12288 + n0 + cl * 4;
            f32x4 a0 = {0.f, 0.f, 0.f, 0.f}, a1 = a0, a2 = a0;
#pragma unroll 8
            for (int i = 0; i < 32; ++i) { const int k = kg + 64 * i; const f32x4 w = *(const f32x4*)(W + (size_t)k * 12288); a0 += w * sil[k]; a1 += w * sil[DM + k]; a2 += w * sil[2 * DM + k]; }
#pragma unroll
            for (int j = 0; j < 4; ++j) { red[(kg * 32 + cl * 4 + j) * 3 + 0] = a0[j]; red[(kg * 32 + cl * 4 + j) * 3 + 1] = a1[j]; red[(kg * 32 + cl * 4 + j) * 3 + 2] = a2[j]; }
            __syncthreads();
            if (F.tid < 96) { const int col = F.tid & 31, v = F.tid >> 5; float s = 0.f;
                for (int k = 0; k < 64; ++k) s += red[(k * 32 + col) * 3 + v];
                ((float*)(F.ws + WS_MOD))[(size_t)(l * 3 + v) * 12288 + n0 + col] = s + AIN(I_ADAB)[l * 12288 + n0 + col]; }
            __syncthreads();
        }
    }
    TPS_STOP(20); TPS_START(21);
#pragma unroll 1
    for (int rep_b = 0; rep_b < ((P0_REP & 2) ? 2 : 1); ++rep_b) {
        LAS float* scr = (LAS float*)(F.lds + F.wave * 16384);
        constexpr int I0 = 32 * 80, I1 = 32 * 64, NIT = I0 + I1 + EARLY_NIT;
        for (int it = gw; it < NIT; it += NGW) {
            int r = it;
            if (r < I0) { p0_transpose_item(AIN(I_AWIN), QKVD, (bf16*)(F.ws + WS_WQKV), DM, (r % 80) * 32, (r / 80) * 64, (r % 80) * 32, scr, F.lane); continue; } r -= I0;
            if (r < I1) { p0_transpose_item(AIN(I_AWOUT), DM, (bf16*)(F.ws + WS_WO0), DM, (r % 64) * 32, (r / 64) * 64, (r % 64) * 32, scr, F.lane); continue; } r -= I1;
            const ConvItem c = early_item(F, r); p0_transpose_item(c.W, c.ldw, c.WT, c.ldt, c.dst_row, c.k0, c.n0, scr, F.lane);
        }
    }
    TPS_STOP(21); TPS_START(22);
    {
        const int j = F.lane; const float fr = AIN(I_FFREQ)[j], b1 = AIN(I_FB1)[j], b2 = AIN(I_FB2)[j], b3 = AIN(I_FB3)[j];
        float wc1[HYEMB], wc2[HYW], wc3[HYW];
#pragma unroll
        for (int i = 0; i < HYEMB; ++i) wc1[i] = AIN(I_FW1)[i * HYW + j];
#pragma unroll
        for (int i = 0; i < HYW; ++i) { wc2[i] = AIN(I_FW2)[i * HYW + j]; wc3[i] = AIN(I_FW3)[i * HYW + j]; }
        bf16* hdn = (bf16*)(F.ws + WS_HDN);
        for (int row = gw; row < SEQ; row += NGW) {
            const float tt = (float)row / (float)(SEQ - 1); const float wv = 6.283185307179586f * (float)row / (float)SEQ;
            float zv = 0.f;
            if (j == 0) zv = tt;
            else if (j <= 32) { const int jj = (j - 1) & 15; const float f = 1e-4f + (float)jj * ((15.f - 1e-4f) / 15.f); const float a = f * wv; zv = (j <= 16) ? cosf(a) : -sinf(a); }
            float h = b1;
#pragma unroll
            for (int i = 0; i < HYEMB; ++i) h += __builtin_bit_cast(float, __builtin_amdgcn_readlane(__builtin_bit_cast(int, zv), i)) * wc1[i];
            float a1 = sinf(fr * h);
            h = b2;
#pragma unroll
            for (int i = 0; i < HYW; ++i) h += __builtin_bit_cast(float, __builtin_amdgcn_readlane(__builtin_bit_cast(int, a1), i)) * wc2[i];
            float a2 = sinf(fr * h);
            h = b3;
#pragma unroll
            for (int i = 0; i < HYW; ++i) h += __builtin_bit_cast(float, __builtin_amdgcn_readlane(__builtin_bit_cast(int, a2), i)) * wc3[i];
            const float a3 = sinf(fr * h);
            hdn[(size_t)row * 128 + j] = (bf16)(cvt_pk_bf16(a3, 0.f) & 0xffffu); hdn[(size_t)row * 128 + 64 + j] = 0;
        }
    }
    TPS_STOP(22); TPS_START(23);
    for (int i = gt; i < hy_ftab_elems(); i += NGT) ((bf16*)(F.ws + WS_FTAB))[i] = (bf16)(cvt_pk_bf16(hy_ftab_value(i >> 9, (i >> 3) & 63, i & 7), 0.f) & 0xffffu);
    for (int i = gt; i < 4096; i += NGT) { const int pos = i >> 4, dd = i & 15; const float inv = powf(10000.f, -(float)(2 * dd) / 32.f); const float a = (float)pos * inv;
        ((float*)(F.ws + WS_ROPE))[i] = cosf(a); ((float*)(F.ws + WS_ROPE))[4096 + i] = sinf(a); }
    for (int i = gt; i < 4096 * 128; i += NGT) { const int k = i >> 12, n = i & 4095;
        ((bf16*)(F.ws + WS_W4T))[(size_t)n * 128 + k] = (k < 64) ? (bf16)(cvt_pk_bf16(AIN(I_FW4)[(size_t)k * 4096 + n], 0.f) & 0xffffu) : (bf16)0; }
    TPS_STOP(23);
}

__device__ __forceinline__ void p1_prologue(Frame& F) {
    if (F.wave < 4) {
        for (int tile = F.bid * 4 + F.wave; tile < 1024; tile += F.G * 4) {
            const int r0 = (tile >> 5) * 16, n0 = (tile & 31) * 16; const int lr = F.lane & 15, kq = F.lane >> 4;
            const float* crow = AIN(I_CTX) + (size_t)(r0 + lr) * DM; const float* sh = mod_ptr(F, 0, 2, 0); const float* sc = mod_ptr(F, 0, 2, 1);
            const bf16* wrow = (const bf16*)(F.ws + WS_WQKV) + (size_t)(2048 + n0 + lr) * DM;
            f32x4 acc = {0.f, 0.f, 0.f, 0.f};
#pragma unroll 4
            for (int k0 = 0; k0 < DM; k0 += 32) { const int k = k0 + 8 * kq;
                const f32x4 x0 = *(const f32x4*)(crow + k), x1 = *(const f32x4*)(crow + k + 4), s0 = *(const f32x4*)(sc + k), s1 = *(const f32x4*)(sc + k + 4), h0 = *(const f32x4*)(sh + k), h1 = *(const f32x4*)(sh + k + 4);
                const f32x4 u0 = x0 * (s0 + 1.f) + h0, u1 = x1 * (s1 + 1.f) + h1;
                u32x4 aw; aw.x = cvt_pk_bf16(u0[0], u0[1]); aw.y = cvt_pk_bf16(u0[2], u0[3]); aw.z = cvt_pk_bf16(u1[0], u1[1]); aw.w = cvt_pk_bf16(u1[2], u1[3]);
                const bf16x8 bfrag = *(const bf16x8*)(wrow + k);
                acc = __builtin_amdgcn_mfma_f32_16x16x32_bf16(__builtin_bit_cast(bf16x8, aw), bfrag, acc, 0, 0, 0); }
            const float bb = AIN(I_ABIN)[2048 + n0 + lr]; bf16* o = (bf16*)(F.ws + WS_CTXKV);
#pragma unroll
            for (int r = 0; r < 4; ++r) o[(size_t)(r0 + 4 * kq + r) * 512 + n0 + lr] = (bf16)(cvt_pk_bf16(acc[r] + bb, 0.f) & 0xffffu);
        }
    }
    const float* x = AIN(I_X); bf16* u0 = (bf16*)(F.ws + WS_A);
    LAS int* cnt = (LAS int*)(F.lds + RING_BYTES + 64);
    const size_t NI = (size_t)MTOK * DM / 8; const size_t per = (NI + F.G - 1) / F.G; const size_t i0 = (size_t)F.bid * per; const size_t i1 = (i0 + per < NI) ? i0 + per : NI;
    const int nch = (int)((i1 - i0 + 255) / 256);
    const bool rowchunks = ((per & 255) == 0) && (i1 > i0) && ((i0 * 8) / ((size_t)SEQ * DM) == ((i1 * 8 - 1) / ((size_t)SEQ * DM)));
    if (rowchunks) {
        const int bq = (int)((i0 * 8) / ((size_t)SEQ * DM));
        f32x4 ms[4][2], mh[4][2];
#pragma unroll
        for (int j = 0; j < 4; ++j) { const int col = 8 * (j * 64 + F.lane); const float* sh = mod_ptr(F, 0, bq, 0) + col; const float* sc = mod_ptr(F, 0, bq, 1) + col;
            ms[j][0] = *(const f32x4*)sc + 1.f; ms[j][1] = *(const f32x4*)(sc + 4) + 1.f; mh[j][0] = *(const f32x4*)sh; mh[j][1] = *(const f32x4*)(sh + 4); }
#define P1_FETCH(C) do { int c_ = 0; if (F.lane == 0) c_ = __hip_atomic_fetch_add(cnt, 1, __ATOMIC_RELAXED, __HIP_MEMORY_SCOPE_WORKGROUP); C = __builtin_amdgcn_readfirstlane(c_); } while (0)
#define P1_LOAD(XA, XB, C) do { _Pragma("unroll") for (int j = 0; j < 4; ++j) { const size_t i = i0 + (size_t)(C) * 256 + j * 64 + F.lane; XA[j] = *(const f32x4*)(x + i * 8); XB[j] = *(const f32x4*)(x + i * 8 + 4); } } while (0)
#define P1_EMIT(XA, XB, C) do { _Pragma("unroll") for (int j = 0; j < 4; ++j) { const size_t e = (i0 + (size_t)(C) * 256 + j * 64 + F.lane) * 8; \
            const f32x4 v0 = XA[j] * ms[j][0] + mh[j][0], v1 = XB[j] * ms[j][1] + mh[j][1]; \
            u32x4 w; w.x = cvt_pk_bf16(v0[0], v0[1]); w.y = cvt_pk_bf16(v0[2], v0[3]); w.z = cvt_pk_bf16(v1[0], v1[1]); w.w = cvt_pk_bf16(v1[2], v1[3]); \
            *(u32x4*)(u0 + e) = w; } } while (0)
        f32x4 xa[4], xb[4], ya[4], yb[4]; int ca, cb;
        P1_FETCH(ca);
        if (ca < nch) {
            P1_LOAD(xa, xb, ca);
            for (;;) {
                P1_FETCH(cb); { const int cl = (cb < nch) ? cb : ca; P1_LOAD(ya, yb, cl); }
                P1_EMIT(xa, xb, ca);
                if (cb >= nch) break;
                P1_FETCH(ca); { const int cl = (ca < nch) ? ca : cb; P1_LOAD(xa, xb, cl); }
                P1_EMIT(ya, yb, cb);
                if (ca >= nch) break;
            }
        }
#undef P1_FETCH
#undef P1_LOAD
#undef P1_EMIT
    } else
    for (;;) {
        int c = 0; if (F.lane == 0) c = __hip_atomic_fetch_add(cnt, 1, __ATOMIC_RELAXED, __HIP_MEMORY_SCOPE_WORKGROUP);
        c = __builtin_amdgcn_readfirstlane(c); if (c >= nch) break;
        f32x4 xa[4], xb[4]; size_t ee[4];
#pragma unroll
        for (int j = 0; j < 4; ++j) { const size_t i = i0 + (size_t)c * 256 + j * 64 + F.lane; ee[j] = (i < i1) ? i * 8 : (size_t)-1; if (i < i1) { xa[j] = *(const f32x4*)(x + i * 8); xb[j] = *(const f32x4*)(x + i * 8 + 4); } }
#pragma unroll
        for (int j = 0; j < 4; ++j) { if (ee[j] == (size_t)-1) continue; const size_t e = ee[j]; const int col = (int)(e & (DM - 1)); const int b = (int)(e / ((size_t)SEQ * DM));
            const float* sh = mod_ptr(F, 0, b, 0) + col; const float* sc = mod_ptr(F, 0, b, 1) + col;
            const f32x4 v0 = xa[j] * (*(const f32x4*)sc + 1.f) + *(const f32x4*)sh, v1 = xb[j] * (*(const f32x4*)(sc + 4) + 1.f) + *(const f32x4*)(sh + 4);
            u32x4 w; w.x = cvt_pk_bf16(v0[0], v0[1]); w.y = cvt_pk_bf16(v0[2], v0[3]); w.z = cvt_pk_bf16(v1[0], v1[1]); w.w = cvt_pk_bf16(v1[2], v1[3]);
            *(u32x4*)(u0 + e) = w; }
    }
}
namespace att {
constexpr int LDS_K = 0, LDS_V = 24576, LDS_WS = 49152, LDS_OST = LDS_WS + NWAVES * 64 * 4, LDS_Q = LDS_OST + NWAVES * 4096;
__device__ __forceinline__ int crow(int r, int hi) { return (r & 3) + 8 * (r >> 2) + 4 * hi; }
__device__ __forceinline__ float max3f(float a, float b, float c) { return __builtin_fmaxf(__builtin_fmaxf(a, b), c); }
__device__ __forceinline__ float rowmax(const f32x16& p0, const f32x16& p1) {
    float a = max3f(p0[0], p0[1], p1[0]), b = max3f(p0[2], p0[3], p1[1]); a = max3f(a, p1[2], p1[3]);
#pragma unroll
    for (int r = 4; r < 16; r += 4) { a = max3f(a, p0[r], p0[r + 1]); b = max3f(b, p0[r + 2], p0[r + 3]); a = max3f(a, p1[r], p1[r + 1]); b = max3f(b, p1[r + 2], p1[r + 3]); }
    const float m = __builtin_fmaxf(a, b);
    auto rr = __builtin_amdgcn_permlane32_swap(__float_as_uint(m), __float_as_uint(m), false, false);
    return __builtin_fmaxf(__uint_as_float(rr[0]), __uint_as_float(rr[1]));
}
__device__ __forceinline__ void qkt(f32x16& p0, f32x16& p1, const LAS unsigned char* Kslot, const bf16x8* qr, const f32x16& z, int r32, int hi) {
    const LAS unsigned char* kb = Kslot + hi * 1024 + r32 * 16;
#pragma unroll
    for (int d0 = 0; d0 < 4; ++d0) {
        const bf16x8 b0 = *(const LAS bf16x8*)(kb + d0 * 2048);
        const bf16x8 b1 = *(const LAS bf16x8*)(kb + d0 * 2048 + 512);
        if (d0 == 0) { p0 = __builtin_amdgcn_mfma_f32_32x32x16_bf16(b0, qr[0], z, 0, 0, 0); p1 = __builtin_amdgcn_mfma_f32_32x32x16_bf16(b1, qr[0], z, 0, 0, 0); }
        else { p0 = __builtin_amdgcn_mfma_f32_32x32x16_bf16(b0, qr[d0], p0, 0, 0, 0); p1 = __builtin_amdgcn_mfma_f32_32x32x16_bf16(b1, qr[d0], p1, 0, 0, 0); }
    }
}
__device__ __forceinline__ void pv(f32x16* o, int vb, bf16x8 pa0, bf16x8 pa1, bf16x8 pa2, bf16x8 pa3) {
#pragma unroll
    for (int d0 = 0; d0 < 2; ++d0) { s16x4 lo[4], hi[4];
#pragma unroll
        for (int ks = 0; ks < 4; ++ks) {
            asm volatile("ds_read_b64_tr_b16 %0,%1 offset:%c2" : "=&v"(lo[ks]) : "v"(vb), "i"(d0 * 4096 + ks * 1024) : "memory");
            asm volatile("ds_read_b64_tr_b16 %0,%1 offset:%c2" : "=&v"(hi[ks]) : "v"(vb), "i"(d0 * 4096 + ks * 1024 + 512) : "memory"); }
        asm volatile("s_waitcnt lgkmcnt(0)" ::: "memory"); __builtin_amdgcn_sched_barrier(0);
#define PK(k) (bf16x8){lo[k][0], lo[k][1], lo[k][2], lo[k][3], hi[k][0], hi[k][1], hi[k][2], hi[k][3]}
        o[d0] = __builtin_amdgcn_mfma_f32_32x32x16_bf16(pa0, PK(0), o[d0], 0, 0, 0);
        o[d0] = __builtin_amdgcn_mfma_f32_32x32x16_bf16(pa1, PK(1), o[d0], 0, 0, 0);
        o[d0] = __builtin_amdgcn_mfma_f32_32x32x16_bf16(pa2, PK(2), o[d0], 0, 0, 0);
        o[d0] = __builtin_amdgcn_mfma_f32_32x32x16_bf16(pa3, PK(3), o[d0], 0, 0, 0);
#undef PK
    }
}
__device__ __forceinline__ void attn_issue(const Frame& F, int u, int t, int slot) {
    const int lane = F.lane, wid = F.wave; LAS unsigned char* shm = F.lds;
    const int qb = u % (SEQ / 32), bk = u / (SEQ / 32), b = bk / NKV, kvh = bk % NKV; const int q0 = qb * 32;
    const bf16* Kb = (const bf16*)(F.ws + WS_B + 128 * MiB); const bf16* Vb = (const bf16*)(F.ws + WS_B + 144 * MiB); const bf16* CKV = (const bf16*)(F.ws + WS_CTXKV);
    const size_t tok0 = (size_t)b * SEQ; const bf16* ksrc; const bf16* vsrc;
    if (t < 4) { const int c0 = b * CTXL + t * 64;
        ksrc = CKV + (size_t)(c0 + lane) * 512 + kvh * HD + wid * 8;
        vsrc = CKV + (size_t)(c0 + 16 * (wid & 3) + (lane >> 2)) * 512 + 256 + kvh * HD + (wid >> 2) * 32 + (lane & 3) * 8;
    } else { const int key0 = ((q0 - 128) & ~63) + (t - 4) * 64;
        int kr = key0 + lane; kr = kr < 0 ? 0 : (kr > SEQ - 1 ? SEQ - 1 : kr);
        int vr = key0 + 16 * (wid & 3) + (lane >> 2); vr = vr < 0 ? 0 : (vr > SEQ - 1 ? SEQ - 1 : vr);
        ksrc = Kb + (tok0 + kr) * KVD + kvh * HD + wid * 8;
        vsrc = Vb + (tok0 + vr) * KVD + kvh * HD + (wid >> 2) * 32 + (lane & 3) * 8;
    }
    __builtin_amdgcn_global_load_lds((const unsigned*)ksrc, (LAS unsigned*)(shm + LDS_K + slot * 8192 + wid * 1024), 16, 0, 0);
    __builtin_amdgcn_global_load_lds((const unsigned*)vsrc, (LAS unsigned*)(shm + LDS_V + slot * 8192 + wid * 1024), 16, 0, 0);
    if (t == 0) {
        const bf16* Qw = (const bf16*)(F.ws + WS_B) + (tok0 + q0 + (lane & 31)) * DM + (kvh * 8 + wid) * HD + (lane >> 5) * 8;
#pragma unroll
        for (int d0 = 0; d0 < 4; ++d0) __builtin_amdgcn_global_load_lds((const unsigned*)(Qw + d0 * 16), (LAS unsigned*)(shm + LDS_Q + wid * 4096 + d0 * 1024), 16, 0, 0);
    }
}
__device__ __forceinline__ void attn_phase(const Frame& F) {
    const int NU = NB * NKV * (SEQ / 32); const int per = (NU + F.G - 1) / F.G;
    const int u0 = F.bid * per; const int u1 = (u0 + per < NU) ? u0 + per : NU; if (u0 >= u1) return;
    const int ntile = (u1 - u0) * 9;
    const int lane = F.lane, r32 = lane & 31, hi = lane >> 5, wid = F.wave;
    LAS unsigned char* shm = F.lds;
    bf16* O = (bf16*)(F.ws + WS_A);
    LAS float* wsf = (LAS float*)(shm + LDS_WS) + wid * 64;
    const int vb0 = (int)(uintptr_t)(shm + LDS_V) + ((lane >> 4) & 1) * 32 + (lane & 3) * 8 + (4 * hi + ((lane & 15) >> 2)) * 64;
    bf16x8 qr[4]; float mref = 0.f, l_reg = 0.f; f32x16 o[2]; o[0] = f32x16{}; o[1] = f32x16{}; f32x16 negm = f32x16{};
    attn_issue(F, u0, 0, 0);
    if (ntile > 1) attn_issue(F, u0, 1, 1);
    int u = u0, t = 0;
    for (int g = 0; g < ntile; ++g) {
        const int slot = g % 3;
        const int qb = u % (SEQ / 32), bk = u / (SEQ / 32), b = bk / NKV, kvh = bk % NKV; const int q0 = qb * 32; const int head = kvh * 8 + wid; const size_t tok0 = (size_t)b * SEQ;
        if (g + 1 < ntile) { if (t == 8 || (t == 0 && g > 0)) asm volatile("s_waitcnt vmcnt(6)" ::: "memory"); else asm volatile("s_waitcnt vmcnt(2)" ::: "memory"); }
        else asm volatile("s_waitcnt vmcnt(0)" ::: "memory");
        LDS_WAIT(); __builtin_amdgcn_s_barrier();
        if (g + 2 < ntile) { const int g2 = g + 2; attn_issue(F, u0 + g2 / 9, g2 % 9, g2 % 3); }
        if (t == 0) {
#pragma unroll
            for (int d0 = 0; d0 < 4; ++d0) qr[d0] = *(const LAS bf16x8*)(shm + LDS_Q + wid * 4096 + d0 * 1024 + lane * 16);
            mref = 0.f; l_reg = 0.f; o[0] = f32x16{}; o[1] = f32x16{}; negm = f32x16{}; }
        f32x16 p0, p1;
        qkt(p0, p1, shm + LDS_K + slot * 8192, qr, negm, r32, hi);
        { const int key0 = ((q0 - 128) & ~63) + (t - 4) * 64;
          if (t >= 4 && (t == 4 || t == 8 || key0 < 0 || key0 + 64 > SEQ)) { const int qpos = q0 + r32;
#pragma unroll
            for (int r = 0; r < 16; ++r) { const int k0 = key0 + crow(r, hi), k1 = k0 + 32;
                const bool v0 = (k0 >= 0) && (k0 < SEQ) && (k0 - qpos <= 128) && (qpos - k0 <= 128);
                const bool v1 = (k1 >= 0) && (k1 < SEQ) && (k1 - qpos <= 128) && (qpos - k1 <= 128);
                p0[r] = v0 ? p0[r] : -INFINITY; p1[r] = v1 ? p1[r] : -INFINITY; } } }
        const float rm = rowmax(p0, p1);
        if (__any(rm > 8.f)) {
            const float dl = __builtin_fmaxf(rm, 0.f); mref += dl;
            const float f = __builtin_amdgcn_exp2f(-dl); l_reg *= f;
#pragma unroll
            for (int r = 0; r < 16; ++r) { p0[r] -= dl; p1[r] -= dl; negm[r] = -mref; }
            if (hi == 0) wsf[r32] = f;
            LDS_WAIT();
#pragma unroll
            for (int d = 0; d < 2; ++d)
#pragma unroll
                for (int r = 0; r < 16; ++r) o[d][r] *= wsf[crow(r, hi)];
        }
        float sacc = 0.f;
#pragma unroll
        for (int r = 0; r < 16; ++r) { p0[r] = __builtin_amdgcn_exp2f(p0[r]); p1[r] = __builtin_amdgcn_exp2f(p1[r]); sacc += p0[r] + p1[r]; }
        l_reg += sacc;
        u32x4 pw0, pw1, pw2, pw3;
#define PKW(P, B) cvt_pk_bf16(P[B], P[B + 1])
        pw0 = (u32x4){PKW(p0, 0), PKW(p0, 2), PKW(p0, 4), PKW(p0, 6)}; pw1 = (u32x4){PKW(p0, 8), PKW(p0, 10), PKW(p0, 12), PKW(p0, 14)};
        pw2 = (u32x4){PKW(p1, 0), PKW(p1, 2), PKW(p1, 4), PKW(p1, 6)}; pw3 = (u32x4){PKW(p1, 8), PKW(p1, 10), PKW(p1, 12), PKW(p1, 14)};
#undef PKW
        pv(o, vb0 + slot * 8192, __builtin_bit_cast(bf16x8, pw0), __builtin_bit_cast(bf16x8, pw1), __builtin_bit_cast(bf16x8, pw2), __builtin_bit_cast(bf16x8, pw3));
        if (t == 8) {
            { auto rr = __builtin_amdgcn_permlane32_swap(__float_as_uint(l_reg), __float_as_uint(l_reg), false, false); l_reg = __uint_as_float(rr[0]) + __uint_as_float(rr[1]); }
            l_reg += __builtin_amdgcn_exp2f(AIN(I_SINK)[head] * 1.4426950408889634f - mref);
            if (hi == 0) wsf[32 + r32] = l_reg;
            LDS_WAIT();
            float rli[16];
#pragma unroll
            for (int r = 0; r < 16; ++r) rli[r] = 1.f / wsf[32 + crow(r, hi)];
            bf16* Ow = O + (tok0 + q0) * DM + head * HD;
            LAS bf16* stg = (LAS bf16*)(shm + LDS_OST) + wid * 2048;
#pragma unroll
            for (int r = 0; r < 16; ++r) { const int orow = crow(r, hi);
#pragma unroll
                for (int d0 = 0; d0 < 2; ++d0) stg[orow * 64 + d0 * 32 + r32] = (bf16)(cvt_pk_bf16(o[d0][r] * rli[r], 0.f) & 0xffffu); }
            LDS_WAIT();
#pragma unroll
            for (int i = 0; i < 4; ++i) { const int row = i * 8 + (lane >> 3), ch = lane & 7; const u32x4 v = *(const LAS u32x4*)(stg + row * 64 + ch * 8); *(u32x4*)(Ow + (size_t)row * DM + ch * 8) = v; }
        }
        if (t == 8) { t = 0; ++u; } else ++t;
    }
}
}

__device__ __forceinline__ float row16_sum(float v) {
    v += __builtin_bit_cast(float, __builtin_amdgcn_update_dpp(0, __builtin_bit_cast(int, v), 0xB1, 0xf, 0xf, true));
    v += __builtin_bit_cast(float, __builtin_amdgcn_update_dpp(0, __builtin_bit_cast(int, v), 0x4E, 0xf, 0xf, true));
    v += __builtin_bit_cast(float, __builtin_amdgcn_update_dpp(0, __builtin_bit_cast(int, v), 0x141, 0xf, 0xf, true));
    v += __builtin_bit_cast(float, __builtin_amdgcn_update_dpp(0, __builtin_bit_cast(int, v), 0x140, 0xf, 0xf, true));
    return v;
}
template <int NV> __device__ __forceinline__ void block_reduce(const float (&x)[NV], LAS float* red, LAS float* tot, int tid, int lane, int wave) {
    float y[NV / 2], z[NV / 4];
#pragma unroll
    for (int i = 0; i < NV / 2; ++i) { auto r = __builtin_amdgcn_permlane32_swap(__float_as_uint(x[i]), __float_as_uint(x[i + NV / 2]), false, false); y[i] = __uint_as_float(r[0]) + __uint_as_float(r[1]); }
#pragma unroll
    for (int i = 0; i < NV / 4; ++i) { auto r = __builtin_amdgcn_permlane16_swap(__float_as_uint(y[i]), __float_as_uint(y[i + NV / 4]), false, false); z[i] = row16_sum(__uint_as_float(r[0]) + __uint_as_float(r[1])); }
    if ((lane & 15) == 0) { const int q = lane >> 4;
#pragma unroll
        for (int i = 0; i < NV / 4; ++i) red[wave * NV + i + q * (NV / 4)] = z[i]; }
    __syncthreads();
    if (tid < NV) { float s = 0.f;
#pragma unroll
        for (int w = 0; w < NWAVES; ++w) s += red[w * NV + tid];
        tot[tid] = s; }
    __syncthreads();
}
struct LnLds { LAS float* red; LAS float* tot; LAS float* sab; LAS int* lcnt; LAS int* lbase; LAS int* lcls; LAS int* lrank; LAS float* lg; LAS float* rowtab; };
__device__ __forceinline__ LnLds ln_lds(const Frame& F) { LnLds L; L.red = (LAS float*)F.lds; L.tot = L.red + 8 * 72; L.sab = L.tot + 72; L.lcnt = (LAS int*)(L.sab + 32); L.lbase = L.lcnt + 32; L.lcls = L.lbase + 32; L.lrank = L.lcls + 256; L.lg = (LAS float*)(L.lrank + 256); L.rowtab = L.lg + 512; return L; }

template <bool HIN_F32> __device__ __forceinline__ void ln1_router_phase(const Frame& F, int layer, const void* hin_, const bf16* ymix, bf16* u2out, bf16* hout) {
    const float* hin = (const float*)hin_; const bf16* hinb = (const bf16*)hin_;
    const LnLds L = ln_lds(F);
    const int tid = F.tid, lane = F.lane, wave = F.wave, c0 = 4 * tid;
    int per = (MTOK + F.G - 1) / F.G; per = (per + 7) & ~7;
    const int rbase = F.bid * per; const int rend = (rbase + per < MTOK) ? rbase + per : MTOK; const int nrows = rend - rbase;
    if (tid < NCLS) L.lcnt[tid] = 0;
    if (nrows > 0 && nrows <= 256) {
    const int b = rbase / SEQ;
    const f32x4 g1 = *(const f32x4*)(mod_ptr(F, layer, b, 2) + c0), sh2 = *(const f32x4*)(mod_ptr(F, layer, b, 3) + c0), sc2 = *(const f32x4*)(mod_ptr(F, layer, b, 4) + c0);
    const f32x4 A0 = *(const f32x4*)(AIN(I_LN1G) + layer * DM + c0), B0 = *(const f32x4*)(AIN(I_LN1B) + layer * DM + c0);
    const f32x4 A1 = A0 * (sc2 + 1.f), B1 = B0 * (sc2 + 1.f) + sh2;
    f32x4 P[4][4];
    { float sx[32];
#pragma unroll
      for (int c = 0; c < 4; ++c)
#pragma unroll
          for (int g = 0; g < 4; ++g) { const f32x4 w = *(const f32x4*)(AIN(I_RW) + (size_t)(c0 + c) * NEXP + 4 * g); P[c][g] = w * A1[c];
#pragma unroll
              for (int i = 0; i < 4; ++i) { if (c == 0) { sx[g * 4 + i] = 0.f; sx[16 + g * 4 + i] = 0.f; } sx[g * 4 + i] += w[i] * A1[c]; sx[16 + g * 4 + i] += w[i] * B1[c]; } }
      block_reduce<32>(sx, L.red, L.tot, tid, lane, wave);
      if (tid < 32) L.sab[tid] = L.tot[tid];
      __syncthreads(); }
    const float* rb = AIN(I_RB);
    f32x4 hf[4], hf2[4]; u32x2 hb[4], hb2[4]; u32x2 yv[4], yv2[4];
#define LN_LOADH(k, r_, o) do { if (HIN_F32) hf##k[r_] = *(const f32x4*)(hin + (o)); else hb##k[r_] = *(const u32x2*)(hinb + (o)); } while (0)
#pragma unroll
    for (int r = 0; r < 4; ++r) { const size_t o = (size_t)(rbase + r) * DM + c0; LN_LOADH(, r, o); yv[r] = *(const u32x2*)(ymix + o); }
    { const int pr0 = (rbase + 4 < rend) ? rbase + 4 : rend - 4;
#pragma unroll
      for (int r = 0; r < 4; ++r) { const size_t o = (size_t)(pr0 + r) * DM + c0; LN_LOADH(2, r, o); yv2[r] = *(const u32x2*)(ymix + o); } }
#define LN1_GROUP(HF, HB, YV, ROW0) do { \
        f32x4 v[4]; float x[72]; \
        _Pragma("unroll") for (int r = 0; r < 4; ++r) { const f32x4 y = {bflo(YV[r].x), bfhi(YV[r].x), bflo(YV[r].y), bfhi(YV[r].y)}; \
            const f32x4 hq = HIN_F32 ? HF[r] : (f32x4){bflo(HB[r].x), bfhi(HB[r].x), bflo(HB[r].y), bfhi(HB[r].y)}; \
            v[r] = hq * DN_ALPHA + g1 * y; \
            x[r * 18] = (v[r][0] + v[r][1]) + (v[r][2] + v[r][3]); x[r * 18 + 1] = (v[r][0] * v[r][0] + v[r][1] * v[r][1]) + (v[r][2] * v[r][2] + v[r][3] * v[r][3]); \
            _Pragma("unroll") for (int g = 0; g < 4; ++g) { const f32x4 q = P[0][g] * v[r][0] + P[1][g] * v[r][1] + P[2][g] * v[r][2] + P[3][g] * v[r][3]; \
                x[r * 18 + 2 + 4 * g] = q[0]; x[r * 18 + 3 + 4 * g] = q[1]; x[r * 18 + 4 + 4 * g] = q[2]; x[r * 18 + 5 + 4 * g] = q[3]; } } \
        { const int pr0 = ((ROW0) + 8 < rend) ? (ROW0) + 8 : rend - 4; \
          _Pragma("unroll") for (int r = 0; r < 4; ++r) { const size_t o = (size_t)(pr0 + r) * DM + c0; if (HIN_F32) HF[r] = *(const f32x4*)(hin + o); else HB[r] = *(const u32x2*)(hinb + o); YV[r] = *(const u32x2*)(ymix + o); } } \
        LAS float* gt = L.rowtab + (((ROW0) - rbase) >> 2) * 72; \
        block_reduce<72>(x, L.red, gt, tid, lane, wave); \
        _Pragma("unroll") for (int r = 0; r < 4; ++r) { const float mean = gt[r * 18] * (1.f / DM); const float var = gt[r * 18 + 1] * (1.f / DM) - mean * mean; const float rstd = 1.f / sqrtf(var + LN_EPS); \
            const f32x4 vn = (v[r] - mean) * rstd; const f32x4 hn = vn * A0 + B0, u = vn * A1 + B1; const size_t o = (size_t)((ROW0) + r) * DM + c0; \
            u32x2 hw; hw.x = cvt_pk_bf16(hn[0], hn[1]); hw.y = cvt_pk_bf16(hn[2], hn[3]); *(u32x2*)(hout + o) = hw; u32x2 w; w.x = cvt_pk_bf16(u[0], u[1]); w.y = cvt_pk_bf16(u[2], u[3]); *(u32x2*)(u2out + o) = w; } \
    } while (0)
    for (int row0 = rbase; row0 < rend; row0 += 8) { LN1_GROUP(hf, hb, yv, row0); LN1_GROUP(hf2, hb2, yv2, row0 + 4); }
#undef LN1_GROUP
    __syncthreads();
    if (tid < nrows) {
            const int rl = tid; const LAS float* gt = L.rowtab + (rl >> 2) * 72 + (rl & 3) * 18;
            const float mean = gt[0] * (1.f / DM); const float var = gt[1] * (1.f / DM) - mean * mean; const float rstd = 1.f / sqrtf(var + LN_EPS);
            float sg[16], sel[16];
#pragma unroll
            for (int e = 0; e < 16; ++e) { const float lgt = rstd * (gt[2 + e] - mean * L.sab[e]) + L.sab[16 + e]; const float sv = 1.f / (1.f + expf(-lgt)); sg[e] = sv; sel[e] = sv + rb[e]; }
            int gb = 0; float gbs = -INFINITY;
#pragma unroll
            for (int g = 0; g < 4; ++g) { const float a = sel[4 * g], bq = sel[4 * g + 1], c = sel[4 * g + 2], d = sel[4 * g + 3];
                const float ps = fmaxf(fmaxf(fmaxf(a + bq, a + c), fmaxf(a + d, bq + c)), fmaxf(bq + d, c + d)); if (ps > gbs) { gbs = ps; gb = g; } }
            float cs[4], cg[4];
#pragma unroll
            for (int i = 0; i < 4; ++i) { cs[i] = sel[i]; cg[i] = sg[i];
#pragma unroll
                for (int g = 1; g < 4; ++g) if (gb == g) { cs[i] = sel[4 * g + i]; cg[i] = sg[4 * g + i]; } }
            int i0 = 0; float b0 = cs[0];
#pragma unroll
            for (int i = 1; i < 4; ++i) if (cs[i] > b0) { b0 = cs[i]; i0 = i; }
            int i1 = -1; float b1 = -INFINITY;
#pragma unroll
            for (int i = 0; i < 4; ++i) if (i != i0 && cs[i] > b1) { b1 = cs[i]; i1 = i; }
            float ga = 0.f, gbv = 0.f;
#pragma unroll
            for (int i = 0; i < 4; ++i) { if (i == i0) ga = cg[i]; if (i == i1) gbv = cg[i]; }
            const float den = ga + gbv; ga /= den; gbv /= den;
            const int lo = i0 < i1 ? i0 : i1, hi = i0 < i1 ? i1 : i0; const float glo = i0 < i1 ? ga : gbv, ghi = i0 < i1 ? gbv : ga;
            const int pidx = (lo == 0) ? (hi - 1) : (lo == 1 ? hi + 1 : 5);
            const int cls = gb * 6 + pidx;
            L.lcls[rl] = cls; L.lrank[rl] = __hip_atomic_fetch_add(&L.lcnt[cls], 1, __ATOMIC_RELAXED, __HIP_MEMORY_SCOPE_WORKGROUP); L.lg[2 * rl] = glo; L.lg[2 * rl + 1] = ghi;
    }
    }
    __syncthreads();
    if (tid < NCLS) L.lbase[tid] = (int)__hip_atomic_fetch_add((unsigned*)(F.ctl + CW_CNT + (layer * NCLS + tid) * 64), (unsigned)L.lcnt[tid], RLX_AGENT);
    __syncthreads();
    if (tid < nrows && nrows <= 256) { const int cls = L.lcls[tid]; const int pos = cls * LCAP + L.lbase[cls] + L.lrank[tid];
        ((int*)(F.ws + WS_TOK))[pos] = rbase + tid; ((float*)(F.ws + WS_GATE))[pos] = L.lg[2 * tid]; ((float*)(F.ws + WS_GATE))[(size_t)NCLS * LCAP + pos] = L.lg[2 * tid + 1]; }
}
#undef LN_LOADH
template <bool OUT_F32> __device__ __forceinline__ void ln2_phase(const Frame& F, int layer, bf16* fio, const bf16* hinb, void* hout_) {
    float* houtf = (float*)hout_; bf16* houtb = (bf16*)hout_;
    const LnLds L = ln_lds(F);
    const int tid = F.tid, lane = F.lane, wave = F.wave, c0 = 4 * tid;
    int per = (MTOK + F.G - 1) / F.G; per = (per + 3) & ~3;
    const int rbase = F.bid * per; const int rend = (rbase + per < MTOK) ? rbase + per : MTOK;
    if (rbase >= rend) return;
    const int b = rbase / SEQ;
    const f32x4 g2 = *(const f32x4*)(mod_ptr(F, layer, b, 5) + c0), sh1 = *(const f32x4*)(mod_ptr(F, 1, b, 0) + c0), sc1 = *(const f32x4*)(mod_ptr(F, 1, b, 1) + c0);
    const f32x4 A0 = *(const f32x4*)(AIN(I_LN2G) + layer * DM + c0), B0 = *(const f32x4*)(AIN(I_LN2B) + layer * DM + c0);
    const f32x4 A1 = A0 * (sc1 + 1.f), B1 = B0 * (sc1 + 1.f) + sh1;
    u32x2 hw[4], hw2[4], hw3[4]; u32x2 yv[4], yv2[4], yv3[4];
#pragma unroll
    for (int r = 0; r < 4; ++r) { const size_t o = (size_t)(rbase + r) * DM + c0; hw[r] = *(const u32x2*)(hinb + o); yv[r] = *(const u32x2*)(fio + o); }
#pragma unroll
    for (int r = 0; r < 4; ++r) { const size_t o = (size_t)(rbase + 4 + r) * DM + c0; if (rbase + 4 < rend) { hw2[r] = *(const u32x2*)(hinb + o); yv2[r] = *(const u32x2*)(fio + o); } }
#pragma unroll
    for (int r = 0; r < 4; ++r) { const size_t o = (size_t)(rbase + 8 + r) * DM + c0; if (rbase + 8 < rend) { hw3[r] = *(const u32x2*)(hinb + o); yv3[r] = *(const u32x2*)(fio + o); } }
    for (int row0 = rbase; row0 < rend; row0 += 4) {
        f32x4 v[4]; float x[8];
#pragma unroll
        for (int r = 0; r < 4; ++r) { const f32x4 y = {bflo(yv[r].x), bfhi(yv[r].x), bflo(yv[r].y), bfhi(yv[r].y)}; const f32x4 hvr = {bflo(hw[r].x), bfhi(hw[r].x), bflo(hw[r].y), bfhi(hw[r].y)}; v[r] = hvr * DN_ALPHA + g2 * y;
            x[r * 2] = (v[r][0] + v[r][1]) + (v[r][2] + v[r][3]); x[r * 2 + 1] = (v[r][0] * v[r][0] + v[r][1] * v[r][1]) + (v[r][2] * v[r][2] + v[r][3] * v[r][3]); }
#pragma unroll
        for (int r = 0; r < 4; ++r) { hw[r] = hw2[r]; yv[r] = yv2[r]; hw2[r] = hw3[r]; yv2[r] = yv3[r]; }
        if (row0 + 12 < rend) {
#pragma unroll
            for (int r = 0; r < 4; ++r) { const size_t o = (size_t)(row0 + 12 + r) * DM + c0; hw3[r] = *(const u32x2*)(hinb + o); yv3[r] = *(const u32x2*)(fio + o); } }
        block_reduce<8>(x, L.red, L.tot, tid, lane, wave);
#pragma unroll
        for (int r = 0; r < 4; ++r) { const float mean = L.tot[r * 2] * (1.f / DM); const float var = L.tot[r * 2 + 1] * (1.f / DM) - mean * mean; const float rstd = 1.f / sqrtf(var + LN_EPS);
            const f32x4 vn = (v[r] - mean) * rstd; const f32x4 hn = vn * A0 + B0; const size_t o = (size_t)(row0 + r) * DM + c0;
            if (OUT_F32) *(f32x4*)(houtf + o) = hn; else { u32x2 hw; hw.x = cvt_pk_bf16(hn[0], hn[1]); hw.y = cvt_pk_bf16(hn[2], hn[3]); *(u32x2*)(houtb + o) = hw; }
            if (layer == 0) { const f32x4 u = vn * A1 + B1; u32x2 w; w.x = cvt_pk_bf16(u[0], u[1]); w.y = cvt_pk_bf16(u[2], u[3]); *(u32x2*)(fio + o) = w; } }
    }
}
namespace hy {
constexpr int L = SEQ;
__device__ constexpr float C32[16] = {1.000000000e+00f, 9.807852804e-01f, 9.238795325e-01f, 8.314696123e-01f, 7.071067812e-01f, 5.555702330e-01f, 3.826834324e-01f, 1.950903220e-01f,
                                      0.f, -1.950903220e-01f, -3.826834324e-01f, -5.555702330e-01f, -7.071067812e-01f, -8.314696123e-01f, -9.238795325e-01f, -9.807852804e-01f};
__device__ constexpr float S32[16] = {0.f, 1.950903220e-01f, 3.826834324e-01f, 5.555702330e-01f, 7.071067812e-01f, 8.314696123e-01f, 9.238795325e-01f, 9.807852804e-01f,
                                      1.f, 9.807852804e-01f, 9.238795325e-01f, 8.314696123e-01f, 7.071067812e-01f, 5.555702330e-01f, 3.826834324e-01f, 1.950903220e-01f};
__host__ __device__ constexpr int brev(int k, int bits) { int r = 0; for (int i = 0; i < bits; ++i) r |= ((k >> i) & 1) << (bits - 1 - i); return r; }
__device__ __forceinline__ void unit_root(float frac, bool inv, float& wr, float& wi) {
    wr = __builtin_amdgcn_cosf(frac); float s = __builtin_amdgcn_sinf(frac);
    asm volatile("s_nop 1" : "+v"(wr), "+v"(s));
    wi = inv ? s : -s;
}
constexpr int FT_F32 = 0, FT_I32 = 8, FT_I32P = 16, FT_F16 = 24, FT_I16 = 26, FT_NFRAG = 28;
__device__ __forceinline__ int crow(int r, int h) { return (r & 3) + 8 * (r >> 2) + 4 * h; }
__device__ __forceinline__ bf16x8 pack8(const float (&v)[8]) { u32x4 w; w.x = cvt_pk_bf16(v[0], v[1]); w.y = cvt_pk_bf16(v[2], v[3]); w.z = cvt_pk_bf16(v[4], v[5]); w.w = cvt_pk_bf16(v[6], v[7]); return __builtin_bit_cast(bf16x8, w); }
__device__ __forceinline__ void cmul(float& xr, float& xi, float wr, float wi) {
    float t0, t1, nr, ni;
    asm("v_mul_f32_e32 %0, %1, %2" : "=v"(t0) : "v"(xi), "v"(wi));
    asm("v_mul_f32_e32 %0, %1, %2" : "=v"(t1) : "v"(xi), "v"(wr));
    asm("v_fma_f32 %0, %1, %2, -%3" : "=v"(nr) : "v"(xr), "v"(wr), "v"(t0));
    asm("v_fma_f32 %0, %1, %2, %3" : "=v"(ni) : "v"(xr), "v"(wi), "v"(t1));
    xr = nr; xi = ni;
}
#define FRAG(f) (tab[(f) * 64 + lane])
template <bool INV> __device__ __forceinline__ void pass1(LAS f32x2* dat, const LAS bf16x8* tab, int lane, int wave) {
    asm volatile("" : "+v"(lane));
    const int h = lane >> 5, c5 = lane & 31;
    const bf16x8 a0 = FRAG((INV ? FT_I16 : FT_F16) + 0), a1 = FRAG((INV ? FT_I16 : FT_F16) + 1);
#pragma unroll 1
    for (int g = 0; g < 4; ++g) {
        const int col = 128 * wave + 32 * g + c5; const int pc = col ^ ((4 * wave + g) & 31) ^ ((2 * g + (c5 >> 4)) & 7);
        float wr, wi; unit_root((float)col * (1.f / 16384.f), INV, wr, wi);
        float w2r = wr, w2i = wi; cmul(w2r, w2i, wr, wi); float w4r = w2r, w4i = w2i; cmul(w4r, w4i, w2r, w2i); float w8r = w4r, w8i = w4i; cmul(w8r, w8i, w4r, w4i);
        float re[8], im[8];
#pragma unroll
        for (int jj = 0; jj < 8; ++jj) { const f32x2 v = dat[pc + 1024 * (8 * h + jj)]; re[jj] = v.x; im[jj] = v.y; }
        if (INV) {
            float cr = h ? w8r : 1.f, ci = h ? w8i : 0.f;
#pragma unroll
            for (int jj = 0; jj < 8; ++jj) { cmul(re[jj], im[jj], cr, ci); cmul(cr, ci, wr, wi); }
        }
        const f32x16 z = {};
        f32x16 d = __builtin_amdgcn_mfma_f32_32x32x16_bf16(a0, pack8(re), z, 0, 0, 0);
        d = __builtin_amdgcn_mfma_f32_32x32x16_bf16(a1, pack8(im), d, 0, 0, 0);
        asm volatile("s_nop 15\n\ts_nop 7" : "+v"(d));
        float cr = h ? w4r : 1.f, ci = h ? w4i : 0.f;
#pragma unroll
        for (int rr = 0; rr < 8; ++rr) { float xr = d[rr], xi = d[rr + 8];
            if (!INV) { if (rr == 4) { cr = h ? w4r : 1.f; ci = h ? w4i : 0.f; cmul(cr, ci, w8r, w8i); } cmul(xr, xi, cr, ci); cmul(cr, ci, wr, wi); }
            f32x2 o; o.x = xr; o.y = xi; dat[pc + 1024 * ((rr & 3) + 8 * (rr >> 2) + 4 * h)] = o; }
    }
}
template <bool INV> __device__ __forceinline__ void pass2(LAS f32x2* dat, const LAS bf16x8* tab, int lane, int wave) {
    asm volatile("" : "+v"(lane));
    const int h = lane >> 5, b = lane & 31, bp = b ^ (b >> 4);
    float wr, wi; unit_root((float)b * (1.f / 1024.f), INV, wr, wi);
    float w2r = wr, w2i = wi; cmul(w2r, w2i, wr, wi); float w4r = w2r, w4i = w2i; cmul(w4r, w4i, w2r, w2i); float w8r = w4r, w8i = w4i; cmul(w8r, w8i, w4r, w4i); float w16r = w8r, w16i = w8i; cmul(w16r, w16i, w8r, w8i);
#pragma unroll 1
    for (int g = 0; g < 2; ++g) {
        const int base = (2 * wave + g) * 1024;
        float re[2][8], im[2][8];
#pragma unroll
        for (int hf = 0; hf < 2; ++hf)
#pragma unroll
            for (int jj = 0; jj < 8; ++jj) { const int n = 16 * hf + 8 * h + jj; const f32x2 v = dat[base + 32 * n + (bp ^ (16 * hf + 8 * h + (jj ^ ((2 * jj) & 7))))]; re[hf][jj] = v.x; im[hf][jj] = v.y; }
        if (INV) {
            float cr = h ? w8r : 1.f, ci = h ? w8i : 0.f;
#pragma unroll
            for (int jj = 0; jj < 8; ++jj) { cmul(re[0][jj], im[0][jj], cr, ci); float dr = cr, di = ci; cmul(dr, di, w16r, w16i); cmul(re[1][jj], im[1][jj], dr, di); cmul(cr, ci, wr, wi); }
        }
        const bf16x8 b0 = pack8(re[0]), b1 = pack8(re[1]), b2 = pack8(im[0]), b3 = pack8(im[1]);
        const int fb = INV ? FT_I32 : FT_F32; const f32x16 z = {};
        f32x16 dre = __builtin_amdgcn_mfma_f32_32x32x16_bf16(FRAG(fb + 0), b0, z, 0, 0, 0); f32x16 dim = __builtin_amdgcn_mfma_f32_32x32x16_bf16(FRAG(fb + 4), b0, z, 0, 0, 0);
        dre = __builtin_amdgcn_mfma_f32_32x32x16_bf16(FRAG(fb + 1), b1, dre, 0, 0, 0); dim = __builtin_amdgcn_mfma_f32_32x32x16_bf16(FRAG(fb + 5), b1, dim, 0, 0, 0);
        dre = __builtin_amdgcn_mfma_f32_32x32x16_bf16(FRAG(fb + 2), b2, dre, 0, 0, 0); dim = __builtin_amdgcn_mfma_f32_32x32x16_bf16(FRAG(fb + 6), b2, dim, 0, 0, 0);
        dre = __builtin_amdgcn_mfma_f32_32x32x16_bf16(FRAG(fb + 3), b3, dre, 0, 0, 0); dim = __builtin_amdgcn_mfma_f32_32x32x16_bf16(FRAG(fb + 7), b3, dim, 0, 0, 0);
        asm volatile("s_nop 15\n\ts_nop 7" : "+v"(dre), "+v"(dim));
        float gr = h ? w4r : 1.f, gi = h ? w4i : 0.f;
#pragma unroll
        for (int r = 0; r < 16; ++r) { float xr = dre[r], xi = dim[r]; const int kf = (r & 3) + 8 * (r >> 2) + 4 * h;
            if (!INV) { float cr = gr, ci = gi; if ((r & 3) == 1) cmul(cr, ci, wr, wi); if ((r & 3) == 2) cmul(cr, ci, w2r, w2i); if ((r & 3) == 3) { cmul(cr, ci, w2r, w2i); cmul(cr, ci, wr, wi); }
                cmul(xr, xi, cr, ci); if ((r & 3) == 3) cmul(gr, gi, w8r, w8i); }
            f32x2 o; o.x = xr; o.y = xi; dat[base + 32 * kf + (bp ^ kf ^ (2 * (r & 3)))] = o; }
    }
}
template <bool FILTER> __device__ __forceinline__ void pass3(LAS f32x2* dat, const LAS bf16x8* tab, int lane, int wave, const int g, f32x2* Kbuf, const f32x2 (&kpre)[16]) {
    asm volatile("" : "+v"(lane));
    const int h = lane >> 5, sw = lane & 31, swp = sw ^ (2 * (sw & 3));
    {
        const int q = 64 * wave + 32 * g + sw, base = 32 * q;
        float re[2][8], im[2][8];
#pragma unroll
        for (int hf = 0; hf < 2; ++hf)
#pragma unroll
            for (int jj = 0; jj < 8; ++jj) { const int n = 16 * hf + 8 * h + jj; const f32x2 v = dat[base + (n ^ swp ^ hf)]; re[hf][jj] = v.x; im[hf][jj] = v.y; }
        const bf16x8 b0 = pack8(re[0]), b1 = pack8(re[1]), b2 = pack8(im[0]), b3 = pack8(im[1]);
        const f32x16 z = {};
        f32x16 dre = __builtin_amdgcn_mfma_f32_32x32x16_bf16(FRAG(FT_F32 + 0), b0, z, 0, 0, 0); f32x16 dim = __builtin_amdgcn_mfma_f32_32x32x16_bf16(FRAG(FT_F32 + 4), b0, z, 0, 0, 0);
        dre = __builtin_amdgcn_mfma_f32_32x32x16_bf16(FRAG(FT_F32 + 1), b1, dre, 0, 0, 0); dim = __builtin_amdgcn_mfma_f32_32x32x16_bf16(FRAG(FT_F32 + 5), b1, dim, 0, 0, 0);
        dre = __builtin_amdgcn_mfma_f32_32x32x16_bf16(FRAG(FT_F32 + 2), b2, dre, 0, 0, 0); dim = __builtin_amdgcn_mfma_f32_32x32x16_bf16(FRAG(FT_F32 + 6), b2, dim, 0, 0, 0);
        dre = __builtin_amdgcn_mfma_f32_32x32x16_bf16(FRAG(FT_F32 + 3), b3, dre, 0, 0, 0); dim = __builtin_amdgcn_mfma_f32_32x32x16_bf16(FRAG(FT_F32 + 7), b3, dim, 0, 0, 0);
        asm volatile("s_nop 15\n\ts_nop 7" : "+v"(dre), "+v"(dim));
        if (FILTER) {
#pragma unroll
            for (int r = 0; r < 16; ++r) { f32x2 o; o.x = dre[r]; o.y = dim[r]; Kbuf[((r & 3) + 8 * (r >> 2) + 4 * h) * 512 + q] = o; }
        } else {
            float yr[16], yi[16];
#pragma unroll
            for (int r = 0; r < 16; ++r) { const f32x2 kv = kpre[r]; float a_ = dre[r], b_ = dim[r]; cmul(a_, b_, kv.x, kv.y); yr[r] = a_; yi[r] = b_; }
            float t0[8], t1[8], t2[8], t3[8];
#pragma unroll
            for (int j = 0; j < 8; ++j) { t0[j] = yr[j]; t1[j] = yr[8 + j]; t2[j] = yi[j]; t3[j] = yi[8 + j]; }
            const bf16x8 c0 = pack8(t0), c1 = pack8(t1), c2 = pack8(t2), c3 = pack8(t3);
            f32x16 ere = __builtin_amdgcn_mfma_f32_32x32x16_bf16(FRAG(FT_I32P + 0), c0, z, 0, 0, 0); f32x16 eim = __builtin_amdgcn_mfma_f32_32x32x16_bf16(FRAG(FT_I32P + 4), c0, z, 0, 0, 0);
            ere = __builtin_amdgcn_mfma_f32_32x32x16_bf16(FRAG(FT_I32P + 1), c1, ere, 0, 0, 0); eim = __builtin_amdgcn_mfma_f32_32x32x16_bf16(FRAG(FT_I32P + 5), c1, eim, 0, 0, 0);
            ere = __builtin_amdgcn_mfma_f32_32x32x16_bf16(FRAG(FT_I32P + 2), c2, ere, 0, 0, 0); eim = __builtin_amdgcn_mfma_f32_32x32x16_bf16(FRAG(FT_I32P + 6), c2, eim, 0, 0, 0);
            ere = __builtin_amdgcn_mfma_f32_32x32x16_bf16(FRAG(FT_I32P + 3), c3, ere, 0, 0, 0); eim = __builtin_amdgcn_mfma_f32_32x32x16_bf16(FRAG(FT_I32P + 7), c3, eim, 0, 0, 0);
#pragma unroll
            for (int r = 0; r < 16; ++r) { f32x2 o; o.x = ere[r]; o.y = eim[r]; dat[base + ((((r & 3) + 8 * (r >> 2) + 4 * h)) ^ swp ^ (r >> 3))] = o; }
        }
    }
}
#undef FRAG
__device__ __forceinline__ float ftab_value(int f, int l, int jj) {
    const int r = l & 31, h = l >> 5;
    if (f < 24) {
        const int kind = f >> 3, rb = (f >> 2) & 1, s = f & 3; int kk, pp;
        if (kind < 2) { kk = 16 * (s & 1) + 8 * h + jj; pp = s >> 1; } else { kk = 16 * (s & 1) + 8 * (jj >> 2) + 4 * h + (jj & 3); pp = s >> 1; }
        const float th = 6.283185307179586f * (float)((r * kk) & 31) * (1.f / 32.f); const float c = cosf(th), sn = sinf(th);
        if (kind == 0) return rb == 0 ? (pp == 0 ? c : sn) : (pp == 0 ? -sn : c);
        return rb == 0 ? (pp == 0 ? c : -sn) : (pp == 0 ? sn : c);
    }
    const int inv = (f - 24) >> 1, s = (f - 24) & 1; const int part = r >> 4, kf = r & 15, n = 8 * h + jj;
    const float th = 6.283185307179586f * (float)((kf * n) & 15) * (1.f / 16.f); const float c = cosf(th), sn = sinf(th);
    if (!inv) return part == 0 ? (s == 0 ? c : sn) : (s == 0 ? -sn : c);
    return part == 0 ? (s == 0 ? c : -sn) : (s == 0 ? sn : c);
}
__device__ __forceinline__ int phys(int p) { return p ^ ((p >> 5) & 31) ^ ((p >> 4) & 7); }
__device__ __forceinline__ void unpack8(const u32x4 v, float (&f)[8]) { f[0] = bflo(v.x); f[1] = bfhi(v.x); f[2] = bflo(v.y); f[3] = bfhi(v.y); f[4] = bflo(v.z); f[5] = bfhi(v.z); f[6] = bflo(v.w); f[7] = bfhi(v.w); }
struct Raw8 { u32x4 v; unsigned l, r; };
__device__ __forceinline__ Raw8 load_raw8(const bf16* rowp, int t0) { Raw8 q; q.v = *(const u32x4*)(rowp + t0); q.l = (t0 > 0) ? (unsigned)rowp[t0 - 1] : 0u; q.r = (t0 + 8 < L) ? (unsigned)rowp[t0 + 8] : 0u; return q; }
__device__ __forceinline__ void conv8(const Raw8& q, float w0, float w1, float w2, float cb, float (&o)[8]) {
    float f[8]; unpack8(q.v, f); const float left = bf2f(q.l), right = bf2f(q.r);
#pragma unroll
    for (int e = 0; e < 8; ++e) { const float a = (e == 0) ? left : f[e - 1], c = (e == 7) ? right : f[e + 1]; o[e] = w0 * a + w1 * f[e] + w2 * c + cb; }
}
typedef const LAS float* ChanPar;
struct RawZ { Raw8 x[2], v[2]; };
__device__ __forceinline__ RawZ load_rawz(const bf16* pT, int d, int t0) { RawZ q;
#pragma unroll
    for (int bt = 0; bt < 2; ++bt) { q.x[bt] = load_raw8(pT + (size_t)(DM + d) * MTOK + bt * L, t0); q.v[bt] = load_raw8(pT + (size_t)(2 * DM + d) * MTOK + bt * L, t0); }
    return q; }
__device__ __forceinline__ void z_from_raw(const RawZ& q, ChanPar P, float (&z0)[8], float (&z1)[8]) {
#pragma unroll
    for (int bt = 0; bt < 2; ++bt) { float a[8], v[8];
        conv8(q.x[bt], P[4], P[5], P[6], P[7], a); conv8(q.v[bt], P[8], P[9], P[10], P[11], v);
#pragma unroll
        for (int e = 0; e < 8; ++e) { if (bt == 0) z0[e] = a[e] * v[e]; else z1[e] = a[e] * v[e]; } }
}
struct RawF { u32x4 hf, hb; unsigned first; };
__device__ __forceinline__ RawF load_rawf(const bf16* HT, int d, int t0) { RawF q; q.hf = *(const u32x4*)(HT + (size_t)d * L + t0); q.hb = *(const u32x4*)(HT + (size_t)(DM + d) * L + (L - t0 - 8));
    q.first = (t0 > 0) ? (unsigned)HT[(size_t)(DM + d) * L + (L - t0)] : 0u; return q; }
__device__ __forceinline__ void filt8(const RawF& q, int t0, ChanPar P, float (&k)[8], float (&kl)[8], float& l1p) {
    float hf[8], hb[8]; unpack8(q.hf, hf); unpack8(q.hb, hb);
    float s = 0.f;
#pragma unroll
    for (int e = 0; e < 8; ++e) { const float dc = __builtin_amdgcn_exp2f(-(float)(t0 + e) * P[13]); k[e] = hf[e] * dc; s += fabsf(k[e]); }
    float hbd[8];
#pragma unroll
    for (int e = 0; e < 8; ++e) { const int m = L - t0 - 8 + e; const float dc = __builtin_amdgcn_exp2f(-(float)m * P[13]); hbd[e] = hb[e] * dc; if (m >= 1) s += fabsf(hbd[e]); }
    kl[0] = (t0 > 0) ? bf2f(q.first) * __builtin_amdgcn_exp2f(-(float)(L - t0) * P[13]) : 0.f;
#pragma unroll
    for (int e = 1; e < 8; ++e) kl[e] = hbd[8 - e];
#pragma unroll
    for (int e = 0; e < 8; ++e) { k[e] *= P[14]; kl[e] *= P[14]; }
    l1p = s;
}
__device__ __forceinline__ void hyena_phase(const Frame& F) {
    LAS f32x2* dat = (LAS f32x2*)F.lds; LAS float* redu = (LAS float*)(F.lds + RING_BYTES);
    const bf16* pT = (const bf16*)(F.ws + WS_B); const bf16* HT = (const bf16*)(F.ws + WS_HT); bf16* yT = (bf16*)(F.ws + WS_A);
    const LAS bf16x8* tab = (const LAS bf16x8*)(F.lds + FTAB_OFF);
    for (int i = F.tid; i < FT_NFRAG * 64; i += NTHR) ((LAS u32x4*)(F.lds + FTAB_OFF))[i] = ((const u32x4*)(F.ws + WS_FTAB))[i];
    __syncthreads();
    f32x2* Ke = (f32x2*)(F.ws + WS_FFTS) + (size_t)F.bid * 49152; f32x2* Ko = Ke + 16384; f32x2* SeB = Ke + 32768;
    RawF rf[4];
    { const int tq = fresh_tid(F.wave); if (F.bid < DM) {
#pragma unroll
        for (int sI = 0; sI < 4; ++sI) rf[sI] = load_rawf((const bf16*)(F.ws + WS_HT), F.bid, 8 * (tq + 512 * sI)); } }
    const int cv_gw = F.bid * NWAVES + F.wave, cv_ngw = F.G * NWAVES; int cv_it = cv_gw; constexpr int CV_NIT = 48 * 1024;
    for (int d = F.bid; d < DM; d += F.G) {
        int tid = fresh_tid(F.wave);
        TPS_START(1);
        LAS float* PW = (LAS float*)(F.lds + RING_BYTES + 64); ChanPar P = PW;
        __syncthreads();
        if (tid < 12) { const int i = tid & 3, pj = tid >> 2; PW[tid] = (i < 3) ? AIN(I_HCW)[i * 3 * DM + pj * DM + d] : AIN(I_HCB)[pj * DM + d]; }
        if (tid == 12) PW[12] = AIN(I_FBIAS)[d];
        if (tid == 13) { const float mind = -4.605170185988091f / 1.5f, maxd = -4.605170185988091f / 0.3f; const float delta = fabsf(mind + (maxd - mind) * ((float)d / (float)(DM - 1)));
            PW[13] = delta * (1.f / (float)(L - 1)) * 1.4426950408889634f; PW[14] = 1.f; }
        __syncthreads();
        TPS_STOP(1); TPS_START(2);
#pragma unroll 1
        for (int odd = 0; odd < 2; ++odd) {
            asm volatile("" : "+v"(tid));
            float l1s = 0.f;
#pragma unroll
            for (int sI = 0; sI < 4; ++sI) { const int t0 = 8 * (tid + 512 * sI); float k[8], kl[8], l1p; filt8(rf[sI], t0, P, k, kl, l1p); l1s += l1p;
#pragma unroll
                for (int e = 0; e < 8; ++e) { f32x2 o; if (!odd) { o.x = k[e] + kl[e]; o.y = 0.f; } else { const float a = k[e] - kl[e]; float wr, wi; unit_root((float)(t0 + e) * (1.f / 32768.f), false, wr, wi); o.x = a * wr; o.y = a * wi; }
                    dat[phys(t0 + e)] = o; } }
            if (!odd) { l1s = wave_sum(l1s); if (F.lane == 0) redu[F.wave] = l1s; }
            __syncthreads();
            if (!odd && tid == 0) { float tot = 0.f;
#pragma unroll
                for (int w = 0; w < NWAVES; ++w) tot += redu[w];
                PW[15] = 1.f / tot; }
            pass1<false>(dat, tab, F.lane, F.wave); __syncthreads(); pass2<false>(dat, tab, F.lane, F.wave); { f32x2 kdummy[16]; pass3<true>(dat, tab, F.lane, F.wave, 0, odd ? Ko : Ke, kdummy); asm volatile("" ::: "memory"); pass3<true>(dat, tab, F.lane, F.wave, 1, odd ? Ko : Ke, kdummy); } __syncthreads();
        }
        TPS_STOP(2); TPS_START(3);
        unsigned zp[4][8];
        const bool cvb3 = (cv_it + 2 * cv_ngw < CV_NIT);
        const ConvItem ia = moe_l1_item(F, cvb3 ? cv_it : 0), ib = moe_l1_item(F, cvb3 ? cv_it + cv_ngw : 0), ic = moe_l1_item(F, cvb3 ? cv_it + 2 * cv_ngw : 0);
#pragma unroll
        for (int odd = 0; odd < 2; ++odd) {
            asm volatile("" : "+v"(tid));
            TPS_START(6);
            if (!odd) {
                RawZ rz[4];
#pragma unroll
                for (int sI = 0; sI < 4; ++sI) rz[sI] = load_rawz(pT, d, 8 * (tid + 512 * sI));
#pragma unroll
                for (int sI = 0; sI < 4; ++sI) { const int t0 = 8 * (tid + 512 * sI); float z0[8], z1[8]; z_from_raw(rz[sI], P, z0, z1);
#pragma unroll
                    for (int e = 0; e < 8; ++e) { f32x2 o; o.x = z0[e]; o.y = z1[e]; zp[sI][e] = cvt_pk_bf16(z0[e], z1[e]); dat[phys(t0 + e)] = o; } }
            } else {
#pragma unroll
                for (int sI = 0; sI < 4; ++sI) { const int t0 = 8 * (tid + 512 * sI);
#pragma unroll
                    for (int e = 0; e < 8; ++e) { const float z0 = bflo(zp[sI][e]), z1 = bfhi(zp[sI][e]); float wr, wi; unit_root((float)(t0 + e) * (1.f / 32768.f), false, wr, wi);
                        f32x2 o; o.x = z0 * wr - z1 * wi; o.y = z0 * wi + z1 * wr; dat[phys(t0 + e)] = o; } }
            }
#ifdef FFT_EXTRA
#pragma unroll 1
            for (int xr = 0; xr < FFT_EXTRA; ++xr) { __syncthreads(); pass2<false>(dat, tab, F.lane, F.wave); __syncthreads(); pass2<true>(dat, tab, F.lane, F.wave); __syncthreads();
#pragma unroll 1
                for (int i = fresh_tid(F.wave); i < L; i += NTHR) { f32x2 v = dat[i]; v.x *= (1.f / 32.f); v.y *= (1.f / 32.f); dat[i] = v; } }
            tid = fresh_tid(F.wave);
#endif
            TPS_STOP(6); TPS_START(5);
            f32x2 kpre0[16], kpre1[16];
            asm volatile("" ::: "memory");
            { const f32x2* Kb = odd ? Ko : Ke; int ln_ = F.lane; asm volatile("" : "+v"(ln_)); const int lq = ln_ & 31, lh = ln_ >> 5; const float il1 = P[15], fb = P[12];
#pragma unroll
              for (int r = 0; r < 16; ++r) { f32x2 k0 = Kb[((r & 3) + 8 * (r >> 2) + 4 * lh) * 512 + 64 * F.wave + lq], k1 = Kb[((r & 3) + 8 * (r >> 2) + 4 * lh) * 512 + 64 * F.wave + 32 + lq];
                  k0.x = k0.x * il1 + fb; k0.y *= il1; k1.x = k1.x * il1 + fb; k1.y *= il1; kpre0[r] = k0; kpre1[r] = k1; } }
            __syncthreads(); pass1<false>(dat, tab, F.lane, F.wave); __syncthreads(); pass2<false>(dat, tab, F.lane, F.wave); pass3<false>(dat, tab, F.lane, F.wave, 0, nullptr, kpre0); asm volatile("" ::: "memory"); pass3<false>(dat, tab, F.lane, F.wave, 1, nullptr, kpre1);
            TPS_STOP(5); TPS_START(7);
            if (odd) { float ca[32], cb[32], cc[32]; const int cvln = fresh_tid(F.wave) & 63;
                conv_issue(ia, cvln, ca); conv_issue(ib, cvln, cb); conv_issue(ic, cvln, cc);
                pass2<true>(dat, tab, F.lane, F.wave); __syncthreads(); pass1<true>(dat, tab, F.lane, F.wave);
                if (cvb3) { conv_finish(ia, cvln, ca); conv_finish(ib, cvln, cb); conv_finish(ic, cvln, cc); cv_it += 3 * cv_ngw; }
                __syncthreads();
            } else { pass2<true>(dat, tab, F.lane, F.wave); __syncthreads(); pass1<true>(dat, tab, F.lane, F.wave); __syncthreads(); }
            TPS_STOP(7);
            if (!odd) {
                asm volatile("" : "+v"(tid));
#pragma unroll 1
                for (int sI = 0; sI < 4; ++sI)
#pragma unroll
                    for (int e = 0; e < 8; ++e) { const f32x2 v = dat[phys(8 * (tid + 512 * sI) + e)]; SeB[e * 2048 + tid + 512 * sI] = v; }
                __syncthreads();
            }
        }
        TPS_STOP(3); TPS_START(4);
        asm volatile("" : "+v"(tid));
        if (d + F.G < DM) {
#pragma unroll
            for (int sI = 0; sI < 4; ++sI) rf[sI] = load_rawf(HT, d + F.G, 8 * (tid + 512 * sI)); }
        { Raw8 rx0[4][2]; f32x2 se[4][8];
#pragma unroll
          for (int sI = 0; sI < 4; ++sI) {
#pragma unroll
              for (int bt = 0; bt < 2; ++bt) rx0[sI][bt] = load_raw8(pT + (size_t)d * MTOK + bt * L, 8 * (tid + 512 * sI));
#pragma unroll
              for (int e = 0; e < 8; ++e) se[sI][e] = SeB[e * 2048 + tid + 512 * sI]; }
#pragma unroll
          for (int sI = 0; sI < 4; ++sI) { const int t0 = 8 * (tid + 512 * sI);
              float o0[8], o1[8];
#pragma unroll
              for (int e = 0; e < 8; ++e) { const f32x2 so = dat[phys(t0 + e)]; float wr, wi; unit_root((float)(t0 + e) * (1.f / 32768.f), true, wr, wi);
                  o0[e] = (se[sI][e].x + so.x * wr - so.y * wi) * (1.f / 32768.f); o1[e] = (se[sI][e].y + so.x * wi + so.y * wr) * (1.f / 32768.f); }
#pragma unroll
              for (int bt = 0; bt < 2; ++bt) { float xc[8]; conv8(rx0[sI][bt], P[0], P[1], P[2], P[3], xc);
                  u32x4 w;
                  if (bt == 0) { w.x = cvt_pk_bf16(xc[0] * o0[0], xc[1] * o0[1]); w.y = cvt_pk_bf16(xc[2] * o0[2], xc[3] * o0[3]); w.z = cvt_pk_bf16(xc[4] * o0[4], xc[5] * o0[5]); w.w = cvt_pk_bf16(xc[6] * o0[6], xc[7] * o0[7]); }
                  else { w.x = cvt_pk_bf16(xc[0] * o1[0], xc[1] * o1[1]); w.y = cvt_pk_bf16(xc[2] * o1[2], xc[3] * o1[3]); w.z = cvt_pk_bf16(xc[4] * o1[4], xc[5] * o1[5]); w.w = cvt_pk_bf16(xc[6] * o1[6], xc[7] * o1[7]); }
                  *(u32x4*)(yT + (size_t)d * MTOK + bt * L + t0) = w; } } }
        __syncthreads();
        TPS_STOP(4);
        if (cvb3) {
        } else {
#pragma unroll 1
            for (int q = 0; q < 3; ++q) { if (cv_it < CV_NIT) { float cva[32]; const ConvItem cvc = moe_l1_item(F, cv_it); conv_issue(cvc, fresh_tid(F.wave) & 63, cva); conv_finish(cvc, fresh_tid(F.wave) & 63, cva); cv_it += cv_ngw; } }
        }
    }
    while (cv_it < CV_NIT) { float cvb[32]; const ConvItem c = moe_l1_item(F, cv_it); conv_issue(c, F.lane, cvb); conv_finish(c, F.lane, cvb); cv_it += cv_ngw; }
}
__device__ __forceinline__ void transpose_phase(const Frame& F) {
    const bf16* yT = (const bf16*)(F.ws + WS_A); bf16* y = (bf16*)(F.ws + WS_B);
    LAS bf16* tl = (LAS bf16*)(F.lds + F.wave * 16384);
    const int gw = F.bid * NWAVES + F.wave, NGW = F.G * NWAVES, lane = F.lane;
    const int NT = 32 * 512;
#define TR_LOAD(BUF, TILE) do { const int d0_ = ((TILE) & 31) * 64, t0_ = ((TILE) >> 5) * 64; \
        _Pragma("unroll") for (int i = 0; i < 8; ++i) { const int r = i * 8 + (lane >> 3), ch = lane & 7; BUF[i] = *(const u32x4*)(yT + (size_t)(d0_ + r) * MTOK + t0_ + ch * 8); } } while (0)
#define TR_EMIT(BUF, TILE) do { const int d0_ = ((TILE) & 31) * 64, t0_ = ((TILE) >> 5) * 64; \
        _Pragma("unroll") for (int i = 0; i < 8; ++i) { const int r = i * 8 + (lane >> 3), ch = lane & 7; *(LAS u32x4*)(tl + r * 72 + ch * 8) = BUF[i]; } \
        LDS_WAIT(); \
        _Pragma("unroll") for (int i = 0; i < 8; ++i) { const int tr = i * 8 + (lane >> 3), ch = lane & 7; unsigned short e[8]; \
            _Pragma("unroll") for (int k = 0; k < 8; ++k) e[k] = tl[(ch * 8 + k) * 72 + tr]; \
            u32x4 w; w.x = e[0] | ((unsigned)e[1] << 16); w.y = e[2] | ((unsigned)e[3] << 16); w.z = e[4] | ((unsigned)e[5] << 16); w.w = e[6] | ((unsigned)e[7] << 16); \
            *(u32x4*)(y + (size_t)(t0_ + tr) * DM + d0_ + ch * 8) = w; } \
        LDS_WAIT(); } while (0)
    u32x4 ba[8], bb[8];
    int tile = gw;
    if (tile < NT) TR_LOAD(ba, tile);
    for (; tile < NT; tile += 2 * NGW) {
        const int t1 = tile + NGW, t2 = tile + 2 * NGW;
        { const int tl1 = (t1 < NT) ? t1 : tile; TR_LOAD(bb, tl1); }
        TR_EMIT(ba, tile);
        { const int tl2 = (t2 < NT) ? t2 : tile; TR_LOAD(ba, tl2); }
        if (t1 < NT) TR_EMIT(bb, t1);
    }
#undef TR_LOAD
#undef TR_EMIT
}
}
__device__ __forceinline__ float hy_ftab_value(int f, int l, int jj) { return hy::ftab_value(f, l, jj); }
constexpr int NPHASE = 19;

__device__ __forceinline__ void moe_table(const Frame& F, int layer, LAS int* tab) {
    if (F.tid < NCLS) tab[32 + F.tid] = (int)__hip_atomic_load((unsigned*)(F.ctl + CW_CNT + (layer * NCLS + F.tid) * 64), RLX_AGENT);
    __syncthreads();
    if (F.tid == 0) { int a = 0; for (int c = 0; c < NCLS; ++c) { tab[c] = a; a += (tab[32 + c] + 255) >> 8; } tab[24] = a; }
    __syncthreads();
}

#ifndef PROBE_MASK
#define PROBE_MASK 0u
#endif
#ifndef TPM
#define TPM 0u
#endif
#define TP_MULT 4
#define IN(k) ((ONLY < 0 || (k) == ONLY) && lo <= (k) && (k) < hi)
#define SEAM(k) do { if ((k) + 1 < hi) { XcdBarrier b_ = bar; asm volatile("" : "+s"(b_.bar), "+s"(b_.x)); xcd_barrier(b_); } if (TPM != 0u && ONLY < 0 && ((TPM >> (k)) & 1u) && F.bid == 0 && F.tid == 0) TPW[0] += __builtin_amdgcn_s_memrealtime() - TPW[1]; if (PROBE_MASK != 0u && ONLY < 0) { if (F.tid == 0) { LAS unsigned long long* tp_ = (LAS unsigned long long*)(F.lds + MISC_OFF + 64); const unsigned long long t1_ = __builtin_amdgcn_s_memrealtime(); if ((PROBE_MASK >> (k)) & 1u) tp_[0] += t1_ - tp_[1]; tp_[1] = t1_; } } } while (0)
#define TPW ((LAS unsigned long long*)(F.lds + MISC_OFF + 96))
#define ENTER() do { int l_; asm volatile("v_mbcnt_lo_u32_b32 %0, -1, 0\n\tv_mbcnt_hi_u32_b32 %0, -1, %0" : "=&v"(l_)); const int t_ = F.wave * 64 + l_; F.tid = t_; F.lane = l_; int b_ = blockIdx.x, g_ = gridDim.x; asm volatile("" : "+s"(b_), "+s"(g_)); F.bid = b_; F.G = g_; if (TPM != 0u && ONLY < 0 && b_ == 0 && t_ == 0) TPW[1] = __builtin_amdgcn_s_memrealtime(); } while (0)
template <int ONLY> __device__ __forceinline__ void layer_phases(Frame& F, const XcdBarrier& bar, const int lo, const int hi, const int layer, LAS int* tab) {
        const int pb = 3 + 8 * layer;
        if (layer == 0) {
            if (IN(pb + 0)) { ENTER();
                pg::PlainSched S; S.init(F.ws + WS_A, F.ws + WS_WQKV, MTOK, QKVD, DM, DM, F.G, F.bid);
                pg::EpiQKV E{(bf16*)(F.ws + WS_B), (bf16*)(F.ws + WS_B + 128 * MiB), (bf16*)(F.ws + WS_B + 144 * MiB), AIN(I_ABIN), (const float*)(F.ws + WS_ROPE), (const float*)(F.ws + WS_ROPE) + 4096};
                pg::gemm_phase<pg::EpiQKV, pg::PlainSched, false, false, true>(F.lds, F.tid, DM, DM, DM, S, E);
                SEAM(pb + 0);
            }
            if (IN(pb + 1)) { ENTER(); att::attn_phase(F); SEAM(pb + 1); }
        } else {
            if (IN(pb + 0)) { ENTER();
                pg::PlainSched S; S.init(F.ws + WS_WHYIN, F.ws + WS_A, 3 * DM, MTOK, DM, DM, F.G, F.bid);
                pg::EpiBf16<true> E{(bf16*)(F.ws + WS_B), MTOK, AIN(I_HBIN)};
                pg::gemm_phase<pg::EpiBf16<true>, pg::PlainSched, false, false, true>(F.lds, F.tid, DM, DM, DM, S, E);
                SEAM(pb + 0);
            }
            if (IN(pb + 1)) { ENTER(); hy::hyena_phase(F); SEAM(pb + 1); }
            if (IN(pb + 2)) { ENTER(); hy::transpose_phase(F); SEAM(pb + 2); }
        }
        if (IN(pb + 3)) { ENTER();
            const void* A = layer ? (const void*)(F.ws + WS_B) : (const void*)(F.ws + WS_A);
            const void* Bt = layer ? (const void*)(F.ws + WS_WHYO) : (const void*)(F.ws + WS_WO0);
            bf16* O = (bf16*)(F.ws + WS_B + (layer ? 128 : 192) * MiB);
            pg::PlainSched S; S.init(A, Bt, MTOK, DM, DM, DM, F.G, F.bid);
            pg::EpiBf16<false> E{O, DM, layer ? AIN(I_HBOUT) : nullptr};
            pg::gemm_phase<pg::EpiBf16<false>, pg::PlainSched, false, false, true>(F.lds, F.tid, DM, DM, DM, S, E);
            SEAM(pb + 3);
        }
        if (IN(pb + 4)) { ENTER();
            if (layer == 0) ln1_router_phase<true>(F, 0, AIN(I_X), (const bf16*)(F.ws + WS_B + 192 * MiB), (bf16*)(F.ws + WS_A), (bf16*)(F.ws + WS_B + 192 * MiB));
            else ln1_router_phase<false>(F, 1, F.out, (const bf16*)(F.ws + WS_B + 128 * MiB), (bf16*)(F.ws + WS_A), (bf16*)(F.ws + WS_B + 256 * MiB));
            SEAM(pb + 4);
        }
        if (IN(pb + 5)) { ENTER();
            moe_table(F, layer, tab);
            pg::MoeSched S{tab, (const char*)(F.ws + WS_A), (const char*)(F.ws + WS_W13 + (size_t)layer * 128 * MiB), (const int*)(F.ws + WS_TOK), F.G, F.bid, 16, 0};
            pg::EpiMoe1 E{(bf16*)(F.ws + WS_B), (const float*)(F.ws + WS_GATE)};
            pg::gemm_phase<pg::EpiMoe1, pg::MoeSched, true, false, true>(F.lds, F.tid, DM, DM, DM, S, E);
            SEAM(pb + 5);
        }
        if (IN(pb + 6)) { ENTER();
            moe_table(F, layer, tab);
            pg::MoeSched S{tab, (const char*)(F.ws + WS_B), (const char*)(F.ws + WS_W2 + (size_t)layer * 64 * MiB), (const int*)(F.ws + WS_TOK), F.G, F.bid, 8, 1};
            pg::EpiMoe2 E{(bf16*)(F.ws + WS_A), (const int*)(F.ws + WS_TOK)};
            pg::gemm_phase<pg::EpiMoe2, pg::MoeSched, false, true, true>(F.lds, F.tid, DM, DM, EFF, S, E);
            SEAM(pb + 6);
        }
        if (IN(pb + 7)) { ENTER();
            if (layer == 0) ln2_phase<false>(F, 0, (bf16*)(F.ws + WS_A), (const bf16*)(F.ws + WS_B + 192 * MiB), F.out);
            else ln2_phase<true>(F, 1, (bf16*)(F.ws + WS_A), (const bf16*)(F.ws + WS_B + 256 * MiB), F.out);
            SEAM(pb + 7); }
}
template <int ONLY> __global__ void __launch_bounds__(NTHR, 2) fwd_kernel(Args args) {
    extern __shared__ __attribute__((aligned(16))) unsigned char lds_raw[];
    Frame F;
    F.lds = (LAS unsigned char*)lds_raw;
    F.tid = threadIdx.x; F.lane = F.tid & 63; F.wave = __builtin_amdgcn_readfirstlane(F.tid >> 6);
    F.G = gridDim.x; F.bid = blockIdx.x; F.ws = args.ws; F.ctl = (gu32*)(args.ws + WS_CTL); F.out = args.out;
    F.a = &args;
    for (int u = F.tid; u < (LDS_BYTES - RING_BYTES) / 4; u += NTHR) ((LAS unsigned*)(F.lds + RING_BYTES))[u] = 0u;
    __syncthreads();
    const int lo = args.ph_lo, hi = args.ph_hi;
    if (PROBE_MASK != 0u && ONLY >= 0) { if (F.bid == 0 && F.tid == 0) ((unsigned long long*)(F.ws + 512 * 1024))[ONLY] = __builtin_amdgcn_s_memrealtime(); }
    if (PROBE_MASK != 0u && ONLY < 0) { if (F.tid == 0) { LAS unsigned long long* tp_ = (LAS unsigned long long*)(F.lds + MISC_OFF + 64); tp_[0] = 0; tp_[1] = __builtin_amdgcn_s_memrealtime(); } }
    XcdBarrier bar; bar.bar = (unsigned*)(F.ctl + CW_BAR); bar.x = 0; bar.st = nullptr;
    if (ONLY < 0 && hi - lo > 1) bar = xcd_barrier_post((unsigned*)(F.ctl + CW_BAR), (volatile LAS unsigned*)(F.lds + MISC_OFF));
    LAS int* tab = (LAS int*)(F.lds + RING_BYTES + 64);

    if (IN(0)) { ENTER(); p0_prologue(F); SEAM(0); }
    if (IN(1)) { ENTER(); p1_prologue(F); if (TPM != 0u && ONLY < 0 && ((TPM >> 1) & 1u) && F.bid == 0 && F.tid == 0) TPW[0] += __builtin_amdgcn_s_memrealtime() - TPW[1]; }
    if (IN(2)) { ENTER();
        pg::PlainSched S; S.init(F.ws + WS_W4T, F.ws + WS_HDN, 4096, SEQ, 128, 128, F.G, F.bid);
        pg::EpiBf16<true> E{(bf16*)(F.ws + WS_HT), SEQ, nullptr};
        int kf = 128; asm volatile("" : "+s"(kf));
        pg::gemm_phase<pg::EpiBf16<true>, pg::PlainSched, false, false, true>(F.lds, F.tid, kf, 128, 128, S, E);
        SEAM(2);
    }
    if constexpr (ONLY >= 0) { if (ONLY >= 3 && ONLY < 11) layer_phases<ONLY>(F, bar, lo, hi, 0, tab); if (ONLY >= 11) layer_phases<ONLY>(F, bar, lo, hi, 1, tab); }
    else {
#pragma unroll 1
        for (int layer = 0; layer < 2; ++layer) layer_phases<ONLY>(F, bar, lo, hi, layer, tab);
    }
    if (PROBE_MASK != 0u && ONLY == NPHASE - 1) { __syncthreads(); if (F.bid == 0 && F.tid == 0) { const unsigned long long* ts = (const unsigned long long*)(F.ws + 512 * 1024); unsigned long long acc = 0, tend = __builtin_amdgcn_s_memrealtime();
        for (int k = 0; k < NPHASE; ++k) if (((PROBE_MASK >> k) & 1u) && k != 5) { int kn = k + 1; if (kn == 5) kn = 6; acc += ((kn < NPHASE) ? ts[kn] : tend) - ts[k]; }
        F.out[0] = 0.1f * (float)acc; } }
    if ((TPM != 0u || TPSEL >= 0) && ONLY < 0) { if (blockIdx.x == 0 && threadIdx.x == 0) { const unsigned long long acc = TPW[0] * TP_MULT, t0 = __builtin_amdgcn_s_memrealtime(); while (__builtin_amdgcn_s_memrealtime() - t0 < acc) __builtin_amdgcn_s_sleep(8); } }
    if (PROBE_MASK != 0u && ONLY < 0) { __syncthreads(); if (F.bid == 0 && F.tid == 0) F.out[0] = 0.1f * (float)((LAS unsigned long long*)(F.lds + MISC_OFF + 64))[0]; }
}
#undef IN
#undef SEAM

extern "C" void kernel_launch(void* const* d_in, const int* in_sizes, int n_in, void* d_out, int out_size, void* d_ws, size_t ws_size, hipStream_t stream) {
    static int grid = 0;
    if (grid == 0) {
        if (n_in != 34 || in_sizes[0] != MTOK * DM || out_size != MTOK * DM || ws_size < WS_END) { fprintf(stderr, "kernel_launch: unexpected shapes / workspace (n_in %d, ws %zu, need %zu)\n", n_in, ws_size, (size_t)WS_END); grid = -1; return; }
        int dev = 0, cus = 0;
        if (hipGetDevice(&dev) != hipSuccess || hipDeviceGetAttribute(&cus, hipDeviceAttributeMultiprocessorCount, dev) != hipSuccess) { grid = -1; return; }
#if !MK_SPLIT
        if (hipFuncSetAttribute((const void*)fwd_kernel<-1>, hipFuncAttributeMaxDynamicSharedMemorySize, LDS_BYTES) != hipSuccess) { fprintf(stderr, "kernel_launch: hipFuncSetAttribute failed\n"); grid = -1; return; }
        int per_cu = 0;
        if (hipOccupancyMaxActiveBlocksPerMultiprocessor(&per_cu, (const void*)fwd_kernel<-1>, NTHR, LDS_BYTES) != hipSuccess || per_cu < 1) fprintf(stderr, "kernel_launch: occupancy query reports %d blocks per CU\n", per_cu);
        (void)hipGetLastError();
#endif
        grid = cus;
    }
    if (grid < 0) return;
    (void)hipMemsetAsync((char*)d_ws + WS_CTL, 0, CTL_ZERO_BYTES, stream);
    Args a{};
    for (int i = 0; i < 34; ++i) a.in[i] = (const float*)d_in[i];
    a.out = (float*)d_out; a.ws = (unsigned char*)d_ws;
#if MK_SPLIT
    typedef void (*kfn)(Args);
    static const kfn fns[NPHASE] = {fwd_kernel<0>, fwd_kernel<1>, fwd_kernel<2>, fwd_kernel<3>, fwd_kernel<4>, nullptr, fwd_kernel<6>, fwd_kernel<7>, fwd_kernel<8>, fwd_kernel<9>, fwd_kernel<10>,
                                      fwd_kernel<11>, fwd_kernel<12>, fwd_kernel<13>, fwd_kernel<14>, fwd_kernel<15>, fwd_kernel<16>, fwd_kernel<17>, fwd_kernel<18>};
    static bool attr_done = false;
    if (!attr_done) { for (int ph = 0; ph < NPHASE; ++ph) if (fns[ph]) (void)hipFuncSetAttribute((const void*)fns[ph], hipFuncAttributeMaxDynamicSharedMemorySize, LDS_BYTES); attr_done = true; }
#ifndef REPEAT_MASK
#define REPEAT_MASK 0u
#endif
    for (int ph = 0; ph < NPHASE; ++ph) { if (!fns[ph]) continue; a.ph_lo = ph; a.ph_hi = ph + 1;
        for (int rep = 0; rep < (((REPEAT_MASK >> ph) & 1u) ? 2 : 1); ++rep) {
            if (rep == 1 && ph == 15) (void)hipMemsetAsync((char*)d_ws + WS_CTL + (size_t)(CW_CNT + NCLS * 64) * 4, 0, NCLS * 64 * 4, stream);
            hipLaunchKernelGGL(fns[ph], dim3(grid), dim3(NTHR), LDS_BYTES, stream, a); } }
#else
    a.ph_lo = 0; a.ph_hi = NPHASE; hipLaunchKernelGGL(fwd_kernel<-1>, dim3(grid), dim3(NTHR), LDS_BYTES, stream, a);
#endif
}
```
